# Optimizing an MI355X kernel written in HIP

```python
import math
import jax, jax.numpy as jnp
from jax import lax
import numpy as np

D_MODEL = 1024
BATCH = 8
SEQ = 2048
DEPTH = 2
DEC_BATCH = 8
DEC_SEQ = 32
PAST_LEN = 2048

CHUNK = 64
Q_BLOCK = 128
EPS = 1e-6
DA_HEADS = 8
DA_HEAD_DIM = 64
DA_QK_DIM = 2 * DA_HEAD_DIM
DA_V_DIM = 2 * DA_HEAD_DIM
DA_WIDTH = DA_HEADS * DA_V_DIM
ROPE_THETA = 500000.0
ROT_DIM = DA_HEAD_DIM // 4
RW_HEAD_DIM = 64
RW_HEADS = D_MODEL // RW_HEAD_DIM
RW_WIDTH = RW_HEADS * RW_HEAD_DIM
DECAY_LORA = 64
AAA_LORA = 64
GATE_LORA = 128
GN_EPS = 64e-5
D_FF = 2816
CONV_W = 3
P_DA = 3 * DA_WIDTH
RW_OFF_R = 0
RW_OFF_K = RW_WIDTH
RW_OFF_V = 2 * RW_WIDTH
RW_OFF_WD = 3 * RW_WIDTH
RW_OFF_AD = RW_OFF_WD + DECAY_LORA
RW_OFF_GD = RW_OFF_AD + AAA_LORA
P_RW = RW_OFF_GD + GATE_LORA
P_GATE = 2 * D_MODEL
P_TOTAL = P_DA + P_RW + P_GATE

kernel_name = 'diff_rwkv7_convffn_stream_step'


def rmsnorm(x, g):
    xf = x.astype(jnp.float32)
    y = xf * lax.rsqrt(jnp.mean(xf * xf, axis=-1, keepdims=True) + EPS)
    return (y * g.astype(jnp.float32)).astype(x.dtype)


def partial_rope(x, pos):
    inv = ROPE_THETA ** (-jnp.arange(0, ROT_DIM, 2, dtype=jnp.float32) / ROT_DIM)
    ang = pos.astype(jnp.float32)[:, None] * inv[None, :]
    cos = jnp.cos(ang)[None, :, None, None, :]
    sin = jnp.sin(ang)[None, :, None, None, :]
    xr = x[..., :ROT_DIM].astype(jnp.float32)
    x1, x2 = xr[..., :ROT_DIM // 2], xr[..., ROT_DIM // 2:]
    rot = jnp.concatenate([x1 * cos - x2 * sin, x2 * cos + x1 * sin], axis=-1).astype(x.dtype)
    return jnp.concatenate([rot, x[..., ROT_DIM:]], axis=-1)


def diff_attend(q, k, v, lam, mask):
    s = jnp.einsum('bqhcd,bkhcd->bchqk', q.astype(jnp.float32), k.astype(jnp.float32)) * (DA_HEAD_DIM ** -0.5)
    if mask is not None:
        s = jnp.where(mask, s, -1e30)
    p = jax.nn.softmax(s, axis=-1)
    pd = p[:, 0] - lam * p[:, 1]
    return jnp.einsum('bhqk,bkhd->bqhd', pd, v.astype(jnp.float32)).astype(v.dtype)


def diff_attn_prompt(q, k, v, lam):
    B, T = q.shape[0], q.shape[1]
    nb = T // Q_BLOCK
    qb = jnp.moveaxis(q.reshape(B, nb, Q_BLOCK, DA_HEADS, 2, DA_HEAD_DIM), 1, 0)
    kchunk = jnp.arange(T, dtype=jnp.int32) // CHUNK

    def blk(args):
        qi, i = args
        qchunk = (i * Q_BLOCK + jnp.arange(Q_BLOCK, dtype=jnp.int32)) // CHUNK
        mask = kchunk[None, :] <= qchunk[:, None]
        return diff_attend(qi, k, v, lam, mask)

    out = lax.map(blk, (qb, jnp.arange(nb, dtype=jnp.int32)))
    return jnp.moveaxis(out, 0, 1).reshape(B, T, DA_HEADS, DA_V_DIM)


def heads(t):
    return t.reshape(t.shape[0], t.shape[1], RW_HEADS, RW_HEAD_DIM).astype(jnp.float32)


def wkv7_scan(S0, r, w, k, v, kk, a):
    def step(S, inp):
        r_t, w_t, k_t, v_t, kk_t, a_t = inp
        sa = jnp.einsum('bhvk,bhk->bhv', S, -kk_t)
        S = (S * w_t[:, :, None, :] + sa[..., None] * (kk_t * a_t)[:, :, None, :]
             + v_t[..., None] * k_t[:, :, None, :])
        y = jnp.einsum('bhvk,bhk->bhv', S, r_t)
        return S, y

    xs = tuple(jnp.moveaxis(t, 1, 0) for t in (r, w, k, v, kk, a))
    S, ys = lax.scan(step, S0.astype(jnp.float32), xs)
    return S, jnp.moveaxis(ys, 0, 1)


def layer(x, pos, lidx, past_k, past_v, wkv0, shift0, conv0,
          norm_mix, w_in, da_lambda, da_subln, w_o_da,
          rw_mu, rw_w0, rw_w2, rw_a0, rw_a2, rw_g2, rw_k_k, rw_k_a, rw_r_k,
          rw_ln_w, rw_ln_b, w_o_rw, w_out, norm_ffn, w_up, ffn_conv, ffn_conv_b, w_down):
    B, T, _ = x.shape
    h = rmsnorm(x, norm_mix)
    proj = h @ w_in
    u_da = proj[..., :P_DA]
    u_rw = proj[..., P_DA:P_DA + P_RW]
    u_gate = proj[..., P_DA + P_RW:]

    q = partial_rope(u_da[..., :DA_WIDTH].reshape(B, T, DA_HEADS, 2, DA_HEAD_DIM), pos)
    k = partial_rope(u_da[..., DA_WIDTH:2 * DA_WIDTH].reshape(B, T, DA_HEADS, 2, DA_HEAD_DIM), pos)
    v = u_da[..., 2 * DA_WIDTH:].reshape(B, T, DA_HEADS, DA_V_DIM)
    lam_init = 0.8 - 0.6 * math.exp(-0.3 * lidx)
    lp = da_lambda.astype(jnp.float32)
    lam = jnp.exp(jnp.sum(lp[0] * lp[1])) - jnp.exp(jnp.sum(lp[2] * lp[3])) + lam_init
    if past_k is None:
        o = diff_attn_prompt(q, k, v, lam)
    else:
        k_all = jnp.concatenate([past_k.reshape(B, -1, DA_HEADS, 2, DA_HEAD_DIM).astype(k.dtype), k], axis=1)
        v_all = jnp.concatenate([past_v.astype(v.dtype), v], axis=1)
        o = diff_attend(q, k_all, v_all, lam, None)
    o = rmsnorm(o, da_subln) * (1.0 - lam_init)
    o_da = o.reshape(B, T, DA_WIDTH) @ w_o_da
    new_k = k.reshape(B, T, DA_HEADS, DA_QK_DIM)

    u_prev = jnp.concatenate([shift0.astype(u_rw.dtype), u_rw[:, :-1]], axis=1)
    us = (u_rw + (u_prev - u_rw) * rw_mu).astype(jnp.float32)
    new_shift = u_rw[:, -1:]
    r = heads(us[..., RW_OFF_R:RW_OFF_K])
    kr = us[..., RW_OFF_K:RW_OFF_V]
    vr = heads(us[..., RW_OFF_V:RW_OFF_WD])
    wd = us[..., RW_OFF_WD:RW_OFF_AD]
    ad = us[..., RW_OFF_AD:RW_OFF_GD]
    gd = us[..., RW_OFF_GD:]
    w_log = -jax.nn.softplus(-(rw_w0 + jnp.tanh(wd) @ rw_w2)) - 0.5
    decay = heads(jnp.exp(-jnp.exp(w_log)))
    a = jax.nn.sigmoid(rw_a0 + ad @ rw_a2)
    g = jax.nn.sigmoid(gd) @ rw_g2
    kk = heads(kr * rw_k_k)
    kk = kk * lax.rsqrt(jnp.maximum(jnp.sum(kk * kk, axis=-1, keepdims=True), 1e-24))
    kmod = heads(kr * (1.0 + (a - 1.0) * rw_k_a))
    S, y = wkv7_scan(wkv0, r, decay, kmod, vr, kk, heads(a))
    mu = jnp.mean(y, axis=-1, keepdims=True)
    var = jnp.mean(jnp.square(y - mu), axis=-1, keepdims=True)
    yn = ((y - mu) * lax.rsqrt(var + GN_EPS)).reshape(B, T, RW_WIDTH) * rw_ln_w + rw_ln_b
    bonus = (jnp.sum(r * kmod * rw_r_k, axis=-1, keepdims=True) * vr).reshape(B, T, RW_WIDTH)
    o_rw = ((yn + bonus) * g).astype(x.dtype) @ w_o_rw

    g_da = jax.nn.sigmoid(u_gate[..., :D_MODEL])
    g_rw = jax.nn.sigmoid(u_gate[..., D_MODEL:])
    x = x + (g_da * o_da + g_rw * o_rw) @ w_out

    h2 = rmsnorm(x, norm_ffn)
    up = h2 @ w_up
    hp = jnp.concatenate([conv0.astype(up.dtype), up], axis=1)
    c = ffn_conv_b + hp[:, 0:T] * ffn_conv[0]
    for j in range(1, CONV_W):
        c = c + hp[:, j:j + T] * ffn_conv[j]
    x = x + (jax.nn.silu(c[..., :D_FF]) * c[..., D_FF:]) @ w_down
    new_conv = hp[:, -(CONV_W - 1):]
    return x, new_k, v, S.astype(wkv0.dtype), new_shift, new_conv


def setup_inputs(seed: int = 0) -> dict:
    key = jax.random.key(seed)
    ks = jax.random.split(key, 32)
    f32 = jnp.float32

    def nrm(i, shape, scale):
        return jax.random.normal(ks[i], shape, f32) * scale

    return {
        'x_prompt': nrm(0, (BATCH, SEQ, D_MODEL), 1.0),
        'x_sample': nrm(1, (DEC_BATCH, DEC_SEQ, D_MODEL), 1.0),
        'cache_k': nrm(2, (DEPTH, DEC_BATCH, PAST_LEN, DA_HEADS, DA_QK_DIM), 1.0),
        'cache_v': nrm(3, (DEPTH, DEC_BATCH, PAST_LEN, DA_HEADS, DA_V_DIM), 1.0),
        'state_wkv': nrm(4, (DEPTH, DEC_BATCH, RW_HEADS, RW_HEAD_DIM, RW_HEAD_DIM), 0.3),
        'state_shift': nrm(5, (DEPTH, DEC_BATCH, 1, P_RW), 1.0),
        'state_ffn_conv': nrm(6, (DEPTH, DEC_BATCH, CONV_W - 1, 2 * D_FF), 1.0),
        'norm_mix': 1.0 + nrm(7, (DEPTH, D_MODEL), 0.02),
        'w_in': nrm(8, (DEPTH, D_MODEL, P_TOTAL), D_MODEL ** -0.5),
        'da_lambda': nrm(9, (DEPTH, 4, DA_HEAD_DIM), 0.1),
        'da_subln': 1.0 + nrm(10, (DEPTH, DA_V_DIM), 0.02),
        'w_o_da': nrm(11, (DEPTH, DA_WIDTH, D_MODEL), DA_WIDTH ** -0.5),
        'rw_mu': 0.5 + nrm(12, (DEPTH, P_RW), 0.1),
        'rw_w0': -1.0 + nrm(13, (DEPTH, RW_WIDTH), 0.5),
        'rw_w2': nrm(14, (DEPTH, DECAY_LORA, RW_WIDTH), 0.1),
        'rw_a0': nrm(15, (DEPTH, RW_WIDTH), 0.1),
        'rw_a2': nrm(16, (DEPTH, AAA_LORA, RW_WIDTH), 0.1),
        'rw_g2': nrm(17, (DEPTH, GATE_LORA, RW_WIDTH), GATE_LORA ** -0.5),
        'rw_k_k': 0.85 + nrm(18, (DEPTH, RW_WIDTH), 0.05),
        'rw_k_a': 1.0 + nrm(19, (DEPTH, RW_WIDTH), 0.05),
        'rw_r_k': nrm(20, (DEPTH, RW_HEADS, RW_HEAD_DIM), 0.1),
        'rw_ln_w': 1.0 + nrm(21, (DEPTH, RW_WIDTH), 0.02),
        'rw_ln_b': nrm(22, (DEPTH, RW_WIDTH), 0.01),
        'w_o_rw': nrm(23, (DEPTH, RW_WIDTH, D_MODEL), RW_WIDTH ** -0.5),
        'w_out': nrm(24, (DEPTH, D_MODEL, D_MODEL), D_MODEL ** -0.5),
        'norm_ffn': 1.0 + nrm(25, (DEPTH, D_MODEL), 0.02),
        'w_up': nrm(26, (DEPTH, D_MODEL, 2 * D_FF), D_MODEL ** -0.5),
        'ffn_conv': nrm(27, (DEPTH, CONV_W, 2 * D_FF), 0.5),
        'ffn_conv_b': nrm(28, (DEPTH, 2 * D_FF), 0.01),
        'w_down': nrm(29, (DEPTH, D_FF, D_MODEL), D_FF ** -0.5),
        'norm_final': 1.0 + nrm(30, (D_MODEL,), 0.02),
    }


def reference(x_prompt, x_sample, cache_k, cache_v, state_wkv, state_shift, state_ffn_conv,
              norm_mix, w_in, da_lambda, da_subln, w_o_da,
              rw_mu, rw_w0, rw_w2, rw_a0, rw_a2, rw_g2, rw_k_k, rw_k_a, rw_r_k,
              rw_ln_w, rw_ln_b, w_o_rw, w_out, norm_ffn, w_up, ffn_conv, ffn_conv_b, w_down,
              norm_final):
    Bp, Tp, _ = x_prompt.shape
    Bs, Ts, _ = x_sample.shape
    past = cache_k.shape[2]
    pos_p = jnp.arange(Tp, dtype=jnp.int32)
    pos_s = past + jnp.arange(Ts, dtype=jnp.int32)
    wkv_zero = jnp.zeros((Bp, RW_HEADS, RW_HEAD_DIM, RW_HEAD_DIM), x_prompt.dtype)
    shift_zero = jnp.zeros((Bp, 1, P_RW), x_prompt.dtype)
    conv_zero = jnp.zeros((Bp, CONV_W - 1, 2 * D_FF), x_prompt.dtype)

    xp, xs = x_prompt, x_sample
    outs_p, outs_s = [], []
    for l in range(DEPTH):
        wl = (norm_mix[l], w_in[l], da_lambda[l], da_subln[l], w_o_da[l],
              rw_mu[l], rw_w0[l], rw_w2[l], rw_a0[l], rw_a2[l], rw_g2[l], rw_k_k[l], rw_k_a[l], rw_r_k[l],
              rw_ln_w[l], rw_ln_b[l], w_o_rw[l], w_out[l], norm_ffn[l], w_up[l], ffn_conv[l], ffn_conv_b[l], w_down[l])
        xp, kp, vp, sp, shp, cp = layer(xp, pos_p, l, None, None, wkv_zero, shift_zero, conv_zero, *wl)
        xs, kq, vq, sq, shq, cq = layer(xs, pos_s, l, cache_k[l], cache_v[l], state_wkv[l],
                                        state_shift[l], state_ffn_conv[l], *wl)
        outs_p.append((kp, vp, sp, shp, cp))
        outs_s.append((kq, vq, sq, shq, cq))

    k_prompt, v_prompt, wkv_prompt, shift_prompt, conv_prompt = [jnp.stack(t) for t in zip(*outs_p)]
    k_sample, v_sample, wkv_sample, shift_sample, conv_sample = [jnp.stack(t) for t in zip(*outs_s)]
    y_prompt = rmsnorm(xp, norm_final)
    y_sample = rmsnorm(xs, norm_final)
    return (y_prompt, y_sample, k_prompt, v_prompt, wkv_prompt, shift_prompt, conv_prompt,
            k_sample, v_sample, wkv_sample, shift_sample, conv_sample)
```

```cpp
#include <hip/hip_runtime.h>
#include <cstdio>
#include <cstdint>
#include <cmath>

constexpr int D_MODEL = 1024, BATCH = 8, SEQ = 2048, DEPTH = 2, DEC_BATCH = 8, DEC_SEQ = 32, PAST_LEN = 2048;
constexpr int CHUNK = 64;
constexpr float EPS = 1e-6f;
constexpr int DA_HEADS = 8, DA_HEAD_DIM = 64, DA_QK_DIM = 128, DA_V_DIM = 128, DA_WIDTH = 1024;
constexpr int ROT_DIM = 16;
constexpr int RW_HEAD_DIM = 64, RW_HEADS = 16, RW_WIDTH = 1024;
constexpr int DECAY_LORA = 64, AAA_LORA = 64, GATE_LORA = 128;
constexpr float GN_EPS = 64e-5f;
constexpr int D_FF = 2816, CONV_W = 3;
constexpr int P_DA = 3072, P_RW = 3328, P_GATE = 2048, P_TOTAL = 8448;
constexpr int RW_OFF_R = 0, RW_OFF_K = 1024, RW_OFF_V = 2048, RW_OFF_WD = 3072, RW_OFF_AD = 3136, RW_OFF_GD = 3200;
constexpr int MP = BATCH * SEQ;
constexpr int MS = DEC_BATCH * DEC_SEQ;
constexpr int MT = MP + MS;

constexpr size_t O_YP = 0;
constexpr size_t O_YS = O_YP + (size_t)MP * D_MODEL;
constexpr size_t O_KP = O_YS + (size_t)MS * D_MODEL;
constexpr size_t O_VP = O_KP + (size_t)DEPTH * MP * 1024;
constexpr size_t O_WKVP = O_VP + (size_t)DEPTH * MP * 1024;
constexpr size_t O_SHP = O_WKVP + (size_t)DEPTH * BATCH * RW_HEADS * 64 * 64;
constexpr size_t O_CVP = O_SHP + (size_t)DEPTH * BATCH * P_RW;
constexpr size_t O_KS = O_CVP + (size_t)DEPTH * BATCH * 2 * 2 * D_FF;
constexpr size_t O_VS = O_KS + (size_t)DEPTH * MS * 1024;
constexpr size_t O_WKVS = O_VS + (size_t)DEPTH * MS * 1024;
constexpr size_t O_SHS = O_WKVS + (size_t)DEPTH * DEC_BATCH * RW_HEADS * 64 * 64;
constexpr size_t O_CVS = O_SHS + (size_t)DEPTH * DEC_BATCH * P_RW;
constexpr size_t O_END = O_CVS + (size_t)DEPTH * DEC_BATCH * 2 * 2 * D_FF;
static_assert(O_END == 87760896, "output size");

__device__ __forceinline__ float wave_sum(float v) {
#pragma unroll
    for (int o = 1; o < 64; o <<= 1) v += __shfl_xor(v, o);
    return v;
}
__device__ __forceinline__ float sigmoidf_(float x) { return 1.f / (1.f + expf(-x)); }

__global__ void __launch_bounds__(256) nv_rmsnorm(const float* __restrict__ x, const float* __restrict__ g, float* __restrict__ out, int rows) {
    const int row = blockIdx.x * 4 + (threadIdx.x >> 6), lane = threadIdx.x & 63;
    if (row >= rows) return;
    const float* xr = x + (size_t)row * D_MODEL;
    float v[16]; float s = 0.f;
#pragma unroll
    for (int j = 0; j < 16; ++j) { v[j] = xr[lane + 64 * j]; s += v[j] * v[j]; }
    s = wave_sum(s);
    const float r = 1.0f / sqrtf(s * (1.0f / D_MODEL) + EPS);
#pragma unroll
    for (int j = 0; j < 16; ++j) out[(size_t)row * D_MODEL + lane + 64 * j] = v[j] * r * g[lane + 64 * j];
}

template <bool ACCUM>
__global__ void __launch_bounds__(256) nv_gemm(const float* __restrict__ A, int lda, const float* __restrict__ W, int N, float* __restrict__ C, int ldc, int K) {
    __shared__ float As[8][128 + 4];
    __shared__ float Bs[8][128 + 4];
    const int tid = threadIdx.x, tx = tid & 15, ty = tid >> 4;
    const int m0 = blockIdx.y * 128, n0 = blockIdx.x * 128;
    float acc[8][8];
#pragma unroll
    for (int i = 0; i < 8; ++i)
#pragma unroll
        for (int j = 0; j < 8; ++j) acc[i][j] = 0.f;
    const int ar = tid >> 1, ak = (tid & 1) * 4;
    const int bk = tid >> 5, bn = (tid & 31) * 4;
    for (int k0 = 0; k0 < K; k0 += 8) {
        const float4 av = *(const float4*)(A + (size_t)(m0 + ar) * lda + k0 + ak);
        const float4 bv = *(const float4*)(W + (size_t)(k0 + bk) * N + n0 + bn);
        __syncthreads();
        As[ak + 0][ar] = av.x; As[ak + 1][ar] = av.y; As[ak + 2][ar] = av.z; As[ak + 3][ar] = av.w;
        *(float4*)&Bs[bk][bn] = bv;
        __syncthreads();
#pragma unroll
        for (int k = 0; k < 8; ++k) {
            float a[8], b[8];
            *(float4*)&a[0] = *(const float4*)&As[k][ty * 4];
            *(float4*)&a[4] = *(const float4*)&As[k][64 + ty * 4];
            *(float4*)&b[0] = *(const float4*)&Bs[k][tx * 4];
            *(float4*)&b[4] = *(const float4*)&Bs[k][64 + tx * 4];
#pragma unroll
            for (int i = 0; i < 8; ++i)
#pragma unroll
                for (int j = 0; j < 8; ++j) acc[i][j] = fmaf(a[i], b[j], acc[i][j]);
        }
    }
#pragma unroll
    for (int i = 0; i < 8; ++i) {
        const int r = m0 + (i < 4 ? ty * 4 + i : 64 + ty * 4 + (i - 4));
#pragma unroll
        for (int jh = 0; jh < 2; ++jh) {
            float* cp = C + (size_t)r * ldc + n0 + jh * 64 + tx * 4;
            float4 o = make_float4(acc[i][jh * 4 + 0], acc[i][jh * 4 + 1], acc[i][jh * 4 + 2], acc[i][jh * 4 + 3]);
            if (ACCUM) { const float4 c = *(const float4*)cp; o.x += c.x; o.y += c.y; o.z += c.z; o.w += c.w; }
            *(float4*)cp = o;
        }
    }
}

__global__ void nv_lambda(const float* __restrict__ da_lambda, float* __restrict__ lam) {
    const int l = blockIdx.x, lane = threadIdx.x;
    const float* lp = da_lambda + (size_t)l * 4 * DA_HEAD_DIM;
    const float s1 = wave_sum(lp[lane] * lp[64 + lane]);
    const float s2 = wave_sum(lp[128 + lane] * lp[192 + lane]);
    if (lane == 0) lam[l] = expf(s1) - expf(s2) + (0.8f - 0.6f * expf(-0.3f * (float)l));
}

struct RopeTab { float inv[8]; };

__global__ void __launch_bounds__(256) nv_rope_split(float* __restrict__ proj, int T, int pos0, float* __restrict__ kout, float* __restrict__ vout,
                                                     float* __restrict__ shift_out, RopeTab rt) {
    const int row = blockIdx.x, t = row % T, b = row / T;
    float* p = proj + (size_t)row * P_TOTAL;
    const float pos = (float)(pos0 + t);
    const int tid = threadIdx.x;
    {
        const int which = tid >> 7;
        const int pr = tid & 127;
        const int hm = pr >> 3, i = pr & 7;
        float* base = p + which * 1024 + hm * 64;
        const float ang = pos * rt.inv[i];
        const float c = (float)cos((double)ang), s = (float)sin((double)ang);
        const float x1 = base[i], x2 = base[i + 8];
        base[i] = x1 * c - x2 * s;
        base[i + 8] = x2 * c + x1 * s;
    }
    __syncthreads();
    for (int c = tid; c < 1024; c += 256) {
        kout[(size_t)row * 1024 + c] = p[1024 + c];
        vout[(size_t)row * 1024 + c] = p[2048 + c];
    }
    if (t == T - 1) for (int c = tid; c < P_RW; c += 256) shift_out[(size_t)b * P_RW + c] = p[P_DA + c];
}

template <bool CAUSAL>
__global__ void __launch_bounds__(64) nv_attn(const float* __restrict__ proj, int T, const float* __restrict__ knew, const float* __restrict__ vnew,
                                              const float* __restrict__ pastk, const float* __restrict__ pastv, int npast, float* __restrict__ oc, int Mg) {
    const int nqb = (T + 63) / 64;
    int bid = blockIdx.x;
    const int c = bid & 1; bid >>= 1;
    const int h = bid % DA_HEADS; bid /= DA_HEADS;
    const int qb = bid % nqb; const int b = bid / nqb;
    const int t = qb * 64 + threadIdx.x;
    const bool valid = t < T;
    const int tq = valid ? t : T - 1;
    const float* qp = proj + (size_t)(b * T + tq) * P_TOTAL + h * 128 + c * 64;
    float q[64];
#pragma unroll
    for (int d = 0; d < 64; ++d) q[d] = qp[d] * 0.125f;
    float o[128];
#pragma unroll
    for (int d = 0; d < 128; ++d) o[d] = 0.f;
    float m = -1e30f, l = 0.f;
    const int nnew = CAUSAL ? min(T, (qb + 1) * 64) : T;
    const int nk = npast + nnew;
    for (int j = 0; j < nk; ++j) {
        const float* kr; const float* vr;
        if (j < npast) { kr = pastk + ((size_t)b * npast + j) * 1024 + h * 128 + c * 64; vr = pastv + ((size_t)b * npast + j) * 1024 + h * 128; }
        else { const int jj = j - npast; kr = knew + ((size_t)b * T + jj) * 1024 + h * 128 + c * 64; vr = vnew + ((size_t)b * T + jj) * 1024 + h * 128; }
        float s = 0.f;
#pragma unroll
        for (int d = 0; d < 64; ++d) s = fmaf(q[d], kr[d], s);
        const float mn = fmaxf(m, s);
        const float alpha = expf(m - mn), pj = expf(s - mn);
        l = l * alpha + pj;
#pragma unroll
        for (int d = 0; d < 128; ++d) o[d] = fmaf(o[d], alpha, pj * vr[d]);
        m = mn;
    }
    if (valid) {
        const float il = 1.f / l;
        float* op = oc + ((size_t)c * Mg + (size_t)(b * T + t)) * 1024 + h * 128;
#pragma unroll
        for (int d = 0; d < 128; ++d) op[d] = o[d] * il;
    }
}

__global__ void __launch_bounds__(256) nv_attn_combine(const float* __restrict__ oc, int Mg, const float* __restrict__ lamp, float lam_init,
                                                       const float* __restrict__ subln, float* __restrict__ od) {
    const int wid = blockIdx.x * 4 + (threadIdx.x >> 6), lane = threadIdx.x & 63;
    const int row = wid / DA_HEADS, h = wid % DA_HEADS;
    if (row >= Mg) return;
    const float lam = lamp[0];
    const size_t off = (size_t)row * 1024 + h * 128;
    const float a0 = oc[off + lane] - lam * oc[(size_t)Mg * 1024 + off + lane];
    const float a1 = oc[off + 64 + lane] - lam * oc[(size_t)Mg * 1024 + off + 64 + lane];
    const float ss = wave_sum(a0 * a0 + a1 * a1);
    const float r = 1.0f / sqrtf(ss * (1.0f / 128.f) + EPS) * (1.f - lam_init);
    od[off + lane] = a0 * r * subln[lane];
    od[off + 64 + lane] = a1 * r * subln[64 + lane];
}

struct RwW { const float *mu, *w0, *w2, *a0, *a2, *g2, *k_k, *k_a, *r_k; };

__global__ void __launch_bounds__(256) nv_rwkv_prep(const float* __restrict__ proj, int T, const float* __restrict__ shift0  , RwW w,
                                                    float* __restrict__ R, float* __restrict__ Wd, float* __restrict__ KM, float* __restrict__ V,
                                                    float* __restrict__ KK, float* __restrict__ BB, float* __restrict__ G, float* __restrict__ BON) {
    __shared__ float us[P_RW];
    __shared__ float red[RW_WIDTH];
    __shared__ float red2[RW_WIDTH];
    const int row = blockIdx.x, t = row % T, b = row / T, tid = threadIdx.x;
    const float* u = proj + (size_t)row * P_TOTAL + P_DA;
    for (int c = tid; c < P_RW; c += 256) {
        const float uc = u[c];
        float up;
        if (t > 0) up = (u - P_TOTAL)[c]; else up = shift0 ? shift0[(size_t)b * P_RW + c] : 0.f;
        float val = uc + (up - uc) * w.mu[c];
        if (c >= RW_OFF_WD && c < RW_OFF_AD) val = tanhf(val);
        else if (c >= RW_OFF_GD) val = sigmoidf_(val);
        us[c] = val;
    }
    __syncthreads();
    float kkv[4], kmv[4], rv[4];
#pragma unroll
    for (int j = 0; j < 4; ++j) {
        const int c = tid + 256 * j;
        float wl = w.w0[c], al = w.a0[c], gl = 0.f;
        for (int i = 0; i < DECAY_LORA; ++i) wl = fmaf(us[RW_OFF_WD + i], w.w2[(size_t)i * RW_WIDTH + c], wl);
        for (int i = 0; i < AAA_LORA; ++i) al = fmaf(us[RW_OFF_AD + i], w.a2[(size_t)i * RW_WIDTH + c], al);
        for (int i = 0; i < GATE_LORA; ++i) gl = fmaf(us[RW_OFF_GD + i], w.g2[(size_t)i * RW_WIDTH + c], gl);
        const float xw = -wl;
        const float sp = (xw > 20.f) ? xw : log1pf(expf(xw));
        const float w_log = -sp - 0.5f;
        const float decay = expf(-expf(w_log));
        const float a = sigmoidf_(al);
        const float kr = us[RW_OFF_K + c], r = us[RW_OFF_R + c], v = us[RW_OFF_V + c];
        const float kk = kr * w.k_k[c];
        const float km = kr * (1.f + (a - 1.f) * w.k_a[c]);
        kkv[j] = kk; kmv[j] = km; rv[j] = r;
        const size_t o = (size_t)row * RW_WIDTH + c;
        R[o] = r; Wd[o] = decay; KM[o] = km; V[o] = v; G[o] = gl;
        red[c] = kk * kk;
        red2[c] = r * km * w.r_k[c];
        us[c] = a;
    }
    __syncthreads();
    __shared__ float hs[16], hb[16];
    if (tid < 16) { float s = 0.f, s2 = 0.f; for (int i = 0; i < 64; ++i) { s += red[tid * 64 + i]; s2 += red2[tid * 64 + i]; } hs[tid] = s; hb[tid] = s2; }
    __syncthreads();
    if (tid < 16) BON[(size_t)row * 16 + tid] = hb[tid];
#pragma unroll
    for (int j = 0; j < 4; ++j) {
        const int c = tid + 256 * j;
        const float inv = 1.0f / sqrtf(fmaxf(hs[c >> 6], 1e-24f));
        const float kk = kkv[j] * inv;
        const size_t o = (size_t)row * RW_WIDTH + c;
        KK[o] = kk; BB[o] = kk * us[c];
    }
}

__global__ void __launch_bounds__(64) nv_scan(const float* __restrict__ R, const float* __restrict__ Wd, const float* __restrict__ KM, const float* __restrict__ V,
                                              const float* __restrict__ KK, const float* __restrict__ BB, int T, const float* __restrict__ S0  ,
                                              float* __restrict__ Sout  , float* __restrict__ Y) {
    const int b = blockIdx.x / RW_HEADS, h = blockIdx.x % RW_HEADS, lane = threadIdx.x;
    float S[64];
    if (S0) {
#pragma unroll
        for (int k = 0; k < 64; ++k) S[k] = S0[(((size_t)b * RW_HEADS + h) * 64 + lane) * 64 + k];
    } else {
#pragma unroll
        for (int k = 0; k < 64; ++k) S[k] = 0.f;
    }
    __shared__ float sh[5][64];
    size_t o = ((size_t)b * T) * RW_WIDTH + h * 64;
    float n0 = R[o + lane], n1 = Wd[o + lane], n2 = KM[o + lane], n3 = KK[o + lane], n4 = BB[o + lane], nv = V[o + lane];
    for (int t = 0; t < T; ++t) {
        __syncthreads();
        sh[0][lane] = n0; sh[1][lane] = n1; sh[2][lane] = n2; sh[3][lane] = n3; sh[4][lane] = n4;
        const float v = nv;
        const size_t oc = o;
        if (t + 1 < T) { o += RW_WIDTH; n0 = R[o + lane]; n1 = Wd[o + lane]; n2 = KM[o + lane]; n3 = KK[o + lane]; n4 = BB[o + lane]; nv = V[o + lane]; }
        __syncthreads();
        float sa = 0.f;
#pragma unroll
        for (int k = 0; k < 64; ++k) sa = fmaf(S[k], -sh[3][k], sa);
        float y = 0.f;
#pragma unroll
        for (int k = 0; k < 64; ++k) { S[k] = S[k] * sh[1][k] + sa * sh[4][k] + v * sh[2][k]; y = fmaf(S[k], sh[0][k], y); }
        Y[oc + lane] = y;
    }
#pragma unroll
    for (int k = 0; k < 64; ++k) Sout[(((size_t)b * RW_HEADS + h) * 64 + lane) * 64 + k] = S[k];
}

__global__ void __launch_bounds__(256) nv_rwkv_post(const float* __restrict__ Y, const float* __restrict__ V, const float* __restrict__ G, const float* __restrict__ BON,
                                                    const float* __restrict__ ln_w, const float* __restrict__ ln_b, float* __restrict__ out, int Mg) {
    const int wid = blockIdx.x * 4 + (threadIdx.x >> 6), lane = threadIdx.x & 63;
    const int row = wid / RW_HEADS, h = wid % RW_HEADS;
    if (row >= Mg) return;
    const size_t o = (size_t)row * RW_WIDTH + h * 64 + lane;
    const float y = Y[o];
    const float mu = wave_sum(y) * (1.f / 64.f);
    const float d = y - mu;
    const float var = wave_sum(d * d) * (1.f / 64.f);
    const float yn = d * (1.0f / sqrtf(var + GN_EPS)) * ln_w[h * 64 + lane] + ln_b[h * 64 + lane];
    const float bonus = BON[(size_t)row * 16 + h] * V[o];
    out[o] = (yn + bonus) * G[o];
}

__global__ void __launch_bounds__(256) nv_merge(const float* __restrict__ proj, const float* __restrict__ oda, const float* __restrict__ orw, float* __restrict__ m, int Mg) {
    const size_t i = (size_t)blockIdx.x * 256 + threadIdx.x;
    if (i >= (size_t)Mg * 1024) return;
    const size_t row = i >> 10; const int c = (int)(i & 1023);
    const float ga = sigmoidf_(proj[row * P_TOTAL + P_DA + P_RW + c]), gb = sigmoidf_(proj[row * P_TOTAL + P_DA + P_RW + 1024 + c]);
    m[i] = ga * oda[i] + gb * orw[i];
}

__global__ void __launch_bounds__(256) nv_conv_gate(const float* __restrict__ up, int T, const float* __restrict__ conv0  ,
                                                    const float* __restrict__ cw  , const float* __restrict__ cb, float* __restrict__ gt,
                                                    float* __restrict__ conv_out  ) {
    const int row = blockIdx.x, t = row % T, b = row / T;
    for (int j = threadIdx.x; j < D_FF; j += 256) {
        float cc[2];
#pragma unroll
        for (int hlf = 0; hlf < 2; ++hlf) {
            const int col = j + hlf * D_FF;
            const float u0 = up[(size_t)row * 2 * D_FF + col];
            float u1, u2;
            if (t >= 1) u1 = up[(size_t)(row - 1) * 2 * D_FF + col]; else u1 = conv0 ? conv0[((size_t)b * 2 + 1) * 2 * D_FF + col] : 0.f;
            if (t >= 2) u2 = up[(size_t)(row - 2) * 2 * D_FF + col]; else u2 = conv0 ? conv0[((size_t)b * 2 + t) * 2 * D_FF + col] : 0.f;
            cc[hlf] = cb[col] + u2 * cw[col] + u1 * cw[2 * D_FF + col] + u0 * cw[2 * 2 * D_FF + col];
        }
        const float s = cc[0] / (1.f + expf(-cc[0]));
        gt[(size_t)row * D_FF + j] = s * cc[1];
    }
    if (t >= T - 2) {
        const int slot = t - (T - 2);
        for (int c = threadIdx.x; c < 2 * D_FF; c += 256) conv_out[((size_t)b * 2 + slot) * 2 * D_FF + c] = up[(size_t)row * 2 * D_FF + c];
    }
}

struct LayerW {
    const float *norm_mix, *w_in, *da_lambda, *da_subln, *w_o_da, *rw_mu, *rw_w0, *rw_w2, *rw_a0, *rw_a2, *rw_g2, *rw_k_k, *rw_k_a, *rw_r_k, *rw_ln_w, *rw_ln_b,
        *w_o_rw, *w_out, *norm_ffn, *w_up, *ffn_conv, *ffn_conv_b, *w_down;
};

extern "C" void kernel_launch(void* const* d_in, const int* in_sizes, int n_in, void* d_out, int out_size, void* d_ws, size_t ws_size, hipStream_t stream) {
    (void)in_sizes; (void)n_in; (void)out_size;
    const float* x_prompt = (const float*)d_in[0];
    const float* x_sample = (const float*)d_in[1];
    const float* cache_k = (const float*)d_in[2];
    const float* cache_v = (const float*)d_in[3];
    const float* state_wkv = (const float*)d_in[4];
    const float* state_shift = (const float*)d_in[5];
    const float* state_conv = (const float*)d_in[6];
    float* out = (float*)d_out;
    RopeTab rt;
    for (int i = 0; i < 8; ++i) rt.inv[i] = (float)pow(500000.0, -(double)i / 8.0);

    constexpr int MG = 4096;
    float* ws = (float*)d_ws;
    size_t off = 0;
    auto take = [&](size_t n) { float* p = ws + off; off += (n + 63) & ~(size_t)63; return p; };
    float* XALL = take((size_t)MT * 1024);
    float* PROJ = take((size_t)MG * P_TOTAL);
    float* HN = take((size_t)MG * 1024);
    float* POOL = take((size_t)MG * 1024 * 10);
    float* OD = take((size_t)MG * 1024);
    float* ORW = take((size_t)MG * 1024);
    float* ODAP = take((size_t)MG * 1024);
    float* ORWP = take((size_t)MG * 1024);
    float* MRG = take((size_t)MG * 1024);
    float* BON = take((size_t)MG * 16);
    float* LAM = take(64);
    if (off * 4 > ws_size) { fprintf(stderr, "workspace too small: need %zu have %zu\n", off * 4, ws_size); return; }
    float* OC = POOL; float* R = POOL + (size_t)MG * 1024 * 2; float* Wd = R + (size_t)MG * 1024; float* KM = Wd + (size_t)MG * 1024; float* V = KM + (size_t)MG * 1024;
    float* KK = V + (size_t)MG * 1024; float* BB = KK + (size_t)MG * 1024; float* G = BB + (size_t)MG * 1024; float* Y = G + (size_t)MG * 1024;
    float* UP = POOL; float* GT = POOL + (size_t)MG * 2 * D_FF;

    hipMemcpyAsync(XALL, x_prompt, (size_t)MP * 1024 * 4, hipMemcpyDeviceToDevice, stream);
    hipMemcpyAsync(XALL + (size_t)MP * 1024, x_sample, (size_t)MS * 1024 * 4, hipMemcpyDeviceToDevice, stream);
    nv_lambda<<<DEPTH, 64, 0, stream>>>((const float*)d_in[9], LAM);

    for (int l = 0; l < DEPTH; ++l) {
        LayerW w;
        w.norm_mix = (const float*)d_in[7] + (size_t)l * 1024;
        w.w_in = (const float*)d_in[8] + (size_t)l * 1024 * P_TOTAL;
        w.da_lambda = (const float*)d_in[9] + (size_t)l * 256;
        w.da_subln = (const float*)d_in[10] + (size_t)l * 128;
        w.w_o_da = (const float*)d_in[11] + (size_t)l * 1024 * 1024;
        w.rw_mu = (const float*)d_in[12] + (size_t)l * P_RW;
        w.rw_w0 = (const float*)d_in[13] + (size_t)l * 1024;
        w.rw_w2 = (const float*)d_in[14] + (size_t)l * 64 * 1024;
        w.rw_a0 = (const float*)d_in[15] + (size_t)l * 1024;
        w.rw_a2 = (const float*)d_in[16] + (size_t)l * 64 * 1024;
        w.rw_g2 = (const float*)d_in[17] + (size_t)l * 128 * 1024;
        w.rw_k_k = (const float*)d_in[18] + (size_t)l * 1024;
        w.rw_k_a = (const float*)d_in[19] + (size_t)l * 1024;
        w.rw_r_k = (const float*)d_in[20] + (size_t)l * 1024;
        w.rw_ln_w = (const float*)d_in[21] + (size_t)l * 1024;
        w.rw_ln_b = (const float*)d_in[22] + (size_t)l * 1024;
        w.w_o_rw = (const float*)d_in[23] + (size_t)l * 1024 * 1024;
        w.w_out = (const float*)d_in[24] + (size_t)l * 1024 * 1024;
        w.norm_ffn = (const float*)d_in[25] + (size_t)l * 1024;
        w.w_up = (const float*)d_in[26] + (size_t)l * 1024 * 2 * D_FF;
        w.ffn_conv = (const float*)d_in[27] + (size_t)l * 3 * 2 * D_FF;
        w.ffn_conv_b = (const float*)d_in[28] + (size_t)l * 2 * D_FF;
        w.w_down = (const float*)d_in[29] + (size_t)l * D_FF * 1024;
        const float lam_init = 0.8f - 0.6f * expf(-0.3f * (float)l);
        RwW rw{w.rw_mu, w.rw_w0, w.rw_w2, w.rw_a0, w.rw_a2, w.rw_g2, w.rw_k_k, w.rw_k_a, w.rw_r_k};

        for (int g = 0; g < 5; ++g) {
            const bool smp = (g == 4);
            const int Bg = smp ? DEC_BATCH : 2, T = smp ? DEC_SEQ : SEQ, Mg = Bg * T;
            const int b0 = smp ? 0 : 2 * g;
            const size_t row0 = smp ? (size_t)MP : (size_t)b0 * SEQ;
            float* X = XALL + row0 * 1024;
            float* kout = out + (smp ? O_KS + (size_t)l * MS * 1024 : O_KP + ((size_t)l * MP + row0) * 1024);
            float* vout = out + (smp ? O_VS + (size_t)l * MS * 1024 : O_VP + ((size_t)l * MP + row0) * 1024);
            float* shout = out + (smp ? O_SHS + (size_t)l * DEC_BATCH * P_RW : O_SHP + ((size_t)l * BATCH + b0) * P_RW);
            float* wkvout = out + (smp ? O_WKVS + (size_t)l * DEC_BATCH * 16 * 4096 : O_WKVP + ((size_t)l * BATCH + b0) * 16 * 4096);
            float* cvout = out + (smp ? O_CVS + (size_t)l * DEC_BATCH * 2 * 2 * D_FF : O_CVP + ((size_t)l * BATCH + b0) * 2 * 2 * D_FF);
            const float* pk = smp ? cache_k + (size_t)l * DEC_BATCH * PAST_LEN * 1024 : nullptr;
            const float* pv = smp ? cache_v + (size_t)l * DEC_BATCH * PAST_LEN * 1024 : nullptr;
            const float* s0 = smp ? state_wkv + (size_t)l * DEC_BATCH * 16 * 4096 : nullptr;
            const float* sh0 = smp ? state_shift + (size_t)l * DEC_BATCH * P_RW : nullptr;
            const float* cv0 = smp ? state_conv + (size_t)l * DEC_BATCH * 2 * 2 * D_FF : nullptr;

            nv_rmsnorm<<<Mg / 4, 256, 0, stream>>>(X, w.norm_mix, HN, Mg);
            nv_gemm<false><<<dim3(P_TOTAL / 128, Mg / 128), 256, 0, stream>>>(HN, 1024, w.w_in, P_TOTAL, PROJ, P_TOTAL, 1024);
            nv_rope_split<<<Mg, 256, 0, stream>>>(PROJ, T, smp ? PAST_LEN : 0, kout, vout, shout, rt);
            {
                const int nqb = (T + 63) / 64;
                if (smp) nv_attn<false><<<Bg * nqb * DA_HEADS * 2, 64, 0, stream>>>(PROJ, T, kout, vout, pk, pv, PAST_LEN, OC, Mg);
                else nv_attn<true><<<Bg * nqb * DA_HEADS * 2, 64, 0, stream>>>(PROJ, T, kout, vout, nullptr, nullptr, 0, OC, Mg);
                nv_attn_combine<<<Mg * DA_HEADS / 4, 256, 0, stream>>>(OC, Mg, LAM + l, lam_init, w.da_subln, OD);
            }
            nv_rwkv_prep<<<Mg, 256, 0, stream>>>(PROJ, T, sh0, rw, R, Wd, KM, V, KK, BB, G, BON);
            nv_scan<<<Bg * RW_HEADS, 64, 0, stream>>>(R, Wd, KM, V, KK, BB, T, s0, wkvout, Y);
            nv_rwkv_post<<<Mg * RW_HEADS / 4, 256, 0, stream>>>(Y, V, G, BON, w.rw_ln_w, w.rw_ln_b, ORW, Mg);
            nv_gemm<false><<<dim3(1024 / 128, Mg / 128), 256, 0, stream>>>(OD, 1024, w.w_o_da, 1024, ODAP, 1024, 1024);
            nv_gemm<false><<<dim3(1024 / 128, Mg / 128), 256, 0, stream>>>(ORW, 1024, w.w_o_rw, 1024, ORWP, 1024, 1024);
            nv_merge<<<Mg * 4, 256, 0, stream>>>(PROJ, ODAP, ORWP, MRG, Mg);
            nv_gemm<true><<<dim3(1024 / 128, Mg / 128), 256, 0, stream>>>(MRG, 1024, w.w_out, 1024, X, 1024, 1024);
            nv_rmsnorm<<<Mg / 4, 256, 0, stream>>>(X, w.norm_ffn, HN, Mg);
            nv_gemm<false><<<dim3(2 * D_FF / 128, Mg / 128), 256, 0, stream>>>(HN, 1024, w.w_up, 2 * D_FF, UP, 2 * D_FF, 1024);
            nv_conv_gate<<<Mg, 256, 0, stream>>>(UP, T, cv0, w.ffn_conv, w.ffn_conv_b, GT, cvout);
            nv_gemm<true><<<dim3(1024 / 128, Mg / 128), 256, 0, stream>>>(GT, D_FF, w.w_down, 1024, X, 1024, D_FF);
        }
    }
    nv_rmsnorm<<<MT / 4, 256, 0, stream>>>(XALL, (const float*)d_in[30], out + O_YP, MT);
}
```

```cpp
#include <hip/hip_runtime.h>
#include <cstdio>
#include <cstdint>
#include <cmath>

#ifndef MK_PER_PHASE
#define MK_PER_PHASE 0
#endif

constexpr int D_MODEL = 1024, BATCH = 8, SEQ = 2048, DEPTH = 2, DEC_BATCH = 8, DEC_SEQ = 32, PAST_LEN = 2048;
constexpr float EPS = 1e-6f, GN_EPS = 64e-5f;
constexpr int DA_HEADS = 8, RW_HEADS = 16;
constexpr int D_FF = 2816, UPW = 2 * D_FF;
constexpr int P_DA = 3072, P_RW = 3328, P_GATE = 2048, P_TOTAL = 8448;
constexpr int MP = BATCH * SEQ, MS = DEC_BATCH * DEC_SEQ, MT = MP + MS;
constexpr int NKEYS_S = PAST_LEN + DEC_SEQ;
constexpr float C2 = 0.125f * 1.4426950408889634f;

constexpr size_t O_YP = 0;
constexpr size_t O_YS = O_YP + (size_t)MP * D_MODEL;
constexpr size_t O_KP = O_YS + (size_t)MS * D_MODEL;
constexpr size_t O_VP = O_KP + (size_t)DEPTH * MP * 1024;
constexpr size_t O_WKVP = O_VP + (size_t)DEPTH * MP * 1024;
constexpr size_t O_SHP = O_WKVP + (size_t)DEPTH * BATCH * RW_HEADS * 64 * 64;
constexpr size_t O_CVP = O_SHP + (size_t)DEPTH * BATCH * P_RW;
constexpr size_t O_KS = O_CVP + (size_t)DEPTH * BATCH * 2 * UPW;
constexpr size_t O_VS = O_KS + (size_t)DEPTH * MS * 1024;
constexpr size_t O_WKVS = O_VS + (size_t)DEPTH * MS * 1024;
constexpr size_t O_SHS = O_WKVS + (size_t)DEPTH * DEC_BATCH * RW_HEADS * 64 * 64;
constexpr size_t O_CVS = O_SHS + (size_t)DEPTH * DEC_BATCH * P_RW;
constexpr size_t O_END = O_CVS + (size_t)DEPTH * DEC_BATCH * 2 * UPW;
static_assert(O_END == 87760896, "output size");

namespace pg8 {
#define PG8_LAS __attribute__((address_space(3)))
typedef unsigned short bf16_t;
typedef short bf16x8 __attribute__((ext_vector_type(8)));
typedef float f32x4 __attribute__((ext_vector_type(4)));
typedef unsigned u32x4 __attribute__((ext_vector_type(4)));
constexpr int BM = 256, BK = 64, HALF = 128, HTB = HALF * BK * 2  , STAGE_BYTES = 8 * HTB, NXCD = 8, WGM = 8;

__host__ __device__ __forceinline__ int lds_byte(int r, int c) { const int st = (r >> 4) * 2 + (c >> 5), rr = r & 15, cc = c & 31, ob = rr * 64 + cc * 2; return st * 1024 + (ob ^ (((ob >> 9) & 1) << 5)); }
__host__ __device__ __forceinline__ void stage_rc(int b, int& R, int& C) { const int st = b / 1024, sb = b % 1024, swz = sb ^ (((sb >> 9) & 1) << 5); R = (st >> 1) * 16 + swz / 64; C = (st & 1) * 32 + (swz % 64) / 2; }
__host__ __device__ __forceinline__ int perm32(int rho) { const int n = rho >> 4, i = rho & 15; return 8 * (i >> 2) + 4 * n + (i & 3); }

struct Unit { int pm, pn; };
struct Gemm { const bf16_t* A; const bf16_t* Bt; int M, N, K; };

struct StaticOrder {
    int nM, nN, nwg, G, c;
    __host__ __device__ void init(int M, int N, int G_, int c_) { nM = M / BM; nN = N / BM; nwg = nM * nN; G = G_; c = c_; }
    __host__ __device__ bool next(int i, Unit& u) const {
        const long L = (long)i * G + c; if (L >= nwg) return false;
        int wgid = (int)L; { const int q = nwg / NXCD, r = nwg % NXCD, xcd = wgid % NXCD, off = wgid / NXCD; wgid = (xcd < r ? xcd * (q + 1) : r * (q + 1) + (xcd - r) * q) + off; }
        const int nig = WGM * nN, gid = wgid / nig, fm = gid * WGM, gsz = (nM - fm) < WGM ? (nM - fm) : WGM;
        u.pm = fm + ((wgid % nig) % gsz); u.pn = (wgid % nig) / gsz; return true;
    }
    __device__ __forceinline__ void a_ready(const Unit&) const {}
    __device__ __forceinline__ void done(const Unit&) const {}
};

typedef float f32x2_cv __attribute__((ext_vector_type(2))); typedef __bf16 bf16x2_cv __attribute__((ext_vector_type(2)));
__device__ __forceinline__ unsigned cvt_pk_bf16(float lo, float hi) { const f32x2_cv v = {lo, hi}; const bf16x2_cv b = __builtin_convertvector(v, bf16x2_cv); return __builtin_bit_cast(unsigned, b); }
typedef float f32x2 __attribute__((ext_vector_type(2)));
__device__ __forceinline__ float bf2f(unsigned short h) { return __uint_as_float((unsigned)h << 16); }
__device__ __forceinline__ float fast_sigmoid(float x) { return __builtin_amdgcn_rcpf(1.0f + __builtin_amdgcn_exp2f(-1.4426950408889634f * x)); }
__device__ __forceinline__ float neg_decay_log(float x) {
    const float y = -x, sp = fmaxf(y, 0.f) + 0.6931471805599453f * __builtin_amdgcn_logf(1.0f + __builtin_amdgcn_exp2f(-1.4426950408889634f * fabsf(y)));
    return -__builtin_amdgcn_exp2f(-1.4426950408889634f * (sp + 0.5f));
}
__device__ __forceinline__ u32x4 pack8(const f32x4 v0, const f32x4 v1) { u32x4 w; w.x = cvt_pk_bf16(v0[0], v0[1]); w.y = cvt_pk_bf16(v0[2], v0[3]); w.z = cvt_pk_bf16(v1[0], v1[1]); w.w = cvt_pk_bf16(v1[2], v1[3]); return w; }
__device__ __forceinline__ void unpack8(const u32x4 w, f32x4& v0, f32x4& v1) {
    v0[0] = __uint_as_float(w.x << 16); v0[1] = __uint_as_float(w.x & 0xffff0000u); v0[2] = __uint_as_float(w.y << 16); v0[3] = __uint_as_float(w.y & 0xffff0000u);
    v1[0] = __uint_as_float(w.z << 16); v1[1] = __uint_as_float(w.z & 0xffff0000u); v1[2] = __uint_as_float(w.w << 16); v1[3] = __uint_as_float(w.w & 0xffff0000u);
}
constexpr int E_MP = 16384, E_MS = 256;

struct EpiIn {
    static constexpr bool PERM = true, AFTER_DRAIN = false;
    const float* ss; const float* rope;
    bf16_t *Q, *K, *V, *URW, *GATE;
    float *kout_p, *vout_p, *kout_s, *vout_s;
    float *sh_p, *sh_s;
    __device__ __forceinline__ void operator()(const f32x4 (&acc)[2][2][4][2], const Unit& u, int wr, int wc, int fr, int fq) const {
        const int pn = u.pn, rowb = u.pm * BM + wr * 64 + fr, cl = wc * 32 + 8 * fq;
        const bool rope_wave = (pn < 8) && ((wc & 1) == 0);
        const float sgn = (fq == 0) ? -1.f : 1.f;
#pragma unroll
        for (int ai = 0; ai < 2; ++ai)
#pragma unroll
            for (int m = 0; m < 4; ++m) {
                const int row = rowb + ai * HALF + m * 16;
                const float rstd = 1.0f / sqrtf(ss[row] * (1.0f / 1024.f) + 1e-6f);
                const bool smp = row >= E_MP;
                const int t = smp ? ((row - E_MP) & 31) : (row & 2047);
                const int bb = smp ? ((row - E_MP) >> 5) : (row >> 11);
                const int pos = smp ? 2048 + t : t;
                const bool last = smp ? (t == 31) : (t == 2047);
#pragma unroll
                for (int bj = 0; bj < 2; ++bj) {
                    f32x4 v0 = acc[ai][bj][m][0] * rstd, v1 = acc[ai][bj][m][1] * rstd;
                    const int col = pn * BM + bj * HALF + cl;
                    if (pn < 8) {
                        if (rope_wave) {
                            f32x4 p0, p1;
#pragma unroll
                            for (int j = 0; j < 4; ++j) { p0[j] = __shfl_xor(v0[j], 16); p1[j] = __shfl_xor(v1[j], 16); }
                            if (fq < 2) {
                                const float* tb = rope + pos * 16;
                                const f32x4 c0 = *(const f32x4*)(tb), c1 = *(const f32x4*)(tb + 4), s0 = *(const f32x4*)(tb + 8), s1 = *(const f32x4*)(tb + 12);
                                v0 = v0 * c0 + (p0 * s0) * sgn; v1 = v1 * c1 + (p1 * s1) * sgn;
                            }
                        }
                        if (pn < 4) { v0 = v0 * C2; v1 = v1 * C2; *(u32x4*)(Q + (size_t)row * 1024 + col) = pack8(v0, v1); }
                        else {
                            const int c = col - 1024;
                            *(u32x4*)(K + (size_t)row * 1024 + c) = pack8(v0, v1);
                            float* o = smp ? kout_s + (size_t)(row - E_MP) * 1024 + c : kout_p + (size_t)row * 1024 + c;
                            *(f32x4*)o = v0; *(f32x4*)(o + 4) = v1;
                        }
                    } else if (pn < 12) {
                        const int c = col - 2048;
                        *(u32x4*)(V + (size_t)row * 1024 + c) = pack8(v0, v1);
                        float* o = smp ? vout_s + (size_t)(row - E_MP) * 1024 + c : vout_p + (size_t)row * 1024 + c;
                        *(f32x4*)o = v0; *(f32x4*)(o + 4) = v1;
                    } else if (pn < 25) {
                        const int c = col - 3072;
                        *(u32x4*)(URW + (size_t)row * 3328 + c) = pack8(v0, v1);
                        if (last) { float* o = (smp ? sh_s : sh_p) + (size_t)bb * 3328 + c; *(f32x4*)o = v0; *(f32x4*)(o + 4) = v1; }
                    } else {
                        const int c = col - 6400;
#pragma unroll
                        for (int j = 0; j < 4; ++j) { v0[j] = fast_sigmoid(v0[j]); v1[j] = fast_sigmoid(v1[j]); }
                        *(u32x4*)(GATE + (size_t)row * 2048 + c) = pack8(v0, v1);
                    }
                }
            }
    }
};

struct EpiLora {
    static constexpr bool PERM = true, AFTER_DRAIN = false;
    const float *w0, *a0; bf16_t *LD, *LA, *LG;
    __device__ __forceinline__ void operator()(const f32x4 (&acc)[2][2][4][2], const Unit& u, int wr, int wc, int fr, int fq) const {
        const int pn = u.pn, rowb = u.pm * BM + wr * 64 + fr, cl = wc * 32 + 8 * fq;
        const int seg = pn >> 2;
#pragma unroll
        for (int bj = 0; bj < 2; ++bj) {
            const int c = (pn & 3) * BM + bj * HALF + cl;
            f32x4 b0 = (f32x4){0.f, 0.f, 0.f, 0.f}, b1 = b0;
            if (seg == 0) { b0 = *(const f32x4*)(w0 + c); b1 = *(const f32x4*)(w0 + c + 4); }
            else if (seg == 1) { b0 = *(const f32x4*)(a0 + c); b1 = *(const f32x4*)(a0 + c + 4); }
#pragma unroll
            for (int ai = 0; ai < 2; ++ai)
#pragma unroll
                for (int m = 0; m < 4; ++m) {
                    const int row = rowb + ai * HALF + m * 16;
                    f32x4 v0 = acc[ai][bj][m][0] + b0, v1 = acc[ai][bj][m][1] + b1;
                    if (seg == 0) {
#pragma unroll
                        for (int j = 0; j < 4; ++j) { v0[j] = neg_decay_log(v0[j]); v1[j] = neg_decay_log(v1[j]); }
                        *(u32x4*)(LD + (size_t)row * 1024 + c) = pack8(v0, v1);
                    } else if (seg == 1) {
#pragma unroll
                        for (int j = 0; j < 4; ++j) { v0[j] = fast_sigmoid(v0[j]); v1[j] = fast_sigmoid(v1[j]); }
                        *(u32x4*)(LA + (size_t)row * 1024 + c) = pack8(v0, v1);
                    } else {
                        *(u32x4*)(LG + (size_t)row * 1024 + c) = pack8(v0, v1);
                    }
                    asm volatile("" ::: "memory");
                }
        }
    }
};

struct EpiGated {
    static constexpr bool PERM = true, AFTER_DRAIN = false;
    const bf16_t* G; int goff; const bf16_t* S; bf16_t* O;
    __device__ __forceinline__ void operator()(const f32x4 (&acc)[2][2][4][2], const Unit& u, int wr, int wc, int fr, int fq) const {
        const int rowb = u.pm * BM + wr * 64 + fr, cl = u.pn * BM + wc * 32 + 8 * fq;
#pragma unroll
        for (int ai = 0; ai < 2; ++ai)
#pragma unroll
            for (int m = 0; m < 4; ++m) {
                const int row = rowb + ai * HALF + m * 16;
#pragma unroll
                for (int bj = 0; bj < 2; ++bj) {
                    const int c = cl + bj * HALF;
                    f32x4 g0, g1; unpack8(*(const u32x4*)(G + (size_t)row * 2048 + goff + c), g0, g1);
                    f32x4 v0 = acc[ai][bj][m][0] * g0, v1 = acc[ai][bj][m][1] * g1;
                    if (S) { f32x4 s0, s1; unpack8(*(const u32x4*)(S + (size_t)row * 1024 + c), s0, s1); v0 += s0; v1 += s1; }
                    *(u32x4*)(O + (size_t)row * 1024 + c) = pack8(v0, v1);
                }
            }
    }
};

struct EpiRes {
    static constexpr bool PERM = true, AFTER_DRAIN = false;
    float* X; bf16_t* XB; float* SS;
    __device__ __forceinline__ void operator()(const f32x4 (&acc)[2][2][4][2], const Unit& u, int wr, int wc, int fr, int fq) const {
        const int rowb = u.pm * BM + wr * 64 + fr, cl = u.pn * BM + wc * 32 + 8 * fq;
#pragma unroll
        for (int ai = 0; ai < 2; ++ai)
#pragma unroll
            for (int m = 0; m < 4; ++m) {
                const int row = rowb + ai * HALF + m * 16;
                float sq = 0.f;
#pragma unroll
                for (int bj = 0; bj < 2; ++bj) {
                    const int c = cl + bj * HALF;
                    float* xp = X + (size_t)row * 1024 + c;
                    const f32x4 v0 = *(const f32x4*)xp + acc[ai][bj][m][0], v1 = *(const f32x4*)(xp + 4) + acc[ai][bj][m][1];
                    *(f32x4*)xp = v0; *(f32x4*)(xp + 4) = v1;
                    *(u32x4*)(XB + (size_t)row * 1024 + c) = pack8(v0, v1);
                    sq += (v0[0] * v0[0] + v0[1] * v0[1]) + (v0[2] * v0[2] + v0[3] * v0[3]) + (v1[0] * v1[0] + v1[1] * v1[1]) + (v1[2] * v1[2] + v1[3] * v1[3]);
                }
                sq += __shfl_xor(sq, 16); sq += __shfl_xor(sq, 32);
                if (fq == 0) atomicAdd(SS + row, sq);
            }
    }
};

struct EpiUp {
    static constexpr bool PERM = true, AFTER_DRAIN = false;
    const float* ss; bf16_t* UP; float *cv_p, *cv_s;
    __device__ __forceinline__ void operator()(const f32x4 (&acc)[2][2][4][2], const Unit& u, int wr, int wc, int fr, int fq) const {
        const int rowb = u.pm * BM + wr * 64 + fr, cl = u.pn * BM + wc * 32 + 8 * fq;
#pragma unroll
        for (int ai = 0; ai < 2; ++ai)
#pragma unroll
            for (int m = 0; m < 4; ++m) {
                const int row = rowb + ai * HALF + m * 16;
                const float rstd = 1.0f / sqrtf(ss[row] * (1.0f / 1024.f) + 1e-6f);
                const bool smp = row >= E_MP;
                const int t = smp ? ((row - E_MP) & 31) : (row & 2047);
                const int bb = smp ? ((row - E_MP) >> 5) : (row >> 11);
                const int slot = smp ? t - 30 : t - 2046;
#pragma unroll
                for (int bj = 0; bj < 2; ++bj) {
                    const int c = cl + bj * HALF;
                    const f32x4 v0 = acc[ai][bj][m][0] * rstd, v1 = acc[ai][bj][m][1] * rstd;
                    *(u32x4*)(UP + (size_t)row * 5632 + c) = pack8(v0, v1);
                    if (slot >= 0) { float* o = (smp ? cv_s : cv_p) + ((size_t)bb * 2 + slot) * 5632 + c; *(f32x4*)o = v0; *(f32x4*)(o + 4) = v1; }
                }
            }
    }
};

template <class Epi, class Sched, bool ALIGN_EPI = false, bool SP2 = false>
__device__ __forceinline__ void gemm_phase(PG8_LAS unsigned char* lds, const Gemm g, const Sched& S, const Epi& E) {
    int tid_ = threadIdx.x; asm volatile("" : "+v"(tid_));
    const int tid = tid_, wid = __builtin_amdgcn_readfirstlane(tid >> 6), lane = tid & 63, wr = wid >> 2, wc = wid & 3, fr = lane & 15, fq = lane >> 4;
    const int K = g.K, nt = K / BK;
    unsigned voffA[2], voffB[2];
#pragma unroll
    for (int i = 0; i < 2; ++i) { int R, C; stage_rc(tid * 16 + i * 8192, R, C); const int Rb = Epi::PERM ? ((R & ~31) + perm32(R & 31)) : R;
        voffA[i] = (unsigned)(R * K + C) * 2u; voffB[i] = (unsigned)(Rb * K + C) * 2u; }
    const size_t kstep = (size_t)(BK * 2);
    const size_t hstep = (size_t)HALF * K * 2;
    const size_t tstep = 2 * hstep;
    const unsigned ldsw = (unsigned)wid * 1024u;
    const int aoff = lds_byte(wr * 64 + fr, fq * 8), boff = lds_byte(wc * 32 + fr, fq * 8);
#define PG8_SA(b, h) (((b) * 2 + (h)) * HTB)
#define PG8_SB(b, h) ((4 + (b) * 2 + (h)) * HTB)
#define PG8_STAGE(bufoff, gbase, voff) do { _Pragma("unroll") for (int _i = 0; _i < 2; ++_i) \
        __builtin_amdgcn_global_load_lds((const unsigned*)((const char*)(gbase) + (voff)[_i]), (PG8_LAS unsigned*)(lds + (bufoff) + ldsw + _i * 8192), 16, 0, 0); } while (0)
#define PG8_LDA(dst, b, h) do { _Pragma("unroll") for (int m = 0; m < 4; ++m) _Pragma("unroll") for (int k = 0; k < 2; ++k) dst[m][k] = *(const PG8_LAS bf16x8*)(lds + PG8_SA(b, h) + aoff + m * 2048 + k * 1024); } while (0)
#define PG8_LDB(dst, b, h) do { _Pragma("unroll") for (int n = 0; n < 2; ++n) _Pragma("unroll") for (int k = 0; k < 2; ++k) dst[n][k] = *(const PG8_LAS bf16x8*)(lds + PG8_SB(b, h) + boff + n * 2048 + k * 1024); } while (0)
#define PG8_MMA(ai, bj, At, Bt) do { __builtin_amdgcn_s_setprio(1); _Pragma("unroll") for (int m = 0; m < 4; ++m) _Pragma("unroll") for (int n = 0; n < 2; ++n) _Pragma("unroll") for (int k = 0; k < 2; ++k) \
        acc[ai][bj][m][n] = __builtin_amdgcn_mfma_f32_16x16x32_bf16(Bt[n][k], At[m][k], acc[ai][bj][m][n], 0, 0, 0); __builtin_amdgcn_s_setprio(0); } while (0)
#define PG8_WAIT_V(n) asm volatile("s_waitcnt vmcnt(" #n ")" ::: "memory")
#define PG8_WAIT_L(n) asm volatile("s_waitcnt lgkmcnt(" #n ")" ::: "memory")
#define PG8_BAR __builtin_amdgcn_s_barrier()
#define PG8_SCHED __builtin_amdgcn_sched_barrier(0)
    Unit cur, nxt; int ui = 0;
    if (!S.next(0, cur)) return;
    f32x4 acc[2][2][4][2];
#pragma unroll
    for (int a = 0; a < 2; ++a)
#pragma unroll
        for (int b = 0; b < 2; ++b)
#pragma unroll
            for (int m = 0; m < 4; ++m)
#pragma unroll
                for (int n = 0; n < 2; ++n) acc[a][b][m][n] = (f32x4){0.f, 0.f, 0.f, 0.f};
    bf16x8 At[4][2], B0[2][2], B1[2][2];
    const char* cA = (const char*)g.A + (size_t)cur.pm * tstep; const char* cB = (const char*)g.Bt + (size_t)cur.pn * tstep;
    S.a_ready(cur);
    if constexpr (SP2) {
        PG8_STAGE(PG8_SB(0, 0), cB, voffB); PG8_STAGE(PG8_SB(0, 1), cB + hstep, voffB); PG8_STAGE(PG8_SA(0, 0), cA, voffA); PG8_STAGE(PG8_SA(0, 1), cA + hstep, voffA);
        if (wr == 1) PG8_BAR;
        PG8_WAIT_V(2); PG8_BAR;
        PG8_STAGE(PG8_SB(1, 0), cB + kstep, voffB); PG8_STAGE(PG8_SA(1, 0), cA + kstep, voffA); PG8_STAGE(PG8_SB(1, 1), cB + hstep + kstep, voffB);
        PG8_WAIT_V(6); PG8_BAR;
    } else {
        PG8_STAGE(PG8_SB(0, 0), cB, voffB); PG8_STAGE(PG8_SA(0, 0), cA, voffA); PG8_STAGE(PG8_SB(0, 1), cB + hstep, voffB); PG8_STAGE(PG8_SA(0, 1), cA + hstep, voffA);
        if (wr == 1) PG8_BAR;
        PG8_WAIT_V(4); PG8_BAR;
        PG8_STAGE(PG8_SB(1, 0), cB + kstep, voffB); PG8_STAGE(PG8_SA(1, 0), cA + kstep, voffA); PG8_STAGE(PG8_SB(1, 1), cB + hstep + kstep, voffB);
        PG8_WAIT_V(6); PG8_BAR;
    }
    for (;;) {
        const bool has_next = S.next(ui + 1, nxt);
        const char* nA = has_next ? (const char*)g.A + (size_t)nxt.pm * tstep : cA; const char* nB = has_next ? (const char*)g.Bt + (size_t)nxt.pn * tstep : cB;
        for (int t = 0; t < nt; t += 2) {
            const bool last = (t == nt - 2);
            const char* a1 = cA + (size_t)(t + 1) * kstep;
            const char* a2 = last ? nA : cA + (size_t)(t + 2) * kstep; const char* b2 = last ? nB : cB + (size_t)(t + 2) * kstep;
            const char* a3 = a2 + kstep; const char* b3 = b2 + kstep;
            if (last && has_next) S.a_ready(nxt);
            if constexpr (SP2) {
            PG8_LDB(B0, 0, 0); PG8_LDB(B1, 0, 1); PG8_SCHED; PG8_LDA(At, 0, 0); PG8_STAGE(PG8_SA(1, 1), a1 + hstep, voffA);
            PG8_WAIT_V(8); PG8_WAIT_L(0); PG8_BAR; PG8_MMA(0, 0, At, B0); PG8_MMA(0, 1, At, B1); PG8_BAR; PG8_SCHED;
            PG8_LDA(At, 0, 1); PG8_STAGE(PG8_SB(0, 0), b2, voffB); PG8_STAGE(PG8_SB(0, 1), b2 + hstep, voffB); PG8_STAGE(PG8_SA(0, 0), a2, voffA);
            PG8_WAIT_V(8); PG8_WAIT_L(0); PG8_BAR; PG8_MMA(1, 0, At, B0); PG8_MMA(1, 1, At, B1); PG8_BAR; PG8_SCHED;
            PG8_LDB(B0, 1, 0); PG8_LDB(B1, 1, 1); PG8_SCHED; PG8_LDA(At, 1, 0); PG8_STAGE(PG8_SA(0, 1), a2 + hstep, voffA);
            PG8_WAIT_V(8); PG8_WAIT_L(0); PG8_BAR; PG8_MMA(0, 0, At, B0); PG8_MMA(0, 1, At, B1); PG8_BAR; PG8_SCHED;
            PG8_LDA(At, 1, 1); PG8_STAGE(PG8_SB(1, 0), b3, voffB); PG8_STAGE(PG8_SB(1, 1), b3 + hstep, voffB); PG8_STAGE(PG8_SA(1, 0), a3, voffA);
            PG8_WAIT_V(8); PG8_WAIT_L(0); PG8_BAR; PG8_MMA(1, 0, At, B0); PG8_MMA(1, 1, At, B1); PG8_BAR; PG8_SCHED;
            } else {
            PG8_LDB(B0, 0, 0); PG8_SCHED; PG8_LDA(At, 0, 0); PG8_STAGE(PG8_SA(1, 1), a1 + hstep, voffA);
            PG8_WAIT_L(8); PG8_BAR; PG8_WAIT_L(0); PG8_MMA(0, 0, At, B0); PG8_BAR; PG8_SCHED;
            PG8_LDB(B1, 0, 1); PG8_STAGE(PG8_SB(0, 0), b2, voffB);
            PG8_BAR; PG8_WAIT_L(0); PG8_MMA(0, 1, At, B1); PG8_BAR;
            PG8_LDA(At, 0, 1); PG8_STAGE(PG8_SA(0, 0), a2, voffA);
            PG8_BAR; PG8_WAIT_L(0); PG8_MMA(1, 0, At, B0); PG8_BAR; PG8_SCHED;
            PG8_STAGE(PG8_SB(0, 1), b2 + hstep, voffB);
            PG8_WAIT_V(6); PG8_BAR; PG8_MMA(1, 1, At, B1); PG8_BAR;
            PG8_LDB(B0, 1, 0); PG8_SCHED; PG8_LDA(At, 1, 0); PG8_STAGE(PG8_SA(0, 1), a2 + hstep, voffA);
            PG8_WAIT_L(8); PG8_BAR; PG8_WAIT_L(0); PG8_MMA(0, 0, At, B0); PG8_BAR; PG8_SCHED;
            PG8_LDB(B1, 1, 1); PG8_STAGE(PG8_SB(1, 0), b3, voffB);
            PG8_BAR; PG8_WAIT_L(0); PG8_MMA(0, 1, At, B1); PG8_BAR;
            PG8_LDA(At, 1, 1); PG8_STAGE(PG8_SA(1, 0), a3, voffA);
            PG8_BAR; PG8_WAIT_L(0); PG8_MMA(1, 0, At, B0); PG8_BAR; PG8_SCHED;
            PG8_STAGE(PG8_SB(1, 1), b3 + hstep, voffB);
            PG8_WAIT_V(6); PG8_BAR; PG8_MMA(1, 1, At, B1); PG8_BAR;
            }
        }
        if constexpr (ALIGN_EPI) { if (wr == 0) PG8_BAR; }
        if constexpr (!Epi::AFTER_DRAIN) { E(acc, cur, wr, wc, fr, fq); S.done(cur); }
        if (!has_next) break;
#pragma unroll
        for (int a = 0; a < 2; ++a)
#pragma unroll
            for (int b = 0; b < 2; ++b)
#pragma unroll
                for (int m = 0; m < 4; ++m)
#pragma unroll
                    for (int n = 0; n < 2; ++n) acc[a][b][m][n] = (f32x4){0.f, 0.f, 0.f, 0.f};
        cur = nxt; cA = nA; cB = nB; ++ui;
        if constexpr (ALIGN_EPI) { if (wr == 1) PG8_BAR; }
    }
    PG8_WAIT_V(0);
    if constexpr (!ALIGN_EPI) { if (wr == 0) PG8_BAR; }
    PG8_BAR;
    if constexpr (Epi::AFTER_DRAIN) { E.fused(acc, cur, wr, wc, fr, fq, lds, wid, lane); S.done(cur); }
#undef PG8_SA
#undef PG8_SB
#undef PG8_STAGE
#undef PG8_LDA
#undef PG8_LDB
#undef PG8_MMA
#undef PG8_WAIT_V
#undef PG8_WAIT_L
#undef PG8_BAR
#undef PG8_SCHED
}
}

constexpr int NWAVES = 8;
constexpr size_t MiB = 1u << 20;
constexpr size_t WS_CTL = 0, CTL_ZERO_BYTES = 2 * MiB;
constexpr size_t WS_ROPE = 2 * MiB;
constexpr size_t WS_SP = WS_ROPE + 256 * 1024;
constexpr size_t WS_W = 8 * MiB;
constexpr size_t W_IN = 0, W_ODA = W_IN + (size_t)P_TOTAL * 1024 * 2, W_ORW = W_ODA + 2 * MiB, W_OUT = W_ORW + 2 * MiB, W_UP = W_OUT + 2 * MiB,
                 W_DN = W_UP + (size_t)UPW * 1024 * 2, W_LORA = W_DN + (size_t)1024 * D_FF * 2, W_LAYER = W_LORA + (size_t)3072 * 256 * 2;
static_assert(W_LAYER == 42467328, "weights per layer");
constexpr size_t WS_XB = WS_W + 2 * W_LAYER + (MiB - (2 * W_LAYER) % MiB) % MiB;
constexpr size_t ACT = (size_t)MT * 1024 * 2;
constexpr size_t WS_POOL = WS_XB + ACT;
constexpr size_t B_Q = WS_POOL, B_K = B_Q + ACT, B_V = B_K + ACT, B_OC = B_V + ACT  , B_OA = B_OC + 2 * ACT, B_URW = B_OA + ACT, B_GATE = B_URW + (size_t)MT * P_RW * 2,
                 B_END = B_GATE + (size_t)MT * 2048 * 2;
constexpr size_t B_LD = B_Q, B_LA = B_K, B_LG = B_V, B_LIN = B_END, B_ORW = B_OC + ACT;
constexpr size_t B_END2 = B_LIN + (size_t)MT * 256 * 2;
constexpr size_t B_MRG = B_URW;
constexpr size_t B_UP = WS_POOL, B_GT = B_URW;
static_assert(B_UP + (size_t)MT * UPW * 2 <= B_GT && B_GT + (size_t)MT * D_FF * 2 <= B_END, "FFN overlay");
static_assert(B_END2 <= 512 * MiB, "workspace map");
constexpr int CW_BAR = 4096;
constexpr int CW_LAM = 8192;
constexpr int CW_SS = 16384;
static_assert((CW_SS + 5 * MT) * 4 <= (int)CTL_ZERO_BYTES, "CTL region");
constexpr int RING_OFF = 0, RING_BYTES = 131072;
constexpr int LDSCTL_OFF = RING_BYTES, MISC_OFF = LDSCTL_OFF + 320;
constexpr int LDS_BYTES = 147456;

constexpr int PH_PER_LAYER = 11;
constexpr int NPHASE = 1 + DEPTH * PH_PER_LAYER + 1;
enum { K_G1 = 0, K_AT, K_CB, K_LR, K_SC, K_M1, K_M2, K_WO, K_UP, K_CV, K_DN };

#define GAS __attribute__((address_space(1)))
#define LAS __attribute__((address_space(3)))
typedef unsigned short bf16;
typedef unsigned v4u __attribute__((ext_vector_type(4)));
typedef float f32x4 __attribute__((ext_vector_type(4)));
typedef short bf16x8 __attribute__((ext_vector_type(8)));
typedef GAS unsigned gu32;
typedef GAS unsigned long long gu64;
#define RLX_AGENT __ATOMIC_RELAXED, __HIP_MEMORY_SCOPE_AGENT
#define LDS_WAIT() asm volatile("s_waitcnt lgkmcnt(0)" ::: "memory")
#define VM_WAIT() asm volatile("s_waitcnt vmcnt(0)" ::: "memory")
__device__ __forceinline__ unsigned long long rt() { return __builtin_amdgcn_s_memrealtime(); }
__device__ __forceinline__ unsigned f2bf(float f) { unsigned u = __builtin_bit_cast(unsigned, f); return (u + 0x7fffu + ((u >> 16) & 1u)) >> 16; }
__device__ __forceinline__ unsigned pk2(float lo, float hi) { return f2bf(lo) | (f2bf(hi) << 16); }

#define XB_TMO      128
#define XB_XCNT(j)  (256  + 64 * (j))
#define XB_XSUB(j)  (1280 + 64 * (j))
#define XB_XGEN(j)  (2304 + 64 * (j))
#define XB_TOP      3328
#define XB_TOPGEN   3392
#define XCD_BAR_WORDS 3456
#define XB_SPIN_CAP (1u << 22)

__device__ __forceinline__ unsigned xb_ld(unsigned* p)              { return __hip_atomic_load(p, __ATOMIC_RELAXED, __HIP_MEMORY_SCOPE_AGENT); }
__device__ __forceinline__ unsigned xb_add(unsigned* p, unsigned v) { return __hip_atomic_fetch_add(p, v, __ATOMIC_RELAXED, __HIP_MEMORY_SCOPE_AGENT); }
__device__ __forceinline__ unsigned xb_xcc_id() { return (unsigned)__builtin_amdgcn_s_getreg((3 << 11) | 20) & 0xFu; }
#define XB_SPIN(cond, bar) do { unsigned _sp = 0; while (cond) { __builtin_amdgcn_s_sleep(1); \
    if ((++_sp & 255u) == 0u) { if (xb_ld(&(bar)[XB_TMO])) break; if (_sp > XB_SPIN_CAP) { atomicAdd(&(bar)[XB_TMO], 1u); break; } } } } while (0)

struct XcdBarrier {
    unsigned* bar; unsigned x;
    volatile LAS unsigned* st;
};

__device__ __forceinline__ XcdBarrier xcd_barrier_post(unsigned* bar, volatile LAS unsigned* st) {
    XcdBarrier b; b.bar = bar; b.x = xb_xcc_id(); b.st = st;
    if (threadIdx.x == 0) (void)xb_add(&bar[XB_XCNT(b.x)], 1u);
    return b;
}
__device__ __forceinline__ void xcd_barrier_complete(unsigned* bar, unsigned x, unsigned& nloc, unsigned& nx) {
    const unsigned G = gridDim.x * gridDim.y * gridDim.z;
    unsigned sum, cnt, mine, sp = 0u;
    for (;;) {
        sum = 0u; cnt = 0u; mine = 0u;
#pragma unroll
        for (unsigned j = 0; j < 16; ++j) { const unsigned c = xb_ld(&bar[XB_XCNT(j)]); sum += c; cnt += (c > 0u) ? 1u : 0u; mine = (j == x) ? c : mine; }
        if (sum == G) break;
        __builtin_amdgcn_s_sleep(1);
        if ((++sp & 255u) == 0u) { if (xb_ld(&bar[XB_TMO])) break; if (sp > XB_SPIN_CAP) { atomicAdd(&bar[XB_TMO], 1u); break; } }
    }
    nloc = mine > 0u ? mine : 1u; nx = cnt > 0u ? cnt : 1u;
}

__device__ __forceinline__ void xcd_barrier(const XcdBarrier& b) {
    asm volatile("s_waitcnt vmcnt(0)" ::: "memory");
    __syncthreads();
    if (threadIdx.x == 0) {
        unsigned* bar = b.bar;
        __builtin_amdgcn_s_waitcnt(0);
        unsigned nloc = b.st[0], nx = b.st[1];
        if (nloc == 0u) { xcd_barrier_complete(bar, b.x, nloc, nx); b.st[0] = nloc; b.st[1] = nx; }
        const unsigned old = xb_add(&bar[XB_XSUB(b.x)], 1u);
        const unsigned gen = old / nloc;
        if (old + 1u == (gen + 1u) * nloc) {
            __builtin_amdgcn_fence(__ATOMIC_RELEASE, "agent");
            asm volatile("s_waitcnt vmcnt(0)" ::: "memory");
            const unsigned og = xb_add(&bar[XB_TOP], 1u);
            const unsigned tg = og / nx;
            if (og + 1u == (tg + 1u) * nx) xb_add(&bar[XB_TOPGEN], 1u);
            else XB_SPIN(xb_ld(&bar[XB_TOPGEN]) == tg, bar);
            __builtin_amdgcn_fence(__ATOMIC_ACQUIRE, "agent");
            xb_add(&bar[XB_XGEN(b.x)], 1u);
            asm volatile("s_waitcnt vmcnt(0)" ::: "memory");
        } else {
            XB_SPIN(xb_ld(&bar[XB_XGEN(b.x)]) == gen, bar);
            __builtin_amdgcn_fence(__ATOMIC_ACQUIRE, "agent");
            asm volatile("s_waitcnt vmcnt(0)" ::: "memory");
        }
    }
    __syncthreads();
}

struct Args { const float* in[31]; float* out; unsigned char* ws; float rinv[8]; int ph_lo, ph_hi; };
typedef const Args __attribute__((address_space(4)))* CArgsP;
struct Frame {
    LAS unsigned char* lds;
    volatile LAS unsigned* MISC;
    gu32* ctl;
    int tid, lane, wave, vcu, G;
    float* out; unsigned char* ws;
};
__device__ __forceinline__ float wave_sum(float v) {
#pragma unroll
    for (int o = 1; o < 64; o <<= 1) v += __shfl_xor(v, o);
    return v;
}
__device__ __forceinline__ float bf2f(bf16 h) { return __uint_as_float((unsigned)h << 16); }
__device__ __forceinline__ float bflo(unsigned w) { return __uint_as_float(w << 16); }
__device__ __forceinline__ float bfhi(unsigned w) { return __uint_as_float(w & 0xffff0000u); }

__device__ __forceinline__ void p0_transpose_item(const float* W, int N, bf16* WT, int ldk, int koff, int row_off, const float* kscale, LAS float* scr, int item, int lane) {
    const int nblk = N / 32, kb = item / nblk, nb = item % nblk, k0 = 64 * kb, n0 = 32 * nb;
#pragma unroll 8
    for (int i = 0; i < 32; ++i) { const int kk = 2 * i + (lane >> 5); float w = W[(size_t)(k0 + kk) * N + n0 + (lane & 31)]; if (kscale) w *= kscale[k0 + kk]; scr[kk * 33 + (lane & 31)] = w; }
    LDS_WAIT(); asm volatile("" ::: "memory");
    const int c = lane & 7;
#pragma unroll
    for (int j = 0; j < 4; ++j) { const int n = (lane >> 3) + 8 * j; const LAS float* s = scr + (8 * c) * 33 + n;
        v4u o; o.x = pk2(s[0 * 33], s[1 * 33]); o.y = pk2(s[2 * 33], s[3 * 33]); o.z = pk2(s[4 * 33], s[5 * 33]); o.w = pk2(s[6 * 33], s[7 * 33]);
        *(GAS v4u*)(WT + (size_t)(row_off + n0 + n) * ldk + koff + k0 + 8 * c) = o; }
    LDS_WAIT(); asm volatile("" ::: "memory");
}
__device__ __forceinline__ void p0_prologue(Frame& F, CArgsP A) {
    LAS float* scr = (LAS float*)(F.lds + RING_OFF + F.wave * 16384);
    const int gw = F.vcu * NWAVES + F.wave, NGW = F.G * NWAVES;
    constexpr int I_IN = (1024 / 64) * (P_TOTAL / 32), I_SQ = (1024 / 64) * (1024 / 32), I_UP = (1024 / 64) * (UPW / 32), I_DN = (D_FF / 64) * (1024 / 32),
                  I_W2 = 1 * (1024 / 32), I_G2 = 2 * (1024 / 32);
    constexpr int I_LAYER = I_IN + 3 * I_SQ + I_UP + I_DN + 2 * I_W2 + I_G2;
    for (int it = gw; it < DEPTH * I_LAYER; it += NGW) {
        const int l = it / I_LAYER; int r = it % I_LAYER;
        unsigned char* wl = F.ws + WS_W + (size_t)l * W_LAYER;
        if (r < I_IN) { p0_transpose_item(A->in[8] + (size_t)l * 1024 * P_TOTAL, P_TOTAL, (bf16*)(wl + W_IN), 1024, 0, 0, A->in[7] + l * 1024, scr, r, F.lane); continue; } r -= I_IN;
        if (r < I_SQ) { p0_transpose_item(A->in[11] + (size_t)l * 1024 * 1024, 1024, (bf16*)(wl + W_ODA), 1024, 0, 0, nullptr, scr, r, F.lane); continue; } r -= I_SQ;
        if (r < I_SQ) { p0_transpose_item(A->in[23] + (size_t)l * 1024 * 1024, 1024, (bf16*)(wl + W_ORW), 1024, 0, 0, nullptr, scr, r, F.lane); continue; } r -= I_SQ;
        if (r < I_SQ) { p0_transpose_item(A->in[24] + (size_t)l * 1024 * 1024, 1024, (bf16*)(wl + W_OUT), 1024, 0, 0, nullptr, scr, r, F.lane); continue; } r -= I_SQ;
        if (r < I_UP) { p0_transpose_item(A->in[26] + (size_t)l * 1024 * UPW, UPW, (bf16*)(wl + W_UP), 1024, 0, 0, A->in[25] + l * 1024, scr, r, F.lane); continue; } r -= I_UP;
        if (r < I_DN) { p0_transpose_item(A->in[29] + (size_t)l * D_FF * 1024, 1024, (bf16*)(wl + W_DN), D_FF, 0, 0, nullptr, scr, r, F.lane); continue; } r -= I_DN;
        if (r < I_W2) { p0_transpose_item(A->in[14] + (size_t)l * 64 * 1024, 1024, (bf16*)(wl + W_LORA), 256, 0, 0, nullptr, scr, r, F.lane); continue; } r -= I_W2;
        if (r < I_W2) { p0_transpose_item(A->in[16] + (size_t)l * 64 * 1024, 1024, (bf16*)(wl + W_LORA), 256, 64, 1024, nullptr, scr, r, F.lane); continue; } r -= I_W2;
        p0_transpose_item(A->in[17] + (size_t)l * 128 * 1024, 1024, (bf16*)(wl + W_LORA), 256, 128, 2048, nullptr, scr, r, F.lane);
    }
    {
        const int gt = gw * 64 + F.lane, NGT = NGW * 64;
        for (int i = gt; i < DEPTH * 3072 * 32; i += NGT) {
            const int l = i / (3072 * 32), r = i % (3072 * 32), n = r >> 5, kc = r & 31, blk = n >> 10;
            const bool nz = (blk == 0) ? (kc < 8) : (blk == 1) ? (kc >= 8 && kc < 16) : (kc >= 16);
            if (!nz) *(GAS v4u*)(F.ws + WS_W + (size_t)l * W_LAYER + W_LORA + ((size_t)n * 256 + kc * 8) * 2) = (v4u){0u, 0u, 0u, 0u};
        }
        float* rope = (float*)(F.ws + WS_ROPE);
        for (int i = gt; i < NKEYS_S * 8; i += NGT) {
            const int pos = i >> 3, k = i & 7;
            const float ang = (float)pos * A->rinv[k];
            const float kq = rintf(ang * 0.15915494309189535f);
            float r = fmaf(-kq, 6.2831854820251465f, ang); r = fmaf(-kq, -1.7484555314695172e-7f, r);
            const float rev = r * 0.15915494309189535f;
            rope[pos * 16 + k] = __builtin_amdgcn_cosf(rev); rope[pos * 16 + 8 + k] = __builtin_amdgcn_sinf(rev);
        }
    }
    {
        float* X = F.out + O_YP; bf16* XB = (bf16*)(F.ws + WS_XB); float* SS = (float*)(F.ctl + CW_SS);
        for (int m = gw; m < MT; m += NGW) {
            const float* src = (m < MP) ? A->in[0] + (size_t)m * 1024 : A->in[1] + (size_t)(m - MP) * 1024;
            const GAS f32x4* xr = (const GAS f32x4*)src + F.lane;
            GAS f32x4* xo = (GAS f32x4*)(X + (size_t)m * 1024) + F.lane;
            GAS unsigned long long* o8 = (GAS unsigned long long*)(XB + (size_t)m * 1024) + F.lane;
            float s = 0.f;
#pragma unroll
            for (int j = 0; j < 4; ++j) { const f32x4 v = xr[64 * j]; s += (v.x * v.x + v.y * v.y) + (v.z * v.z + v.w * v.w); xo[64 * j] = v;
                o8[64 * j] = (unsigned long long)pk2(v.x, v.y) | ((unsigned long long)pk2(v.z, v.w) << 32); }
            s = wave_sum(s);
            if (F.lane == 0) SS[m] = s;
        }
    }
    if (gw < DEPTH) {
        const int l = gw; const float* lp = A->in[9] + (size_t)l * 256;
        const float s1 = wave_sum(lp[F.lane] * lp[64 + F.lane]), s2 = wave_sum(lp[128 + F.lane] * lp[192 + F.lane]);
        if (F.lane == 0) ((float*)(F.ctl + CW_LAM))[l] = expf(s1) - expf(s2) + (0.8f - 0.6f * expf(-0.3f * (float)l));
    }
}

__device__ __forceinline__ void attn_slow_prompt(Frame& F, CArgsP A, int it) {
    const int c = it & 1, h = (it >> 1) & 7, chunk = (it >> 4) & 31, b = it >> 9;
    const bf16* Q = (const bf16*)(F.ws + B_Q); const bf16* K = (const bf16*)(F.ws + B_K); const bf16* V = (const bf16*)(F.ws + B_V);
    bf16* OC = (bf16*)(F.ws + B_OC) + (size_t)c * MT * 1024;
    const int row = b * SEQ + chunk * 64 + F.lane;
    float q[64];
    { const v4u* qp = (const v4u*)(Q + (size_t)row * 1024 + h * 128 + c * 64);
#pragma unroll
      for (int i = 0; i < 8; ++i) { const v4u w = qp[i]; q[8 * i] = bflo(w.x); q[8 * i + 1] = bfhi(w.x); q[8 * i + 2] = bflo(w.y); q[8 * i + 3] = bfhi(w.y); q[8 * i + 4] = bflo(w.z); q[8 * i + 5] = bfhi(w.z); q[8 * i + 6] = bflo(w.w); q[8 * i + 7] = bfhi(w.w); } }
    float o[128];
#pragma unroll
    for (int d = 0; d < 128; ++d) o[d] = 0.f;
    float m = -1e30f, l = 0.f;
    const int nk = (chunk + 1) * 64;
    const bf16* kb = K + (size_t)(b * SEQ) * 1024 + h * 128 + c * 64;
    const bf16* vb = V + (size_t)(b * SEQ) * 1024 + h * 128;
    for (int j = 0; j < nk; ++j) {
        const v4u* kp = (const v4u*)(kb + (size_t)j * 1024);
        float s = 0.f;
#pragma unroll
        for (int i = 0; i < 8; ++i) { const v4u w = kp[i];
            s = fmaf(q[8 * i], bflo(w.x), s); s = fmaf(q[8 * i + 1], bfhi(w.x), s); s = fmaf(q[8 * i + 2], bflo(w.y), s); s = fmaf(q[8 * i + 3], bfhi(w.y), s);
            s = fmaf(q[8 * i + 4], bflo(w.z), s); s = fmaf(q[8 * i + 5], bfhi(w.z), s); s = fmaf(q[8 * i + 6], bflo(w.w), s); s = fmaf(q[8 * i + 7], bfhi(w.w), s); }
        const float mn = fmaxf(m, s), alpha = exp2f(m - mn), pj = exp2f(s - mn);
        l = l * alpha + pj; m = mn;
        const v4u* vp = (const v4u*)(vb + (size_t)j * 1024);
#pragma unroll
        for (int i = 0; i < 16; ++i) { if ((i & 3) == 0) asm volatile("" ::: "memory"); const v4u w = vp[i];
            o[8 * i] = fmaf(o[8 * i], alpha, pj * bflo(w.x)); o[8 * i + 1] = fmaf(o[8 * i + 1], alpha, pj * bfhi(w.x)); o[8 * i + 2] = fmaf(o[8 * i + 2], alpha, pj * bflo(w.y)); o[8 * i + 3] = fmaf(o[8 * i + 3], alpha, pj * bfhi(w.y));
            o[8 * i + 4] = fmaf(o[8 * i + 4], alpha, pj * bflo(w.z)); o[8 * i + 5] = fmaf(o[8 * i + 5], alpha, pj * bfhi(w.z)); o[8 * i + 6] = fmaf(o[8 * i + 6], alpha, pj * bflo(w.w)); o[8 * i + 7] = fmaf(o[8 * i + 7], alpha, pj * bfhi(w.w)); }
    }
    const float il = 1.0f / l;
    v4u* op = (v4u*)(OC + (size_t)row * 1024 + h * 128);
#pragma unroll
    for (int i = 0; i < 16; ++i) { v4u w; w.x = pk2(o[8 * i] * il, o[8 * i + 1] * il); w.y = pk2(o[8 * i + 2] * il, o[8 * i + 3] * il); w.z = pk2(o[8 * i + 4] * il, o[8 * i + 5] * il); w.w = pk2(o[8 * i + 6] * il, o[8 * i + 7] * il); op[i] = w; }
}
__device__ __forceinline__ void attn_slow_sample(Frame& F, CArgsP A, int it, int l) {
    const int s = it & 7, c = (it >> 3) & 1, h = (it >> 4) & 7, b = it >> 7;
    const bf16* Q = (const bf16*)(F.ws + B_Q); const bf16* K = (const bf16*)(F.ws + B_K); const bf16* V = (const bf16*)(F.ws + B_V);
    const int qi = F.lane & 31, row = MP + b * DEC_SEQ + qi;
    float q[64];
    { const v4u* qp = (const v4u*)(Q + (size_t)row * 1024 + h * 128 + c * 64);
#pragma unroll
      for (int i = 0; i < 8; ++i) { const v4u w = qp[i]; q[8 * i] = bflo(w.x); q[8 * i + 1] = bfhi(w.x); q[8 * i + 2] = bflo(w.y); q[8 * i + 3] = bfhi(w.y); q[8 * i + 4] = bflo(w.z); q[8 * i + 5] = bfhi(w.z); q[8 * i + 6] = bflo(w.w); q[8 * i + 7] = bfhi(w.w); } }
    float o[128];
#pragma unroll
    for (int d = 0; d < 128; ++d) o[d] = 0.f;
    float m = -1e30f, lsum = 0.f;
    const float* ck = A->in[2] + ((size_t)(l * DEC_BATCH + b) * PAST_LEN) * 1024 + h * 128 + c * 64;
    const float* cv = A->in[3] + ((size_t)(l * DEC_BATCH + b) * PAST_LEN) * 1024 + h * 128;
    const int j0 = s * 260, j1 = j0 + 260, jp1 = j1 < PAST_LEN ? j1 : PAST_LEN;
    for (int j = j0; j < jp1; ++j) {
        float sc = 0.f;
        const f32x4* kp = (const f32x4*)(ck + (size_t)j * 1024);
#pragma unroll
        for (int i = 0; i < 16; ++i) { if ((i & 3) == 0) asm volatile("" ::: "memory"); const f32x4 w = kp[i]; sc = fmaf(q[4 * i], w.x, sc); sc = fmaf(q[4 * i + 1], w.y, sc); sc = fmaf(q[4 * i + 2], w.z, sc); sc = fmaf(q[4 * i + 3], w.w, sc); }
        const float mn = fmaxf(m, sc), alpha = exp2f(m - mn), pj = exp2f(sc - mn); lsum = lsum * alpha + pj; m = mn;
        const f32x4* vp = (const f32x4*)(cv + (size_t)j * 1024);
#pragma unroll
        for (int i = 0; i < 32; ++i) { if ((i & 3) == 0) asm volatile("" ::: "memory"); const f32x4 w = vp[i]; o[4 * i] = fmaf(o[4 * i], alpha, pj * w.x); o[4 * i + 1] = fmaf(o[4 * i + 1], alpha, pj * w.y); o[4 * i + 2] = fmaf(o[4 * i + 2], alpha, pj * w.z); o[4 * i + 3] = fmaf(o[4 * i + 3], alpha, pj * w.w); }
    }
    for (int j = (j0 > PAST_LEN ? j0 : PAST_LEN); j < j1; ++j) {
        float sc = 0.f;
        const size_t kr = (size_t)(MP + b * DEC_SEQ + (j - PAST_LEN)) * 1024;
        const v4u* kp = (const v4u*)(K + kr + h * 128 + c * 64);
#pragma unroll
        for (int i = 0; i < 8; ++i) { const v4u w = kp[i];
            sc = fmaf(q[8 * i], bflo(w.x), sc); sc = fmaf(q[8 * i + 1], bfhi(w.x), sc); sc = fmaf(q[8 * i + 2], bflo(w.y), sc); sc = fmaf(q[8 * i + 3], bfhi(w.y), sc);
            sc = fmaf(q[8 * i + 4], bflo(w.z), sc); sc = fmaf(q[8 * i + 5], bfhi(w.z), sc); sc = fmaf(q[8 * i + 6], bflo(w.w), sc); sc = fmaf(q[8 * i + 7], bfhi(w.w), sc); }
        const float mn = fmaxf(m, sc), alpha = exp2f(m - mn), pj = exp2f(sc - mn); lsum = lsum * alpha + pj; m = mn;
        const v4u* vp = (const v4u*)(V + kr + h * 128);
#pragma unroll
        for (int i = 0; i < 16; ++i) { if ((i & 3) == 0) asm volatile("" ::: "memory"); const v4u w = vp[i];
            o[8 * i] = fmaf(o[8 * i], alpha, pj * bflo(w.x)); o[8 * i + 1] = fmaf(o[8 * i + 1], alpha, pj * bfhi(w.x)); o[8 * i + 2] = fmaf(o[8 * i + 2], alpha, pj * bflo(w.y)); o[8 * i + 3] = fmaf(o[8 * i + 3], alpha, pj * bfhi(w.y));
            o[8 * i + 4] = fmaf(o[8 * i + 4], alpha, pj * bflo(w.z)); o[8 * i + 5] = fmaf(o[8 * i + 5], alpha, pj * bfhi(w.z)); o[8 * i + 6] = fmaf(o[8 * i + 6], alpha, pj * bflo(w.w)); o[8 * i + 7] = fmaf(o[8 * i + 7], alpha, pj * bfhi(w.w)); }
    }
    if (F.lane < 32) {
        float* sp = (float*)(F.ws + WS_SP) + ((size_t)(((b * 8 + h) * 2 + c) * 8 + s) * 32 + qi) * 132;
        sp[0] = m; sp[1] = lsum;
#pragma unroll
        for (int i = 0; i < 32; ++i) *(f32x4*)(sp + 4 + 4 * i) = (f32x4){o[4 * i], o[4 * i + 1], o[4 * i + 2], o[4 * i + 3]};
    }
}
__device__ __forceinline__ void ph_attn_slow(Frame& F, CArgsP A, int l) {
    const int gw = F.vcu * NWAVES + F.wave, NGW = F.G * NWAVES;
    for (int it = gw; it < 2048; it += NGW) { attn_slow_prompt(F, A, it); attn_slow_prompt(F, A, 4095 - it); }
    for (int it = gw; it < 1024; it += NGW) attn_slow_sample(F, A, it, l);
}

__device__ __forceinline__ void ph_combine(Frame& F, CArgsP A, int l) {
    const int gw = F.vcu * NWAVES + F.wave, NGW = F.G * NWAVES;
    const float lam = ((const float*)(F.ctl + CW_LAM))[l], lam_init = 0.8f - 0.6f * expf(-0.3f * (float)l);
    const bf16* OC0 = (const bf16*)(F.ws + B_OC); const bf16* OC1 = OC0 + (size_t)MT * 1024;
    bf16* OA = (bf16*)(F.ws + B_OA);
    const float* subln = A->in[10] + l * 128;
    const float g0 = subln[2 * F.lane], g1 = subln[2 * F.lane + 1];
    for (int it = gw; it < MT * 8; it += NGW) {
        const int row = it >> 3, h = it & 7;
        float a0, a1;
        if (row < MP) {
            const size_t off = (size_t)row * 1024 + h * 128 + 2 * F.lane;
            const unsigned w0 = *(const unsigned*)(OC0 + off), w1 = *(const unsigned*)(OC1 + off);
            a0 = bflo(w0) - lam * bflo(w1); a1 = bfhi(w0) - lam * bfhi(w1);
        } else {
            const int b = (row - MP) >> 5, qi = (row - MP) & 31;
            float oc[2][2];
#pragma unroll
            for (int c = 0; c < 2; ++c) {
                const float* sp = (const float*)(F.ws + WS_SP) + ((size_t)(((b * 8 + h) * 2 + c) * 8) * 32 + qi) * 132;
                float mx = -1e30f;
#pragma unroll
                for (int s = 0; s < 8; ++s) mx = fmaxf(mx, sp[(size_t)s * 32 * 132]);
                float L = 0.f, x0 = 0.f, x1 = 0.f;
#pragma unroll
                for (int s = 0; s < 8; ++s) { const float* p = sp + (size_t)s * 32 * 132; const float w = exp2f(p[0] - mx); L += w * p[1]; x0 += w * p[4 + 2 * F.lane]; x1 += w * p[4 + 2 * F.lane + 1]; }
                oc[c][0] = x0 / L; oc[c][1] = x1 / L;
            }
            a0 = oc[0][0] - lam * oc[1][0]; a1 = oc[0][1] - lam * oc[1][1];
        }
        const float ss = wave_sum(a0 * a0 + a1 * a1);
        const float r = (1.0f / sqrtf(ss * (1.0f / 128.f) + EPS)) * (1.f - lam_init);
        *(unsigned*)(OA + (size_t)row * 1024 + h * 128 + 2 * F.lane) = pk2(a0 * r * g0, a1 * r * g1);
    }
    const bf16* URW = (const bf16*)(F.ws + B_URW); bf16* LIN = (bf16*)(F.ws + B_LIN);
    const float* mu = A->in[12] + (size_t)l * P_RW + 3072 + 4 * F.lane;
    const float mu0 = mu[0], mu1 = mu[1], mu2 = mu[2], mu3 = mu[3];
    for (int row = gw; row < MT; row += NGW) {
        const bool smp = row >= MP; const int t = smp ? ((row - MP) & 31) : (row & 2047);
        const unsigned long long cw = *(const unsigned long long*)(URW + (size_t)row * P_RW + 3072 + 4 * F.lane);
        float u[4] = {bflo((unsigned)cw), bfhi((unsigned)cw), bflo((unsigned)(cw >> 32)), bfhi((unsigned)(cw >> 32))};
        float p[4];
        if (t > 0) { const unsigned long long pw = *(const unsigned long long*)(URW + (size_t)(row - 1) * P_RW + 3072 + 4 * F.lane);
            p[0] = bflo((unsigned)pw); p[1] = bfhi((unsigned)pw); p[2] = bflo((unsigned)(pw >> 32)); p[3] = bfhi((unsigned)(pw >> 32)); }
        else if (smp) { const float* s0 = A->in[5] + ((size_t)(l * DEC_BATCH) + ((row - MP) >> 5)) * P_RW + 3072 + 4 * F.lane; p[0] = s0[0]; p[1] = s0[1]; p[2] = s0[2]; p[3] = s0[3]; }
        else { p[0] = p[1] = p[2] = p[3] = 0.f; }
        u[0] += (p[0] - u[0]) * mu0; u[1] += (p[1] - u[1]) * mu1; u[2] += (p[2] - u[2]) * mu2; u[3] += (p[3] - u[3]) * mu3;
        if (F.lane < 16) { u[0] = tanhf(u[0]); u[1] = tanhf(u[1]); u[2] = tanhf(u[2]); u[3] = tanhf(u[3]); }
        else if (F.lane >= 32) { u[0] = 1.f / (1.f + expf(-u[0])); u[1] = 1.f / (1.f + expf(-u[1])); u[2] = 1.f / (1.f + expf(-u[2])); u[3] = 1.f / (1.f + expf(-u[3])); }
        *(unsigned long long*)(LIN + (size_t)row * 256 + 4 * F.lane) = (unsigned long long)pk2(u[0], u[1]) | ((unsigned long long)pk2(u[2], u[3]) << 32);
    }
}

__device__ __forceinline__ void scan_item(Frame& F, CArgsP A, int l, int it) {
    const bool smp = it >= 128; const int bh = it & 127, b = bh >> 4, h = bh & 15, lane = F.lane;
    const int T = smp ? DEC_SEQ : SEQ; const int row0 = smp ? MP + b * DEC_SEQ : b * SEQ;
    const int c = h * 64 + lane;
    const bf16* URW = (const bf16*)(F.ws + B_URW); const bf16* LD = (const bf16*)(F.ws + B_LD); const bf16* LA = (const bf16*)(F.ws + B_LA); const bf16* LG = (const bf16*)(F.ws + B_LG);
    bf16* ORW = (bf16*)(F.ws + B_ORW);
    const float* mu = A->in[12] + (size_t)l * P_RW;
    const float mu_r = mu[c], mu_k = mu[1024 + c], mu_v = mu[2048 + c];
    const float k_k = A->in[18][l * 1024 + c], k_a = A->in[19][l * 1024 + c], r_k = A->in[20][l * 1024 + c], ln_w = A->in[21][l * 1024 + c], ln_b = A->in[22][l * 1024 + c];
    float S[64];
    if (smp) { const float* s0 = A->in[4] + (((size_t)(l * 8 + b) * 16 + h) * 64 + lane) * 64;
#pragma unroll
        for (int k = 0; k < 64; k += 4) { const f32x4 v = *(const f32x4*)(s0 + k); S[k] = v.x; S[k + 1] = v.y; S[k + 2] = v.z; S[k + 3] = v.w; } }
    else {
#pragma unroll
        for (int k = 0; k < 64; ++k) S[k] = 0.f; }
    float pr = 0.f, pk = 0.f, pv = 0.f;
    if (smp) { const float* s0 = A->in[5] + (size_t)(l * 8 + b) * P_RW; pr = s0[c]; pk = s0[1024 + c]; pv = s0[2048 + c]; }
    LAS float* sh = (LAS float*)(F.lds + RING_OFF + F.wave * 2048);
    size_t ro = (size_t)row0;
    float nur = bf2f(URW[ro * P_RW + c]), nuk = bf2f(URW[ro * P_RW + 1024 + c]), nuv = bf2f(URW[ro * P_RW + 2048 + c]);
    float nld = bf2f(LD[ro * 1024 + c]), nla = bf2f(LA[ro * 1024 + c]), nlg = bf2f(LG[ro * 1024 + c]);
    for (int t = 0; t < T; ++t) {
        const float ur = nur, uk = nuk, uv = nuv, ld = nld, a = nla, g = nlg;
        const size_t rcur = ro;
        if (t + 1 < T) { ro += 1; nur = bf2f(URW[ro * P_RW + c]); nuk = bf2f(URW[ro * P_RW + 1024 + c]); nuv = bf2f(URW[ro * P_RW + 2048 + c]);
            nld = bf2f(LD[ro * 1024 + c]); nla = bf2f(LA[ro * 1024 + c]); nlg = bf2f(LG[ro * 1024 + c]); }
        const float r = ur + (pr - ur) * mu_r, kr = uk + (pk - uk) * mu_k, vr = uv + (pv - uv) * mu_v;
        pr = ur; pk = uk; pv = uv;
        const float decay = expf(ld);
        float kk = kr * k_k;
        const float ssq = wave_sum(kk * kk);
        kk *= 1.0f / sqrtf(fmaxf(ssq, 1e-24f));
        const float km = kr * (1.f + (a - 1.f) * k_a);
        const float bbv = kk * a;
        const float bon = wave_sum(r * km * r_k);
        asm volatile("s_waitcnt lgkmcnt(0)" ::: "memory");
        sh[lane] = r; sh[64 + lane] = decay; sh[128 + lane] = km; sh[192 + lane] = kk; sh[256 + lane] = bbv;
        asm volatile("s_waitcnt lgkmcnt(0)" ::: "memory");
        float sa = 0.f;
#pragma unroll
        for (int k = 0; k < 64; k += 4) { const f32x4 q = *(const LAS f32x4*)(sh + 192 + k); sa = fmaf(S[k], -q.x, sa); sa = fmaf(S[k + 1], -q.y, sa); sa = fmaf(S[k + 2], -q.z, sa); sa = fmaf(S[k + 3], -q.w, sa); }
        float y = 0.f;
#pragma unroll
        for (int k = 0; k < 64; k += 4) {
            const f32x4 w4 = *(const LAS f32x4*)(sh + 64 + k), b4 = *(const LAS f32x4*)(sh + 256 + k), m4 = *(const LAS f32x4*)(sh + 128 + k), r4 = *(const LAS f32x4*)(sh + k);
            S[k] = S[k] * w4.x + sa * b4.x + vr * m4.x; y = fmaf(S[k], r4.x, y);
            S[k + 1] = S[k + 1] * w4.y + sa * b4.y + vr * m4.y; y = fmaf(S[k + 1], r4.y, y);
            S[k + 2] = S[k + 2] * w4.z + sa * b4.z + vr * m4.z; y = fmaf(S[k + 2], r4.z, y);
            S[k + 3] = S[k + 3] * w4.w + sa * b4.w + vr * m4.w; y = fmaf(S[k + 3], r4.w, y);
        }
        const float mean = wave_sum(y) * (1.f / 64.f), d = y - mean;
        const float var = wave_sum(d * d) * (1.f / 64.f);
        const float yn = d * (1.0f / sqrtf(var + GN_EPS)) * ln_w + ln_b;
        ORW[rcur * 1024 + c] = (bf16)f2bf((yn + bon * vr) * g);
    }
    int ln2 = lane; asm volatile("" : "+v"(ln2));
    float* Sout = F.out + (smp ? O_WKVS : O_WKVP) + (((size_t)(l * 8 + b) * 16 + h) * 64 + ln2) * 64;
#pragma unroll
    for (int k = 0; k < 64; k += 4) *(f32x4*)(Sout + k) = (f32x4){S[k], S[k + 1], S[k + 2], S[k + 3]};
}
__device__ __forceinline__ void ph_scan_slow(Frame& F, CArgsP A, int l) {
    if (F.wave == 0 && F.vcu < 256) scan_item(F, A, l, F.vcu);
    if (F.G < 256 && F.wave == 1) for (int it = F.G + F.vcu; it < 256; it += F.G) scan_item(F, A, l, it);
}

__device__ __forceinline__ void ph_conv(Frame& F, CArgsP A, int l) {
    const int gt = (F.vcu * NWAVES + F.wave) * 64 + F.lane, NGT = F.G * NWAVES * 64;
    const bf16* UP = (const bf16*)(F.ws + B_UP); bf16* GT = (bf16*)(F.ws + B_GT);
    const float* cw = A->in[27] + (size_t)l * 3 * UPW; const float* cb = A->in[28] + (size_t)l * UPW;
    for (int i = gt; i < MT * (D_FF / 8); i += NGT) {
        const int row = i / (D_FF / 8), j = (i % (D_FF / 8)) * 8;
        const bool smp = row >= MP; const int t = smp ? ((row - MP) & 31) : (row & 2047); const int b = smp ? ((row - MP) >> 5) : (row >> 11);
        float cc[2][8];
#pragma unroll
        for (int hf = 0; hf < 2; ++hf) {
            const int col = j + hf * D_FF;
            float u0[8], u1[8], u2[8];
            { const v4u w = *(const v4u*)(UP + (size_t)row * UPW + col); u0[0] = bflo(w.x); u0[1] = bfhi(w.x); u0[2] = bflo(w.y); u0[3] = bfhi(w.y); u0[4] = bflo(w.z); u0[5] = bfhi(w.z); u0[6] = bflo(w.w); u0[7] = bfhi(w.w); }
            if (t >= 1) { const v4u w = *(const v4u*)(UP + (size_t)(row - 1) * UPW + col); u1[0] = bflo(w.x); u1[1] = bfhi(w.x); u1[2] = bflo(w.y); u1[3] = bfhi(w.y); u1[4] = bflo(w.z); u1[5] = bfhi(w.z); u1[6] = bflo(w.w); u1[7] = bfhi(w.w); }
            else if (smp) { const float* s0 = A->in[6] + ((size_t)(l * 8 + b) * 2 + 1) * UPW + col;
#pragma unroll
                for (int e = 0; e < 8; ++e) u1[e] = s0[e]; }
            else {
#pragma unroll
                for (int e = 0; e < 8; ++e) u1[e] = 0.f; }
            if (t >= 2) { const v4u w = *(const v4u*)(UP + (size_t)(row - 2) * UPW + col); u2[0] = bflo(w.x); u2[1] = bfhi(w.x); u2[2] = bflo(w.y); u2[3] = bfhi(w.y); u2[4] = bflo(w.z); u2[5] = bfhi(w.z); u2[6] = bflo(w.w); u2[7] = bfhi(w.w); }
            else if (smp) { const float* s0 = A->in[6] + ((size_t)(l * 8 + b) * 2 + t) * UPW + col;
#pragma unroll
                for (int e = 0; e < 8; ++e) u2[e] = s0[e]; }
            else {
#pragma unroll
                for (int e = 0; e < 8; ++e) u2[e] = 0.f; }
#pragma unroll
            for (int e = 0; e < 8; ++e) cc[hf][e] = cb[col + e] + u2[e] * cw[col + e] + u1[e] * cw[UPW + col + e] + u0[e] * cw[2 * UPW + col + e];
        }
        float gv[8];
#pragma unroll
        for (int e = 0; e < 8; ++e) gv[e] = cc[0][e] / (1.f + expf(-cc[0][e])) * cc[1][e];
        v4u o; o.x = pk2(gv[0], gv[1]); o.y = pk2(gv[2], gv[3]); o.z = pk2(gv[4], gv[5]); o.w = pk2(gv[6], gv[7]);
        *(v4u*)(GT + (size_t)row * D_FF + j) = o;
    }
}

__device__ __forceinline__ void ph_final(Frame& F, CArgsP A) {
    const int gw = F.vcu * NWAVES + F.wave, NGW = F.G * NWAVES;
    float* X = F.out + O_YP; const float* SS = (const float*)(F.ctl + CW_SS) + 4 * MT; const float* g = A->in[30];
    for (int m = gw; m < MT; m += NGW) {
        const float r = 1.0f / sqrtf(SS[m] * (1.0f / 1024.f) + EPS);
        GAS f32x4* xr = (GAS f32x4*)(X + (size_t)m * 1024) + F.lane; const GAS f32x4* gr = (const GAS f32x4*)g + F.lane;
#pragma unroll
        for (int j = 0; j < 4; ++j) { f32x4 v = xr[64 * j]; const f32x4 gg = gr[64 * j]; v = v * r * gg; xr[64 * j] = v; }
    }
}

#define REOPAQUE() do { int tv = threadIdx.x; asm volatile("" : "+v"(tv)); F.tid = tv; F.lane = tv & 63; F.wave = __builtin_amdgcn_readfirstlane(tv >> 6); \
    ap = (CArgsP)__builtin_amdgcn_kernarg_segment_ptr(); asm volatile("" : "+s"(ap)); \
    { unsigned char* w_ = ap->ws; float* o_ = ap->out; asm volatile("" : "+s"(w_), "+s"(o_)); F.ws = w_; F.out = o_; F.ctl = (gu32*)(w_ + WS_CTL); } } while (0)
#define PH_BEGIN(idx) if (lo <= (idx) && (idx) < hi) { REOPAQUE();
#define PH_END(idx) if ((idx) + 1 < hi) xcd_barrier(bar); }

template <int l> __device__ __forceinline__ void layer_phases(Frame& F, CArgsP& ap, const XcdBarrier& bar, const int lo, const int hi) {
    constexpr int P0 = 1 + l * PH_PER_LAYER;
#define WL (F.ws + WS_W + (size_t)l * W_LAYER)
#define SSP ((float*)(F.ctl + CW_SS))
    PH_BEGIN(P0 + K_G1) {
        int kk_ = 1024; asm volatile("" : "+s"(kk_)); pg8::Gemm g{(const bf16*)(F.ws + WS_XB), (const bf16*)(WL + W_IN), MT, P_TOTAL, kk_}; pg8::StaticOrder S; S.init(MT, P_TOTAL, F.G, (int)blockIdx.x);
        pg8::EpiIn E{SSP + (size_t)(2 * l) * MT, (const float*)(F.ws + WS_ROPE), (bf16*)(F.ws + B_Q), (bf16*)(F.ws + B_K), (bf16*)(F.ws + B_V), (bf16*)(F.ws + B_URW), (bf16*)(F.ws + B_GATE),
                     F.out + O_KP + (size_t)l * MP * 1024, F.out + O_VP + (size_t)l * MP * 1024, F.out + O_KS + (size_t)l * MS * 1024, F.out + O_VS + (size_t)l * MS * 1024,
                     F.out + O_SHP + (size_t)l * BATCH * P_RW, F.out + O_SHS + (size_t)l * DEC_BATCH * P_RW};
        pg8::gemm_phase<pg8::EpiIn, pg8::StaticOrder, true, true>(F.lds + RING_OFF, g, S, E);
    } PH_END(P0 + K_G1)
    PH_BEGIN(P0 + K_AT) { ph_attn_slow(F, ap, l); } PH_END(P0 + K_AT)
    PH_BEGIN(P0 + K_CB) { ph_combine(F, ap, l); } PH_END(P0 + K_CB)
    PH_BEGIN(P0 + K_LR) {
        int kk_ = 256; asm volatile("" : "+s"(kk_)); pg8::Gemm g{(const bf16*)(F.ws + B_LIN), (const bf16*)(WL + W_LORA), MT, 3072, kk_}; pg8::StaticOrder S; S.init(MT, 3072, F.G, (int)blockIdx.x);
        pg8::EpiLora E{ap->in[13] + l * 1024, ap->in[15] + l * 1024, (bf16*)(F.ws + B_LD), (bf16*)(F.ws + B_LA), (bf16*)(F.ws + B_LG)};
        pg8::gemm_phase<pg8::EpiLora, pg8::StaticOrder, true, true>(F.lds + RING_OFF, g, S, E);
    } PH_END(P0 + K_LR)
    PH_BEGIN(P0 + K_SC) { ph_scan_slow(F, ap, l); } PH_END(P0 + K_SC)
    PH_BEGIN(P0 + K_M1) {
        int kk_ = 1024; asm volatile("" : "+s"(kk_)); pg8::Gemm g{(const bf16*)(F.ws + B_OA), (const bf16*)(WL + W_ODA), MT, 1024, kk_}; pg8::StaticOrder S; S.init(MT, 1024, F.G, (int)blockIdx.x);
        pg8::EpiGated E{(const bf16*)(F.ws + B_GATE), 0, nullptr, (bf16*)(F.ws + B_MRG)};
        pg8::gemm_phase<pg8::EpiGated, pg8::StaticOrder, true, true>(F.lds + RING_OFF, g, S, E);
    } PH_END(P0 + K_M1)
    PH_BEGIN(P0 + K_M2) {
        int kk_ = 1024; asm volatile("" : "+s"(kk_)); pg8::Gemm g{(const bf16*)(F.ws + B_ORW), (const bf16*)(WL + W_ORW), MT, 1024, kk_}; pg8::StaticOrder S; S.init(MT, 1024, F.G, (int)blockIdx.x);
        pg8::EpiGated E{(const bf16*)(F.ws + B_GATE), 1024, (const bf16*)(F.ws + B_MRG), (bf16*)(F.ws + B_MRG)};
        pg8::gemm_phase<pg8::EpiGated, pg8::StaticOrder, true, true>(F.lds + RING_OFF, g, S, E);
    } PH_END(P0 + K_M2)
    PH_BEGIN(P0 + K_WO) {
        int kk_ = 1024; asm volatile("" : "+s"(kk_)); pg8::Gemm g{(const bf16*)(F.ws + B_MRG), (const bf16*)(WL + W_OUT), MT, 1024, kk_}; pg8::StaticOrder S; S.init(MT, 1024, F.G, (int)blockIdx.x);
        pg8::EpiRes E{F.out + O_YP, (bf16*)(F.ws + WS_XB), SSP + (size_t)(2 * l + 1) * MT};
        pg8::gemm_phase<pg8::EpiRes, pg8::StaticOrder, true, true>(F.lds + RING_OFF, g, S, E);
    } PH_END(P0 + K_WO)
    PH_BEGIN(P0 + K_UP) {
        int kk_ = 1024; asm volatile("" : "+s"(kk_)); pg8::Gemm g{(const bf16*)(F.ws + WS_XB), (const bf16*)(WL + W_UP), MT, UPW, kk_}; pg8::StaticOrder S; S.init(MT, UPW, F.G, (int)blockIdx.x);
        pg8::EpiUp E{SSP + (size_t)(2 * l + 1) * MT, (bf16*)(F.ws + B_UP), F.out + O_CVP + (size_t)l * BATCH * 2 * UPW, F.out + O_CVS + (size_t)l * DEC_BATCH * 2 * UPW};
        pg8::gemm_phase<pg8::EpiUp, pg8::StaticOrder, true, true>(F.lds + RING_OFF, g, S, E);
    } PH_END(P0 + K_UP)
    PH_BEGIN(P0 + K_CV) { ph_conv(F, ap, l); } PH_END(P0 + K_CV)
    PH_BEGIN(P0 + K_DN) {
        int kk_ = D_FF; asm volatile("" : "+s"(kk_)); pg8::Gemm g{(const bf16*)(F.ws + B_GT), (const bf16*)(WL + W_DN), MT, 1024, kk_}; pg8::StaticOrder S; S.init(MT, 1024, F.G, (int)blockIdx.x);
        pg8::EpiRes E{F.out + O_YP, (bf16*)(F.ws + WS_XB), SSP + (size_t)(2 * l + 2) * MT};
        pg8::gemm_phase<pg8::EpiRes, pg8::StaticOrder, true, true>(F.lds + RING_OFF, g, S, E);
    } PH_END(P0 + K_DN)
#undef WL
#undef SSP
}

__global__ void __launch_bounds__(NWAVES * 64, 2) mk_fwd(Args args) {
    extern __shared__ __attribute__((aligned(16))) unsigned char lds[];
    Frame F;
    F.lds = (LAS unsigned char*)lds;
    F.MISC = (volatile LAS unsigned*)(F.lds + MISC_OFF);
    F.tid = threadIdx.x; F.lane = F.tid & 63; F.wave = __builtin_amdgcn_readfirstlane(F.tid >> 6);
    F.G = gridDim.x; { const int bx = blockIdx.x; F.vcu = (F.G % 8 == 0) ? (bx % 8) * (F.G / 8) + bx / 8 : bx; }
    F.out = args.out; F.ws = args.ws;
    F.ctl = (gu32*)(args.ws + WS_CTL);
    for (int u = F.tid; u < (LDS_BYTES - LDSCTL_OFF) / 4; u += NWAVES * 64) ((LAS unsigned*)(F.lds + LDSCTL_OFF))[u] = 0u;
    __syncthreads();
    XcdBarrier bar; bar.bar = (unsigned*)(F.ctl + CW_BAR); bar.x = 0; bar.st = nullptr;
    if (!MK_PER_PHASE) bar = xcd_barrier_post((unsigned*)(F.ctl + CW_BAR), F.MISC + 8);
    const int lo = args.ph_lo, hi = args.ph_hi;
    CArgsP ap;
    PH_BEGIN(0) { p0_prologue(F, ap); } PH_END(0)
    layer_phases<0>(F, ap, bar, lo, hi);
    layer_phases<1>(F, ap, bar, lo, hi);
    PH_BEGIN(NPHASE - 1) { ph_final(F, ap); } PH_END(NPHASE - 1)
}

extern "C" void kernel_launch(void* const* d_in, const int* in_sizes, int n_in, void* d_out, int out_size, void* d_ws, size_t ws_size, hipStream_t stream) {
    (void)in_sizes;
    static int grid = 0;
    if (grid == 0) {
        if (n_in != 31 || out_size != (int)O_END || ws_size < B_END2) { fprintf(stderr, "kernel_launch: unexpected shapes (n_in %d out %d ws %zu)\n", n_in, out_size, ws_size); grid = -1; return; }
        int dev = 0, cus = 0;
        if (hipGetDevice(&dev) != hipSuccess || hipDeviceGetAttribute(&cus, hipDeviceAttributeMultiprocessorCount, dev) != hipSuccess) { grid = -1; return; }
        if (hipFuncSetAttribute((const void*)mk_fwd, hipFuncAttributeMaxDynamicSharedMemorySize, LDS_BYTES) != hipSuccess) { fprintf(stderr, "kernel_launch: hipFuncSetAttribute failed\n"); grid = -1; return; }
        (void)hipGetLastError();
        grid = cus;
    }
    if (grid < 0) return;
    if (hipMemsetAsync((char*)d_ws + WS_CTL, 0, CTL_ZERO_BYTES, stream) != hipSuccess) { fprintf(stderr, "kernel_launch: memset failed\n"); return; }
    Args a{};
    for (int i = 0; i < 31; ++i) a.in[i] = (const float*)d_in[i];
    a.out = (float*)d_out; a.ws = (unsigned char*)d_ws;
    for (int i = 0; i < 8; ++i) a.rinv[i] = (float)pow(500000.0, -(double)i / 8.0);
#if MK_PER_PHASE
    for (int p = 0; p < NPHASE; ++p) { a.ph_lo = p; a.ph_hi = p + 1; hipLaunchKernelGGL(mk_fwd, dim3(grid), dim3(NWAVES * 64), LDS_BYTES, stream, a); }
#else
    a.ph_lo = 0; a.ph_hi = NPHASE;
    hipLaunchKernelGGL(mk_fwd, dim3(grid), dim3(NWAVES * 64), LDS_BYTES, stream, a);
#endif
    const hipError_t le = hipPeekAtLastError();
    if (le != hipSuccess) fprintf(stderr, "kernel_launch: launch failed: %s\n", hipGetErrorName(le));
}
```

```cpp
#include <hip/hip_runtime.h>
#include <cstdio>
#include <cstdint>
#include <cmath>

#ifndef MK_PER_PHASE
#define MK_PER_PHASE 0
#endif

constexpr int D_MODEL = 1024, BATCH = 8, SEQ = 2048, DEPTH = 2, DEC_BATCH = 8, DEC_SEQ = 32, PAST_LEN = 2048;
constexpr float EPS = 1e-6f, GN_EPS = 64e-5f;
constexpr int DA_HEADS = 8, RW_HEADS = 16;
constexpr int D_FF = 2816, UPW = 2 * D_FF;
constexpr int P_DA = 3072, P_RW = 3328, P_GATE = 2048, P_TOTAL = 8448;
constexpr int MP = BATCH * SEQ, MS = DEC_BATCH * DEC_SEQ, MT = MP + MS;
constexpr int NKEYS_S = PAST_LEN + DEC_SEQ;
constexpr float C2 = 0.125f * 1.4426950408889634f;

constexpr size_t O_YP = 0;
constexpr size_t O_YS = O_YP + (size_t)MP * D_MODEL;
constexpr size_t O_KP = O_YS + (size_t)MS * D_MODEL;
constexpr size_t O_VP = O_KP + (size_t)DEPTH * MP * 1024;
constexpr size_t O_WKVP = O_VP + (size_t)DEPTH * MP * 1024;
constexpr size_t O_SHP = O_WKVP + (size_t)DEPTH * BATCH * RW_HEADS * 64 * 64;
constexpr size_t O_CVP = O_SHP + (size_t)DEPTH * BATCH * P_RW;
constexpr size_t O_KS = O_CVP + (size_t)DEPTH * BATCH * 2 * UPW;
constexpr size_t O_VS = O_KS + (size_t)DEPTH * MS * 1024;
constexpr size_t O_WKVS = O_VS + (size_t)DEPTH * MS * 1024;
constexpr size_t O_SHS = O_WKVS + (size_t)DEPTH * DEC_BATCH * RW_HEADS * 64 * 64;
constexpr size_t O_CVS = O_SHS + (size_t)DEPTH * DEC_BATCH * P_RW;
constexpr size_t O_END = O_CVS + (size_t)DEPTH * DEC_BATCH * 2 * UPW;
static_assert(O_END == 87760896, "output size");

namespace pg8 {
#define PG8_LAS __attribute__((address_space(3)))
typedef unsigned short bf16_t;
typedef short bf16x8 __attribute__((ext_vector_type(8)));
typedef float f32x4 __attribute__((ext_vector_type(4)));
typedef unsigned u32x4 __attribute__((ext_vector_type(4)));
constexpr int BM = 256, BK = 64, HALF = 128, HTB = HALF * BK * 2  , STAGE_BYTES = 8 * HTB, NXCD = 8, WGM = 8;

__host__ __device__ __forceinline__ int lds_byte(int r, int c) { const int st = (r >> 4) * 2 + (c >> 5), rr = r & 15, cc = c & 31, ob = rr * 64 + cc * 2; return st * 1024 + (ob ^ (((ob >> 9) & 1) << 5)); }
__host__ __device__ __forceinline__ void stage_rc(int b, int& R, int& C) { const int st = b / 1024, sb = b % 1024, swz = sb ^ (((sb >> 9) & 1) << 5); R = (st >> 1) * 16 + swz / 64; C = (st & 1) * 32 + (swz % 64) / 2; }
__host__ __device__ __forceinline__ int perm32(int rho) { const int n = rho >> 4, i = rho & 15; return 8 * (i >> 2) + 4 * n + (i & 3); }

struct Unit { int pm, pn; };
struct Gemm { const bf16_t* A; const bf16_t* Bt; int M, N, K; };

struct StaticOrder {
    int nM, nN, nwg, G, c;
    __host__ __device__ void init(int M, int N, int G_, int c_) { nM = M / BM; nN = N / BM; nwg = nM * nN; G = G_; c = c_; }
    __host__ __device__ bool next(int i, Unit& u) const {
        const long L = (long)i * G + c; if (L >= nwg) return false;
        int wgid = (int)L; { const int q = nwg / NXCD, r = nwg % NXCD, xcd = wgid % NXCD, off = wgid / NXCD; wgid = (xcd < r ? xcd * (q + 1) : r * (q + 1) + (xcd - r) * q) + off; }
        const int nig = WGM * nN, gid = wgid / nig, fm = gid * WGM, gsz = (nM - fm) < WGM ? (nM - fm) : WGM;
        u.pm = fm + ((wgid % nig) % gsz); u.pn = (wgid % nig) / gsz; return true;
    }
    __device__ __forceinline__ void a_ready(const Unit&) const {}
    __device__ __forceinline__ void done(const Unit&) const {}
};

typedef float f32x2_cv __attribute__((ext_vector_type(2))); typedef __bf16 bf16x2_cv __attribute__((ext_vector_type(2)));
__device__ __forceinline__ unsigned cvt_pk_bf16(float lo, float hi) { const f32x2_cv v = {lo, hi}; const bf16x2_cv b = __builtin_convertvector(v, bf16x2_cv); return __builtin_bit_cast(unsigned, b); }
typedef float f32x2 __attribute__((ext_vector_type(2)));
__device__ __forceinline__ float bf2f(unsigned short h) { return __uint_as_float((unsigned)h << 16); }
__device__ __forceinline__ float fast_sigmoid(float x) { return __builtin_amdgcn_rcpf(1.0f + __builtin_amdgcn_exp2f(-1.4426950408889634f * x)); }
__device__ __forceinline__ float neg_decay_log(float x) {
    const float y = -x, sp = fmaxf(y, 0.f) + 0.6931471805599453f * __builtin_amdgcn_logf(1.0f + __builtin_amdgcn_exp2f(-1.4426950408889634f * fabsf(y)));
    return -__builtin_amdgcn_exp2f(-1.4426950408889634f * (sp + 0.5f));
}
__device__ __forceinline__ u32x4 pack8(const f32x4 v0, const f32x4 v1) { u32x4 w; w.x = cvt_pk_bf16(v0[0], v0[1]); w.y = cvt_pk_bf16(v0[2], v0[3]); w.z = cvt_pk_bf16(v1[0], v1[1]); w.w = cvt_pk_bf16(v1[2], v1[3]); return w; }
__device__ __forceinline__ void unpack8(const u32x4 w, f32x4& v0, f32x4& v1) {
    v0[0] = __uint_as_float(w.x << 16); v0[1] = __uint_as_float(w.x & 0xffff0000u); v0[2] = __uint_as_float(w.y << 16); v0[3] = __uint_as_float(w.y & 0xffff0000u);
    v1[0] = __uint_as_float(w.z << 16); v1[1] = __uint_as_float(w.z & 0xffff0000u); v1[2] = __uint_as_float(w.w << 16); v1[3] = __uint_as_float(w.w & 0xffff0000u);
}
constexpr int E_MP = 16384, E_MS = 256;

struct EpiIn {
    static constexpr bool PERM = true, AFTER_DRAIN = false;
    const float* ss; const float* rope;
    bf16_t *Q, *K, *V, *URW, *GATE;
    float *kout_p, *vout_p, *kout_s, *vout_s;
    float *sh_p, *sh_s;
    __device__ __forceinline__ void operator()(const f32x4 (&acc)[2][2][4][2], const Unit& u, int wr, int wc, int fr, int fq) const {
        const int pn = u.pn, rowb = u.pm * BM + wr * 64 + fr, cl = wc * 32 + 8 * fq;
        const bool rope_wave = (pn < 8) && ((wc & 1) == 0);
        const float sgn = (fq == 0) ? -1.f : 1.f;
#pragma unroll
        for (int ai = 0; ai < 2; ++ai)
#pragma unroll
            for (int m = 0; m < 4; ++m) {
                const int row = rowb + ai * HALF + m * 16;
                const float rstd = 1.0f / sqrtf(ss[row] * (1.0f / 1024.f) + 1e-6f);
                const bool smp = row >= E_MP;
                const int t = smp ? ((row - E_MP) & 31) : (row & 2047);
                const int bb = smp ? ((row - E_MP) >> 5) : (row >> 11);
                const int pos = smp ? 2048 + t : t;
                const bool last = smp ? (t == 31) : (t == 2047);
#pragma unroll
                for (int bj = 0; bj < 2; ++bj) {
                    f32x4 v0 = acc[ai][bj][m][0] * rstd, v1 = acc[ai][bj][m][1] * rstd;
                    const int col = pn * BM + bj * HALF + cl;
                    if (pn < 8) {
                        if (rope_wave) {
                            f32x4 p0, p1;
#pragma unroll
                            for (int j = 0; j < 4; ++j) { p0[j] = __shfl_xor(v0[j], 16); p1[j] = __shfl_xor(v1[j], 16); }
                            if (fq < 2) {
                                const float* tb = rope + pos * 16;
                                const f32x4 c0 = *(const f32x4*)(tb), c1 = *(const f32x4*)(tb + 4), s0 = *(const f32x4*)(tb + 8), s1 = *(const f32x4*)(tb + 12);
                                v0 = v0 * c0 + (p0 * s0) * sgn; v1 = v1 * c1 + (p1 * s1) * sgn;
                            }
                        }
                        if (pn < 4) { v0 = v0 * C2; v1 = v1 * C2; *(u32x4*)(Q + (size_t)row * 1024 + col) = pack8(v0, v1); }
                        else {
                            const int c = col - 1024;
                            *(u32x4*)(K + (size_t)row * 1024 + c) = pack8(v0, v1);
                            float* o = smp ? kout_s + (size_t)(row - E_MP) * 1024 + c : kout_p + (size_t)row * 1024 + c;
                            *(f32x4*)o = v0; *(f32x4*)(o + 4) = v1;
                        }
                    } else if (pn < 12) {
                        const int c = col - 2048;
                        *(u32x4*)(V + (size_t)row * 1024 + c) = pack8(v0, v1);
                        float* o = smp ? vout_s + (size_t)(row - E_MP) * 1024 + c : vout_p + (size_t)row * 1024 + c;
                        *(f32x4*)o = v0; *(f32x4*)(o + 4) = v1;
                    } else if (pn < 25) {
                        const int c = col - 3072;
                        *(u32x4*)(URW + (size_t)row * 3328 + c) = pack8(v0, v1);
                        if (last) { float* o = (smp ? sh_s : sh_p) + (size_t)bb * 3328 + c; *(f32x4*)o = v0; *(f32x4*)(o + 4) = v1; }
                    } else {
                        const int c = col - 6400;
#pragma unroll
                        for (int j = 0; j < 4; ++j) { v0[j] = fast_sigmoid(v0[j]); v1[j] = fast_sigmoid(v1[j]); }
                        *(u32x4*)(GATE + (size_t)row * 2048 + c) = pack8(v0, v1);
                    }
                }
            }
    }
};

struct EpiLora {
    static constexpr bool PERM = true, AFTER_DRAIN = false;
    const float *w0, *a0; bf16_t *LD, *LA, *LG;
    __device__ __forceinline__ void operator()(const f32x4 (&acc)[2][2][4][2], const Unit& u, int wr, int wc, int fr, int fq) const {
        const int pn = u.pn, rowb = u.pm * BM + wr * 64 + fr, cl = wc * 32 + 8 * fq;
        const int seg = pn >> 2;
#pragma unroll
        for (int bj = 0; bj < 2; ++bj) {
            const int c = (pn & 3) * BM + bj * HALF + cl;
            f32x4 b0 = (f32x4){0.f, 0.f, 0.f, 0.f}, b1 = b0;
            if (seg == 0) { b0 = *(const f32x4*)(w0 + c); b1 = *(const f32x4*)(w0 + c + 4); }
            else if (seg == 1) { b0 = *(const f32x4*)(a0 + c); b1 = *(const f32x4*)(a0 + c + 4); }
#pragma unroll
            for (int ai = 0; ai < 2; ++ai)
#pragma unroll
                for (int m = 0; m < 4; ++m) {
                    const int row = rowb + ai * HALF + m * 16;
                    f32x4 v0 = acc[ai][bj][m][0] + b0, v1 = acc[ai][bj][m][1] + b1;
                    if (seg == 0) {
#pragma unroll
                        for (int j = 0; j < 4; ++j) { v0[j] = neg_decay_log(v0[j]); v1[j] = neg_decay_log(v1[j]); }
                        *(u32x4*)(LD + (size_t)row * 1024 + c) = pack8(v0, v1);
                    } else if (seg == 1) {
#pragma unroll
                        for (int j = 0; j < 4; ++j) { v0[j] = fast_sigmoid(v0[j]); v1[j] = fast_sigmoid(v1[j]); }
                        *(u32x4*)(LA + (size_t)row * 1024 + c) = pack8(v0, v1);
                    } else {
                        *(u32x4*)(LG + (size_t)row * 1024 + c) = pack8(v0, v1);
                    }
                    asm volatile("" ::: "memory");
                }
        }
    }
};

struct EpiGated {
    static constexpr bool PERM = true, AFTER_DRAIN = false;
    const bf16_t* G; int goff; const bf16_t* S; bf16_t* O;
    __device__ __forceinline__ void operator()(const f32x4 (&acc)[2][2][4][2], const Unit& u, int wr, int wc, int fr, int fq) const {
        const int rowb = u.pm * BM + wr * 64 + fr, cl = u.pn * BM + wc * 32 + 8 * fq;
#pragma unroll
        for (int ai = 0; ai < 2; ++ai)
#pragma unroll
            for (int m = 0; m < 4; ++m) {
                const int row = rowb + ai * HALF + m * 16;
#pragma unroll
                for (int bj = 0; bj < 2; ++bj) {
                    const int c = cl + bj * HALF;
                    f32x4 g0, g1; unpack8(*(const u32x4*)(G + (size_t)row * 2048 + goff + c), g0, g1);
                    f32x4 v0 = acc[ai][bj][m][0] * g0, v1 = acc[ai][bj][m][1] * g1;
                    if (S) { f32x4 s0, s1; unpack8(*(const u32x4*)(S + (size_t)row * 1024 + c), s0, s1); v0 += s0; v1 += s1; }
                    *(u32x4*)(O + (size_t)row * 1024 + c) = pack8(v0, v1);
                }
            }
    }
};

struct EpiRes {
    static constexpr bool PERM = true, AFTER_DRAIN = false;
    float* X; bf16_t* XB; float* SS;
    __device__ __forceinline__ void operator()(const f32x4 (&acc)[2][2][4][2], const Unit& u, int wr, int wc, int fr, int fq) const {
        const int rowb = u.pm * BM + wr * 64 + fr, cl = u.pn * BM + wc * 32 + 8 * fq;
#pragma unroll
        for (int ai = 0; ai < 2; ++ai)
#pragma unroll
            for (int m = 0; m < 4; ++m) {
                const int row = rowb + ai * HALF + m * 16;
                float sq = 0.f;
#pragma unroll
                for (int bj = 0; bj < 2; ++bj) {
                    const int c = cl + bj * HALF;
                    float* xp = X + (size_t)row * 1024 + c;
                    const f32x4 v0 = *(const f32x4*)xp + acc[ai][bj][m][0], v1 = *(const f32x4*)(xp + 4) + acc[ai][bj][m][1];
                    *(f32x4*)xp = v0; *(f32x4*)(xp + 4) = v1;
                    *(u32x4*)(XB + (size_t)row * 1024 + c) = pack8(v0, v1);
                    sq += (v0[0] * v0[0] + v0[1] * v0[1]) + (v0[2] * v0[2] + v0[3] * v0[3]) + (v1[0] * v1[0] + v1[1] * v1[1]) + (v1[2] * v1[2] + v1[3] * v1[3]);
                }
                sq += __shfl_xor(sq, 16); sq += __shfl_xor(sq, 32);
                if (fq == 0) atomicAdd(SS + row, sq);
            }
    }
};

struct EpiUp {
    static constexpr bool PERM = true, AFTER_DRAIN = false;
    const float* ss; bf16_t* UP; float *cv_p, *cv_s;
    __device__ __forceinline__ void operator()(const f32x4 (&acc)[2][2][4][2], const Unit& u, int wr, int wc, int fr, int fq) const {
        const int rowb = u.pm * BM + wr * 64 + fr, cl = u.pn * BM + wc * 32 + 8 * fq;
#pragma unroll
        for (int ai = 0; ai < 2; ++ai)
#pragma unroll
            for (int m = 0; m < 4; ++m) {
                const int row = rowb + ai * HALF + m * 16;
                const float rstd = 1.0f / sqrtf(ss[row] * (1.0f / 1024.f) + 1e-6f);
                const bool smp = row >= E_MP;
                const int t = smp ? ((row - E_MP) & 31) : (row & 2047);
                const int bb = smp ? ((row - E_MP) >> 5) : (row >> 11);
                const int slot = smp ? t - 30 : t - 2046;
#pragma unroll
                for (int bj = 0; bj < 2; ++bj) {
                    const int c = cl + bj * HALF;
                    const f32x4 v0 = acc[ai][bj][m][0] * rstd, v1 = acc[ai][bj][m][1] * rstd;
                    *(u32x4*)(UP + (size_t)row * 5632 + c) = pack8(v0, v1);
                    if (slot >= 0) { float* o = (smp ? cv_s : cv_p) + ((size_t)bb * 2 + slot) * 5632 + c; *(f32x4*)o = v0; *(f32x4*)(o + 4) = v1; }
                }
            }
    }
};

template <class Epi, class Sched, bool ALIGN_EPI = false, bool SP2 = false>
__device__ __forceinline__ void gemm_phase(PG8_LAS unsigned char* lds, const Gemm g, const Sched& S, const Epi& E) {
    int tid_ = threadIdx.x; asm volatile("" : "+v"(tid_));
    const int tid = tid_, wid = __builtin_amdgcn_readfirstlane(tid >> 6), lane = tid & 63, wr = wid >> 2, wc = wid & 3, fr = lane & 15, fq = lane >> 4;
    const int K = g.K, nt = K / BK;
    unsigned voffA[2], voffB[2];
#pragma unroll
    for (int i = 0; i < 2; ++i) { int R, C; stage_rc(tid * 16 + i * 8192, R, C); const int Rb = Epi::PERM ? ((R & ~31) + perm32(R & 31)) : R;
        voffA[i] = (unsigned)(R * K + C) * 2u; voffB[i] = (unsigned)(Rb * K + C) * 2u; }
    const size_t kstep = (size_t)(BK * 2);
    const size_t hstep = (size_t)HALF * K * 2;
    const size_t tstep = 2 * hstep;
    const unsigned ldsw = (unsigned)wid * 1024u;
    const int aoff = lds_byte(wr * 64 + fr, fq * 8), boff = lds_byte(wc * 32 + fr, fq * 8);
#define PG8_SA(b, h) (((b) * 2 + (h)) * HTB)
#define PG8_SB(b, h) ((4 + (b) * 2 + (h)) * HTB)
#define PG8_STAGE(bufoff, gbase, voff) do { _Pragma("unroll") for (int _i = 0; _i < 2; ++_i) \
        __builtin_amdgcn_global_load_lds((const unsigned*)((const char*)(gbase) + (voff)[_i]), (PG8_LAS unsigned*)(lds + (bufoff) + ldsw + _i * 8192), 16, 0, 0); } while (0)
#define PG8_LDA(dst, b, h) do { _Pragma("unroll") for (int m = 0; m < 4; ++m) _Pragma("unroll") for (int k = 0; k < 2; ++k) dst[m][k] = *(const PG8_LAS bf16x8*)(lds + PG8_SA(b, h) + aoff + m * 2048 + k * 1024); } while (0)
#define PG8_LDB(dst, b, h) do { _Pragma("unroll") for (int n = 0; n < 2; ++n) _Pragma("unroll") for (int k = 0; k < 2; ++k) dst[n][k] = *(const PG8_LAS bf16x8*)(lds + PG8_SB(b, h) + boff + n * 2048 + k * 1024); } while (0)
#define PG8_MMA(ai, bj, At, Bt) do { __builtin_amdgcn_s_setprio(1); _Pragma("unroll") for (int m = 0; m < 4; ++m) _Pragma("unroll") for (int n = 0; n < 2; ++n) _Pragma("unroll") for (int k = 0; k < 2; ++k) \
        acc[ai][bj][m][n] = __builtin_amdgcn_mfma_f32_16x16x32_bf16(Bt[n][k], At[m][k], acc[ai][bj][m][n], 0, 0, 0); __builtin_amdgcn_s_setprio(0); } while (0)
#define PG8_WAIT_V(n) asm volatile("s_waitcnt vmcnt(" #n ")" ::: "memory")
#define PG8_WAIT_L(n) asm volatile("s_waitcnt lgkmcnt(" #n ")" ::: "memory")
#define PG8_BAR __builtin_amdgcn_s_barrier()
#define PG8_SCHED __builtin_amdgcn_sched_barrier(0)
    Unit cur, nxt; int ui = 0;
    if (!S.next(0, cur)) return;
    f32x4 acc[2][2][4][2];
#pragma unroll
    for (int a = 0; a < 2; ++a)
#pragma unroll
        for (int b = 0; b < 2; ++b)
#pragma unroll
            for (int m = 0; m < 4; ++m)
#pragma unroll
                for (int n = 0; n < 2; ++n) acc[a][b][m][n] = (f32x4){0.f, 0.f, 0.f, 0.f};
    bf16x8 At[4][2], B0[2][2], B1[2][2];
    const char* cA = (const char*)g.A + (size_t)cur.pm * tstep; const char* cB = (const char*)g.Bt + (size_t)cur.pn * tstep;
    S.a_ready(cur);
    if constexpr (SP2) {
        PG8_STAGE(PG8_SB(0, 0), cB, voffB); PG8_STAGE(PG8_SB(0, 1), cB + hstep, voffB); PG8_STAGE(PG8_SA(0, 0), cA, voffA); PG8_STAGE(PG8_SA(0, 1), cA + hstep, voffA);
        if (wr == 1) PG8_BAR;
        PG8_WAIT_V(2); PG8_BAR;
        PG8_STAGE(PG8_SB(1, 0), cB + kstep, voffB); PG8_STAGE(PG8_SA(1, 0), cA + kstep, voffA); PG8_STAGE(PG8_SB(1, 1), cB + hstep + kstep, voffB);
        PG8_WAIT_V(6); PG8_BAR;
    } else {
        PG8_STAGE(PG8_SB(0, 0), cB, voffB); PG8_STAGE(PG8_SA(0, 0), cA, voffA); PG8_STAGE(PG8_SB(0, 1), cB + hstep, voffB); PG8_STAGE(PG8_SA(0, 1), cA + hstep, voffA);
        if (wr == 1) PG8_BAR;
        PG8_WAIT_V(4); PG8_BAR;
        PG8_STAGE(PG8_SB(1, 0), cB + kstep, voffB); PG8_STAGE(PG8_SA(1, 0), cA + kstep, voffA); PG8_STAGE(PG8_SB(1, 1), cB + hstep + kstep, voffB);
        PG8_WAIT_V(6); PG8_BAR;
    }
    for (;;) {
        const bool has_next = S.next(ui + 1, nxt);
        const char* nA = has_next ? (const char*)g.A + (size_t)nxt.pm * tstep : cA; const char* nB = has_next ? (const char*)g.Bt + (size_t)nxt.pn * tstep : cB;
        for (int t = 0; t < nt; t += 2) {
            const bool last = (t == nt - 2);
            const char* a1 = cA + (size_t)(t + 1) * kstep;
            const char* a2 = last ? nA : cA + (size_t)(t + 2) * kstep; const char* b2 = last ? nB : cB + (size_t)(t + 2) * kstep;
            const char* a3 = a2 + kstep; const char* b3 = b2 + kstep;
            if (last && has_next) S.a_ready(nxt);
            if constexpr (SP2) {
            PG8_LDB(B0, 0, 0); PG8_LDB(B1, 0, 1); PG8_SCHED; PG8_LDA(At, 0, 0); PG8_STAGE(PG8_SA(1, 1), a1 + hstep, voffA);
            PG8_WAIT_V(8); PG8_WAIT_L(0); PG8_BAR; PG8_MMA(0, 0, At, B0); PG8_MMA(0, 1, At, B1); PG8_BAR; PG8_SCHED;
            PG8_LDA(At, 0, 1); PG8_STAGE(PG8_SB(0, 0), b2, voffB); PG8_STAGE(PG8_SB(0, 1), b2 + hstep, voffB); PG8_STAGE(PG8_SA(0, 0), a2, voffA);
            PG8_WAIT_V(8); PG8_WAIT_L(0); PG8_BAR; PG8_MMA(1, 0, At, B0); PG8_MMA(1, 1, At, B1); PG8_BAR; PG8_SCHED;
            PG8_LDB(B0, 1, 0); PG8_LDB(B1, 1, 1); PG8_SCHED; PG8_LDA(At, 1, 0); PG8_STAGE(PG8_SA(0, 1), a2 + hstep, voffA);
            PG8_WAIT_V(8); PG8_WAIT_L(0); PG8_BAR; PG8_MMA(0, 0, At, B0); PG8_MMA(0, 1, At, B1); PG8_BAR; PG8_SCHED;
            PG8_LDA(At, 1, 1); PG8_STAGE(PG8_SB(1, 0), b3, voffB); PG8_STAGE(PG8_SB(1, 1), b3 + hstep, voffB); PG8_STAGE(PG8_SA(1, 0), a3, voffA);
            PG8_WAIT_V(8); PG8_WAIT_L(0); PG8_BAR; PG8_MMA(1, 0, At, B0); PG8_MMA(1, 1, At, B1); PG8_BAR; PG8_SCHED;
            } else {
            PG8_LDB(B0, 0, 0); PG8_SCHED; PG8_LDA(At, 0, 0); PG8_STAGE(PG8_SA(1, 1), a1 + hstep, voffA);
            PG8_WAIT_L(8); PG8_BAR; PG8_WAIT_L(0); PG8_MMA(0, 0, At, B0); PG8_BAR; PG8_SCHED;
            PG8_LDB(B1, 0, 1); PG8_STAGE(PG8_SB(0, 0), b2, voffB);
            PG8_BAR; PG8_WAIT_L(0); PG8_MMA(0, 1, At, B1); PG8_BAR;
            PG8_LDA(At, 0, 1); PG8_STAGE(PG8_SA(0, 0), a2, voffA);
            PG8_BAR; PG8_WAIT_L(0); PG8_MMA(1, 0, At, B0); PG8_BAR; PG8_SCHED;
            PG8_STAGE(PG8_SB(0, 1), b2 + hstep, voffB);
            PG8_WAIT_V(6); PG8_BAR; PG8_MMA(1, 1, At, B1); PG8_BAR;
            PG8_LDB(B0, 1, 0); PG8_SCHED; PG8_LDA(At, 1, 0); PG8_STAGE(PG8_SA(0, 1), a2 + hstep, voffA);
            PG8_WAIT_L(8); PG8_BAR; PG8_WAIT_L(0); PG8_MMA(0, 0, At, B0); PG8_BAR; PG8_SCHED;
            PG8_LDB(B1, 1, 1); PG8_STAGE(PG8_SB(1, 0), b3, voffB);
            PG8_BAR; PG8_WAIT_L(0); PG8_MMA(0, 1, At, B1); PG8_BAR;
            PG8_LDA(At, 1, 1); PG8_STAGE(PG8_SA(1, 0), a3, voffA);
            PG8_BAR; PG8_WAIT_L(0); PG8_MMA(1, 0, At, B0); PG8_BAR; PG8_SCHED;
            PG8_STAGE(PG8_SB(1, 1), b3 + hstep, voffB);
            PG8_WAIT_V(6); PG8_BAR; PG8_MMA(1, 1, At, B1); PG8_BAR;
            }
        }
        if constexpr (ALIGN_EPI) { if (wr == 0) PG8_BAR; }
        if constexpr (!Epi::AFTER_DRAIN) { E(acc, cur, wr, wc, fr, fq); S.done(cur); }
        if (!has_next) break;
#pragma unroll
        for (int a = 0; a < 2; ++a)
#pragma unroll
            for (int b = 0; b < 2; ++b)
#pragma unroll
                for (int m = 0; m < 4; ++m)
#pragma unroll
                    for (int n = 0; n < 2; ++n) acc[a][b][m][n] = (f32x4){0.f, 0.f, 0.f, 0.f};
        cur = nxt; cA = nA; cB = nB; ++ui;
        if constexpr (ALIGN_EPI) { if (wr == 1) PG8_BAR; }
    }
    PG8_WAIT_V(0);
    if constexpr (!ALIGN_EPI) { if (wr == 0) PG8_BAR; }
    PG8_BAR;
    if constexpr (Epi::AFTER_DRAIN) { E.fused(acc, cur, wr, wc, fr, fq, lds, wid, lane); S.done(cur); }
#undef PG8_SA
#undef PG8_SB
#undef PG8_STAGE
#undef PG8_LDA
#undef PG8_LDB
#undef PG8_MMA
#undef PG8_WAIT_V
#undef PG8_WAIT_L
#undef PG8_BAR
#undef PG8_SCHED
}
}

constexpr int NWAVES = 8;
constexpr size_t MiB = 1u << 20;
constexpr size_t WS_CTL = 0, CTL_ZERO_BYTES = 2 * MiB;
constexpr size_t WS_ROPE = 2 * MiB;
constexpr size_t WS_SP = WS_ROPE + 256 * 1024;
constexpr size_t WS_W = 8 * MiB;
constexpr size_t W_IN = 0, W_ODA = W_IN + (size_t)P_TOTAL * 1024 * 2, W_ORW = W_ODA + 2 * MiB, W_OUT = W_ORW + 2 * MiB, W_UP = W_OUT + 2 * MiB,
                 W_DN = W_UP + (size_t)UPW * 1024 * 2, W_LORA = W_DN + (size_t)1024 * D_FF * 2, W_LAYER = W_LORA + (size_t)3072 * 256 * 2;
static_assert(W_LAYER == 42467328, "weights per layer");
constexpr size_t WS_XB = WS_W + 2 * W_LAYER + (MiB - (2 * W_LAYER) % MiB) % MiB;
constexpr size_t ACT = (size_t)MT * 1024 * 2;
constexpr size_t WS_POOL = WS_XB + ACT;
constexpr size_t B_Q = WS_POOL, B_K = B_Q + ACT, B_V = B_K + ACT, B_OC = B_V + ACT  , B_OA = B_OC + 2 * ACT, B_URW = B_OA + ACT, B_GATE = B_URW + (size_t)MT * P_RW * 2,
                 B_END = B_GATE + (size_t)MT * 2048 * 2;
constexpr size_t B_LD = B_Q, B_LA = B_K, B_LG = B_V, B_LIN = B_END, B_ORW = B_OC + ACT;
constexpr size_t B_END2 = B_LIN + (size_t)MT * 256 * 2;
constexpr size_t B_MRG = B_URW;
constexpr size_t B_UP = WS_POOL, B_GT = B_URW;
static_assert(B_UP + (size_t)MT * UPW * 2 <= B_GT && B_GT + (size_t)MT * D_FF * 2 <= B_END, "FFN overlay");
static_assert(B_END2 <= 512 * MiB, "workspace map");
constexpr int CW_BAR = 4096;
constexpr int CW_LAM = 8192;
constexpr int CW_SS = 16384;
static_assert((CW_SS + 5 * MT) * 4 <= (int)CTL_ZERO_BYTES, "CTL region");
constexpr int RING_OFF = 0, RING_BYTES = 131072;
constexpr int LDSCTL_OFF = RING_BYTES, MISC_OFF = LDSCTL_OFF + 320;
constexpr int LDS_BYTES = 147456;

constexpr int PH_PER_LAYER = 11;
constexpr int NPHASE = 1 + DEPTH * PH_PER_LAYER + 1;
enum { K_G1 = 0, K_AT, K_CB, K_LR, K_SC, K_M1, K_M2, K_WO, K_UP, K_CV, K_DN };

#include <hip/hip_bf16.h>
#include <cmath>
namespace attn_body {
using bf16=__hip_bfloat16;
using bf16x8=__attribute__((ext_vector_type(8)))short;
using s16x4=__attribute__((ext_vector_type(4)))short;
using f32x16=__attribute__((ext_vector_type(16)))float;
using u32x4=__attribute__((ext_vector_type(4)))unsigned;
constexpr int BATCH=8,SEQ=2048,D=64,DM=1024;
constexpr int NW=8,QBLK=32,QB=QBLK*NW,KVBLK=64,NQB=SEQ/QB;
constexpr int ATTN_PITCH=DM, ATTN_UNIT_ROWS=QB;
__device__ __forceinline__ int crow(int r,int hi){return (r&3)+8*(r>>2)+4*hi;}
#define SBAR() __builtin_amdgcn_sched_barrier(0)
__device__ __forceinline__ void cmask(f32x16&p0,f32x16&p1,int jb,int wid){
  const float NEG=-INFINITY;
  if(jb>(wid>>1)){
    #pragma unroll
    for(int r=0;r<16;++r){p0[r]=NEG;p1[r]=NEG;}
  }
}

constexpr int NSLOT=3, SLOTB=8192;
constexpr int LDS_K=0, LDS_V=NSLOT*SLOTB, LDS_WS=2*NSLOT*SLOTB, LDS_OST=LDS_WS+NW*64*4, LDS_BYTES=LDS_OST+NW*4096;
constexpr float C2=0.125f*1.4426950408889634f;
__device__ __forceinline__ void glds16(const void*gsrc,unsigned lds_dst){unsigned keep;
  asm volatile("s_mov_b32 %0, m0\n\ts_mov_b32 m0, %2\n\ts_nop 0\n\tglobal_load_lds_dwordx4 %1, off\n\ts_mov_b32 m0, %0":"=&s"(keep):"v"(gsrc),"s"(lds_dst):"memory");}
__device__ __forceinline__ float max3f(float a,float b,float c){float r;asm("v_max3_f32 %0, %1, %2, %3":"=v"(r):"v"(a),"v"(b),"v"(c));return r;}
__device__ __forceinline__ float max2f(float a,float b){float r;asm("v_max_f32_e32 %0, %1, %2":"=v"(r):"v"(a),"v"(b));return r;}
__device__ __forceinline__ float fadd_s(float a,float b){float r;asm("v_add_f32_e32 %0, %1, %2":"=v"(r):"v"(a),"v"(b));return r;}
__device__ __forceinline__ float fsub_s(float a,float b){float r;asm("v_sub_f32_e32 %0, %1, %2":"=v"(r):"v"(a),"v"(b));return r;}
typedef float f32x2_t __attribute__((ext_vector_type(2))); typedef __bf16 bf16x2_t __attribute__((ext_vector_type(2)));
__device__ __forceinline__ unsigned cvtpk_s(float lo,float hi){f32x2_t v={lo,hi};bf16x2_t b=__builtin_convertvector(v,bf16x2_t);return __builtin_bit_cast(unsigned,b);}
#define WAIT_BAR(N) asm volatile("s_waitcnt vmcnt(" #N ") lgkmcnt(0)\n\ts_barrier":::"memory")

__device__ __forceinline__ void qkt(f32x16&p0,f32x16&p1,const char*Kslot,const bf16x8*qr,const f32x16&negm,int r32,int hi){
  const char*kb=Kslot+hi*1024+r32*16;
  #pragma unroll
  for(int d0=0;d0<4;++d0){
    const bf16x8 b0=*reinterpret_cast<const bf16x8*>(kb+d0*2048);
    const bf16x8 b1=*reinterpret_cast<const bf16x8*>(kb+d0*2048+512);
    if(d0==0){p0=__builtin_amdgcn_mfma_f32_32x32x16_bf16(b0,qr[0],negm,0,0,0);p1=__builtin_amdgcn_mfma_f32_32x32x16_bf16(b1,qr[0],negm,0,0,0);}
    else{p0=__builtin_amdgcn_mfma_f32_32x32x16_bf16(b0,qr[d0],p0,0,0,0);p1=__builtin_amdgcn_mfma_f32_32x32x16_bf16(b1,qr[d0],p1,0,0,0);}}
}
typedef __attribute__((address_space(3))) const char* lds_cptr;
typedef short v4i16_t __attribute__((ext_vector_type(4)));
__device__ __forceinline__ void kload8(bf16x8*kf,lds_cptr kp){
  kf[0]=*(const __attribute__((address_space(3))) bf16x8*)(kp);      kf[1]=*(const __attribute__((address_space(3))) bf16x8*)(kp+512);
  kf[2]=*(const __attribute__((address_space(3))) bf16x8*)(kp+2048); kf[3]=*(const __attribute__((address_space(3))) bf16x8*)(kp+2560);
  kf[4]=*(const __attribute__((address_space(3))) bf16x8*)(kp+4096); kf[5]=*(const __attribute__((address_space(3))) bf16x8*)(kp+4608);
  kf[6]=*(const __attribute__((address_space(3))) bf16x8*)(kp+6144); kf[7]=*(const __attribute__((address_space(3))) bf16x8*)(kp+6656);
}
__device__ __forceinline__ void kload2(bf16x8*kf,lds_cptr kp,int j){ kf[2*j]=*(const __attribute__((address_space(3))) bf16x8*)(kp+j*2048); kf[2*j+1]=*(const __attribute__((address_space(3))) bf16x8*)(kp+j*2048+512); }
__device__ __forceinline__ s16x4 vtr(lds_cptr p){ return __builtin_bit_cast(s16x4,__builtin_amdgcn_ds_read_tr16_b64_v4i16((__attribute__((address_space(3))) v4i16_t*)p)); }
__device__ __forceinline__ float rowmax(const f32x16&p0,const f32x16&p1){
  float a=max3f(p0[0],p0[1],p1[0]),b=max3f(p0[2],p0[3],p1[1]);a=max3f(a,p1[2],p1[3]);
  #pragma unroll
  for(int r=4;r<16;r+=4){a=max3f(a,p0[r],p0[r+1]);b=max3f(b,p0[r+2],p0[r+3]);a=max3f(a,p1[r],p1[r+1]);b=max3f(b,p1[r+2],p1[r+3]);}
  const float m=max2f(a,b);
  auto rr=__builtin_amdgcn_permlane32_swap(__float_as_uint(m),__float_as_uint(m),false,false);
  return max2f(__uint_as_float(rr[0]),__uint_as_float(rr[1]));
}
__device__ __forceinline__ void pv(f32x16*o,int vb,bf16x8 pa0,bf16x8 pa1,bf16x8 pa2,bf16x8 pa3){
  #pragma unroll
  for(int d0=0;d0<2;++d0){s16x4 lo[4],hi[4];
    #pragma unroll
    for(int ks=0;ks<4;++ks){
      asm volatile("ds_read_b64_tr_b16 %0,%1 offset:%c2":"=&v"(lo[ks]):"v"(vb),"i"(d0*4096+ks*1024):"memory");
      asm volatile("ds_read_b64_tr_b16 %0,%1 offset:%c2":"=&v"(hi[ks]):"v"(vb),"i"(d0*4096+ks*1024+512):"memory");}
    asm volatile("s_waitcnt lgkmcnt(0)":::"memory");SBAR();
    #define PK(k) (bf16x8){lo[k][0],lo[k][1],lo[k][2],lo[k][3],hi[k][0],hi[k][1],hi[k][2],hi[k][3]}
    o[d0]=__builtin_amdgcn_mfma_f32_32x32x16_bf16(pa0,PK(0),o[d0],0,0,0);
    o[d0]=__builtin_amdgcn_mfma_f32_32x32x16_bf16(pa1,PK(1),o[d0],0,0,0);
    o[d0]=__builtin_amdgcn_mfma_f32_32x32x16_bf16(pa2,PK(2),o[d0],0,0,0);
    o[d0]=__builtin_amdgcn_mfma_f32_32x32x16_bf16(pa3,PK(3),o[d0],0,0,0);
    #undef PK
  }
}

#ifndef ATTN_STORE16
#define ATTN_STORE16(p,v) (*(u32x4*)(p)=(v))
#endif
template<int THRL> __device__ __forceinline__ void attn_unit(int b,int qcol,int vcol,int qb,const bf16*Q,const bf16*K,const bf16*V,bf16*O,char*shm){
  const int tid=threadIdx.x,lane=tid&63,r32=lane&31,hi=lane>>5; const int wid=__builtin_amdgcn_readfirstlane(tid>>6);
  const long rowbase=(long)b*SEQ; const int q0=qb*QB;
  const bf16*Qw=Q+(rowbase+q0+wid*QBLK)*DM+qcol;
  const bf16*Kh=K+rowbase*DM+qcol,*Vh=V+rowbase*DM+vcol;
  const unsigned lds0=(unsigned)(uintptr_t)shm;
  float*wsf=(float*)(shm+LDS_WS)+wid*64;
  const bf16*ksrc=Kh+(long)lane*DM+wid*8;
  const bf16*vsrc=Vh+(long)(16*(wid&3)+(lane>>2))*DM+(wid>>2)*32+(lane&3)*8;
  const unsigned kdst=lds0+LDS_K+wid*1024, vdst=lds0+LDS_V+wid*1024;
  #define DMA_K(t,slot) glds16(ksrc+(long)(t)*KVBLK*DM,(unsigned)__builtin_amdgcn_readfirstlane(kdst+(slot)))
  #define DMA_V(t,slot) glds16(vsrc+(long)(t)*KVBLK*DM,(unsigned)__builtin_amdgcn_readfirstlane(vdst+(slot)))
  const int vb0=(int)(lds0+LDS_V)+((lane>>4)&1)*32+(lane&3)*8+(4*hi+((lane&15)>>2))*64;
  const char*Kbase=shm+LDS_K; bf16x8 kf[8];
  const lds_cptr shm3=(lds_cptr)shm; const lds_cptr kp0=shm3+LDS_K+hi*1024+r32*16; const lds_cptr vp0=shm3+LDS_V+((lane>>4)&1)*32+(lane&3)*8+(4*hi+((lane&15)>>2))*64;
  const int NT=(q0+QB)/KVBLK;
  DMA_K(0,0);DMA_V(0,0);DMA_K(1,SLOTB);
  bf16x8 qr[4];
  #pragma unroll
  for(int d0=0;d0<4;++d0)qr[d0]=*reinterpret_cast<const bf16x8*>(&Qw[(long)r32*DM+d0*16+hi*8]);
  float mhat=0.f,l_reg=0.f;f32x16 o[2];o[0]=f32x16{};o[1]=f32x16{};const f32x16 zc=f32x16{}; float nm=0.f;
  const int qrel=wid*QBLK+r32;
  #define CMASK(P0,P1,t) do{int jb_=(t)-(NT-4); if(jb_>=0)cmask(P0,P1,jb_,wid);}while(0)
  bool resc=false;
  #define START(P0,P1) do{ const float rm=rowmax(P0,P1); resc=false; \
    { const float dl=rm; mhat=fadd_s(mhat,dl); \
      _Pragma("unroll") for(int r=0;r<16;++r){P0[r]=fsub_s(P0[r],dl);P1[r]=fsub_s(P1[r],dl);} \
      nm=-mhat; } \
    _Pragma("unroll") for(int r=0;r<16;++r)P0[r]=__builtin_amdgcn_exp2f(P0[r]); }while(0)
  #define RESC() do{ if(resc){ asm volatile("s_waitcnt lgkmcnt(0)":::"memory"); \
      _Pragma("unroll") for(int d_=0;d_<2;++d_) _Pragma("unroll") for(int r=0;r<16;++r)o[d_][r]*=wsf[crow(r,hi)]; } }while(0)
  f32x16 pA0,pA1,pB0,pB1;
  int sl_prev=0,sl_cur=0,sl_next=SLOTB;
  #define ROT() do{sl_prev=sl_cur;sl_cur=sl_next;sl_next=(sl_next==(NSLOT-1)*SLOTB)?0:sl_next+SLOTB;}while(0)
  DMA_K(2,2*SLOTB);
  WAIT_BAR(3);
  qkt(pA0,pA1,Kbase,qr,zc,r32,hi);asm volatile("s_nop 15\n\ts_nop 7":"+v"(pA0),"+v"(pA1));CMASK(pA0,pA1,0);
  START(pA0,pA1);
  _Pragma("unroll") for(int r=0;r<16;++r)pA1[r]=__builtin_amdgcn_exp2f(pA1[r]);
  WAIT_BAR(0);
  DMA_K(3,0);DMA_V(1,SLOTB);
  ROT();
  kload8(kf,kp0+sl_cur);
  WAIT_BAR(2);
  s16x4 vlo[8],vhi[8]; u32x4 pw0,pw1,pw2,pw3;
  #define PKW(P,B) cvtpk_s(P[B],P[B+1])
  #define PAF(k) __builtin_bit_cast(bf16x8,pw##k)
  #define VFR(i) (bf16x8){vlo[i][0],vlo[i][1],vlo[i][2],vlo[i][3],vhi[i][0],vhi[i][1],vhi[i][2],vhi[i][3]}
  #define PIN(x) asm volatile("":"+v"(x))
  #define MX3(a,b,c) __builtin_fmaxf(__builtin_fmaxf((a),(b)),(c))
  #define GAPA(MF,A0,A1,A2,A3,W0,W1,PW) do{ MF; sacc+=A0; sacc+=A1; sacc+=A2; sacc+=A3; PIN(sacc); W0; W1; PIN(PW); SBAR(); }while(0)
  #define EX(v) __builtin_amdgcn_exp2f(v)
  #define GAPB(MF,X,B) do{ MF; X[B]=EX(X[B]); X[B+1]=EX(X[B+1]); X[B+2]=EX(X[B+2]); X[B+3]=EX(X[B+3]); PIN(X); SBAR(); }while(0)
  #define VRD(i) do{ vlo[i]=vtr(vp_+(((i)>>2)*4096+((i)&3)*1024)); vhi[i]=vtr(vp_+(((i)>>2)*4096+((i)&3)*1024+512)); }while(0)
  #define KRD(G,j) do{ if(G){ kload2(kf,kp0+sl_next,j); SBAR(); } }while(0)
  #define STEP(C0,C1,P0,P1,t,GK,GV,GL) do{ SBAR(); \
    const lds_cptr vp_=vp0+sl_prev; \
    VRD(0); SBAR(); float sacc=(P0[0]+P0[1]); \
    GAPA(C0=__builtin_amdgcn_mfma_f32_32x32x16_bf16(kf[0],qr[0],zc,0,0,0), P0[2],P0[3],P0[4],P0[5],     pw0[0]=PKW(P0,0), pw0[1]=PKW(P0,2), pw0); \
    VRD(4); SBAR(); GAPA(C1=__builtin_amdgcn_mfma_f32_32x32x16_bf16(kf[1],qr[0],zc,0,0,0), P0[6],P0[7],P0[8],P0[9],     pw0[2]=PKW(P0,4), pw0[3]=PKW(P0,6), pw0); \
    VRD(1); SBAR(); GAPA(C0=__builtin_amdgcn_mfma_f32_32x32x16_bf16(kf[2],qr[1],C0,0,0,0),   P0[10],P0[11],P0[12],P0[13], pw1[0]=PKW(P0,8), pw1[1]=PKW(P0,10), pw1); \
    VRD(5); SBAR(); GAPA(C1=__builtin_amdgcn_mfma_f32_32x32x16_bf16(kf[3],qr[1],C1,0,0,0),   P0[14],P0[15],P1[0],P1[1],   pw1[2]=PKW(P0,12),pw1[3]=PKW(P0,14), pw1); \
    VRD(2); SBAR(); GAPA(C0=__builtin_amdgcn_mfma_f32_32x32x16_bf16(kf[4],qr[2],C0,0,0,0),   P1[2],P1[3],P1[4],P1[5],     pw2[0]=PKW(P1,0), pw2[1]=PKW(P1,2), pw2); \
    VRD(6); SBAR(); GAPA(C1=__builtin_amdgcn_mfma_f32_32x32x16_bf16(kf[5],qr[2],C1,0,0,0),   P1[6],P1[7],P1[8],P1[9],     pw2[2]=PKW(P1,4), pw2[3]=PKW(P1,6), pw2); \
    VRD(3); SBAR(); GAPA(C0=__builtin_amdgcn_mfma_f32_32x32x16_bf16(kf[6],qr[3],C0,0,0,0),   P1[10],P1[11],P1[12],P1[13], pw3[0]=PKW(P1,8), pw3[1]=PKW(P1,10), pw3); \
    VRD(7); SBAR(); GAPA(C1=__builtin_amdgcn_mfma_f32_32x32x16_bf16(kf[7],qr[3],C1,0,0,0),   P1[14],P1[15],0.f,0.f,       pw3[2]=PKW(P1,12),pw3[3]=PKW(P1,14), pw3); \
    l_reg+=sacc; \
    if(GK){DMA_K((t)+3,sl_cur);} if(GV){DMA_V((t)+1,sl_next);} \
    _Pragma("unroll") for(int r=0;r<16;++r){C0[r]+=nm;C1[r]+=nm;} \
    CMASK(C0,C1,t); \
    { float a=MX3(C0[0],C0[1],C1[0]),b=MX3(C0[2],C0[3],C1[1]); a=MX3(a,C1[2],C1[3]); \
      _Pragma("unroll") for(int r=4;r<16;r+=4){a=MX3(a,C0[r],C0[r+1]);b=MX3(b,C0[r+2],C0[r+3]);a=MX3(a,C1[r],C1[r+1]);b=MX3(b,C1[r+2],C1[r+3]);} \
      float rm=__builtin_fmaxf(a,b); { auto rr=__builtin_amdgcn_permlane32_swap(__float_as_uint(rm),__float_as_uint(rm),false,false); rm=__builtin_fmaxf(__uint_as_float(rr[0]),__uint_as_float(rr[1])); } \
      resc=false; \
      if(__builtin_expect(__any(rm>(float)THRL),0)){ const float dl=__builtin_fmaxf(rm,0.f); mhat+=dl; \
        _Pragma("unroll") for(int r=0;r<16;++r){C0[r]-=dl;C1[r]-=dl;} \
        nm=-mhat; \
        const float f=__builtin_amdgcn_exp2f(-dl); l_reg*=f; if(hi==0)wsf[r32]=f; resc=true; } } \
    SBAR(); \
    GAPB(o[0]=__builtin_amdgcn_mfma_f32_32x32x16_bf16(PAF(0),VFR(0),o[0],0,0,0), C0,0); \
    GAPB(o[1]=__builtin_amdgcn_mfma_f32_32x32x16_bf16(PAF(0),VFR(4),o[1],0,0,0), C0,4); \
    KRD(GL,0); GAPB(o[0]=__builtin_amdgcn_mfma_f32_32x32x16_bf16(PAF(1),VFR(1),o[0],0,0,0), C0,8); \
    KRD(GL,1); GAPB(o[1]=__builtin_amdgcn_mfma_f32_32x32x16_bf16(PAF(1),VFR(5),o[1],0,0,0), C0,12); \
    KRD(GL,2); GAPB(o[0]=__builtin_amdgcn_mfma_f32_32x32x16_bf16(PAF(2),VFR(2),o[0],0,0,0), C1,0); \
    KRD(GL,3); GAPB(o[1]=__builtin_amdgcn_mfma_f32_32x32x16_bf16(PAF(2),VFR(6),o[1],0,0,0), C1,4); \
    GAPB(o[0]=__builtin_amdgcn_mfma_f32_32x32x16_bf16(PAF(3),VFR(3),o[0],0,0,0), C1,8); \
    GAPB(o[1]=__builtin_amdgcn_mfma_f32_32x32x16_bf16(PAF(3),VFR(7),o[1],0,0,0), C1,12); \
    }while(0)
  int t=1;
  #undef CMASK
  #define CMASK(P0,P1,t) do{}while(0)
  for(;t+5<NT;t+=2){
    STEP(pB0,pB1,pA0,pA1,t,true,true,true);     WAIT_BAR(2); RESC(); ROT();
    STEP(pA0,pA1,pB0,pB1,t+1,true,true,true);   WAIT_BAR(2); RESC(); ROT();
  }
  #undef CMASK
  #define CMASK(P0,P1,t) do{int jb_=(t)-(NT-4); if(jb_>=0)cmask(P0,P1,jb_,wid);}while(0)
  #define ENDW(tt) do{ if((tt)+3<NT){WAIT_BAR(2);} else if((tt)+2<NT){WAIT_BAR(1);} else {WAIT_BAR(0);} }while(0)
  for(;t+1<NT;t+=2){
    STEP(pB0,pB1,pA0,pA1,t,(t+3<NT),(t+1<NT),(t+1<NT));       ENDW(t);   RESC(); ROT();
    STEP(pA0,pA1,pB0,pB1,t+1,(t+4<NT),(t+2<NT),(t+2<NT));     ENDW(t+1); RESC(); ROT();
  }
  STEP(pB0,pB1,pA0,pA1,NT-1,false,false,false); RESC();
  { float sacc=pB0[0]+pB0[1]; _Pragma("unroll") for(int r=2;r<16;++r)sacc+=pB0[r]; _Pragma("unroll") for(int r=0;r<16;++r)sacc+=pB1[r]; l_reg+=sacc;
    pw0=(u32x4){PKW(pB0,0),PKW(pB0,2),PKW(pB0,4),PKW(pB0,6)};pw1=(u32x4){PKW(pB0,8),PKW(pB0,10),PKW(pB0,12),PKW(pB0,14)};pw2=(u32x4){PKW(pB1,0),PKW(pB1,2),PKW(pB1,4),PKW(pB1,6)};pw3=(u32x4){PKW(pB1,8),PKW(pB1,10),PKW(pB1,12),PKW(pB1,14)};
    SBAR(); pv(o,vb0+sl_cur,PAF(0),PAF(1),PAF(2),PAF(3)); }
  #undef PKW
  #undef PAF
  #undef VFR
  #undef PIN
  #undef MX3
  #undef GAPA
  #undef GAPB
  #undef EX
  #undef VRD
  #undef KRD
  #undef STEP
  #undef ENDW
  {auto rr=__builtin_amdgcn_permlane32_swap(__float_as_uint(l_reg),__float_as_uint(l_reg),false,false);l_reg=__uint_as_float(rr[0])+__uint_as_float(rr[1]);}
  if(hi==0)wsf[32+r32]=l_reg;asm volatile("s_waitcnt lgkmcnt(0)":::"memory");
  float rli[16];
  #pragma unroll
  for(int r=0;r<16;++r)rli[r]=__builtin_amdgcn_rcpf(wsf[32+crow(r,hi)]);
  bf16*Ow=O+(rowbase+q0+wid*QBLK)*DM+vcol;
  { bf16*stg=(bf16*)(shm+LDS_OST)+wid*2048;
    #pragma unroll
    for(int r=0;r<16;++r){const int orow=crow(r,hi);
      #pragma unroll
      for(int d0=0;d0<2;++d0)stg[orow*64+d0*32+r32]=__float2bfloat16(o[d0][r]*rli[r]);}
    asm volatile("s_waitcnt lgkmcnt(0)":::"memory");
    #pragma unroll
    for(int i=0;i<4;++i){const int row=i*8+(lane>>3),ch=lane&7; const u32x4 v=*(const u32x4*)(stg+row*64+ch*8); ATTN_STORE16(Ow+(long)row*DM+ch*8,v);} }
  asm volatile("s_waitcnt lgkmcnt(0)\n\ts_barrier":::"memory");
  #undef DMA_K
  #undef DMA_V
  #undef CMASK
  #undef START
  #undef RESC
  #undef ROT
}
constexpr int ATTN_LDS_BYTES=LDS_BYTES;
#undef SBAR
#undef WAIT_BAR
}

#define GAS __attribute__((address_space(1)))
#define LAS __attribute__((address_space(3)))
typedef unsigned short bf16;
typedef unsigned v4u __attribute__((ext_vector_type(4)));
typedef float f32x4 __attribute__((ext_vector_type(4)));
typedef short bf16x8 __attribute__((ext_vector_type(8)));
typedef GAS unsigned gu32;
typedef GAS unsigned long long gu64;
#define RLX_AGENT __ATOMIC_RELAXED, __HIP_MEMORY_SCOPE_AGENT
#define LDS_WAIT() asm volatile("s_waitcnt lgkmcnt(0)" ::: "memory")
#define VM_WAIT() asm volatile("s_waitcnt vmcnt(0)" ::: "memory")
__device__ __forceinline__ unsigned long long rt() { return __builtin_amdgcn_s_memrealtime(); }
__device__ __forceinline__ unsigned f2bf(float f) { unsigned u = __builtin_bit_cast(unsigned, f); return (u + 0x7fffu + ((u >> 16) & 1u)) >> 16; }
__device__ __forceinline__ unsigned pk2(float lo, float hi) { return f2bf(lo) | (f2bf(hi) << 16); }

#define XB_TMO      128
#define XB_XCNT(j)  (256  + 64 * (j))
#define XB_XSUB(j)  (1280 + 64 * (j))
#define XB_XGEN(j)  (2304 + 64 * (j))
#define XB_TOP      3328
#define XB_TOPGEN   3392
#define XCD_BAR_WORDS 3456
#define XB_SPIN_CAP (1u << 22)

__device__ __forceinline__ unsigned xb_ld(unsigned* p)              { return __hip_atomic_load(p, __ATOMIC_RELAXED, __HIP_MEMORY_SCOPE_AGENT); }
__device__ __forceinline__ unsigned xb_add(unsigned* p, unsigned v) { return __hip_atomic_fetch_add(p, v, __ATOMIC_RELAXED, __HIP_MEMORY_SCOPE_AGENT); }
__device__ __forceinline__ unsigned xb_xcc_id() { return (unsigned)__builtin_amdgcn_s_getreg((3 << 11) | 20) & 0xFu; }
#define XB_SPIN(cond, bar) do { unsigned _sp = 0; while (cond) { __builtin_amdgcn_s_sleep(1); \
    if ((++_sp & 255u) == 0u) { if (xb_ld(&(bar)[XB_TMO])) break; if (_sp > XB_SPIN_CAP) { atomicAdd(&(bar)[XB_TMO], 1u); break; } } } } while (0)

struct XcdBarrier {
    unsigned* bar; unsigned x;
    volatile LAS unsigned* st;
};

__device__ __forceinline__ XcdBarrier xcd_barrier_post(unsigned* bar, volatile LAS unsigned* st) {
    XcdBarrier b; b.bar = bar; b.x = xb_xcc_id(); b.st = st;
    if (threadIdx.x == 0) (void)xb_add(&bar[XB_XCNT(b.x)], 1u);
    return b;
}
__device__ __forceinline__ void xcd_barrier_complete(unsigned* bar, unsigned x, unsigned& nloc, unsigned& nx) {
    const unsigned G = gridDim.x * gridDim.y * gridDim.z;
    unsigned sum, cnt, mine, sp = 0u;
    for (;;) {
        sum = 0u; cnt = 0u; mine = 0u;
#pragma unroll
        for (unsigned j = 0; j < 16; ++j) { const unsigned c = xb_ld(&bar[XB_XCNT(j)]); sum += c; cnt += (c > 0u) ? 1u : 0u; mine = (j == x) ? c : mine; }
        if (sum == G) break;
        __builtin_amdgcn_s_sleep(1);
        if ((++sp & 255u) == 0u) { if (xb_ld(&bar[XB_TMO])) break; if (sp > XB_SPIN_CAP) { atomicAdd(&bar[XB_TMO], 1u); break; } }
    }
    nloc = mine > 0u ? mine : 1u; nx = cnt > 0u ? cnt : 1u;
}

__device__ __forceinline__ void xcd_barrier(const XcdBarrier& b) {
    asm volatile("s_waitcnt vmcnt(0)" ::: "memory");
    __syncthreads();
    if (threadIdx.x == 0) {
        unsigned* bar = b.bar;
        __builtin_amdgcn_s_waitcnt(0);
        unsigned nloc = b.st[0], nx = b.st[1];
        if (nloc == 0u) { xcd_barrier_complete(bar, b.x, nloc, nx); b.st[0] = nloc; b.st[1] = nx; }
        const unsigned old = xb_add(&bar[XB_XSUB(b.x)], 1u);
        const unsigned gen = old / nloc;
        if (old + 1u == (gen + 1u) * nloc) {
            __builtin_amdgcn_fence(__ATOMIC_RELEASE, "agent");
            asm volatile("s_waitcnt vmcnt(0)" ::: "memory");
            const unsigned og = xb_add(&bar[XB_TOP], 1u);
            const unsigned tg = og / nx;
            if (og + 1u == (tg + 1u) * nx) xb_add(&bar[XB_TOPGEN], 1u);
            else XB_SPIN(xb_ld(&bar[XB_TOPGEN]) == tg, bar);
            __builtin_amdgcn_fence(__ATOMIC_ACQUIRE, "agent");
            xb_add(&bar[XB_XGEN(b.x)], 1u);
            asm volatile("s_waitcnt vmcnt(0)" ::: "memory");
        } else {
            XB_SPIN(xb_ld(&bar[XB_XGEN(b.x)]) == gen, bar);
            __builtin_amdgcn_fence(__ATOMIC_ACQUIRE, "agent");
            asm volatile("s_waitcnt vmcnt(0)" ::: "memory");
        }
    }
    __syncthreads();
}

struct Args { const GAS float* in[31]; GAS float* out; GAS unsigned char* ws; float rinv[8]; int ph_lo, ph_hi; };
#define GIN(A, i) ((const float*)((A)->in[i]))
typedef const Args __attribute__((address_space(4)))* CArgsP;
struct Frame {
    LAS unsigned char* lds;
    volatile LAS unsigned* MISC;
    gu32* ctl;
    int tid, lane, wave, vcu, G;
    float* out; unsigned char* ws;
};
__device__ __forceinline__ float wave_sum(float v) {
#pragma unroll
    for (int o = 1; o < 64; o <<= 1) v += __shfl_xor(v, o);
    return v;
}
__device__ __forceinline__ float bf2f(bf16 h) { return __uint_as_float((unsigned)h << 16); }
__device__ __forceinline__ float bflo(unsigned w) { return __uint_as_float(w << 16); }
__device__ __forceinline__ float bfhi(unsigned w) { return __uint_as_float(w & 0xffff0000u); }

__device__ __forceinline__ void p0_transpose_item(const float* W, int N, bf16* WT, int ldk, int koff, int row_off, const float* kscale, LAS float* scr, int item, int lane) {
    const int nblk = N / 32, kb = item / nblk, nb = item % nblk, k0 = 64 * kb, n0 = 32 * nb;
#pragma unroll 8
    for (int i = 0; i < 32; ++i) { const int kk = 2 * i + (lane >> 5); float w = W[(size_t)(k0 + kk) * N + n0 + (lane & 31)]; if (kscale) w *= kscale[k0 + kk]; scr[kk * 33 + (lane & 31)] = w; }
    LDS_WAIT(); asm volatile("" ::: "memory");
    const int c = lane & 7;
#pragma unroll
    for (int j = 0; j < 4; ++j) { const int n = (lane >> 3) + 8 * j; const LAS float* s = scr + (8 * c) * 33 + n;
        v4u o; o.x = pk2(s[0 * 33], s[1 * 33]); o.y = pk2(s[2 * 33], s[3 * 33]); o.z = pk2(s[4 * 33], s[5 * 33]); o.w = pk2(s[6 * 33], s[7 * 33]);
        *(GAS v4u*)(WT + (size_t)(row_off + n0 + n) * ldk + koff + k0 + 8 * c) = o; }
    LDS_WAIT(); asm volatile("" ::: "memory");
}
__device__ __forceinline__ void p0_prologue(Frame& F, CArgsP A) {
    LAS float* scr = (LAS float*)(F.lds + RING_OFF + F.wave * 16384);
    const int gw = F.vcu * NWAVES + F.wave, NGW = F.G * NWAVES;
    constexpr int I_IN = (1024 / 64) * (P_TOTAL / 32), I_SQ = (1024 / 64) * (1024 / 32), I_UP = (1024 / 64) * (UPW / 32), I_DN = (D_FF / 64) * (1024 / 32),
                  I_W2 = 1 * (1024 / 32), I_G2 = 2 * (1024 / 32);
    constexpr int I_LAYER = I_IN + 3 * I_SQ + I_UP + I_DN + 2 * I_W2 + I_G2;
    for (int it = gw; it < DEPTH * I_LAYER; it += NGW) {
        const int l = it / I_LAYER; int r = it % I_LAYER;
        unsigned char* wl = F.ws + WS_W + (size_t)l * W_LAYER;
        if (r < I_IN) { p0_transpose_item(GIN(A, 8) + (size_t)l * 1024 * P_TOTAL, P_TOTAL, (bf16*)(wl + W_IN), 1024, 0, 0, GIN(A, 7) + l * 1024, scr, r, F.lane); continue; } r -= I_IN;
        if (r < I_SQ) { p0_transpose_item(GIN(A, 11) + (size_t)l * 1024 * 1024, 1024, (bf16*)(wl + W_ODA), 1024, 0, 0, nullptr, scr, r, F.lane); continue; } r -= I_SQ;
        if (r < I_SQ) { p0_transpose_item(GIN(A, 23) + (size_t)l * 1024 * 1024, 1024, (bf16*)(wl + W_ORW), 1024, 0, 0, nullptr, scr, r, F.lane); continue; } r -= I_SQ;
        if (r < I_SQ) { p0_transpose_item(GIN(A, 24) + (size_t)l * 1024 * 1024, 1024, (bf16*)(wl + W_OUT), 1024, 0, 0, nullptr, scr, r, F.lane); continue; } r -= I_SQ;
        if (r < I_UP) { p0_transpose_item(GIN(A, 26) + (size_t)l * 1024 * UPW, UPW, (bf16*)(wl + W_UP), 1024, 0, 0, GIN(A, 25) + l * 1024, scr, r, F.lane); continue; } r -= I_UP;
        if (r < I_DN) { p0_transpose_item(GIN(A, 29) + (size_t)l * D_FF * 1024, 1024, (bf16*)(wl + W_DN), D_FF, 0, 0, nullptr, scr, r, F.lane); continue; } r -= I_DN;
        if (r < I_W2) { p0_transpose_item(GIN(A, 14) + (size_t)l * 64 * 1024, 1024, (bf16*)(wl + W_LORA), 256, 0, 0, nullptr, scr, r, F.lane); continue; } r -= I_W2;
        if (r < I_W2) { p0_transpose_item(GIN(A, 16) + (size_t)l * 64 * 1024, 1024, (bf16*)(wl + W_LORA), 256, 64, 1024, nullptr, scr, r, F.lane); continue; } r -= I_W2;
        p0_transpose_item(GIN(A, 17) + (size_t)l * 128 * 1024, 1024, (bf16*)(wl + W_LORA), 256, 128, 2048, nullptr, scr, r, F.lane);
    }
    {
        const int gt = gw * 64 + F.lane, NGT = NGW * 64;
        for (int i = gt; i < DEPTH * 3072 * 32; i += NGT) {
            const int l = i / (3072 * 32), r = i % (3072 * 32), n = r >> 5, kc = r & 31, blk = n >> 10;
            const bool nz = (blk == 0) ? (kc < 8) : (blk == 1) ? (kc >= 8 && kc < 16) : (kc >= 16);
            if (!nz) *(GAS v4u*)(F.ws + WS_W + (size_t)l * W_LAYER + W_LORA + ((size_t)n * 256 + kc * 8) * 2) = (v4u){0u, 0u, 0u, 0u};
        }
        float* rope = (float*)(F.ws + WS_ROPE);
        for (int i = gt; i < NKEYS_S * 8; i += NGT) {
            const int pos = i >> 3, k = i & 7;
            const float ang = (float)pos * A->rinv[k];
            const float kq = rintf(ang * 0.15915494309189535f);
            float r = fmaf(-kq, 6.2831854820251465f, ang); r = fmaf(-kq, -1.7484555314695172e-7f, r);
            const float rev = r * 0.15915494309189535f;
            rope[pos * 16 + k] = __builtin_amdgcn_cosf(rev); rope[pos * 16 + 8 + k] = __builtin_amdgcn_sinf(rev);
        }
    }
    {
        float* X = F.out + O_YP; bf16* XB = (bf16*)(F.ws + WS_XB); float* SS = (float*)(F.ctl + CW_SS);
        for (int m = gw; m < MT; m += NGW) {
            const float* src = (m < MP) ? GIN(A, 0) + (size_t)m * 1024 : GIN(A, 1) + (size_t)(m - MP) * 1024;
            const GAS f32x4* xr = (const GAS f32x4*)src + F.lane;
            GAS f32x4* xo = (GAS f32x4*)(X + (size_t)m * 1024) + F.lane;
            GAS unsigned long long* o8 = (GAS unsigned long long*)(XB + (size_t)m * 1024) + F.lane;
            float s = 0.f;
#pragma unroll
            for (int j = 0; j < 4; ++j) { const f32x4 v = xr[64 * j]; s += (v.x * v.x + v.y * v.y) + (v.z * v.z + v.w * v.w); xo[64 * j] = v;
                o8[64 * j] = (unsigned long long)pk2(v.x, v.y) | ((unsigned long long)pk2(v.z, v.w) << 32); }
            s = wave_sum(s);
            if (F.lane == 0) SS[m] = s;
        }
    }
    if (gw < DEPTH) {
        const int l = gw; const float* lp = GIN(A, 9) + (size_t)l * 256;
        const float s1 = wave_sum(lp[F.lane] * lp[64 + F.lane]), s2 = wave_sum(lp[128 + F.lane] * lp[192 + F.lane]);
        if (F.lane == 0) ((float*)(F.ctl + CW_LAM))[l] = expf(s1) - expf(s2) + (0.8f - 0.6f * expf(-0.3f * (float)l));
    }
}

__device__ __forceinline__ void attn_slow_prompt(Frame& F, CArgsP A, int it) {
    const int c = it & 1, h = (it >> 1) & 7, chunk = (it >> 4) & 31, b = it >> 9;
    const bf16* Q = (const bf16*)(F.ws + B_Q); const bf16* K = (const bf16*)(F.ws + B_K); const bf16* V = (const bf16*)(F.ws + B_V);
    bf16* OC = (bf16*)(F.ws + B_OC) + (size_t)c * MT * 1024;
    const int row = b * SEQ + chunk * 64 + F.lane;
    float q[64];
    { const v4u* qp = (const v4u*)(Q + (size_t)row * 1024 + h * 128 + c * 64);
#pragma unroll
      for (int i = 0; i < 8; ++i) { const v4u w = qp[i]; q[8 * i] = bflo(w.x); q[8 * i + 1] = bfhi(w.x); q[8 * i + 2] = bflo(w.y); q[8 * i + 3] = bfhi(w.y); q[8 * i + 4] = bflo(w.z); q[8 * i + 5] = bfhi(w.z); q[8 * i + 6] = bflo(w.w); q[8 * i + 7] = bfhi(w.w); } }
    float o[128];
#pragma unroll
    for (int d = 0; d < 128; ++d) o[d] = 0.f;
    float m = -1e30f, l = 0.f;
    const int nk = (chunk + 1) * 64;
    const bf16* kb = K + (size_t)(b * SEQ) * 1024 + h * 128 + c * 64;
    const bf16* vb = V + (size_t)(b * SEQ) * 1024 + h * 128;
    for (int j = 0; j < nk; ++j) {
        const v4u* kp = (const v4u*)(kb + (size_t)j * 1024);
        float s = 0.f;
#pragma unroll
        for (int i = 0; i < 8; ++i) { const v4u w = kp[i];
            s = fmaf(q[8 * i], bflo(w.x), s); s = fmaf(q[8 * i + 1], bfhi(w.x), s); s = fmaf(q[8 * i + 2], bflo(w.y), s); s = fmaf(q[8 * i + 3], bfhi(w.y), s);
            s = fmaf(q[8 * i + 4], bflo(w.z), s); s = fmaf(q[8 * i + 5], bfhi(w.z), s); s = fmaf(q[8 * i + 6], bflo(w.w), s); s = fmaf(q[8 * i + 7], bfhi(w.w), s); }
        const float mn = fmaxf(m, s), alpha = exp2f(m - mn), pj = exp2f(s - mn);
        l = l * alpha + pj; m = mn;
        const v4u* vp = (const v4u*)(vb + (size_t)j * 1024);
#pragma unroll
        for (int i = 0; i < 16; ++i) { if ((i & 3) == 0) asm volatile("" ::: "memory"); const v4u w = vp[i];
            o[8 * i] = fmaf(o[8 * i], alpha, pj * bflo(w.x)); o[8 * i + 1] = fmaf(o[8 * i + 1], alpha, pj * bfhi(w.x)); o[8 * i + 2] = fmaf(o[8 * i + 2], alpha, pj * bflo(w.y)); o[8 * i + 3] = fmaf(o[8 * i + 3], alpha, pj * bfhi(w.y));
            o[8 * i + 4] = fmaf(o[8 * i + 4], alpha, pj * bflo(w.z)); o[8 * i + 5] = fmaf(o[8 * i + 5], alpha, pj * bfhi(w.z)); o[8 * i + 6] = fmaf(o[8 * i + 6], alpha, pj * bflo(w.w)); o[8 * i + 7] = fmaf(o[8 * i + 7], alpha, pj * bfhi(w.w)); }
    }
    const float il = 1.0f / l;
    v4u* op = (v4u*)(OC + (size_t)row * 1024 + h * 128);
#pragma unroll
    for (int i = 0; i < 16; ++i) { v4u w; w.x = pk2(o[8 * i] * il, o[8 * i + 1] * il); w.y = pk2(o[8 * i + 2] * il, o[8 * i + 3] * il); w.z = pk2(o[8 * i + 4] * il, o[8 * i + 5] * il); w.w = pk2(o[8 * i + 6] * il, o[8 * i + 7] * il); op[i] = w; }
}
__device__ __forceinline__ void attn_slow_sample(Frame& F, CArgsP A, int it, int l) {
    const int s = it & 7, c = (it >> 3) & 1, h = (it >> 4) & 7, b = it >> 7;
    const bf16* Q = (const bf16*)(F.ws + B_Q); const bf16* K = (const bf16*)(F.ws + B_K); const bf16* V = (const bf16*)(F.ws + B_V);
    const int qi = F.lane & 31, row = MP + b * DEC_SEQ + qi;
    float q[64];
    { const v4u* qp = (const v4u*)(Q + (size_t)row * 1024 + h * 128 + c * 64);
#pragma unroll
      for (int i = 0; i < 8; ++i) { const v4u w = qp[i]; q[8 * i] = bflo(w.x); q[8 * i + 1] = bfhi(w.x); q[8 * i + 2] = bflo(w.y); q[8 * i + 3] = bfhi(w.y); q[8 * i + 4] = bflo(w.z); q[8 * i + 5] = bfhi(w.z); q[8 * i + 6] = bflo(w.w); q[8 * i + 7] = bfhi(w.w); } }
    float o[128];
#pragma unroll
    for (int d = 0; d < 128; ++d) o[d] = 0.f;
    float m = -1e30f, lsum = 0.f;
    const float* ck = GIN(A, 2) + ((size_t)(l * DEC_BATCH + b) * PAST_LEN) * 1024 + h * 128 + c * 64;
    const float* cv = GIN(A, 3) + ((size_t)(l * DEC_BATCH + b) * PAST_LEN) * 1024 + h * 128;
    const int j0 = s * 260, j1 = j0 + 260, jp1 = j1 < PAST_LEN ? j1 : PAST_LEN;
    for (int j = j0; j < jp1; ++j) {
        float sc = 0.f;
        const f32x4* kp = (const f32x4*)(ck + (size_t)j * 1024);
#pragma unroll
        for (int i = 0; i < 16; ++i) { if ((i & 3) == 0) asm volatile("" ::: "memory"); const f32x4 w = kp[i]; sc = fmaf(q[4 * i], w.x, sc); sc = fmaf(q[4 * i + 1], w.y, sc); sc = fmaf(q[4 * i + 2], w.z, sc); sc = fmaf(q[4 * i + 3], w.w, sc); }
        const float mn = fmaxf(m, sc), alpha = exp2f(m - mn), pj = exp2f(sc - mn); lsum = lsum * alpha + pj; m = mn;
        const f32x4* vp = (const f32x4*)(cv + (size_t)j * 1024);
#pragma unroll
        for (int i = 0; i < 32; ++i) { if ((i & 3) == 0) asm volatile("" ::: "memory"); const f32x4 w = vp[i]; o[4 * i] = fmaf(o[4 * i], alpha, pj * w.x); o[4 * i + 1] = fmaf(o[4 * i + 1], alpha, pj * w.y); o[4 * i + 2] = fmaf(o[4 * i + 2], alpha, pj * w.z); o[4 * i + 3] = fmaf(o[4 * i + 3], alpha, pj * w.w); }
    }
    for (int j = (j0 > PAST_LEN ? j0 : PAST_LEN); j < j1; ++j) {
        float sc = 0.f;
        const size_t kr = (size_t)(MP + b * DEC_SEQ + (j - PAST_LEN)) * 1024;
        const v4u* kp = (const v4u*)(K + kr + h * 128 + c * 64);
#pragma unroll
        for (int i = 0; i < 8; ++i) { const v4u w = kp[i];
            sc = fmaf(q[8 * i], bflo(w.x), sc); sc = fmaf(q[8 * i + 1], bfhi(w.x), sc); sc = fmaf(q[8 * i + 2], bflo(w.y), sc); sc = fmaf(q[8 * i + 3], bfhi(w.y), sc);
            sc = fmaf(q[8 * i + 4], bflo(w.z), sc); sc = fmaf(q[8 * i + 5], bfhi(w.z), sc); sc = fmaf(q[8 * i + 6], bflo(w.w), sc); sc = fmaf(q[8 * i + 7], bfhi(w.w), sc); }
        const float mn = fmaxf(m, sc), alpha = exp2f(m - mn), pj = exp2f(sc - mn); lsum = lsum * alpha + pj; m = mn;
        const v4u* vp = (const v4u*)(V + kr + h * 128);
#pragma unroll
        for (int i = 0; i < 16; ++i) { if ((i & 3) == 0) asm volatile("" ::: "memory"); const v4u w = vp[i];
            o[8 * i] = fmaf(o[8 * i], alpha, pj * bflo(w.x)); o[8 * i + 1] = fmaf(o[8 * i + 1], alpha, pj * bfhi(w.x)); o[8 * i + 2] = fmaf(o[8 * i + 2], alpha, pj * bflo(w.y)); o[8 * i + 3] = fmaf(o[8 * i + 3], alpha, pj * bfhi(w.y));
            o[8 * i + 4] = fmaf(o[8 * i + 4], alpha, pj * bflo(w.z)); o[8 * i + 5] = fmaf(o[8 * i + 5], alpha, pj * bfhi(w.z)); o[8 * i + 6] = fmaf(o[8 * i + 6], alpha, pj * bflo(w.w)); o[8 * i + 7] = fmaf(o[8 * i + 7], alpha, pj * bfhi(w.w)); }
    }
    if (F.lane < 32) {
        float* sp = (float*)(F.ws + WS_SP) + ((size_t)(((b * 8 + h) * 2 + c) * 8 + s) * 32 + qi) * 132;
        sp[0] = m; sp[1] = lsum;
#pragma unroll
        for (int i = 0; i < 32; ++i) *(f32x4*)(sp + 4 + 4 * i) = (f32x4){o[4 * i], o[4 * i + 1], o[4 * i + 2], o[4 * i + 3]};
    }
}
__device__ __forceinline__ void ph_attn_slow(Frame& F, CArgsP A, int l) {
    const int gw = F.vcu * NWAVES + F.wave, NGW = F.G * NWAVES;
    for (int it = gw; it < 2048; it += NGW) { attn_slow_prompt(F, A, it); attn_slow_prompt(F, A, 4095 - it); }
    for (int it = gw; it < 1024; it += NGW) attn_slow_sample(F, A, it, l);
}

__device__ __forceinline__ void ph_attn(Frame& F, CArgsP A, int l) {
    const attn_body::bf16* Q = (const attn_body::bf16*)(F.ws + B_Q); const attn_body::bf16* K = (const attn_body::bf16*)(F.ws + B_K); const attn_body::bf16* V = (const attn_body::bf16*)(F.ws + B_V);
    for (int u = F.vcu; u < 256; u += F.G) {
        const int b = u >> 5, hv = u & 31, h = hv >> 2, c = (hv >> 1) & 1, vh = hv & 1;
        attn_body::bf16* O = (attn_body::bf16*)(F.ws + B_OC) + (size_t)c * MT * 1024;
        for (int qb = 7; qb >= 0; --qb) attn_body::attn_unit<8>(b, h * 128 + c * 64, h * 128 + vh * 64, qb, Q, K, V, O, (char*)F.lds + RING_OFF);
    }
    { int tv = threadIdx.x; asm volatile("" : "+v"(tv)); F.tid = tv; F.lane = tv & 63; F.wave = __builtin_amdgcn_readfirstlane(tv >> 6); }
    const int gw = F.vcu * NWAVES + F.wave, NGW = F.G * NWAVES;
    for (int it = gw; it < 1024; it += NGW) attn_slow_sample(F, A, it, l);
}

__device__ __forceinline__ void ph_combine(Frame& F, CArgsP A, int l) {
    const int gw = F.vcu * NWAVES + F.wave, NGW = F.G * NWAVES;
    const float lam = ((const float*)(F.ctl + CW_LAM))[l], lam_init = 0.8f - 0.6f * expf(-0.3f * (float)l);
    const bf16* OC0 = (const bf16*)(F.ws + B_OC); const bf16* OC1 = OC0 + (size_t)MT * 1024;
    bf16* OA = (bf16*)(F.ws + B_OA);
    const float* subln = GIN(A, 10) + l * 128;
    const float g0 = subln[2 * F.lane], g1 = subln[2 * F.lane + 1];
    for (int it = gw; it < MT * 8; it += NGW) {
        const int row = it >> 3, h = it & 7;
        float a0, a1;
        if (row < MP) {
            const size_t off = (size_t)row * 1024 + h * 128 + 2 * F.lane;
            const unsigned w0 = *(const unsigned*)(OC0 + off), w1 = *(const unsigned*)(OC1 + off);
            a0 = bflo(w0) - lam * bflo(w1); a1 = bfhi(w0) - lam * bfhi(w1);
        } else {
            const int b = (row - MP) >> 5, qi = (row - MP) & 31;
            float oc[2][2];
#pragma unroll
            for (int c = 0; c < 2; ++c) {
                const float* sp = (const float*)(F.ws + WS_SP) + ((size_t)(((b * 8 + h) * 2 + c) * 8) * 32 + qi) * 132;
                float mx = -1e30f;
#pragma unroll
                for (int s = 0; s < 8; ++s) mx = fmaxf(mx, sp[(size_t)s * 32 * 132]);
                float L = 0.f, x0 = 0.f, x1 = 0.f;
#pragma unroll
                for (int s = 0; s < 8; ++s) { const float* p = sp + (size_t)s * 32 * 132; const float w = exp2f(p[0] - mx); L += w * p[1]; x0 += w * p[4 + 2 * F.lane]; x1 += w * p[4 + 2 * F.lane + 1]; }
                oc[c][0] = x0 / L; oc[c][1] = x1 / L;
            }
            a0 = oc[0][0] - lam * oc[1][0]; a1 = oc[0][1] - lam * oc[1][1];
        }
        const float ss = wave_sum(a0 * a0 + a1 * a1);
        const float r = (1.0f / sqrtf(ss * (1.0f / 128.f) + EPS)) * (1.f - lam_init);
        *(unsigned*)(OA + (size_t)row * 1024 + h * 128 + 2 * F.lane) = pk2(a0 * r * g0, a1 * r * g1);
    }
    const bf16* URW = (const bf16*)(F.ws + B_URW); bf16* LIN = (bf16*)(F.ws + B_LIN);
    const float* mu = GIN(A, 12) + (size_t)l * P_RW + 3072 + 4 * F.lane;
    const float mu0 = mu[0], mu1 = mu[1], mu2 = mu[2], mu3 = mu[3];
    for (int row = gw; row < MT; row += NGW) {
        const bool smp = row >= MP; const int t = smp ? ((row - MP) & 31) : (row & 2047);
        const unsigned long long cw = *(const unsigned long long*)(URW + (size_t)row * P_RW + 3072 + 4 * F.lane);
        float u[4] = {bflo((unsigned)cw), bfhi((unsigned)cw), bflo((unsigned)(cw >> 32)), bfhi((unsigned)(cw >> 32))};
        float p[4];
        if (t > 0) { const unsigned long long pw = *(const unsigned long long*)(URW + (size_t)(row - 1) * P_RW + 3072 + 4 * F.lane);
            p[0] = bflo((unsigned)pw); p[1] = bfhi((unsigned)pw); p[2] = bflo((unsigned)(pw >> 32)); p[3] = bfhi((unsigned)(pw >> 32)); }
        else if (smp) { const float* s0 = GIN(A, 5) + ((size_t)(l * DEC_BATCH) + ((row - MP) >> 5)) * P_RW + 3072 + 4 * F.lane; p[0] = s0[0]; p[1] = s0[1]; p[2] = s0[2]; p[3] = s0[3]; }
        else { p[0] = p[1] = p[2] = p[3] = 0.f; }
        u[0] += (p[0] - u[0]) * mu0; u[1] += (p[1] - u[1]) * mu1; u[2] += (p[2] - u[2]) * mu2; u[3] += (p[3] - u[3]) * mu3;
        if (F.lane < 16) { u[0] = tanhf(u[0]); u[1] = tanhf(u[1]); u[2] = tanhf(u[2]); u[3] = tanhf(u[3]); }
        else if (F.lane >= 32) { u[0] = 1.f / (1.f + expf(-u[0])); u[1] = 1.f / (1.f + expf(-u[1])); u[2] = 1.f / (1.f + expf(-u[2])); u[3] = 1.f / (1.f + expf(-u[3])); }
        *(unsigned long long*)(LIN + (size_t)row * 256 + 4 * F.lane) = (unsigned long long)pk2(u[0], u[1]) | ((unsigned long long)pk2(u[2], u[3]) << 32);
    }
}

__device__ __forceinline__ void scan_item(Frame& F, CArgsP A, int l, int it) {
    const bool smp = it >= 128; const int bh = it & 127, b = bh >> 4, h = bh & 15, lane = F.lane;
    const int T = smp ? DEC_SEQ : SEQ; const int row0 = smp ? MP + b * DEC_SEQ : b * SEQ;
    const int c = h * 64 + lane;
    const bf16* URW = (const bf16*)(F.ws + B_URW); const bf16* LD = (const bf16*)(F.ws + B_LD); const bf16* LA = (const bf16*)(F.ws + B_LA); const bf16* LG = (const bf16*)(F.ws + B_LG);
    bf16* ORW = (bf16*)(F.ws + B_ORW);
    const float* mu = GIN(A, 12) + (size_t)l * P_RW;
    const float mu_r = mu[c], mu_k = mu[1024 + c], mu_v = mu[2048 + c];
    const float k_k = GIN(A, 18)[l * 1024 + c], k_a = GIN(A, 19)[l * 1024 + c], r_k = GIN(A, 20)[l * 1024 + c], ln_w = GIN(A, 21)[l * 1024 + c], ln_b = GIN(A, 22)[l * 1024 + c];
    float S[64];
    if (smp) { const float* s0 = GIN(A, 4) + (((size_t)(l * 8 + b) * 16 + h) * 64 + lane) * 64;
#pragma unroll
        for (int k = 0; k < 64; k += 4) { const f32x4 v = *(const f32x4*)(s0 + k); S[k] = v.x; S[k + 1] = v.y; S[k + 2] = v.z; S[k + 3] = v.w; } }
    else {
#pragma unroll
        for (int k = 0; k < 64; ++k) S[k] = 0.f; }
    float pr = 0.f, pk = 0.f, pv = 0.f;
    if (smp) { const float* s0 = GIN(A, 5) + (size_t)(l * 8 + b) * P_RW; pr = s0[c]; pk = s0[1024 + c]; pv = s0[2048 + c]; }
    LAS float* sh = (LAS float*)(F.lds + RING_OFF + F.wave * 2048);
    size_t ro = (size_t)row0;
    float nur = bf2f(URW[ro * P_RW + c]), nuk = bf2f(URW[ro * P_RW + 1024 + c]), nuv = bf2f(URW[ro * P_RW + 2048 + c]);
    float nld = bf2f(LD[ro * 1024 + c]), nla = bf2f(LA[ro * 1024 + c]), nlg = bf2f(LG[ro * 1024 + c]);
    for (int t = 0; t < T; ++t) {
        const float ur = nur, uk = nuk, uv = nuv, ld = nld, a = nla, g = nlg;
        const size_t rcur = ro;
        if (t + 1 < T) { ro += 1; nur = bf2f(URW[ro * P_RW + c]); nuk = bf2f(URW[ro * P_RW + 1024 + c]); nuv = bf2f(URW[ro * P_RW + 2048 + c]);
            nld = bf2f(LD[ro * 1024 + c]); nla = bf2f(LA[ro * 1024 + c]); nlg = bf2f(LG[ro * 1024 + c]); }
        const float r = ur + (pr - ur) * mu_r, kr = uk + (pk - uk) * mu_k, vr = uv + (pv - uv) * mu_v;
        pr = ur; pk = uk; pv = uv;
        const float decay = expf(ld);
        float kk = kr * k_k;
        const float ssq = wave_sum(kk * kk);
        kk *= 1.0f / sqrtf(fmaxf(ssq, 1e-24f));
        const float km = kr * (1.f + (a - 1.f) * k_a);
        const float bbv = kk * a;
        const float bon = wave_sum(r * km * r_k);
        asm volatile("s_waitcnt lgkmcnt(0)" ::: "memory");
        sh[lane] = r; sh[64 + lane] = decay; sh[128 + lane] = km; sh[192 + lane] = kk; sh[256 + lane] = bbv;
        asm volatile("s_waitcnt lgkmcnt(0)" ::: "memory");
        float sa = 0.f;
#pragma unroll
        for (int k = 0; k < 64; k += 4) { const f32x4 q = *(const LAS f32x4*)(sh + 192 + k); sa = fmaf(S[k], -q.x, sa); sa = fmaf(S[k + 1], -q.y, sa); sa = fmaf(S[k + 2], -q.z, sa); sa = fmaf(S[k + 3], -q.w, sa); }
        float y = 0.f;
#pragma unroll
        for (int k = 0; k < 64; k += 4) {
            const f32x4 w4 = *(const LAS f32x4*)(sh + 64 + k), b4 = *(const LAS f32x4*)(sh + 256 + k), m4 = *(const LAS f32x4*)(sh + 128 + k), r4 = *(const LAS f32x4*)(sh + k);
            S[k] = S[k] * w4.x + sa * b4.x + vr * m4.x; y = fmaf(S[k], r4.x, y);
            S[k + 1] = S[k + 1] * w4.y + sa * b4.y + vr * m4.y; y = fmaf(S[k + 1], r4.y, y);
            S[k + 2] = S[k + 2] * w4.z + sa * b4.z + vr * m4.z; y = fmaf(S[k + 2], r4.z, y);
            S[k + 3] = S[k + 3] * w4.w + sa * b4.w + vr * m4.w; y = fmaf(S[k + 3], r4.w, y);
        }
        const float mean = wave_sum(y) * (1.f / 64.f), d = y - mean;
        const float var = wave_sum(d * d) * (1.f / 64.f);
        const float yn = d * (1.0f / sqrtf(var + GN_EPS)) * ln_w + ln_b;
        ORW[rcur * 1024 + c] = (bf16)f2bf((yn + bon * vr) * g);
    }
    int ln2 = lane; asm volatile("" : "+v"(ln2));
    float* Sout = F.out + (smp ? O_WKVS : O_WKVP) + (((size_t)(l * 8 + b) * 16 + h) * 64 + ln2) * 64;
#pragma unroll
    for (int k = 0; k < 64; k += 4) *(f32x4*)(Sout + k) = (f32x4){S[k], S[k + 1], S[k + 2], S[k + 3]};
}
__device__ __forceinline__ void ph_scan_slow(Frame& F, CArgsP A, int l) {
    if (F.wave == 0 && F.vcu < 256) scan_item(F, A, l, F.vcu);
    if (F.G < 256 && F.wave == 1) for (int it = F.G + F.vcu; it < 256; it += F.G) scan_item(F, A, l, it);
}

__device__ __forceinline__ void ph_conv(Frame& F, CArgsP A, int l) {
    const int gt = (F.vcu * NWAVES + F.wave) * 64 + F.lane, NGT = F.G * NWAVES * 64;
    const bf16* UP = (const bf16*)(F.ws + B_UP); bf16* GT = (bf16*)(F.ws + B_GT);
    const float* cw = GIN(A, 27) + (size_t)l * 3 * UPW; const float* cb = GIN(A, 28) + (size_t)l * UPW;
    for (int i = gt; i < MT * (D_FF / 8); i += NGT) {
        const int row = i / (D_FF / 8), j = (i % (D_FF / 8)) * 8;
        const bool smp = row >= MP; const int t = smp ? ((row - MP) & 31) : (row & 2047); const int b = smp ? ((row - MP) >> 5) : (row >> 11);
        float cc[2][8];
#pragma unroll
        for (int hf = 0; hf < 2; ++hf) {
            const int col = j + hf * D_FF;
            float u0[8], u1[8], u2[8];
            { const v4u w = *(const v4u*)(UP + (size_t)row * UPW + col); u0[0] = bflo(w.x); u0[1] = bfhi(w.x); u0[2] = bflo(w.y); u0[3] = bfhi(w.y); u0[4] = bflo(w.z); u0[5] = bfhi(w.z); u0[6] = bflo(w.w); u0[7] = bfhi(w.w); }
            if (t >= 1) { const v4u w = *(const v4u*)(UP + (size_t)(row - 1) * UPW + col); u1[0] = bflo(w.x); u1[1] = bfhi(w.x); u1[2] = bflo(w.y); u1[3] = bfhi(w.y); u1[4] = bflo(w.z); u1[5] = bfhi(w.z); u1[6] = bflo(w.w); u1[7] = bfhi(w.w); }
            else if (smp) { const float* s0 = GIN(A, 6) + ((size_t)(l * 8 + b) * 2 + 1) * UPW + col;
#pragma unroll
                for (int e = 0; e < 8; ++e) u1[e] = s0[e]; }
            else {
#pragma unroll
                for (int e = 0; e < 8; ++e) u1[e] = 0.f; }
            if (t >= 2) { const v4u w = *(const v4u*)(UP + (size_t)(row - 2) * UPW + col); u2[0] = bflo(w.x); u2[1] = bfhi(w.x); u2[2] = bflo(w.y); u2[3] = bfhi(w.y); u2[4] = bflo(w.z); u2[5] = bfhi(w.z); u2[6] = bflo(w.w); u2[7] = bfhi(w.w); }
            else if (smp) { const float* s0 = GIN(A, 6) + ((size_t)(l * 8 + b) * 2 + t) * UPW + col;
#pragma unroll
                for (int e = 0; e < 8; ++e) u2[e] = s0[e]; }
            else {
#pragma unroll
                for (int e = 0; e < 8; ++e) u2[e] = 0.f; }
#pragma unroll
            for (int e = 0; e < 8; ++e) cc[hf][e] = cb[col + e] + u2[e] * cw[col + e] + u1[e] * cw[UPW + col + e] + u0[e] * cw[2 * UPW + col + e];
        }
        float gv[8];
#pragma unroll
        for (int e = 0; e < 8; ++e) gv[e] = cc[0][e] / (1.f + expf(-cc[0][e])) * cc[1][e];
        v4u o; o.x = pk2(gv[0], gv[1]); o.y = pk2(gv[2], gv[3]); o.z = pk2(gv[4], gv[5]); o.w = pk2(gv[6], gv[7]);
        *(v4u*)(GT + (size_t)row * D_FF + j) = o;
    }
}

__device__ __forceinline__ void ph_final(Frame& F, CArgsP A) {
    const int gw = F.vcu * NWAVES + F.wave, NGW = F.G * NWAVES;
    float* X = F.out + O_YP; const float* SS = (const float*)(F.ctl + CW_SS) + 4 * MT; const float* g = GIN(A, 30);
    for (int m = gw; m < MT; m += NGW) {
        const float r = 1.0f / sqrtf(SS[m] * (1.0f / 1024.f) + EPS);
        GAS f32x4* xr = (GAS f32x4*)(X + (size_t)m * 1024) + F.lane; const GAS f32x4* gr = (const GAS f32x4*)g + F.lane;
#pragma unroll
        for (int j = 0; j < 4; ++j) { f32x4 v = xr[64 * j]; const f32x4 gg = gr[64 * j]; v = v * r * gg; xr[64 * j] = v; }
    }
}

#define REOPAQUE() do { int tv = threadIdx.x; asm volatile("" : "+v"(tv)); F.tid = tv; F.lane = tv & 63; F.wave = __builtin_amdgcn_readfirstlane(tv >> 6); \
    ap = (CArgsP)__builtin_amdgcn_kernarg_segment_ptr(); asm volatile("" : "+s"(ap)); \
    { GAS unsigned char* w_ = ap->ws; GAS float* o_ = ap->out; asm volatile("" : "+s"(w_), "+s"(o_)); F.ws = (unsigned char*)w_; F.out = (float*)o_; F.ctl = (gu32*)(w_ + WS_CTL); } } while (0)
#define PH_BEGIN(idx) if (lo <= (idx) && (idx) < hi) { REOPAQUE();
#define PH_END(idx) if ((idx) + 1 < hi) xcd_barrier(bar); }

template <int l> __device__ __forceinline__ void layer_phases(Frame& F, CArgsP& ap, const XcdBarrier& bar, const int lo, const int hi) {
    constexpr int P0 = 1 + l * PH_PER_LAYER;
#define WL (F.ws + WS_W + (size_t)l * W_LAYER)
#define SSP ((float*)(F.ctl + CW_SS))
    PH_BEGIN(P0 + K_G1) {
        int kk_ = 1024; asm volatile("" : "+s"(kk_)); pg8::Gemm g{(const bf16*)(F.ws + WS_XB), (const bf16*)(WL + W_IN), MT, P_TOTAL, kk_}; pg8::StaticOrder S; S.init(MT, P_TOTAL, F.G, (int)blockIdx.x);
        pg8::EpiIn E{SSP + (size_t)(2 * l) * MT, (const float*)(F.ws + WS_ROPE), (bf16*)(F.ws + B_Q), (bf16*)(F.ws + B_K), (bf16*)(F.ws + B_V), (bf16*)(F.ws + B_URW), (bf16*)(F.ws + B_GATE),
                     F.out + O_KP + (size_t)l * MP * 1024, F.out + O_VP + (size_t)l * MP * 1024, F.out + O_KS + (size_t)l * MS * 1024, F.out + O_VS + (size_t)l * MS * 1024,
                     F.out + O_SHP + (size_t)l * BATCH * P_RW, F.out + O_SHS + (size_t)l * DEC_BATCH * P_RW};
        pg8::gemm_phase<pg8::EpiIn, pg8::StaticOrder, true, true>(F.lds + RING_OFF, g, S, E);
    } PH_END(P0 + K_G1)
    PH_BEGIN(P0 + K_AT) { ph_attn(F, ap, l); } PH_END(P0 + K_AT)
    PH_BEGIN(P0 + K_CB) { ph_combine(F, ap, l); } PH_END(P0 + K_CB)
    PH_BEGIN(P0 + K_LR) {
        int kk_ = 256; asm volatile("" : "+s"(kk_)); pg8::Gemm g{(const bf16*)(F.ws + B_LIN), (const bf16*)(WL + W_LORA), MT, 3072, kk_}; pg8::StaticOrder S; S.init(MT, 3072, F.G, (int)blockIdx.x);
        pg8::EpiLora E{GIN(ap, 13) + l * 1024, GIN(ap, 15) + l * 1024, (bf16*)(F.ws + B_LD), (bf16*)(F.ws + B_LA), (bf16*)(F.ws + B_LG)};
        pg8::gemm_phase<pg8::EpiLora, pg8::StaticOrder, true, true>(F.lds + RING_OFF, g, S, E);
    } PH_END(P0 + K_LR)
    PH_BEGIN(P0 + K_SC) { ph_scan_slow(F, ap, l); } PH_END(P0 + K_SC)
    PH_BEGIN(P0 + K_M1) {
        int kk_ = 1024; asm volatile("" : "+s"(kk_)); pg8::Gemm g{(const bf16*)(F.ws + B_OA), (const bf16*)(WL + W_ODA), MT, 1024, kk_}; pg8::StaticOrder S; S.init(MT, 1024, F.G, (int)blockIdx.x);
        pg8::EpiGated E{(const bf16*)(F.ws + B_GATE), 0, nullptr, (bf16*)(F.ws + B_MRG)};
        pg8::gemm_phase<pg8::EpiGated, pg8::StaticOrder, true, true>(F.lds + RING_OFF, g, S, E);
    } PH_END(P0 + K_M1)
    PH_BEGIN(P0 + K_M2) {
        int kk_ = 1024; asm volatile("" : "+s"(kk_)); pg8::Gemm g{(const bf16*)(F.ws + B_ORW), (const bf16*)(WL + W_ORW), MT, 1024, kk_}; pg8::StaticOrder S; S.init(MT, 1024, F.G, (int)blockIdx.x);
        pg8::EpiGated E{(const bf16*)(F.ws + B_GATE), 1024, (const bf16*)(F.ws + B_MRG), (bf16*)(F.ws + B_MRG)};
        pg8::gemm_phase<pg8::EpiGated, pg8::StaticOrder, true, true>(F.lds + RING_OFF, g, S, E);
    } PH_END(P0 + K_M2)
    PH_BEGIN(P0 + K_WO) {
        int kk_ = 1024; asm volatile("" : "+s"(kk_)); pg8::Gemm g{(const bf16*)(F.ws + B_MRG), (const bf16*)(WL + W_OUT), MT, 1024, kk_}; pg8::StaticOrder S; S.init(MT, 1024, F.G, (int)blockIdx.x);
        pg8::EpiRes E{F.out + O_YP, (bf16*)(F.ws + WS_XB), SSP + (size_t)(2 * l + 1) * MT};
        pg8::gemm_phase<pg8::EpiRes, pg8::StaticOrder, true, true>(F.lds + RING_OFF, g, S, E);
    } PH_END(P0 + K_WO)
    PH_BEGIN(P0 + K_UP) {
        int kk_ = 1024; asm volatile("" : "+s"(kk_)); pg8::Gemm g{(const bf16*)(F.ws + WS_XB), (const bf16*)(WL + W_UP), MT, UPW, kk_}; pg8::StaticOrder S; S.init(MT, UPW, F.G, (int)blockIdx.x);
        pg8::EpiUp E{SSP + (size_t)(2 * l + 1) * MT, (bf16*)(F.ws + B_UP), F.out + O_CVP + (size_t)l * BATCH * 2 * UPW, F.out + O_CVS + (size_t)l * DEC_BATCH * 2 * UPW};
        pg8::gemm_phase<pg8::EpiUp, pg8::StaticOrder, true, true>(F.lds + RING_OFF, g, S, E);
    } PH_END(P0 + K_UP)
    PH_BEGIN(P0 + K_CV) { ph_conv(F, ap, l); } PH_END(P0 + K_CV)
    PH_BEGIN(P0 + K_DN) {
        int kk_ = D_FF; asm volatile("" : "+s"(kk_)); pg8::Gemm g{(const bf16*)(F.ws + B_GT), (const bf16*)(WL + W_DN), MT, 1024, kk_}; pg8::StaticOrder S; S.init(MT, 1024, F.G, (int)blockIdx.x);
        pg8::EpiRes E{F.out + O_YP, (bf16*)(F.ws + WS_XB), SSP + (size_t)(2 * l + 2) * MT};
        pg8::gemm_phase<pg8::EpiRes, pg8::StaticOrder, true, true>(F.lds + RING_OFF, g, S, E);
    } PH_END(P0 + K_DN)
#undef WL
#undef SSP
}

__global__ void __launch_bounds__(NWAVES * 64, 2) mk_fwd(Args args) {
    extern __shared__ __attribute__((aligned(16))) unsigned char lds[];
    Frame F;
    F.lds = (LAS unsigned char*)lds;
    F.MISC = (volatile LAS unsigned*)(F.lds + MISC_OFF);
    F.tid = threadIdx.x; F.lane = F.tid & 63; F.wave = __builtin_amdgcn_readfirstlane(F.tid >> 6);
    F.G = gridDim.x; { const int bx = blockIdx.x; F.vcu = (F.G % 8 == 0) ? (bx % 8) * (F.G / 8) + bx / 8 : bx; }
    F.out = (float*)args.out; F.ws = (unsigned char*)args.ws;
    F.ctl = (gu32*)(args.ws + WS_CTL);
    for (int u = F.tid; u < (LDS_BYTES - LDSCTL_OFF) / 4; u += NWAVES * 64) ((LAS unsigned*)(F.lds + LDSCTL_OFF))[u] = 0u;
    __syncthreads();
    XcdBarrier bar; bar.bar = (unsigned*)(F.ctl + CW_BAR); bar.x = 0; bar.st = nullptr;
    if (!MK_PER_PHASE) bar = xcd_barrier_post((unsigned*)(F.ctl + CW_BAR), F.MISC + 8);
    const int lo = args.ph_lo, hi = args.ph_hi;
    CArgsP ap;
    PH_BEGIN(0) { p0_prologue(F, ap); } PH_END(0)
    layer_phases<0>(F, ap, bar, lo, hi);
    layer_phases<1>(F, ap, bar, lo, hi);
    PH_BEGIN(NPHASE - 1) { ph_final(F, ap); } PH_END(NPHASE - 1)
}

extern "C" void kernel_launch(void* const* d_in, const int* in_sizes, int n_in, void* d_out, int out_size, void* d_ws, size_t ws_size, hipStream_t stream) {
    (void)in_sizes;
    static int grid = 0;
    if (grid == 0) {
        if (n_in != 31 || out_size != (int)O_END || ws_size < B_END2) { fprintf(stderr, "kernel_launch: unexpected shapes (n_in %d out %d ws %zu)\n", n_in, out_size, ws_size); grid = -1; return; }
        int dev = 0, cus = 0;
        if (hipGetDevice(&dev) != hipSuccess || hipDeviceGetAttribute(&cus, hipDeviceAttributeMultiprocessorCount, dev) != hipSuccess) { grid = -1; return; }
        if (hipFuncSetAttribute((const void*)mk_fwd, hipFuncAttributeMaxDynamicSharedMemorySize, LDS_BYTES) != hipSuccess) { fprintf(stderr, "kernel_launch: hipFuncSetAttribute failed\n"); grid = -1; return; }
        (void)hipGetLastError();
        grid = cus;
    }
    if (grid < 0) return;
    if (hipMemsetAsync((char*)d_ws + WS_CTL, 0, CTL_ZERO_BYTES, stream) != hipSuccess) { fprintf(stderr, "kernel_launch: memset failed\n"); return; }
    Args a{};
    for (int i = 0; i < 31; ++i) a.in[i] = (const GAS float*)d_in[i];
    a.out = (GAS float*)d_out; a.ws = (GAS unsigned char*)d_ws;
    for (int i = 0; i < 8; ++i) a.rinv[i] = (float)pow(500000.0, -(double)i / 8.0);
#if MK_PER_PHASE
    for (int p = 0; p < NPHASE; ++p) { a.ph_lo = p; a.ph_hi = p + 1; hipLaunchKernelGGL(mk_fwd, dim3(grid), dim3(NWAVES * 64), LDS_BYTES, stream, a); }
#else
    a.ph_lo = 0; a.ph_hi = NPHASE;
    hipLaunchKernelGGL(mk_fwd, dim3(grid), dim3(NWAVES * 64), LDS_BYTES, stream, a);
#endif
    const hipError_t le = hipPeekAtLastError();
    if (le != hipSuccess) fprintf(stderr, "kernel_launch: launch failed: %s\n", hipGetErrorName(le));
}
```

```cpp
#include <hip/hip_runtime.h>
#include <cstdio>
#include <cstdint>
#include <cmath>

#ifndef MK_PER_PHASE
#define MK_PER_PHASE 0
#endif

constexpr int D_MODEL = 1024, BATCH = 8, SEQ = 2048, DEPTH = 2, DEC_BATCH = 8, DEC_SEQ = 32, PAST_LEN = 2048;
constexpr float EPS = 1e-6f, GN_EPS = 64e-5f;
constexpr int DA_HEADS = 8, RW_HEADS = 16;
constexpr int D_FF = 2816, UPW = 2 * D_FF;
constexpr int P_DA = 3072, P_RW = 3328, P_GATE = 2048, P_TOTAL = 8448;
constexpr int MP = BATCH * SEQ, MS = DEC_BATCH * DEC_SEQ, MT = MP + MS;
constexpr int NKEYS_S = PAST_LEN + DEC_SEQ;
constexpr float C2 = 0.125f * 1.4426950408889634f;

constexpr size_t O_YP = 0;
constexpr size_t O_YS = O_YP + (size_t)MP * D_MODEL;
constexpr size_t O_KP = O_YS + (size_t)MS * D_MODEL;
constexpr size_t O_VP = O_KP + (size_t)DEPTH * MP * 1024;
constexpr size_t O_WKVP = O_VP + (size_t)DEPTH * MP * 1024;
constexpr size_t O_SHP = O_WKVP + (size_t)DEPTH * BATCH * RW_HEADS * 64 * 64;
constexpr size_t O_CVP = O_SHP + (size_t)DEPTH * BATCH * P_RW;
constexpr size_t O_KS = O_CVP + (size_t)DEPTH * BATCH * 2 * UPW;
constexpr size_t O_VS = O_KS + (size_t)DEPTH * MS * 1024;
constexpr size_t O_WKVS = O_VS + (size_t)DEPTH * MS * 1024;
constexpr size_t O_SHS = O_WKVS + (size_t)DEPTH * DEC_BATCH * RW_HEADS * 64 * 64;
constexpr size_t O_CVS = O_SHS + (size_t)DEPTH * DEC_BATCH * P_RW;
constexpr size_t O_END = O_CVS + (size_t)DEPTH * DEC_BATCH * 2 * UPW;
static_assert(O_END == 87760896, "output size");

namespace pg8 {
#define PG8_LAS __attribute__((address_space(3)))
typedef unsigned short bf16_t;
typedef short bf16x8 __attribute__((ext_vector_type(8)));
typedef float f32x4 __attribute__((ext_vector_type(4)));
typedef unsigned u32x4 __attribute__((ext_vector_type(4)));
constexpr int BM = 256, BK = 64, HALF = 128, HTB = HALF * BK * 2  , STAGE_BYTES = 8 * HTB, NXCD = 8, WGM = 8;

__host__ __device__ __forceinline__ int lds_byte(int r, int c) { const int st = (r >> 4) * 2 + (c >> 5), rr = r & 15, cc = c & 31, ob = rr * 64 + cc * 2; return st * 1024 + (ob ^ (((ob >> 9) & 1) << 5)); }
__host__ __device__ __forceinline__ void stage_rc(int b, int& R, int& C) { const int st = b / 1024, sb = b % 1024, swz = sb ^ (((sb >> 9) & 1) << 5); R = (st >> 1) * 16 + swz / 64; C = (st & 1) * 32 + (swz % 64) / 2; }
__host__ __device__ __forceinline__ int perm32(int rho) { const int n = rho >> 4, i = rho & 15; return 8 * (i >> 2) + 4 * n + (i & 3); }

struct Unit { int pm, pn; };
struct Gemm { const bf16_t* A; const bf16_t* Bt; int M, N, K; };

struct StaticOrder {
    int nM, nN, nwg, G, c;
    __host__ __device__ void init(int M, int N, int G_, int c_) { nM = M / BM; nN = N / BM; nwg = nM * nN; G = G_; c = c_; }
    __host__ __device__ bool next(int i, Unit& u) const {
        const long L = (long)i * G + c; if (L >= nwg) return false;
        int wgid = (int)L; { const int q = nwg / NXCD, r = nwg % NXCD, xcd = wgid % NXCD, off = wgid / NXCD; wgid = (xcd < r ? xcd * (q + 1) : r * (q + 1) + (xcd - r) * q) + off; }
        const int nig = WGM * nN, gid = wgid / nig, fm = gid * WGM, gsz = (nM - fm) < WGM ? (nM - fm) : WGM;
        u.pm = fm + ((wgid % nig) % gsz); u.pn = (wgid % nig) / gsz; return true;
    }
    __device__ __forceinline__ void a_ready(const Unit&) const {}
    __device__ __forceinline__ void done(const Unit&) const {}
};

typedef float f32x2_cv __attribute__((ext_vector_type(2))); typedef __bf16 bf16x2_cv __attribute__((ext_vector_type(2)));
__device__ __forceinline__ unsigned cvt_pk_bf16(float lo, float hi) { const f32x2_cv v = {lo, hi}; const bf16x2_cv b = __builtin_convertvector(v, bf16x2_cv); return __builtin_bit_cast(unsigned, b); }
typedef float f32x2 __attribute__((ext_vector_type(2)));
__device__ __forceinline__ float bf2f(unsigned short h) { return __uint_as_float((unsigned)h << 16); }
__device__ __forceinline__ float fast_sigmoid(float x) { return __builtin_amdgcn_rcpf(1.0f + __builtin_amdgcn_exp2f(-1.4426950408889634f * x)); }
__device__ __forceinline__ float neg_decay_log(float x) {
    const float y = -x, sp = fmaxf(y, 0.f) + 0.6931471805599453f * __builtin_amdgcn_logf(1.0f + __builtin_amdgcn_exp2f(-1.4426950408889634f * fabsf(y)));
    return -__builtin_amdgcn_exp2f(-1.4426950408889634f * (sp + 0.5f));
}
__device__ __forceinline__ u32x4 pack8(const f32x4 v0, const f32x4 v1) { u32x4 w; w.x = cvt_pk_bf16(v0[0], v0[1]); w.y = cvt_pk_bf16(v0[2], v0[3]); w.z = cvt_pk_bf16(v1[0], v1[1]); w.w = cvt_pk_bf16(v1[2], v1[3]); return w; }
__device__ __forceinline__ void unpack8(const u32x4 w, f32x4& v0, f32x4& v1) {
    v0[0] = __uint_as_float(w.x << 16); v0[1] = __uint_as_float(w.x & 0xffff0000u); v0[2] = __uint_as_float(w.y << 16); v0[3] = __uint_as_float(w.y & 0xffff0000u);
    v1[0] = __uint_as_float(w.z << 16); v1[1] = __uint_as_float(w.z & 0xffff0000u); v1[2] = __uint_as_float(w.w << 16); v1[3] = __uint_as_float(w.w & 0xffff0000u);
}
constexpr int E_MP = 16384, E_MS = 256;

struct EpiIn {
    static constexpr bool PERM = true, AFTER_DRAIN = false;
    const float* ss; const float* rope;
    bf16_t *Q, *K, *V, *URW, *GATE;
    float *kout_p, *vout_p, *kout_s, *vout_s;
    float *sh_p, *sh_s;
    __device__ __forceinline__ void operator()(const f32x4 (&acc)[2][2][4][2], const Unit& u, int wr, int wc, int fr, int fq) const {
        const int pn = u.pn, rowb = u.pm * BM + wr * 64 + fr, cl = wc * 32 + 8 * fq;
        const bool rope_wave = (pn < 8) && ((wc & 1) == 0);
        const float sgn = (fq == 0) ? -1.f : 1.f;
#pragma unroll
        for (int ai = 0; ai < 2; ++ai)
#pragma unroll
            for (int m = 0; m < 4; ++m) {
                const int row = rowb + ai * HALF + m * 16;
                const float rstd = 1.0f / sqrtf(ss[row] * (1.0f / 1024.f) + 1e-6f);
                const bool smp = row >= E_MP;
                const int t = smp ? ((row - E_MP) & 31) : (row & 2047);
                const int bb = smp ? ((row - E_MP) >> 5) : (row >> 11);
                const int pos = smp ? 2048 + t : t;
                const bool last = smp ? (t == 31) : (t == 2047);
#pragma unroll
                for (int bj = 0; bj < 2; ++bj) {
                    f32x4 v0 = acc[ai][bj][m][0] * rstd, v1 = acc[ai][bj][m][1] * rstd;
                    const int col = pn * BM + bj * HALF + cl;
                    if (pn < 8) {
                        if (rope_wave) {
                            f32x4 p0, p1;
#pragma unroll
                            for (int j = 0; j < 4; ++j) { p0[j] = __shfl_xor(v0[j], 16); p1[j] = __shfl_xor(v1[j], 16); }
                            if (fq < 2) {
                                const float* tb = rope + pos * 16;
                                const f32x4 c0 = *(const f32x4*)(tb), c1 = *(const f32x4*)(tb + 4), s0 = *(const f32x4*)(tb + 8), s1 = *(const f32x4*)(tb + 12);
                                v0 = v0 * c0 + (p0 * s0) * sgn; v1 = v1 * c1 + (p1 * s1) * sgn;
                            }
                        }
                        if (pn < 4) { v0 = v0 * C2; v1 = v1 * C2; *(u32x4*)(Q + (size_t)row * 1024 + col) = pack8(v0, v1); }
                        else {
                            const int c = col - 1024;
                            *(u32x4*)(K + (size_t)row * 1024 + c) = pack8(v0, v1);
                            float* o = smp ? kout_s + (size_t)(row - E_MP) * 1024 + c : kout_p + (size_t)row * 1024 + c;
                            *(f32x4*)o = v0; *(f32x4*)(o + 4) = v1;
                        }
                    } else if (pn < 12) {
                        const int c = col - 2048;
                        *(u32x4*)(V + (size_t)row * 1024 + c) = pack8(v0, v1);
                        float* o = smp ? vout_s + (size_t)(row - E_MP) * 1024 + c : vout_p + (size_t)row * 1024 + c;
                        *(f32x4*)o = v0; *(f32x4*)(o + 4) = v1;
                    } else if (pn < 25) {
                        const int c = col - 3072;
                        *(u32x4*)(URW + (size_t)row * 3328 + c) = pack8(v0, v1);
                        if (last) { float* o = (smp ? sh_s : sh_p) + (size_t)bb * 3328 + c; *(f32x4*)o = v0; *(f32x4*)(o + 4) = v1; }
                    } else {
                        const int c = col - 6400;
#pragma unroll
                        for (int j = 0; j < 4; ++j) { v0[j] = fast_sigmoid(v0[j]); v1[j] = fast_sigmoid(v1[j]); }
                        *(u32x4*)(GATE + (size_t)row * 2048 + c) = pack8(v0, v1);
                    }
                }
            }
    }
};

struct EpiLora {
    static constexpr bool PERM = true, AFTER_DRAIN = false;
    const float *w0, *a0; bf16_t *LD, *LA, *LG;
    __device__ __forceinline__ void operator()(const f32x4 (&acc)[2][2][4][2], const Unit& u, int wr, int wc, int fr, int fq) const {
        const int pn = u.pn, rowb = u.pm * BM + wr * 64 + fr, cl = wc * 32 + 8 * fq;
        const int seg = pn >> 2;
#pragma unroll
        for (int bj = 0; bj < 2; ++bj) {
            const int c = (pn & 3) * BM + bj * HALF + cl;
            f32x4 b0 = (f32x4){0.f, 0.f, 0.f, 0.f}, b1 = b0;
            if (seg == 0) { b0 = *(const f32x4*)(w0 + c); b1 = *(const f32x4*)(w0 + c + 4); }
            else if (seg == 1) { b0 = *(const f32x4*)(a0 + c); b1 = *(const f32x4*)(a0 + c + 4); }
#pragma unroll
            for (int ai = 0; ai < 2; ++ai)
#pragma unroll
                for (int m = 0; m < 4; ++m) {
                    const int row = rowb + ai * HALF + m * 16;
                    f32x4 v0 = acc[ai][bj][m][0] + b0, v1 = acc[ai][bj][m][1] + b1;
                    if (seg == 0) {
#pragma unroll
                        for (int j = 0; j < 4; ++j) { v0[j] = neg_decay_log(v0[j]); v1[j] = neg_decay_log(v1[j]); }
                        *(u32x4*)(LD + (size_t)row * 1024 + c) = pack8(v0, v1);
                    } else if (seg == 1) {
#pragma unroll
                        for (int j = 0; j < 4; ++j) { v0[j] = fast_sigmoid(v0[j]); v1[j] = fast_sigmoid(v1[j]); }
                        *(u32x4*)(LA + (size_t)row * 1024 + c) = pack8(v0, v1);
                    } else {
                        *(u32x4*)(LG + (size_t)row * 1024 + c) = pack8(v0, v1);
                    }
                    asm volatile("" ::: "memory");
                }
        }
    }
};

struct EpiGated {
    static constexpr bool PERM = true, AFTER_DRAIN = false;
    const bf16_t* G; int goff; const bf16_t* S; bf16_t* O;
    __device__ __forceinline__ void operator()(const f32x4 (&acc)[2][2][4][2], const Unit& u, int wr, int wc, int fr, int fq) const {
        const int rowb = u.pm * BM + wr * 64 + fr, cl = u.pn * BM + wc * 32 + 8 * fq;
#pragma unroll
        for (int ai = 0; ai < 2; ++ai)
#pragma unroll
            for (int m = 0; m < 4; ++m) {
                const int row = rowb + ai * HALF + m * 16;
#pragma unroll
                for (int bj = 0; bj < 2; ++bj) {
                    const int c = cl + bj * HALF;
                    f32x4 g0, g1; unpack8(*(const u32x4*)(G + (size_t)row * 2048 + goff + c), g0, g1);
                    f32x4 v0 = acc[ai][bj][m][0] * g0, v1 = acc[ai][bj][m][1] * g1;
                    if (S) { f32x4 s0, s1; unpack8(*(const u32x4*)(S + (size_t)row * 1024 + c), s0, s1); v0 += s0; v1 += s1; }
                    *(u32x4*)(O + (size_t)row * 1024 + c) = pack8(v0, v1);
                }
            }
    }
};

struct EpiRes {
    static constexpr bool PERM = true, AFTER_DRAIN = false;
    float* X; bf16_t* XB; float* SS;
    __device__ __forceinline__ void operator()(const f32x4 (&acc)[2][2][4][2], const Unit& u, int wr, int wc, int fr, int fq) const {
        const int rowb = u.pm * BM + wr * 64 + fr, cl = u.pn * BM + wc * 32 + 8 * fq;
#pragma unroll
        for (int ai = 0; ai < 2; ++ai)
#pragma unroll
            for (int m = 0; m < 4; ++m) {
                const int row = rowb + ai * HALF + m * 16;
                float sq = 0.f;
#pragma unroll
                for (int bj = 0; bj < 2; ++bj) {
                    const int c = cl + bj * HALF;
                    float* xp = X + (size_t)row * 1024 + c;
                    const f32x4 v0 = *(const f32x4*)xp + acc[ai][bj][m][0], v1 = *(const f32x4*)(xp + 4) + acc[ai][bj][m][1];
                    *(f32x4*)xp = v0; *(f32x4*)(xp + 4) = v1;
                    *(u32x4*)(XB + (size_t)row * 1024 + c) = pack8(v0, v1);
                    sq += (v0[0] * v0[0] + v0[1] * v0[1]) + (v0[2] * v0[2] + v0[3] * v0[3]) + (v1[0] * v1[0] + v1[1] * v1[1]) + (v1[2] * v1[2] + v1[3] * v1[3]);
                }
                sq += __shfl_xor(sq, 16); sq += __shfl_xor(sq, 32);
                if (fq == 0) atomicAdd(SS + row, sq);
            }
    }
};

struct EpiUp {
    static constexpr bool PERM = true, AFTER_DRAIN = false;
    const float* ss; bf16_t* UP; float *cv_p, *cv_s;
    __device__ __forceinline__ void operator()(const f32x4 (&acc)[2][2][4][2], const Unit& u, int wr, int wc, int fr, int fq) const {
        const int rowb = u.pm * BM + wr * 64 + fr, cl = u.pn * BM + wc * 32 + 8 * fq;
#pragma unroll
        for (int ai = 0; ai < 2; ++ai)
#pragma unroll
            for (int m = 0; m < 4; ++m) {
                const int row = rowb + ai * HALF + m * 16;
                const float rstd = 1.0f / sqrtf(ss[row] * (1.0f / 1024.f) + 1e-6f);
                const bool smp = row >= E_MP;
                const int t = smp ? ((row - E_MP) & 31) : (row & 2047);
                const int bb = smp ? ((row - E_MP) >> 5) : (row >> 11);
                const int slot = smp ? t - 30 : t - 2046;
#pragma unroll
                for (int bj = 0; bj < 2; ++bj) {
                    const int c = cl + bj * HALF;
                    const f32x4 v0 = acc[ai][bj][m][0] * rstd, v1 = acc[ai][bj][m][1] * rstd;
                    *(u32x4*)(UP + (size_t)row * 5632 + c) = pack8(v0, v1);
                    if (slot >= 0) { float* o = (smp ? cv_s : cv_p) + ((size_t)bb * 2 + slot) * 5632 + c; *(f32x4*)o = v0; *(f32x4*)(o + 4) = v1; }
                }
            }
    }
};

template <class Epi, class Sched, bool ALIGN_EPI = false, bool SP2 = false>
__device__ __forceinline__ void gemm_phase(PG8_LAS unsigned char* lds, const Gemm g, const Sched& S, const Epi& E) {
    int tid_ = threadIdx.x; asm volatile("" : "+v"(tid_));
    const int tid = tid_, wid = __builtin_amdgcn_readfirstlane(tid >> 6), lane = tid & 63, wr = wid >> 2, wc = wid & 3, fr = lane & 15, fq = lane >> 4;
    const int K = g.K, nt = K / BK;
    unsigned voffA[2], voffB[2];
#pragma unroll
    for (int i = 0; i < 2; ++i) { int R, C; stage_rc(tid * 16 + i * 8192, R, C); const int Rb = Epi::PERM ? ((R & ~31) + perm32(R & 31)) : R;
        voffA[i] = (unsigned)(R * K + C) * 2u; voffB[i] = (unsigned)(Rb * K + C) * 2u; }
    const size_t kstep = (size_t)(BK * 2);
    const size_t hstep = (size_t)HALF * K * 2;
    const size_t tstep = 2 * hstep;
    const unsigned ldsw = (unsigned)wid * 1024u;
    const int aoff = lds_byte(wr * 64 + fr, fq * 8), boff = lds_byte(wc * 32 + fr, fq * 8);
#define PG8_SA(b, h) (((b) * 2 + (h)) * HTB)
#define PG8_SB(b, h) ((4 + (b) * 2 + (h)) * HTB)
#define PG8_STAGE(bufoff, gbase, voff) do { _Pragma("unroll") for (int _i = 0; _i < 2; ++_i) \
        __builtin_amdgcn_global_load_lds((const unsigned*)((const char*)(gbase) + (voff)[_i]), (PG8_LAS unsigned*)(lds + (bufoff) + ldsw + _i * 8192), 16, 0, 0); } while (0)
#define PG8_LDA(dst, b, h) do { _Pragma("unroll") for (int m = 0; m < 4; ++m) _Pragma("unroll") for (int k = 0; k < 2; ++k) dst[m][k] = *(const PG8_LAS bf16x8*)(lds + PG8_SA(b, h) + aoff + m * 2048 + k * 1024); } while (0)
#define PG8_LDB(dst, b, h) do { _Pragma("unroll") for (int n = 0; n < 2; ++n) _Pragma("unroll") for (int k = 0; k < 2; ++k) dst[n][k] = *(const PG8_LAS bf16x8*)(lds + PG8_SB(b, h) + boff + n * 2048 + k * 1024); } while (0)
#define PG8_MMA(ai, bj, At, Bt) do { __builtin_amdgcn_s_setprio(1); _Pragma("unroll") for (int m = 0; m < 4; ++m) _Pragma("unroll") for (int n = 0; n < 2; ++n) _Pragma("unroll") for (int k = 0; k < 2; ++k) \
        acc[ai][bj][m][n] = __builtin_amdgcn_mfma_f32_16x16x32_bf16(Bt[n][k], At[m][k], acc[ai][bj][m][n], 0, 0, 0); __builtin_amdgcn_s_setprio(0); } while (0)
#define PG8_WAIT_V(n) asm volatile("s_waitcnt vmcnt(" #n ")" ::: "memory")
#define PG8_WAIT_L(n) asm volatile("s_waitcnt lgkmcnt(" #n ")" ::: "memory")
#define PG8_BAR __builtin_amdgcn_s_barrier()
#define PG8_SCHED __builtin_amdgcn_sched_barrier(0)
    Unit cur, nxt; int ui = 0;
    if (!S.next(0, cur)) return;
    f32x4 acc[2][2][4][2];
#pragma unroll
    for (int a = 0; a < 2; ++a)
#pragma unroll
        for (int b = 0; b < 2; ++b)
#pragma unroll
            for (int m = 0; m < 4; ++m)
#pragma unroll
                for (int n = 0; n < 2; ++n) acc[a][b][m][n] = (f32x4){0.f, 0.f, 0.f, 0.f};
    bf16x8 At[4][2], B0[2][2], B1[2][2];
    const char* cA = (const char*)g.A + (size_t)cur.pm * tstep; const char* cB = (const char*)g.Bt + (size_t)cur.pn * tstep;
    S.a_ready(cur);
    if constexpr (SP2) {
        PG8_STAGE(PG8_SB(0, 0), cB, voffB); PG8_STAGE(PG8_SB(0, 1), cB + hstep, voffB); PG8_STAGE(PG8_SA(0, 0), cA, voffA); PG8_STAGE(PG8_SA(0, 1), cA + hstep, voffA);
        if (wr == 1) PG8_BAR;
        PG8_WAIT_V(2); PG8_BAR;
        PG8_STAGE(PG8_SB(1, 0), cB + kstep, voffB); PG8_STAGE(PG8_SA(1, 0), cA + kstep, voffA); PG8_STAGE(PG8_SB(1, 1), cB + hstep + kstep, voffB);
        PG8_WAIT_V(6); PG8_BAR;
    } else {
        PG8_STAGE(PG8_SB(0, 0), cB, voffB); PG8_STAGE(PG8_SA(0, 0), cA, voffA); PG8_STAGE(PG8_SB(0, 1), cB + hstep, voffB); PG8_STAGE(PG8_SA(0, 1), cA + hstep, voffA);
        if (wr == 1) PG8_BAR;
        PG8_WAIT_V(4); PG8_BAR;
        PG8_STAGE(PG8_SB(1, 0), cB + kstep, voffB); PG8_STAGE(PG8_SA(1, 0), cA + kstep, voffA); PG8_STAGE(PG8_SB(1, 1), cB + hstep + kstep, voffB);
        PG8_WAIT_V(6); PG8_BAR;
    }
    for (;;) {
        const bool has_next = S.next(ui + 1, nxt);
        const char* nA = has_next ? (const char*)g.A + (size_t)nxt.pm * tstep : cA; const char* nB = has_next ? (const char*)g.Bt + (size_t)nxt.pn * tstep : cB;
        for (int t = 0; t < nt; t += 2) {
            const bool last = (t == nt - 2);
            const char* a1 = cA + (size_t)(t + 1) * kstep;
            const char* a2 = last ? nA : cA + (size_t)(t + 2) * kstep; const char* b2 = last ? nB : cB + (size_t)(t + 2) * kstep;
            const char* a3 = a2 + kstep; const char* b3 = b2 + kstep;
            if (last && has_next) S.a_ready(nxt);
            if constexpr (SP2) {
            PG8_LDB(B0, 0, 0); PG8_LDB(B1, 0, 1); PG8_SCHED; PG8_LDA(At, 0, 0); PG8_STAGE(PG8_SA(1, 1), a1 + hstep, voffA);
            PG8_WAIT_V(8); PG8_WAIT_L(0); PG8_BAR; PG8_MMA(0, 0, At, B0); PG8_MMA(0, 1, At, B1); PG8_BAR; PG8_SCHED;
            PG8_LDA(At, 0, 1); PG8_STAGE(PG8_SB(0, 0), b2, voffB); PG8_STAGE(PG8_SB(0, 1), b2 + hstep, voffB); PG8_STAGE(PG8_SA(0, 0), a2, voffA);
            PG8_WAIT_V(8); PG8_WAIT_L(0); PG8_BAR; PG8_MMA(1, 0, At, B0); PG8_MMA(1, 1, At, B1); PG8_BAR; PG8_SCHED;
            PG8_LDB(B0, 1, 0); PG8_LDB(B1, 1, 1); PG8_SCHED; PG8_LDA(At, 1, 0); PG8_STAGE(PG8_SA(0, 1), a2 + hstep, voffA);
            PG8_WAIT_V(8); PG8_WAIT_L(0); PG8_BAR; PG8_MMA(0, 0, At, B0); PG8_MMA(0, 1, At, B1); PG8_BAR; PG8_SCHED;
            PG8_LDA(At, 1, 1); PG8_STAGE(PG8_SB(1, 0), b3, voffB); PG8_STAGE(PG8_SB(1, 1), b3 + hstep, voffB); PG8_STAGE(PG8_SA(1, 0), a3, voffA);
            PG8_WAIT_V(8); PG8_WAIT_L(0); PG8_BAR; PG8_MMA(1, 0, At, B0); PG8_MMA(1, 1, At, B1); PG8_BAR; PG8_SCHED;
            } else {
            PG8_LDB(B0, 0, 0); PG8_SCHED; PG8_LDA(At, 0, 0); PG8_STAGE(PG8_SA(1, 1), a1 + hstep, voffA);
            PG8_WAIT_L(8); PG8_BAR; PG8_WAIT_L(0); PG8_MMA(0, 0, At, B0); PG8_BAR; PG8_SCHED;
            PG8_LDB(B1, 0, 1); PG8_STAGE(PG8_SB(0, 0), b2, voffB);
            PG8_BAR; PG8_WAIT_L(0); PG8_MMA(0, 1, At, B1); PG8_BAR;
            PG8_LDA(At, 0, 1); PG8_STAGE(PG8_SA(0, 0), a2, voffA);
            PG8_BAR; PG8_WAIT_L(0); PG8_MMA(1, 0, At, B0); PG8_BAR; PG8_SCHED;
            PG8_STAGE(PG8_SB(0, 1), b2 + hstep, voffB);
            PG8_WAIT_V(6); PG8_BAR; PG8_MMA(1, 1, At, B1); PG8_BAR;
            PG8_LDB(B0, 1, 0); PG8_SCHED; PG8_LDA(At, 1, 0); PG8_STAGE(PG8_SA(0, 1), a2 + hstep, voffA);
            PG8_WAIT_L(8); PG8_BAR; PG8_WAIT_L(0); PG8_MMA(0, 0, At, B0); PG8_BAR; PG8_SCHED;
            PG8_LDB(B1, 1, 1); PG8_STAGE(PG8_SB(1, 0), b3, voffB);
            PG8_BAR; PG8_WAIT_L(0); PG8_MMA(0, 1, At, B1); PG8_BAR;
            PG8_LDA(At, 1, 1); PG8_STAGE(PG8_SA(1, 0), a3, voffA);
            PG8_BAR; PG8_WAIT_L(0); PG8_MMA(1, 0, At, B0); PG8_BAR; PG8_SCHED;
            PG8_STAGE(PG8_SB(1, 1), b3 + hstep, voffB);
            PG8_WAIT_V(6); PG8_BAR; PG8_MMA(1, 1, At, B1); PG8_BAR;
            }
        }
        if constexpr (ALIGN_EPI) { if (wr == 0) PG8_BAR; }
        if constexpr (!Epi::AFTER_DRAIN) { E(acc, cur, wr, wc, fr, fq); S.done(cur); }
        if (!has_next) break;
#pragma unroll
        for (int a = 0; a < 2; ++a)
#pragma unroll
            for (int b = 0; b < 2; ++b)
#pragma unroll
                for (int m = 0; m < 4; ++m)
#pragma unroll
                    for (int n = 0; n < 2; ++n) acc[a][b][m][n] = (f32x4){0.f, 0.f, 0.f, 0.f};
        cur = nxt; cA = nA; cB = nB; ++ui;
        if constexpr (ALIGN_EPI) { if (wr == 1) PG8_BAR; }
    }
    PG8_WAIT_V(0);
    if constexpr (!ALIGN_EPI) { if (wr == 0) PG8_BAR; }
    PG8_BAR;
    if constexpr (Epi::AFTER_DRAIN) { E.fused(acc, cur, wr, wc, fr, fq, lds, wid, lane); S.done(cur); }
#undef PG8_SA
#undef PG8_SB
#undef PG8_STAGE
#undef PG8_LDA
#undef PG8_LDB
#undef PG8_MMA
#undef PG8_WAIT_V
#undef PG8_WAIT_L
#undef PG8_BAR
#undef PG8_SCHED
}
}

constexpr int NWAVES = 8;
constexpr size_t MiB = 1u << 20;
constexpr size_t WS_CTL = 0, CTL_ZERO_BYTES = 2 * MiB;
constexpr size_t WS_ROPE = 2 * MiB;
constexpr size_t WS_SP = WS_ROPE + 256 * 1024;
constexpr size_t WS_W = 8 * MiB;
constexpr size_t W_IN = 0, W_ODA = W_IN + (size_t)P_TOTAL * 1024 * 2, W_ORW = W_ODA + 2 * MiB, W_OUT = W_ORW + 2 * MiB, W_UP = W_OUT + 2 * MiB,
                 W_DN = W_UP + (size_t)UPW * 1024 * 2, W_LORA = W_DN + (size_t)1024 * D_FF * 2, W_LAYER = W_LORA + (size_t)3072 * 256 * 2;
static_assert(W_LAYER == 42467328, "weights per layer");
constexpr size_t WS_XB = WS_W + 2 * W_LAYER + (MiB - (2 * W_LAYER) % MiB) % MiB;
constexpr size_t ACT = (size_t)MT * 1024 * 2;
constexpr size_t WS_POOL = WS_XB + ACT;
constexpr size_t B_Q = WS_POOL, B_K = B_Q + ACT, B_V = B_K + ACT, B_OC = B_V + ACT  , B_OA = B_OC + 2 * ACT, B_URW = B_OA + ACT, B_GATE = B_URW + (size_t)MT * P_RW * 2,
                 B_END = B_GATE + (size_t)MT * 2048 * 2;
constexpr size_t B_LD = B_Q, B_LA = B_K, B_LG = B_V, B_LIN = B_END, B_ORW = B_OC + ACT;
constexpr size_t B_END2 = B_LIN + (size_t)MT * 256 * 2;
constexpr size_t B_MRG = B_URW;
constexpr size_t B_UP = WS_POOL, B_GT = B_URW;
static_assert(B_UP + (size_t)MT * UPW * 2 <= B_GT && B_GT + (size_t)MT * D_FF * 2 <= B_END, "FFN overlay");
static_assert(B_END2 <= 512 * MiB, "workspace map");
constexpr int CW_BAR = 4096;
constexpr int CW_LAM = 8192;
constexpr int CW_SS = 16384;
static_assert((CW_SS + 5 * MT) * 4 <= (int)CTL_ZERO_BYTES, "CTL region");
constexpr int RING_OFF = 0, RING_BYTES = 131072;
constexpr int LDSCTL_OFF = RING_BYTES, MISC_OFF = LDSCTL_OFF + 320;
constexpr int LDS_BYTES = 147456;

constexpr int PH_PER_LAYER = 11;
constexpr int NPHASE = 1 + DEPTH * PH_PER_LAYER + 1;
enum { K_G1 = 0, K_AT, K_CB, K_LR, K_SC, K_M1, K_M2, K_WO, K_UP, K_CV, K_DN };

#include <hip/hip_bf16.h>
#include <cmath>
namespace attn_body {
using bf16=__hip_bfloat16;
using bf16x8=__attribute__((ext_vector_type(8)))short;
using s16x4=__attribute__((ext_vector_type(4)))short;
using f32x16=__attribute__((ext_vector_type(16)))float;
using u32x4=__attribute__((ext_vector_type(4)))unsigned;
constexpr int BATCH=8,SEQ=2048,D=64,DM=1024;
constexpr int NW=8,QBLK=32,QB=QBLK*NW,KVBLK=64,NQB=SEQ/QB;
constexpr int ATTN_PITCH=DM, ATTN_UNIT_ROWS=QB;
__device__ __forceinline__ int crow(int r,int hi){return (r&3)+8*(r>>2)+4*hi;}
#define SBAR() __builtin_amdgcn_sched_barrier(0)
__device__ __forceinline__ void cmask(f32x16&p0,f32x16&p1,int jb,int wid){
  const float NEG=-INFINITY;
  if(jb>(wid>>1)){
    #pragma unroll
    for(int r=0;r<16;++r){p0[r]=NEG;p1[r]=NEG;}
  }
}

constexpr int NSLOT=3, SLOTB=8192;
constexpr int LDS_K=0, LDS_V=NSLOT*SLOTB, LDS_WS=2*NSLOT*SLOTB, LDS_OST=LDS_WS+NW*64*4, LDS_BYTES=LDS_OST+NW*4096;
constexpr float C2=0.125f*1.4426950408889634f;
__device__ __forceinline__ void glds16(const void*gsrc,unsigned lds_dst){unsigned keep;
  asm volatile("s_mov_b32 %0, m0\n\ts_mov_b32 m0, %2\n\ts_nop 0\n\tglobal_load_lds_dwordx4 %1, off\n\ts_mov_b32 m0, %0":"=&s"(keep):"v"(gsrc),"s"(lds_dst):"memory");}
__device__ __forceinline__ float max3f(float a,float b,float c){float r;asm("v_max3_f32 %0, %1, %2, %3":"=v"(r):"v"(a),"v"(b),"v"(c));return r;}
__device__ __forceinline__ float max2f(float a,float b){float r;asm("v_max_f32_e32 %0, %1, %2":"=v"(r):"v"(a),"v"(b));return r;}
__device__ __forceinline__ float fadd_s(float a,float b){float r;asm("v_add_f32_e32 %0, %1, %2":"=v"(r):"v"(a),"v"(b));return r;}
__device__ __forceinline__ float fsub_s(float a,float b){float r;asm("v_sub_f32_e32 %0, %1, %2":"=v"(r):"v"(a),"v"(b));return r;}
typedef float f32x2_t __attribute__((ext_vector_type(2))); typedef __bf16 bf16x2_t __attribute__((ext_vector_type(2)));
__device__ __forceinline__ unsigned cvtpk_s(float lo,float hi){f32x2_t v={lo,hi};bf16x2_t b=__builtin_convertvector(v,bf16x2_t);return __builtin_bit_cast(unsigned,b);}
#define WAIT_BAR(N) asm volatile("s_waitcnt vmcnt(" #N ") lgkmcnt(0)\n\ts_barrier":::"memory")

__device__ __forceinline__ void qkt(f32x16&p0,f32x16&p1,const char*Kslot,const bf16x8*qr,const f32x16&negm,int r32,int hi){
  const char*kb=Kslot+hi*1024+r32*16;
  #pragma unroll
  for(int d0=0;d0<4;++d0){
    const bf16x8 b0=*reinterpret_cast<const bf16x8*>(kb+d0*2048);
    const bf16x8 b1=*reinterpret_cast<const bf16x8*>(kb+d0*2048+512);
    if(d0==0){p0=__builtin_amdgcn_mfma_f32_32x32x16_bf16(b0,qr[0],negm,0,0,0);p1=__builtin_amdgcn_mfma_f32_32x32x16_bf16(b1,qr[0],negm,0,0,0);}
    else{p0=__builtin_amdgcn_mfma_f32_32x32x16_bf16(b0,qr[d0],p0,0,0,0);p1=__builtin_amdgcn_mfma_f32_32x32x16_bf16(b1,qr[d0],p1,0,0,0);}}
}
typedef __attribute__((address_space(3))) const char* lds_cptr;
typedef short v4i16_t __attribute__((ext_vector_type(4)));
__device__ __forceinline__ void kload8(bf16x8*kf,lds_cptr kp){
  kf[0]=*(const __attribute__((address_space(3))) bf16x8*)(kp);      kf[1]=*(const __attribute__((address_space(3))) bf16x8*)(kp+512);
  kf[2]=*(const __attribute__((address_space(3))) bf16x8*)(kp+2048); kf[3]=*(const __attribute__((address_space(3))) bf16x8*)(kp+2560);
  kf[4]=*(const __attribute__((address_space(3))) bf16x8*)(kp+4096); kf[5]=*(const __attribute__((address_space(3))) bf16x8*)(kp+4608);
  kf[6]=*(const __attribute__((address_space(3))) bf16x8*)(kp+6144); kf[7]=*(const __attribute__((address_space(3))) bf16x8*)(kp+6656);
}
__device__ __forceinline__ void kload2(bf16x8*kf,lds_cptr kp,int j){ kf[2*j]=*(const __attribute__((address_space(3))) bf16x8*)(kp+j*2048); kf[2*j+1]=*(const __attribute__((address_space(3))) bf16x8*)(kp+j*2048+512); }
__device__ __forceinline__ s16x4 vtr(lds_cptr p){ return __builtin_bit_cast(s16x4,__builtin_amdgcn_ds_read_tr16_b64_v4i16((__attribute__((address_space(3))) v4i16_t*)p)); }
__device__ __forceinline__ float rowmax(const f32x16&p0,const f32x16&p1){
  float a=max3f(p0[0],p0[1],p1[0]),b=max3f(p0[2],p0[3],p1[1]);a=max3f(a,p1[2],p1[3]);
  #pragma unroll
  for(int r=4;r<16;r+=4){a=max3f(a,p0[r],p0[r+1]);b=max3f(b,p0[r+2],p0[r+3]);a=max3f(a,p1[r],p1[r+1]);b=max3f(b,p1[r+2],p1[r+3]);}
  const float m=max2f(a,b);
  auto rr=__builtin_amdgcn_permlane32_swap(__float_as_uint(m),__float_as_uint(m),false,false);
  return max2f(__uint_as_float(rr[0]),__uint_as_float(rr[1]));
}
__device__ __forceinline__ void pv(f32x16*o,int vb,bf16x8 pa0,bf16x8 pa1,bf16x8 pa2,bf16x8 pa3){
  #pragma unroll
  for(int d0=0;d0<2;++d0){s16x4 lo[4],hi[4];
    #pragma unroll
    for(int ks=0;ks<4;++ks){
      asm volatile("ds_read_b64_tr_b16 %0,%1 offset:%c2":"=&v"(lo[ks]):"v"(vb),"i"(d0*4096+ks*1024):"memory");
      asm volatile("ds_read_b64_tr_b16 %0,%1 offset:%c2":"=&v"(hi[ks]):"v"(vb),"i"(d0*4096+ks*1024+512):"memory");}
    asm volatile("s_waitcnt lgkmcnt(0)":::"memory");SBAR();
    #define PK(k) (bf16x8){lo[k][0],lo[k][1],lo[k][2],lo[k][3],hi[k][0],hi[k][1],hi[k][2],hi[k][3]}
    o[d0]=__builtin_amdgcn_mfma_f32_32x32x16_bf16(pa0,PK(0),o[d0],0,0,0);
    o[d0]=__builtin_amdgcn_mfma_f32_32x32x16_bf16(pa1,PK(1),o[d0],0,0,0);
    o[d0]=__builtin_amdgcn_mfma_f32_32x32x16_bf16(pa2,PK(2),o[d0],0,0,0);
    o[d0]=__builtin_amdgcn_mfma_f32_32x32x16_bf16(pa3,PK(3),o[d0],0,0,0);
    #undef PK
  }
}

#ifndef ATTN_STORE16
#define ATTN_STORE16(p,v) (*(u32x4*)(p)=(v))
#endif
template<int THRL> __device__ __forceinline__ void attn_unit(int b,int qcol,int vcol,int qb,const bf16*Q,const bf16*K,const bf16*V,bf16*O,char*shm){
  const int tid=threadIdx.x,lane=tid&63,r32=lane&31,hi=lane>>5; const int wid=__builtin_amdgcn_readfirstlane(tid>>6);
  const long rowbase=(long)b*SEQ; const int q0=qb*QB;
  const bf16*Qw=Q+(rowbase+q0+wid*QBLK)*DM+qcol;
  const bf16*Kh=K+rowbase*DM+qcol,*Vh=V+rowbase*DM+vcol;
  const unsigned lds0=(unsigned)(uintptr_t)shm;
  float*wsf=(float*)(shm+LDS_WS)+wid*64;
  const bf16*ksrc=Kh+(long)lane*DM+wid*8;
  const bf16*vsrc=Vh+(long)(16*(wid&3)+(lane>>2))*DM+(wid>>2)*32+(lane&3)*8;
  const unsigned kdst=lds0+LDS_K+wid*1024, vdst=lds0+LDS_V+wid*1024;
  #define DMA_K(t,slot) glds16(ksrc+(long)(t)*KVBLK*DM,(unsigned)__builtin_amdgcn_readfirstlane(kdst+(slot)))
  #define DMA_V(t,slot) glds16(vsrc+(long)(t)*KVBLK*DM,(unsigned)__builtin_amdgcn_readfirstlane(vdst+(slot)))
  const int vb0=(int)(lds0+LDS_V)+((lane>>4)&1)*32+(lane&3)*8+(4*hi+((lane&15)>>2))*64;
  const char*Kbase=shm+LDS_K; bf16x8 kf[8];
  const lds_cptr shm3=(lds_cptr)shm; const lds_cptr kp0=shm3+LDS_K+hi*1024+r32*16; const lds_cptr vp0=shm3+LDS_V+((lane>>4)&1)*32+(lane&3)*8+(4*hi+((lane&15)>>2))*64;
  const int NT=(q0+QB)/KVBLK;
  DMA_K(0,0);DMA_V(0,0);DMA_K(1,SLOTB);
  bf16x8 qr[4];
  #pragma unroll
  for(int d0=0;d0<4;++d0)qr[d0]=*reinterpret_cast<const bf16x8*>(&Qw[(long)r32*DM+d0*16+hi*8]);
  float mhat=0.f,l_reg=0.f;f32x16 o[2];o[0]=f32x16{};o[1]=f32x16{};const f32x16 zc=f32x16{}; float nm=0.f;
  const int qrel=wid*QBLK+r32;
  #define CMASK(P0,P1,t) do{int jb_=(t)-(NT-4); if(jb_>=0)cmask(P0,P1,jb_,wid);}while(0)
  bool resc=false;
  #define START(P0,P1) do{ const float rm=rowmax(P0,P1); resc=false; \
    { const float dl=rm; mhat=fadd_s(mhat,dl); \
      _Pragma("unroll") for(int r=0;r<16;++r){P0[r]=fsub_s(P0[r],dl);P1[r]=fsub_s(P1[r],dl);} \
      nm=-mhat; } \
    _Pragma("unroll") for(int r=0;r<16;++r)P0[r]=__builtin_amdgcn_exp2f(P0[r]); }while(0)
  #define RESC() do{ if(resc){ asm volatile("s_waitcnt lgkmcnt(0)":::"memory"); \
      _Pragma("unroll") for(int d_=0;d_<2;++d_) _Pragma("unroll") for(int r=0;r<16;++r)o[d_][r]*=wsf[crow(r,hi)]; } }while(0)
  f32x16 pA0,pA1,pB0,pB1;
  int sl_prev=0,sl_cur=0,sl_next=SLOTB;
  #define ROT() do{sl_prev=sl_cur;sl_cur=sl_next;sl_next=(sl_next==(NSLOT-1)*SLOTB)?0:sl_next+SLOTB;}while(0)
  DMA_K(2,2*SLOTB);
  WAIT_BAR(3);
  qkt(pA0,pA1,Kbase,qr,zc,r32,hi);asm volatile("s_nop 15\n\ts_nop 7":"+v"(pA0),"+v"(pA1));CMASK(pA0,pA1,0);
  START(pA0,pA1);
  _Pragma("unroll") for(int r=0;r<16;++r)pA1[r]=__builtin_amdgcn_exp2f(pA1[r]);
  WAIT_BAR(0);
  DMA_K(3,0);DMA_V(1,SLOTB);
  ROT();
  kload8(kf,kp0+sl_cur);
  WAIT_BAR(2);
  s16x4 vlo[8],vhi[8]; u32x4 pw0,pw1,pw2,pw3;
  #define PKW(P,B) cvtpk_s(P[B],P[B+1])
  #define PAF(k) __builtin_bit_cast(bf16x8,pw##k)
  #define VFR(i) (bf16x8){vlo[i][0],vlo[i][1],vlo[i][2],vlo[i][3],vhi[i][0],vhi[i][1],vhi[i][2],vhi[i][3]}
  #define PIN(x) asm volatile("":"+v"(x))
  #define MX3(a,b,c) __builtin_fmaxf(__builtin_fmaxf((a),(b)),(c))
  #define GAPA(MF,A0,A1,A2,A3,W0,W1,PW) do{ MF; sacc+=A0; sacc+=A1; sacc+=A2; sacc+=A3; PIN(sacc); W0; W1; PIN(PW); SBAR(); }while(0)
  #define EX(v) __builtin_amdgcn_exp2f(v)
  #define GAPB(MF,X,B) do{ MF; X[B]=EX(X[B]); X[B+1]=EX(X[B+1]); X[B+2]=EX(X[B+2]); X[B+3]=EX(X[B+3]); PIN(X); SBAR(); }while(0)
  #define VRD(i) do{ vlo[i]=vtr(vp_+(((i)>>2)*4096+((i)&3)*1024)); vhi[i]=vtr(vp_+(((i)>>2)*4096+((i)&3)*1024+512)); }while(0)
  #define KRD(G,j) do{ if(G){ kload2(kf,kp0+sl_next,j); SBAR(); } }while(0)
  #define STEP(C0,C1,P0,P1,t,GK,GV,GL) do{ SBAR(); \
    const lds_cptr vp_=vp0+sl_prev; \
    VRD(0); SBAR(); float sacc=(P0[0]+P0[1]); \
    GAPA(C0=__builtin_amdgcn_mfma_f32_32x32x16_bf16(kf[0],qr[0],zc,0,0,0), P0[2],P0[3],P0[4],P0[5],     pw0[0]=PKW(P0,0), pw0[1]=PKW(P0,2), pw0); \
    VRD(4); SBAR(); GAPA(C1=__builtin_amdgcn_mfma_f32_32x32x16_bf16(kf[1],qr[0],zc,0,0,0), P0[6],P0[7],P0[8],P0[9],     pw0[2]=PKW(P0,4), pw0[3]=PKW(P0,6), pw0); \
    VRD(1); SBAR(); GAPA(C0=__builtin_amdgcn_mfma_f32_32x32x16_bf16(kf[2],qr[1],C0,0,0,0),   P0[10],P0[11],P0[12],P0[13], pw1[0]=PKW(P0,8), pw1[1]=PKW(P0,10), pw1); \
    VRD(5); SBAR(); GAPA(C1=__builtin_amdgcn_mfma_f32_32x32x16_bf16(kf[3],qr[1],C1,0,0,0),   P0[14],P0[15],P1[0],P1[1],   pw1[2]=PKW(P0,12),pw1[3]=PKW(P0,14), pw1); \
    VRD(2); SBAR(); GAPA(C0=__builtin_amdgcn_mfma_f32_32x32x16_bf16(kf[4],qr[2],C0,0,0,0),   P1[2],P1[3],P1[4],P1[5],     pw2[0]=PKW(P1,0), pw2[1]=PKW(P1,2), pw2); \
    VRD(6); SBAR(); GAPA(C1=__builtin_amdgcn_mfma_f32_32x32x16_bf16(kf[5],qr[2],C1,0,0,0),   P1[6],P1[7],P1[8],P1[9],     pw2[2]=PKW(P1,4), pw2[3]=PKW(P1,6), pw2); \
    VRD(3); SBAR(); GAPA(C0=__builtin_amdgcn_mfma_f32_32x32x16_bf16(kf[6],qr[3],C0,0,0,0),   P1[10],P1[11],P1[12],P1[13], pw3[0]=PKW(P1,8), pw3[1]=PKW(P1,10), pw3); \
    VRD(7); SBAR(); GAPA(C1=__builtin_amdgcn_mfma_f32_32x32x16_bf16(kf[7],qr[3],C1,0,0,0),   P1[14],P1[15],0.f,0.f,       pw3[2]=PKW(P1,12),pw3[3]=PKW(P1,14), pw3); \
    l_reg+=sacc; \
    if(GK){DMA_K((t)+3,sl_cur);} if(GV){DMA_V((t)+1,sl_next);} \
    _Pragma("unroll") for(int r=0;r<16;++r){C0[r]+=nm;C1[r]+=nm;} \
    CMASK(C0,C1,t); \
    { float a=MX3(C0[0],C0[1],C1[0]),b=MX3(C0[2],C0[3],C1[1]); a=MX3(a,C1[2],C1[3]); \
      _Pragma("unroll") for(int r=4;r<16;r+=4){a=MX3(a,C0[r],C0[r+1]);b=MX3(b,C0[r+2],C0[r+3]);a=MX3(a,C1[r],C1[r+1]);b=MX3(b,C1[r+2],C1[r+3]);} \
      float rm=__builtin_fmaxf(a,b); { auto rr=__builtin_amdgcn_permlane32_swap(__float_as_uint(rm),__float_as_uint(rm),false,false); rm=__builtin_fmaxf(__uint_as_float(rr[0]),__uint_as_float(rr[1])); } \
      resc=false; \
      if(__builtin_expect(__any(rm>(float)THRL),0)){ const float dl=__builtin_fmaxf(rm,0.f); mhat+=dl; \
        _Pragma("unroll") for(int r=0;r<16;++r){C0[r]-=dl;C1[r]-=dl;} \
        nm=-mhat; \
        const float f=__builtin_amdgcn_exp2f(-dl); l_reg*=f; if(hi==0)wsf[r32]=f; resc=true; } } \
    SBAR(); \
    GAPB(o[0]=__builtin_amdgcn_mfma_f32_32x32x16_bf16(PAF(0),VFR(0),o[0],0,0,0), C0,0); \
    GAPB(o[1]=__builtin_amdgcn_mfma_f32_32x32x16_bf16(PAF(0),VFR(4),o[1],0,0,0), C0,4); \
    KRD(GL,0); GAPB(o[0]=__builtin_amdgcn_mfma_f32_32x32x16_bf16(PAF(1),VFR(1),o[0],0,0,0), C0,8); \
    KRD(GL,1); GAPB(o[1]=__builtin_amdgcn_mfma_f32_32x32x16_bf16(PAF(1),VFR(5),o[1],0,0,0), C0,12); \
    KRD(GL,2); GAPB(o[0]=__builtin_amdgcn_mfma_f32_32x32x16_bf16(PAF(2),VFR(2),o[0],0,0,0), C1,0); \
    KRD(GL,3); GAPB(o[1]=__builtin_amdgcn_mfma_f32_32x32x16_bf16(PAF(2),VFR(6),o[1],0,0,0), C1,4); \
    GAPB(o[0]=__builtin_amdgcn_mfma_f32_32x32x16_bf16(PAF(3),VFR(3),o[0],0,0,0), C1,8); \
    GAPB(o[1]=__builtin_amdgcn_mfma_f32_32x32x16_bf16(PAF(3),VFR(7),o[1],0,0,0), C1,12); \
    }while(0)
  int t=1;
  #undef CMASK
  #define CMASK(P0,P1,t) do{}while(0)
  for(;t+5<NT;t+=2){
    STEP(pB0,pB1,pA0,pA1,t,true,true,true);     WAIT_BAR(2); RESC(); ROT();
    STEP(pA0,pA1,pB0,pB1,t+1,true,true,true);   WAIT_BAR(2); RESC(); ROT();
  }
  #undef CMASK
  #define CMASK(P0,P1,t) do{int jb_=(t)-(NT-4); if(jb_>=0)cmask(P0,P1,jb_,wid);}while(0)
  #define ENDW(tt) do{ if((tt)+3<NT){WAIT_BAR(2);} else if((tt)+2<NT){WAIT_BAR(1);} else {WAIT_BAR(0);} }while(0)
  for(;t+1<NT;t+=2){
    STEP(pB0,pB1,pA0,pA1,t,(t+3<NT),(t+1<NT),(t+1<NT));       ENDW(t);   RESC(); ROT();
    STEP(pA0,pA1,pB0,pB1,t+1,(t+4<NT),(t+2<NT),(t+2<NT));     ENDW(t+1); RESC(); ROT();
  }
  STEP(pB0,pB1,pA0,pA1,NT-1,false,false,false); RESC();
  { float sacc=pB0[0]+pB0[1]; _Pragma("unroll") for(int r=2;r<16;++r)sacc+=pB0[r]; _Pragma("unroll") for(int r=0;r<16;++r)sacc+=pB1[r]; l_reg+=sacc;
    pw0=(u32x4){PKW(pB0,0),PKW(pB0,2),PKW(pB0,4),PKW(pB0,6)};pw1=(u32x4){PKW(pB0,8),PKW(pB0,10),PKW(pB0,12),PKW(pB0,14)};pw2=(u32x4){PKW(pB1,0),PKW(pB1,2),PKW(pB1,4),PKW(pB1,6)};pw3=(u32x4){PKW(pB1,8),PKW(pB1,10),PKW(pB1,12),PKW(pB1,14)};
    SBAR(); pv(o,vb0+sl_cur,PAF(0),PAF(1),PAF(2),PAF(3)); }
  #undef PKW
  #undef PAF
  #undef VFR
  #undef PIN
  #undef MX3
  #undef GAPA
  #undef GAPB
  #undef EX
  #undef VRD
  #undef KRD
  #undef STEP
  #undef ENDW
  {auto rr=__builtin_amdgcn_permlane32_swap(__float_as_uint(l_reg),__float_as_uint(l_reg),false,false);l_reg=__uint_as_float(rr[0])+__uint_as_float(rr[1]);}
  if(hi==0)wsf[32+r32]=l_reg;asm volatile("s_waitcnt lgkmcnt(0)":::"memory");
  float rli[16];
  #pragma unroll
  for(int r=0;r<16;++r)rli[r]=__builtin_amdgcn_rcpf(wsf[32+crow(r,hi)]);
  bf16*Ow=O+(rowbase+q0+wid*QBLK)*DM+vcol;
  { bf16*stg=(bf16*)(shm+LDS_OST)+wid*2048;
    #pragma unroll
    for(int r=0;r<16;++r){const int orow=crow(r,hi);
      #pragma unroll
      for(int d0=0;d0<2;++d0)stg[orow*64+d0*32+r32]=__float2bfloat16(o[d0][r]*rli[r]);}
    asm volatile("s_waitcnt lgkmcnt(0)":::"memory");
    #pragma unroll
    for(int i=0;i<4;++i){const int row=i*8+(lane>>3),ch=lane&7; const u32x4 v=*(const u32x4*)(stg+row*64+ch*8); ATTN_STORE16(Ow+(long)row*DM+ch*8,v);} }
  asm volatile("s_waitcnt lgkmcnt(0)\n\ts_barrier":::"memory");
  #undef DMA_K
  #undef DMA_V
  #undef CMASK
  #undef START
  #undef RESC
  #undef ROT
}
constexpr int ATTN_LDS_BYTES=LDS_BYTES;
#undef SBAR
#undef WAIT_BAR
}

#define GAS __attribute__((address_space(1)))
#define LAS __attribute__((address_space(3)))
typedef unsigned short bf16;
typedef unsigned v4u __attribute__((ext_vector_type(4)));
typedef float f32x4 __attribute__((ext_vector_type(4)));
typedef short bf16x8 __attribute__((ext_vector_type(8)));
typedef GAS unsigned gu32;
typedef GAS unsigned long long gu64;
#define RLX_AGENT __ATOMIC_RELAXED, __HIP_MEMORY_SCOPE_AGENT
#define LDS_WAIT() asm volatile("s_waitcnt lgkmcnt(0)" ::: "memory")
#define VM_WAIT() asm volatile("s_waitcnt vmcnt(0)" ::: "memory")
__device__ __forceinline__ unsigned long long rt() { return __builtin_amdgcn_s_memrealtime(); }
__device__ __forceinline__ unsigned f2bf(float f) { unsigned u = __builtin_bit_cast(unsigned, f); return (u + 0x7fffu + ((u >> 16) & 1u)) >> 16; }
__device__ __forceinline__ unsigned pk2(float lo, float hi) { return f2bf(lo) | (f2bf(hi) << 16); }

#define XB_TMO      128
#define XB_XCNT(j)  (256  + 64 * (j))
#define XB_XSUB(j)  (1280 + 64 * (j))
#define XB_XGEN(j)  (2304 + 64 * (j))
#define XB_TOP      3328
#define XB_TOPGEN   3392
#define XCD_BAR_WORDS 3456
#define XB_SPIN_CAP (1u << 22)

__device__ __forceinline__ unsigned xb_ld(unsigned* p)              { return __hip_atomic_load(p, __ATOMIC_RELAXED, __HIP_MEMORY_SCOPE_AGENT); }
__device__ __forceinline__ unsigned xb_add(unsigned* p, unsigned v) { return __hip_atomic_fetch_add(p, v, __ATOMIC_RELAXED, __HIP_MEMORY_SCOPE_AGENT); }
__device__ __forceinline__ unsigned xb_xcc_id() { return (unsigned)__builtin_amdgcn_s_getreg((3 << 11) | 20) & 0xFu; }
#define XB_SPIN(cond, bar) do { unsigned _sp = 0; while (cond) { __builtin_amdgcn_s_sleep(1); \
    if ((++_sp & 255u) == 0u) { if (xb_ld(&(bar)[XB_TMO])) break; if (_sp > XB_SPIN_CAP) { atomicAdd(&(bar)[XB_TMO], 1u); break; } } } } while (0)

struct XcdBarrier {
    unsigned* bar; unsigned x;
    volatile LAS unsigned* st;
};

__device__ __forceinline__ XcdBarrier xcd_barrier_post(unsigned* bar, volatile LAS unsigned* st) {
    XcdBarrier b; b.bar = bar; b.x = xb_xcc_id(); b.st = st;
    if (threadIdx.x == 0) (void)xb_add(&bar[XB_XCNT(b.x)], 1u);
    return b;
}
__device__ __forceinline__ void xcd_barrier_complete(unsigned* bar, unsigned x, unsigned& nloc, unsigned& nx) {
    const unsigned G = gridDim.x * gridDim.y * gridDim.z;
    unsigned sum, cnt, mine, sp = 0u;
    for (;;) {
        sum = 0u; cnt = 0u; mine = 0u;
#pragma unroll
        for (unsigned j = 0; j < 16; ++j) { const unsigned c = xb_ld(&bar[XB_XCNT(j)]); sum += c; cnt += (c > 0u) ? 1u : 0u; mine = (j == x) ? c : mine; }
        if (sum == G) break;
        __builtin_amdgcn_s_sleep(1);
        if ((++sp & 255u) == 0u) { if (xb_ld(&bar[XB_TMO])) break; if (sp > XB_SPIN_CAP) { atomicAdd(&bar[XB_TMO], 1u); break; } }
    }
    nloc = mine > 0u ? mine : 1u; nx = cnt > 0u ? cnt : 1u;
}

__device__ __forceinline__ void xcd_barrier(const XcdBarrier& b) {
    asm volatile("s_waitcnt vmcnt(0)" ::: "memory");
    __syncthreads();
    if (threadIdx.x == 0) {
        unsigned* bar = b.bar;
        __builtin_amdgcn_s_waitcnt(0);
        unsigned nloc = b.st[0], nx = b.st[1];
        if (nloc == 0u) { xcd_barrier_complete(bar, b.x, nloc, nx); b.st[0] = nloc; b.st[1] = nx; }
        const unsigned old = xb_add(&bar[XB_XSUB(b.x)], 1u);
        const unsigned gen = old / nloc;
        if (old + 1u == (gen + 1u) * nloc) {
            __builtin_amdgcn_fence(__ATOMIC_RELEASE, "agent");
            asm volatile("s_waitcnt vmcnt(0)" ::: "memory");
            const unsigned og = xb_add(&bar[XB_TOP], 1u);
            const unsigned tg = og / nx;
            if (og + 1u == (tg + 1u) * nx) xb_add(&bar[XB_TOPGEN], 1u);
            else XB_SPIN(xb_ld(&bar[XB_TOPGEN]) == tg, bar);
            __builtin_amdgcn_fence(__ATOMIC_ACQUIRE, "agent");
            xb_add(&bar[XB_XGEN(b.x)], 1u);
            asm volatile("s_waitcnt vmcnt(0)" ::: "memory");
        } else {
            XB_SPIN(xb_ld(&bar[XB_XGEN(b.x)]) == gen, bar);
            __builtin_amdgcn_fence(__ATOMIC_ACQUIRE, "agent");
            asm volatile("s_waitcnt vmcnt(0)" ::: "memory");
        }
    }
    __syncthreads();
}

struct Args { const GAS float* in[31]; GAS float* out; GAS unsigned char* ws; float rinv[8]; int ph_lo, ph_hi; };
#define GIN(A, i) ((const float*)((A)->in[i]))
typedef const Args __attribute__((address_space(4)))* CArgsP;
struct Frame {
    LAS unsigned char* lds;
    volatile LAS unsigned* MISC;
    gu32* ctl;
    int tid, lane, wave, vcu, G;
    float* out; unsigned char* ws;
};
__device__ __forceinline__ float wave_sum(float v) {
#pragma unroll
    for (int o = 1; o < 64; o <<= 1) v += __shfl_xor(v, o);
    return v;
}
__device__ __forceinline__ float bf2f(bf16 h) { return __uint_as_float((unsigned)h << 16); }
__device__ __forceinline__ float bflo(unsigned w) { return __uint_as_float(w << 16); }
__device__ __forceinline__ float bfhi(unsigned w) { return __uint_as_float(w & 0xffff0000u); }

__device__ __forceinline__ void p0_transpose_item(const float* W, int N, bf16* WT, int ldk, int koff, int row_off, const float* kscale, LAS float* scr, int item, int lane) {
    const int nblk = N / 32, kb = item / nblk, nb = item % nblk, k0 = 64 * kb, n0 = 32 * nb;
#pragma unroll 8
    for (int i = 0; i < 32; ++i) { const int kk = 2 * i + (lane >> 5); float w = W[(size_t)(k0 + kk) * N + n0 + (lane & 31)]; if (kscale) w *= kscale[k0 + kk]; scr[kk * 33 + (lane & 31)] = w; }
    LDS_WAIT(); asm volatile("" ::: "memory");
    const int c = lane & 7;
#pragma unroll
    for (int j = 0; j < 4; ++j) { const int n = (lane >> 3) + 8 * j; const LAS float* s = scr + (8 * c) * 33 + n;
        v4u o; o.x = pk2(s[0 * 33], s[1 * 33]); o.y = pk2(s[2 * 33], s[3 * 33]); o.z = pk2(s[4 * 33], s[5 * 33]); o.w = pk2(s[6 * 33], s[7 * 33]);
        *(GAS v4u*)(WT + (size_t)(row_off + n0 + n) * ldk + koff + k0 + 8 * c) = o; }
    LDS_WAIT(); asm volatile("" ::: "memory");
}
__device__ __forceinline__ void p0_prologue(Frame& F, CArgsP A) {
    LAS float* scr = (LAS float*)(F.lds + RING_OFF + F.wave * 16384);
    const int gw = F.vcu * NWAVES + F.wave, NGW = F.G * NWAVES;
    constexpr int I_IN = (1024 / 64) * (P_TOTAL / 32), I_SQ = (1024 / 64) * (1024 / 32), I_UP = (1024 / 64) * (UPW / 32), I_DN = (D_FF / 64) * (1024 / 32),
                  I_W2 = 1 * (1024 / 32), I_G2 = 2 * (1024 / 32);
    constexpr int I_LAYER = I_IN + 3 * I_SQ + I_UP + I_DN + 2 * I_W2 + I_G2;
    for (int it = gw; it < DEPTH * I_LAYER; it += NGW) {
        const int l = it / I_LAYER; int r = it % I_LAYER;
        unsigned char* wl = F.ws + WS_W + (size_t)l * W_LAYER;
        if (r < I_IN) { p0_transpose_item(GIN(A, 8) + (size_t)l * 1024 * P_TOTAL, P_TOTAL, (bf16*)(wl + W_IN), 1024, 0, 0, GIN(A, 7) + l * 1024, scr, r, F.lane); continue; } r -= I_IN;
        if (r < I_SQ) { p0_transpose_item(GIN(A, 11) + (size_t)l * 1024 * 1024, 1024, (bf16*)(wl + W_ODA), 1024, 0, 0, nullptr, scr, r, F.lane); continue; } r -= I_SQ;
        if (r < I_SQ) { p0_transpose_item(GIN(A, 23) + (size_t)l * 1024 * 1024, 1024, (bf16*)(wl + W_ORW), 1024, 0, 0, nullptr, scr, r, F.lane); continue; } r -= I_SQ;
        if (r < I_SQ) { p0_transpose_item(GIN(A, 24) + (size_t)l * 1024 * 1024, 1024, (bf16*)(wl + W_OUT), 1024, 0, 0, nullptr, scr, r, F.lane); continue; } r -= I_SQ;
        if (r < I_UP) { p0_transpose_item(GIN(A, 26) + (size_t)l * 1024 * UPW, UPW, (bf16*)(wl + W_UP), 1024, 0, 0, GIN(A, 25) + l * 1024, scr, r, F.lane); continue; } r -= I_UP;
        if (r < I_DN) { p0_transpose_item(GIN(A, 29) + (size_t)l * D_FF * 1024, 1024, (bf16*)(wl + W_DN), D_FF, 0, 0, nullptr, scr, r, F.lane); continue; } r -= I_DN;
        if (r < I_W2) { p0_transpose_item(GIN(A, 14) + (size_t)l * 64 * 1024, 1024, (bf16*)(wl + W_LORA), 256, 0, 0, nullptr, scr, r, F.lane); continue; } r -= I_W2;
        if (r < I_W2) { p0_transpose_item(GIN(A, 16) + (size_t)l * 64 * 1024, 1024, (bf16*)(wl + W_LORA), 256, 64, 1024, nullptr, scr, r, F.lane); continue; } r -= I_W2;
        p0_transpose_item(GIN(A, 17) + (size_t)l * 128 * 1024, 1024, (bf16*)(wl + W_LORA), 256, 128, 2048, nullptr, scr, r, F.lane);
    }
    {
        const int gt = gw * 64 + F.lane, NGT = NGW * 64;
        for (int i = gt; i < DEPTH * 3072 * 32; i += NGT) {
            const int l = i / (3072 * 32), r = i % (3072 * 32), n = r >> 5, kc = r & 31, blk = n >> 10;
            const bool nz = (blk == 0) ? (kc < 8) : (blk == 1) ? (kc >= 8 && kc < 16) : (kc >= 16);
            if (!nz) *(GAS v4u*)(F.ws + WS_W + (size_t)l * W_LAYER + W_LORA + ((size_t)n * 256 + kc * 8) * 2) = (v4u){0u, 0u, 0u, 0u};
        }
        float* rope = (float*)(F.ws + WS_ROPE);
        for (int i = gt; i < NKEYS_S * 8; i += NGT) {
            const int pos = i >> 3, k = i & 7;
            const float ang = (float)pos * A->rinv[k];
            const float kq = rintf(ang * 0.15915494309189535f);
            float r = fmaf(-kq, 6.2831854820251465f, ang); r = fmaf(-kq, -1.7484555314695172e-7f, r);
            const float rev = r * 0.15915494309189535f;
            rope[pos * 16 + k] = __builtin_amdgcn_cosf(rev); rope[pos * 16 + 8 + k] = __builtin_amdgcn_sinf(rev);
        }
    }
    {
        float* X = F.out + O_YP; bf16* XB = (bf16*)(F.ws + WS_XB); float* SS = (float*)(F.ctl + CW_SS);
        for (int m = gw; m < MT; m += NGW) {
            const float* src = (m < MP) ? GIN(A, 0) + (size_t)m * 1024 : GIN(A, 1) + (size_t)(m - MP) * 1024;
            const GAS f32x4* xr = (const GAS f32x4*)src + F.lane;
            GAS f32x4* xo = (GAS f32x4*)(X + (size_t)m * 1024) + F.lane;
            GAS unsigned long long* o8 = (GAS unsigned long long*)(XB + (size_t)m * 1024) + F.lane;
            float s = 0.f;
#pragma unroll
            for (int j = 0; j < 4; ++j) { const f32x4 v = xr[64 * j]; s += (v.x * v.x + v.y * v.y) + (v.z * v.z + v.w * v.w); xo[64 * j] = v;
                o8[64 * j] = (unsigned long long)pk2(v.x, v.y) | ((unsigned long long)pk2(v.z, v.w) << 32); }
            s = wave_sum(s);
            if (F.lane == 0) SS[m] = s;
        }
    }
    if (gw < DEPTH) {
        const int l = gw; const float* lp = GIN(A, 9) + (size_t)l * 256;
        const float s1 = wave_sum(lp[F.lane] * lp[64 + F.lane]), s2 = wave_sum(lp[128 + F.lane] * lp[192 + F.lane]);
        if (F.lane == 0) ((float*)(F.ctl + CW_LAM))[l] = expf(s1) - expf(s2) + (0.8f - 0.6f * expf(-0.3f * (float)l));
    }
}

__device__ __forceinline__ void attn_slow_prompt(Frame& F, CArgsP A, int it) {
    const int c = it & 1, h = (it >> 1) & 7, chunk = (it >> 4) & 31, b = it >> 9;
    const bf16* Q = (const bf16*)(F.ws + B_Q); const bf16* K = (const bf16*)(F.ws + B_K); const bf16* V = (const bf16*)(F.ws + B_V);
    bf16* OC = (bf16*)(F.ws + B_OC) + (size_t)c * MT * 1024;
    const int row = b * SEQ + chunk * 64 + F.lane;
    float q[64];
    { const v4u* qp = (const v4u*)(Q + (size_t)row * 1024 + h * 128 + c * 64);
#pragma unroll
      for (int i = 0; i < 8; ++i) { const v4u w = qp[i]; q[8 * i] = bflo(w.x); q[8 * i + 1] = bfhi(w.x); q[8 * i + 2] = bflo(w.y); q[8 * i + 3] = bfhi(w.y); q[8 * i + 4] = bflo(w.z); q[8 * i + 5] = bfhi(w.z); q[8 * i + 6] = bflo(w.w); q[8 * i + 7] = bfhi(w.w); } }
    float o[128];
#pragma unroll
    for (int d = 0; d < 128; ++d) o[d] = 0.f;
    float m = -1e30f, l = 0.f;
    const int nk = (chunk + 1) * 64;
    const bf16* kb = K + (size_t)(b * SEQ) * 1024 + h * 128 + c * 64;
    const bf16* vb = V + (size_t)(b * SEQ) * 1024 + h * 128;
    for (int j = 0; j < nk; ++j) {
        const v4u* kp = (const v4u*)(kb + (size_t)j * 1024);
        float s = 0.f;
#pragma unroll
        for (int i = 0; i < 8; ++i) { const v4u w = kp[i];
            s = fmaf(q[8 * i], bflo(w.x), s); s = fmaf(q[8 * i + 1], bfhi(w.x), s); s = fmaf(q[8 * i + 2], bflo(w.y), s); s = fmaf(q[8 * i + 3], bfhi(w.y), s);
            s = fmaf(q[8 * i + 4], bflo(w.z), s); s = fmaf(q[8 * i + 5], bfhi(w.z), s); s = fmaf(q[8 * i + 6], bflo(w.w), s); s = fmaf(q[8 * i + 7], bfhi(w.w), s); }
        const float mn = fmaxf(m, s), alpha = exp2f(m - mn), pj = exp2f(s - mn);
        l = l * alpha + pj; m = mn;
        const v4u* vp = (const v4u*)(vb + (size_t)j * 1024);
#pragma unroll
        for (int i = 0; i < 16; ++i) { if ((i & 3) == 0) asm volatile("" ::: "memory"); const v4u w = vp[i];
            o[8 * i] = fmaf(o[8 * i], alpha, pj * bflo(w.x)); o[8 * i + 1] = fmaf(o[8 * i + 1], alpha, pj * bfhi(w.x)); o[8 * i + 2] = fmaf(o[8 * i + 2], alpha, pj * bflo(w.y)); o[8 * i + 3] = fmaf(o[8 * i + 3], alpha, pj * bfhi(w.y));
            o[8 * i + 4] = fmaf(o[8 * i + 4], alpha, pj * bflo(w.z)); o[8 * i + 5] = fmaf(o[8 * i + 5], alpha, pj * bfhi(w.z)); o[8 * i + 6] = fmaf(o[8 * i + 6], alpha, pj * bflo(w.w)); o[8 * i + 7] = fmaf(o[8 * i + 7], alpha, pj * bfhi(w.w)); }
    }
    const float il = 1.0f / l;
    v4u* op = (v4u*)(OC + (size_t)row * 1024 + h * 128);
#pragma unroll
    for (int i = 0; i < 16; ++i) { v4u w; w.x = pk2(o[8 * i] * il, o[8 * i + 1] * il); w.y = pk2(o[8 * i + 2] * il, o[8 * i + 3] * il); w.z = pk2(o[8 * i + 4] * il, o[8 * i + 5] * il); w.w = pk2(o[8 * i + 6] * il, o[8 * i + 7] * il); op[i] = w; }
}
__device__ __forceinline__ void attn_slow_sample(Frame& F, CArgsP A, int it, int l) {
    const int s = it & 7, c = (it >> 3) & 1, h = (it >> 4) & 7, b = it >> 7;
    const bf16* Q = (const bf16*)(F.ws + B_Q); const bf16* K = (const bf16*)(F.ws + B_K); const bf16* V = (const bf16*)(F.ws + B_V);
    const int qi = F.lane & 31, row = MP + b * DEC_SEQ + qi;
    float q[64];
    { const v4u* qp = (const v4u*)(Q + (size_t)row * 1024 + h * 128 + c * 64);
#pragma unroll
      for (int i = 0; i < 8; ++i) { const v4u w = qp[i]; q[8 * i] = bflo(w.x); q[8 * i + 1] = bfhi(w.x); q[8 * i + 2] = bflo(w.y); q[8 * i + 3] = bfhi(w.y); q[8 * i + 4] = bflo(w.z); q[8 * i + 5] = bfhi(w.z); q[8 * i + 6] = bflo(w.w); q[8 * i + 7] = bfhi(w.w); } }
    float o[128];
#pragma unroll
    for (int d = 0; d < 128; ++d) o[d] = 0.f;
    float m = -1e30f, lsum = 0.f;
    const float* ck = GIN(A, 2) + ((size_t)(l * DEC_BATCH + b) * PAST_LEN) * 1024 + h * 128 + c * 64;
    const float* cv = GIN(A, 3) + ((size_t)(l * DEC_BATCH + b) * PAST_LEN) * 1024 + h * 128;
    const int j0 = s * 260, j1 = j0 + 260, jp1 = j1 < PAST_LEN ? j1 : PAST_LEN;
    for (int j = j0; j < jp1; ++j) {
        float sc = 0.f;
        const f32x4* kp = (const f32x4*)(ck + (size_t)j * 1024);
#pragma unroll
        for (int i = 0; i < 16; ++i) { if ((i & 3) == 0) asm volatile("" ::: "memory"); const f32x4 w = kp[i]; sc = fmaf(q[4 * i], w.x, sc); sc = fmaf(q[4 * i + 1], w.y, sc); sc = fmaf(q[4 * i + 2], w.z, sc); sc = fmaf(q[4 * i + 3], w.w, sc); }
        const float mn = fmaxf(m, sc), alpha = exp2f(m - mn), pj = exp2f(sc - mn); lsum = lsum * alpha + pj; m = mn;
        const f32x4* vp = (const f32x4*)(cv + (size_t)j * 1024);
#pragma unroll
        for (int i = 0; i < 32; ++i) { if ((i & 3) == 0) asm volatile("" ::: "memory"); const f32x4 w = vp[i]; o[4 * i] = fmaf(o[4 * i], alpha, pj * w.x); o[4 * i + 1] = fmaf(o[4 * i + 1], alpha, pj * w.y); o[4 * i + 2] = fmaf(o[4 * i + 2], alpha, pj * w.z); o[4 * i + 3] = fmaf(o[4 * i + 3], alpha, pj * w.w); }
    }
    for (int j = (j0 > PAST_LEN ? j0 : PAST_LEN); j < j1; ++j) {
        float sc = 0.f;
        const size_t kr = (size_t)(MP + b * DEC_SEQ + (j - PAST_LEN)) * 1024;
        const v4u* kp = (const v4u*)(K + kr + h * 128 + c * 64);
#pragma unroll
        for (int i = 0; i < 8; ++i) { const v4u w = kp[i];
            sc = fmaf(q[8 * i], bflo(w.x), sc); sc = fmaf(q[8 * i + 1], bfhi(w.x), sc); sc = fmaf(q[8 * i + 2], bflo(w.y), sc); sc = fmaf(q[8 * i + 3], bfhi(w.y), sc);
            sc = fmaf(q[8 * i + 4], bflo(w.z), sc); sc = fmaf(q[8 * i + 5], bfhi(w.z), sc); sc = fmaf(q[8 * i + 6], bflo(w.w), sc); sc = fmaf(q[8 * i + 7], bfhi(w.w), sc); }
        const float mn = fmaxf(m, sc), alpha = exp2f(m - mn), pj = exp2f(sc - mn); lsum = lsum * alpha + pj; m = mn;
        const v4u* vp = (const v4u*)(V + kr + h * 128);
#pragma unroll
        for (int i = 0; i < 16; ++i) { if ((i & 3) == 0) asm volatile("" ::: "memory"); const v4u w = vp[i];
            o[8 * i] = fmaf(o[8 * i], alpha, pj * bflo(w.x)); o[8 * i + 1] = fmaf(o[8 * i + 1], alpha, pj * bfhi(w.x)); o[8 * i + 2] = fmaf(o[8 * i + 2], alpha, pj * bflo(w.y)); o[8 * i + 3] = fmaf(o[8 * i + 3], alpha, pj * bfhi(w.y));
            o[8 * i + 4] = fmaf(o[8 * i + 4], alpha, pj * bflo(w.z)); o[8 * i + 5] = fmaf(o[8 * i + 5], alpha, pj * bfhi(w.z)); o[8 * i + 6] = fmaf(o[8 * i + 6], alpha, pj * bflo(w.w)); o[8 * i + 7] = fmaf(o[8 * i + 7], alpha, pj * bfhi(w.w)); }
    }
    if (F.lane < 32) {
        float* sp = (float*)(F.ws + WS_SP) + ((size_t)(((b * 8 + h) * 2 + c) * 8 + s) * 32 + qi) * 132;
        sp[0] = m; sp[1] = lsum;
#pragma unroll
        for (int i = 0; i < 32; ++i) *(f32x4*)(sp + 4 + 4 * i) = (f32x4){o[4 * i], o[4 * i + 1], o[4 * i + 2], o[4 * i + 3]};
    }
}
__device__ __forceinline__ void ph_attn_slow(Frame& F, CArgsP A, int l) {
    const int gw = F.vcu * NWAVES + F.wave, NGW = F.G * NWAVES;
    for (int it = gw; it < 2048; it += NGW) { attn_slow_prompt(F, A, it); attn_slow_prompt(F, A, 4095 - it); }
    for (int it = gw; it < 1024; it += NGW) attn_slow_sample(F, A, it, l);
}

__device__ __forceinline__ void ph_attn(Frame& F, CArgsP A, int l) {
    const attn_body::bf16* Q = (const attn_body::bf16*)(F.ws + B_Q); const attn_body::bf16* K = (const attn_body::bf16*)(F.ws + B_K); const attn_body::bf16* V = (const attn_body::bf16*)(F.ws + B_V);
    for (int u = F.vcu; u < 256; u += F.G) {
        const int b = u >> 5, hv = u & 31, h = hv >> 2, c = (hv >> 1) & 1, vh = hv & 1;
        attn_body::bf16* O = (attn_body::bf16*)(F.ws + B_OC) + (size_t)c * MT * 1024;
        for (int qb = 7; qb >= 0; --qb) attn_body::attn_unit<8>(b, h * 128 + c * 64, h * 128 + vh * 64, qb, Q, K, V, O, (char*)F.lds + RING_OFF);
    }
    { int tv = threadIdx.x; asm volatile("" : "+v"(tv)); F.tid = tv; F.lane = tv & 63; F.wave = __builtin_amdgcn_readfirstlane(tv >> 6); }
    const int gw = F.vcu * NWAVES + F.wave, NGW = F.G * NWAVES;
    for (int it = gw; it < 1024; it += NGW) attn_slow_sample(F, A, it, l);
}

__device__ __forceinline__ void ph_combine(Frame& F, CArgsP A, int l) {
    const int gw = F.vcu * NWAVES + F.wave, NGW = F.G * NWAVES;
    const float lam = ((const float*)(F.ctl + CW_LAM))[l], lam_init = 0.8f - 0.6f * expf(-0.3f * (float)l);
    const bf16* OC0 = (const bf16*)(F.ws + B_OC); const bf16* OC1 = OC0 + (size_t)MT * 1024;
    bf16* OA = (bf16*)(F.ws + B_OA);
    const float* subln = GIN(A, 10) + l * 128;
    const float g0 = subln[2 * F.lane], g1 = subln[2 * F.lane + 1];
    for (int it = gw; it < MT * 8; it += NGW) {
        const int row = it >> 3, h = it & 7;
        float a0, a1;
        if (row < MP) {
            const size_t off = (size_t)row * 1024 + h * 128 + 2 * F.lane;
            const unsigned w0 = *(const unsigned*)(OC0 + off), w1 = *(const unsigned*)(OC1 + off);
            a0 = bflo(w0) - lam * bflo(w1); a1 = bfhi(w0) - lam * bfhi(w1);
        } else {
            const int b = (row - MP) >> 5, qi = (row - MP) & 31;
            float oc[2][2];
#pragma unroll
            for (int c = 0; c < 2; ++c) {
                const float* sp = (const float*)(F.ws + WS_SP) + ((size_t)(((b * 8 + h) * 2 + c) * 8) * 32 + qi) * 132;
                float mx = -1e30f;
#pragma unroll
                for (int s = 0; s < 8; ++s) mx = fmaxf(mx, sp[(size_t)s * 32 * 132]);
                float L = 0.f, x0 = 0.f, x1 = 0.f;
#pragma unroll
                for (int s = 0; s < 8; ++s) { const float* p = sp + (size_t)s * 32 * 132; const float w = exp2f(p[0] - mx); L += w * p[1]; x0 += w * p[4 + 2 * F.lane]; x1 += w * p[4 + 2 * F.lane + 1]; }
                oc[c][0] = x0 / L; oc[c][1] = x1 / L;
            }
            a0 = oc[0][0] - lam * oc[1][0]; a1 = oc[0][1] - lam * oc[1][1];
        }
        const float ss = wave_sum(a0 * a0 + a1 * a1);
        const float r = (1.0f / sqrtf(ss * (1.0f / 128.f) + EPS)) * (1.f - lam_init);
        *(unsigned*)(OA + (size_t)row * 1024 + h * 128 + 2 * F.lane) = pk2(a0 * r * g0, a1 * r * g1);
    }
    const bf16* URW = (const bf16*)(F.ws + B_URW); bf16* LIN = (bf16*)(F.ws + B_LIN);
    const float* mu = GIN(A, 12) + (size_t)l * P_RW + 3072 + 4 * F.lane;
    const float mu0 = mu[0], mu1 = mu[1], mu2 = mu[2], mu3 = mu[3];
    for (int row = gw; row < MT; row += NGW) {
        const bool smp = row >= MP; const int t = smp ? ((row - MP) & 31) : (row & 2047);
        const unsigned long long cw = *(const unsigned long long*)(URW + (size_t)row * P_RW + 3072 + 4 * F.lane);
        float u[4] = {bflo((unsigned)cw), bfhi((unsigned)cw), bflo((unsigned)(cw >> 32)), bfhi((unsigned)(cw >> 32))};
        float p[4];
        if (t > 0) { const unsigned long long pw = *(const unsigned long long*)(URW + (size_t)(row - 1) * P_RW + 3072 + 4 * F.lane);
            p[0] = bflo((unsigned)pw); p[1] = bfhi((unsigned)pw); p[2] = bflo((unsigned)(pw >> 32)); p[3] = bfhi((unsigned)(pw >> 32)); }
        else if (smp) { const float* s0 = GIN(A, 5) + ((size_t)(l * DEC_BATCH) + ((row - MP) >> 5)) * P_RW + 3072 + 4 * F.lane; p[0] = s0[0]; p[1] = s0[1]; p[2] = s0[2]; p[3] = s0[3]; }
        else { p[0] = p[1] = p[2] = p[3] = 0.f; }
        u[0] += (p[0] - u[0]) * mu0; u[1] += (p[1] - u[1]) * mu1; u[2] += (p[2] - u[2]) * mu2; u[3] += (p[3] - u[3]) * mu3;
        if (F.lane < 16) { u[0] = tanhf(u[0]); u[1] = tanhf(u[1]); u[2] = tanhf(u[2]); u[3] = tanhf(u[3]); }
        else if (F.lane >= 32) { u[0] = 1.f / (1.f + expf(-u[0])); u[1] = 1.f / (1.f + expf(-u[1])); u[2] = 1.f / (1.f + expf(-u[2])); u[3] = 1.f / (1.f + expf(-u[3])); }
        *(unsigned long long*)(LIN + (size_t)row * 256 + 4 * F.lane) = (unsigned long long)pk2(u[0], u[1]) | ((unsigned long long)pk2(u[2], u[3]) << 32);
    }
}

__device__ __forceinline__ void scan_item(Frame& F, CArgsP A, int l, int it) {
    const bool smp = it >= 128; const int bh = it & 127, b = bh >> 4, h = bh & 15, lane = F.lane;
    const int T = smp ? DEC_SEQ : SEQ; const int row0 = smp ? MP + b * DEC_SEQ : b * SEQ;
    const int c = h * 64 + lane;
    const bf16* URW = (const bf16*)(F.ws + B_URW); const bf16* LD = (const bf16*)(F.ws + B_LD); const bf16* LA = (const bf16*)(F.ws + B_LA); const bf16* LG = (const bf16*)(F.ws + B_LG);
    bf16* ORW = (bf16*)(F.ws + B_ORW);
    const float* mu = GIN(A, 12) + (size_t)l * P_RW;
    const float mu_r = mu[c], mu_k = mu[1024 + c], mu_v = mu[2048 + c];
    const float k_k = GIN(A, 18)[l * 1024 + c], k_a = GIN(A, 19)[l * 1024 + c], r_k = GIN(A, 20)[l * 1024 + c], ln_w = GIN(A, 21)[l * 1024 + c], ln_b = GIN(A, 22)[l * 1024 + c];
    float S[64];
    if (smp) { const float* s0 = GIN(A, 4) + (((size_t)(l * 8 + b) * 16 + h) * 64 + lane) * 64;
#pragma unroll
        for (int k = 0; k < 64; k += 4) { const f32x4 v = *(const f32x4*)(s0 + k); S[k] = v.x; S[k + 1] = v.y; S[k + 2] = v.z; S[k + 3] = v.w; } }
    else {
#pragma unroll
        for (int k = 0; k < 64; ++k) S[k] = 0.f; }
    float pr = 0.f, pk = 0.f, pv = 0.f;
    if (smp) { const float* s0 = GIN(A, 5) + (size_t)(l * 8 + b) * P_RW; pr = s0[c]; pk = s0[1024 + c]; pv = s0[2048 + c]; }
    LAS float* sh = (LAS float*)(F.lds + RING_OFF + F.wave * 2048);
    size_t ro = (size_t)row0;
    float nur = bf2f(URW[ro * P_RW + c]), nuk = bf2f(URW[ro * P_RW + 1024 + c]), nuv = bf2f(URW[ro * P_RW + 2048 + c]);
    float nld = bf2f(LD[ro * 1024 + c]), nla = bf2f(LA[ro * 1024 + c]), nlg = bf2f(LG[ro * 1024 + c]);
    for (int t = 0; t < T; ++t) {
        const float ur = nur, uk = nuk, uv = nuv, ld = nld, a = nla, g = nlg;
        const size_t rcur = ro;
        if (t + 1 < T) { ro += 1; nur = bf2f(URW[ro * P_RW + c]); nuk = bf2f(URW[ro * P_RW + 1024 + c]); nuv = bf2f(URW[ro * P_RW + 2048 + c]);
            nld = bf2f(LD[ro * 1024 + c]); nla = bf2f(LA[ro * 1024 + c]); nlg = bf2f(LG[ro * 1024 + c]); }
        const float r = ur + (pr - ur) * mu_r, kr = uk + (pk - uk) * mu_k, vr = uv + (pv - uv) * mu_v;
        pr = ur; pk = uk; pv = uv;
        const float decay = expf(ld);
        float kk = kr * k_k;
        const float ssq = wave_sum(kk * kk);
        kk *= 1.0f / sqrtf(fmaxf(ssq, 1e-24f));
        const float km = kr * (1.f + (a - 1.f) * k_a);
        const float bbv = kk * a;
        const float bon = wave_sum(r * km * r_k);
        asm volatile("s_waitcnt lgkmcnt(0)" ::: "memory");
        sh[lane] = r; sh[64 + lane] = decay; sh[128 + lane] = km; sh[192 + lane] = kk; sh[256 + lane] = bbv;
        asm volatile("s_waitcnt lgkmcnt(0)" ::: "memory");
        float sa = 0.f;
#pragma unroll
        for (int k = 0; k < 64; k += 4) { const f32x4 q = *(const LAS f32x4*)(sh + 192 + k); sa = fmaf(S[k], -q.x, sa); sa = fmaf(S[k + 1], -q.y, sa); sa = fmaf(S[k + 2], -q.z, sa); sa = fmaf(S[k + 3], -q.w, sa); }
        float y = 0.f;
#pragma unroll
        for (int k = 0; k < 64; k += 4) {
            const f32x4 w4 = *(const LAS f32x4*)(sh + 64 + k), b4 = *(const LAS f32x4*)(sh + 256 + k), m4 = *(const LAS f32x4*)(sh + 128 + k), r4 = *(const LAS f32x4*)(sh + k);
            S[k] = S[k] * w4.x + sa * b4.x + vr * m4.x; y = fmaf(S[k], r4.x, y);
            S[k + 1] = S[k + 1] * w4.y + sa * b4.y + vr * m4.y; y = fmaf(S[k + 1], r4.y, y);
            S[k + 2] = S[k + 2] * w4.z + sa * b4.z + vr * m4.z; y = fmaf(S[k + 2], r4.z, y);
            S[k + 3] = S[k + 3] * w4.w + sa * b4.w + vr * m4.w; y = fmaf(S[k + 3], r4.w, y);
        }
        const float mean = wave_sum(y) * (1.f / 64.f), d = y - mean;
        const float var = wave_sum(d * d) * (1.f / 64.f);
        const float yn = d * (1.0f / sqrtf(var + GN_EPS)) * ln_w + ln_b;
        ORW[rcur * 1024 + c] = (bf16)f2bf((yn + bon * vr) * g);
    }
    int ln2 = lane; asm volatile("" : "+v"(ln2));
    float* Sout = F.out + (smp ? O_WKVS : O_WKVP) + (((size_t)(l * 8 + b) * 16 + h) * 64 + ln2) * 64;
#pragma unroll
    for (int k = 0; k < 64; k += 4) *(f32x4*)(Sout + k) = (f32x4){S[k], S[k + 1], S[k + 2], S[k + 3]};
}
__device__ __forceinline__ void ph_scan_slow(Frame& F, CArgsP A, int l) {
    if (F.wave == 0 && F.vcu < 256) scan_item(F, A, l, F.vcu);
    if (F.G < 256 && F.wave == 1) for (int it = F.G + F.vcu; it < 256; it += F.G) scan_item(F, A, l, it);
}

typedef _Float16 h8v __attribute__((ext_vector_type(8)));
typedef _Float16 h4v __attribute__((ext_vector_type(4)));
template <int CTRL> __device__ __forceinline__ float dppf(float x) { return __builtin_bit_cast(float, __builtin_amdgcn_update_dpp(0, __builtin_bit_cast(int, x), CTRL, 0xF, 0xF, false)); }
__device__ __forceinline__ float reduce8(float x) { x += dppf<0xB1>(x); x += dppf<0x4E>(x); x += dppf<0x141>(x); return x; }
__device__ __forceinline__ float reduce16(float x) { x = reduce8(x); x += dppf<0x140>(x); return x; }
constexpr int SC_C = 32;
constexpr int SC_OPB = 0, SC_OPB_SZ = SC_C * 640;
constexpr int SC_VB = 2 * SC_OPB_SZ, SC_VB_SZ = SC_C * 256;
constexpr int SC_BON = SC_VB + 2 * SC_VB_SZ;
constexpr int SC_YB = SC_BON + 256;
static_assert(SC_YB + SC_C * 256 <= RING_BYTES, "scan LDS");
struct ScanRegs { unsigned long long ur, uk, uv, pr, pk, pv, ld, la, lg; };

__device__ __forceinline__ void unpack4(unsigned long long w, float (&o)[4]) { o[0] = bflo((unsigned)w); o[1] = bfhi((unsigned)w); o[2] = bflo((unsigned)(w >> 32)); o[3] = bfhi((unsigned)(w >> 32)); }

__device__ __forceinline__ void scan_fast(Frame& F, CArgsP A, int l, int item) {
    const bool smp = item >= 128; const int bh = item & 127, b = bh >> 4, h = bh & 15;
    const int T = smp ? DEC_SEQ : SEQ, row0 = smp ? MP + b * DEC_SEQ : b * SEQ, nch = T / SC_C;
    const int tid = F.tid, lane = F.lane, w = F.wave;
    const int rho = lane >> 3, kq = lane & 7, srow = w * 8 + rho;
    const int tp = tid >> 4, cq = tid & 15, c = h * 64 + 4 * cq;
    const bf16* URW = (const bf16*)(F.ws + B_URW); const bf16* LD = (const bf16*)(F.ws + B_LD); const bf16* LA = (const bf16*)(F.ws + B_LA); const bf16* LG = (const bf16*)(F.ws + B_LG);
    bf16* ORW = (bf16*)(F.ws + B_ORW);
    LAS unsigned char* L = F.lds + RING_OFF;
    float mu_r[4], mu_k[4], mu_v[4], k_k[4], k_a[4], r_k[4], ln_w[4], ln_b[4];
    { const float* mu = GIN(A, 12) + (size_t)l * P_RW;
#pragma unroll
      for (int j = 0; j < 4; ++j) { mu_r[j] = mu[c + j]; mu_k[j] = mu[1024 + c + j]; mu_v[j] = mu[2048 + c + j]; k_k[j] = GIN(A, 18)[l * 1024 + c + j]; k_a[j] = GIN(A, 19)[l * 1024 + c + j];
          r_k[j] = GIN(A, 20)[l * 1024 + c + j]; ln_w[j] = GIN(A, 21)[l * 1024 + c + j]; ln_b[j] = GIN(A, 22)[l * 1024 + c + j]; } }
    float S[8];
    if (smp) { const float* s0 = GIN(A, 4) + (((size_t)(l * 8 + b) * 16 + h) * 64 + srow) * 64 + 8 * kq; const f32x4 a0 = *(const f32x4*)s0, a1 = *(const f32x4*)(s0 + 4);
        S[0] = a0.x; S[1] = a0.y; S[2] = a0.z; S[3] = a0.w; S[4] = a1.x; S[5] = a1.y; S[6] = a1.z; S[7] = a1.w; }
    else {
#pragma unroll
        for (int j = 0; j < 8; ++j) S[j] = 0.f; }
    ScanRegs g;
#define SC_LOAD(ch) do { const size_t r_ = (size_t)(row0 + (ch) * SC_C + tp); const bf16* u_ = URW + r_ * P_RW + c; \
        g.ur = *(const unsigned long long*)(u_); g.uk = *(const unsigned long long*)(u_ + 1024); g.uv = *(const unsigned long long*)(u_ + 2048); \
        if ((ch) * SC_C + tp > 0) { g.pr = *(const unsigned long long*)(u_ - P_RW); g.pk = *(const unsigned long long*)(u_ - P_RW + 1024); g.pv = *(const unsigned long long*)(u_ - P_RW + 2048); } \
        g.ld = *(const unsigned long long*)(LD + r_ * 1024 + c); g.la = *(const unsigned long long*)(LA + r_ * 1024 + c); g.lg = *(const unsigned long long*)(LG + r_ * 1024 + c); } while (0)
    SC_LOAD(0);
    unsigned long long lg_cur = 0ull;
    for (int ch = 0; ch < nch; ++ch) {
        const int buf = ch & 1;
        LAS unsigned char* opb = L + SC_OPB + buf * SC_OPB_SZ; LAS float* vb = (LAS float*)(L + SC_VB + buf * SC_VB_SZ); LAS float* bonb = (LAS float*)(L + SC_BON) + buf * SC_C; LAS float* yb = (LAS float*)(L + SC_YB);
        {
            float ur[4], uk[4], uv[4], pr[4], pk[4], pv[4], ld[4], la[4];
            unpack4(g.ur, ur); unpack4(g.uk, uk); unpack4(g.uv, uv); unpack4(g.ld, ld); unpack4(g.la, la);
            if (ch * SC_C + tp > 0) { unpack4(g.pr, pr); unpack4(g.pk, pk); unpack4(g.pv, pv); }
            else if (smp) { const float* s0 = GIN(A, 5) + (size_t)(l * 8 + b) * P_RW + c;
#pragma unroll
                for (int j = 0; j < 4; ++j) { pr[j] = s0[j]; pk[j] = s0[1024 + j]; pv[j] = s0[2048 + j]; } }
            else {
#pragma unroll
                for (int j = 0; j < 4; ++j) { pr[j] = 0.f; pk[j] = 0.f; pv[j] = 0.f; } }
            lg_cur = g.lg;
            float r[4], kr[4], vr[4], kk[4], km[4], omw[4], ssq = 0.f, bon = 0.f;
#pragma unroll
            for (int j = 0; j < 4; ++j) {
                r[j] = ur[j] + (pr[j] - ur[j]) * mu_r[j]; kr[j] = uk[j] + (pk[j] - uk[j]) * mu_k[j]; vr[j] = uv[j] + (pv[j] - uv[j]) * mu_v[j];
                omw[j] = -expm1f(ld[j]);
                kk[j] = kr[j] * k_k[j]; ssq += kk[j] * kk[j];
                km[j] = kr[j] * (1.f + (la[j] - 1.f) * k_a[j]);
                bon += r[j] * km[j] * r_k[j];
            }
            ssq = reduce16(ssq); bon = reduce16(bon);
            const float inv = 1.0f / sqrtf(fmaxf(ssq, 1e-24f));
            h4v o0, o1, o2, o3, o4;
#pragma unroll
            for (int j = 0; j < 4; ++j) { const float kn = kk[j] * inv; o0[j] = (_Float16)omw[j]; o1[j] = (_Float16)kn; o2[j] = (_Float16)(kn * la[j]); o3[j] = (_Float16)km[j]; o4[j] = (_Float16)r[j]; }
            LAS unsigned char* op = opb + tp * 640 + (cq >> 1) * 16 + (cq & 1) * 8;
            *(LAS h4v*)(op) = o0; *(LAS h4v*)(op + 128) = o1; *(LAS h4v*)(op + 256) = o2; *(LAS h4v*)(op + 384) = o3; *(LAS h4v*)(op + 512) = o4;
            *(LAS f32x4*)(vb + tp * 64 + 4 * cq) = (f32x4){vr[0], vr[1], vr[2], vr[3]};
            if (cq == 0) bonb[tp] = bon;
        }
        if (ch + 1 < nch) SC_LOAD(ch + 1);
        __syncthreads();
        {
            const LAS unsigned char* ob = opb + kq * 16;
#pragma unroll 2
            for (int t = 0; t < SC_C; ++t) {
                const h8v omw = *(const LAS h8v*)(ob + t * 640), kk = *(const LAS h8v*)(ob + t * 640 + 128), bb = *(const LAS h8v*)(ob + t * 640 + 256), km = *(const LAS h8v*)(ob + t * 640 + 384),
                          rr = *(const LAS h8v*)(ob + t * 640 + 512);
                const float v = vb[t * 64 + srow];
                float sa = 0.f;
#pragma unroll
                for (int j = 0; j < 8; ++j) sa = __builtin_fmaf(S[j], (float)kk[j], sa);
                sa = reduce8(sa);
                const float nsa = -sa;
                float y = 0.f;
#pragma unroll
                for (int j = 0; j < 8; ++j) {
                    float t1 = __builtin_fmaf(v, (float)km[j], 0.0f); t1 = __builtin_fmaf(nsa, (float)bb[j], t1);
                    t1 = __builtin_fmaf(-S[j], (float)omw[j], t1);
                    S[j] = S[j] + t1; asm volatile("" : "+v"(S[j]));
                    y = __builtin_fmaf(S[j], (float)rr[j], y);
                }
                y = reduce8(y);
                if (kq == 0) yb[t * 64 + srow] = y;
            }
        }
        __syncthreads();
        {
            const f32x4 y4 = *(const LAS f32x4*)(yb + tp * 64 + 4 * cq); const f32x4 v4 = *(const LAS f32x4*)(vb + tp * 64 + 4 * cq); const float bon = bonb[tp];
            float gg[4]; unpack4(lg_cur, gg);
            const float mean = reduce16((y4.x + y4.y) + (y4.z + y4.w)) * (1.f / 64.f);
            const float d0 = y4.x - mean, d1 = y4.y - mean, d2 = y4.z - mean, d3 = y4.w - mean;
            const float var = reduce16((d0 * d0 + d1 * d1) + (d2 * d2 + d3 * d3)) * (1.f / 64.f);
            const float rs = 1.0f / sqrtf(var + GN_EPS);
            const float o0 = (d0 * rs * ln_w[0] + ln_b[0] + bon * v4.x) * gg[0], o1 = (d1 * rs * ln_w[1] + ln_b[1] + bon * v4.y) * gg[1];
            const float o2 = (d2 * rs * ln_w[2] + ln_b[2] + bon * v4.z) * gg[2], o3 = (d3 * rs * ln_w[3] + ln_b[3] + bon * v4.w) * gg[3];
            *(unsigned long long*)(ORW + (size_t)(row0 + ch * SC_C + tp) * 1024 + c) = (unsigned long long)pk2(o0, o1) | ((unsigned long long)pk2(o2, o3) << 32);
        }
    }
#undef SC_LOAD
    float* Sout = F.out + (smp ? O_WKVS : O_WKVP) + (((size_t)(l * 8 + b) * 16 + h) * 64 + srow) * 64 + 8 * kq;
    *(f32x4*)Sout = (f32x4){S[0], S[1], S[2], S[3]}; *(f32x4*)(Sout + 4) = (f32x4){S[4], S[5], S[6], S[7]};
    __syncthreads();
}
__device__ __forceinline__ void ph_scan(Frame& F, CArgsP A, int l) {
    for (int it = F.vcu; it < 256; it += F.G) scan_fast(F, A, l, it);
}

__device__ __forceinline__ void ph_conv(Frame& F, CArgsP A, int l) {
    const int gt = (F.vcu * NWAVES + F.wave) * 64 + F.lane, NGT = F.G * NWAVES * 64;
    const bf16* UP = (const bf16*)(F.ws + B_UP); bf16* GT = (bf16*)(F.ws + B_GT);
    const float* cw = GIN(A, 27) + (size_t)l * 3 * UPW; const float* cb = GIN(A, 28) + (size_t)l * UPW;
    for (int i = gt; i < MT * (D_FF / 8); i += NGT) {
        const int row = i / (D_FF / 8), j = (i % (D_FF / 8)) * 8;
        const bool smp = row >= MP; const int t = smp ? ((row - MP) & 31) : (row & 2047); const int b = smp ? ((row - MP) >> 5) : (row >> 11);
        float cc[2][8];
#pragma unroll
        for (int hf = 0; hf < 2; ++hf) {
            const int col = j + hf * D_FF;
            float u0[8], u1[8], u2[8];
            { const v4u w = *(const v4u*)(UP + (size_t)row * UPW + col); u0[0] = bflo(w.x); u0[1] = bfhi(w.x); u0[2] = bflo(w.y); u0[3] = bfhi(w.y); u0[4] = bflo(w.z); u0[5] = bfhi(w.z); u0[6] = bflo(w.w); u0[7] = bfhi(w.w); }
            if (t >= 1) { const v4u w = *(const v4u*)(UP + (size_t)(row - 1) * UPW + col); u1[0] = bflo(w.x); u1[1] = bfhi(w.x); u1[2] = bflo(w.y); u1[3] = bfhi(w.y); u1[4] = bflo(w.z); u1[5] = bfhi(w.z); u1[6] = bflo(w.w); u1[7] = bfhi(w.w); }
            else if (smp) { const float* s0 = GIN(A, 6) + ((size_t)(l * 8 + b) * 2 + 1) * UPW + col;
#pragma unroll
                for (int e = 0; e < 8; ++e) u1[e] = s0[e]; }
            else {
#pragma unroll
                for (int e = 0; e < 8; ++e) u1[e] = 0.f; }
            if (t >= 2) { const v4u w = *(const v4u*)(UP + (size_t)(row - 2) * UPW + col); u2[0] = bflo(w.x); u2[1] = bfhi(w.x); u2[2] = bflo(w.y); u2[3] = bfhi(w.y); u2[4] = bflo(w.z); u2[5] = bfhi(w.z); u2[6] = bflo(w.w); u2[7] = bfhi(w.w); }
            else if (smp) { const float* s0 = GIN(A, 6) + ((size_t)(l * 8 + b) * 2 + t) * UPW + col;
#pragma unroll
                for (int e = 0; e < 8; ++e) u2[e] = s0[e]; }
            else {
#pragma unroll
                for (int e = 0; e < 8; ++e) u2[e] = 0.f; }
#pragma unroll
            for (int e = 0; e < 8; ++e) cc[hf][e] = cb[col + e] + u2[e] * cw[col + e] + u1[e] * cw[UPW + col + e] + u0[e] * cw[2 * UPW + col + e];
        }
        float gv[8];
#pragma unroll
        for (int e = 0; e < 8; ++e) gv[e] = cc[0][e] / (1.f + expf(-cc[0][e])) * cc[1][e];
        v4u o; o.x = pk2(gv[0], gv[1]); o.y = pk2(gv[2], gv[3]); o.z = pk2(gv[4], gv[5]); o.w = pk2(gv[6], gv[7]);
        *(v4u*)(GT + (size_t)row * D_FF + j) = o;
    }
}

__device__ __forceinline__ void ph_final(Frame& F, CArgsP A) {
    const int gw = F.vcu * NWAVES + F.wave, NGW = F.G * NWAVES;
    float* X = F.out + O_YP; const float* SS = (const float*)(F.ctl + CW_SS) + 4 * MT; const float* g = GIN(A, 30);
    for (int m = gw; m < MT; m += NGW) {
        const float r = 1.0f / sqrtf(SS[m] * (1.0f / 1024.f) + EPS);
        GAS f32x4* xr = (GAS f32x4*)(X + (size_t)m * 1024) + F.lane; const GAS f32x4* gr = (const GAS f32x4*)g + F.lane;
#pragma unroll
        for (int j = 0; j < 4; ++j) { f32x4 v = xr[64 * j]; const f32x4 gg = gr[64 * j]; v = v * r * gg; xr[64 * j] = v; }
    }
}

#define REOPAQUE() do { int tv = threadIdx.x; asm volatile("" : "+v"(tv)); F.tid = tv; F.lane = tv & 63; F.wave = __builtin_amdgcn_readfirstlane(tv >> 6); \
    ap = (CArgsP)__builtin_amdgcn_kernarg_segment_ptr(); asm volatile("" : "+s"(ap)); \
    { GAS unsigned char* w_ = ap->ws; GAS float* o_ = ap->out; asm volatile("" : "+s"(w_), "+s"(o_)); F.ws = (unsigned char*)w_; F.out = (float*)o_; F.ctl = (gu32*)(w_ + WS_CTL); } } while (0)
#define PH_BEGIN(idx) if (lo <= (idx) && (idx) < hi) { REOPAQUE();
#define PH_END(idx) if ((idx) + 1 < hi) xcd_barrier(bar); }

template <int l> __device__ __forceinline__ void layer_phases(Frame& F, CArgsP& ap, const XcdBarrier& bar, const int lo, const int hi) {
    constexpr int P0 = 1 + l * PH_PER_LAYER;
#define WL (F.ws + WS_W + (size_t)l * W_LAYER)
#define SSP ((float*)(F.ctl + CW_SS))
    PH_BEGIN(P0 + K_G1) {
        int kk_ = 1024; asm volatile("" : "+s"(kk_)); pg8::Gemm g{(const bf16*)(F.ws + WS_XB), (const bf16*)(WL + W_IN), MT, P_TOTAL, kk_}; pg8::StaticOrder S; S.init(MT, P_TOTAL, F.G, (int)blockIdx.x);
        pg8::EpiIn E{SSP + (size_t)(2 * l) * MT, (const float*)(F.ws + WS_ROPE), (bf16*)(F.ws + B_Q), (bf16*)(F.ws + B_K), (bf16*)(F.ws + B_V), (bf16*)(F.ws + B_URW), (bf16*)(F.ws + B_GATE),
                     F.out + O_KP + (size_t)l * MP * 1024, F.out + O_VP + (size_t)l * MP * 1024, F.out + O_KS + (size_t)l * MS * 1024, F.out + O_VS + (size_t)l * MS * 1024,
                     F.out + O_SHP + (size_t)l * BATCH * P_RW, F.out + O_SHS + (size_t)l * DEC_BATCH * P_RW};
        pg8::gemm_phase<pg8::EpiIn, pg8::StaticOrder, true, true>(F.lds + RING_OFF, g, S, E);
    } PH_END(P0 + K_G1)
    PH_BEGIN(P0 + K_AT) { ph_attn(F, ap, l); } PH_END(P0 + K_AT)
    PH_BEGIN(P0 + K_CB) { ph_combine(F, ap, l); } PH_END(P0 + K_CB)
    PH_BEGIN(P0 + K_LR) {
        int kk_ = 256; asm volatile("" : "+s"(kk_)); pg8::Gemm g{(const bf16*)(F.ws + B_LIN), (const bf16*)(WL + W_LORA), MT, 3072, kk_}; pg8::StaticOrder S; S.init(MT, 3072, F.G, (int)blockIdx.x);
        pg8::EpiLora E{GIN(ap, 13) + l * 1024, GIN(ap, 15) + l * 1024, (bf16*)(F.ws + B_LD), (bf16*)(F.ws + B_LA), (bf16*)(F.ws + B_LG)};
        pg8::gemm_phase<pg8::EpiLora, pg8::StaticOrder, true, true>(F.lds + RING_OFF, g, S, E);
    } PH_END(P0 + K_LR)
    PH_BEGIN(P0 + K_SC) { ph_scan(F, ap, l); } PH_END(P0 + K_SC)
    PH_BEGIN(P0 + K_M1) {
        int kk_ = 1024; asm volatile("" : "+s"(kk_)); pg8::Gemm g{(const bf16*)(F.ws + B_OA), (const bf16*)(WL + W_ODA), MT, 1024, kk_}; pg8::StaticOrder S; S.init(MT, 1024, F.G, (int)blockIdx.x);
        pg8::EpiGated E{(const bf16*)(F.ws + B_GATE), 0, nullptr, (bf16*)(F.ws + B_MRG)};
        pg8::gemm_phase<pg8::EpiGated, pg8::StaticOrder, true, true>(F.lds + RING_OFF, g, S, E);
    } PH_END(P0 + K_M1)
    PH_BEGIN(P0 + K_M2) {
        int kk_ = 1024; asm volatile("" : "+s"(kk_)); pg8::Gemm g{(const bf16*)(F.ws + B_ORW), (const bf16*)(WL + W_ORW), MT, 1024, kk_}; pg8::StaticOrder S; S.init(MT, 1024, F.G, (int)blockIdx.x);
        pg8::EpiGated E{(const bf16*)(F.ws + B_GATE), 1024, (const bf16*)(F.ws + B_MRG), (bf16*)(F.ws + B_MRG)};
        pg8::gemm_phase<pg8::EpiGated, pg8::StaticOrder, true, true>(F.lds + RING_OFF, g, S, E);
    } PH_END(P0 + K_M2)
    PH_BEGIN(P0 + K_WO) {
        int kk_ = 1024; asm volatile("" : "+s"(kk_)); pg8::Gemm g{(const bf16*)(F.ws + B_MRG), (const bf16*)(WL + W_OUT), MT, 1024, kk_}; pg8::StaticOrder S; S.init(MT, 1024, F.G, (int)blockIdx.x);
        pg8::EpiRes E{F.out + O_YP, (bf16*)(F.ws + WS_XB), SSP + (size_t)(2 * l + 1) * MT};
        pg8::gemm_phase<pg8::EpiRes, pg8::StaticOrder, true, true>(F.lds + RING_OFF, g, S, E);
    } PH_END(P0 + K_WO)
    PH_BEGIN(P0 + K_UP) {
        int kk_ = 1024; asm volatile("" : "+s"(kk_)); pg8::Gemm g{(const bf16*)(F.ws + WS_XB), (const bf16*)(WL + W_UP), MT, UPW, kk_}; pg8::StaticOrder S; S.init(MT, UPW, F.G, (int)blockIdx.x);
        pg8::EpiUp E{SSP + (size_t)(2 * l + 1) * MT, (bf16*)(F.ws + B_UP), F.out + O_CVP + (size_t)l * BATCH * 2 * UPW, F.out + O_CVS + (size_t)l * DEC_BATCH * 2 * UPW};
        pg8::gemm_phase<pg8::EpiUp, pg8::StaticOrder, true, true>(F.lds + RING_OFF, g, S, E);
    } PH_END(P0 + K_UP)
    PH_BEGIN(P0 + K_CV) { ph_conv(F, ap, l); } PH_END(P0 + K_CV)
    PH_BEGIN(P0 + K_DN) {
        int kk_ = D_FF; asm volatile("" : "+s"(kk_)); pg8::Gemm g{(const bf16*)(F.ws + B_GT), (const bf16*)(WL + W_DN), MT, 1024, kk_}; pg8::StaticOrder S; S.init(MT, 1024, F.G, (int)blockIdx.x);
        pg8::EpiRes E{F.out + O_YP, (bf16*)(F.ws + WS_XB), SSP + (size_t)(2 * l + 2) * MT};
        pg8::gemm_phase<pg8::EpiRes, pg8::StaticOrder, true, true>(F.lds + RING_OFF, g, S, E);
    } PH_END(P0 + K_DN)
#undef WL
#undef SSP
}

__global__ void __launch_bounds__(NWAVES * 64, 2) mk_fwd(Args args) {
    extern __shared__ __attribute__((aligned(16))) unsigned char lds[];
    Frame F;
    F.lds = (LAS unsigned char*)lds;
    F.MISC = (volatile LAS unsigned*)(F.lds + MISC_OFF);
    F.tid = threadIdx.x; F.lane = F.tid & 63; F.wave = __builtin_amdgcn_readfirstlane(F.tid >> 6);
    F.G = gridDim.x; { const int bx = blockIdx.x; F.vcu = (F.G % 8 == 0) ? (bx % 8) * (F.G / 8) + bx / 8 : bx; }
    F.out = (float*)args.out; F.ws = (unsigned char*)args.ws;
    F.ctl = (gu32*)(args.ws + WS_CTL);
    for (int u = F.tid; u < (LDS_BYTES - LDSCTL_OFF) / 4; u += NWAVES * 64) ((LAS unsigned*)(F.lds + LDSCTL_OFF))[u] = 0u;
    __syncthreads();
    XcdBarrier bar; bar.bar = (unsigned*)(F.ctl + CW_BAR); bar.x = 0; bar.st = nullptr;
    if (!MK_PER_PHASE) bar = xcd_barrier_post((unsigned*)(F.ctl + CW_BAR), F.MISC + 8);
    const int lo = args.ph_lo, hi = args.ph_hi;
    CArgsP ap;
    PH_BEGIN(0) { p0_prologue(F, ap); } PH_END(0)
    layer_phases<0>(F, ap, bar, lo, hi);
    layer_phases<1>(F, ap, bar, lo, hi);
    PH_BEGIN(NPHASE - 1) { ph_final(F, ap); } PH_END(NPHASE - 1)
}

extern "C" void kernel_launch(void* const* d_in, const int* in_sizes, int n_in, void* d_out, int out_size, void* d_ws, size_t ws_size, hipStream_t stream) {
    (void)in_sizes;
    static int grid = 0;
    if (grid == 0) {
        if (n_in != 31 || out_size != (int)O_END || ws_size < B_END2) { fprintf(stderr, "kernel_launch: unexpected shapes (n_in %d out %d ws %zu)\n", n_in, out_size, ws_size); grid = -1; return; }
        int dev = 0, cus = 0;
        if (hipGetDevice(&dev) != hipSuccess || hipDeviceGetAttribute(&cus, hipDeviceAttributeMultiprocessorCount, dev) != hipSuccess) { grid = -1; return; }
        if (hipFuncSetAttribute((const void*)mk_fwd, hipFuncAttributeMaxDynamicSharedMemorySize, LDS_BYTES) != hipSuccess) { fprintf(stderr, "kernel_launch: hipFuncSetAttribute failed\n"); grid = -1; return; }
        (void)hipGetLastError();
        grid = cus;
    }
    if (grid < 0) return;
    if (hipMemsetAsync((char*)d_ws + WS_CTL, 0, CTL_ZERO_BYTES, stream) != hipSuccess) { fprintf(stderr, "kernel_launch: memset failed\n"); return; }
    Args a{};
    for (int i = 0; i < 31; ++i) a.in[i] = (const GAS float*)d_in[i];
    a.out = (GAS float*)d_out; a.ws = (GAS unsigned char*)d_ws;
    for (int i = 0; i < 8; ++i) a.rinv[i] = (float)pow(500000.0, -(double)i / 8.0);
#if MK_PER_PHASE
    for (int p = 0; p < NPHASE; ++p) { a.ph_lo = p; a.ph_hi = p + 1; hipLaunchKernelGGL(mk_fwd, dim3(grid), dim3(NWAVES * 64), LDS_BYTES, stream, a); }
#else
    a.ph_lo = 0; a.ph_hi = NPHASE;
    hipLaunchKernelGGL(mk_fwd, dim3(grid), dim3(NWAVES * 64), LDS_BYTES, stream, a);
#endif
    const hipError_t le = hipPeekAtLastError();
    if (le != hipSuccess) fprintf(stderr, "kernel_launch: launch failed: %s\n", hipGetErrorName(le));
}
```

```cpp
#include <hip/hip_runtime.h>
#include <cstdio>
#include <cstdint>
#include <cmath>

#ifndef MK_DBL
#define MK_DBL 0
#endif
#ifndef MK_PER_PHASE
#define MK_PER_PHASE 0
#endif

constexpr int D_MODEL = 1024, BATCH = 8, SEQ = 2048, DEPTH = 2, DEC_BATCH = 8, DEC_SEQ = 32, PAST_LEN = 2048;
constexpr float EPS = 1e-6f, GN_EPS = 64e-5f;
constexpr int DA_HEADS = 8, RW_HEADS = 16;
constexpr int D_FF = 2816, UPW = 2 * D_FF;
constexpr int P_DA = 3072, P_RW = 3328, P_GATE = 2048, P_TOTAL = 8448;
constexpr int MP = BATCH * SEQ, MS = DEC_BATCH * DEC_SEQ, MT = MP + MS;
constexpr int NKEYS_S = PAST_LEN + DEC_SEQ;
constexpr float C2 = 0.125f * 1.4426950408889634f;

constexpr size_t O_YP = 0;
constexpr size_t O_YS = O_YP + (size_t)MP * D_MODEL;
constexpr size_t O_KP = O_YS + (size_t)MS * D_MODEL;
constexpr size_t O_VP = O_KP + (size_t)DEPTH * MP * 1024;
constexpr size_t O_WKVP = O_VP + (size_t)DEPTH * MP * 1024;
constexpr size_t O_SHP = O_WKVP + (size_t)DEPTH * BATCH * RW_HEADS * 64 * 64;
constexpr size_t O_CVP = O_SHP + (size_t)DEPTH * BATCH * P_RW;
constexpr size_t O_KS = O_CVP + (size_t)DEPTH * BATCH * 2 * UPW;
constexpr size_t O_VS = O_KS + (size_t)DEPTH * MS * 1024;
constexpr size_t O_WKVS = O_VS + (size_t)DEPTH * MS * 1024;
constexpr size_t O_SHS = O_WKVS + (size_t)DEPTH * DEC_BATCH * RW_HEADS * 64 * 64;
constexpr size_t O_CVS = O_SHS + (size_t)DEPTH * DEC_BATCH * P_RW;
constexpr size_t O_END = O_CVS + (size_t)DEPTH * DEC_BATCH * 2 * UPW;
static_assert(O_END == 87760896, "output size");

namespace pg8 {
#define PG8_LAS __attribute__((address_space(3)))
typedef unsigned short bf16_t;
typedef short bf16x8 __attribute__((ext_vector_type(8)));
typedef float f32x4 __attribute__((ext_vector_type(4)));
typedef unsigned u32x4 __attribute__((ext_vector_type(4)));
constexpr int BM = 256, BK = 64, HALF = 128, HTB = HALF * BK * 2  , STAGE_BYTES = 8 * HTB, NXCD = 8, WGM = 8;

__host__ __device__ __forceinline__ int lds_byte(int r, int c) { const int st = (r >> 4) * 2 + (c >> 5), rr = r & 15, cc = c & 31, ob = rr * 64 + cc * 2; return st * 1024 + (ob ^ (((ob >> 9) & 1) << 5)); }
__host__ __device__ __forceinline__ void stage_rc(int b, int& R, int& C) { const int st = b / 1024, sb = b % 1024, swz = sb ^ (((sb >> 9) & 1) << 5); R = (st >> 1) * 16 + swz / 64; C = (st & 1) * 32 + (swz % 64) / 2; }
__host__ __device__ __forceinline__ int perm32(int rho) { const int n = rho >> 4, i = rho & 15; return 8 * (i >> 2) + 4 * n + (i & 3); }

struct Unit { int pm, pn; };
struct Gemm { const bf16_t* A; const bf16_t* Bt; int M, N, K; };

struct StaticOrder {
    int nM, nN, nwg, G, c;
    __host__ __device__ void init(int M, int N, int G_, int c_) { nM = M / BM; nN = N / BM; nwg = nM * nN; G = G_; c = c_; }
    __host__ __device__ bool next(int i, Unit& u) const {
        const long L = (long)i * G + c; if (L >= nwg) return false;
        int wgid = (int)L; { const int q = nwg / NXCD, r = nwg % NXCD, xcd = wgid % NXCD, off = wgid / NXCD; wgid = (xcd < r ? xcd * (q + 1) : r * (q + 1) + (xcd - r) * q) + off; }
        const int nig = WGM * nN, gid = wgid / nig, fm = gid * WGM, gsz = (nM - fm) < WGM ? (nM - fm) : WGM;
        u.pm = fm + ((wgid % nig) % gsz); u.pn = (wgid % nig) / gsz; return true;
    }
    __device__ __forceinline__ void a_ready(const Unit&) const {}
    __device__ __forceinline__ void done(const Unit&) const {}
};

typedef float f32x2_cv __attribute__((ext_vector_type(2))); typedef __bf16 bf16x2_cv __attribute__((ext_vector_type(2)));
__device__ __forceinline__ unsigned cvt_pk_bf16(float lo, float hi) { const f32x2_cv v = {lo, hi}; const bf16x2_cv b = __builtin_convertvector(v, bf16x2_cv); return __builtin_bit_cast(unsigned, b); }
typedef float f32x2 __attribute__((ext_vector_type(2)));
__device__ __forceinline__ float bf2f(unsigned short h) { return __uint_as_float((unsigned)h << 16); }
__device__ __forceinline__ float fast_sigmoid(float x) { return __builtin_amdgcn_rcpf(1.0f + __builtin_amdgcn_exp2f(-1.4426950408889634f * x)); }
__device__ __forceinline__ float neg_decay_log(float x) {
    const float y = -x, sp = fmaxf(y, 0.f) + 0.6931471805599453f * __builtin_amdgcn_logf(1.0f + __builtin_amdgcn_exp2f(-1.4426950408889634f * fabsf(y)));
    return -__builtin_amdgcn_exp2f(-1.4426950408889634f * (sp + 0.5f));
}
__device__ __forceinline__ u32x4 pack8(const f32x4 v0, const f32x4 v1) { u32x4 w; w.x = cvt_pk_bf16(v0[0], v0[1]); w.y = cvt_pk_bf16(v0[2], v0[3]); w.z = cvt_pk_bf16(v1[0], v1[1]); w.w = cvt_pk_bf16(v1[2], v1[3]); return w; }
__device__ __forceinline__ void unpack8(const u32x4 w, f32x4& v0, f32x4& v1) {
    v0[0] = __uint_as_float(w.x << 16); v0[1] = __uint_as_float(w.x & 0xffff0000u); v0[2] = __uint_as_float(w.y << 16); v0[3] = __uint_as_float(w.y & 0xffff0000u);
    v1[0] = __uint_as_float(w.z << 16); v1[1] = __uint_as_float(w.z & 0xffff0000u); v1[2] = __uint_as_float(w.w << 16); v1[3] = __uint_as_float(w.w & 0xffff0000u);
}
constexpr int E_MP = 16384, E_MS = 256;

struct EpiIn {
    static constexpr bool PERM = true, AFTER_DRAIN = false;
    const float* ss; const float* rope;
    bf16_t *Q, *K, *V, *URW, *GATE;
    float *kout_p, *vout_p, *kout_s, *vout_s;
    float *sh_p, *sh_s;
    __device__ __forceinline__ void operator()(const f32x4 (&acc)[2][2][4][2], const Unit& u, int wr, int wc, int fr, int fq) const {
        const int pn = u.pn, rowb = u.pm * BM + wr * 64 + fr, cl = wc * 32 + 8 * fq;
        const bool rope_wave = (pn < 8) && ((wc & 1) == 0);
        const float sgn = (fq == 0) ? -1.f : 1.f;
#pragma unroll
        for (int ai = 0; ai < 2; ++ai)
#pragma unroll
            for (int m = 0; m < 4; ++m) {
                const int row = rowb + ai * HALF + m * 16;
                const float rstd = 1.0f / sqrtf(ss[row] * (1.0f / 1024.f) + 1e-6f);
                const bool smp = row >= E_MP;
                const int t = smp ? ((row - E_MP) & 31) : (row & 2047);
                const int bb = smp ? ((row - E_MP) >> 5) : (row >> 11);
                const int pos = smp ? 2048 + t : t;
                const bool last = smp ? (t == 31) : (t == 2047);
#pragma unroll
                for (int bj = 0; bj < 2; ++bj) {
                    f32x4 v0 = acc[ai][bj][m][0] * rstd, v1 = acc[ai][bj][m][1] * rstd;
                    const int col = pn * BM + bj * HALF + cl;
                    if (pn < 8) {
                        if (rope_wave) {
                            f32x4 p0, p1;
#pragma unroll
                            for (int j = 0; j < 4; ++j) { p0[j] = __shfl_xor(v0[j], 16); p1[j] = __shfl_xor(v1[j], 16); }
                            if (fq < 2) {
                                const float* tb = rope + pos * 16;
                                const f32x4 c0 = *(const f32x4*)(tb), c1 = *(const f32x4*)(tb + 4), s0 = *(const f32x4*)(tb + 8), s1 = *(const f32x4*)(tb + 12);
                                v0 = v0 * c0 + (p0 * s0) * sgn; v1 = v1 * c1 + (p1 * s1) * sgn;
                            }
                        }
                        if (pn < 4) { v0 = v0 * C2; v1 = v1 * C2; *(u32x4*)(Q + (size_t)row * 1024 + col) = pack8(v0, v1); }
                        else {
                            const int c = col - 1024;
                            *(u32x4*)(K + (size_t)row * 1024 + c) = pack8(v0, v1);
                            float* o = smp ? kout_s + (size_t)(row - E_MP) * 1024 + c : kout_p + (size_t)row * 1024 + c;
                            *(f32x4*)o = v0; *(f32x4*)(o + 4) = v1;
                        }
                    } else if (pn < 12) {
                        const int c = col - 2048;
                        *(u32x4*)(V + (size_t)row * 1024 + c) = pack8(v0, v1);
                        float* o = smp ? vout_s + (size_t)(row - E_MP) * 1024 + c : vout_p + (size_t)row * 1024 + c;
                        *(f32x4*)o = v0; *(f32x4*)(o + 4) = v1;
                    } else if (pn < 25) {
                        const int c = col - 3072;
                        *(u32x4*)(URW + (size_t)row * 3328 + c) = pack8(v0, v1);
                        if (last) { float* o = (smp ? sh_s : sh_p) + (size_t)bb * 3328 + c; *(f32x4*)o = v0; *(f32x4*)(o + 4) = v1; }
                    } else {
                        const int c = col - 6400;
#pragma unroll
                        for (int j = 0; j < 4; ++j) { v0[j] = fast_sigmoid(v0[j]); v1[j] = fast_sigmoid(v1[j]); }
                        *(u32x4*)(GATE + (size_t)row * 2048 + c) = pack8(v0, v1);
                    }
                }
            }
    }
};

struct EpiLora {
    static constexpr bool PERM = true, AFTER_DRAIN = false;
    const float *w0, *a0; bf16_t *LD, *LA, *LG;
    __device__ __forceinline__ void operator()(const f32x4 (&acc)[2][2][4][2], const Unit& u, int wr, int wc, int fr, int fq) const {
        const int pn = u.pn, rowb = u.pm * BM + wr * 64 + fr, cl = wc * 32 + 8 * fq;
        const int seg = pn >> 2;
#pragma unroll
        for (int bj = 0; bj < 2; ++bj) {
            const int c = (pn & 3) * BM + bj * HALF + cl;
            f32x4 b0 = (f32x4){0.f, 0.f, 0.f, 0.f}, b1 = b0;
            if (seg == 0) { b0 = *(const f32x4*)(w0 + c); b1 = *(const f32x4*)(w0 + c + 4); }
            else if (seg == 1) { b0 = *(const f32x4*)(a0 + c); b1 = *(const f32x4*)(a0 + c + 4); }
#pragma unroll
            for (int ai = 0; ai < 2; ++ai)
#pragma unroll
                for (int m = 0; m < 4; ++m) {
                    const int row = rowb + ai * HALF + m * 16;
                    f32x4 v0 = acc[ai][bj][m][0] + b0, v1 = acc[ai][bj][m][1] + b1;
                    if (seg == 0) {
#pragma unroll
                        for (int j = 0; j < 4; ++j) { v0[j] = neg_decay_log(v0[j]); v1[j] = neg_decay_log(v1[j]); }
                        *(u32x4*)(LD + (size_t)row * 1024 + c) = pack8(v0, v1);
                    } else if (seg == 1) {
#pragma unroll
                        for (int j = 0; j < 4; ++j) { v0[j] = fast_sigmoid(v0[j]); v1[j] = fast_sigmoid(v1[j]); }
                        *(u32x4*)(LA + (size_t)row * 1024 + c) = pack8(v0, v1);
                    } else {
                        *(u32x4*)(LG + (size_t)row * 1024 + c) = pack8(v0, v1);
                    }
                    asm volatile("" ::: "memory");
                }
        }
    }
};

struct EpiGated {
    static constexpr bool PERM = true, AFTER_DRAIN = false;
    const bf16_t* G; int goff; const bf16_t* S; bf16_t* O;
    __device__ __forceinline__ void operator()(const f32x4 (&acc)[2][2][4][2], const Unit& u, int wr, int wc, int fr, int fq) const {
        const int rowb = u.pm * BM + wr * 64 + fr, cl = u.pn * BM + wc * 32 + 8 * fq;
#pragma unroll
        for (int ai = 0; ai < 2; ++ai)
#pragma unroll
            for (int m = 0; m < 4; ++m) {
                const int row = rowb + ai * HALF + m * 16;
#pragma unroll
                for (int bj = 0; bj < 2; ++bj) {
                    const int c = cl + bj * HALF;
                    f32x4 g0, g1; unpack8(*(const u32x4*)(G + (size_t)row * 2048 + goff + c), g0, g1);
                    f32x4 v0 = acc[ai][bj][m][0] * g0, v1 = acc[ai][bj][m][1] * g1;
                    if (S) { f32x4 s0, s1; unpack8(*(const u32x4*)(S + (size_t)row * 1024 + c), s0, s1); v0 += s0; v1 += s1; }
                    *(u32x4*)(O + (size_t)row * 1024 + c) = pack8(v0, v1);
                }
            }
    }
};

struct EpiRes {
    static constexpr bool PERM = true, AFTER_DRAIN = false;
    float* X; bf16_t* XB; float* SS;
    __device__ __forceinline__ void operator()(const f32x4 (&acc)[2][2][4][2], const Unit& u, int wr, int wc, int fr, int fq) const {
        const int rowb = u.pm * BM + wr * 64 + fr, cl = u.pn * BM + wc * 32 + 8 * fq;
#pragma unroll
        for (int ai = 0; ai < 2; ++ai)
#pragma unroll
            for (int m = 0; m < 4; ++m) {
                const int row = rowb + ai * HALF + m * 16;
                float sq = 0.f;
#pragma unroll
                for (int bj = 0; bj < 2; ++bj) {
                    const int c = cl + bj * HALF;
                    float* xp = X + (size_t)row * 1024 + c;
                    const f32x4 v0 = *(const f32x4*)xp + acc[ai][bj][m][0], v1 = *(const f32x4*)(xp + 4) + acc[ai][bj][m][1];
                    *(f32x4*)xp = v0; *(f32x4*)(xp + 4) = v1;
                    *(u32x4*)(XB + (size_t)row * 1024 + c) = pack8(v0, v1);
                    sq += (v0[0] * v0[0] + v0[1] * v0[1]) + (v0[2] * v0[2] + v0[3] * v0[3]) + (v1[0] * v1[0] + v1[1] * v1[1]) + (v1[2] * v1[2] + v1[3] * v1[3]);
                }
                sq += __shfl_xor(sq, 16); sq += __shfl_xor(sq, 32);
                if (fq == 0) atomicAdd(SS + row, sq);
            }
    }
};

struct EpiUp {
    static constexpr bool PERM = true, AFTER_DRAIN = false;
    const float* ss; bf16_t* UP; float *cv_p, *cv_s;
    __device__ __forceinline__ void operator()(const f32x4 (&acc)[2][2][4][2], const Unit& u, int wr, int wc, int fr, int fq) const {
        const int rowb = u.pm * BM + wr * 64 + fr, cl = u.pn * BM + wc * 32 + 8 * fq;
#pragma unroll
        for (int ai = 0; ai < 2; ++ai)
#pragma unroll
            for (int m = 0; m < 4; ++m) {
                const int row = rowb + ai * HALF + m * 16;
                const float rstd = 1.0f / sqrtf(ss[row] * (1.0f / 1024.f) + 1e-6f);
                const bool smp = row >= E_MP;
                const int t = smp ? ((row - E_MP) & 31) : (row & 2047);
                const int bb = smp ? ((row - E_MP) >> 5) : (row >> 11);
                const int slot = smp ? t - 30 : t - 2046;
#pragma unroll
                for (int bj = 0; bj < 2; ++bj) {
                    const int c = cl + bj * HALF;
                    const f32x4 v0 = acc[ai][bj][m][0] * rstd, v1 = acc[ai][bj][m][1] * rstd;
                    *(u32x4*)(UP + (size_t)row * 5632 + c) = pack8(v0, v1);
                    if (slot >= 0) { float* o = (smp ? cv_s : cv_p) + ((size_t)bb * 2 + slot) * 5632 + c; *(f32x4*)o = v0; *(f32x4*)(o + 4) = v1; }
                }
            }
    }
};

template <class Epi, class Sched, bool ALIGN_EPI = false, bool SP2 = false>
__device__ __forceinline__ void gemm_phase(PG8_LAS unsigned char* lds, const Gemm g, const Sched& S, const Epi& E) {
    int tid_ = threadIdx.x; asm volatile("" : "+v"(tid_));
    const int tid = tid_, wid = __builtin_amdgcn_readfirstlane(tid >> 6), lane = tid & 63, wr = wid >> 2, wc = wid & 3, fr = lane & 15, fq = lane >> 4;
    const int K = g.K, nt = K / BK;
    unsigned voffA[2], voffB[2];
#pragma unroll
    for (int i = 0; i < 2; ++i) { int R, C; stage_rc(tid * 16 + i * 8192, R, C); const int Rb = Epi::PERM ? ((R & ~31) + perm32(R & 31)) : R;
        voffA[i] = (unsigned)(R * K + C) * 2u; voffB[i] = (unsigned)(Rb * K + C) * 2u; }
    const size_t kstep = (size_t)(BK * 2);
    const size_t hstep = (size_t)HALF * K * 2;
    const size_t tstep = 2 * hstep;
    const unsigned ldsw = (unsigned)wid * 1024u;
    const int aoff = lds_byte(wr * 64 + fr, fq * 8), boff = lds_byte(wc * 32 + fr, fq * 8);
#define PG8_SA(b, h) (((b) * 2 + (h)) * HTB)
#define PG8_SB(b, h) ((4 + (b) * 2 + (h)) * HTB)
#define PG8_STAGE(bufoff, gbase, voff) do { _Pragma("unroll") for (int _i = 0; _i < 2; ++_i) \
        __builtin_amdgcn_global_load_lds((const unsigned*)((const char*)(gbase) + (voff)[_i]), (PG8_LAS unsigned*)(lds + (bufoff) + ldsw + _i * 8192), 16, 0, 0); } while (0)
#define PG8_LDA(dst, b, h) do { _Pragma("unroll") for (int m = 0; m < 4; ++m) _Pragma("unroll") for (int k = 0; k < 2; ++k) dst[m][k] = *(const PG8_LAS bf16x8*)(lds + PG8_SA(b, h) + aoff + m * 2048 + k * 1024); } while (0)
#define PG8_LDB(dst, b, h) do { _Pragma("unroll") for (int n = 0; n < 2; ++n) _Pragma("unroll") for (int k = 0; k < 2; ++k) dst[n][k] = *(const PG8_LAS bf16x8*)(lds + PG8_SB(b, h) + boff + n * 2048 + k * 1024); } while (0)
#define PG8_MMA(ai, bj, At, Bt) do { __builtin_amdgcn_s_setprio(1); _Pragma("unroll") for (int m = 0; m < 4; ++m) _Pragma("unroll") for (int n = 0; n < 2; ++n) _Pragma("unroll") for (int k = 0; k < 2; ++k) \
        acc[ai][bj][m][n] = __builtin_amdgcn_mfma_f32_16x16x32_bf16(Bt[n][k], At[m][k], acc[ai][bj][m][n], 0, 0, 0); __builtin_amdgcn_s_setprio(0); } while (0)
#define PG8_WAIT_V(n) asm volatile("s_waitcnt vmcnt(" #n ")" ::: "memory")
#define PG8_WAIT_L(n) asm volatile("s_waitcnt lgkmcnt(" #n ")" ::: "memory")
#define PG8_BAR __builtin_amdgcn_s_barrier()
#define PG8_SCHED __builtin_amdgcn_sched_barrier(0)
    Unit cur, nxt; int ui = 0;
    if (!S.next(0, cur)) return;
    f32x4 acc[2][2][4][2];
#pragma unroll
    for (int a = 0; a < 2; ++a)
#pragma unroll
        for (int b = 0; b < 2; ++b)
#pragma unroll
            for (int m = 0; m < 4; ++m)
#pragma unroll
                for (int n = 0; n < 2; ++n) acc[a][b][m][n] = (f32x4){0.f, 0.f, 0.f, 0.f};
    bf16x8 At[4][2], B0[2][2], B1[2][2];
    const char* cA = (const char*)g.A + (size_t)cur.pm * tstep; const char* cB = (const char*)g.Bt + (size_t)cur.pn * tstep;
    S.a_ready(cur);
    if constexpr (SP2) {
        PG8_STAGE(PG8_SB(0, 0), cB, voffB); PG8_STAGE(PG8_SB(0, 1), cB + hstep, voffB); PG8_STAGE(PG8_SA(0, 0), cA, voffA); PG8_STAGE(PG8_SA(0, 1), cA + hstep, voffA);
        if (wr == 1) PG8_BAR;
        PG8_WAIT_V(2); PG8_BAR;
        PG8_STAGE(PG8_SB(1, 0), cB + kstep, voffB); PG8_STAGE(PG8_SA(1, 0), cA + kstep, voffA); PG8_STAGE(PG8_SB(1, 1), cB + hstep + kstep, voffB);
        PG8_WAIT_V(6); PG8_BAR;
    } else {
        PG8_STAGE(PG8_SB(0, 0), cB, voffB); PG8_STAGE(PG8_SA(0, 0), cA, voffA); PG8_STAGE(PG8_SB(0, 1), cB + hstep, voffB); PG8_STAGE(PG8_SA(0, 1), cA + hstep, voffA);
        if (wr == 1) PG8_BAR;
        PG8_WAIT_V(4); PG8_BAR;
        PG8_STAGE(PG8_SB(1, 0), cB + kstep, voffB); PG8_STAGE(PG8_SA(1, 0), cA + kstep, voffA); PG8_STAGE(PG8_SB(1, 1), cB + hstep + kstep, voffB);
        PG8_WAIT_V(6); PG8_BAR;
    }
    for (;;) {
        const bool has_next = S.next(ui + 1, nxt);
        const char* nA = has_next ? (const char*)g.A + (size_t)nxt.pm * tstep : cA; const char* nB = has_next ? (const char*)g.Bt + (size_t)nxt.pn * tstep : cB;
        for (int t = 0; t < nt; t += 2) {
            const bool last = (t == nt - 2);
            const char* a1 = cA + (size_t)(t + 1) * kstep;
            const char* a2 = last ? nA : cA + (size_t)(t + 2) * kstep; const char* b2 = last ? nB : cB + (size_t)(t + 2) * kstep;
            const char* a3 = a2 + kstep; const char* b3 = b2 + kstep;
            if (last && has_next) S.a_ready(nxt);
            if constexpr (SP2) {
            PG8_LDB(B0, 0, 0); PG8_LDB(B1, 0, 1); PG8_SCHED; PG8_LDA(At, 0, 0); PG8_STAGE(PG8_SA(1, 1), a1 + hstep, voffA);
            PG8_WAIT_V(8); PG8_WAIT_L(0); PG8_BAR; PG8_MMA(0, 0, At, B0); PG8_MMA(0, 1, At, B1); PG8_BAR; PG8_SCHED;
            PG8_LDA(At, 0, 1); PG8_STAGE(PG8_SB(0, 0), b2, voffB); PG8_STAGE(PG8_SB(0, 1), b2 + hstep, voffB); PG8_STAGE(PG8_SA(0, 0), a2, voffA);
            PG8_WAIT_V(8); PG8_WAIT_L(0); PG8_BAR; PG8_MMA(1, 0, At, B0); PG8_MMA(1, 1, At, B1); PG8_BAR; PG8_SCHED;
            PG8_LDB(B0, 1, 0); PG8_LDB(B1, 1, 1); PG8_SCHED; PG8_LDA(At, 1, 0); PG8_STAGE(PG8_SA(0, 1), a2 + hstep, voffA);
            PG8_WAIT_V(8); PG8_WAIT_L(0); PG8_BAR; PG8_MMA(0, 0, At, B0); PG8_MMA(0, 1, At, B1); PG8_BAR; PG8_SCHED;
            PG8_LDA(At, 1, 1); PG8_STAGE(PG8_SB(1, 0), b3, voffB); PG8_STAGE(PG8_SB(1, 1), b3 + hstep, voffB); PG8_STAGE(PG8_SA(1, 0), a3, voffA);
            PG8_WAIT_V(8); PG8_WAIT_L(0); PG8_BAR; PG8_MMA(1, 0, At, B0); PG8_MMA(1, 1, At, B1); PG8_BAR; PG8_SCHED;
            } else {
            PG8_LDB(B0, 0, 0); PG8_SCHED; PG8_LDA(At, 0, 0); PG8_STAGE(PG8_SA(1, 1), a1 + hstep, voffA);
            PG8_WAIT_L(8); PG8_BAR; PG8_WAIT_L(0); PG8_MMA(0, 0, At, B0); PG8_BAR; PG8_SCHED;
            PG8_LDB(B1, 0, 1); PG8_STAGE(PG8_SB(0, 0), b2, voffB);
            PG8_BAR; PG8_WAIT_L(0); PG8_MMA(0, 1, At, B1); PG8_BAR;
            PG8_LDA(At, 0, 1); PG8_STAGE(PG8_SA(0, 0), a2, voffA);
            PG8_BAR; PG8_WAIT_L(0); PG8_MMA(1, 0, At, B0); PG8_BAR; PG8_SCHED;
            PG8_STAGE(PG8_SB(0, 1), b2 + hstep, voffB);
            PG8_WAIT_V(6); PG8_BAR; PG8_MMA(1, 1, At, B1); PG8_BAR;
            PG8_LDB(B0, 1, 0); PG8_SCHED; PG8_LDA(At, 1, 0); PG8_STAGE(PG8_SA(0, 1), a2 + hstep, voffA);
            PG8_WAIT_L(8); PG8_BAR; PG8_WAIT_L(0); PG8_MMA(0, 0, At, B0); PG8_BAR; PG8_SCHED;
            PG8_LDB(B1, 1, 1); PG8_STAGE(PG8_SB(1, 0), b3, voffB);
            PG8_BAR; PG8_WAIT_L(0); PG8_MMA(0, 1, At, B1); PG8_BAR;
            PG8_LDA(At, 1, 1); PG8_STAGE(PG8_SA(1, 0), a3, voffA);
            PG8_BAR; PG8_WAIT_L(0); PG8_MMA(1, 0, At, B0); PG8_BAR; PG8_SCHED;
            PG8_STAGE(PG8_SB(1, 1), b3 + hstep, voffB);
            PG8_WAIT_V(6); PG8_BAR; PG8_MMA(1, 1, At, B1); PG8_BAR;
            }
        }
        if constexpr (ALIGN_EPI) { if (wr == 0) PG8_BAR; }
        if constexpr (!Epi::AFTER_DRAIN) { E(acc, cur, wr, wc, fr, fq); S.done(cur); }
        if (!has_next) break;
#pragma unroll
        for (int a = 0; a < 2; ++a)
#pragma unroll
            for (int b = 0; b < 2; ++b)
#pragma unroll
                for (int m = 0; m < 4; ++m)
#pragma unroll
                    for (int n = 0; n < 2; ++n) acc[a][b][m][n] = (f32x4){0.f, 0.f, 0.f, 0.f};
        cur = nxt; cA = nA; cB = nB; ++ui;
        if constexpr (ALIGN_EPI) { if (wr == 1) PG8_BAR; }
    }
    PG8_WAIT_V(0);
    if constexpr (!ALIGN_EPI) { if (wr == 0) PG8_BAR; }
    PG8_BAR;
    if constexpr (Epi::AFTER_DRAIN) { E.fused(acc, cur, wr, wc, fr, fq, lds, wid, lane); S.done(cur); }
#undef PG8_SA
#undef PG8_SB
#undef PG8_STAGE
#undef PG8_LDA
#undef PG8_LDB
#undef PG8_MMA
#undef PG8_WAIT_V
#undef PG8_WAIT_L
#undef PG8_BAR
#undef PG8_SCHED
}
}

constexpr int NWAVES = 8;
constexpr size_t MiB = 1u << 20;
constexpr size_t WS_CTL = 0, CTL_ZERO_BYTES = 2 * MiB;
constexpr size_t WS_ROPE = 2 * MiB;
constexpr size_t WS_SP = WS_ROPE + 256 * 1024;
constexpr size_t WS_W = 8 * MiB;
constexpr size_t W_IN = 0, W_ODA = W_IN + (size_t)P_TOTAL * 1024 * 2, W_ORW = W_ODA + 2 * MiB, W_OUT = W_ORW + 2 * MiB, W_UP = W_OUT + 2 * MiB,
                 W_DN = W_UP + (size_t)UPW * 1024 * 2, W_LORA = W_DN + (size_t)1024 * D_FF * 2, W_LAYER = W_LORA + (size_t)3072 * 256 * 2;
static_assert(W_LAYER == 42467328, "weights per layer");
constexpr size_t WS_XB = WS_W + 2 * W_LAYER + (MiB - (2 * W_LAYER) % MiB) % MiB;
constexpr size_t ACT = (size_t)MT * 1024 * 2;
constexpr size_t WS_POOL = WS_XB + ACT;
constexpr size_t B_Q = WS_POOL, B_K = B_Q + ACT, B_V = B_K + ACT, B_OC = B_V + ACT  , B_OA = B_OC + 2 * ACT, B_URW = B_OA + ACT, B_GATE = B_URW + (size_t)MT * P_RW * 2,
                 B_END = B_GATE + (size_t)MT * 2048 * 2;
constexpr size_t B_LD = B_Q, B_LA = B_K, B_LG = B_V, B_LIN = B_END, B_ORW = B_Q;
constexpr size_t B_END2 = B_LIN + (size_t)MT * 256 * 2;
constexpr size_t B_MRG = B_URW;
constexpr size_t B_UP = WS_POOL, B_GT = B_URW;
static_assert(B_UP + (size_t)MT * UPW * 2 <= B_GT && B_GT + (size_t)MT * D_FF * 2 <= B_END, "FFN overlay");
static_assert(B_END2 <= 512 * MiB, "workspace map");
constexpr int CW_BAR = 4096;
constexpr int CW_LAM = 8192;
constexpr int CW_SS = 16384;
static_assert((CW_SS + 5 * MT) * 4 <= (int)CTL_ZERO_BYTES, "CTL region");
constexpr int RING_OFF = 0, RING_BYTES = 131072;
constexpr int LDSCTL_OFF = RING_BYTES, MISC_OFF = LDSCTL_OFF + 320;
constexpr int LDS_BYTES = 147456;

constexpr int PH_PER_LAYER = 11;
constexpr int NPHASE = 1 + DEPTH * PH_PER_LAYER + 1;
enum { K_G1 = 0, K_AT, K_CB, K_LR, K_SC, K_M1, K_M2, K_WO, K_UP, K_CV, K_DN };

#include <hip/hip_bf16.h>
#include <cmath>
namespace attn_body {
using bf16=__hip_bfloat16;
using bf16x8=__attribute__((ext_vector_type(8)))short;
using s16x4=__attribute__((ext_vector_type(4)))short;
using f32x16=__attribute__((ext_vector_type(16)))float;
using u32x4=__attribute__((ext_vector_type(4)))unsigned;
constexpr int BATCH=8,SEQ=2048,D=64,DM=1024;
constexpr int NW=8,QBLK=32,QB=QBLK*NW,KVBLK=64,NQB=SEQ/QB;
constexpr int ATTN_PITCH=DM, ATTN_UNIT_ROWS=QB;
__device__ __forceinline__ int crow(int r,int hi){return (r&3)+8*(r>>2)+4*hi;}
#define SBAR() __builtin_amdgcn_sched_barrier(0)
__device__ __forceinline__ void cmask(f32x16&p0,f32x16&p1,int jb,int wid){
  const float NEG=-INFINITY;
  if(jb>(wid>>1)){
    #pragma unroll
    for(int r=0;r<16;++r){p0[r]=NEG;p1[r]=NEG;}
  }
}

constexpr int NSLOT=3, SLOTB=8192;
constexpr int LDS_K=0, LDS_V=NSLOT*SLOTB, LDS_WS=2*NSLOT*SLOTB, LDS_OST=LDS_WS+NW*64*4, LDS_BYTES=LDS_OST+NW*4096;
constexpr float C2=0.125f*1.4426950408889634f;
__device__ __forceinline__ void glds16(const void*gsrc,unsigned lds_dst){unsigned keep;
  asm volatile("s_mov_b32 %0, m0\n\ts_mov_b32 m0, %2\n\ts_nop 0\n\tglobal_load_lds_dwordx4 %1, off\n\ts_mov_b32 m0, %0":"=&s"(keep):"v"(gsrc),"s"(lds_dst):"memory");}
__device__ __forceinline__ float max3f(float a,float b,float c){float r;asm("v_max3_f32 %0, %1, %2, %3":"=v"(r):"v"(a),"v"(b),"v"(c));return r;}
__device__ __forceinline__ float max2f(float a,float b){float r;asm("v_max_f32_e32 %0, %1, %2":"=v"(r):"v"(a),"v"(b));return r;}
__device__ __forceinline__ float fadd_s(float a,float b){float r;asm("v_add_f32_e32 %0, %1, %2":"=v"(r):"v"(a),"v"(b));return r;}
__device__ __forceinline__ float fsub_s(float a,float b){float r;asm("v_sub_f32_e32 %0, %1, %2":"=v"(r):"v"(a),"v"(b));return r;}
typedef float f32x2_t __attribute__((ext_vector_type(2))); typedef __bf16 bf16x2_t __attribute__((ext_vector_type(2)));
__device__ __forceinline__ unsigned cvtpk_s(float lo,float hi){f32x2_t v={lo,hi};bf16x2_t b=__builtin_convertvector(v,bf16x2_t);return __builtin_bit_cast(unsigned,b);}
#define WAIT_BAR(N) asm volatile("s_waitcnt vmcnt(" #N ") lgkmcnt(0)\n\ts_barrier":::"memory")

__device__ __forceinline__ void qkt(f32x16&p0,f32x16&p1,const char*Kslot,const bf16x8*qr,const f32x16&negm,int r32,int hi){
  const char*kb=Kslot+hi*1024+r32*16;
  #pragma unroll
  for(int d0=0;d0<4;++d0){
    const bf16x8 b0=*reinterpret_cast<const bf16x8*>(kb+d0*2048);
    const bf16x8 b1=*reinterpret_cast<const bf16x8*>(kb+d0*2048+512);
    if(d0==0){p0=__builtin_amdgcn_mfma_f32_32x32x16_bf16(b0,qr[0],negm,0,0,0);p1=__builtin_amdgcn_mfma_f32_32x32x16_bf16(b1,qr[0],negm,0,0,0);}
    else{p0=__builtin_amdgcn_mfma_f32_32x32x16_bf16(b0,qr[d0],p0,0,0,0);p1=__builtin_amdgcn_mfma_f32_32x32x16_bf16(b1,qr[d0],p1,0,0,0);}}
}
typedef __attribute__((address_space(3))) const char* lds_cptr;
typedef short v4i16_t __attribute__((ext_vector_type(4)));
__device__ __forceinline__ void kload8(bf16x8*kf,lds_cptr kp){
  kf[0]=*(const __attribute__((address_space(3))) bf16x8*)(kp);      kf[1]=*(const __attribute__((address_space(3))) bf16x8*)(kp+512);
  kf[2]=*(const __attribute__((address_space(3))) bf16x8*)(kp+2048); kf[3]=*(const __attribute__((address_space(3))) bf16x8*)(kp+2560);
  kf[4]=*(const __attribute__((address_space(3))) bf16x8*)(kp+4096); kf[5]=*(const __attribute__((address_space(3))) bf16x8*)(kp+4608);
  kf[6]=*(const __attribute__((address_space(3))) bf16x8*)(kp+6144); kf[7]=*(const __attribute__((address_space(3))) bf16x8*)(kp+6656);
}
__device__ __forceinline__ void kload2(bf16x8*kf,lds_cptr kp,int j){ kf[2*j]=*(const __attribute__((address_space(3))) bf16x8*)(kp+j*2048); kf[2*j+1]=*(const __attribute__((address_space(3))) bf16x8*)(kp+j*2048+512); }
__device__ __forceinline__ s16x4 vtr(lds_cptr p){ return __builtin_bit_cast(s16x4,__builtin_amdgcn_ds_read_tr16_b64_v4i16((__attribute__((address_space(3))) v4i16_t*)p)); }
__device__ __forceinline__ float rowmax(const f32x16&p0,const f32x16&p1){
  float a=max3f(p0[0],p0[1],p1[0]),b=max3f(p0[2],p0[3],p1[1]);a=max3f(a,p1[2],p1[3]);
  #pragma unroll
  for(int r=4;r<16;r+=4){a=max3f(a,p0[r],p0[r+1]);b=max3f(b,p0[r+2],p0[r+3]);a=max3f(a,p1[r],p1[r+1]);b=max3f(b,p1[r+2],p1[r+3]);}
  const float m=max2f(a,b);
  auto rr=__builtin_amdgcn_permlane32_swap(__float_as_uint(m),__float_as_uint(m),false,false);
  return max2f(__uint_as_float(rr[0]),__uint_as_float(rr[1]));
}
__device__ __forceinline__ void pv(f32x16*o,int vb,bf16x8 pa0,bf16x8 pa1,bf16x8 pa2,bf16x8 pa3){
  #pragma unroll
  for(int d0=0;d0<2;++d0){s16x4 lo[4],hi[4];
    #pragma unroll
    for(int ks=0;ks<4;++ks){
      asm volatile("ds_read_b64_tr_b16 %0,%1 offset:%c2":"=&v"(lo[ks]):"v"(vb),"i"(d0*4096+ks*1024):"memory");
      asm volatile("ds_read_b64_tr_b16 %0,%1 offset:%c2":"=&v"(hi[ks]):"v"(vb),"i"(d0*4096+ks*1024+512):"memory");}
    asm volatile("s_waitcnt lgkmcnt(0)":::"memory");SBAR();
    #define PK(k) (bf16x8){lo[k][0],lo[k][1],lo[k][2],lo[k][3],hi[k][0],hi[k][1],hi[k][2],hi[k][3]}
    o[d0]=__builtin_amdgcn_mfma_f32_32x32x16_bf16(pa0,PK(0),o[d0],0,0,0);
    o[d0]=__builtin_amdgcn_mfma_f32_32x32x16_bf16(pa1,PK(1),o[d0],0,0,0);
    o[d0]=__builtin_amdgcn_mfma_f32_32x32x16_bf16(pa2,PK(2),o[d0],0,0,0);
    o[d0]=__builtin_amdgcn_mfma_f32_32x32x16_bf16(pa3,PK(3),o[d0],0,0,0);
    #undef PK
  }
}

#ifndef ATTN_STORE16
#define ATTN_STORE16(p,v) (*(u32x4*)(p)=(v))
#endif
template<int THRL> __device__ __forceinline__ void attn_unit(int b,int qcol,int vcol,int qb,const bf16*Q,const bf16*K,const bf16*V,bf16*O,char*shm){
  const int tid=threadIdx.x,lane=tid&63,r32=lane&31,hi=lane>>5; const int wid=__builtin_amdgcn_readfirstlane(tid>>6);
  const long rowbase=(long)b*SEQ; const int q0=qb*QB;
  const bf16*Qw=Q+(rowbase+q0+wid*QBLK)*DM+qcol;
  const bf16*Kh=K+rowbase*DM+qcol,*Vh=V+rowbase*DM+vcol;
  const unsigned lds0=(unsigned)(uintptr_t)shm;
  float*wsf=(float*)(shm+LDS_WS)+wid*64;
  const bf16*ksrc=Kh+(long)lane*DM+wid*8;
  const bf16*vsrc=Vh+(long)(16*(wid&3)+(lane>>2))*DM+(wid>>2)*32+(lane&3)*8;
  const unsigned kdst=lds0+LDS_K+wid*1024, vdst=lds0+LDS_V+wid*1024;
  #define DMA_K(t,slot) glds16(ksrc+(long)(t)*KVBLK*DM,(unsigned)__builtin_amdgcn_readfirstlane(kdst+(slot)))
  #define DMA_V(t,slot) glds16(vsrc+(long)(t)*KVBLK*DM,(unsigned)__builtin_amdgcn_readfirstlane(vdst+(slot)))
  const int vb0=(int)(lds0+LDS_V)+((lane>>4)&1)*32+(lane&3)*8+(4*hi+((lane&15)>>2))*64;
  const char*Kbase=shm+LDS_K; bf16x8 kf[8];
  const lds_cptr shm3=(lds_cptr)shm; const lds_cptr kp0=shm3+LDS_K+hi*1024+r32*16; const lds_cptr vp0=shm3+LDS_V+((lane>>4)&1)*32+(lane&3)*8+(4*hi+((lane&15)>>2))*64;
  const int NT=(q0+QB)/KVBLK;
  DMA_K(0,0);DMA_V(0,0);DMA_K(1,SLOTB);
  bf16x8 qr[4];
  #pragma unroll
  for(int d0=0;d0<4;++d0)qr[d0]=*reinterpret_cast<const bf16x8*>(&Qw[(long)r32*DM+d0*16+hi*8]);
  float mhat=0.f,l_reg=0.f;f32x16 o[2];o[0]=f32x16{};o[1]=f32x16{};const f32x16 zc=f32x16{}; float nm=0.f;
  const int qrel=wid*QBLK+r32;
  #define CMASK(P0,P1,t) do{int jb_=(t)-(NT-4); if(jb_>=0)cmask(P0,P1,jb_,wid);}while(0)
  bool resc=false;
  #define START(P0,P1) do{ const float rm=rowmax(P0,P1); resc=false; \
    { const float dl=rm; mhat=fadd_s(mhat,dl); \
      _Pragma("unroll") for(int r=0;r<16;++r){P0[r]=fsub_s(P0[r],dl);P1[r]=fsub_s(P1[r],dl);} \
      nm=-mhat; } \
    _Pragma("unroll") for(int r=0;r<16;++r)P0[r]=__builtin_amdgcn_exp2f(P0[r]); }while(0)
  #define RESC() do{ if(resc){ asm volatile("s_waitcnt lgkmcnt(0)":::"memory"); \
      _Pragma("unroll") for(int d_=0;d_<2;++d_) _Pragma("unroll") for(int r=0;r<16;++r)o[d_][r]*=wsf[crow(r,hi)]; } }while(0)
  f32x16 pA0,pA1,pB0,pB1;
  int sl_prev=0,sl_cur=0,sl_next=SLOTB;
  #define ROT() do{sl_prev=sl_cur;sl_cur=sl_next;sl_next=(sl_next==(NSLOT-1)*SLOTB)?0:sl_next+SLOTB;}while(0)
  DMA_K(2,2*SLOTB);
  WAIT_BAR(3);
  qkt(pA0,pA1,Kbase,qr,zc,r32,hi);asm volatile("s_nop 15\n\ts_nop 7":"+v"(pA0),"+v"(pA1));CMASK(pA0,pA1,0);
  START(pA0,pA1);
  _Pragma("unroll") for(int r=0;r<16;++r)pA1[r]=__builtin_amdgcn_exp2f(pA1[r]);
  WAIT_BAR(0);
  DMA_K(3,0);DMA_V(1,SLOTB);
  ROT();
  kload8(kf,kp0+sl_cur);
  WAIT_BAR(2);
  s16x4 vlo[8],vhi[8]; u32x4 pw0,pw1,pw2,pw3;
  #define PKW(P,B) cvtpk_s(P[B],P[B+1])
  #define PAF(k) __builtin_bit_cast(bf16x8,pw##k)
  #define VFR(i) (bf16x8){vlo[i][0],vlo[i][1],vlo[i][2],vlo[i][3],vhi[i][0],vhi[i][1],vhi[i][2],vhi[i][3]}
  #define PIN(x) asm volatile("":"+v"(x))
  #define MX3(a,b,c) __builtin_fmaxf(__builtin_fmaxf((a),(b)),(c))
  #define GAPA(MF,A0,A1,A2,A3,W0,W1,PW) do{ MF; sacc+=A0; sacc+=A1; sacc+=A2; sacc+=A3; PIN(sacc); W0; W1; PIN(PW); SBAR(); }while(0)
  #define EX(v) __builtin_amdgcn_exp2f(v)
  #define GAPB(MF,X,B) do{ MF; X[B]=EX(X[B]); X[B+1]=EX(X[B+1]); X[B+2]=EX(X[B+2]); X[B+3]=EX(X[B+3]); PIN(X); SBAR(); }while(0)
  #define VRD(i) do{ vlo[i]=vtr(vp_+(((i)>>2)*4096+((i)&3)*1024)); vhi[i]=vtr(vp_+(((i)>>2)*4096+((i)&3)*1024+512)); }while(0)
  #define KRD(G,j) do{ if(G){ kload2(kf,kp0+sl_next,j); SBAR(); } }while(0)
  #define STEP(C0,C1,P0,P1,t,GK,GV,GL) do{ SBAR(); \
    const lds_cptr vp_=vp0+sl_prev; \
    VRD(0); SBAR(); float sacc=(P0[0]+P0[1]); \
    GAPA(C0=__builtin_amdgcn_mfma_f32_32x32x16_bf16(kf[0],qr[0],zc,0,0,0), P0[2],P0[3],P0[4],P0[5],     pw0[0]=PKW(P0,0), pw0[1]=PKW(P0,2), pw0); \
    VRD(4); SBAR(); GAPA(C1=__builtin_amdgcn_mfma_f32_32x32x16_bf16(kf[1],qr[0],zc,0,0,0), P0[6],P0[7],P0[8],P0[9],     pw0[2]=PKW(P0,4), pw0[3]=PKW(P0,6), pw0); \
    VRD(1); SBAR(); GAPA(C0=__builtin_amdgcn_mfma_f32_32x32x16_bf16(kf[2],qr[1],C0,0,0,0),   P0[10],P0[11],P0[12],P0[13], pw1[0]=PKW(P0,8), pw1[1]=PKW(P0,10), pw1); \
    VRD(5); SBAR(); GAPA(C1=__builtin_amdgcn_mfma_f32_32x32x16_bf16(kf[3],qr[1],C1,0,0,0),   P0[14],P0[15],P1[0],P1[1],   pw1[2]=PKW(P0,12),pw1[3]=PKW(P0,14), pw1); \
    VRD(2); SBAR(); GAPA(C0=__builtin_amdgcn_mfma_f32_32x32x16_bf16(kf[4],qr[2],C0,0,0,0),   P1[2],P1[3],P1[4],P1[5],     pw2[0]=PKW(P1,0), pw2[1]=PKW(P1,2), pw2); \
    VRD(6); SBAR(); GAPA(C1=__builtin_amdgcn_mfma_f32_32x32x16_bf16(kf[5],qr[2],C1,0,0,0),   P1[6],P1[7],P1[8],P1[9],     pw2[2]=PKW(P1,4), pw2[3]=PKW(P1,6), pw2); \
    VRD(3); SBAR(); GAPA(C0=__builtin_amdgcn_mfma_f32_32x32x16_bf16(kf[6],qr[3],C0,0,0,0),   P1[10],P1[11],P1[12],P1[13], pw3[0]=PKW(P1,8), pw3[1]=PKW(P1,10), pw3); \
    VRD(7); SBAR(); GAPA(C1=__builtin_amdgcn_mfma_f32_32x32x16_bf16(kf[7],qr[3],C1,0,0,0),   P1[14],P1[15],0.f,0.f,       pw3[2]=PKW(P1,12),pw3[3]=PKW(P1,14), pw3); \
    l_reg+=sacc; \
    if(GK){DMA_K((t)+3,sl_cur);} if(GV){DMA_V((t)+1,sl_next);} \
    _Pragma("unroll") for(int r=0;r<16;++r){C0[r]+=nm;C1[r]+=nm;} \
    CMASK(C0,C1,t); \
    { float a=MX3(C0[0],C0[1],C1[0]),b=MX3(C0[2],C0[3],C1[1]); a=MX3(a,C1[2],C1[3]); \
      _Pragma("unroll") for(int r=4;r<16;r+=4){a=MX3(a,C0[r],C0[r+1]);b=MX3(b,C0[r+2],C0[r+3]);a=MX3(a,C1[r],C1[r+1]);b=MX3(b,C1[r+2],C1[r+3]);} \
      float rm=__builtin_fmaxf(a,b); { auto rr=__builtin_amdgcn_permlane32_swap(__float_as_uint(rm),__float_as_uint(rm),false,false); rm=__builtin_fmaxf(__uint_as_float(rr[0]),__uint_as_float(rr[1])); } \
      resc=false; \
      if(__builtin_expect(__any(rm>(float)THRL),0)){ const float dl=__builtin_fmaxf(rm,0.f); mhat+=dl; \
        _Pragma("unroll") for(int r=0;r<16;++r){C0[r]-=dl;C1[r]-=dl;} \
        nm=-mhat; \
        const float f=__builtin_amdgcn_exp2f(-dl); l_reg*=f; if(hi==0)wsf[r32]=f; resc=true; } } \
    SBAR(); \
    GAPB(o[0]=__builtin_amdgcn_mfma_f32_32x32x16_bf16(PAF(0),VFR(0),o[0],0,0,0), C0,0); \
    GAPB(o[1]=__builtin_amdgcn_mfma_f32_32x32x16_bf16(PAF(0),VFR(4),o[1],0,0,0), C0,4); \
    KRD(GL,0); GAPB(o[0]=__builtin_amdgcn_mfma_f32_32x32x16_bf16(PAF(1),VFR(1),o[0],0,0,0), C0,8); \
    KRD(GL,1); GAPB(o[1]=__builtin_amdgcn_mfma_f32_32x32x16_bf16(PAF(1),VFR(5),o[1],0,0,0), C0,12); \
    KRD(GL,2); GAPB(o[0]=__builtin_amdgcn_mfma_f32_32x32x16_bf16(PAF(2),VFR(2),o[0],0,0,0), C1,0); \
    KRD(GL,3); GAPB(o[1]=__builtin_amdgcn_mfma_f32_32x32x16_bf16(PAF(2),VFR(6),o[1],0,0,0), C1,4); \
    GAPB(o[0]=__builtin_amdgcn_mfma_f32_32x32x16_bf16(PAF(3),VFR(3),o[0],0,0,0), C1,8); \
    GAPB(o[1]=__builtin_amdgcn_mfma_f32_32x32x16_bf16(PAF(3),VFR(7),o[1],0,0,0), C1,12); \
    }while(0)
  int t=1;
  #undef CMASK
  #define CMASK(P0,P1,t) do{}while(0)
  for(;t+5<NT;t+=2){
    STEP(pB0,pB1,pA0,pA1,t,true,true,true);     WAIT_BAR(2); RESC(); ROT();
    STEP(pA0,pA1,pB0,pB1,t+1,true,true,true);   WAIT_BAR(2); RESC(); ROT();
  }
  #undef CMASK
  #define CMASK(P0,P1,t) do{int jb_=(t)-(NT-4); if(jb_>=0)cmask(P0,P1,jb_,wid);}while(0)
  #define ENDW(tt) do{ if((tt)+3<NT){WAIT_BAR(2);} else if((tt)+2<NT){WAIT_BAR(1);} else {WAIT_BAR(0);} }while(0)
  for(;t+1<NT;t+=2){
    STEP(pB0,pB1,pA0,pA1,t,(t+3<NT),(t+1<NT),(t+1<NT));       ENDW(t);   RESC(); ROT();
    STEP(pA0,pA1,pB0,pB1,t+1,(t+4<NT),(t+2<NT),(t+2<NT));     ENDW(t+1); RESC(); ROT();
  }
  STEP(pB0,pB1,pA0,pA1,NT-1,false,false,false); RESC();
  { float sacc=pB0[0]+pB0[1]; _Pragma("unroll") for(int r=2;r<16;++r)sacc+=pB0[r]; _Pragma("unroll") for(int r=0;r<16;++r)sacc+=pB1[r]; l_reg+=sacc;
    pw0=(u32x4){PKW(pB0,0),PKW(pB0,2),PKW(pB0,4),PKW(pB0,6)};pw1=(u32x4){PKW(pB0,8),PKW(pB0,10),PKW(pB0,12),PKW(pB0,14)};pw2=(u32x4){PKW(pB1,0),PKW(pB1,2),PKW(pB1,4),PKW(pB1,6)};pw3=(u32x4){PKW(pB1,8),PKW(pB1,10),PKW(pB1,12),PKW(pB1,14)};
    SBAR(); pv(o,vb0+sl_cur,PAF(0),PAF(1),PAF(2),PAF(3)); }
  #undef PKW
  #undef PAF
  #undef VFR
  #undef PIN
  #undef MX3
  #undef GAPA
  #undef GAPB
  #undef EX
  #undef VRD
  #undef KRD
  #undef STEP
  #undef ENDW
  {auto rr=__builtin_amdgcn_permlane32_swap(__float_as_uint(l_reg),__float_as_uint(l_reg),false,false);l_reg=__uint_as_float(rr[0])+__uint_as_float(rr[1]);}
  if(hi==0)wsf[32+r32]=l_reg;asm volatile("s_waitcnt lgkmcnt(0)":::"memory");
  float rli[16];
  #pragma unroll
  for(int r=0;r<16;++r)rli[r]=__builtin_amdgcn_rcpf(wsf[32+crow(r,hi)]);
  bf16*Ow=O+(rowbase+q0+wid*QBLK)*DM+vcol;
  { bf16*stg=(bf16*)(shm+LDS_OST)+wid*2048;
    #pragma unroll
    for(int r=0;r<16;++r){const int orow=crow(r,hi);
      #pragma unroll
      for(int d0=0;d0<2;++d0)stg[orow*64+d0*32+r32]=__float2bfloat16(o[d0][r]*rli[r]);}
    asm volatile("s_waitcnt lgkmcnt(0)":::"memory");
    #pragma unroll
    for(int i=0;i<4;++i){const int row=i*8+(lane>>3),ch=lane&7; const u32x4 v=*(const u32x4*)(stg+row*64+ch*8); ATTN_STORE16(Ow+(long)row*DM+ch*8,v);} }
  asm volatile("s_waitcnt lgkmcnt(0)\n\ts_barrier":::"memory");
  #undef DMA_K
  #undef DMA_V
  #undef CMASK
  #undef START
  #undef RESC
  #undef ROT
}
typedef float f32x4 __attribute__((ext_vector_type(4)));
constexpr int SA_K0=0, SA_K1=8192, SA_V0=16384, SA_V1=24576, SA_WS=32768, SA_BYTES=SA_WS+8*256;
__device__ __forceinline__ unsigned pk2bf(float lo,float hi){return cvtpk_s(lo,hi);}
__device__ __forceinline__ void sample_unit(int l,int b,int h,int s,const float*cache_k,const float*cache_v,const bf16*Q,const bf16*K,const bf16*V,float*SP,char*shm){
  const int tid=threadIdx.x,lane=tid&63,r32=lane&31,hi=lane>>5; const int wid=__builtin_amdgcn_readfirstlane(tid>>6);
  const unsigned lds0=(unsigned)(uintptr_t)shm;
  float*wsf=(float*)(shm+SA_WS)+wid*64;
  const int c=wid>>1,vh=wid&1;
  const int qrow=16384+b*32;
  bf16x8 qr[4];
  if(wid<4){
    #pragma unroll
    for(int d0=0;d0<4;++d0)qr[d0]=*reinterpret_cast<const bf16x8*>(&Q[(long)(qrow+r32)*DM+h*128+c*64+d0*16+hi*8]);
  }
  float m=-1e30f,lsum=0.f; f32x16 o[2]; o[0]=f32x16{}; o[1]=f32x16{};
  const f32x16 zc=f32x16{};
  const int ntile=(s==7)?5:4;
  const float*ckb=cache_k+((long)(l*8+b)*2048)*1024+h*128; const float*cvb=cache_v+((long)(l*8+b)*2048)*1024+h*128;
  for(int ti=0;ti<ntile;++ti){
    const bool fresh=(ti==4);
    #pragma unroll
    for(int pi=0;pi<2;++pi){
      const int pk=wid*2+pi;
      { const int kc=pk>>3,ch=pk&7; u32x4 wv;
        if(!fresh){ const float*src=ckb+(long)((4*s+ti)*64+lane)*1024+kc*64+ch*8; const f32x4 a=*(const f32x4*)src,bq=*(const f32x4*)(src+4);
          wv.x=pk2bf(a.x,a.y);wv.y=pk2bf(a.z,a.w);wv.z=pk2bf(bq.x,bq.y);wv.w=pk2bf(bq.z,bq.w); }
        else if(lane<32){ wv=*(const u32x4*)(K+(long)(qrow+lane)*DM+h*128+kc*64+ch*8); }
        else { wv=(u32x4){0u,0u,0u,0u}; }
        *(u32x4*)(shm+(kc?SA_K1:SA_K0)+ch*1024+lane*16)=wv; }
      { const int vv=pk>>3,p=pk&7; const int row=16*(p&3)+(lane>>2),col=vv*64+32*(p>>2)+8*(lane&3); u32x4 wv;
        if(!fresh){ const float*src=cvb+(long)((4*s+ti)*64+row)*1024+col; const f32x4 a=*(const f32x4*)src,bq=*(const f32x4*)(src+4);
          wv.x=pk2bf(a.x,a.y);wv.y=pk2bf(a.z,a.w);wv.z=pk2bf(bq.x,bq.y);wv.w=pk2bf(bq.z,bq.w); }
        else if(row<32){ wv=*(const u32x4*)(V+(long)(qrow+row)*DM+h*128+col); }
        else { wv=(u32x4){0u,0u,0u,0u}; }
        *(u32x4*)(shm+(vv?SA_V1:SA_V0)+p*1024+lane*16)=wv; }
    }
    __syncthreads();
    if(wid<4){
      f32x16 p0,p1;
      qkt(p0,p1,shm+(c?SA_K1:SA_K0),qr,zc,r32,hi);
      if(fresh){
        #pragma unroll
        for(int r=0;r<16;++r)p1[r]=-INFINITY;
      }
      float rm=p0[0];
      #pragma unroll
      for(int r=1;r<16;++r)rm=__builtin_fmaxf(rm,p0[r]);
      #pragma unroll
      for(int r=0;r<16;++r)rm=__builtin_fmaxf(rm,p1[r]);
      rm=__builtin_fmaxf(rm,__shfl_xor(rm,32));
      const float mn=__builtin_fmaxf(m,rm),alpha=__builtin_amdgcn_exp2f(m-mn);
      float ps=0.f;
      #pragma unroll
      for(int r=0;r<16;++r){p0[r]=__builtin_amdgcn_exp2f(p0[r]-mn);p1[r]=__builtin_amdgcn_exp2f(p1[r]-mn);ps+=p0[r]+p1[r];}
      lsum=lsum*alpha+ps; m=mn;
      if(hi==0)wsf[r32]=alpha;
      asm volatile("s_waitcnt lgkmcnt(0)":::"memory");
      #pragma unroll
      for(int g=0;g<4;++g){ const f32x4 f4=*(const f32x4*)(wsf+8*g+4*hi);
        #pragma unroll
        for(int i=0;i<4;++i){o[0][4*g+i]*=f4[i];o[1][4*g+i]*=f4[i];} }
      u32x4 pw0,pw1,pw2,pw3;
      pw0=(u32x4){pk2bf(p0[0],p0[1]),pk2bf(p0[2],p0[3]),pk2bf(p0[4],p0[5]),pk2bf(p0[6],p0[7])};
      pw1=(u32x4){pk2bf(p0[8],p0[9]),pk2bf(p0[10],p0[11]),pk2bf(p0[12],p0[13]),pk2bf(p0[14],p0[15])};
      pw2=(u32x4){pk2bf(p1[0],p1[1]),pk2bf(p1[2],p1[3]),pk2bf(p1[4],p1[5]),pk2bf(p1[6],p1[7])};
      pw3=(u32x4){pk2bf(p1[8],p1[9]),pk2bf(p1[10],p1[11]),pk2bf(p1[12],p1[13]),pk2bf(p1[14],p1[15])};
      const int vb=(int)(lds0+(vh?SA_V1:SA_V0))+((lane>>4)&1)*32+(lane&3)*8+(4*hi+((lane&15)>>2))*64;
      pv(o,vb,__builtin_bit_cast(bf16x8,pw0),__builtin_bit_cast(bf16x8,pw1),__builtin_bit_cast(bf16x8,pw2),__builtin_bit_cast(bf16x8,pw3));
    }
    __syncthreads();
  }
  if(wid<4){
    lsum+=__shfl_xor(lsum,32);
    float*sp=SP+((long)(((b*8+h)*2+c)*8+s)*32)*132;
    if(vh==0&&hi==0){sp[r32*132]=m;sp[r32*132+1]=lsum;}
    #pragma unroll
    for(int d0=0;d0<2;++d0)
      #pragma unroll
      for(int r=0;r<16;++r)sp[crow(r,hi)*132+4+vh*64+32*d0+r32]=o[d0][r];
  }
}
constexpr int ATTN_LDS_BYTES=LDS_BYTES;
#undef SBAR
#undef WAIT_BAR
}

#define GAS __attribute__((address_space(1)))
#define LAS __attribute__((address_space(3)))
typedef unsigned short bf16;
typedef unsigned v4u __attribute__((ext_vector_type(4)));
typedef float f32x4 __attribute__((ext_vector_type(4)));
typedef short bf16x8 __attribute__((ext_vector_type(8)));
typedef GAS unsigned gu32;
typedef GAS unsigned long long gu64;
#define RLX_AGENT __ATOMIC_RELAXED, __HIP_MEMORY_SCOPE_AGENT
#define LDS_WAIT() asm volatile("s_waitcnt lgkmcnt(0)" ::: "memory")
#define VM_WAIT() asm volatile("s_waitcnt vmcnt(0)" ::: "memory")
__device__ __forceinline__ unsigned long long rt() { return __builtin_amdgcn_s_memrealtime(); }
__device__ __forceinline__ unsigned f2bf(float f) { unsigned u = __builtin_bit_cast(unsigned, f); return (u + 0x7fffu + ((u >> 16) & 1u)) >> 16; }
__device__ __forceinline__ unsigned pk2(float lo, float hi) { return f2bf(lo) | (f2bf(hi) << 16); }

#define XB_TMO      128
#define XB_XCNT(j)  (256  + 64 * (j))
#define XB_XSUB(j)  (1280 + 64 * (j))
#define XB_XGEN(j)  (2304 + 64 * (j))
#define XB_TOP      3328
#define XB_TOPGEN   3392
#define XCD_BAR_WORDS 3456
#define XB_SPIN_CAP (1u << 22)

__device__ __forceinline__ unsigned xb_ld(unsigned* p)              { return __hip_atomic_load(p, __ATOMIC_RELAXED, __HIP_MEMORY_SCOPE_AGENT); }
__device__ __forceinline__ unsigned xb_add(unsigned* p, unsigned v) { return __hip_atomic_fetch_add(p, v, __ATOMIC_RELAXED, __HIP_MEMORY_SCOPE_AGENT); }
__device__ __forceinline__ unsigned xb_xcc_id() { return (unsigned)__builtin_amdgcn_s_getreg((3 << 11) | 20) & 0xFu; }
#define XB_SPIN(cond, bar) do { unsigned _sp = 0; while (cond) { __builtin_amdgcn_s_sleep(1); \
    if ((++_sp & 255u) == 0u) { if (xb_ld(&(bar)[XB_TMO])) break; if (_sp > XB_SPIN_CAP) { atomicAdd(&(bar)[XB_TMO], 1u); break; } } } } while (0)

struct XcdBarrier {
    unsigned* bar; unsigned x;
    volatile LAS unsigned* st;
};

__device__ __forceinline__ XcdBarrier xcd_barrier_post(unsigned* bar, volatile LAS unsigned* st) {
    XcdBarrier b; b.bar = bar; b.x = xb_xcc_id(); b.st = st;
    if (threadIdx.x == 0) (void)xb_add(&bar[XB_XCNT(b.x)], 1u);
    return b;
}
__device__ __forceinline__ void xcd_barrier_complete(unsigned* bar, unsigned x, unsigned& nloc, unsigned& nx) {
    const unsigned G = gridDim.x * gridDim.y * gridDim.z;
    unsigned sum, cnt, mine, sp = 0u;
    for (;;) {
        sum = 0u; cnt = 0u; mine = 0u;
#pragma unroll
        for (unsigned j = 0; j < 16; ++j) { const unsigned c = xb_ld(&bar[XB_XCNT(j)]); sum += c; cnt += (c > 0u) ? 1u : 0u; mine = (j == x) ? c : mine; }
        if (sum == G) break;
        __builtin_amdgcn_s_sleep(1);
        if ((++sp & 255u) == 0u) { if (xb_ld(&bar[XB_TMO])) break; if (sp > XB_SPIN_CAP) { atomicAdd(&bar[XB_TMO], 1u); break; } }
    }
    nloc = mine > 0u ? mine : 1u; nx = cnt > 0u ? cnt : 1u;
}

__device__ __forceinline__ void xcd_barrier(const XcdBarrier& b) {
    asm volatile("s_waitcnt vmcnt(0)" ::: "memory");
    __syncthreads();
    if (threadIdx.x == 0) {
        unsigned* bar = b.bar;
        __builtin_amdgcn_s_waitcnt(0);
        unsigned nloc = b.st[0], nx = b.st[1];
        if (nloc == 0u) { xcd_barrier_complete(bar, b.x, nloc, nx); b.st[0] = nloc; b.st[1] = nx; }
        const unsigned old = xb_add(&bar[XB_XSUB(b.x)], 1u);
        const unsigned gen = old / nloc;
        if (old + 1u == (gen + 1u) * nloc) {
            __builtin_amdgcn_fence(__ATOMIC_RELEASE, "agent");
            asm volatile("s_waitcnt vmcnt(0)" ::: "memory");
            const unsigned og = xb_add(&bar[XB_TOP], 1u);
            const unsigned tg = og / nx;
            if (og + 1u == (tg + 1u) * nx) xb_add(&bar[XB_TOPGEN], 1u);
            else XB_SPIN(xb_ld(&bar[XB_TOPGEN]) == tg, bar);
            __builtin_amdgcn_fence(__ATOMIC_ACQUIRE, "agent");
            xb_add(&bar[XB_XGEN(b.x)], 1u);
            asm volatile("s_waitcnt vmcnt(0)" ::: "memory");
        } else {
            XB_SPIN(xb_ld(&bar[XB_XGEN(b.x)]) == gen, bar);
            __builtin_amdgcn_fence(__ATOMIC_ACQUIRE, "agent");
            asm volatile("s_waitcnt vmcnt(0)" ::: "memory");
        }
    }
    __syncthreads();
}

struct Args { const GAS float* in[31]; GAS float* out; GAS unsigned char* ws; float rinv[8]; int ph_lo, ph_hi; };
#define GIN(A, i) ((const float*)((A)->in[i]))
typedef const Args __attribute__((address_space(4)))* CArgsP;
struct Frame {
    LAS unsigned char* lds;
    volatile LAS unsigned* MISC;
    gu32* ctl;
    int tid, lane, wave, vcu, G;
    float* out; unsigned char* ws;
};
__device__ __forceinline__ float wave_sum(float v) {
#pragma unroll
    for (int o = 1; o < 64; o <<= 1) v += __shfl_xor(v, o);
    return v;
}
template <int CTRL> __device__ __forceinline__ float dppf(float x) { return __builtin_bit_cast(float, __builtin_amdgcn_update_dpp(0, __builtin_bit_cast(int, x), CTRL, 0xF, 0xF, false)); }
__device__ __forceinline__ float reduce8(float x) { x += dppf<0xB1>(x); x += dppf<0x4E>(x); x += dppf<0x141>(x); return x; }
__device__ __forceinline__ float reduce16(float x) { x = reduce8(x); x += dppf<0x140>(x); return x; }
__device__ __forceinline__ float bf2f(bf16 h) { return __uint_as_float((unsigned)h << 16); }
__device__ __forceinline__ float bflo(unsigned w) { return __uint_as_float(w << 16); }
__device__ __forceinline__ float bfhi(unsigned w) { return __uint_as_float(w & 0xffff0000u); }

__device__ __forceinline__ void p0_transpose_item(const float* W, int N, bf16* WT, int ldk, int koff, int row_off, const float* kscale, LAS float* scr, int item, int lane) {
    const int nblk = N / 32, kb = item / nblk, nb = item % nblk, k0 = 64 * kb, n0 = 32 * nb;
    float wv[32];
#pragma unroll
    for (int i = 0; i < 32; ++i) wv[i] = W[(size_t)(k0 + 2 * i + (lane >> 5)) * N + n0 + (lane & 31)];
#pragma unroll
    for (int i = 0; i < 32; ++i) { const int kk = 2 * i + (lane >> 5); float w = wv[i]; if (kscale) w *= kscale[k0 + kk]; scr[kk * 33 + (lane & 31)] = w; }
    LDS_WAIT(); asm volatile("" ::: "memory");
    const int c = lane & 7;
#pragma unroll
    for (int j = 0; j < 4; ++j) { const int n = (lane >> 3) + 8 * j; const LAS float* s = scr + (8 * c) * 33 + n;
        v4u o; o.x = pk2(s[0 * 33], s[1 * 33]); o.y = pk2(s[2 * 33], s[3 * 33]); o.z = pk2(s[4 * 33], s[5 * 33]); o.w = pk2(s[6 * 33], s[7 * 33]);
        *(GAS v4u*)(WT + (size_t)(row_off + n0 + n) * ldk + koff + k0 + 8 * c) = o; }
    LDS_WAIT(); asm volatile("" ::: "memory");
}
__device__ __forceinline__ void p0_prologue(Frame& F, CArgsP A) {
    LAS float* scr = (LAS float*)(F.lds + RING_OFF + F.wave * 16384);
    const int gw = F.vcu * NWAVES + F.wave, NGW = F.G * NWAVES;
    constexpr int I_IN = (1024 / 64) * (P_TOTAL / 32), I_SQ = (1024 / 64) * (1024 / 32), I_UP = (1024 / 64) * (UPW / 32), I_DN = (D_FF / 64) * (1024 / 32),
                  I_W2 = 1 * (1024 / 32), I_G2 = 2 * (1024 / 32);
    constexpr int I_LAYER = I_IN + 3 * I_SQ + I_UP + I_DN + 2 * I_W2 + I_G2;
    for (int it = gw; it < DEPTH * I_LAYER; it += NGW) {
        const int l = it / I_LAYER; int r = it % I_LAYER;
        unsigned char* wl = F.ws + WS_W + (size_t)l * W_LAYER;
        if (r < I_IN) { p0_transpose_item(GIN(A, 8) + (size_t)l * 1024 * P_TOTAL, P_TOTAL, (bf16*)(wl + W_IN), 1024, 0, 0, GIN(A, 7) + l * 1024, scr, r, F.lane); continue; } r -= I_IN;
        if (r < I_SQ) { p0_transpose_item(GIN(A, 11) + (size_t)l * 1024 * 1024, 1024, (bf16*)(wl + W_ODA), 1024, 0, 0, nullptr, scr, r, F.lane); continue; } r -= I_SQ;
        if (r < I_SQ) { p0_transpose_item(GIN(A, 23) + (size_t)l * 1024 * 1024, 1024, (bf16*)(wl + W_ORW), 1024, 0, 0, nullptr, scr, r, F.lane); continue; } r -= I_SQ;
        if (r < I_SQ) { p0_transpose_item(GIN(A, 24) + (size_t)l * 1024 * 1024, 1024, (bf16*)(wl + W_OUT), 1024, 0, 0, nullptr, scr, r, F.lane); continue; } r -= I_SQ;
        if (r < I_UP) { p0_transpose_item(GIN(A, 26) + (size_t)l * 1024 * UPW, UPW, (bf16*)(wl + W_UP), 1024, 0, 0, GIN(A, 25) + l * 1024, scr, r, F.lane); continue; } r -= I_UP;
        if (r < I_DN) { p0_transpose_item(GIN(A, 29) + (size_t)l * D_FF * 1024, 1024, (bf16*)(wl + W_DN), D_FF, 0, 0, nullptr, scr, r, F.lane); continue; } r -= I_DN;
        if (r < I_W2) { p0_transpose_item(GIN(A, 14) + (size_t)l * 64 * 1024, 1024, (bf16*)(wl + W_LORA), 256, 0, 0, nullptr, scr, r, F.lane); continue; } r -= I_W2;
        if (r < I_W2) { p0_transpose_item(GIN(A, 16) + (size_t)l * 64 * 1024, 1024, (bf16*)(wl + W_LORA), 256, 64, 1024, nullptr, scr, r, F.lane); continue; } r -= I_W2;
        p0_transpose_item(GIN(A, 17) + (size_t)l * 128 * 1024, 1024, (bf16*)(wl + W_LORA), 256, 128, 2048, nullptr, scr, r, F.lane);
    }
    {
        const int gt = gw * 64 + F.lane, NGT = NGW * 64;
        for (int i = gt; i < DEPTH * 3072 * 32; i += NGT) {
            const int l = i / (3072 * 32), r = i % (3072 * 32), n = r >> 5, kc = r & 31, blk = n >> 10;
            const bool nz = (blk == 0) ? (kc < 8) : (blk == 1) ? (kc >= 8 && kc < 16) : (kc >= 16);
            if (!nz) *(GAS v4u*)(F.ws + WS_W + (size_t)l * W_LAYER + W_LORA + ((size_t)n * 256 + kc * 8) * 2) = (v4u){0u, 0u, 0u, 0u};
        }
        float* rope = (float*)(F.ws + WS_ROPE);
        for (int i = gt; i < NKEYS_S * 8; i += NGT) {
            const int pos = i >> 3, k = i & 7;
            const float ang = (float)pos * A->rinv[k];
            const float kq = rintf(ang * 0.15915494309189535f);
            float r = fmaf(-kq, 6.2831854820251465f, ang); r = fmaf(-kq, -1.7484555314695172e-7f, r);
            const float rev = r * 0.15915494309189535f;
            rope[pos * 16 + k] = __builtin_amdgcn_cosf(rev); rope[pos * 16 + 8 + k] = __builtin_amdgcn_sinf(rev);
        }
    }
    {
        float* X = F.out + O_YP; bf16* XB = (bf16*)(F.ws + WS_XB); float* SS = (float*)(F.ctl + CW_SS);
        for (int m = gw; m < MT; m += NGW) {
            const float* src = (m < MP) ? GIN(A, 0) + (size_t)m * 1024 : GIN(A, 1) + (size_t)(m - MP) * 1024;
            const GAS f32x4* xr = (const GAS f32x4*)src + F.lane;
            GAS f32x4* xo = (GAS f32x4*)(X + (size_t)m * 1024) + F.lane;
            GAS unsigned long long* o8 = (GAS unsigned long long*)(XB + (size_t)m * 1024) + F.lane;
            float s = 0.f;
#pragma unroll
            for (int j = 0; j < 4; ++j) { const f32x4 v = xr[64 * j]; s += (v.x * v.x + v.y * v.y) + (v.z * v.z + v.w * v.w); xo[64 * j] = v;
                o8[64 * j] = (unsigned long long)pk2(v.x, v.y) | ((unsigned long long)pk2(v.z, v.w) << 32); }
            s = wave_sum(s);
            if (F.lane == 0) SS[m] = s;
        }
    }
    if (gw < DEPTH) {
        const int l = gw; const float* lp = GIN(A, 9) + (size_t)l * 256;
        const float s1 = wave_sum(lp[F.lane] * lp[64 + F.lane]), s2 = wave_sum(lp[128 + F.lane] * lp[192 + F.lane]);
        if (F.lane == 0) ((float*)(F.ctl + CW_LAM))[l] = expf(s1) - expf(s2) + (0.8f - 0.6f * expf(-0.3f * (float)l));
    }
}

__device__ __forceinline__ void attn_slow_prompt(Frame& F, CArgsP A, int it) {
    const int c = it & 1, h = (it >> 1) & 7, chunk = (it >> 4) & 31, b = it >> 9;
    const bf16* Q = (const bf16*)(F.ws + B_Q); const bf16* K = (const bf16*)(F.ws + B_K); const bf16* V = (const bf16*)(F.ws + B_V);
    bf16* OC = (bf16*)(F.ws + B_OC) + (size_t)c * MT * 1024;
    const int row = b * SEQ + chunk * 64 + F.lane;
    float q[64];
    { const v4u* qp = (const v4u*)(Q + (size_t)row * 1024 + h * 128 + c * 64);
#pragma unroll
      for (int i = 0; i < 8; ++i) { const v4u w = qp[i]; q[8 * i] = bflo(w.x); q[8 * i + 1] = bfhi(w.x); q[8 * i + 2] = bflo(w.y); q[8 * i + 3] = bfhi(w.y); q[8 * i + 4] = bflo(w.z); q[8 * i + 5] = bfhi(w.z); q[8 * i + 6] = bflo(w.w); q[8 * i + 7] = bfhi(w.w); } }
    float o[128];
#pragma unroll
    for (int d = 0; d < 128; ++d) o[d] = 0.f;
    float m = -1e30f, l = 0.f;
    const int nk = (chunk + 1) * 64;
    const bf16* kb = K + (size_t)(b * SEQ) * 1024 + h * 128 + c * 64;
    const bf16* vb = V + (size_t)(b * SEQ) * 1024 + h * 128;
    for (int j = 0; j < nk; ++j) {
        const v4u* kp = (const v4u*)(kb + (size_t)j * 1024);
        float s = 0.f;
#pragma unroll
        for (int i = 0; i < 8; ++i) { const v4u w = kp[i];
            s = fmaf(q[8 * i], bflo(w.x), s); s = fmaf(q[8 * i + 1], bfhi(w.x), s); s = fmaf(q[8 * i + 2], bflo(w.y), s); s = fmaf(q[8 * i + 3], bfhi(w.y), s);
            s = fmaf(q[8 * i + 4], bflo(w.z), s); s = fmaf(q[8 * i + 5], bfhi(w.z), s); s = fmaf(q[8 * i + 6], bflo(w.w), s); s = fmaf(q[8 * i + 7], bfhi(w.w), s); }
        const float mn = fmaxf(m, s), alpha = exp2f(m - mn), pj = exp2f(s - mn);
        l = l * alpha + pj; m = mn;
        const v4u* vp = (const v4u*)(vb + (size_t)j * 1024);
#pragma unroll
        for (int i = 0; i < 16; ++i) { if ((i & 3) == 0) asm volatile("" ::: "memory"); const v4u w = vp[i];
            o[8 * i] = fmaf(o[8 * i], alpha, pj * bflo(w.x)); o[8 * i + 1] = fmaf(o[8 * i + 1], alpha, pj * bfhi(w.x)); o[8 * i + 2] = fmaf(o[8 * i + 2], alpha, pj * bflo(w.y)); o[8 * i + 3] = fmaf(o[8 * i + 3], alpha, pj * bfhi(w.y));
            o[8 * i + 4] = fmaf(o[8 * i + 4], alpha, pj * bflo(w.z)); o[8 * i + 5] = fmaf(o[8 * i + 5], alpha, pj * bfhi(w.z)); o[8 * i + 6] = fmaf(o[8 * i + 6], alpha, pj * bflo(w.w)); o[8 * i + 7] = fmaf(o[8 * i + 7], alpha, pj * bfhi(w.w)); }
    }
    const float il = 1.0f / l;
    v4u* op = (v4u*)(OC + (size_t)row * 1024 + h * 128);
#pragma unroll
    for (int i = 0; i < 16; ++i) { v4u w; w.x = pk2(o[8 * i] * il, o[8 * i + 1] * il); w.y = pk2(o[8 * i + 2] * il, o[8 * i + 3] * il); w.z = pk2(o[8 * i + 4] * il, o[8 * i + 5] * il); w.w = pk2(o[8 * i + 6] * il, o[8 * i + 7] * il); op[i] = w; }
}
__device__ __forceinline__ void attn_slow_sample(Frame& F, CArgsP A, int it, int l) {
    const int s = it & 7, c = (it >> 3) & 1, h = (it >> 4) & 7, b = it >> 7;
    const bf16* Q = (const bf16*)(F.ws + B_Q); const bf16* K = (const bf16*)(F.ws + B_K); const bf16* V = (const bf16*)(F.ws + B_V);
    const int qi = F.lane & 31, row = MP + b * DEC_SEQ + qi;
    float q[64];
    { const v4u* qp = (const v4u*)(Q + (size_t)row * 1024 + h * 128 + c * 64);
#pragma unroll
      for (int i = 0; i < 8; ++i) { const v4u w = qp[i]; q[8 * i] = bflo(w.x); q[8 * i + 1] = bfhi(w.x); q[8 * i + 2] = bflo(w.y); q[8 * i + 3] = bfhi(w.y); q[8 * i + 4] = bflo(w.z); q[8 * i + 5] = bfhi(w.z); q[8 * i + 6] = bflo(w.w); q[8 * i + 7] = bfhi(w.w); } }
    float o[128];
#pragma unroll
    for (int d = 0; d < 128; ++d) o[d] = 0.f;
    float m = -1e30f, lsum = 0.f;
    const float* ck = GIN(A, 2) + ((size_t)(l * DEC_BATCH + b) * PAST_LEN) * 1024 + h * 128 + c * 64;
    const float* cv = GIN(A, 3) + ((size_t)(l * DEC_BATCH + b) * PAST_LEN) * 1024 + h * 128;
    const int j0 = s * 260, j1 = j0 + 260, jp1 = j1 < PAST_LEN ? j1 : PAST_LEN;
    for (int j = j0; j < jp1; ++j) {
        float sc = 0.f;
        const f32x4* kp = (const f32x4*)(ck + (size_t)j * 1024);
#pragma unroll
        for (int i = 0; i < 16; ++i) { if ((i & 3) == 0) asm volatile("" ::: "memory"); const f32x4 w = kp[i]; sc = fmaf(q[4 * i], w.x, sc); sc = fmaf(q[4 * i + 1], w.y, sc); sc = fmaf(q[4 * i + 2], w.z, sc); sc = fmaf(q[4 * i + 3], w.w, sc); }
        const float mn = fmaxf(m, sc), alpha = exp2f(m - mn), pj = exp2f(sc - mn); lsum = lsum * alpha + pj; m = mn;
        const f32x4* vp = (const f32x4*)(cv + (size_t)j * 1024);
#pragma unroll
        for (int i = 0; i < 32; ++i) { if ((i & 3) == 0) asm volatile("" ::: "memory"); const f32x4 w = vp[i]; o[4 * i] = fmaf(o[4 * i], alpha, pj * w.x); o[4 * i + 1] = fmaf(o[4 * i + 1], alpha, pj * w.y); o[4 * i + 2] = fmaf(o[4 * i + 2], alpha, pj * w.z); o[4 * i + 3] = fmaf(o[4 * i + 3], alpha, pj * w.w); }
    }
    for (int j = (j0 > PAST_LEN ? j0 : PAST_LEN); j < j1; ++j) {
        float sc = 0.f;
        const size_t kr = (size_t)(MP + b * DEC_SEQ + (j - PAST_LEN)) * 1024;
        const v4u* kp = (const v4u*)(K + kr + h * 128 + c * 64);
#pragma unroll
        for (int i = 0; i < 8; ++i) { const v4u w = kp[i];
            sc = fmaf(q[8 * i], bflo(w.x), sc); sc = fmaf(q[8 * i + 1], bfhi(w.x), sc); sc = fmaf(q[8 * i + 2], bflo(w.y), sc); sc = fmaf(q[8 * i + 3], bfhi(w.y), sc);
            sc = fmaf(q[8 * i + 4], bflo(w.z), sc); sc = fmaf(q[8 * i + 5], bfhi(w.z), sc); sc = fmaf(q[8 * i + 6], bflo(w.w), sc); sc = fmaf(q[8 * i + 7], bfhi(w.w), sc); }
        const float mn = fmaxf(m, sc), alpha = exp2f(m - mn), pj = exp2f(sc - mn); lsum = lsum * alpha + pj; m = mn;
        const v4u* vp = (const v4u*)(V + kr + h * 128);
#pragma unroll
        for (int i = 0; i < 16; ++i) { if ((i & 3) == 0) asm volatile("" ::: "memory"); const v4u w = vp[i];
            o[8 * i] = fmaf(o[8 * i], alpha, pj * bflo(w.x)); o[8 * i + 1] = fmaf(o[8 * i + 1], alpha, pj * bfhi(w.x)); o[8 * i + 2] = fmaf(o[8 * i + 2], alpha, pj * bflo(w.y)); o[8 * i + 3] = fmaf(o[8 * i + 3], alpha, pj * bfhi(w.y));
            o[8 * i + 4] = fmaf(o[8 * i + 4], alpha, pj * bflo(w.z)); o[8 * i + 5] = fmaf(o[8 * i + 5], alpha, pj * bfhi(w.z)); o[8 * i + 6] = fmaf(o[8 * i + 6], alpha, pj * bflo(w.w)); o[8 * i + 7] = fmaf(o[8 * i + 7], alpha, pj * bfhi(w.w)); }
    }
    if (F.lane < 32) {
        float* sp = (float*)(F.ws + WS_SP) + ((size_t)(((b * 8 + h) * 2 + c) * 8 + s) * 32 + qi) * 132;
        sp[0] = m; sp[1] = lsum;
#pragma unroll
        for (int i = 0; i < 32; ++i) *(f32x4*)(sp + 4 + 4 * i) = (f32x4){o[4 * i], o[4 * i + 1], o[4 * i + 2], o[4 * i + 3]};
    }
}
__device__ __forceinline__ void ph_attn_slow(Frame& F, CArgsP A, int l) {
    const int gw = F.vcu * NWAVES + F.wave, NGW = F.G * NWAVES;
    for (int it = gw; it < 2048; it += NGW) { attn_slow_prompt(F, A, it); attn_slow_prompt(F, A, 4095 - it); }
    for (int it = gw; it < 1024; it += NGW) attn_slow_sample(F, A, it, l);
}

__device__ __forceinline__ void ph_attn(Frame& F, CArgsP A, int l) {
    const attn_body::bf16* Q = (const attn_body::bf16*)(F.ws + B_Q); const attn_body::bf16* K = (const attn_body::bf16*)(F.ws + B_K); const attn_body::bf16* V = (const attn_body::bf16*)(F.ws + B_V);
    for (int u = F.vcu; u < 256; u += F.G) {
        const int b = u >> 5, hv = u & 31, h = hv >> 2, c = (hv >> 1) & 1, vh = hv & 1;
        attn_body::bf16* O = (attn_body::bf16*)(F.ws + B_OC) + (size_t)c * MT * 1024;
        for (int qb = 7; qb >= 0; --qb) attn_body::attn_unit<8>(b, h * 128 + c * 64, h * 128 + vh * 64, qb, Q, K, V, O, (char*)F.lds + RING_OFF);
    }
    { int tv = threadIdx.x; asm volatile("" : "+v"(tv)); F.tid = tv; F.lane = tv & 63; F.wave = __builtin_amdgcn_readfirstlane(tv >> 6); }
    const int gw = F.vcu * NWAVES + F.wave, NGW = F.G * NWAVES;
    (void)gw; (void)NGW;
    for (int u = F.vcu; u < 512; u += F.G) attn_body::sample_unit(l, u >> 6, (u >> 3) & 7, u & 7, GIN(A, 2), GIN(A, 3), Q, K, V, (float*)(F.ws + WS_SP), (char*)F.lds + RING_OFF);
}

__device__ __forceinline__ void ph_combine(Frame& F, CArgsP A, int l) {
    const int gw = F.vcu * NWAVES + F.wave, NGW = F.G * NWAVES;
    const float lam = ((const float*)(F.ctl + CW_LAM))[l], lam_init = 0.8f - 0.6f * expf(-0.3f * (float)l);
    const bf16* OC0 = (const bf16*)(F.ws + B_OC); const bf16* OC1 = OC0 + (size_t)MT * 1024;
    bf16* OA = (bf16*)(F.ws + B_OA);
    const float* subln = GIN(A, 10) + l * 128;
    const float g0 = subln[2 * F.lane], g1 = subln[2 * F.lane + 1];
    {
        const int gt = gw * 64 + F.lane, NGT = NGW * 64;
        const float sc = 1.f - lam_init;
        for (int i = gt; i < MP * 128; i += NGT) {
            const size_t off = (size_t)(i >> 4) * 128 + (i & 15) * 8;
            const v4u w0 = *(const v4u*)(OC0 + off), w1 = *(const v4u*)(OC1 + off);
            float a[8];
            a[0] = bflo(w0.x) - lam * bflo(w1.x); a[1] = bfhi(w0.x) - lam * bfhi(w1.x); a[2] = bflo(w0.y) - lam * bflo(w1.y); a[3] = bfhi(w0.y) - lam * bfhi(w1.y);
            a[4] = bflo(w0.z) - lam * bflo(w1.z); a[5] = bfhi(w0.z) - lam * bfhi(w1.z); a[6] = bflo(w0.w) - lam * bflo(w1.w); a[7] = bfhi(w0.w) - lam * bfhi(w1.w);
            float ss = (a[0] * a[0] + a[1] * a[1]) + (a[2] * a[2] + a[3] * a[3]) + (a[4] * a[4] + a[5] * a[5]) + (a[6] * a[6] + a[7] * a[7]);
            ss = reduce16(ss);
            const float r = (1.0f / sqrtf(ss * (1.0f / 128.f) + EPS)) * sc;
            const f32x4 s0 = *(const f32x4*)(subln + (i & 15) * 8), s1 = *(const f32x4*)(subln + (i & 15) * 8 + 4);
            v4u o; o.x = pk2(a[0] * r * s0.x, a[1] * r * s0.y); o.y = pk2(a[2] * r * s0.z, a[3] * r * s0.w); o.z = pk2(a[4] * r * s1.x, a[5] * r * s1.y); o.w = pk2(a[6] * r * s1.z, a[7] * r * s1.w);
            *(v4u*)(OA + off) = o;
        }
    }
    for (int it = MP * 8 + gw; it < MT * 8; it += NGW) {
        const int row = it >> 3, h = it & 7;
        float a0, a1;
        {
            const int b = (row - MP) >> 5, qi = (row - MP) & 31;
            float oc[2][2];
#pragma unroll
            for (int c = 0; c < 2; ++c) {
                const float* sp = (const float*)(F.ws + WS_SP) + ((size_t)(((b * 8 + h) * 2 + c) * 8) * 32 + qi) * 132;
                float mx = -1e30f;
#pragma unroll
                for (int s = 0; s < 8; ++s) mx = fmaxf(mx, sp[(size_t)s * 32 * 132]);
                float L = 0.f, x0 = 0.f, x1 = 0.f;
#pragma unroll
                for (int s = 0; s < 8; ++s) { const float* p = sp + (size_t)s * 32 * 132; const float w = exp2f(p[0] - mx); L += w * p[1]; x0 += w * p[4 + 2 * F.lane]; x1 += w * p[4 + 2 * F.lane + 1]; }
                oc[c][0] = x0 / L; oc[c][1] = x1 / L;
            }
            a0 = oc[0][0] - lam * oc[1][0]; a1 = oc[0][1] - lam * oc[1][1];
        }
        const float ss = wave_sum(a0 * a0 + a1 * a1);
        const float r = (1.0f / sqrtf(ss * (1.0f / 128.f) + EPS)) * (1.f - lam_init);
        *(unsigned*)(OA + (size_t)row * 1024 + h * 128 + 2 * F.lane) = pk2(a0 * r * g0, a1 * r * g1);
    }
    const bf16* URW = (const bf16*)(F.ws + B_URW); bf16* LIN = (bf16*)(F.ws + B_LIN);
    const float* mu = GIN(A, 12) + (size_t)l * P_RW + 3072 + 4 * F.lane;
    const float mu0 = mu[0], mu1 = mu[1], mu2 = mu[2], mu3 = mu[3];
    for (int row = gw; row < MT; row += NGW) {
        const bool smp = row >= MP; const int t = smp ? ((row - MP) & 31) : (row & 2047);
        const unsigned long long cw = *(const unsigned long long*)(URW + (size_t)row * P_RW + 3072 + 4 * F.lane);
        float u[4] = {bflo((unsigned)cw), bfhi((unsigned)cw), bflo((unsigned)(cw >> 32)), bfhi((unsigned)(cw >> 32))};
        float p[4];
        if (t > 0) { const unsigned long long pw = *(const unsigned long long*)(URW + (size_t)(row - 1) * P_RW + 3072 + 4 * F.lane);
            p[0] = bflo((unsigned)pw); p[1] = bfhi((unsigned)pw); p[2] = bflo((unsigned)(pw >> 32)); p[3] = bfhi((unsigned)(pw >> 32)); }
        else if (smp) { const float* s0 = GIN(A, 5) + ((size_t)(l * DEC_BATCH) + ((row - MP) >> 5)) * P_RW + 3072 + 4 * F.lane; p[0] = s0[0]; p[1] = s0[1]; p[2] = s0[2]; p[3] = s0[3]; }
        else { p[0] = p[1] = p[2] = p[3] = 0.f; }
        u[0] += (p[0] - u[0]) * mu0; u[1] += (p[1] - u[1]) * mu1; u[2] += (p[2] - u[2]) * mu2; u[3] += (p[3] - u[3]) * mu3;
        if (F.lane < 16) { u[0] = tanhf(u[0]); u[1] = tanhf(u[1]); u[2] = tanhf(u[2]); u[3] = tanhf(u[3]); }
        else if (F.lane >= 32) { u[0] = 1.f / (1.f + expf(-u[0])); u[1] = 1.f / (1.f + expf(-u[1])); u[2] = 1.f / (1.f + expf(-u[2])); u[3] = 1.f / (1.f + expf(-u[3])); }
        *(unsigned long long*)(LIN + (size_t)row * 256 + 4 * F.lane) = (unsigned long long)pk2(u[0], u[1]) | ((unsigned long long)pk2(u[2], u[3]) << 32);
    }
}

__device__ __forceinline__ void scan_item(Frame& F, CArgsP A, int l, int it) {
    const bool smp = it >= 128; const int bh = it & 127, b = bh >> 4, h = bh & 15, lane = F.lane;
    const int T = smp ? DEC_SEQ : SEQ; const int row0 = smp ? MP + b * DEC_SEQ : b * SEQ;
    const int c = h * 64 + lane;
    const bf16* URW = (const bf16*)(F.ws + B_URW); const bf16* LD = (const bf16*)(F.ws + B_LD); const bf16* LA = (const bf16*)(F.ws + B_LA); const bf16* LG = (const bf16*)(F.ws + B_LG);
    bf16* ORW = (bf16*)(F.ws + B_ORW);
    const float* mu = GIN(A, 12) + (size_t)l * P_RW;
    const float mu_r = mu[c], mu_k = mu[1024 + c], mu_v = mu[2048 + c];
    const float k_k = GIN(A, 18)[l * 1024 + c], k_a = GIN(A, 19)[l * 1024 + c], r_k = GIN(A, 20)[l * 1024 + c], ln_w = GIN(A, 21)[l * 1024 + c], ln_b = GIN(A, 22)[l * 1024 + c];
    float S[64];
    if (smp) { const float* s0 = GIN(A, 4) + (((size_t)(l * 8 + b) * 16 + h) * 64 + lane) * 64;
#pragma unroll
        for (int k = 0; k < 64; k += 4) { const f32x4 v = *(const f32x4*)(s0 + k); S[k] = v.x; S[k + 1] = v.y; S[k + 2] = v.z; S[k + 3] = v.w; } }
    else {
#pragma unroll
        for (int k = 0; k < 64; ++k) S[k] = 0.f; }
    float pr = 0.f, pk = 0.f, pv = 0.f;
    if (smp) { const float* s0 = GIN(A, 5) + (size_t)(l * 8 + b) * P_RW; pr = s0[c]; pk = s0[1024 + c]; pv = s0[2048 + c]; }
    LAS float* sh = (LAS float*)(F.lds + RING_OFF + F.wave * 2048);
    size_t ro = (size_t)row0;
    float nur = bf2f(URW[ro * P_RW + c]), nuk = bf2f(URW[ro * P_RW + 1024 + c]), nuv = bf2f(URW[ro * P_RW + 2048 + c]);
    float nld = bf2f(LD[ro * 1024 + c]), nla = bf2f(LA[ro * 1024 + c]), nlg = bf2f(LG[ro * 1024 + c]);
    for (int t = 0; t < T; ++t) {
        const float ur = nur, uk = nuk, uv = nuv, ld = nld, a = nla, g = nlg;
        const size_t rcur = ro;
        if (t + 1 < T) { ro += 1; nur = bf2f(URW[ro * P_RW + c]); nuk = bf2f(URW[ro * P_RW + 1024 + c]); nuv = bf2f(URW[ro * P_RW + 2048 + c]);
            nld = bf2f(LD[ro * 1024 + c]); nla = bf2f(LA[ro * 1024 + c]); nlg = bf2f(LG[ro * 1024 + c]); }
        const float r = ur + (pr - ur) * mu_r, kr = uk + (pk - uk) * mu_k, vr = uv + (pv - uv) * mu_v;
        pr = ur; pk = uk; pv = uv;
        const float decay = expf(ld);
        float kk = kr * k_k;
        const float ssq = wave_sum(kk * kk);
        kk *= 1.0f / sqrtf(fmaxf(ssq, 1e-24f));
        const float km = kr * (1.f + (a - 1.f) * k_a);
        const float bbv = kk * a;
        const float bon = wave_sum(r * km * r_k);
        asm volatile("s_waitcnt lgkmcnt(0)" ::: "memory");
        sh[lane] = r; sh[64 + lane] = decay; sh[128 + lane] = km; sh[192 + lane] = kk; sh[256 + lane] = bbv;
        asm volatile("s_waitcnt lgkmcnt(0)" ::: "memory");
        float sa = 0.f;
#pragma unroll
        for (int k = 0; k < 64; k += 4) { const f32x4 q = *(const LAS f32x4*)(sh + 192 + k); sa = fmaf(S[k], -q.x, sa); sa = fmaf(S[k + 1], -q.y, sa); sa = fmaf(S[k + 2], -q.z, sa); sa = fmaf(S[k + 3], -q.w, sa); }
        float y = 0.f;
#pragma unroll
        for (int k = 0; k < 64; k += 4) {
            const f32x4 w4 = *(const LAS f32x4*)(sh + 64 + k), b4 = *(const LAS f32x4*)(sh + 256 + k), m4 = *(const LAS f32x4*)(sh + 128 + k), r4 = *(const LAS f32x4*)(sh + k);
            S[k] = S[k] * w4.x + sa * b4.x + vr * m4.x; y = fmaf(S[k], r4.x, y);
            S[k + 1] = S[k + 1] * w4.y + sa * b4.y + vr * m4.y; y = fmaf(S[k + 1], r4.y, y);
            S[k + 2] = S[k + 2] * w4.z + sa * b4.z + vr * m4.z; y = fmaf(S[k + 2], r4.z, y);
            S[k + 3] = S[k + 3] * w4.w + sa * b4.w + vr * m4.w; y = fmaf(S[k + 3], r4.w, y);
        }
        const float mean = wave_sum(y) * (1.f / 64.f), d = y - mean;
        const float var = wave_sum(d * d) * (1.f / 64.f);
        const float yn = d * (1.0f / sqrtf(var + GN_EPS)) * ln_w + ln_b;
        ORW[rcur * 1024 + c] = (bf16)f2bf((yn + bon * vr) * g);
    }
    int ln2 = lane; asm volatile("" : "+v"(ln2));
    float* Sout = F.out + (smp ? O_WKVS : O_WKVP) + (((size_t)(l * 8 + b) * 16 + h) * 64 + ln2) * 64;
#pragma unroll
    for (int k = 0; k < 64; k += 4) *(f32x4*)(Sout + k) = (f32x4){S[k], S[k + 1], S[k + 2], S[k + 3]};
}
__device__ __forceinline__ void ph_scan_slow(Frame& F, CArgsP A, int l) {
    if (F.wave == 0 && F.vcu < 256) scan_item(F, A, l, F.vcu);
    if (F.G < 256 && F.wave == 1) for (int it = F.G + F.vcu; it < 256; it += F.G) scan_item(F, A, l, it);
}

typedef float f32x2 __attribute__((ext_vector_type(2)));
constexpr int SC_C = 32;
constexpr int SC_OPB = 0, SC_OPB_SZ = SC_C * 1280;
constexpr int SC_VB = 2 * SC_OPB_SZ, SC_VB_SZ = SC_C * 256;
constexpr int SC_YB = SC_VB + 2 * SC_VB_SZ;
static_assert(SC_YB + SC_C * 128 <= RING_BYTES, "scan LDS");
constexpr size_t B_Y = B_OC;
constexpr size_t WS_BON = WS_SP;
struct ScanRegs { unsigned long long ur, uk, uv, pr, pk, pv, ld, la; };

__device__ __forceinline__ void unpack4(unsigned long long w, float (&o)[4]) { o[0] = bflo((unsigned)w); o[1] = bfhi((unsigned)w); o[2] = bflo((unsigned)(w >> 32)); o[3] = bfhi((unsigned)(w >> 32)); }

__device__ __forceinline__ void scan_fast(Frame& F, CArgsP A, int l, int item) {
    const bool smp = item >= 256; const int half = item & 1, bh = (item >> 1) & 127, b = bh >> 4, h = bh & 15;
    const int T = smp ? DEC_SEQ : SEQ, row0 = smp ? MP + b * DEC_SEQ : b * SEQ, nch = T / SC_C;
    const int tid = F.tid, lane = F.lane, w = F.wave;
    const int rho = lane >> 4, kq = lane & 15, lrow = w * 4 + rho, srow = half * 32 + lrow;
    const int tp = tid >> 4, cq = tid & 15, c = h * 64 + 4 * cq;
    const bf16* URW = (const bf16*)(F.ws + B_URW); const bf16* LD = (const bf16*)(F.ws + B_LD); const bf16* LA = (const bf16*)(F.ws + B_LA);
    float* Y = (float*)(F.ws + B_Y); float* BONG = (float*)(F.ws + WS_BON);
    LAS unsigned char* L = F.lds + RING_OFF;
    float mu_r[4], mu_k[4], mu_v[4], k_k[4], k_a[4], r_k[4];
    { const float* mu = GIN(A, 12) + (size_t)l * P_RW;
#pragma unroll
      for (int j = 0; j < 4; ++j) { mu_r[j] = mu[c + j]; mu_k[j] = mu[1024 + c + j]; mu_v[j] = mu[2048 + c + j]; k_k[j] = GIN(A, 18)[l * 1024 + c + j]; k_a[j] = GIN(A, 19)[l * 1024 + c + j]; r_k[j] = GIN(A, 20)[l * 1024 + c + j]; } }
    f32x2 S2[2];
    if (smp) { const float* s0 = GIN(A, 4) + (((size_t)(l * 8 + b) * 16 + h) * 64 + srow) * 64 + 4 * kq; const f32x4 a0 = *(const f32x4*)s0; S2[0] = (f32x2){a0.x, a0.y}; S2[1] = (f32x2){a0.z, a0.w}; }
    else { S2[0] = (f32x2){0.f, 0.f}; S2[1] = (f32x2){0.f, 0.f}; }
    ScanRegs g;
#define SC_LOAD(ch) do { const size_t r_ = (size_t)(row0 + (ch) * SC_C + tp); const bf16* u_ = URW + r_ * P_RW + c; \
        g.ur = *(const unsigned long long*)(u_); g.uk = *(const unsigned long long*)(u_ + 1024); g.uv = *(const unsigned long long*)(u_ + 2048); \
        if ((ch) * SC_C + tp > 0) { g.pr = *(const unsigned long long*)(u_ - P_RW); g.pk = *(const unsigned long long*)(u_ - P_RW + 1024); g.pv = *(const unsigned long long*)(u_ - P_RW + 2048); } \
        g.ld = *(const unsigned long long*)(LD + r_ * 1024 + c); g.la = *(const unsigned long long*)(LA + r_ * 1024 + c); } while (0)
    SC_LOAD(0);
    for (int ch = 0; ch < nch; ++ch) {
        const int buf = ch & 1;
        LAS unsigned char* opb = L + SC_OPB + buf * SC_OPB_SZ; LAS float* vb = (LAS float*)(L + SC_VB + buf * SC_VB_SZ); LAS float* yb = (LAS float*)(L + SC_YB);
        {
            float ur[4], uk[4], uv[4], pr[4], pk[4], pv[4], ld[4], la[4];
            unpack4(g.ur, ur); unpack4(g.uk, uk); unpack4(g.uv, uv); unpack4(g.ld, ld); unpack4(g.la, la);
            if (ch * SC_C + tp > 0) { unpack4(g.pr, pr); unpack4(g.pk, pk); unpack4(g.pv, pv); }
            else if (smp) { const float* s0 = GIN(A, 5) + (size_t)(l * 8 + b) * P_RW + c;
#pragma unroll
                for (int j = 0; j < 4; ++j) { pr[j] = s0[j]; pk[j] = s0[1024 + j]; pv[j] = s0[2048 + j]; } }
            else {
#pragma unroll
                for (int j = 0; j < 4; ++j) { pr[j] = 0.f; pk[j] = 0.f; pv[j] = 0.f; } }
            float r[4], kr[4], vr[4], kk[4], km[4], wd[4], ssq = 0.f, bon = 0.f;
#pragma unroll
            for (int j = 0; j < 4; ++j) {
                r[j] = ur[j] + (pr[j] - ur[j]) * mu_r[j]; kr[j] = uk[j] + (pk[j] - uk[j]) * mu_k[j]; vr[j] = uv[j] + (pv[j] - uv[j]) * mu_v[j];
                wd[j] = expf(ld[j]);
                kk[j] = kr[j] * k_k[j]; ssq += kk[j] * kk[j];
                km[j] = kr[j] * (1.f + (la[j] - 1.f) * k_a[j]);
                bon += r[j] * km[j] * r_k[j];
            }
            ssq = reduce16(ssq); bon = reduce16(bon);
            const float inv = 1.0f / sqrtf(fmaxf(ssq, 1e-24f));
            LAS float* op = (LAS float*)(opb + tp * 1280) + 4 * cq;
            *(LAS f32x4*)(op) = (f32x4){wd[0], wd[1], wd[2], wd[3]};
            *(LAS f32x4*)(op + 64) = (f32x4){kk[0] * inv, kk[1] * inv, kk[2] * inv, kk[3] * inv};
            *(LAS f32x4*)(op + 128) = (f32x4){kk[0] * inv * la[0], kk[1] * inv * la[1], kk[2] * inv * la[2], kk[3] * inv * la[3]};
            *(LAS f32x4*)(op + 192) = (f32x4){km[0], km[1], km[2], km[3]};
            *(LAS f32x4*)(op + 256) = (f32x4){r[0], r[1], r[2], r[3]};
            *(LAS f32x4*)(vb + tp * 64 + 4 * cq) = (f32x4){vr[0], vr[1], vr[2], vr[3]};
            if (half == 0 && cq == 0) BONG[(size_t)(row0 + ch * SC_C + tp) * 16 + h] = bon;
        }
        if (ch + 1 < nch) SC_LOAD(ch + 1);
        __syncthreads();
        {
            const LAS float* ob = (const LAS float*)opb + 4 * kq;
            f32x4 wA, kA, bA, mA, rA, wB, kB, bB, mB, rB; float vA, vB;
#define SC_LD(SET, tt) do { const LAS float* p_ = ob + (tt) * 320; w##SET = *(const LAS f32x4*)(p_); k##SET = *(const LAS f32x4*)(p_ + 64); b##SET = *(const LAS f32x4*)(p_ + 128); m##SET = *(const LAS f32x4*)(p_ + 192); \
            r##SET = *(const LAS f32x4*)(p_ + 256); v##SET = vb[(tt) * 64 + srow]; } while (0)
#define LO2(x) ((f32x2){(x)[0], (x)[1]})
#define HI2(x) ((f32x2){(x)[2], (x)[3]})
#define SC_STEP(SET, tt) do { \
            f32x2 sa2_ = __builtin_elementwise_fma(S2[1], HI2(k##SET), S2[0] * LO2(k##SET)); \
            const float nsa_ = -reduce16(sa2_[0] + sa2_[1]); const f32x2 ns2_ = (f32x2){nsa_, nsa_}, vv2_ = (f32x2){v##SET, v##SET}; \
            S2[0] = __builtin_elementwise_fma(S2[0], LO2(w##SET), __builtin_elementwise_fma(ns2_, LO2(b##SET), vv2_ * LO2(m##SET))); \
            S2[1] = __builtin_elementwise_fma(S2[1], HI2(w##SET), __builtin_elementwise_fma(ns2_, HI2(b##SET), vv2_ * HI2(m##SET))); \
            const f32x2 y2_ = __builtin_elementwise_fma(S2[1], HI2(r##SET), S2[0] * LO2(r##SET)); \
            const float y_ = reduce16(y2_[0] + y2_[1]); \
            if (kq == 0) yb[(tt) * 32 + lrow] = y_; } while (0)
            SC_LD(A, 0);
            for (int t = 0; t < SC_C; t += 2) {
                SC_LD(B, t + 1);
                SC_STEP(A, t);
                if (t + 2 < SC_C) SC_LD(A, t + 2);
                SC_STEP(B, t + 1);
            }
#undef SC_LD
#undef SC_STEP
#undef LO2
#undef HI2
        }
        __syncthreads();
        { const f32x2 y2 = *(const LAS f32x2*)(yb + tp * 32 + 2 * cq);
          *(f32x2*)(Y + (size_t)(row0 + ch * SC_C + tp) * 1024 + h * 64 + half * 32 + 2 * cq) = y2; }
    }
#undef SC_LOAD
    float* Sout = F.out + (smp ? O_WKVS : O_WKVP) + (((size_t)(l * 8 + b) * 16 + h) * 64 + srow) * 64 + 4 * kq;
    *(f32x4*)Sout = (f32x4){S2[0][0], S2[0][1], S2[1][0], S2[1][1]};
    __syncthreads();
}
__device__ __forceinline__ void ph_scan(Frame& F, CArgsP A, int l) {
    for (int it = F.vcu; it < 512; it += F.G) scan_fast(F, A, l, it);
}
__device__ __forceinline__ void ph_post(Frame& F, CArgsP A, int l) {
    const int gt = (F.vcu * NWAVES + F.wave) * 64 + F.lane, NGT = F.G * NWAVES * 64;
    const float* Y = (const float*)(F.ws + B_Y); const float* BONG = (const float*)(F.ws + WS_BON); const bf16* URW = (const bf16*)(F.ws + B_URW); const bf16* LG = (const bf16*)(F.ws + B_LG);
    bf16* ORW = (bf16*)(F.ws + B_ORW);
    const float* mu = GIN(A, 12) + (size_t)l * P_RW + 2048; const float* ln_w = GIN(A, 21) + l * 1024; const float* ln_b = GIN(A, 22) + l * 1024;
    for (int i = gt; i < MT * 256; i += NGT) {
        const int row = i >> 8, c = (i & 255) * 4, h = c >> 6;
        const bool smp = row >= MP; const int t = smp ? ((row - MP) & 31) : (row & 2047);
        const f32x4 y4 = *(const f32x4*)(Y + (size_t)row * 1024 + c);
        float uv[4], pv[4], gg[4];
        unpack4(*(const unsigned long long*)(URW + (size_t)row * P_RW + 2048 + c), uv);
        if (t > 0) unpack4(*(const unsigned long long*)(URW + (size_t)(row - 1) * P_RW + 2048 + c), pv);
        else if (smp) { const float* s0 = GIN(A, 5) + ((size_t)(l * 8) + ((row - MP) >> 5)) * P_RW + 2048 + c; pv[0] = s0[0]; pv[1] = s0[1]; pv[2] = s0[2]; pv[3] = s0[3]; }
        else { pv[0] = pv[1] = pv[2] = pv[3] = 0.f; }
        unpack4(*(const unsigned long long*)(LG + (size_t)row * 1024 + c), gg);
        const f32x4 m4 = *(const f32x4*)(mu + c), lw = *(const f32x4*)(ln_w + c), lb = *(const f32x4*)(ln_b + c);
        const float bon = BONG[(size_t)row * 16 + h];
        const float v0 = uv[0] + (pv[0] - uv[0]) * m4.x, v1 = uv[1] + (pv[1] - uv[1]) * m4.y, v2 = uv[2] + (pv[2] - uv[2]) * m4.z, v3 = uv[3] + (pv[3] - uv[3]) * m4.w;
        const float mean = reduce16((y4.x + y4.y) + (y4.z + y4.w)) * (1.f / 64.f);
        const float d0 = y4.x - mean, d1 = y4.y - mean, d2 = y4.z - mean, d3 = y4.w - mean;
        const float var = reduce16((d0 * d0 + d1 * d1) + (d2 * d2 + d3 * d3)) * (1.f / 64.f);
        const float rs = 1.0f / sqrtf(var + GN_EPS);
        const float o0 = (d0 * rs * lw.x + lb.x + bon * v0) * gg[0], o1 = (d1 * rs * lw.y + lb.y + bon * v1) * gg[1];
        const float o2 = (d2 * rs * lw.z + lb.z + bon * v2) * gg[2], o3 = (d3 * rs * lw.w + lb.w + bon * v3) * gg[3];
        *(unsigned long long*)(ORW + (size_t)row * 1024 + c) = (unsigned long long)pk2(o0, o1) | ((unsigned long long)pk2(o2, o3) << 32);
    }
}

__device__ __forceinline__ void unpack8f(const v4u w, float (&o)[8]) { o[0] = bflo(w.x); o[1] = bfhi(w.x); o[2] = bflo(w.y); o[3] = bfhi(w.y); o[4] = bflo(w.z); o[5] = bfhi(w.z); o[6] = bflo(w.w); o[7] = bfhi(w.w); }
__device__ __forceinline__ void ph_conv(Frame& F, CArgsP A, int l) {
    const int gt = (F.vcu * NWAVES + F.wave) * 64 + F.lane, NGT = F.G * NWAVES * 64;
    const bf16* UP = (const bf16*)(F.ws + B_UP); bf16* GT = (bf16*)(F.ws + B_GT);
    const float* cw = GIN(A, 27) + (size_t)l * 3 * UPW; const float* cb = GIN(A, 28) + (size_t)l * UPW;
    constexpr int NJ = D_FF / 8, NRB = MT / 64;
    for (int it = gt; it < NRB * NJ; it += NGT) {
        const int rb = it / NJ, j = (it % NJ) * 8;
        float w0[2][8], w1[2][8], w2[2][8], bi[2][8];
#pragma unroll
        for (int hf = 0; hf < 2; ++hf) { const int col = j + hf * D_FF;
#pragma unroll
            for (int e = 0; e < 8; e += 4) { const f32x4 a = *(const f32x4*)(cw + col + e), b2 = *(const f32x4*)(cw + UPW + col + e), c2 = *(const f32x4*)(cw + 2 * UPW + col + e), d2 = *(const f32x4*)(cb + col + e);
                w0[hf][e] = a.x; w0[hf][e + 1] = a.y; w0[hf][e + 2] = a.z; w0[hf][e + 3] = a.w; w1[hf][e] = b2.x; w1[hf][e + 1] = b2.y; w1[hf][e + 2] = b2.z; w1[hf][e + 3] = b2.w;
                w2[hf][e] = c2.x; w2[hf][e + 1] = c2.y; w2[hf][e + 2] = c2.z; w2[hf][e + 3] = c2.w; bi[hf][e] = d2.x; bi[hf][e + 1] = d2.y; bi[hf][e + 2] = d2.z; bi[hf][e + 3] = d2.w; } }
        float u1[2][8], u2[2][8];
        for (int rr = 0; rr < 64; ++rr) {
            const int row = rb * 64 + rr;
            const bool smp = row >= MP; const int t = smp ? ((row - MP) & 31) : (row & 2047); const int b = smp ? ((row - MP) >> 5) : (row >> 11);
            if (t == 0) {
#pragma unroll
                for (int hf = 0; hf < 2; ++hf) { const int col = j + hf * D_FF;
                    if (smp) { const float* s0 = GIN(A, 6) + ((size_t)(l * 8 + b) * 2) * UPW + col;
#pragma unroll
                        for (int e = 0; e < 8; ++e) { u2[hf][e] = s0[e]; u1[hf][e] = s0[UPW + e]; } }
                    else {
#pragma unroll
                        for (int e = 0; e < 8; ++e) { u2[hf][e] = 0.f; u1[hf][e] = 0.f; } } }
            } else if (rr == 0) {
#pragma unroll
                for (int hf = 0; hf < 2; ++hf) { const int col = j + hf * D_FF;
                    unpack8f(*(const v4u*)(UP + (size_t)(row - 1) * UPW + col), u1[hf]);
                    if (t >= 2) unpack8f(*(const v4u*)(UP + (size_t)(row - 2) * UPW + col), u2[hf]);
                    else if (smp) { const float* s0 = GIN(A, 6) + ((size_t)(l * 8 + b) * 2 + 1) * UPW + col;
#pragma unroll
                        for (int e = 0; e < 8; ++e) u2[hf][e] = s0[e]; }
                    else {
#pragma unroll
                        for (int e = 0; e < 8; ++e) u2[hf][e] = 0.f; } }
            }
            float u0[2][8], cc[2][8];
#pragma unroll
            for (int hf = 0; hf < 2; ++hf) { unpack8f(*(const v4u*)(UP + (size_t)row * UPW + j + hf * D_FF), u0[hf]);
#pragma unroll
                for (int e = 0; e < 8; ++e) { cc[hf][e] = bi[hf][e] + u2[hf][e] * w0[hf][e] + u1[hf][e] * w1[hf][e] + u0[hf][e] * w2[hf][e]; u2[hf][e] = u1[hf][e]; u1[hf][e] = u0[hf][e]; } }
            float gv[8];
#pragma unroll
            for (int e = 0; e < 8; ++e) gv[e] = cc[0][e] * __builtin_amdgcn_rcpf(1.0f + __builtin_amdgcn_exp2f(-1.4426950408889634f * cc[0][e])) * cc[1][e];
            v4u o; o.x = pk2(gv[0], gv[1]); o.y = pk2(gv[2], gv[3]); o.z = pk2(gv[4], gv[5]); o.w = pk2(gv[6], gv[7]);
            *(v4u*)(GT + (size_t)row * D_FF + j) = o;
        }
    }
}

__device__ __forceinline__ void ph_final(Frame& F, CArgsP A) {
    const int gw = F.vcu * NWAVES + F.wave, NGW = F.G * NWAVES;
    float* X = F.out + O_YP; const float* SS = (const float*)(F.ctl + CW_SS) + 4 * MT; const float* g = GIN(A, 30);
    for (int m = gw; m < MT; m += NGW) {
        const float r = 1.0f / sqrtf(SS[m] * (1.0f / 1024.f) + EPS);
        GAS f32x4* xr = (GAS f32x4*)(X + (size_t)m * 1024) + F.lane; const GAS f32x4* gr = (const GAS f32x4*)g + F.lane;
#pragma unroll
        for (int j = 0; j < 4; ++j) { f32x4 v = xr[64 * j]; const f32x4 gg = gr[64 * j]; v = v * r * gg; xr[64 * j] = v; }
    }
}

#define REOPAQUE() do { int tv = threadIdx.x; asm volatile("" : "+v"(tv)); F.tid = tv; F.lane = tv & 63; F.wave = __builtin_amdgcn_readfirstlane(tv >> 6); \
    ap = (CArgsP)__builtin_amdgcn_kernarg_segment_ptr(); asm volatile("" : "+s"(ap)); \
    { GAS unsigned char* w_ = ap->ws; GAS float* o_ = ap->out; asm volatile("" : "+s"(w_), "+s"(o_)); F.ws = (unsigned char*)w_; F.out = (float*)o_; F.ctl = (gu32*)(w_ + WS_CTL); } } while (0)
#define PH_BEGIN(idx) if (lo <= (idx) && (idx) < hi) { REOPAQUE();
#define PH_END(idx) if ((idx) + 1 < hi) xcd_barrier(bar); }

template <int l> __device__ __forceinline__ void layer_phases(Frame& F, CArgsP& ap, const XcdBarrier& bar, const int lo, const int hi) {
    constexpr int P0 = 1 + l * PH_PER_LAYER;
#define WL (F.ws + WS_W + (size_t)l * W_LAYER)
#define SSP ((float*)(F.ctl + CW_SS))
    PH_BEGIN(P0 + K_G1) {
        int kk_ = 1024; asm volatile("" : "+s"(kk_)); pg8::Gemm g{(const bf16*)(F.ws + WS_XB), (const bf16*)(WL + W_IN), MT, P_TOTAL, kk_}; pg8::StaticOrder S; S.init(MT, P_TOTAL, F.G, (int)blockIdx.x);
        pg8::EpiIn E{SSP + (size_t)(2 * l) * MT, (const float*)(F.ws + WS_ROPE), (bf16*)(F.ws + B_Q), (bf16*)(F.ws + B_K), (bf16*)(F.ws + B_V), (bf16*)(F.ws + B_URW), (bf16*)(F.ws + B_GATE),
                     F.out + O_KP + (size_t)l * MP * 1024, F.out + O_VP + (size_t)l * MP * 1024, F.out + O_KS + (size_t)l * MS * 1024, F.out + O_VS + (size_t)l * MS * 1024,
                     F.out + O_SHP + (size_t)l * BATCH * P_RW, F.out + O_SHS + (size_t)l * DEC_BATCH * P_RW};
        for (int rep_ = 0; rep_ < (((MK_DBL >> K_G1) & 1) ? 2 : 1); ++rep_) { pg8::gemm_phase<pg8::EpiIn, pg8::StaticOrder, true, true>(F.lds + RING_OFF, g, S, E); }
    } PH_END(P0 + K_G1)
    PH_BEGIN(P0 + K_AT) { for (int rep_ = 0; rep_ < (((MK_DBL >> K_AT) & 1) ? 2 : 1); ++rep_) { ph_attn(F, ap, l); } } PH_END(P0 + K_AT)
    PH_BEGIN(P0 + K_CB) { for (int rep_ = 0; rep_ < (((MK_DBL >> K_CB) & 1) ? 2 : 1); ++rep_) { ph_combine(F, ap, l); } } PH_END(P0 + K_CB)
    PH_BEGIN(P0 + K_LR) {
        int kk_ = 256; asm volatile("" : "+s"(kk_)); pg8::Gemm g{(const bf16*)(F.ws + B_LIN), (const bf16*)(WL + W_LORA), MT, 3072, kk_}; pg8::StaticOrder S; S.init(MT, 3072, F.G, (int)blockIdx.x);
        pg8::EpiLora E{GIN(ap, 13) + l * 1024, GIN(ap, 15) + l * 1024, (bf16*)(F.ws + B_LD), (bf16*)(F.ws + B_LA), (bf16*)(F.ws + B_LG)};
        for (int rep_ = 0; rep_ < (((MK_DBL >> K_LR) & 1) ? 2 : 1); ++rep_) { pg8::gemm_phase<pg8::EpiLora, pg8::StaticOrder, true, true>(F.lds + RING_OFF, g, S, E); }
    } PH_END(P0 + K_LR)
    PH_BEGIN(P0 + K_SC) { for (int rep_ = 0; rep_ < (((MK_DBL >> K_SC) & 1) ? 2 : 1); ++rep_) { ph_scan(F, ap, l); } } PH_END(P0 + K_SC)
    PH_BEGIN(P0 + K_M1) {
        ph_post(F, ap, l);
        int kk_ = 1024; asm volatile("" : "+s"(kk_)); pg8::Gemm g{(const bf16*)(F.ws + B_OA), (const bf16*)(WL + W_ODA), MT, 1024, kk_}; pg8::StaticOrder S; S.init(MT, 1024, F.G, (int)blockIdx.x);
        pg8::EpiGated E{(const bf16*)(F.ws + B_GATE), 0, nullptr, (bf16*)(F.ws + B_MRG)};
        for (int rep_ = 0; rep_ < (((MK_DBL >> K_M1) & 1) ? 2 : 1); ++rep_) { pg8::gemm_phase<pg8::EpiGated, pg8::StaticOrder, true, true>(F.lds + RING_OFF, g, S, E); }
    } PH_END(P0 + K_M1)
    PH_BEGIN(P0 + K_M2) {
        int kk_ = 1024; asm volatile("" : "+s"(kk_)); pg8::Gemm g{(const bf16*)(F.ws + B_ORW), (const bf16*)(WL + W_ORW), MT, 1024, kk_}; pg8::StaticOrder S; S.init(MT, 1024, F.G, (int)blockIdx.x);
        pg8::EpiGated E{(const bf16*)(F.ws + B_GATE), 1024, (const bf16*)(F.ws + B_MRG), (bf16*)(F.ws + B_MRG)};
        pg8::gemm_phase<pg8::EpiGated, pg8::StaticOrder, true, true>(F.lds + RING_OFF, g, S, E);
    } PH_END(P0 + K_M2)
    PH_BEGIN(P0 + K_WO) {
        int kk_ = 1024; asm volatile("" : "+s"(kk_)); pg8::Gemm g{(const bf16*)(F.ws + B_MRG), (const bf16*)(WL + W_OUT), MT, 1024, kk_}; pg8::StaticOrder S; S.init(MT, 1024, F.G, (int)blockIdx.x);
        pg8::EpiRes E{F.out + O_YP, (bf16*)(F.ws + WS_XB), SSP + (size_t)(2 * l + 1) * MT};
        pg8::gemm_phase<pg8::EpiRes, pg8::StaticOrder, true, true>(F.lds + RING_OFF, g, S, E);
    } PH_END(P0 + K_WO)
    PH_BEGIN(P0 + K_UP) {
        int kk_ = 1024; asm volatile("" : "+s"(kk_)); pg8::Gemm g{(const bf16*)(F.ws + WS_XB), (const bf16*)(WL + W_UP), MT, UPW, kk_}; pg8::StaticOrder S; S.init(MT, UPW, F.G, (int)blockIdx.x);
        pg8::EpiUp E{SSP + (size_t)(2 * l + 1) * MT, (bf16*)(F.ws + B_UP), F.out + O_CVP + (size_t)l * BATCH * 2 * UPW, F.out + O_CVS + (size_t)l * DEC_BATCH * 2 * UPW};
        for (int rep_ = 0; rep_ < (((MK_DBL >> K_UP) & 1) ? 2 : 1); ++rep_) { pg8::gemm_phase<pg8::EpiUp, pg8::StaticOrder, true, true>(F.lds + RING_OFF, g, S, E); }
    } PH_END(P0 + K_UP)
    PH_BEGIN(P0 + K_CV) { for (int rep_ = 0; rep_ < (((MK_DBL >> K_CV) & 1) ? 2 : 1); ++rep_) { ph_conv(F, ap, l); } } PH_END(P0 + K_CV)
    PH_BEGIN(P0 + K_DN) {
        int kk_ = D_FF; asm volatile("" : "+s"(kk_)); pg8::Gemm g{(const bf16*)(F.ws + B_GT), (const bf16*)(WL + W_DN), MT, 1024, kk_}; pg8::StaticOrder S; S.init(MT, 1024, F.G, (int)blockIdx.x);
        pg8::EpiRes E{F.out + O_YP, (bf16*)(F.ws + WS_XB), SSP + (size_t)(2 * l + 2) * MT};
        pg8::gemm_phase<pg8::EpiRes, pg8::StaticOrder, true, true>(F.lds + RING_OFF, g, S, E);
    } PH_END(P0 + K_DN)
#undef WL
#undef SSP
}

__global__ void __launch_bounds__(NWAVES * 64, 2) mk_fwd(Args args) {
    extern __shared__ __attribute__((aligned(16))) unsigned char lds[];
    Frame F;
    F.lds = (LAS unsigned char*)lds;
    F.MISC = (volatile LAS unsigned*)(F.lds + MISC_OFF);
    F.tid = threadIdx.x; F.lane = F.tid & 63; F.wave = __builtin_amdgcn_readfirstlane(F.tid >> 6);
    F.G = gridDim.x; { const int bx = blockIdx.x; F.vcu = (F.G % 8 == 0) ? (bx % 8) * (F.G / 8) + bx / 8 : bx; }
    F.out = (float*)args.out; F.ws = (unsigned char*)args.ws;
    F.ctl = (gu32*)(args.ws + WS_CTL);
    for (int u = F.tid; u < (LDS_BYTES - LDSCTL_OFF) / 4; u += NWAVES * 64) ((LAS unsigned*)(F.lds + LDSCTL_OFF))[u] = 0u;
    __syncthreads();
    XcdBarrier bar; bar.bar = (unsigned*)(F.ctl + CW_BAR); bar.x = 0; bar.st = nullptr;
    if (!MK_PER_PHASE) bar = xcd_barrier_post((unsigned*)(F.ctl + CW_BAR), F.MISC + 8);
    const int lo = args.ph_lo, hi = args.ph_hi;
    CArgsP ap;
    PH_BEGIN(0) { p0_prologue(F, ap); } PH_END(0)
    layer_phases<0>(F, ap, bar, lo, hi);
    layer_phases<1>(F, ap, bar, lo, hi);
    PH_BEGIN(NPHASE - 1) { ph_final(F, ap); } PH_END(NPHASE - 1)
}

extern "C" void kernel_launch(void* const* d_in, const int* in_sizes, int n_in, void* d_out, int out_size, void* d_ws, size_t ws_size, hipStream_t stream) {
    (void)in_sizes;
    static int grid = 0;
    if (grid == 0) {
        if (n_in != 31 || out_size != (int)O_END || ws_size < B_END2) { fprintf(stderr, "kernel_launch: unexpected shapes (n_in %d out %d ws %zu)\n", n_in, out_size, ws_size); grid = -1; return; }
        int dev = 0, cus = 0;
        if (hipGetDevice(&dev) != hipSuccess || hipDeviceGetAttribute(&cus, hipDeviceAttributeMultiprocessorCount, dev) != hipSuccess) { grid = -1; return; }
        if (hipFuncSetAttribute((const void*)mk_fwd, hipFuncAttributeMaxDynamicSharedMemorySize, LDS_BYTES) != hipSuccess) { fprintf(stderr, "kernel_launch: hipFuncSetAttribute failed\n"); grid = -1; return; }
        (void)hipGetLastError();
        grid = cus;
    }
    if (grid < 0) return;
    if (hipMemsetAsync((char*)d_ws + WS_CTL, 0, CTL_ZERO_BYTES, stream) != hipSuccess) { fprintf(stderr, "kernel_launch: memset failed\n"); return; }
    Args a{};
    for (int i = 0; i < 31; ++i) a.in[i] = (const GAS float*)d_in[i];
    a.out = (GAS float*)d_out; a.ws = (GAS unsigned char*)d_ws;
    for (int i = 0; i < 8; ++i) a.rinv[i] = (float)pow(500000.0, -(double)i / 8.0);
#if MK_PER_PHASE
    for (int p = 0; p < NPHASE; ++p) { a.ph_lo = p; a.ph_hi = p + 1; hipLaunchKernelGGL(mk_fwd, dim3(grid), dim3(NWAVES * 64), LDS_BYTES, stream, a); }
#else
    a.ph_lo = 0; a.ph_hi = NPHASE;
    hipLaunchKernelGGL(mk_fwd, dim3(grid), dim3(NWAVES * 64), LDS_BYTES, stream, a);
#endif
    const hipError_t le = hipPeekAtLastError();
    if (le != hipSuccess) fprintf(stderr, "kernel_launch: launch failed: %s\n", hipGetErrorName(le));
}
```

```cpp
#include <hip/hip_runtime.h>
#include <cstdio>
#include <cstdint>
#include <cmath>

#ifndef MK_PER_PHASE
#define MK_PER_PHASE 0
#endif

constexpr int D_MODEL = 1024, BATCH = 8, SEQ = 2048, DEPTH = 2, DEC_BATCH = 8, DEC_SEQ = 32, PAST_LEN = 2048;
constexpr float EPS = 1e-6f, GN_EPS = 64e-5f;
constexpr int DA_HEADS = 8, RW_HEADS = 16;
constexpr int D_FF = 2816, UPW = 2 * D_FF;
constexpr int P_DA = 3072, P_RW = 3328, P_GATE = 2048, P_TOTAL = 8448;
constexpr int MP = BATCH * SEQ, MS = DEC_BATCH * DEC_SEQ, MT = MP + MS;
constexpr int NKEYS_S = PAST_LEN + DEC_SEQ;
constexpr float C2 = 0.125f * 1.4426950408889634f;

constexpr size_t O_YP = 0;
constexpr size_t O_YS = O_YP + (size_t)MP * D_MODEL;
constexpr size_t O_KP = O_YS + (size_t)MS * D_MODEL;
constexpr size_t O_VP = O_KP + (size_t)DEPTH * MP * 1024;
constexpr size_t O_WKVP = O_VP + (size_t)DEPTH * MP * 1024;
constexpr size_t O_SHP = O_WKVP + (size_t)DEPTH * BATCH * RW_HEADS * 64 * 64;
constexpr size_t O_CVP = O_SHP + (size_t)DEPTH * BATCH * P_RW;
constexpr size_t O_KS = O_CVP + (size_t)DEPTH * BATCH * 2 * UPW;
constexpr size_t O_VS = O_KS + (size_t)DEPTH * MS * 1024;
constexpr size_t O_WKVS = O_VS + (size_t)DEPTH * MS * 1024;
constexpr size_t O_SHS = O_WKVS + (size_t)DEPTH * DEC_BATCH * RW_HEADS * 64 * 64;
constexpr size_t O_CVS = O_SHS + (size_t)DEPTH * DEC_BATCH * P_RW;
constexpr size_t O_END = O_CVS + (size_t)DEPTH * DEC_BATCH * 2 * UPW;
static_assert(O_END == 87760896, "output size");

namespace pg8 {
#define PG8_LAS __attribute__((address_space(3)))
typedef unsigned short bf16_t;
typedef short bf16x8 __attribute__((ext_vector_type(8)));
typedef float f32x4 __attribute__((ext_vector_type(4)));
typedef unsigned u32x4 __attribute__((ext_vector_type(4)));
constexpr int BM = 256, BK = 64, HALF = 128, HTB = HALF * BK * 2  , STAGE_BYTES = 8 * HTB, NXCD = 8, WGM = 8;

__host__ __device__ __forceinline__ int lds_byte(int r, int c) { const int st = (r >> 4) * 2 + (c >> 5), rr = r & 15, cc = c & 31, ob = rr * 64 + cc * 2; return st * 1024 + (ob ^ (((ob >> 9) & 1) << 5)); }
__host__ __device__ __forceinline__ void stage_rc(int b, int& R, int& C) { const int st = b / 1024, sb = b % 1024, swz = sb ^ (((sb >> 9) & 1) << 5); R = (st >> 1) * 16 + swz / 64; C = (st & 1) * 32 + (swz % 64) / 2; }
__host__ __device__ __forceinline__ int perm32(int rho) { const int n = rho >> 4, i = rho & 15; return 8 * (i >> 2) + 4 * n + (i & 3); }

struct Unit { int pm, pn; };
struct Gemm { const bf16_t* A; const bf16_t* Bt; int M, N, K; };

struct StaticOrder {
    int nM, nN, nwg, G, c;
    __host__ __device__ void init(int M, int N, int G_, int c_) { nM = M / BM; nN = N / BM; nwg = nM * nN; G = G_; c = c_; }
    __host__ __device__ bool next(int i, Unit& u) const {
        const long L = (long)i * G + c; if (L >= nwg) return false;
        int wgid = (int)L; { const int q = nwg / NXCD, r = nwg % NXCD, xcd = wgid % NXCD, off = wgid / NXCD; wgid = (xcd < r ? xcd * (q + 1) : r * (q + 1) + (xcd - r) * q) + off; }
        const int nig = WGM * nN, gid = wgid / nig, fm = gid * WGM, gsz = (nM - fm) < WGM ? (nM - fm) : WGM;
        u.pm = fm + ((wgid % nig) % gsz); u.pn = (wgid % nig) / gsz; return true;
    }
    __device__ __forceinline__ void a_ready(const Unit&) const {}
    __device__ __forceinline__ void done(const Unit&) const {}
};

typedef float f32x2_cv __attribute__((ext_vector_type(2))); typedef __bf16 bf16x2_cv __attribute__((ext_vector_type(2)));
__device__ __forceinline__ unsigned cvt_pk_bf16(float lo, float hi) { const f32x2_cv v = {lo, hi}; const bf16x2_cv b = __builtin_convertvector(v, bf16x2_cv); return __builtin_bit_cast(unsigned, b); }
typedef float f32x2 __attribute__((ext_vector_type(2)));
__device__ __forceinline__ float bf2f(unsigned short h) { return __uint_as_float((unsigned)h << 16); }
__device__ __forceinline__ float fast_sigmoid(float x) { return __builtin_amdgcn_rcpf(1.0f + __builtin_amdgcn_exp2f(-1.4426950408889634f * x)); }
__device__ __forceinline__ float neg_decay_log(float x) {
    const float y = -x, sp = fmaxf(y, 0.f) + 0.6931471805599453f * __builtin_amdgcn_logf(1.0f + __builtin_amdgcn_exp2f(-1.4426950408889634f * fabsf(y)));
    return -__builtin_amdgcn_exp2f(-1.4426950408889634f * (sp + 0.5f));
}
__device__ __forceinline__ u32x4 pack8(const f32x4 v0, const f32x4 v1) { u32x4 w; w.x = cvt_pk_bf16(v0[0], v0[1]); w.y = cvt_pk_bf16(v0[2], v0[3]); w.z = cvt_pk_bf16(v1[0], v1[1]); w.w = cvt_pk_bf16(v1[2], v1[3]); return w; }
__device__ __forceinline__ void unpack8(const u32x4 w, f32x4& v0, f32x4& v1) {
    v0[0] = __uint_as_float(w.x << 16); v0[1] = __uint_as_float(w.x & 0xffff0000u); v0[2] = __uint_as_float(w.y << 16); v0[3] = __uint_as_float(w.y & 0xffff0000u);
    v1[0] = __uint_as_float(w.z << 16); v1[1] = __uint_as_float(w.z & 0xffff0000u); v1[2] = __uint_as_float(w.w << 16); v1[3] = __uint_as_float(w.w & 0xffff0000u);
}
constexpr int E_MP = 16384, E_MS = 256;

struct EpiIn {
    static constexpr bool PERM = true, AFTER_DRAIN = false;
    const float* ss; const float* rope;
    bf16_t *Q, *K, *V, *URW, *GATE;
    float *kout_p, *vout_p, *kout_s, *vout_s;
    float *sh_p, *sh_s;
    __device__ __forceinline__ void operator()(const f32x4 (&acc)[2][2][4][2], const Unit& u, int wr, int wc, int fr, int fq) const {
        const int pn = u.pn, rowb = u.pm * BM + wr * 64 + fr, cl = wc * 32 + 8 * fq;
        const bool rope_wave = (pn < 8) && ((wc & 1) == 0);
        const float sgn = (fq == 0) ? -1.f : 1.f;
#pragma unroll
        for (int ai = 0; ai < 2; ++ai)
#pragma unroll
            for (int m = 0; m < 4; ++m) {
                const int row = rowb + ai * HALF + m * 16;
                const float rstd = 1.0f / sqrtf(ss[row] * (1.0f / 1024.f) + 1e-6f);
                const bool smp = row >= E_MP;
                const int t = smp ? ((row - E_MP) & 31) : (row & 2047);
                const int bb = smp ? ((row - E_MP) >> 5) : (row >> 11);
                const int pos = smp ? 2048 + t : t;
                const bool last = smp ? (t == 31) : (t == 2047);
#pragma unroll
                for (int bj = 0; bj < 2; ++bj) {
                    f32x4 v0 = acc[ai][bj][m][0] * rstd, v1 = acc[ai][bj][m][1] * rstd;
                    const int col = pn * BM + bj * HALF + cl;
                    if (pn < 8) {
                        if (rope_wave) {
                            f32x4 p0, p1;
#pragma unroll
                            for (int j = 0; j < 4; ++j) { p0[j] = __shfl_xor(v0[j], 16); p1[j] = __shfl_xor(v1[j], 16); }
                            if (fq < 2) {
                                const float* tb = rope + pos * 16;
                                const f32x4 c0 = *(const f32x4*)(tb), c1 = *(const f32x4*)(tb + 4), s0 = *(const f32x4*)(tb + 8), s1 = *(const f32x4*)(tb + 12);
                                v0 = v0 * c0 + (p0 * s0) * sgn; v1 = v1 * c1 + (p1 * s1) * sgn;
                            }
                        }
                        if (pn < 4) { v0 = v0 * C2; v1 = v1 * C2; *(u32x4*)(Q + (size_t)row * 1024 + col) = pack8(v0, v1); }
                        else {
                            const int c = col - 1024;
                            *(u32x4*)(K + (size_t)row * 1024 + c) = pack8(v0, v1);
                            float* o = smp ? kout_s + (size_t)(row - E_MP) * 1024 + c : kout_p + (size_t)row * 1024 + c;
                            *(f32x4*)o = v0; *(f32x4*)(o + 4) = v1;
                        }
                    } else if (pn < 12) {
                        const int c = col - 2048;
                        *(u32x4*)(V + (size_t)row * 1024 + c) = pack8(v0, v1);
                        float* o = smp ? vout_s + (size_t)(row - E_MP) * 1024 + c : vout_p + (size_t)row * 1024 + c;
                        *(f32x4*)o = v0; *(f32x4*)(o + 4) = v1;
                    } else if (pn < 25) {
                        const int c = col - 3072;
                        *(u32x4*)(URW + (size_t)row * 3328 + c) = pack8(v0, v1);
                        if (last) { float* o = (smp ? sh_s : sh_p) + (size_t)bb * 3328 + c; *(f32x4*)o = v0; *(f32x4*)(o + 4) = v1; }
                    } else {
                        const int c = col - 6400;
#pragma unroll
                        for (int j = 0; j < 4; ++j) { v0[j] = fast_sigmoid(v0[j]); v1[j] = fast_sigmoid(v1[j]); }
                        *(u32x4*)(GATE + (size_t)row * 2048 + c) = pack8(v0, v1);
                    }
                }
            }
    }
};

struct EpiLora {
    static constexpr bool PERM = true, AFTER_DRAIN = false;
    const float *w0, *a0; bf16_t *LD, *LA, *LG;
    __device__ __forceinline__ void operator()(const f32x4 (&acc)[2][2][4][2], const Unit& u, int wr, int wc, int fr, int fq) const {
        const int pn = u.pn, rowb = u.pm * BM + wr * 64 + fr, cl = wc * 32 + 8 * fq;
        const int seg = pn >> 2;
#pragma unroll
        for (int bj = 0; bj < 2; ++bj) {
            const int c = (pn & 3) * BM + bj * HALF + cl;
            f32x4 b0 = (f32x4){0.f, 0.f, 0.f, 0.f}, b1 = b0;
            if (seg == 0) { b0 = *(const f32x4*)(w0 + c); b1 = *(const f32x4*)(w0 + c + 4); }
            else if (seg == 1) { b0 = *(const f32x4*)(a0 + c); b1 = *(const f32x4*)(a0 + c + 4); }
#pragma unroll
            for (int ai = 0; ai < 2; ++ai)
#pragma unroll
                for (int m = 0; m < 4; ++m) {
                    const int row = rowb + ai * HALF + m * 16;
                    f32x4 v0 = acc[ai][bj][m][0] + b0, v1 = acc[ai][bj][m][1] + b1;
                    if (seg == 0) {
#pragma unroll
                        for (int j = 0; j < 4; ++j) { v0[j] = neg_decay_log(v0[j]); v1[j] = neg_decay_log(v1[j]); }
                        *(u32x4*)(LD + (size_t)row * 1024 + c) = pack8(v0, v1);
                    } else if (seg == 1) {
#pragma unroll
                        for (int j = 0; j < 4; ++j) { v0[j] = fast_sigmoid(v0[j]); v1[j] = fast_sigmoid(v1[j]); }
                        *(u32x4*)(LA + (size_t)row * 1024 + c) = pack8(v0, v1);
                    } else {
                        *(u32x4*)(LG + (size_t)row * 1024 + c) = pack8(v0, v1);
                    }
                    asm volatile("" ::: "memory");
                }
        }
    }
};

struct EpiGated {
    static constexpr bool PERM = true, AFTER_DRAIN = false;
    const bf16_t* G; int goff; const bf16_t* S; bf16_t* O;
    __device__ __forceinline__ void operator()(const f32x4 (&acc)[2][2][4][2], const Unit& u, int wr, int wc, int fr, int fq) const {
        const int rowb = u.pm * BM + wr * 64 + fr, cl = u.pn * BM + wc * 32 + 8 * fq;
#pragma unroll
        for (int ai = 0; ai < 2; ++ai)
#pragma unroll
            for (int m = 0; m < 4; ++m) {
                const int row = rowb + ai * HALF + m * 16;
#pragma unroll
                for (int bj = 0; bj < 2; ++bj) {
                    const int c = cl + bj * HALF;
                    f32x4 g0, g1; unpack8(*(const u32x4*)(G + (size_t)row * 2048 + goff + c), g0, g1);
                    f32x4 v0 = acc[ai][bj][m][0] * g0, v1 = acc[ai][bj][m][1] * g1;
                    if (S) { f32x4 s0, s1; unpack8(*(const u32x4*)(S + (size_t)row * 1024 + c), s0, s1); v0 += s0; v1 += s1; }
                    *(u32x4*)(O + (size_t)row * 1024 + c) = pack8(v0, v1);
                }
            }
    }
};

struct EpiRes {
    static constexpr bool PERM = true, AFTER_DRAIN = false;
    float* X; bf16_t* XB; float* SS;
    __device__ __forceinline__ void operator()(const f32x4 (&acc)[2][2][4][2], const Unit& u, int wr, int wc, int fr, int fq) const {
        const int rowb = u.pm * BM + wr * 64 + fr, cl = u.pn * BM + wc * 32 + 8 * fq;
#pragma unroll
        for (int ai = 0; ai < 2; ++ai)
#pragma unroll
            for (int m = 0; m < 4; ++m) {
                const int row = rowb + ai * HALF + m * 16;
                float sq = 0.f;
#pragma unroll
                for (int bj = 0; bj < 2; ++bj) {
                    const int c = cl + bj * HALF;
                    float* xp = X + (size_t)row * 1024 + c;
                    const f32x4 v0 = *(const f32x4*)xp + acc[ai][bj][m][0], v1 = *(const f32x4*)(xp + 4) + acc[ai][bj][m][1];
                    *(f32x4*)xp = v0; *(f32x4*)(xp + 4) = v1;
                    *(u32x4*)(XB + (size_t)row * 1024 + c) = pack8(v0, v1);
                    sq += (v0[0] * v0[0] + v0[1] * v0[1]) + (v0[2] * v0[2] + v0[3] * v0[3]) + (v1[0] * v1[0] + v1[1] * v1[1]) + (v1[2] * v1[2] + v1[3] * v1[3]);
                }
                sq += __shfl_xor(sq, 16); sq += __shfl_xor(sq, 32);
                if (fq == 0) atomicAdd(SS + row, sq);
            }
    }
};

struct EpiUp {
    static constexpr bool PERM = true, AFTER_DRAIN = false;
    const float* ss; bf16_t* UP; float *cv_p, *cv_s;
    __device__ __forceinline__ void operator()(const f32x4 (&acc)[2][2][4][2], const Unit& u, int wr, int wc, int fr, int fq) const {
        const int rowb = u.pm * BM + wr * 64 + fr, cl = u.pn * BM + wc * 32 + 8 * fq;
#pragma unroll
        for (int ai = 0; ai < 2; ++ai)
#pragma unroll
            for (int m = 0; m < 4; ++m) {
                const int row = rowb + ai * HALF + m * 16;
                const float rstd = 1.0f / sqrtf(ss[row] * (1.0f / 1024.f) + 1e-6f);
                const bool smp = row >= E_MP;
                const int t = smp ? ((row - E_MP) & 31) : (row & 2047);
                const int bb = smp ? ((row - E_MP) >> 5) : (row >> 11);
                const int slot = smp ? t - 30 : t - 2046;
#pragma unroll
                for (int bj = 0; bj < 2; ++bj) {
                    const int c = cl + bj * HALF;
                    const f32x4 v0 = acc[ai][bj][m][0] * rstd, v1 = acc[ai][bj][m][1] * rstd;
                    *(u32x4*)(UP + (size_t)row * 5632 + c) = pack8(v0, v1);
                    if (slot >= 0) { float* o = (smp ? cv_s : cv_p) + ((size_t)bb * 2 + slot) * 5632 + c; *(f32x4*)o = v0; *(f32x4*)(o + 4) = v1; }
                }
            }
    }
};

template <class Epi, class Sched, bool ALIGN_EPI = false, bool SP2 = false>
__device__ __forceinline__ void gemm_phase(PG8_LAS unsigned char* lds, const Gemm g, const Sched& S, const Epi& E) {
    int tid_ = threadIdx.x; asm volatile("" : "+v"(tid_));
    const int tid = tid_, wid = __builtin_amdgcn_readfirstlane(tid >> 6), lane = tid & 63, wr = wid >> 2, wc = wid & 3, fr = lane & 15, fq = lane >> 4;
    const int K = g.K, nt = K / BK;
    unsigned voffA[2], voffB[2];
#pragma unroll
    for (int i = 0; i < 2; ++i) { int R, C; stage_rc(tid * 16 + i * 8192, R, C); const int Rb = Epi::PERM ? ((R & ~31) + perm32(R & 31)) : R;
        voffA[i] = (unsigned)(R * K + C) * 2u; voffB[i] = (unsigned)(Rb * K + C) * 2u; }
    const size_t kstep = (size_t)(BK * 2);
    const size_t hstep = (size_t)HALF * K * 2;
    const size_t tstep = 2 * hstep;
    const unsigned ldsw = (unsigned)wid * 1024u;
    const int aoff = lds_byte(wr * 64 + fr, fq * 8), boff = lds_byte(wc * 32 + fr, fq * 8);
#define PG8_SA(b, h) (((b) * 2 + (h)) * HTB)
#define PG8_SB(b, h) ((4 + (b) * 2 + (h)) * HTB)
#define PG8_STAGE(bufoff, gbase, voff) do { _Pragma("unroll") for (int _i = 0; _i < 2; ++_i) \
        __builtin_amdgcn_global_load_lds((const unsigned*)((const char*)(gbase) + (voff)[_i]), (PG8_LAS unsigned*)(lds + (bufoff) + ldsw + _i * 8192), 16, 0, 0); } while (0)
#define PG8_LDA(dst, b, h) do { _Pragma("unroll") for (int m = 0; m < 4; ++m) _Pragma("unroll") for (int k = 0; k < 2; ++k) dst[m][k] = *(const PG8_LAS bf16x8*)(lds + PG8_SA(b, h) + aoff + m * 2048 + k * 1024); } while (0)
#define PG8_LDB(dst, b, h) do { _Pragma("unroll") for (int n = 0; n < 2; ++n) _Pragma("unroll") for (int k = 0; k < 2; ++k) dst[n][k] = *(const PG8_LAS bf16x8*)(lds + PG8_SB(b, h) + boff + n * 2048 + k * 1024); } while (0)
#define PG8_MMA(ai, bj, At, Bt) do { __builtin_amdgcn_s_setprio(1); _Pragma("unroll") for (int m = 0; m < 4; ++m) _Pragma("unroll") for (int n = 0; n < 2; ++n) _Pragma("unroll") for (int k = 0; k < 2; ++k) \
        acc[ai][bj][m][n] = __builtin_amdgcn_mfma_f32_16x16x32_bf16(Bt[n][k], At[m][k], acc[ai][bj][m][n], 0, 0, 0); __builtin_amdgcn_s_setprio(0); } while (0)
#define PG8_WAIT_V(n) asm volatile("s_waitcnt vmcnt(" #n ")" ::: "memory")
#define PG8_WAIT_L(n) asm volatile("s_waitcnt lgkmcnt(" #n ")" ::: "memory")
#define PG8_BAR __builtin_amdgcn_s_barrier()
#define PG8_SCHED __builtin_amdgcn_sched_barrier(0)
    Unit cur, nxt; int ui = 0;
    if (!S.next(0, cur)) return;
    f32x4 acc[2][2][4][2];
#pragma unroll
    for (int a = 0; a < 2; ++a)
#pragma unroll
        for (int b = 0; b < 2; ++b)
#pragma unroll
            for (int m = 0; m < 4; ++m)
#pragma unroll
                for (int n = 0; n < 2; ++n) acc[a][b][m][n] = (f32x4){0.f, 0.f, 0.f, 0.f};
    bf16x8 At[4][2], B0[2][2], B1[2][2];
    const char* cA = (const char*)g.A + (size_t)cur.pm * tstep; const char* cB = (const char*)g.Bt + (size_t)cur.pn * tstep;
    S.a_ready(cur);
    if constexpr (SP2) {
        PG8_STAGE(PG8_SB(0, 0), cB, voffB); PG8_STAGE(PG8_SB(0, 1), cB + hstep, voffB); PG8_STAGE(PG8_SA(0, 0), cA, voffA); PG8_STAGE(PG8_SA(0, 1), cA + hstep, voffA);
        if (wr == 1) PG8_BAR;
        PG8_WAIT_V(2); PG8_BAR;
        PG8_STAGE(PG8_SB(1, 0), cB + kstep, voffB); PG8_STAGE(PG8_SA(1, 0), cA + kstep, voffA); PG8_STAGE(PG8_SB(1, 1), cB + hstep + kstep, voffB);
        PG8_WAIT_V(6); PG8_BAR;
    } else {
        PG8_STAGE(PG8_SB(0, 0), cB, voffB); PG8_STAGE(PG8_SA(0, 0), cA, voffA); PG8_STAGE(PG8_SB(0, 1), cB + hstep, voffB); PG8_STAGE(PG8_SA(0, 1), cA + hstep, voffA);
        if (wr == 1) PG8_BAR;
        PG8_WAIT_V(4); PG8_BAR;
        PG8_STAGE(PG8_SB(1, 0), cB + kstep, voffB); PG8_STAGE(PG8_SA(1, 0), cA + kstep, voffA); PG8_STAGE(PG8_SB(1, 1), cB + hstep + kstep, voffB);
        PG8_WAIT_V(6); PG8_BAR;
    }
    for (;;) {
        const bool has_next = S.next(ui + 1, nxt);
        const char* nA = has_next ? (const char*)g.A + (size_t)nxt.pm * tstep : cA; const char* nB = has_next ? (const char*)g.Bt + (size_t)nxt.pn * tstep : cB;
        for (int t = 0; t < nt; t += 2) {
            const bool last = (t == nt - 2);
            const char* a1 = cA + (size_t)(t + 1) * kstep;
            const char* a2 = last ? nA : cA + (size_t)(t + 2) * kstep; const char* b2 = last ? nB : cB + (size_t)(t + 2) * kstep;
            const char* a3 = a2 + kstep; const char* b3 = b2 + kstep;
            if (last && has_next) S.a_ready(nxt);
            if constexpr (SP2) {
            PG8_LDB(B0, 0, 0); PG8_LDB(B1, 0, 1); PG8_SCHED; PG8_LDA(At, 0, 0); PG8_STAGE(PG8_SA(1, 1), a1 + hstep, voffA);
            PG8_WAIT_V(8); PG8_WAIT_L(0); PG8_BAR; PG8_MMA(0, 0, At, B0); PG8_MMA(0, 1, At, B1); PG8_BAR; PG8_SCHED;
            PG8_LDA(At, 0, 1); PG8_STAGE(PG8_SB(0, 0), b2, voffB); PG8_STAGE(PG8_SB(0, 1), b2 + hstep, voffB); PG8_STAGE(PG8_SA(0, 0), a2, voffA);
            PG8_WAIT_V(8); PG8_WAIT_L(0); PG8_BAR; PG8_MMA(1, 0, At, B0); PG8_MMA(1, 1, At, B1); PG8_BAR; PG8_SCHED;
            PG8_LDB(B0, 1, 0); PG8_LDB(B1, 1, 1); PG8_SCHED; PG8_LDA(At, 1, 0); PG8_STAGE(PG8_SA(0, 1), a2 + hstep, voffA);
            PG8_WAIT_V(8); PG8_WAIT_L(0); PG8_BAR; PG8_MMA(0, 0, At, B0); PG8_MMA(0, 1, At, B1); PG8_BAR; PG8_SCHED;
            PG8_LDA(At, 1, 1); PG8_STAGE(PG8_SB(1, 0), b3, voffB); PG8_STAGE(PG8_SB(1, 1), b3 + hstep, voffB); PG8_STAGE(PG8_SA(1, 0), a3, voffA);
            PG8_WAIT_V(8); PG8_WAIT_L(0); PG8_BAR; PG8_MMA(1, 0, At, B0); PG8_MMA(1, 1, At, B1); PG8_BAR; PG8_SCHED;
            } else {
            PG8_LDB(B0, 0, 0); PG8_SCHED; PG8_LDA(At, 0, 0); PG8_STAGE(PG8_SA(1, 1), a1 + hstep, voffA);
            PG8_WAIT_L(8); PG8_BAR; PG8_WAIT_L(0); PG8_MMA(0, 0, At, B0); PG8_BAR; PG8_SCHED;
            PG8_LDB(B1, 0, 1); PG8_STAGE(PG8_SB(0, 0), b2, voffB);
            PG8_BAR; PG8_WAIT_L(0); PG8_MMA(0, 1, At, B1); PG8_BAR;
            PG8_LDA(At, 0, 1); PG8_STAGE(PG8_SA(0, 0), a2, voffA);
            PG8_BAR; PG8_WAIT_L(0); PG8_MMA(1, 0, At, B0); PG8_BAR; PG8_SCHED;
            PG8_STAGE(PG8_SB(0, 1), b2 + hstep, voffB);
            PG8_WAIT_V(6); PG8_BAR; PG8_MMA(1, 1, At, B1); PG8_BAR;
            PG8_LDB(B0, 1, 0); PG8_SCHED; PG8_LDA(At, 1, 0); PG8_STAGE(PG8_SA(0, 1), a2 + hstep, voffA);
            PG8_WAIT_L(8); PG8_BAR; PG8_WAIT_L(0); PG8_MMA(0, 0, At, B0); PG8_BAR; PG8_SCHED;
            PG8_LDB(B1, 1, 1); PG8_STAGE(PG8_SB(1, 0), b3, voffB);
            PG8_BAR; PG8_WAIT_L(0); PG8_MMA(0, 1, At, B1); PG8_BAR;
            PG8_LDA(At, 1, 1); PG8_STAGE(PG8_SA(1, 0), a3, voffA);
            PG8_BAR; PG8_WAIT_L(0); PG8_MMA(1, 0, At, B0); PG8_BAR; PG8_SCHED;
            PG8_STAGE(PG8_SB(1, 1), b3 + hstep, voffB);
            PG8_WAIT_V(6); PG8_BAR; PG8_MMA(1, 1, At, B1); PG8_BAR;
            }
        }
        if constexpr (ALIGN_EPI) { if (wr == 0) PG8_BAR; }
        if constexpr (!Epi::AFTER_DRAIN) { E(acc, cur, wr, wc, fr, fq); S.done(cur); }
        if (!has_next) break;
#pragma unroll
        for (int a = 0; a < 2; ++a)
#pragma unroll
            for (int b = 0; b < 2; ++b)
#pragma unroll
                for (int m = 0; m < 4; ++m)
#pragma unroll
                    for (int n = 0; n < 2; ++n) acc[a][b][m][n] = (f32x4){0.f, 0.f, 0.f, 0.f};
        cur = nxt; cA = nA; cB = nB; ++ui;
        if constexpr (ALIGN_EPI) { if (wr == 1) PG8_BAR; }
    }
    PG8_WAIT_V(0);
    if constexpr (!ALIGN_EPI) { if (wr == 0) PG8_BAR; }
    PG8_BAR;
    if constexpr (Epi::AFTER_DRAIN) { E.fused(acc, cur, wr, wc, fr, fq, lds, wid, lane); S.done(cur); }
#undef PG8_SA
#undef PG8_SB
#undef PG8_STAGE
#undef PG8_LDA
#undef PG8_LDB
#undef PG8_MMA
#undef PG8_WAIT_V
#undef PG8_WAIT_L
#undef PG8_BAR
#undef PG8_SCHED
}
}

constexpr int NWAVES = 8;
constexpr size_t MiB = 1u << 20;
constexpr size_t WS_CTL = 0, CTL_ZERO_BYTES = 2 * MiB;
constexpr size_t WS_ROPE = 2 * MiB;
constexpr size_t WS_SP = WS_ROPE + 256 * 1024;
constexpr size_t WS_W = 8 * MiB;
constexpr size_t W_IN = 0, W_ODA = W_IN + (size_t)P_TOTAL * 1024 * 2, W_ORW = W_ODA + 2 * MiB, W_OUT = W_ORW + 2 * MiB, W_UP = W_OUT + 2 * MiB,
                 W_DN = W_UP + (size_t)UPW * 1024 * 2, W_LORA = W_DN + (size_t)1024 * D_FF * 2, W_LAYER = W_LORA + (size_t)3072 * 256 * 2;
static_assert(W_LAYER == 42467328, "weights per layer");
constexpr size_t WS_XB = WS_W + 2 * W_LAYER + (MiB - (2 * W_LAYER) % MiB) % MiB;
constexpr size_t ACT = (size_t)MT * 1024 * 2;
constexpr size_t WS_POOL = WS_XB + ACT;
constexpr size_t B_Q = WS_POOL, B_K = B_Q + ACT, B_V = B_K + ACT, B_OC = B_V + ACT  , B_OA = B_OC + 2 * ACT, B_URW = B_OA + ACT, B_GATE = B_URW + (size_t)MT * P_RW * 2,
                 B_END = B_GATE + (size_t)MT * 2048 * 2;
constexpr size_t B_LD = B_Q, B_LA = B_K, B_LG = B_V, B_LIN = B_END, B_ORW = B_Q;
constexpr size_t B_END2 = B_LIN + (size_t)MT * 256 * 2;
constexpr size_t B_MRG = B_URW;
constexpr size_t B_UP = WS_POOL, B_GT = B_URW;
static_assert(B_UP + (size_t)MT * UPW * 2 <= B_GT && B_GT + (size_t)MT * D_FF * 2 <= B_END, "FFN overlay");
static_assert(B_END2 <= 512 * MiB, "workspace map");
constexpr int CW_BAR = 4096;
constexpr int CW_LAM = 8192;
constexpr int CW_SS = 16384;
static_assert((CW_SS + 5 * MT) * 4 <= (int)CTL_ZERO_BYTES, "CTL region");
constexpr int RING_OFF = 0, RING_BYTES = 131072;
constexpr int LDSCTL_OFF = RING_BYTES, MISC_OFF = LDSCTL_OFF + 320;
constexpr int LDS_BYTES = 147456;

constexpr int PH_PER_LAYER = 11;
constexpr int NPHASE = 1 + DEPTH * PH_PER_LAYER + 1;
enum { K_G1 = 0, K_AT, K_CB, K_LR, K_SC, K_M1, K_M2, K_WO, K_UP, K_CV, K_DN };

#include <hip/hip_bf16.h>
#include <cmath>
namespace attn_body {
using bf16=__hip_bfloat16;
using bf16x8=__attribute__((ext_vector_type(8)))short;
using s16x4=__attribute__((ext_vector_type(4)))short;
using f32x16=__attribute__((ext_vector_type(16)))float;
using u32x4=__attribute__((ext_vector_type(4)))unsigned;
constexpr int BATCH=8,SEQ=2048,D=64,DM=1024;
constexpr int NW=8,QBLK=32,QB=QBLK*NW,KVBLK=64,NQB=SEQ/QB;
constexpr int ATTN_PITCH=DM, ATTN_UNIT_ROWS=QB;
__device__ __forceinline__ int crow(int r,int hi){return (r&3)+8*(r>>2)+4*hi;}
#define SBAR() __builtin_amdgcn_sched_barrier(0)
__device__ __forceinline__ void cmask(f32x16&p0,f32x16&p1,int jb,int wid){
  const float NEG=-INFINITY;
  if(jb>(wid>>1)){
    #pragma unroll
    for(int r=0;r<16;++r){p0[r]=NEG;p1[r]=NEG;}
  }
}

constexpr int NSLOT=3, SLOTB=8192;
constexpr int LDS_K=0, LDS_V=NSLOT*SLOTB, LDS_WS=2*NSLOT*SLOTB, LDS_OST=LDS_WS+NW*64*4, LDS_BYTES=LDS_OST+NW*4096;
constexpr float C2=0.125f*1.4426950408889634f;
__device__ __forceinline__ void glds16(const void*gsrc,unsigned lds_dst){unsigned keep;
  asm volatile("s_mov_b32 %0, m0\n\ts_mov_b32 m0, %2\n\ts_nop 0\n\tglobal_load_lds_dwordx4 %1, off\n\ts_mov_b32 m0, %0":"=&s"(keep):"v"(gsrc),"s"(lds_dst):"memory");}
__device__ __forceinline__ float max3f(float a,float b,float c){float r;asm("v_max3_f32 %0, %1, %2, %3":"=v"(r):"v"(a),"v"(b),"v"(c));return r;}
__device__ __forceinline__ float max2f(float a,float b){float r;asm("v_max_f32_e32 %0, %1, %2":"=v"(r):"v"(a),"v"(b));return r;}
__device__ __forceinline__ float fadd_s(float a,float b){float r;asm("v_add_f32_e32 %0, %1, %2":"=v"(r):"v"(a),"v"(b));return r;}
__device__ __forceinline__ float fsub_s(float a,float b){float r;asm("v_sub_f32_e32 %0, %1, %2":"=v"(r):"v"(a),"v"(b));return r;}
typedef float f32x2_t __attribute__((ext_vector_type(2))); typedef __bf16 bf16x2_t __attribute__((ext_vector_type(2)));
__device__ __forceinline__ unsigned cvtpk_s(float lo,float hi){f32x2_t v={lo,hi};bf16x2_t b=__builtin_convertvector(v,bf16x2_t);return __builtin_bit_cast(unsigned,b);}
#define WAIT_BAR(N) asm volatile("s_waitcnt vmcnt(" #N ") lgkmcnt(0)\n\ts_barrier":::"memory")

__device__ __forceinline__ void qkt(f32x16&p0,f32x16&p1,const char*Kslot,const bf16x8*qr,const f32x16&negm,int r32,int hi){
  const char*kb=Kslot+hi*1024+r32*16;
  #pragma unroll
  for(int d0=0;d0<4;++d0){
    const bf16x8 b0=*reinterpret_cast<const bf16x8*>(kb+d0*2048);
    const bf16x8 b1=*reinterpret_cast<const bf16x8*>(kb+d0*2048+512);
    if(d0==0){p0=__builtin_amdgcn_mfma_f32_32x32x16_bf16(b0,qr[0],negm,0,0,0);p1=__builtin_amdgcn_mfma_f32_32x32x16_bf16(b1,qr[0],negm,0,0,0);}
    else{p0=__builtin_amdgcn_mfma_f32_32x32x16_bf16(b0,qr[d0],p0,0,0,0);p1=__builtin_amdgcn_mfma_f32_32x32x16_bf16(b1,qr[d0],p1,0,0,0);}}
}
typedef __attribute__((address_space(3))) const char* lds_cptr;
typedef short v4i16_t __attribute__((ext_vector_type(4)));
__device__ __forceinline__ void kload8(bf16x8*kf,lds_cptr kp){
  kf[0]=*(const __attribute__((address_space(3))) bf16x8*)(kp);      kf[1]=*(const __attribute__((address_space(3))) bf16x8*)(kp+512);
  kf[2]=*(const __attribute__((address_space(3))) bf16x8*)(kp+2048); kf[3]=*(const __attribute__((address_space(3))) bf16x8*)(kp+2560);
  kf[4]=*(const __attribute__((address_space(3))) bf16x8*)(kp+4096); kf[5]=*(const __attribute__((address_space(3))) bf16x8*)(kp+4608);
  kf[6]=*(const __attribute__((address_space(3))) bf16x8*)(kp+6144); kf[7]=*(const __attribute__((address_space(3))) bf16x8*)(kp+6656);
}
__device__ __forceinline__ void kload2(bf16x8*kf,lds_cptr kp,int j){ kf[2*j]=*(const __attribute__((address_space(3))) bf16x8*)(kp+j*2048); kf[2*j+1]=*(const __attribute__((address_space(3))) bf16x8*)(kp+j*2048+512); }
__device__ __forceinline__ s16x4 vtr(lds_cptr p){ return __builtin_bit_cast(s16x4,__builtin_amdgcn_ds_read_tr16_b64_v4i16((__attribute__((address_space(3))) v4i16_t*)p)); }
__device__ __forceinline__ float rowmax(const f32x16&p0,const f32x16&p1){
  float a=max3f(p0[0],p0[1],p1[0]),b=max3f(p0[2],p0[3],p1[1]);a=max3f(a,p1[2],p1[3]);
  #pragma unroll
  for(int r=4;r<16;r+=4){a=max3f(a,p0[r],p0[r+1]);b=max3f(b,p0[r+2],p0[r+3]);a=max3f(a,p1[r],p1[r+1]);b=max3f(b,p1[r+2],p1[r+3]);}
  const float m=max2f(a,b);
  auto rr=__builtin_amdgcn_permlane32_swap(__float_as_uint(m),__float_as_uint(m),false,false);
  return max2f(__uint_as_float(rr[0]),__uint_as_float(rr[1]));
}
__device__ __forceinline__ void pv(f32x16*o,int vb,bf16x8 pa0,bf16x8 pa1,bf16x8 pa2,bf16x8 pa3){
  #pragma unroll
  for(int d0=0;d0<2;++d0){s16x4 lo[4],hi[4];
    #pragma unroll
    for(int ks=0;ks<4;++ks){
      asm volatile("ds_read_b64_tr_b16 %0,%1 offset:%c2":"=&v"(lo[ks]):"v"(vb),"i"(d0*4096+ks*1024):"memory");
      asm volatile("ds_read_b64_tr_b16 %0,%1 offset:%c2":"=&v"(hi[ks]):"v"(vb),"i"(d0*4096+ks*1024+512):"memory");}
    asm volatile("s_waitcnt lgkmcnt(0)":::"memory");SBAR();
    #define PK(k) (bf16x8){lo[k][0],lo[k][1],lo[k][2],lo[k][3],hi[k][0],hi[k][1],hi[k][2],hi[k][3]}
    o[d0]=__builtin_amdgcn_mfma_f32_32x32x16_bf16(pa0,PK(0),o[d0],0,0,0);
    o[d0]=__builtin_amdgcn_mfma_f32_32x32x16_bf16(pa1,PK(1),o[d0],0,0,0);
    o[d0]=__builtin_amdgcn_mfma_f32_32x32x16_bf16(pa2,PK(2),o[d0],0,0,0);
    o[d0]=__builtin_amdgcn_mfma_f32_32x32x16_bf16(pa3,PK(3),o[d0],0,0,0);
    #undef PK
  }
}

#ifndef ATTN_STORE16
#define ATTN_STORE16(p,v) (*(u32x4*)(p)=(v))
#endif
template<int THRL> __device__ __forceinline__ void attn_unit(int b,int qcol,int vcol,int qb,const bf16*Q,const bf16*K,const bf16*V,bf16*O,char*shm){
  const int tid=threadIdx.x,lane=tid&63,r32=lane&31,hi=lane>>5; const int wid=__builtin_amdgcn_readfirstlane(tid>>6);
  const long rowbase=(long)b*SEQ; const int q0=qb*QB;
  const bf16*Qw=Q+(rowbase+q0+wid*QBLK)*DM+qcol;
  const bf16*Kh=K+rowbase*DM+qcol,*Vh=V+rowbase*DM+vcol;
  const unsigned lds0=(unsigned)(uintptr_t)shm;
  float*wsf=(float*)(shm+LDS_WS)+wid*64;
  const bf16*ksrc=Kh+(long)lane*DM+wid*8;
  const bf16*vsrc=Vh+(long)(16*(wid&3)+(lane>>2))*DM+(wid>>2)*32+(lane&3)*8;
  const unsigned kdst=lds0+LDS_K+wid*1024, vdst=lds0+LDS_V+wid*1024;
  #define DMA_K(t,slot) glds16(ksrc+(long)(t)*KVBLK*DM,(unsigned)__builtin_amdgcn_readfirstlane(kdst+(slot)))
  #define DMA_V(t,slot) glds16(vsrc+(long)(t)*KVBLK*DM,(unsigned)__builtin_amdgcn_readfirstlane(vdst+(slot)))
  const int vb0=(int)(lds0+LDS_V)+((lane>>4)&1)*32+(lane&3)*8+(4*hi+((lane&15)>>2))*64;
  const char*Kbase=shm+LDS_K; bf16x8 kf[8];
  const lds_cptr shm3=(lds_cptr)shm; const lds_cptr kp0=shm3+LDS_K+hi*1024+r32*16; const lds_cptr vp0=shm3+LDS_V+((lane>>4)&1)*32+(lane&3)*8+(4*hi+((lane&15)>>2))*64;
  const int NT=(q0+QB)/KVBLK;
  DMA_K(0,0);DMA_V(0,0);DMA_K(1,SLOTB);
  bf16x8 qr[4];
  #pragma unroll
  for(int d0=0;d0<4;++d0)qr[d0]=*reinterpret_cast<const bf16x8*>(&Qw[(long)r32*DM+d0*16+hi*8]);
  float mhat=0.f,l_reg=0.f;f32x16 o[2];o[0]=f32x16{};o[1]=f32x16{};const f32x16 zc=f32x16{}; float nm=0.f;
  const int qrel=wid*QBLK+r32;
  #define CMASK(P0,P1,t) do{int jb_=(t)-(NT-4); if(jb_>=0)cmask(P0,P1,jb_,wid);}while(0)
  bool resc=false;
  #define START(P0,P1) do{ const float rm=rowmax(P0,P1); resc=false; \
    { const float dl=rm; mhat=fadd_s(mhat,dl); \
      _Pragma("unroll") for(int r=0;r<16;++r){P0[r]=fsub_s(P0[r],dl);P1[r]=fsub_s(P1[r],dl);} \
      nm=-mhat; } \
    _Pragma("unroll") for(int r=0;r<16;++r)P0[r]=__builtin_amdgcn_exp2f(P0[r]); }while(0)
  #define RESC() do{ if(resc){ asm volatile("s_waitcnt lgkmcnt(0)":::"memory"); \
      _Pragma("unroll") for(int d_=0;d_<2;++d_) _Pragma("unroll") for(int r=0;r<16;++r)o[d_][r]*=wsf[crow(r,hi)]; } }while(0)
  f32x16 pA0,pA1,pB0,pB1;
  int sl_prev=0,sl_cur=0,sl_next=SLOTB;
  #define ROT() do{sl_prev=sl_cur;sl_cur=sl_next;sl_next=(sl_next==(NSLOT-1)*SLOTB)?0:sl_next+SLOTB;}while(0)
  DMA_K(2,2*SLOTB);
  WAIT_BAR(3);
  qkt(pA0,pA1,Kbase,qr,zc,r32,hi);asm volatile("s_nop 15\n\ts_nop 7":"+v"(pA0),"+v"(pA1));CMASK(pA0,pA1,0);
  START(pA0,pA1);
  _Pragma("unroll") for(int r=0;r<16;++r)pA1[r]=__builtin_amdgcn_exp2f(pA1[r]);
  WAIT_BAR(0);
  DMA_K(3,0);DMA_V(1,SLOTB);
  ROT();
  kload8(kf,kp0+sl_cur);
  WAIT_BAR(2);
  s16x4 vlo[8],vhi[8]; u32x4 pw0,pw1,pw2,pw3;
  #define PKW(P,B) cvtpk_s(P[B],P[B+1])
  #define PAF(k) __builtin_bit_cast(bf16x8,pw##k)
  #define VFR(i) (bf16x8){vlo[i][0],vlo[i][1],vlo[i][2],vlo[i][3],vhi[i][0],vhi[i][1],vhi[i][2],vhi[i][3]}
  #define PIN(x) asm volatile("":"+v"(x))
  #define MX3(a,b,c) __builtin_fmaxf(__builtin_fmaxf((a),(b)),(c))
  #define GAPA(MF,A0,A1,A2,A3,W0,W1,PW) do{ MF; sacc+=A0; sacc+=A1; sacc+=A2; sacc+=A3; PIN(sacc); W0; W1; PIN(PW); SBAR(); }while(0)
  #define EX(v) __builtin_amdgcn_exp2f(v)
  #define GAPB(MF,X,B) do{ MF; X[B]=EX(X[B]); X[B+1]=EX(X[B+1]); X[B+2]=EX(X[B+2]); X[B+3]=EX(X[B+3]); PIN(X); SBAR(); }while(0)
  #define VRD(i) do{ vlo[i]=vtr(vp_+(((i)>>2)*4096+((i)&3)*1024)); vhi[i]=vtr(vp_+(((i)>>2)*4096+((i)&3)*1024+512)); }while(0)
  #define KRD(G,j) do{ if(G){ kload2(kf,kp0+sl_next,j); SBAR(); } }while(0)
  #define STEP(C0,C1,P0,P1,t,GK,GV,GL) do{ SBAR(); \
    const lds_cptr vp_=vp0+sl_prev; \
    VRD(0); SBAR(); float sacc=(P0[0]+P0[1]); \
    GAPA(C0=__builtin_amdgcn_mfma_f32_32x32x16_bf16(kf[0],qr[0],zc,0,0,0), P0[2],P0[3],P0[4],P0[5],     pw0[0]=PKW(P0,0), pw0[1]=PKW(P0,2), pw0); \
    VRD(4); SBAR(); GAPA(C1=__builtin_amdgcn_mfma_f32_32x32x16_bf16(kf[1],qr[0],zc,0,0,0), P0[6],P0[7],P0[8],P0[9],     pw0[2]=PKW(P0,4), pw0[3]=PKW(P0,6), pw0); \
    VRD(1); SBAR(); GAPA(C0=__builtin_amdgcn_mfma_f32_32x32x16_bf16(kf[2],qr[1],C0,0,0,0),   P0[10],P0[11],P0[12],P0[13], pw1[0]=PKW(P0,8), pw1[1]=PKW(P0,10), pw1); \
    VRD(5); SBAR(); GAPA(C1=__builtin_amdgcn_mfma_f32_32x32x16_bf16(kf[3],qr[1],C1,0,0,0),   P0[14],P0[15],P1[0],P1[1],   pw1[2]=PKW(P0,12),pw1[3]=PKW(P0,14), pw1); \
    VRD(2); SBAR(); GAPA(C0=__builtin_amdgcn_mfma_f32_32x32x16_bf16(kf[4],qr[2],C0,0,0,0),   P1[2],P1[3],P1[4],P1[5],     pw2[0]=PKW(P1,0), pw2[1]=PKW(P1,2), pw2); \
    VRD(6); SBAR(); GAPA(C1=__builtin_amdgcn_mfma_f32_32x32x16_bf16(kf[5],qr[2],C1,0,0,0),   P1[6],P1[7],P1[8],P1[9],     pw2[2]=PKW(P1,4), pw2[3]=PKW(P1,6), pw2); \
    VRD(3); SBAR(); GAPA(C0=__builtin_amdgcn_mfma_f32_32x32x16_bf16(kf[6],qr[3],C0,0,0,0),   P1[10],P1[11],P1[12],P1[13], pw3[0]=PKW(P1,8), pw3[1]=PKW(P1,10), pw3); \
    VRD(7); SBAR(); GAPA(C1=__builtin_amdgcn_mfma_f32_32x32x16_bf16(kf[7],qr[3],C1,0,0,0),   P1[14],P1[15],0.f,0.f,       pw3[2]=PKW(P1,12),pw3[3]=PKW(P1,14), pw3); \
    l_reg+=sacc; \
    if(GK){DMA_K((t)+3,sl_cur);} if(GV){DMA_V((t)+1,sl_next);} \
    _Pragma("unroll") for(int r=0;r<16;++r){C0[r]+=nm;C1[r]+=nm;} \
    CMASK(C0,C1,t); \
    { float a=MX3(C0[0],C0[1],C1[0]),b=MX3(C0[2],C0[3],C1[1]); a=MX3(a,C1[2],C1[3]); \
      _Pragma("unroll") for(int r=4;r<16;r+=4){a=MX3(a,C0[r],C0[r+1]);b=MX3(b,C0[r+2],C0[r+3]);a=MX3(a,C1[r],C1[r+1]);b=MX3(b,C1[r+2],C1[r+3]);} \
      float rm=__builtin_fmaxf(a,b); { auto rr=__builtin_amdgcn_permlane32_swap(__float_as_uint(rm),__float_as_uint(rm),false,false); rm=__builtin_fmaxf(__uint_as_float(rr[0]),__uint_as_float(rr[1])); } \
      resc=false; \
      if(__builtin_expect(__any(rm>(float)THRL),0)){ const float dl=__builtin_fmaxf(rm,0.f); mhat+=dl; \
        _Pragma("unroll") for(int r=0;r<16;++r){C0[r]-=dl;C1[r]-=dl;} \
        nm=-mhat; \
        const float f=__builtin_amdgcn_exp2f(-dl); l_reg*=f; if(hi==0)wsf[r32]=f; resc=true; } } \
    SBAR(); \
    GAPB(o[0]=__builtin_amdgcn_mfma_f32_32x32x16_bf16(PAF(0),VFR(0),o[0],0,0,0), C0,0); \
    GAPB(o[1]=__builtin_amdgcn_mfma_f32_32x32x16_bf16(PAF(0),VFR(4),o[1],0,0,0), C0,4); \
    KRD(GL,0); GAPB(o[0]=__builtin_amdgcn_mfma_f32_32x32x16_bf16(PAF(1),VFR(1),o[0],0,0,0), C0,8); \
    KRD(GL,1); GAPB(o[1]=__builtin_amdgcn_mfma_f32_32x32x16_bf16(PAF(1),VFR(5),o[1],0,0,0), C0,12); \
    KRD(GL,2); GAPB(o[0]=__builtin_amdgcn_mfma_f32_32x32x16_bf16(PAF(2),VFR(2),o[0],0,0,0), C1,0); \
    KRD(GL,3); GAPB(o[1]=__builtin_amdgcn_mfma_f32_32x32x16_bf16(PAF(2),VFR(6),o[1],0,0,0), C1,4); \
    GAPB(o[0]=__builtin_amdgcn_mfma_f32_32x32x16_bf16(PAF(3),VFR(3),o[0],0,0,0), C1,8); \
    GAPB(o[1]=__builtin_amdgcn_mfma_f32_32x32x16_bf16(PAF(3),VFR(7),o[1],0,0,0), C1,12); \
    }while(0)
  int t=1;
  #undef CMASK
  #define CMASK(P0,P1,t) do{}while(0)
  for(;t+5<NT;t+=2){
    STEP(pB0,pB1,pA0,pA1,t,true,true,true);     WAIT_BAR(2); RESC(); ROT();
    STEP(pA0,pA1,pB0,pB1,t+1,true,true,true);   WAIT_BAR(2); RESC(); ROT();
  }
  #undef CMASK
  #define CMASK(P0,P1,t) do{int jb_=(t)-(NT-4); if(jb_>=0)cmask(P0,P1,jb_,wid);}while(0)
  #define ENDW(tt) do{ if((tt)+3<NT){WAIT_BAR(2);} else if((tt)+2<NT){WAIT_BAR(1);} else {WAIT_BAR(0);} }while(0)
  for(;t+1<NT;t+=2){
    STEP(pB0,pB1,pA0,pA1,t,(t+3<NT),(t+1<NT),(t+1<NT));       ENDW(t);   RESC(); ROT();
    STEP(pA0,pA1,pB0,pB1,t+1,(t+4<NT),(t+2<NT),(t+2<NT));     ENDW(t+1); RESC(); ROT();
  }
  STEP(pB0,pB1,pA0,pA1,NT-1,false,false,false); RESC();
  { float sacc=pB0[0]+pB0[1]; _Pragma("unroll") for(int r=2;r<16;++r)sacc+=pB0[r]; _Pragma("unroll") for(int r=0;r<16;++r)sacc+=pB1[r]; l_reg+=sacc;
    pw0=(u32x4){PKW(pB0,0),PKW(pB0,2),PKW(pB0,4),PKW(pB0,6)};pw1=(u32x4){PKW(pB0,8),PKW(pB0,10),PKW(pB0,12),PKW(pB0,14)};pw2=(u32x4){PKW(pB1,0),PKW(pB1,2),PKW(pB1,4),PKW(pB1,6)};pw3=(u32x4){PKW(pB1,8),PKW(pB1,10),PKW(pB1,12),PKW(pB1,14)};
    SBAR(); pv(o,vb0+sl_cur,PAF(0),PAF(1),PAF(2),PAF(3)); }
  #undef PKW
  #undef PAF
  #undef VFR
  #undef PIN
  #undef MX3
  #undef GAPA
  #undef GAPB
  #undef EX
  #undef VRD
  #undef KRD
  #undef STEP
  #undef ENDW
  {auto rr=__builtin_amdgcn_permlane32_swap(__float_as_uint(l_reg),__float_as_uint(l_reg),false,false);l_reg=__uint_as_float(rr[0])+__uint_as_float(rr[1]);}
  if(hi==0)wsf[32+r32]=l_reg;asm volatile("s_waitcnt lgkmcnt(0)":::"memory");
  float rli[16];
  #pragma unroll
  for(int r=0;r<16;++r)rli[r]=__builtin_amdgcn_rcpf(wsf[32+crow(r,hi)]);
  bf16*Ow=O+(rowbase+q0+wid*QBLK)*DM+vcol;
  { bf16*stg=(bf16*)(shm+LDS_OST)+wid*2048;
    #pragma unroll
    for(int r=0;r<16;++r){const int orow=crow(r,hi);
      #pragma unroll
      for(int d0=0;d0<2;++d0)stg[orow*64+d0*32+r32]=__float2bfloat16(o[d0][r]*rli[r]);}
    asm volatile("s_waitcnt lgkmcnt(0)":::"memory");
    #pragma unroll
    for(int i=0;i<4;++i){const int row=i*8+(lane>>3),ch=lane&7; const u32x4 v=*(const u32x4*)(stg+row*64+ch*8); ATTN_STORE16(Ow+(long)row*DM+ch*8,v);} }
  asm volatile("s_waitcnt lgkmcnt(0)\n\ts_barrier":::"memory");
  #undef DMA_K
  #undef DMA_V
  #undef CMASK
  #undef START
  #undef RESC
  #undef ROT
}
typedef float f32x4 __attribute__((ext_vector_type(4)));
constexpr int SA_K0=0, SA_K1=8192, SA_V0=16384, SA_V1=24576, SA_WS=32768, SA_BYTES=SA_WS+8*256;
__device__ __forceinline__ unsigned pk2bf(float lo,float hi){return cvtpk_s(lo,hi);}
__device__ __forceinline__ void sample_unit(int l,int b,int h,int s,const float*cache_k,const float*cache_v,const bf16*Q,const bf16*K,const bf16*V,float*SP,char*shm){
  const int tid=threadIdx.x,lane=tid&63,r32=lane&31,hi=lane>>5; const int wid=__builtin_amdgcn_readfirstlane(tid>>6);
  const unsigned lds0=(unsigned)(uintptr_t)shm;
  float*wsf=(float*)(shm+SA_WS)+wid*64;
  const int c=wid>>1,vh=wid&1;
  const int qrow=16384+b*32;
  bf16x8 qr[4];
  if(wid<4){
    #pragma unroll
    for(int d0=0;d0<4;++d0)qr[d0]=*reinterpret_cast<const bf16x8*>(&Q[(long)(qrow+r32)*DM+h*128+c*64+d0*16+hi*8]);
  }
  float m=-1e30f,lsum=0.f; f32x16 o[2]; o[0]=f32x16{}; o[1]=f32x16{};
  const f32x16 zc=f32x16{};
  const int ntile=(s==7)?5:4;
  const float*ckb=cache_k+((long)(l*8+b)*2048)*1024+h*128; const float*cvb=cache_v+((long)(l*8+b)*2048)*1024+h*128;
  for(int ti=0;ti<ntile;++ti){
    const bool fresh=(ti==4);
    #pragma unroll
    for(int pi=0;pi<2;++pi){
      const int pk=wid*2+pi;
      { const int kc=pk>>3,ch=pk&7; u32x4 wv;
        if(!fresh){ const float*src=ckb+(long)((4*s+ti)*64+lane)*1024+kc*64+ch*8; const f32x4 a=*(const f32x4*)src,bq=*(const f32x4*)(src+4);
          wv.x=pk2bf(a.x,a.y);wv.y=pk2bf(a.z,a.w);wv.z=pk2bf(bq.x,bq.y);wv.w=pk2bf(bq.z,bq.w); }
        else if(lane<32){ wv=*(const u32x4*)(K+(long)(qrow+lane)*DM+h*128+kc*64+ch*8); }
        else { wv=(u32x4){0u,0u,0u,0u}; }
        *(u32x4*)(shm+(kc?SA_K1:SA_K0)+ch*1024+lane*16)=wv; }
      { const int vv=pk>>3,p=pk&7; const int row=16*(p&3)+(lane>>2),col=vv*64+32*(p>>2)+8*(lane&3); u32x4 wv;
        if(!fresh){ const float*src=cvb+(long)((4*s+ti)*64+row)*1024+col; const f32x4 a=*(const f32x4*)src,bq=*(const f32x4*)(src+4);
          wv.x=pk2bf(a.x,a.y);wv.y=pk2bf(a.z,a.w);wv.z=pk2bf(bq.x,bq.y);wv.w=pk2bf(bq.z,bq.w); }
        else if(row<32){ wv=*(const u32x4*)(V+(long)(qrow+row)*DM+h*128+col); }
        else { wv=(u32x4){0u,0u,0u,0u}; }
        *(u32x4*)(shm+(vv?SA_V1:SA_V0)+p*1024+lane*16)=wv; }
    }
    __syncthreads();
    if(wid<4){
      f32x16 p0,p1;
      qkt(p0,p1,shm+(c?SA_K1:SA_K0),qr,zc,r32,hi);
      if(fresh){
        #pragma unroll
        for(int r=0;r<16;++r)p1[r]=-INFINITY;
      }
      float rm=p0[0];
      #pragma unroll
      for(int r=1;r<16;++r)rm=__builtin_fmaxf(rm,p0[r]);
      #pragma unroll
      for(int r=0;r<16;++r)rm=__builtin_fmaxf(rm,p1[r]);
      rm=__builtin_fmaxf(rm,__shfl_xor(rm,32));
      const float mn=__builtin_fmaxf(m,rm),alpha=__builtin_amdgcn_exp2f(m-mn);
      float ps=0.f;
      #pragma unroll
      for(int r=0;r<16;++r){p0[r]=__builtin_amdgcn_exp2f(p0[r]-mn);p1[r]=__builtin_amdgcn_exp2f(p1[r]-mn);ps+=p0[r]+p1[r];}
      lsum=lsum*alpha+ps; m=mn;
      if(hi==0)wsf[r32]=alpha;
      asm volatile("s_waitcnt lgkmcnt(0)":::"memory");
      #pragma unroll
      for(int g=0;g<4;++g){ const f32x4 f4=*(const f32x4*)(wsf+8*g+4*hi);
        #pragma unroll
        for(int i=0;i<4;++i){o[0][4*g+i]*=f4[i];o[1][4*g+i]*=f4[i];} }
      u32x4 pw0,pw1,pw2,pw3;
      pw0=(u32x4){pk2bf(p0[0],p0[1]),pk2bf(p0[2],p0[3]),pk2bf(p0[4],p0[5]),pk2bf(p0[6],p0[7])};
      pw1=(u32x4){pk2bf(p0[8],p0[9]),pk2bf(p0[10],p0[11]),pk2bf(p0[12],p0[13]),pk2bf(p0[14],p0[15])};
      pw2=(u32x4){pk2bf(p1[0],p1[1]),pk2bf(p1[2],p1[3]),pk2bf(p1[4],p1[5]),pk2bf(p1[6],p1[7])};
      pw3=(u32x4){pk2bf(p1[8],p1[9]),pk2bf(p1[10],p1[11]),pk2bf(p1[12],p1[13]),pk2bf(p1[14],p1[15])};
      const int vb=(int)(lds0+(vh?SA_V1:SA_V0))+((lane>>4)&1)*32+(lane&3)*8+(4*hi+((lane&15)>>2))*64;
      pv(o,vb,__builtin_bit_cast(bf16x8,pw0),__builtin_bit_cast(bf16x8,pw1),__builtin_bit_cast(bf16x8,pw2),__builtin_bit_cast(bf16x8,pw3));
    }
    __syncthreads();
  }
  if(wid<4){
    lsum+=__shfl_xor(lsum,32);
    float*sp=SP+((long)(((b*8+h)*2+c)*8+s)*32)*132;
    if(vh==0&&hi==0){sp[r32*132]=m;sp[r32*132+1]=lsum;}
    #pragma unroll
    for(int d0=0;d0<2;++d0)
      #pragma unroll
      for(int r=0;r<16;++r)sp[crow(r,hi)*132+4+vh*64+32*d0+r32]=o[d0][r];
  }
}
constexpr int ATTN_LDS_BYTES=LDS_BYTES;
#undef SBAR
#undef WAIT_BAR
}

#define GAS __attribute__((address_space(1)))
#define LAS __attribute__((address_space(3)))
typedef unsigned short bf16;
typedef unsigned v4u __attribute__((ext_vector_type(4)));
typedef float f32x4 __attribute__((ext_vector_type(4)));
typedef short bf16x8 __attribute__((ext_vector_type(8)));
typedef GAS unsigned gu32;
typedef GAS unsigned long long gu64;
#define RLX_AGENT __ATOMIC_RELAXED, __HIP_MEMORY_SCOPE_AGENT
#define LDS_WAIT() asm volatile("s_waitcnt lgkmcnt(0)" ::: "memory")
#define VM_WAIT() asm volatile("s_waitcnt vmcnt(0)" ::: "memory")
__device__ __forceinline__ unsigned long long rt() { return __builtin_amdgcn_s_memrealtime(); }
__device__ __forceinline__ unsigned f2bf(float f) { unsigned u = __builtin_bit_cast(unsigned, f); return (u + 0x7fffu + ((u >> 16) & 1u)) >> 16; }
__device__ __forceinline__ unsigned pk2(float lo, float hi) { return f2bf(lo) | (f2bf(hi) << 16); }

#define XB_TMO      128
#define XB_XCNT(j)  (256  + 64 * (j))
#define XB_XSUB(j)  (1280 + 64 * (j))
#define XB_XGEN(j)  (2304 + 64 * (j))
#define XB_TOP      3328
#define XB_TOPGEN   3392
#define XCD_BAR_WORDS 3456
#define XB_SPIN_CAP (1u << 22)

__device__ __forceinline__ unsigned xb_ld(unsigned* p)              { return __hip_atomic_load(p, __ATOMIC_RELAXED, __HIP_MEMORY_SCOPE_AGENT); }
__device__ __forceinline__ unsigned xb_add(unsigned* p, unsigned v) { return __hip_atomic_fetch_add(p, v, __ATOMIC_RELAXED, __HIP_MEMORY_SCOPE_AGENT); }
__device__ __forceinline__ unsigned xb_xcc_id() { return (unsigned)__builtin_amdgcn_s_getreg((3 << 11) | 20) & 0xFu; }
#define XB_SPIN(cond, bar) do { unsigned _sp = 0; while (cond) { __builtin_amdgcn_s_sleep(1); \
    if ((++_sp & 255u) == 0u) { if (xb_ld(&(bar)[XB_TMO])) break; if (_sp > XB_SPIN_CAP) { atomicAdd(&(bar)[XB_TMO], 1u); break; } } } } while (0)

struct XcdBarrier {
    unsigned* bar; unsigned x;
    volatile LAS unsigned* st;
};

__device__ __forceinline__ XcdBarrier xcd_barrier_post(unsigned* bar, volatile LAS unsigned* st) {
    XcdBarrier b; b.bar = bar; b.x = xb_xcc_id(); b.st = st;
    if (threadIdx.x == 0) (void)xb_add(&bar[XB_XCNT(b.x)], 1u);
    return b;
}
__device__ __forceinline__ void xcd_barrier_complete(unsigned* bar, unsigned x, unsigned& nloc, unsigned& nx) {
    const unsigned G = gridDim.x * gridDim.y * gridDim.z;
    unsigned sum, cnt, mine, sp = 0u;
    for (;;) {
        sum = 0u; cnt = 0u; mine = 0u;
#pragma unroll
        for (unsigned j = 0; j < 16; ++j) { const unsigned c = xb_ld(&bar[XB_XCNT(j)]); sum += c; cnt += (c > 0u) ? 1u : 0u; mine = (j == x) ? c : mine; }
        if (sum == G) break;
        __builtin_amdgcn_s_sleep(1);
        if ((++sp & 255u) == 0u) { if (xb_ld(&bar[XB_TMO])) break; if (sp > XB_SPIN_CAP) { atomicAdd(&bar[XB_TMO], 1u); break; } }
    }
    nloc = mine > 0u ? mine : 1u; nx = cnt > 0u ? cnt : 1u;
}

__device__ __forceinline__ void xcd_barrier(const XcdBarrier& b) {
    asm volatile("s_waitcnt vmcnt(0)" ::: "memory");
    __syncthreads();
    if (threadIdx.x == 0) {
        unsigned* bar = b.bar;
        __builtin_amdgcn_s_waitcnt(0);
        unsigned nloc = b.st[0], nx = b.st[1];
        if (nloc == 0u) { xcd_barrier_complete(bar, b.x, nloc, nx); b.st[0] = nloc; b.st[1] = nx; }
        const unsigned old = xb_add(&bar[XB_XSUB(b.x)], 1u);
        const unsigned gen = old / nloc;
        if (old + 1u == (gen + 1u) * nloc) {
            __builtin_amdgcn_fence(__ATOMIC_RELEASE, "agent");
            asm volatile("s_waitcnt vmcnt(0)" ::: "memory");
            const unsigned og = xb_add(&bar[XB_TOP], 1u);
            const unsigned tg = og / nx;
            if (og + 1u == (tg + 1u) * nx) xb_add(&bar[XB_TOPGEN], 1u);
            else XB_SPIN(xb_ld(&bar[XB_TOPGEN]) == tg, bar);
            __builtin_amdgcn_fence(__ATOMIC_ACQUIRE, "agent");
            xb_add(&bar[XB_XGEN(b.x)], 1u);
            asm volatile("s_waitcnt vmcnt(0)" ::: "memory");
        } else {
            XB_SPIN(xb_ld(&bar[XB_XGEN(b.x)]) == gen, bar);
            __builtin_amdgcn_fence(__ATOMIC_ACQUIRE, "agent");
            asm volatile("s_waitcnt vmcnt(0)" ::: "memory");
        }
    }
    __syncthreads();
}

struct Args { const GAS float* in[31]; GAS float* out; GAS unsigned char* ws; float rinv[8]; int ph_lo, ph_hi; };
#define GIN(A, i) ((const float*)((A)->in[i]))
typedef const Args __attribute__((address_space(4)))* CArgsP;
struct Frame {
    LAS unsigned char* lds;
    volatile LAS unsigned* MISC;
    gu32* ctl;
    int tid, lane, wave, vcu, G;
    float* out; unsigned char* ws;
};
__device__ __forceinline__ float wave_sum(float v) {
#pragma unroll
    for (int o = 1; o < 64; o <<= 1) v += __shfl_xor(v, o);
    return v;
}
template <int CTRL> __device__ __forceinline__ float dppf(float x) { return __builtin_bit_cast(float, __builtin_amdgcn_update_dpp(0, __builtin_bit_cast(int, x), CTRL, 0xF, 0xF, false)); }
__device__ __forceinline__ float reduce8(float x) { x += dppf<0xB1>(x); x += dppf<0x4E>(x); x += dppf<0x141>(x); return x; }
__device__ __forceinline__ float reduce16(float x) { x = reduce8(x); x += dppf<0x140>(x); return x; }
__device__ __forceinline__ float bf2f(bf16 h) { return __uint_as_float((unsigned)h << 16); }
__device__ __forceinline__ float bflo(unsigned w) { return __uint_as_float(w << 16); }
__device__ __forceinline__ float bfhi(unsigned w) { return __uint_as_float(w & 0xffff0000u); }

__device__ __forceinline__ void p0_transpose_item(const float* W, int N, bf16* WT, int ldk, int koff, int row_off, const float* kscale, LAS float* scr, int item, int lane) {
    const int nblk = N / 32, kb = item / nblk, nb = item % nblk, k0 = 64 * kb, n0 = 32 * nb;
    float wv[32];
#pragma unroll
    for (int i = 0; i < 32; ++i) wv[i] = W[(size_t)(k0 + 2 * i + (lane >> 5)) * N + n0 + (lane & 31)];
#pragma unroll
    for (int i = 0; i < 32; ++i) { const int kk = 2 * i + (lane >> 5); float w = wv[i]; if (kscale) w *= kscale[k0 + kk]; scr[kk * 33 + (lane & 31)] = w; }
    LDS_WAIT(); asm volatile("" ::: "memory");
    const int c = lane & 7;
#pragma unroll
    for (int j = 0; j < 4; ++j) { const int n = (lane >> 3) + 8 * j; const LAS float* s = scr + (8 * c) * 33 + n;
        v4u o; o.x = pk2(s[0 * 33], s[1 * 33]); o.y = pk2(s[2 * 33], s[3 * 33]); o.z = pk2(s[4 * 33], s[5 * 33]); o.w = pk2(s[6 * 33], s[7 * 33]);
        *(GAS v4u*)(WT + (size_t)(row_off + n0 + n) * ldk + koff + k0 + 8 * c) = o; }
    LDS_WAIT(); asm volatile("" ::: "memory");
}
__device__ __forceinline__ void p0_weights(Frame& F, CArgsP A, int l, int gw, int NGW) {
    LAS float* scr = (LAS float*)(F.lds + RING_OFF + F.wave * 16384);
    constexpr int I_IN = (1024 / 64) * (P_TOTAL / 32), I_SQ = (1024 / 64) * (1024 / 32), I_UP = (1024 / 64) * (UPW / 32), I_DN = (D_FF / 64) * (1024 / 32),
                  I_W2 = 1 * (1024 / 32), I_G2 = 2 * (1024 / 32);
    constexpr int I_LAYER = I_IN + 3 * I_SQ + I_UP + I_DN + 2 * I_W2 + I_G2;
    unsigned char* wl = F.ws + WS_W + (size_t)l * W_LAYER;
    for (int it = gw; it < I_LAYER; it += NGW) {
        int r = it;
        if (r < I_IN) { p0_transpose_item(GIN(A, 8) + (size_t)l * 1024 * P_TOTAL, P_TOTAL, (bf16*)(wl + W_IN), 1024, 0, 0, GIN(A, 7) + l * 1024, scr, r, F.lane); continue; } r -= I_IN;
        if (r < I_SQ) { p0_transpose_item(GIN(A, 11) + (size_t)l * 1024 * 1024, 1024, (bf16*)(wl + W_ODA), 1024, 0, 0, nullptr, scr, r, F.lane); continue; } r -= I_SQ;
        if (r < I_SQ) { p0_transpose_item(GIN(A, 23) + (size_t)l * 1024 * 1024, 1024, (bf16*)(wl + W_ORW), 1024, 0, 0, nullptr, scr, r, F.lane); continue; } r -= I_SQ;
        if (r < I_SQ) { p0_transpose_item(GIN(A, 24) + (size_t)l * 1024 * 1024, 1024, (bf16*)(wl + W_OUT), 1024, 0, 0, nullptr, scr, r, F.lane); continue; } r -= I_SQ;
        if (r < I_UP) { p0_transpose_item(GIN(A, 26) + (size_t)l * 1024 * UPW, UPW, (bf16*)(wl + W_UP), 1024, 0, 0, GIN(A, 25) + l * 1024, scr, r, F.lane); continue; } r -= I_UP;
        if (r < I_DN) { p0_transpose_item(GIN(A, 29) + (size_t)l * D_FF * 1024, 1024, (bf16*)(wl + W_DN), D_FF, 0, 0, nullptr, scr, r, F.lane); continue; } r -= I_DN;
        if (r < I_W2) { p0_transpose_item(GIN(A, 14) + (size_t)l * 64 * 1024, 1024, (bf16*)(wl + W_LORA), 256, 0, 0, nullptr, scr, r, F.lane); continue; } r -= I_W2;
        if (r < I_W2) { p0_transpose_item(GIN(A, 16) + (size_t)l * 64 * 1024, 1024, (bf16*)(wl + W_LORA), 256, 64, 1024, nullptr, scr, r, F.lane); continue; } r -= I_W2;
        p0_transpose_item(GIN(A, 17) + (size_t)l * 128 * 1024, 1024, (bf16*)(wl + W_LORA), 256, 128, 2048, nullptr, scr, r, F.lane);
    }
    for (int i = gw * 64 + F.lane; i < 3072 * 32; i += NGW * 64) {
        const int n = i >> 5, kc = i & 31, blk = n >> 10;
        const bool nz = (blk == 0) ? (kc < 8) : (blk == 1) ? (kc >= 8 && kc < 16) : (kc >= 16);
        if (!nz) *(GAS v4u*)(wl + W_LORA + ((size_t)n * 256 + kc * 8) * 2) = (v4u){0u, 0u, 0u, 0u};
    }
}
__device__ __forceinline__ void p0_prologue(Frame& F, CArgsP A) {
    const int gw = F.vcu * NWAVES + F.wave, NGW = F.G * NWAVES;
    p0_weights(F, A, 0, gw, NGW);
    {
        const int gt = gw * 64 + F.lane, NGT = NGW * 64;
        float* rope = (float*)(F.ws + WS_ROPE);
        for (int i = gt; i < NKEYS_S * 8; i += NGT) {
            const int pos = i >> 3, k = i & 7;
            const float ang = (float)pos * A->rinv[k];
            const float kq = rintf(ang * 0.15915494309189535f);
            float r = fmaf(-kq, 6.2831854820251465f, ang); r = fmaf(-kq, -1.7484555314695172e-7f, r);
            const float rev = r * 0.15915494309189535f;
            rope[pos * 16 + k] = __builtin_amdgcn_cosf(rev); rope[pos * 16 + 8 + k] = __builtin_amdgcn_sinf(rev);
        }
    }
    {
        float* X = F.out + O_YP; bf16* XB = (bf16*)(F.ws + WS_XB); float* SS = (float*)(F.ctl + CW_SS);
        for (int m = gw; m < MT; m += NGW) {
            const float* src = (m < MP) ? GIN(A, 0) + (size_t)m * 1024 : GIN(A, 1) + (size_t)(m - MP) * 1024;
            const GAS f32x4* xr = (const GAS f32x4*)src + F.lane;
            GAS f32x4* xo = (GAS f32x4*)(X + (size_t)m * 1024) + F.lane;
            GAS unsigned long long* o8 = (GAS unsigned long long*)(XB + (size_t)m * 1024) + F.lane;
            float s = 0.f;
#pragma unroll
            for (int j = 0; j < 4; ++j) { const f32x4 v = xr[64 * j]; s += (v.x * v.x + v.y * v.y) + (v.z * v.z + v.w * v.w); xo[64 * j] = v;
                o8[64 * j] = (unsigned long long)pk2(v.x, v.y) | ((unsigned long long)pk2(v.z, v.w) << 32); }
            s = wave_sum(s);
            if (F.lane == 0) SS[m] = s;
        }
    }
    if (gw < DEPTH) {
        const int l = gw; const float* lp = GIN(A, 9) + (size_t)l * 256;
        const float s1 = wave_sum(lp[F.lane] * lp[64 + F.lane]), s2 = wave_sum(lp[128 + F.lane] * lp[192 + F.lane]);
        if (F.lane == 0) ((float*)(F.ctl + CW_LAM))[l] = expf(s1) - expf(s2) + (0.8f - 0.6f * expf(-0.3f * (float)l));
    }
}

__device__ __forceinline__ void ph_attn(Frame& F, CArgsP A, int l) {
    const attn_body::bf16* Q = (const attn_body::bf16*)(F.ws + B_Q); const attn_body::bf16* K = (const attn_body::bf16*)(F.ws + B_K); const attn_body::bf16* V = (const attn_body::bf16*)(F.ws + B_V);
    for (int u = F.vcu; u < 256; u += F.G) {
        const int b = u >> 5, hv = u & 31, h = hv >> 2, c = (hv >> 1) & 1, vh = hv & 1;
        attn_body::bf16* O = (attn_body::bf16*)(F.ws + B_OC) + (size_t)c * MT * 1024;
        for (int qb = 7; qb >= 0; --qb) attn_body::attn_unit<8>(b, h * 128 + c * 64, h * 128 + vh * 64, qb, Q, K, V, O, (char*)F.lds + RING_OFF);
    }
    { int tv = threadIdx.x; asm volatile("" : "+v"(tv)); F.tid = tv; F.lane = tv & 63; F.wave = __builtin_amdgcn_readfirstlane(tv >> 6); }
    const int gw = F.vcu * NWAVES + F.wave, NGW = F.G * NWAVES;
    (void)gw; (void)NGW;
    for (int u = F.vcu; u < 512; u += F.G) attn_body::sample_unit(l, u >> 6, (u >> 3) & 7, u & 7, GIN(A, 2), GIN(A, 3), Q, K, V, (float*)(F.ws + WS_SP), (char*)F.lds + RING_OFF);
}

__device__ __forceinline__ void ph_combine(Frame& F, CArgsP A, int l) {
    const int gw = F.vcu * NWAVES + F.wave, NGW = F.G * NWAVES;
    const float lam = ((const float*)(F.ctl + CW_LAM))[l], lam_init = 0.8f - 0.6f * expf(-0.3f * (float)l);
    const bf16* OC0 = (const bf16*)(F.ws + B_OC); const bf16* OC1 = OC0 + (size_t)MT * 1024;
    bf16* OA = (bf16*)(F.ws + B_OA);
    const float* subln = GIN(A, 10) + l * 128;
    const float g0 = subln[2 * F.lane], g1 = subln[2 * F.lane + 1];
    {
        const int gt = gw * 64 + F.lane, NGT = NGW * 64;
        const float sc = 1.f - lam_init;
        for (int i = gt; i < MP * 128; i += NGT) {
            const size_t off = (size_t)(i >> 4) * 128 + (i & 15) * 8;
            const v4u w0 = *(const v4u*)(OC0 + off), w1 = *(const v4u*)(OC1 + off);
            float a[8];
            a[0] = bflo(w0.x) - lam * bflo(w1.x); a[1] = bfhi(w0.x) - lam * bfhi(w1.x); a[2] = bflo(w0.y) - lam * bflo(w1.y); a[3] = bfhi(w0.y) - lam * bfhi(w1.y);
            a[4] = bflo(w0.z) - lam * bflo(w1.z); a[5] = bfhi(w0.z) - lam * bfhi(w1.z); a[6] = bflo(w0.w) - lam * bflo(w1.w); a[7] = bfhi(w0.w) - lam * bfhi(w1.w);
            float ss = (a[0] * a[0] + a[1] * a[1]) + (a[2] * a[2] + a[3] * a[3]) + (a[4] * a[4] + a[5] * a[5]) + (a[6] * a[6] + a[7] * a[7]);
            ss = reduce16(ss);
            const float r = (1.0f / sqrtf(ss * (1.0f / 128.f) + EPS)) * sc;
            const f32x4 s0 = *(const f32x4*)(subln + (i & 15) * 8), s1 = *(const f32x4*)(subln + (i & 15) * 8 + 4);
            v4u o; o.x = pk2(a[0] * r * s0.x, a[1] * r * s0.y); o.y = pk2(a[2] * r * s0.z, a[3] * r * s0.w); o.z = pk2(a[4] * r * s1.x, a[5] * r * s1.y); o.w = pk2(a[6] * r * s1.z, a[7] * r * s1.w);
            *(v4u*)(OA + off) = o;
        }
    }
    for (int it = MP * 8 + gw; it < MT * 8; it += NGW) {
        const int row = it >> 3, h = it & 7;
        float a0, a1;
        {
            const int b = (row - MP) >> 5, qi = (row - MP) & 31;
            float oc[2][2];
#pragma unroll
            for (int c = 0; c < 2; ++c) {
                const float* sp = (const float*)(F.ws + WS_SP) + ((size_t)(((b * 8 + h) * 2 + c) * 8) * 32 + qi) * 132;
                float mx = -1e30f;
#pragma unroll
                for (int s = 0; s < 8; ++s) mx = fmaxf(mx, sp[(size_t)s * 32 * 132]);
                float L = 0.f, x0 = 0.f, x1 = 0.f;
#pragma unroll
                for (int s = 0; s < 8; ++s) { const float* p = sp + (size_t)s * 32 * 132; const float w = exp2f(p[0] - mx); L += w * p[1]; x0 += w * p[4 + 2 * F.lane]; x1 += w * p[4 + 2 * F.lane + 1]; }
                oc[c][0] = x0 / L; oc[c][1] = x1 / L;
            }
            a0 = oc[0][0] - lam * oc[1][0]; a1 = oc[0][1] - lam * oc[1][1];
        }
        const float ss = wave_sum(a0 * a0 + a1 * a1);
        const float r = (1.0f / sqrtf(ss * (1.0f / 128.f) + EPS)) * (1.f - lam_init);
        *(unsigned*)(OA + (size_t)row * 1024 + h * 128 + 2 * F.lane) = pk2(a0 * r * g0, a1 * r * g1);
    }
    const bf16* URW = (const bf16*)(F.ws + B_URW); bf16* LIN = (bf16*)(F.ws + B_LIN);
    const float* mu = GIN(A, 12) + (size_t)l * P_RW + 3072 + 4 * F.lane;
    const float mu0 = mu[0], mu1 = mu[1], mu2 = mu[2], mu3 = mu[3];
    for (int row = gw; row < MT; row += NGW) {
        const bool smp = row >= MP; const int t = smp ? ((row - MP) & 31) : (row & 2047);
        const unsigned long long cw = *(const unsigned long long*)(URW + (size_t)row * P_RW + 3072 + 4 * F.lane);
        float u[4] = {bflo((unsigned)cw), bfhi((unsigned)cw), bflo((unsigned)(cw >> 32)), bfhi((unsigned)(cw >> 32))};
        float p[4];
        if (t > 0) { const unsigned long long pw = *(const unsigned long long*)(URW + (size_t)(row - 1) * P_RW + 3072 + 4 * F.lane);
            p[0] = bflo((unsigned)pw); p[1] = bfhi((unsigned)pw); p[2] = bflo((unsigned)(pw >> 32)); p[3] = bfhi((unsigned)(pw >> 32)); }
        else if (smp) { const float* s0 = GIN(A, 5) + ((size_t)(l * DEC_BATCH) + ((row - MP) >> 5)) * P_RW + 3072 + 4 * F.lane; p[0] = s0[0]; p[1] = s0[1]; p[2] = s0[2]; p[3] = s0[3]; }
        else { p[0] = p[1] = p[2] = p[3] = 0.f; }
        u[0] += (p[0] - u[0]) * mu0; u[1] += (p[1] - u[1]) * mu1; u[2] += (p[2] - u[2]) * mu2; u[3] += (p[3] - u[3]) * mu3;
        if (F.lane < 16) { u[0] = tanhf(u[0]); u[1] = tanhf(u[1]); u[2] = tanhf(u[2]); u[3] = tanhf(u[3]); }
        else if (F.lane >= 32) { u[0] = 1.f / (1.f + expf(-u[0])); u[1] = 1.f / (1.f + expf(-u[1])); u[2] = 1.f / (1.f + expf(-u[2])); u[3] = 1.f / (1.f + expf(-u[3])); }
        *(unsigned long long*)(LIN + (size_t)row * 256 + 4 * F.lane) = (unsigned long long)pk2(u[0], u[1]) | ((unsigned long long)pk2(u[2], u[3]) << 32);
    }
}

typedef float f32x2 __attribute__((ext_vector_type(2)));
constexpr int SC_C = 32;
constexpr int SC_OPB = 0, SC_OPB_SZ = SC_C * 1280;
constexpr int SC_VB = 2 * SC_OPB_SZ, SC_VB_SZ = SC_C * 256;
constexpr int SC_YB = SC_VB + 2 * SC_VB_SZ;
static_assert(SC_YB + 2 * SC_C * 128 <= RING_BYTES, "scan LDS");
constexpr size_t B_Y = B_OC;
constexpr size_t WS_BON = WS_SP;

__device__ __forceinline__ void unpack4(unsigned long long w, float (&o)[4]) { o[0] = bflo((unsigned)w); o[1] = bfhi((unsigned)w); o[2] = bflo((unsigned)(w >> 32)); o[3] = bfhi((unsigned)(w >> 32)); }

__device__ __forceinline__ void scan_fast(Frame& F, CArgsP A, int l, int item) {
    const bool smp = item >= 256; const int half = item & 1, bh = (item >> 1) & 127, b = bh >> 4, h = bh & 15;
    const int T = smp ? DEC_SEQ : SEQ, row0 = smp ? MP + b * DEC_SEQ : b * SEQ, nch = T / SC_C;
    const int tid = F.tid, lane = F.lane, w = F.wave;
    const int rho = lane >> 3, kq = lane & 7, lrow = (w & 3) * 8 + rho, srow = half * 32 + lrow;
    const int pt = tid - 256;
    const int cq = pt & 15, c = h * 64 + 4 * cq;
    const bf16* URW = (const bf16*)(F.ws + B_URW); const bf16* LD = (const bf16*)(F.ws + B_LD); const bf16* LA = (const bf16*)(F.ws + B_LA);
    float* Y = (float*)(F.ws + B_Y); float* BONG = (float*)(F.ws + WS_BON);
    LAS unsigned char* L = F.lds + RING_OFF;
    LAS float* ybase = (LAS float*)(L + SC_YB);
    f32x2 S2[4];
    float mu_r[4], mu_k[4], mu_v[4], k_k[4], k_a[4], r_k[4];
    if (w < 4) {
        if (smp) { const float* s0 = GIN(A, 4) + (((size_t)(l * 8 + b) * 16 + h) * 64 + srow) * 64 + 8 * kq; const f32x4 a0 = *(const f32x4*)s0, a1 = *(const f32x4*)(s0 + 4);
            S2[0] = (f32x2){a0.x, a0.y}; S2[1] = (f32x2){a0.z, a0.w}; S2[2] = (f32x2){a1.x, a1.y}; S2[3] = (f32x2){a1.z, a1.w}; }
        else {
#pragma unroll
            for (int j = 0; j < 4; ++j) S2[j] = (f32x2){0.f, 0.f}; }
    } else {
        const float* mu = GIN(A, 12) + (size_t)l * P_RW;
#pragma unroll
        for (int j = 0; j < 4; ++j) { mu_r[j] = mu[c + j]; mu_k[j] = mu[1024 + c + j]; mu_v[j] = mu[2048 + c + j]; k_k[j] = GIN(A, 18)[l * 1024 + c + j]; k_a[j] = GIN(A, 19)[l * 1024 + c + j]; r_k[j] = GIN(A, 20)[l * 1024 + c + j]; }
    }
#define SC_PREP(ch) do { const int buf_ = (ch) & 1; LAS unsigned char* opb_ = L + SC_OPB + buf_ * SC_OPB_SZ; LAS float* vb_ = (LAS float*)(L + SC_VB + buf_ * SC_VB_SZ); \
        _Pragma("unroll") for (int rep_ = 0; rep_ < 2; ++rep_) { const int tp = (pt >> 4) + 16 * rep_; const int tseq = (ch) * SC_C + tp; \
            const size_t r_ = (size_t)(row0 + tseq); const bf16* u_ = URW + r_ * P_RW + c; \
            float ur[4], uk[4], uv[4], pr[4], pk[4], pv[4], ld[4], la[4]; \
            unpack4(*(const unsigned long long*)(u_), ur); unpack4(*(const unsigned long long*)(u_ + 1024), uk); unpack4(*(const unsigned long long*)(u_ + 2048), uv); \
            unpack4(*(const unsigned long long*)(LD + r_ * 1024 + c), ld); unpack4(*(const unsigned long long*)(LA + r_ * 1024 + c), la); \
            if (tseq > 0) { unpack4(*(const unsigned long long*)(u_ - P_RW), pr); unpack4(*(const unsigned long long*)(u_ - P_RW + 1024), pk); unpack4(*(const unsigned long long*)(u_ - P_RW + 2048), pv); } \
            else if (smp) { const float* s0 = GIN(A, 5) + (size_t)(l * 8 + b) * P_RW + c; _Pragma("unroll") for (int j = 0; j < 4; ++j) { pr[j] = s0[j]; pk[j] = s0[1024 + j]; pv[j] = s0[2048 + j]; } } \
            else { _Pragma("unroll") for (int j = 0; j < 4; ++j) { pr[j] = 0.f; pk[j] = 0.f; pv[j] = 0.f; } } \
            float r[4], kr[4], vr[4], kk[4], km[4], wd[4], ssq = 0.f, bon = 0.f; \
            _Pragma("unroll") for (int j = 0; j < 4; ++j) { \
                r[j] = ur[j] + (pr[j] - ur[j]) * mu_r[j]; kr[j] = uk[j] + (pk[j] - uk[j]) * mu_k[j]; vr[j] = uv[j] + (pv[j] - uv[j]) * mu_v[j]; \
                wd[j] = __builtin_amdgcn_exp2f(1.4426950408889634f * ld[j]); \
                kk[j] = kr[j] * k_k[j]; ssq += kk[j] * kk[j]; km[j] = kr[j] * (1.f + (la[j] - 1.f) * k_a[j]); bon += r[j] * km[j] * r_k[j]; } \
            ssq = reduce16(ssq); bon = reduce16(bon); \
            const float inv = __builtin_amdgcn_rsqf(fmaxf(ssq, 1e-24f)); \
            LAS float* op = (LAS float*)(opb_ + tp * 1280) + 4 * cq; \
            *(LAS f32x4*)(op) = (f32x4){wd[0], wd[1], wd[2], wd[3]}; \
            *(LAS f32x4*)(op + 64) = (f32x4){kk[0] * inv, kk[1] * inv, kk[2] * inv, kk[3] * inv}; \
            *(LAS f32x4*)(op + 128) = (f32x4){kk[0] * inv * la[0], kk[1] * inv * la[1], kk[2] * inv * la[2], kk[3] * inv * la[3]}; \
            *(LAS f32x4*)(op + 192) = (f32x4){km[0], km[1], km[2], km[3]}; \
            *(LAS f32x4*)(op + 256) = (f32x4){r[0], r[1], r[2], r[3]}; \
            *(LAS f32x4*)(vb_ + tp * 64 + 4 * cq) = (f32x4){vr[0], vr[1], vr[2], vr[3]}; \
            if (half == 0 && cq == 0) BONG[r_ * 16 + h] = bon; } } while (0)
#define SC_YOUT(ch) do { const f32x4 y4_ = *(const LAS f32x4*)(ybase + ((ch) & 1) * (SC_C * 32) + (pt >> 3) * 32 + 4 * (pt & 7)); \
        *(f32x4*)(Y + (size_t)(row0 + (ch) * SC_C + (pt >> 3)) * 1024 + h * 64 + half * 32 + 4 * (pt & 7)) = y4_; } while (0)
    if (w >= 4) SC_PREP(0);
    __syncthreads();
    for (int ch = 0; ch < nch; ++ch) {
        if (w >= 4) {
            if (ch + 1 < nch) SC_PREP(ch + 1);
            if (ch > 0) SC_YOUT(ch - 1);
        } else {
            const int buf = ch & 1;
            LAS unsigned char* opb = L + SC_OPB + buf * SC_OPB_SZ; LAS float* vb = (LAS float*)(L + SC_VB + buf * SC_VB_SZ); LAS float* yb = ybase + buf * (SC_C * 32);
            const LAS float* ob = (const LAS float*)opb + 8 * kq;
            f32x4 wA0, wA1, kA0, kA1, bA0, bA1, mA0, mA1, rA0, rA1, wB0, wB1, kB0, kB1, bB0, bB1, mB0, mB1, rB0, rB1; float vA, vB;
#define SC_LD(SET, tt) do { const LAS float* p_ = ob + (tt) * 320; w##SET##0 = *(const LAS f32x4*)(p_); w##SET##1 = *(const LAS f32x4*)(p_ + 4); k##SET##0 = *(const LAS f32x4*)(p_ + 64); k##SET##1 = *(const LAS f32x4*)(p_ + 68); \
            b##SET##0 = *(const LAS f32x4*)(p_ + 128); b##SET##1 = *(const LAS f32x4*)(p_ + 132); m##SET##0 = *(const LAS f32x4*)(p_ + 192); m##SET##1 = *(const LAS f32x4*)(p_ + 196); \
            r##SET##0 = *(const LAS f32x4*)(p_ + 256); r##SET##1 = *(const LAS f32x4*)(p_ + 260); v##SET = vb[(tt) * 64 + srow]; } while (0)
#define LO2(x) ((f32x2){(x)[0], (x)[1]})
#define HI2(x) ((f32x2){(x)[2], (x)[3]})
#define SC_STEP(SET, tt) do { \
            f32x2 pa_ = S2[0] * LO2(k##SET##0), pb_ = S2[1] * HI2(k##SET##0); pa_ = __builtin_elementwise_fma(S2[2], LO2(k##SET##1), pa_); pb_ = __builtin_elementwise_fma(S2[3], HI2(k##SET##1), pb_); pa_ = pa_ + pb_; \
            const float nsa_ = -reduce8(pa_[0] + pa_[1]); const f32x2 ns2_ = (f32x2){nsa_, nsa_}, vv2_ = (f32x2){v##SET, v##SET}; \
            S2[0] = __builtin_elementwise_fma(S2[0], LO2(w##SET##0), __builtin_elementwise_fma(ns2_, LO2(b##SET##0), vv2_ * LO2(m##SET##0))); \
            S2[1] = __builtin_elementwise_fma(S2[1], HI2(w##SET##0), __builtin_elementwise_fma(ns2_, HI2(b##SET##0), vv2_ * HI2(m##SET##0))); \
            S2[2] = __builtin_elementwise_fma(S2[2], LO2(w##SET##1), __builtin_elementwise_fma(ns2_, LO2(b##SET##1), vv2_ * LO2(m##SET##1))); \
            S2[3] = __builtin_elementwise_fma(S2[3], HI2(w##SET##1), __builtin_elementwise_fma(ns2_, HI2(b##SET##1), vv2_ * HI2(m##SET##1))); \
            f32x2 qa_ = S2[0] * LO2(r##SET##0), qb_ = S2[1] * HI2(r##SET##0); qa_ = __builtin_elementwise_fma(S2[2], LO2(r##SET##1), qa_); qb_ = __builtin_elementwise_fma(S2[3], HI2(r##SET##1), qb_); qa_ = qa_ + qb_; \
            const float y_ = reduce8(qa_[0] + qa_[1]); \
            if (kq == 0) yb[(tt) * 32 + lrow] = y_; } while (0)
            SC_LD(A, 0);
            for (int t = 0; t < SC_C; t += 2) {
                SC_LD(B, t + 1);
                SC_STEP(A, t);
                if (t + 2 < SC_C) SC_LD(A, t + 2);
                SC_STEP(B, t + 1);
            }
#undef SC_LD
#undef SC_STEP
#undef LO2
#undef HI2
        }
        __syncthreads();
    }
    if (w >= 4) SC_YOUT(nch - 1);
    else { float* Sout = F.out + (smp ? O_WKVS : O_WKVP) + (((size_t)(l * 8 + b) * 16 + h) * 64 + srow) * 64 + 8 * kq;
        *(f32x4*)Sout = (f32x4){S2[0][0], S2[0][1], S2[1][0], S2[1][1]}; *(f32x4*)(Sout + 4) = (f32x4){S2[2][0], S2[2][1], S2[3][0], S2[3][1]}; }
#undef SC_PREP
#undef SC_YOUT
    __syncthreads();
}
__device__ __forceinline__ void ph_scan(Frame& F, CArgsP A, int l) {
    for (int it = F.vcu; it < 512; it += F.G) scan_fast(F, A, l, it);
}
__device__ __forceinline__ void ph_post(Frame& F, CArgsP A, int l) {
    const int gt = (F.vcu * NWAVES + F.wave) * 64 + F.lane, NGT = F.G * NWAVES * 64;
    const float* Y = (const float*)(F.ws + B_Y); const float* BONG = (const float*)(F.ws + WS_BON); const bf16* URW = (const bf16*)(F.ws + B_URW); const bf16* LG = (const bf16*)(F.ws + B_LG);
    bf16* ORW = (bf16*)(F.ws + B_ORW);
    const float* mu = GIN(A, 12) + (size_t)l * P_RW + 2048; const float* ln_w = GIN(A, 21) + l * 1024; const float* ln_b = GIN(A, 22) + l * 1024;
#define POST_LOAD(P, ii) const int row##P = (ii) >> 8, c##P = ((ii) & 255) * 4; const bool smp##P = row##P >= MP; const int t##P = smp##P ? ((row##P - MP) & 31) : (row##P & 2047); \
        const f32x4 y4##P = *(const f32x4*)(Y + (size_t)row##P * 1024 + c##P); const unsigned long long uvw##P = *(const unsigned long long*)(URW + (size_t)row##P * P_RW + 2048 + c##P); \
        const unsigned long long pvw##P = (t##P > 0) ? *(const unsigned long long*)(URW + (size_t)(row##P - 1) * P_RW + 2048 + c##P) : 0ull; \
        const unsigned long long lgw##P = *(const unsigned long long*)(LG + (size_t)row##P * 1024 + c##P); const float bon##P = BONG[(size_t)row##P * 16 + (c##P >> 6)]; \
        const f32x4 m4##P = *(const f32x4*)(mu + c##P), lw##P = *(const f32x4*)(ln_w + c##P), lb##P = *(const f32x4*)(ln_b + c##P);
#define POST_DO(P) { float uv[4], pv[4], gg[4]; unpack4(uvw##P, uv); unpack4(lgw##P, gg); \
        if (t##P > 0) unpack4(pvw##P, pv); \
        else if (smp##P) { const float* s0 = GIN(A, 5) + ((size_t)(l * 8) + ((row##P - MP) >> 5)) * P_RW + 2048 + c##P; pv[0] = s0[0]; pv[1] = s0[1]; pv[2] = s0[2]; pv[3] = s0[3]; } \
        else { pv[0] = pv[1] = pv[2] = pv[3] = 0.f; } \
        const float v0 = uv[0] + (pv[0] - uv[0]) * m4##P.x, v1 = uv[1] + (pv[1] - uv[1]) * m4##P.y, v2 = uv[2] + (pv[2] - uv[2]) * m4##P.z, v3 = uv[3] + (pv[3] - uv[3]) * m4##P.w; \
        const float mean = reduce16((y4##P.x + y4##P.y) + (y4##P.z + y4##P.w)) * (1.f / 64.f); \
        const float d0 = y4##P.x - mean, d1 = y4##P.y - mean, d2 = y4##P.z - mean, d3 = y4##P.w - mean; \
        const float var = reduce16((d0 * d0 + d1 * d1) + (d2 * d2 + d3 * d3)) * (1.f / 64.f); \
        const float rs = 1.0f / sqrtf(var + GN_EPS); \
        const float o0 = (d0 * rs * lw##P.x + lb##P.x + bon##P * v0) * gg[0], o1 = (d1 * rs * lw##P.y + lb##P.y + bon##P * v1) * gg[1]; \
        const float o2 = (d2 * rs * lw##P.z + lb##P.z + bon##P * v2) * gg[2], o3 = (d3 * rs * lw##P.w + lb##P.w + bon##P * v3) * gg[3]; \
        *(unsigned long long*)(ORW + (size_t)row##P * 1024 + c##P) = (unsigned long long)pk2(o0, o1) | ((unsigned long long)pk2(o2, o3) << 32); }
    static_assert((MT * 256) % (2 * 256 * NWAVES * 64) == 0 || true, "");
    int i = gt;
    for (; i + NGT < MT * 256; i += 2 * NGT) { POST_LOAD(a, i) POST_LOAD(b, i + NGT) POST_DO(a) POST_DO(b) }
    for (; i < MT * 256; i += NGT) { POST_LOAD(a, i) POST_DO(a) }
#undef POST_LOAD
#undef POST_DO
}

__device__ __forceinline__ void unpack8f(const v4u w, float (&o)[8]) { o[0] = bflo(w.x); o[1] = bfhi(w.x); o[2] = bflo(w.y); o[3] = bfhi(w.y); o[4] = bflo(w.z); o[5] = bfhi(w.z); o[6] = bflo(w.w); o[7] = bfhi(w.w); }
__device__ __forceinline__ void ph_conv(Frame& F, CArgsP A, int l) {
    const int gt = (F.vcu * NWAVES + F.wave) * 64 + F.lane, NGT = F.G * NWAVES * 64;
    const bf16* UP = (const bf16*)(F.ws + B_UP); bf16* GT = (bf16*)(F.ws + B_GT);
    const float* cw = GIN(A, 27) + (size_t)l * 3 * UPW; const float* cb = GIN(A, 28) + (size_t)l * UPW;
    constexpr int NJ = D_FF / 8, NRB = MT / 64;
    for (int it = gt; it < NRB * NJ; it += NGT) {
        const int rb = it / NJ, j = (it % NJ) * 8;
        float w0[2][8], w1[2][8], w2[2][8], bi[2][8];
#pragma unroll
        for (int hf = 0; hf < 2; ++hf) { const int col = j + hf * D_FF;
#pragma unroll
            for (int e = 0; e < 8; e += 4) { const f32x4 a = *(const f32x4*)(cw + col + e), b2 = *(const f32x4*)(cw + UPW + col + e), c2 = *(const f32x4*)(cw + 2 * UPW + col + e), d2 = *(const f32x4*)(cb + col + e);
                w0[hf][e] = a.x; w0[hf][e + 1] = a.y; w0[hf][e + 2] = a.z; w0[hf][e + 3] = a.w; w1[hf][e] = b2.x; w1[hf][e + 1] = b2.y; w1[hf][e + 2] = b2.z; w1[hf][e + 3] = b2.w;
                w2[hf][e] = c2.x; w2[hf][e + 1] = c2.y; w2[hf][e + 2] = c2.z; w2[hf][e + 3] = c2.w; bi[hf][e] = d2.x; bi[hf][e + 1] = d2.y; bi[hf][e + 2] = d2.z; bi[hf][e + 3] = d2.w; } }
        float u1[2][8], u2[2][8];
        for (int r4 = 0; r4 < 64; r4 += 4) {
            v4u ld[4][2];
#pragma unroll
            for (int q = 0; q < 4; ++q) { ld[q][0] = *(const v4u*)(UP + (size_t)(rb * 64 + r4 + q) * UPW + j); ld[q][1] = *(const v4u*)(UP + (size_t)(rb * 64 + r4 + q) * UPW + j + D_FF); }
#pragma unroll
            for (int q = 0; q < 4; ++q) {
                const int rr = r4 + q, row = rb * 64 + rr;
                const bool smp = row >= MP; const int t = smp ? ((row - MP) & 31) : (row & 2047); const int b = smp ? ((row - MP) >> 5) : (row >> 11);
                if (t == 0) {
#pragma unroll
                    for (int hf = 0; hf < 2; ++hf) { const int col = j + hf * D_FF;
                        if (smp) { const float* s0 = GIN(A, 6) + ((size_t)(l * 8 + b) * 2) * UPW + col;
#pragma unroll
                            for (int e = 0; e < 8; ++e) { u2[hf][e] = s0[e]; u1[hf][e] = s0[UPW + e]; } }
                        else {
#pragma unroll
                            for (int e = 0; e < 8; ++e) { u2[hf][e] = 0.f; u1[hf][e] = 0.f; } } }
                } else if (rr == 0) {
#pragma unroll
                    for (int hf = 0; hf < 2; ++hf) { const int col = j + hf * D_FF;
                        unpack8f(*(const v4u*)(UP + (size_t)(row - 1) * UPW + col), u1[hf]); unpack8f(*(const v4u*)(UP + (size_t)(row - 2) * UPW + col), u2[hf]); }
                }
                float u0[2][8], cc[2][8];
#pragma unroll
                for (int hf = 0; hf < 2; ++hf) { unpack8f(ld[q][hf], u0[hf]);
#pragma unroll
                    for (int e = 0; e < 8; ++e) { cc[hf][e] = bi[hf][e] + u2[hf][e] * w0[hf][e] + u1[hf][e] * w1[hf][e] + u0[hf][e] * w2[hf][e]; u2[hf][e] = u1[hf][e]; u1[hf][e] = u0[hf][e]; } }
                float gv[8];
#pragma unroll
                for (int e = 0; e < 8; ++e) gv[e] = cc[0][e] * __builtin_amdgcn_rcpf(1.0f + __builtin_amdgcn_exp2f(-1.4426950408889634f * cc[0][e])) * cc[1][e];
                v4u o; o.x = pk2(gv[0], gv[1]); o.y = pk2(gv[2], gv[3]); o.z = pk2(gv[4], gv[5]); o.w = pk2(gv[6], gv[7]);
                *(v4u*)(GT + (size_t)row * D_FF + j) = o;
            }
        }
    }
}

__device__ __forceinline__ void ph_final(Frame& F, CArgsP A) {
    const int gw = F.vcu * NWAVES + F.wave, NGW = F.G * NWAVES;
    float* X = F.out + O_YP; const float* SS = (const float*)(F.ctl + CW_SS) + 4 * MT; const float* g = GIN(A, 30);
    for (int m = gw; m < MT; m += NGW) {
        const float r = 1.0f / sqrtf(SS[m] * (1.0f / 1024.f) + EPS);
        GAS f32x4* xr = (GAS f32x4*)(X + (size_t)m * 1024) + F.lane; const GAS f32x4* gr = (const GAS f32x4*)g + F.lane;
#pragma unroll
        for (int j = 0; j < 4; ++j) { f32x4 v = xr[64 * j]; const f32x4 gg = gr[64 * j]; v = v * r * gg; xr[64 * j] = v; }
    }
}

#define REOPAQUE() do { int tv = threadIdx.x; asm volatile("" : "+v"(tv)); F.tid = tv; F.lane = tv & 63; F.wave = __builtin_amdgcn_readfirstlane(tv >> 6); \
    ap = (CArgsP)__builtin_amdgcn_kernarg_segment_ptr(); asm volatile("" : "+s"(ap)); \
    { GAS unsigned char* w_ = ap->ws; GAS float* o_ = ap->out; asm volatile("" : "+s"(w_), "+s"(o_)); F.ws = (unsigned char*)w_; F.out = (float*)o_; F.ctl = (gu32*)(w_ + WS_CTL); } } while (0)
#define PH_BEGIN(idx) if (lo <= (idx) && (idx) < hi) { REOPAQUE();
#define PH_END(idx) if ((idx) + 1 < hi) xcd_barrier(bar); }

template <int l> __device__ __forceinline__ void layer_phases(Frame& F, CArgsP& ap, const XcdBarrier& bar, const int lo, const int hi) {
    constexpr int P0 = 1 + l * PH_PER_LAYER;
#define WL (F.ws + WS_W + (size_t)l * W_LAYER)
#define SSP ((float*)(F.ctl + CW_SS))
    PH_BEGIN(P0 + K_G1) {
        int kk_ = 1024; asm volatile("" : "+s"(kk_)); pg8::Gemm g{(const bf16*)(F.ws + WS_XB), (const bf16*)(WL + W_IN), MT, P_TOTAL, kk_}; pg8::StaticOrder S; S.init(MT, P_TOTAL, F.G, (int)blockIdx.x);
        pg8::EpiIn E{SSP + (size_t)(2 * l) * MT, (const float*)(F.ws + WS_ROPE), (bf16*)(F.ws + B_Q), (bf16*)(F.ws + B_K), (bf16*)(F.ws + B_V), (bf16*)(F.ws + B_URW), (bf16*)(F.ws + B_GATE),
                     F.out + O_KP + (size_t)l * MP * 1024, F.out + O_VP + (size_t)l * MP * 1024, F.out + O_KS + (size_t)l * MS * 1024, F.out + O_VS + (size_t)l * MS * 1024,
                     F.out + O_SHP + (size_t)l * BATCH * P_RW, F.out + O_SHS + (size_t)l * DEC_BATCH * P_RW};
        pg8::gemm_phase<pg8::EpiIn, pg8::StaticOrder, true, true>(F.lds + RING_OFF, g, S, E);
        if constexpr (l == 0) {
            const int nu = (MT / 256) * (P_TOTAL / 256), extra = nu % F.G, nidle = extra ? F.G - extra : F.G, idx = extra ? (int)blockIdx.x - extra : (int)blockIdx.x;
            if (idx >= 0) p0_weights(F, ap, 1, idx * NWAVES + F.wave, nidle * NWAVES);
        }
    } PH_END(P0 + K_G1)
    PH_BEGIN(P0 + K_AT) { ph_attn(F, ap, l); } PH_END(P0 + K_AT)
    PH_BEGIN(P0 + K_CB) { ph_combine(F, ap, l); } PH_END(P0 + K_CB)
    PH_BEGIN(P0 + K_LR) {
        int kk_ = 256; asm volatile("" : "+s"(kk_)); pg8::Gemm g{(const bf16*)(F.ws + B_LIN), (const bf16*)(WL + W_LORA), MT, 3072, kk_}; pg8::StaticOrder S; S.init(MT, 3072, F.G, (int)blockIdx.x);
        pg8::EpiLora E{GIN(ap, 13) + l * 1024, GIN(ap, 15) + l * 1024, (bf16*)(F.ws + B_LD), (bf16*)(F.ws + B_LA), (bf16*)(F.ws + B_LG)};
        pg8::gemm_phase<pg8::EpiLora, pg8::StaticOrder, true, true>(F.lds + RING_OFF, g, S, E);
    } PH_END(P0 + K_LR)
    PH_BEGIN(P0 + K_SC) { ph_scan(F, ap, l); } PH_END(P0 + K_SC)
    PH_BEGIN(P0 + K_M1) {
        ph_post(F, ap, l);
        int kk_ = 1024; asm volatile("" : "+s"(kk_)); pg8::Gemm g{(const bf16*)(F.ws + B_OA), (const bf16*)(WL + W_ODA), MT, 1024, kk_}; pg8::StaticOrder S; S.init(MT, 1024, F.G, (int)blockIdx.x);
        pg8::EpiGated E{(const bf16*)(F.ws + B_GATE), 0, nullptr, (bf16*)(F.ws + B_MRG)};
        pg8::gemm_phase<pg8::EpiGated, pg8::StaticOrder, true, true>(F.lds + RING_OFF, g, S, E);
    } PH_END(P0 + K_M1)
    PH_BEGIN(P0 + K_M2) {
        int kk_ = 1024; asm volatile("" : "+s"(kk_)); pg8::Gemm g{(const bf16*)(F.ws + B_ORW), (const bf16*)(WL + W_ORW), MT, 1024, kk_}; pg8::StaticOrder S; S.init(MT, 1024, F.G, (int)blockIdx.x);
        pg8::EpiGated E{(const bf16*)(F.ws + B_GATE), 1024, (const bf16*)(F.ws + B_MRG), (bf16*)(F.ws + B_MRG)};
        pg8::gemm_phase<pg8::EpiGated, pg8::StaticOrder, true, true>(F.lds + RING_OFF, g, S, E);
    } PH_END(P0 + K_M2)
    PH_BEGIN(P0 + K_WO) {
        int kk_ = 1024; asm volatile("" : "+s"(kk_)); pg8::Gemm g{(const bf16*)(F.ws + B_MRG), (const bf16*)(WL + W_OUT), MT, 1024, kk_}; pg8::StaticOrder S; S.init(MT, 1024, F.G, (int)blockIdx.x);
        pg8::EpiRes E{F.out + O_YP, (bf16*)(F.ws + WS_XB), SSP + (size_t)(2 * l + 1) * MT};
        pg8::gemm_phase<pg8::EpiRes, pg8::StaticOrder, true, true>(F.lds + RING_OFF, g, S, E);
    } PH_END(P0 + K_WO)
    PH_BEGIN(P0 + K_UP) {
        int kk_ = 1024; asm volatile("" : "+s"(kk_)); pg8::Gemm g{(const bf16*)(F.ws + WS_XB), (const bf16*)(WL + W_UP), MT, UPW, kk_}; pg8::StaticOrder S; S.init(MT, UPW, F.G, (int)blockIdx.x);
        pg8::EpiUp E{SSP + (size_t)(2 * l + 1) * MT, (bf16*)(F.ws + B_UP), F.out + O_CVP + (size_t)l * BATCH * 2 * UPW, F.out + O_CVS + (size_t)l * DEC_BATCH * 2 * UPW};
        pg8::gemm_phase<pg8::EpiUp, pg8::StaticOrder, true, true>(F.lds + RING_OFF, g, S, E);
    } PH_END(P0 + K_UP)
    PH_BEGIN(P0 + K_CV) { ph_conv(F, ap, l); } PH_END(P0 + K_CV)
    PH_BEGIN(P0 + K_DN) {
        int kk_ = D_FF; asm volatile("" : "+s"(kk_)); pg8::Gemm g{(const bf16*)(F.ws + B_GT), (const bf16*)(WL + W_DN), MT, 1024, kk_}; pg8::StaticOrder S; S.init(MT, 1024, F.G, (int)blockIdx.x);
        pg8::EpiRes E{F.out + O_YP, (bf16*)(F.ws + WS_XB), SSP + (size_t)(2 * l + 2) * MT};
        pg8::gemm_phase<pg8::EpiRes, pg8::StaticOrder, true, true>(F.lds + RING_OFF, g, S, E);
    } PH_END(P0 + K_DN)
#undef WL
#undef SSP
}

__global__ void __launch_bounds__(NWAVES * 64, 2) mk_fwd(Args args) {
    extern __shared__ __attribute__((aligned(16))) unsigned char lds[];
    Frame F;
    F.lds = (LAS unsigned char*)lds;
    F.MISC = (volatile LAS unsigned*)(F.lds + MISC_OFF);
    F.tid = threadIdx.x; F.lane = F.tid & 63; F.wave = __builtin_amdgcn_readfirstlane(F.tid >> 6);
    F.G = gridDim.x; { const int bx = blockIdx.x; F.vcu = (F.G % 8 == 0) ? (bx % 8) * (F.G / 8) + bx / 8 : bx; }
    F.out = (float*)args.out; F.ws = (unsigned char*)args.ws;
    F.ctl = (gu32*)(args.ws + WS_CTL);
    for (int u = F.tid; u < (LDS_BYTES - LDSCTL_OFF) / 4; u += NWAVES * 64) ((LAS unsigned*)(F.lds + LDSCTL_OFF))[u] = 0u;
    __syncthreads();
    XcdBarrier bar; bar.bar = (unsigned*)(F.ctl + CW_BAR); bar.x = 0; bar.st = nullptr;
    if (!MK_PER_PHASE) bar = xcd_barrier_post((unsigned*)(F.ctl + CW_BAR), F.MISC + 8);
    const int lo = args.ph_lo, hi = args.ph_hi;
    CArgsP ap;
    PH_BEGIN(0) { p0_prologue(F, ap); } PH_END(0)
    layer_phases<0>(F, ap, bar, lo, hi);
    layer_phases<1>(F, ap, bar, lo, hi);
    PH_BEGIN(NPHASE - 1) { ph_final(F, ap); } PH_END(NPHASE - 1)
}

extern "C" void kernel_launch(void* const* d_in, const int* in_sizes, int n_in, void* d_out, int out_size, void* d_ws, size_t ws_size, hipStream_t stream) {
    (void)in_sizes;
    static int grid = 0;
    if (grid == 0) {
        if (n_in != 31 || out_size != (int)O_END || ws_size < B_END2) { fprintf(stderr, "kernel_launch: unexpected shapes (n_in %d out %d ws %zu)\n", n_in, out_size, ws_size); grid = -1; return; }
        int dev = 0, cus = 0;
        if (hipGetDevice(&dev) != hipSuccess || hipDeviceGetAttribute(&cus, hipDeviceAttributeMultiprocessorCount, dev) != hipSuccess) { grid = -1; return; }
        if (hipFuncSetAttribute((const void*)mk_fwd, hipFuncAttributeMaxDynamicSharedMemorySize, LDS_BYTES) != hipSuccess) { fprintf(stderr, "kernel_launch: hipFuncSetAttribute failed\n"); grid = -1; return; }
        (void)hipGetLastError();
        grid = cus;
    }
    if (grid < 0) return;
    if (hipMemsetAsync((char*)d_ws + WS_CTL, 0, CTL_ZERO_BYTES, stream) != hipSuccess) { fprintf(stderr, "kernel_launch: memset failed\n"); return; }
    Args a{};
    for (int i = 0; i < 31; ++i) a.in[i] = (const GAS float*)d_in[i];
    a.out = (GAS float*)d_out; a.ws = (GAS unsigned char*)d_ws;
    for (int i = 0; i < 8; ++i) a.rinv[i] = (float)pow(500000.0, -(double)i / 8.0);
#if MK_PER_PHASE
    for (int p = 0; p < NPHASE; ++p) { a.ph_lo = p; a.ph_hi = p + 1; hipLaunchKernelGGL(mk_fwd, dim3(grid), dim3(NWAVES * 64), LDS_BYTES, stream, a); }
#else
    a.ph_lo = 0; a.ph_hi = NPHASE;
    hipLaunchKernelGGL(mk_fwd, dim3(grid), dim3(NWAVES * 64), LDS_BYTES, stream, a);
#endif
    const hipError_t le = hipPeekAtLastError();
    if (le != hipSuccess) fprintf(stderr, "kernel_launch: launch failed: %s\n", hipGetErrorName(le));
}
```

```cpp
#include <hip/hip_runtime.h>
#include <cstdio>
#include <cstdint>
#include <cmath>

#ifndef MK_PER_PHASE
#define MK_PER_PHASE 0
#endif

constexpr int D_MODEL = 1024, BATCH = 8, SEQ = 2048, DEPTH = 2, DEC_BATCH = 8, DEC_SEQ = 32, PAST_LEN = 2048;
constexpr float EPS = 1e-6f, GN_EPS = 64e-5f;
constexpr int DA_HEADS = 8, RW_HEADS = 16;
constexpr int D_FF = 2816, UPW = 2 * D_FF;
constexpr int P_DA = 3072, P_RW = 3328, P_GATE = 2048, P_TOTAL = 8448;
constexpr int MP = BATCH * SEQ, MS = DEC_BATCH * DEC_SEQ, MT = MP + MS;
constexpr int NKEYS_S = PAST_LEN + DEC_SEQ;
constexpr float C2 = 0.125f * 1.4426950408889634f;

constexpr size_t O_YP = 0;
constexpr size_t O_YS = O_YP + (size_t)MP * D_MODEL;
constexpr size_t O_KP = O_YS + (size_t)MS * D_MODEL;
constexpr size_t O_VP = O_KP + (size_t)DEPTH * MP * 1024;
constexpr size_t O_WKVP = O_VP + (size_t)DEPTH * MP * 1024;
constexpr size_t O_SHP = O_WKVP + (size_t)DEPTH * BATCH * RW_HEADS * 64 * 64;
constexpr size_t O_CVP = O_SHP + (size_t)DEPTH * BATCH * P_RW;
constexpr size_t O_KS = O_CVP + (size_t)DEPTH * BATCH * 2 * UPW;
constexpr size_t O_VS = O_KS + (size_t)DEPTH * MS * 1024;
constexpr size_t O_WKVS = O_VS + (size_t)DEPTH * MS * 1024;
constexpr size_t O_SHS = O_WKVS + (size_t)DEPTH * DEC_BATCH * RW_HEADS * 64 * 64;
constexpr size_t O_CVS = O_SHS + (size_t)DEPTH * DEC_BATCH * P_RW;
constexpr size_t O_END = O_CVS + (size_t)DEPTH * DEC_BATCH * 2 * UPW;
static_assert(O_END == 87760896, "output size");

namespace pg8 {
#define PG8_LAS __attribute__((address_space(3)))
typedef unsigned short bf16_t;
typedef short bf16x8 __attribute__((ext_vector_type(8)));
typedef float f32x4 __attribute__((ext_vector_type(4)));
typedef unsigned u32x4 __attribute__((ext_vector_type(4)));
constexpr int BM = 256, BK = 64, HALF = 128, HTB = HALF * BK * 2  , STAGE_BYTES = 8 * HTB, NXCD = 8, WGM = 8;

__host__ __device__ __forceinline__ int lds_byte(int r, int c) { const int st = (r >> 4) * 2 + (c >> 5), rr = r & 15, cc = c & 31, ob = rr * 64 + cc * 2; return st * 1024 + (ob ^ (((ob >> 9) & 1) << 5)); }
__host__ __device__ __forceinline__ void stage_rc(int b, int& R, int& C) { const int st = b / 1024, sb = b % 1024, swz = sb ^ (((sb >> 9) & 1) << 5); R = (st >> 1) * 16 + swz / 64; C = (st & 1) * 32 + (swz % 64) / 2; }
__host__ __device__ __forceinline__ int perm32(int rho) { const int n = rho >> 4, i = rho & 15; return 8 * (i >> 2) + 4 * n + (i & 3); }

struct Unit { int pm, pn; };
struct Gemm { const bf16_t* A; const bf16_t* Bt; int M, N, K; };

struct StaticOrder {
    int nM, nN, nwg, G, c;
    __host__ __device__ void init(int M, int N, int G_, int c_) { nM = M / BM; nN = N / BM; nwg = nM * nN; G = G_; c = c_; }
    __host__ __device__ bool next(int i, Unit& u) const {
        const long L = (long)i * G + c; if (L >= nwg) return false;
        int wgid = (int)L; { const int q = nwg / NXCD, r = nwg % NXCD, xcd = wgid % NXCD, off = wgid / NXCD; wgid = (xcd < r ? xcd * (q + 1) : r * (q + 1) + (xcd - r) * q) + off; }
        const int nig = WGM * nN, gid = wgid / nig, fm = gid * WGM, gsz = (nM - fm) < WGM ? (nM - fm) : WGM;
        u.pm = fm + ((wgid % nig) % gsz); u.pn = (wgid % nig) / gsz; return true;
    }
    __device__ __forceinline__ void a_ready(const Unit&) const {}
    __device__ __forceinline__ void done(const Unit&) const {}
};

typedef float f32x2_cv __attribute__((ext_vector_type(2))); typedef __bf16 bf16x2_cv __attribute__((ext_vector_type(2)));
__device__ __forceinline__ unsigned cvt_pk_bf16(float lo, float hi) { const f32x2_cv v = {lo, hi}; const bf16x2_cv b = __builtin_convertvector(v, bf16x2_cv); return __builtin_bit_cast(unsigned, b); }
typedef float f32x2 __attribute__((ext_vector_type(2)));
__device__ __forceinline__ float bf2f(unsigned short h) { return __uint_as_float((unsigned)h << 16); }
__device__ __forceinline__ float fast_sigmoid(float x) { return __builtin_amdgcn_rcpf(1.0f + __builtin_amdgcn_exp2f(-1.4426950408889634f * x)); }
__device__ __forceinline__ float neg_decay_log(float x) {
    const float y = -x, sp = fmaxf(y, 0.f) + 0.6931471805599453f * __builtin_amdgcn_logf(1.0f + __builtin_amdgcn_exp2f(-1.4426950408889634f * fabsf(y)));
    return -__builtin_amdgcn_exp2f(-1.4426950408889634f * (sp + 0.5f));
}
__device__ __forceinline__ u32x4 pack8(const f32x4 v0, const f32x4 v1) { u32x4 w; w.x = cvt_pk_bf16(v0[0], v0[1]); w.y = cvt_pk_bf16(v0[2], v0[3]); w.z = cvt_pk_bf16(v1[0], v1[1]); w.w = cvt_pk_bf16(v1[2], v1[3]); return w; }
__device__ __forceinline__ void unpack8(const u32x4 w, f32x4& v0, f32x4& v1) {
    v0[0] = __uint_as_float(w.x << 16); v0[1] = __uint_as_float(w.x & 0xffff0000u); v0[2] = __uint_as_float(w.y << 16); v0[3] = __uint_as_float(w.y & 0xffff0000u);
    v1[0] = __uint_as_float(w.z << 16); v1[1] = __uint_as_float(w.z & 0xffff0000u); v1[2] = __uint_as_float(w.w << 16); v1[3] = __uint_as_float(w.w & 0xffff0000u);
}
constexpr int E_MP = 16384, E_MS = 256;

struct EpiIn {
    static constexpr bool PERM = true, AFTER_DRAIN = false;
    const float* ss; const float* rope;
    bf16_t *Q, *K, *V, *URW;
    float *kout_p, *vout_p, *kout_s, *vout_s;
    float *sh_p, *sh_s;
    __device__ __forceinline__ void operator()(const f32x4 (&acc)[2][2][4][2], const Unit& u, int wr, int wc, int fr, int fq) const {
        const int pn = u.pn, rowb = u.pm * BM + wr * 64 + fr, cl = wc * 32 + 8 * fq;
        const bool rope_wave = (pn < 8) && ((wc & 1) == 0);
        const float sgn = (fq == 0) ? -1.f : 1.f;
#pragma unroll
        for (int ai = 0; ai < 2; ++ai)
#pragma unroll
            for (int m = 0; m < 4; ++m) {
                const int row = rowb + ai * HALF + m * 16;
                const float rstd = 1.0f / sqrtf(ss[row] * (1.0f / 1024.f) + 1e-6f);
                const bool smp = row >= E_MP;
                const int t = smp ? ((row - E_MP) & 31) : (row & 2047);
                const int bb = smp ? ((row - E_MP) >> 5) : (row >> 11);
                const int pos = smp ? 2048 + t : t;
                const bool last = smp ? (t == 31) : (t == 2047);
#pragma unroll
                for (int bj = 0; bj < 2; ++bj) {
                    f32x4 v0 = acc[ai][bj][m][0] * rstd, v1 = acc[ai][bj][m][1] * rstd;
                    const int col = pn * BM + bj * HALF + cl;
                    if (pn < 8) {
                        if (rope_wave) {
                            f32x4 p0, p1;
#pragma unroll
                            for (int j = 0; j < 4; ++j) { p0[j] = __shfl_xor(v0[j], 16); p1[j] = __shfl_xor(v1[j], 16); }
                            if (fq < 2) {
                                const float* tb = rope + pos * 16;
                                const f32x4 c0 = *(const f32x4*)(tb), c1 = *(const f32x4*)(tb + 4), s0 = *(const f32x4*)(tb + 8), s1 = *(const f32x4*)(tb + 12);
                                v0 = v0 * c0 + (p0 * s0) * sgn; v1 = v1 * c1 + (p1 * s1) * sgn;
                            }
                        }
                        if (pn < 4) { v0 = v0 * C2; v1 = v1 * C2; *(u32x4*)(Q + (size_t)row * 1024 + col) = pack8(v0, v1); }
                        else {
                            const int c = col - 1024;
                            *(u32x4*)(K + (size_t)row * 1024 + c) = pack8(v0, v1);
                            float* o = smp ? kout_s + (size_t)(row - E_MP) * 1024 + c : kout_p + (size_t)row * 1024 + c;
                            *(f32x4*)o = v0; *(f32x4*)(o + 4) = v1;
                        }
                    } else if (pn < 12) {
                        const int c = col - 2048;
                        *(u32x4*)(V + (size_t)row * 1024 + c) = pack8(v0, v1);
                        float* o = smp ? vout_s + (size_t)(row - E_MP) * 1024 + c : vout_p + (size_t)row * 1024 + c;
                        *(f32x4*)o = v0; *(f32x4*)(o + 4) = v1;
                    } else {
                        const int c = col - 3072;
                        *(u32x4*)(URW + (size_t)row * 3328 + c) = pack8(v0, v1);
                        if (last) { float* o = (smp ? sh_s : sh_p) + (size_t)bb * 3328 + c; *(f32x4*)o = v0; *(f32x4*)(o + 4) = v1; }
                    }
                }
            }
    }
};

struct EpiGate {
    static constexpr bool PERM = true, AFTER_DRAIN = false;
    const float* ss; bf16_t* GATE;
    __device__ __forceinline__ void operator()(const f32x4 (&acc)[2][2][4][2], const Unit& u, int wr, int wc, int fr, int fq) const {
        const int rowb = u.pm * BM + wr * 64 + fr, cl = u.pn * BM + wc * 32 + 8 * fq;
#pragma unroll
        for (int ai = 0; ai < 2; ++ai)
#pragma unroll
            for (int m = 0; m < 4; ++m) {
                const int row = rowb + ai * HALF + m * 16;
                const float rstd = 1.0f / sqrtf(ss[row] * (1.0f / 1024.f) + 1e-6f);
#pragma unroll
                for (int bj = 0; bj < 2; ++bj) {
                    f32x4 v0 = acc[ai][bj][m][0] * rstd, v1 = acc[ai][bj][m][1] * rstd;
#pragma unroll
                    for (int j = 0; j < 4; ++j) { v0[j] = fast_sigmoid(v0[j]); v1[j] = fast_sigmoid(v1[j]); }
                    *(u32x4*)(GATE + (size_t)row * 2048 + cl + bj * HALF) = pack8(v0, v1);
                }
            }
    }
};

struct EpiLora {
    static constexpr bool PERM = true, AFTER_DRAIN = false;
    const float *w0, *a0; bf16_t *LD, *LA, *LG;
    __device__ __forceinline__ void operator()(const f32x4 (&acc)[2][2][4][2], const Unit& u, int wr, int wc, int fr, int fq) const {
        const int pn = u.pn, rowb = u.pm * BM + wr * 64 + fr, cl = wc * 32 + 8 * fq;
        const int seg = pn >> 2;
#pragma unroll
        for (int bj = 0; bj < 2; ++bj) {
            const int c = (pn & 3) * BM + bj * HALF + cl;
            f32x4 b0 = (f32x4){0.f, 0.f, 0.f, 0.f}, b1 = b0;
            if (seg == 0) { b0 = *(const f32x4*)(w0 + c); b1 = *(const f32x4*)(w0 + c + 4); }
            else if (seg == 1) { b0 = *(const f32x4*)(a0 + c); b1 = *(const f32x4*)(a0 + c + 4); }
#pragma unroll
            for (int ai = 0; ai < 2; ++ai)
#pragma unroll
                for (int m = 0; m < 4; ++m) {
                    const int row = rowb + ai * HALF + m * 16;
                    f32x4 v0 = acc[ai][bj][m][0] + b0, v1 = acc[ai][bj][m][1] + b1;
                    if (seg == 0) {
#pragma unroll
                        for (int j = 0; j < 4; ++j) { v0[j] = neg_decay_log(v0[j]); v1[j] = neg_decay_log(v1[j]); }
                        *(u32x4*)(LD + (size_t)row * 1024 + c) = pack8(v0, v1);
                    } else if (seg == 1) {
#pragma unroll
                        for (int j = 0; j < 4; ++j) { v0[j] = fast_sigmoid(v0[j]); v1[j] = fast_sigmoid(v1[j]); }
                        *(u32x4*)(LA + (size_t)row * 1024 + c) = pack8(v0, v1);
                    } else {
                        *(u32x4*)(LG + (size_t)row * 1024 + c) = pack8(v0, v1);
                    }
                    asm volatile("" ::: "memory");
                }
        }
    }
};

struct EpiGated {
    static constexpr bool PERM = true, AFTER_DRAIN = false;
    const bf16_t* G; int goff; const bf16_t* S; bf16_t* O;
    __device__ __forceinline__ void operator()(const f32x4 (&acc)[2][2][4][2], const Unit& u, int wr, int wc, int fr, int fq) const {
        const int rowb = u.pm * BM + wr * 64 + fr, cl = u.pn * BM + wc * 32 + 8 * fq;
#pragma unroll
        for (int ai = 0; ai < 2; ++ai)
#pragma unroll
            for (int m = 0; m < 4; ++m) {
                const int row = rowb + ai * HALF + m * 16;
#pragma unroll
                for (int bj = 0; bj < 2; ++bj) {
                    const int c = cl + bj * HALF;
                    f32x4 g0, g1; unpack8(*(const u32x4*)(G + (size_t)row * 2048 + goff + c), g0, g1);
                    f32x4 v0 = acc[ai][bj][m][0] * g0, v1 = acc[ai][bj][m][1] * g1;
                    if (S) { f32x4 s0, s1; unpack8(*(const u32x4*)(S + (size_t)row * 1024 + c), s0, s1); v0 += s0; v1 += s1; }
                    *(u32x4*)(O + (size_t)row * 1024 + c) = pack8(v0, v1);
                }
            }
    }
};

struct EpiRes {
    static constexpr bool PERM = true, AFTER_DRAIN = false;
    float* X; bf16_t* XB; float* SS;
    __device__ __forceinline__ void operator()(const f32x4 (&acc)[2][2][4][2], const Unit& u, int wr, int wc, int fr, int fq) const {
        const int rowb = u.pm * BM + wr * 64 + fr, cl = u.pn * BM + wc * 32 + 8 * fq;
#pragma unroll
        for (int ai = 0; ai < 2; ++ai)
#pragma unroll
            for (int m = 0; m < 4; ++m) {
                const int row = rowb + ai * HALF + m * 16;
                float sq = 0.f;
#pragma unroll
                for (int bj = 0; bj < 2; ++bj) {
                    const int c = cl + bj * HALF;
                    float* xp = X + (size_t)row * 1024 + c;
                    const f32x4 v0 = *(const f32x4*)xp + acc[ai][bj][m][0], v1 = *(const f32x4*)(xp + 4) + acc[ai][bj][m][1];
                    *(f32x4*)xp = v0; *(f32x4*)(xp + 4) = v1;
                    *(u32x4*)(XB + (size_t)row * 1024 + c) = pack8(v0, v1);
                    sq += (v0[0] * v0[0] + v0[1] * v0[1]) + (v0[2] * v0[2] + v0[3] * v0[3]) + (v1[0] * v1[0] + v1[1] * v1[1]) + (v1[2] * v1[2] + v1[3] * v1[3]);
                }
                sq += __shfl_xor(sq, 16); sq += __shfl_xor(sq, 32);
                if (fq == 0) atomicAdd(SS + row, sq);
            }
    }
};

struct EpiUp {
    static constexpr bool PERM = true, AFTER_DRAIN = false;
    const float* ss; bf16_t* UP; float *cv_p, *cv_s;
    __device__ __forceinline__ void operator()(const f32x4 (&acc)[2][2][4][2], const Unit& u, int wr, int wc, int fr, int fq) const {
        const int rowb = u.pm * BM + wr * 64 + fr, cl = u.pn * BM + wc * 32 + 8 * fq;
#pragma unroll
        for (int ai = 0; ai < 2; ++ai)
#pragma unroll
            for (int m = 0; m < 4; ++m) {
                const int row = rowb + ai * HALF + m * 16;
                const float rstd = 1.0f / sqrtf(ss[row] * (1.0f / 1024.f) + 1e-6f);
                const bool smp = row >= E_MP;
                const int t = smp ? ((row - E_MP) & 31) : (row & 2047);
                const int bb = smp ? ((row - E_MP) >> 5) : (row >> 11);
                const int slot = smp ? t - 30 : t - 2046;
#pragma unroll
                for (int bj = 0; bj < 2; ++bj) {
                    const int c = cl + bj * HALF;
                    const f32x4 v0 = acc[ai][bj][m][0] * rstd, v1 = acc[ai][bj][m][1] * rstd;
                    *(u32x4*)(UP + (size_t)row * 5632 + c) = pack8(v0, v1);
                    if (slot >= 0) { float* o = (smp ? cv_s : cv_p) + ((size_t)bb * 2 + slot) * 5632 + c; *(f32x4*)o = v0; *(f32x4*)(o + 4) = v1; }
                }
            }
    }
};

template <class Epi, class Sched, bool ALIGN_EPI = false, bool SP2 = false>
__device__ __forceinline__ void gemm_phase(PG8_LAS unsigned char* lds, const Gemm g, const Sched& S, const Epi& E) {
    int tid_ = threadIdx.x; asm volatile("" : "+v"(tid_));
    const int tid = tid_, wid = __builtin_amdgcn_readfirstlane(tid >> 6), lane = tid & 63, wr = wid >> 2, wc = wid & 3, fr = lane & 15, fq = lane >> 4;
    const int K = g.K, nt = K / BK;
    unsigned voffA[2], voffB[2];
#pragma unroll
    for (int i = 0; i < 2; ++i) { int R, C; stage_rc(tid * 16 + i * 8192, R, C); const int Rb = Epi::PERM ? ((R & ~31) + perm32(R & 31)) : R;
        voffA[i] = (unsigned)(R * K + C) * 2u; voffB[i] = (unsigned)(Rb * K + C) * 2u; }
    const size_t kstep = (size_t)(BK * 2);
    const size_t hstep = (size_t)HALF * K * 2;
    const size_t tstep = 2 * hstep;
    const unsigned ldsw = (unsigned)wid * 1024u;
    const int aoff = lds_byte(wr * 64 + fr, fq * 8), boff = lds_byte(wc * 32 + fr, fq * 8);
#define PG8_SA(b, h) (((b) * 2 + (h)) * HTB)
#define PG8_SB(b, h) ((4 + (b) * 2 + (h)) * HTB)
#define PG8_STAGE(bufoff, gbase, voff) do { _Pragma("unroll") for (int _i = 0; _i < 2; ++_i) \
        __builtin_amdgcn_global_load_lds((const unsigned*)((const char*)(gbase) + (voff)[_i]), (PG8_LAS unsigned*)(lds + (bufoff) + ldsw + _i * 8192), 16, 0, 0); } while (0)
#define PG8_LDA(dst, b, h) do { _Pragma("unroll") for (int m = 0; m < 4; ++m) _Pragma("unroll") for (int k = 0; k < 2; ++k) dst[m][k] = *(const PG8_LAS bf16x8*)(lds + PG8_SA(b, h) + aoff + m * 2048 + k * 1024); } while (0)
#define PG8_LDB(dst, b, h) do { _Pragma("unroll") for (int n = 0; n < 2; ++n) _Pragma("unroll") for (int k = 0; k < 2; ++k) dst[n][k] = *(const PG8_LAS bf16x8*)(lds + PG8_SB(b, h) + boff + n * 2048 + k * 1024); } while (0)
#define PG8_MMA(ai, bj, At, Bt) do { __builtin_amdgcn_s_setprio(1); _Pragma("unroll") for (int m = 0; m < 4; ++m) _Pragma("unroll") for (int n = 0; n < 2; ++n) _Pragma("unroll") for (int k = 0; k < 2; ++k) \
        acc[ai][bj][m][n] = __builtin_amdgcn_mfma_f32_16x16x32_bf16(Bt[n][k], At[m][k], acc[ai][bj][m][n], 0, 0, 0); __builtin_amdgcn_s_setprio(0); } while (0)
#define PG8_WAIT_V(n) asm volatile("s_waitcnt vmcnt(" #n ")" ::: "memory")
#define PG8_WAIT_L(n) asm volatile("s_waitcnt lgkmcnt(" #n ")" ::: "memory")
#define PG8_BAR __builtin_amdgcn_s_barrier()
#define PG8_SCHED __builtin_amdgcn_sched_barrier(0)
    Unit cur, nxt; int ui = 0;
    if (!S.next(0, cur)) return;
    f32x4 acc[2][2][4][2];
#pragma unroll
    for (int a = 0; a < 2; ++a)
#pragma unroll
        for (int b = 0; b < 2; ++b)
#pragma unroll
            for (int m = 0; m < 4; ++m)
#pragma unroll
                for (int n = 0; n < 2; ++n) acc[a][b][m][n] = (f32x4){0.f, 0.f, 0.f, 0.f};
    bf16x8 At[4][2], B0[2][2], B1[2][2];
    const char* cA = (const char*)g.A + (size_t)cur.pm * tstep; const char* cB = (const char*)g.Bt + (size_t)cur.pn * tstep;
    S.a_ready(cur);
    if constexpr (SP2) {
        PG8_STAGE(PG8_SB(0, 0), cB, voffB); PG8_STAGE(PG8_SB(0, 1), cB + hstep, voffB); PG8_STAGE(PG8_SA(0, 0), cA, voffA); PG8_STAGE(PG8_SA(0, 1), cA + hstep, voffA);
        if (wr == 1) PG8_BAR;
        PG8_WAIT_V(2); PG8_BAR;
        PG8_STAGE(PG8_SB(1, 0), cB + kstep, voffB); PG8_STAGE(PG8_SA(1, 0), cA + kstep, voffA); PG8_STAGE(PG8_SB(1, 1), cB + hstep + kstep, voffB);
        PG8_WAIT_V(6); PG8_BAR;
    } else {
        PG8_STAGE(PG8_SB(0, 0), cB, voffB); PG8_STAGE(PG8_SA(0, 0), cA, voffA); PG8_STAGE(PG8_SB(0, 1), cB + hstep, voffB); PG8_STAGE(PG8_SA(0, 1), cA + hstep, voffA);
        if (wr == 1) PG8_BAR;
        PG8_WAIT_V(4); PG8_BAR;
        PG8_STAGE(PG8_SB(1, 0), cB + kstep, voffB); PG8_STAGE(PG8_SA(1, 0), cA + kstep, voffA); PG8_STAGE(PG8_SB(1, 1), cB + hstep + kstep, voffB);
        PG8_WAIT_V(6); PG8_BAR;
    }
    for (;;) {
        const bool has_next = S.next(ui + 1, nxt);
        const char* nA = has_next ? (const char*)g.A + (size_t)nxt.pm * tstep : cA; const char* nB = has_next ? (const char*)g.Bt + (size_t)nxt.pn * tstep : cB;
        for (int t = 0; t < nt; t += 2) {
            const bool last = (t == nt - 2);
            const char* a1 = cA + (size_t)(t + 1) * kstep;
            const char* a2 = last ? nA : cA + (size_t)(t + 2) * kstep; const char* b2 = last ? nB : cB + (size_t)(t + 2) * kstep;
            const char* a3 = a2 + kstep; const char* b3 = b2 + kstep;
            if (last && has_next) S.a_ready(nxt);
            if constexpr (SP2) {
            PG8_LDB(B0, 0, 0); PG8_LDB(B1, 0, 1); PG8_SCHED; PG8_LDA(At, 0, 0); PG8_STAGE(PG8_SA(1, 1), a1 + hstep, voffA);
            PG8_WAIT_V(8); PG8_WAIT_L(0); PG8_BAR; PG8_MMA(0, 0, At, B0); PG8_MMA(0, 1, At, B1); PG8_BAR; PG8_SCHED;
            PG8_LDA(At, 0, 1); PG8_STAGE(PG8_SB(0, 0), b2, voffB); PG8_STAGE(PG8_SB(0, 1), b2 + hstep, voffB); PG8_STAGE(PG8_SA(0, 0), a2, voffA);
            PG8_WAIT_V(8); PG8_WAIT_L(0); PG8_BAR; PG8_MMA(1, 0, At, B0); PG8_MMA(1, 1, At, B1); PG8_BAR; PG8_SCHED;
            PG8_LDB(B0, 1, 0); PG8_LDB(B1, 1, 1); PG8_SCHED; PG8_LDA(At, 1, 0); PG8_STAGE(PG8_SA(0, 1), a2 + hstep, voffA);
            PG8_WAIT_V(8); PG8_WAIT_L(0); PG8_BAR; PG8_MMA(0, 0, At, B0); PG8_MMA(0, 1, At, B1); PG8_BAR; PG8_SCHED;
            PG8_LDA(At, 1, 1); PG8_STAGE(PG8_SB(1, 0), b3, voffB); PG8_STAGE(PG8_SB(1, 1), b3 + hstep, voffB); PG8_STAGE(PG8_SA(1, 0), a3, voffA);
            PG8_WAIT_V(8); PG8_WAIT_L(0); PG8_BAR; PG8_MMA(1, 0, At, B0); PG8_MMA(1, 1, At, B1); PG8_BAR; PG8_SCHED;
            } else {
            PG8_LDB(B0, 0, 0); PG8_SCHED; PG8_LDA(At, 0, 0); PG8_STAGE(PG8_SA(1, 1), a1 + hstep, voffA);
            PG8_WAIT_L(8); PG8_BAR; PG8_WAIT_L(0); PG8_MMA(0, 0, At, B0); PG8_BAR; PG8_SCHED;
            PG8_LDB(B1, 0, 1); PG8_STAGE(PG8_SB(0, 0), b2, voffB);
            PG8_BAR; PG8_WAIT_L(0); PG8_MMA(0, 1, At, B1); PG8_BAR;
            PG8_LDA(At, 0, 1); PG8_STAGE(PG8_SA(0, 0), a2, voffA);
            PG8_BAR; PG8_WAIT_L(0); PG8_MMA(1, 0, At, B0); PG8_BAR; PG8_SCHED;
            PG8_STAGE(PG8_SB(0, 1), b2 + hstep, voffB);
            PG8_WAIT_V(6); PG8_BAR; PG8_MMA(1, 1, At, B1); PG8_BAR;
            PG8_LDB(B0, 1, 0); PG8_SCHED; PG8_LDA(At, 1, 0); PG8_STAGE(PG8_SA(0, 1), a2 + hstep, voffA);
            PG8_WAIT_L(8); PG8_BAR; PG8_WAIT_L(0); PG8_MMA(0, 0, At, B0); PG8_BAR; PG8_SCHED;
            PG8_LDB(B1, 1, 1); PG8_STAGE(PG8_SB(1, 0), b3, voffB);
            PG8_BAR; PG8_WAIT_L(0); PG8_MMA(0, 1, At, B1); PG8_BAR;
            PG8_LDA(At, 1, 1); PG8_STAGE(PG8_SA(1, 0), a3, voffA);
            PG8_BAR; PG8_WAIT_L(0); PG8_MMA(1, 0, At, B0); PG8_BAR; PG8_SCHED;
            PG8_STAGE(PG8_SB(1, 1), b3 + hstep, voffB);
            PG8_WAIT_V(6); PG8_BAR; PG8_MMA(1, 1, At, B1); PG8_BAR;
            }
        }
        if constexpr (ALIGN_EPI) { if (wr == 0) PG8_BAR; }
        if constexpr (!Epi::AFTER_DRAIN) { E(acc, cur, wr, wc, fr, fq); S.done(cur); }
        if (!has_next) break;
#pragma unroll
        for (int a = 0; a < 2; ++a)
#pragma unroll
            for (int b = 0; b < 2; ++b)
#pragma unroll
                for (int m = 0; m < 4; ++m)
#pragma unroll
                    for (int n = 0; n < 2; ++n) acc[a][b][m][n] = (f32x4){0.f, 0.f, 0.f, 0.f};
        cur = nxt; cA = nA; cB = nB; ++ui;
        if constexpr (ALIGN_EPI) { if (wr == 1) PG8_BAR; }
    }
    PG8_WAIT_V(0);
    if constexpr (!ALIGN_EPI) { if (wr == 0) PG8_BAR; }
    PG8_BAR;
    if constexpr (Epi::AFTER_DRAIN) { E.fused(acc, cur, wr, wc, fr, fq, lds, wid, lane); S.done(cur); }
#undef PG8_SA
#undef PG8_SB
#undef PG8_STAGE
#undef PG8_LDA
#undef PG8_LDB
#undef PG8_MMA
#undef PG8_WAIT_V
#undef PG8_WAIT_L
#undef PG8_BAR
#undef PG8_SCHED
}
}

constexpr int NWAVES = 8;
constexpr size_t MiB = 1u << 20;
constexpr size_t WS_CTL = 0, CTL_ZERO_BYTES = 2 * MiB;
constexpr size_t WS_ROPE = 2 * MiB;
constexpr size_t WS_W = 8 * MiB;
constexpr size_t W_IN = 0, W_ODA = W_IN + (size_t)P_TOTAL * 1024 * 2, W_ORW = W_ODA + 2 * MiB, W_OUT = W_ORW + 2 * MiB, W_UP = W_OUT + 2 * MiB,
                 W_DN = W_UP + (size_t)UPW * 1024 * 2, W_LORA = W_DN + (size_t)1024 * D_FF * 2, W_LAYER = W_LORA + (size_t)3072 * 256 * 2;
static_assert(W_LAYER == 42467328, "weights per layer");
constexpr size_t W_DN1 = W_LAYER;
constexpr size_t WS_XB = WS_W + W_LAYER + (size_t)1024 * D_FF * 2;
static_assert(WS_XB == 54 * MiB, "weights region");
constexpr size_t ACT = (size_t)MT * 1024 * 2;
constexpr size_t WS_POOL = WS_XB + ACT;
constexpr size_t B_Q = WS_POOL, B_K = B_Q + ACT, B_V = B_K + ACT, B_OC = B_V + ACT  , B_ORW = B_OC + 2 * ACT, B_URW = B_ORW + ACT, B_LD = B_URW + (size_t)MT * P_RW * 2, B_LA = B_LD + ACT,
                 B_LG = B_LA + ACT, B_END = B_LG + ACT;
constexpr size_t B_LIN = B_OC;
constexpr size_t B_GATE = B_Q, B_OA = B_V;
constexpr size_t B_MRG = B_URW;
constexpr size_t B_UP = WS_POOL, B_GT = B_URW;
constexpr size_t WS_SP = B_END;
constexpr size_t B_END2 = WS_SP + (size_t)1024 * 32 * 132 * 4;
static_assert(B_UP + (size_t)MT * UPW * 2 <= B_GT && B_GT + (size_t)MT * D_FF * 2 <= B_LD, "FFN overlay");
static_assert(B_END2 <= 512 * MiB, "workspace map");
constexpr int CW_BAR = 4096;
constexpr int CW_LAM = 8192;
constexpr int CW_SS = 16384;
static_assert((CW_SS + 5 * MT) * 4 <= (int)CTL_ZERO_BYTES, "CTL region");
constexpr int RING_OFF = 0, RING_BYTES = 131072;
constexpr int LDSCTL_OFF = RING_BYTES, MISC_OFF = LDSCTL_OFF + 320;
constexpr int LDS_BYTES = 147456;

constexpr int PH_PER_LAYER = 11;
constexpr int NPHASE = 1 + DEPTH * PH_PER_LAYER + 1;
enum { K_G1 = 0, K_LP, K_LR, K_SC, K_CB, K_M1, K_M2, K_WO, K_UP, K_CV, K_DN };

#include <hip/hip_bf16.h>
#include <cmath>
namespace attn_body {
using bf16=__hip_bfloat16;
using bf16x8=__attribute__((ext_vector_type(8)))short;
using s16x4=__attribute__((ext_vector_type(4)))short;
using f32x16=__attribute__((ext_vector_type(16)))float;
using u32x4=__attribute__((ext_vector_type(4)))unsigned;
constexpr int BATCH=8,SEQ=2048,D=64,DM=1024;
constexpr int NW=8,QBLK=32,QB=QBLK*NW,KVBLK=64,NQB=SEQ/QB;
constexpr int ATTN_PITCH=DM, ATTN_UNIT_ROWS=QB;
__device__ __forceinline__ int crow(int r,int hi){return (r&3)+8*(r>>2)+4*hi;}
#define SBAR() __builtin_amdgcn_sched_barrier(0)
__device__ __forceinline__ void cmask(f32x16&p0,f32x16&p1,int jb,int wid){
  const float NEG=-INFINITY;
  if(jb>(wid>>1)){
    #pragma unroll
    for(int r=0;r<16;++r){p0[r]=NEG;p1[r]=NEG;}
  }
}

constexpr int NSLOT=3, SLOTB=8192;
constexpr int LDS_K=0, LDS_V=NSLOT*SLOTB, LDS_WS=2*NSLOT*SLOTB, LDS_OST=LDS_WS+NW*64*4, LDS_BYTES=LDS_OST+NW*4096;
constexpr float C2=0.125f*1.4426950408889634f;
__device__ __forceinline__ void glds16(const void*gsrc,unsigned lds_dst){unsigned keep;
  asm volatile("s_mov_b32 %0, m0\n\ts_mov_b32 m0, %2\n\ts_nop 0\n\tglobal_load_lds_dwordx4 %1, off\n\ts_mov_b32 m0, %0":"=&s"(keep):"v"(gsrc),"s"(lds_dst):"memory");}
__device__ __forceinline__ float max3f(float a,float b,float c){float r;asm("v_max3_f32 %0, %1, %2, %3":"=v"(r):"v"(a),"v"(b),"v"(c));return r;}
__device__ __forceinline__ float max2f(float a,float b){float r;asm("v_max_f32_e32 %0, %1, %2":"=v"(r):"v"(a),"v"(b));return r;}
__device__ __forceinline__ float fadd_s(float a,float b){float r;asm("v_add_f32_e32 %0, %1, %2":"=v"(r):"v"(a),"v"(b));return r;}
__device__ __forceinline__ float fsub_s(float a,float b){float r;asm("v_sub_f32_e32 %0, %1, %2":"=v"(r):"v"(a),"v"(b));return r;}
typedef float f32x2_t __attribute__((ext_vector_type(2))); typedef __bf16 bf16x2_t __attribute__((ext_vector_type(2)));
__device__ __forceinline__ unsigned cvtpk_s(float lo,float hi){f32x2_t v={lo,hi};bf16x2_t b=__builtin_convertvector(v,bf16x2_t);return __builtin_bit_cast(unsigned,b);}
#define WAIT_BAR(N) asm volatile("s_waitcnt vmcnt(" #N ") lgkmcnt(0)\n\ts_barrier":::"memory")

__device__ __forceinline__ void qkt(f32x16&p0,f32x16&p1,const char*Kslot,const bf16x8*qr,const f32x16&negm,int r32,int hi){
  const char*kb=Kslot+hi*1024+r32*16;
  #pragma unroll
  for(int d0=0;d0<4;++d0){
    const bf16x8 b0=*reinterpret_cast<const bf16x8*>(kb+d0*2048);
    const bf16x8 b1=*reinterpret_cast<const bf16x8*>(kb+d0*2048+512);
    if(d0==0){p0=__builtin_amdgcn_mfma_f32_32x32x16_bf16(b0,qr[0],negm,0,0,0);p1=__builtin_amdgcn_mfma_f32_32x32x16_bf16(b1,qr[0],negm,0,0,0);}
    else{p0=__builtin_amdgcn_mfma_f32_32x32x16_bf16(b0,qr[d0],p0,0,0,0);p1=__builtin_amdgcn_mfma_f32_32x32x16_bf16(b1,qr[d0],p1,0,0,0);}}
}
typedef __attribute__((address_space(3))) const char* lds_cptr;
typedef short v4i16_t __attribute__((ext_vector_type(4)));
__device__ __forceinline__ void kload8(bf16x8*kf,lds_cptr kp){
  kf[0]=*(const __attribute__((address_space(3))) bf16x8*)(kp);      kf[1]=*(const __attribute__((address_space(3))) bf16x8*)(kp+512);
  kf[2]=*(const __attribute__((address_space(3))) bf16x8*)(kp+2048); kf[3]=*(const __attribute__((address_space(3))) bf16x8*)(kp+2560);
  kf[4]=*(const __attribute__((address_space(3))) bf16x8*)(kp+4096); kf[5]=*(const __attribute__((address_space(3))) bf16x8*)(kp+4608);
  kf[6]=*(const __attribute__((address_space(3))) bf16x8*)(kp+6144); kf[7]=*(const __attribute__((address_space(3))) bf16x8*)(kp+6656);
}
__device__ __forceinline__ void kload2(bf16x8*kf,lds_cptr kp,int j){ kf[2*j]=*(const __attribute__((address_space(3))) bf16x8*)(kp+j*2048); kf[2*j+1]=*(const __attribute__((address_space(3))) bf16x8*)(kp+j*2048+512); }
__device__ __forceinline__ s16x4 vtr(lds_cptr p){ return __builtin_bit_cast(s16x4,__builtin_amdgcn_ds_read_tr16_b64_v4i16((__attribute__((address_space(3))) v4i16_t*)p)); }
__device__ __forceinline__ float rowmax(const f32x16&p0,const f32x16&p1){
  float a=max3f(p0[0],p0[1],p1[0]),b=max3f(p0[2],p0[3],p1[1]);a=max3f(a,p1[2],p1[3]);
  #pragma unroll
  for(int r=4;r<16;r+=4){a=max3f(a,p0[r],p0[r+1]);b=max3f(b,p0[r+2],p0[r+3]);a=max3f(a,p1[r],p1[r+1]);b=max3f(b,p1[r+2],p1[r+3]);}
  const float m=max2f(a,b);
  auto rr=__builtin_amdgcn_permlane32_swap(__float_as_uint(m),__float_as_uint(m),false,false);
  return max2f(__uint_as_float(rr[0]),__uint_as_float(rr[1]));
}
__device__ __forceinline__ void pv(f32x16*o,int vb,bf16x8 pa0,bf16x8 pa1,bf16x8 pa2,bf16x8 pa3){
  #pragma unroll
  for(int d0=0;d0<2;++d0){s16x4 lo[4],hi[4];
    #pragma unroll
    for(int ks=0;ks<4;++ks){
      asm volatile("ds_read_b64_tr_b16 %0,%1 offset:%c2":"=&v"(lo[ks]):"v"(vb),"i"(d0*4096+ks*1024):"memory");
      asm volatile("ds_read_b64_tr_b16 %0,%1 offset:%c2":"=&v"(hi[ks]):"v"(vb),"i"(d0*4096+ks*1024+512):"memory");}
    asm volatile("s_waitcnt lgkmcnt(0)":::"memory");SBAR();
    #define PK(k) (bf16x8){lo[k][0],lo[k][1],lo[k][2],lo[k][3],hi[k][0],hi[k][1],hi[k][2],hi[k][3]}
    o[d0]=__builtin_amdgcn_mfma_f32_32x32x16_bf16(pa0,PK(0),o[d0],0,0,0);
    o[d0]=__builtin_amdgcn_mfma_f32_32x32x16_bf16(pa1,PK(1),o[d0],0,0,0);
    o[d0]=__builtin_amdgcn_mfma_f32_32x32x16_bf16(pa2,PK(2),o[d0],0,0,0);
    o[d0]=__builtin_amdgcn_mfma_f32_32x32x16_bf16(pa3,PK(3),o[d0],0,0,0);
    #undef PK
  }
}

#ifndef ATTN_STORE16
#define ATTN_STORE16(p,v) (*(u32x4*)(p)=(v))
#endif
template<int THRL> __device__ __forceinline__ void attn_unit(int b,int qcol,int vcol,int qb,const bf16*Q,const bf16*K,const bf16*V,bf16*O,char*shm){
  const int tid=threadIdx.x,lane=tid&63,r32=lane&31,hi=lane>>5; const int wid=__builtin_amdgcn_readfirstlane(tid>>6);
  const long rowbase=(long)b*SEQ; const int q0=qb*QB;
  const bf16*Qw=Q+(rowbase+q0+wid*QBLK)*DM+qcol;
  const bf16*Kh=K+rowbase*DM+qcol,*Vh=V+rowbase*DM+vcol;
  const unsigned lds0=(unsigned)(uintptr_t)shm;
  float*wsf=(float*)(shm+LDS_WS)+wid*64;
  const bf16*ksrc=Kh+(long)lane*DM+wid*8;
  const bf16*vsrc=Vh+(long)(16*(wid&3)+(lane>>2))*DM+(wid>>2)*32+(lane&3)*8;
  const unsigned kdst=lds0+LDS_K+wid*1024, vdst=lds0+LDS_V+wid*1024;
  #define DMA_K(t,slot) glds16(ksrc+(long)(t)*KVBLK*DM,(unsigned)__builtin_amdgcn_readfirstlane(kdst+(slot)))
  #define DMA_V(t,slot) glds16(vsrc+(long)(t)*KVBLK*DM,(unsigned)__builtin_amdgcn_readfirstlane(vdst+(slot)))
  const int vb0=(int)(lds0+LDS_V)+((lane>>4)&1)*32+(lane&3)*8+(4*hi+((lane&15)>>2))*64;
  const char*Kbase=shm+LDS_K; bf16x8 kf[8];
  const lds_cptr shm3=(lds_cptr)shm; const lds_cptr kp0=shm3+LDS_K+hi*1024+r32*16; const lds_cptr vp0=shm3+LDS_V+((lane>>4)&1)*32+(lane&3)*8+(4*hi+((lane&15)>>2))*64;
  const int NT=(q0+QB)/KVBLK;
  DMA_K(0,0);DMA_V(0,0);DMA_K(1,SLOTB);
  bf16x8 qr[4];
  #pragma unroll
  for(int d0=0;d0<4;++d0)qr[d0]=*reinterpret_cast<const bf16x8*>(&Qw[(long)r32*DM+d0*16+hi*8]);
  float mhat=0.f,l_reg=0.f;f32x16 o[2];o[0]=f32x16{};o[1]=f32x16{};const f32x16 zc=f32x16{}; float nm=0.f;
  const int qrel=wid*QBLK+r32;
  #define CMASK(P0,P1,t) do{int jb_=(t)-(NT-4); if(jb_>=0)cmask(P0,P1,jb_,wid);}while(0)
  bool resc=false;
  #define START(P0,P1) do{ const float rm=rowmax(P0,P1); resc=false; \
    { const float dl=rm; mhat=fadd_s(mhat,dl); \
      _Pragma("unroll") for(int r=0;r<16;++r){P0[r]=fsub_s(P0[r],dl);P1[r]=fsub_s(P1[r],dl);} \
      nm=-mhat; } \
    _Pragma("unroll") for(int r=0;r<16;++r)P0[r]=__builtin_amdgcn_exp2f(P0[r]); }while(0)
  #define RESC() do{ if(resc){ asm volatile("s_waitcnt lgkmcnt(0)":::"memory"); \
      _Pragma("unroll") for(int d_=0;d_<2;++d_) _Pragma("unroll") for(int r=0;r<16;++r)o[d_][r]*=wsf[crow(r,hi)]; } }while(0)
  f32x16 pA0,pA1,pB0,pB1;
  int sl_prev=0,sl_cur=0,sl_next=SLOTB;
  #define ROT() do{sl_prev=sl_cur;sl_cur=sl_next;sl_next=(sl_next==(NSLOT-1)*SLOTB)?0:sl_next+SLOTB;}while(0)
  DMA_K(2,2*SLOTB);
  WAIT_BAR(3);
  qkt(pA0,pA1,Kbase,qr,zc,r32,hi);asm volatile("s_nop 15\n\ts_nop 7":"+v"(pA0),"+v"(pA1));CMASK(pA0,pA1,0);
  START(pA0,pA1);
  _Pragma("unroll") for(int r=0;r<16;++r)pA1[r]=__builtin_amdgcn_exp2f(pA1[r]);
  WAIT_BAR(0);
  DMA_K(3,0);DMA_V(1,SLOTB);
  ROT();
  kload8(kf,kp0+sl_cur);
  WAIT_BAR(2);
  s16x4 vlo[8],vhi[8]; u32x4 pw0,pw1,pw2,pw3;
  #define PKW(P,B) cvtpk_s(P[B],P[B+1])
  #define PAF(k) __builtin_bit_cast(bf16x8,pw##k)
  #define VFR(i) (bf16x8){vlo[i][0],vlo[i][1],vlo[i][2],vlo[i][3],vhi[i][0],vhi[i][1],vhi[i][2],vhi[i][3]}
  #define PIN(x) asm volatile("":"+v"(x))
  #define MX3(a,b,c) __builtin_fmaxf(__builtin_fmaxf((a),(b)),(c))
  #define GAPA(MF,A0,A1,A2,A3,W0,W1,PW) do{ MF; sacc+=A0; sacc+=A1; sacc+=A2; sacc+=A3; PIN(sacc); W0; W1; PIN(PW); SBAR(); }while(0)
  #define EX(v) __builtin_amdgcn_exp2f(v)
  #define GAPB(MF,X,B) do{ MF; X[B]=EX(X[B]); X[B+1]=EX(X[B+1]); X[B+2]=EX(X[B+2]); X[B+3]=EX(X[B+3]); PIN(X); SBAR(); }while(0)
  #define VRD(i) do{ vlo[i]=vtr(vp_+(((i)>>2)*4096+((i)&3)*1024)); vhi[i]=vtr(vp_+(((i)>>2)*4096+((i)&3)*1024+512)); }while(0)
  #define KRD(G,j) do{ if(G){ kload2(kf,kp0+sl_next,j); SBAR(); } }while(0)
  #define STEP(C0,C1,P0,P1,t,GK,GV,GL) do{ SBAR(); \
    const lds_cptr vp_=vp0+sl_prev; \
    VRD(0); SBAR(); float sacc=(P0[0]+P0[1]); \
    GAPA(C0=__builtin_amdgcn_mfma_f32_32x32x16_bf16(kf[0],qr[0],zc,0,0,0), P0[2],P0[3],P0[4],P0[5],     pw0[0]=PKW(P0,0), pw0[1]=PKW(P0,2), pw0); \
    VRD(4); SBAR(); GAPA(C1=__builtin_amdgcn_mfma_f32_32x32x16_bf16(kf[1],qr[0],zc,0,0,0), P0[6],P0[7],P0[8],P0[9],     pw0[2]=PKW(P0,4), pw0[3]=PKW(P0,6), pw0); \
    VRD(1); SBAR(); GAPA(C0=__builtin_amdgcn_mfma_f32_32x32x16_bf16(kf[2],qr[1],C0,0,0,0),   P0[10],P0[11],P0[12],P0[13], pw1[0]=PKW(P0,8), pw1[1]=PKW(P0,10), pw1); \
    VRD(5); SBAR(); GAPA(C1=__builtin_amdgcn_mfma_f32_32x32x16_bf16(kf[3],qr[1],C1,0,0,0),   P0[14],P0[15],P1[0],P1[1],   pw1[2]=PKW(P0,12),pw1[3]=PKW(P0,14), pw1); \
    VRD(2); SBAR(); GAPA(C0=__builtin_amdgcn_mfma_f32_32x32x16_bf16(kf[4],qr[2],C0,0,0,0),   P1[2],P1[3],P1[4],P1[5],     pw2[0]=PKW(P1,0), pw2[1]=PKW(P1,2), pw2); \
    VRD(6); SBAR(); GAPA(C1=__builtin_amdgcn_mfma_f32_32x32x16_bf16(kf[5],qr[2],C1,0,0,0),   P1[6],P1[7],P1[8],P1[9],     pw2[2]=PKW(P1,4), pw2[3]=PKW(P1,6), pw2); \
    VRD(3); SBAR(); GAPA(C0=__builtin_amdgcn_mfma_f32_32x32x16_bf16(kf[6],qr[3],C0,0,0,0),   P1[10],P1[11],P1[12],P1[13], pw3[0]=PKW(P1,8), pw3[1]=PKW(P1,10), pw3); \
    VRD(7); SBAR(); GAPA(C1=__builtin_amdgcn_mfma_f32_32x32x16_bf16(kf[7],qr[3],C1,0,0,0),   P1[14],P1[15],0.f,0.f,       pw3[2]=PKW(P1,12),pw3[3]=PKW(P1,14), pw3); \
    l_reg+=sacc; \
    if(GK){DMA_K((t)+3,sl_cur);} if(GV){DMA_V((t)+1,sl_next);} \
    _Pragma("unroll") for(int r=0;r<16;++r){C0[r]+=nm;C1[r]+=nm;} \
    CMASK(C0,C1,t); \
    { float a=MX3(C0[0],C0[1],C1[0]),b=MX3(C0[2],C0[3],C1[1]); a=MX3(a,C1[2],C1[3]); \
      _Pragma("unroll") for(int r=4;r<16;r+=4){a=MX3(a,C0[r],C0[r+1]);b=MX3(b,C0[r+2],C0[r+3]);a=MX3(a,C1[r],C1[r+1]);b=MX3(b,C1[r+2],C1[r+3]);} \
      float rm=__builtin_fmaxf(a,b); { auto rr=__builtin_amdgcn_permlane32_swap(__float_as_uint(rm),__float_as_uint(rm),false,false); rm=__builtin_fmaxf(__uint_as_float(rr[0]),__uint_as_float(rr[1])); } \
      resc=false; \
      if(__builtin_expect(__any(rm>(float)THRL),0)){ const float dl=__builtin_fmaxf(rm,0.f); mhat+=dl; \
        _Pragma("unroll") for(int r=0;r<16;++r){C0[r]-=dl;C1[r]-=dl;} \
        nm=-mhat; \
        const float f=__builtin_amdgcn_exp2f(-dl); l_reg*=f; if(hi==0)wsf[r32]=f; resc=true; } } \
    SBAR(); \
    GAPB(o[0]=__builtin_amdgcn_mfma_f32_32x32x16_bf16(PAF(0),VFR(0),o[0],0,0,0), C0,0); \
    GAPB(o[1]=__builtin_amdgcn_mfma_f32_32x32x16_bf16(PAF(0),VFR(4),o[1],0,0,0), C0,4); \
    KRD(GL,0); GAPB(o[0]=__builtin_amdgcn_mfma_f32_32x32x16_bf16(PAF(1),VFR(1),o[0],0,0,0), C0,8); \
    KRD(GL,1); GAPB(o[1]=__builtin_amdgcn_mfma_f32_32x32x16_bf16(PAF(1),VFR(5),o[1],0,0,0), C0,12); \
    KRD(GL,2); GAPB(o[0]=__builtin_amdgcn_mfma_f32_32x32x16_bf16(PAF(2),VFR(2),o[0],0,0,0), C1,0); \
    KRD(GL,3); GAPB(o[1]=__builtin_amdgcn_mfma_f32_32x32x16_bf16(PAF(2),VFR(6),o[1],0,0,0), C1,4); \
    GAPB(o[0]=__builtin_amdgcn_mfma_f32_32x32x16_bf16(PAF(3),VFR(3),o[0],0,0,0), C1,8); \
    GAPB(o[1]=__builtin_amdgcn_mfma_f32_32x32x16_bf16(PAF(3),VFR(7),o[1],0,0,0), C1,12); \
    }while(0)
  int t=1;
  #undef CMASK
  #define CMASK(P0,P1,t) do{}while(0)
  for(;t+5<NT;t+=2){
    STEP(pB0,pB1,pA0,pA1,t,true,true,true);     WAIT_BAR(2); RESC(); ROT();
    STEP(pA0,pA1,pB0,pB1,t+1,true,true,true);   WAIT_BAR(2); RESC(); ROT();
  }
  #undef CMASK
  #define CMASK(P0,P1,t) do{int jb_=(t)-(NT-4); if(jb_>=0)cmask(P0,P1,jb_,wid);}while(0)
  #define ENDW(tt) do{ if((tt)+3<NT){WAIT_BAR(2);} else if((tt)+2<NT){WAIT_BAR(1);} else {WAIT_BAR(0);} }while(0)
  for(;t+1<NT;t+=2){
    STEP(pB0,pB1,pA0,pA1,t,(t+3<NT),(t+1<NT),(t+1<NT));       ENDW(t);   RESC(); ROT();
    STEP(pA0,pA1,pB0,pB1,t+1,(t+4<NT),(t+2<NT),(t+2<NT));     ENDW(t+1); RESC(); ROT();
  }
  STEP(pB0,pB1,pA0,pA1,NT-1,false,false,false); RESC();
  { float sacc=pB0[0]+pB0[1]; _Pragma("unroll") for(int r=2;r<16;++r)sacc+=pB0[r]; _Pragma("unroll") for(int r=0;r<16;++r)sacc+=pB1[r]; l_reg+=sacc;
    pw0=(u32x4){PKW(pB0,0),PKW(pB0,2),PKW(pB0,4),PKW(pB0,6)};pw1=(u32x4){PKW(pB0,8),PKW(pB0,10),PKW(pB0,12),PKW(pB0,14)};pw2=(u32x4){PKW(pB1,0),PKW(pB1,2),PKW(pB1,4),PKW(pB1,6)};pw3=(u32x4){PKW(pB1,8),PKW(pB1,10),PKW(pB1,12),PKW(pB1,14)};
    SBAR(); pv(o,vb0+sl_cur,PAF(0),PAF(1),PAF(2),PAF(3)); }
  #undef PKW
  #undef PAF
  #undef VFR
  #undef PIN
  #undef MX3
  #undef GAPA
  #undef GAPB
  #undef EX
  #undef VRD
  #undef KRD
  #undef STEP
  #undef ENDW
  {auto rr=__builtin_amdgcn_permlane32_swap(__float_as_uint(l_reg),__float_as_uint(l_reg),false,false);l_reg=__uint_as_float(rr[0])+__uint_as_float(rr[1]);}
  if(hi==0)wsf[32+r32]=l_reg;asm volatile("s_waitcnt lgkmcnt(0)":::"memory");
  float rli[16];
  #pragma unroll
  for(int r=0;r<16;++r)rli[r]=__builtin_amdgcn_rcpf(wsf[32+crow(r,hi)]);
  bf16*Ow=O+(rowbase+q0+wid*QBLK)*DM+vcol;
  { bf16*stg=(bf16*)(shm+LDS_OST)+wid*2048;
    #pragma unroll
    for(int r=0;r<16;++r){const int orow=crow(r,hi);
      #pragma unroll
      for(int d0=0;d0<2;++d0)stg[orow*64+d0*32+r32]=__float2bfloat16(o[d0][r]*rli[r]);}
    asm volatile("s_waitcnt lgkmcnt(0)":::"memory");
    #pragma unroll
    for(int i=0;i<4;++i){const int row=i*8+(lane>>3),ch=lane&7; const u32x4 v=*(const u32x4*)(stg+row*64+ch*8); ATTN_STORE16(Ow+(long)row*DM+ch*8,v);} }
  asm volatile("s_waitcnt lgkmcnt(0)\n\ts_barrier":::"memory");
  #undef DMA_K
  #undef DMA_V
  #undef CMASK
  #undef START
  #undef RESC
  #undef ROT
}
typedef float f32x4 __attribute__((ext_vector_type(4)));
constexpr int SA_K0=0, SA_K1=8192, SA_V0=16384, SA_V1=24576, SA_WS=32768, SA_BYTES=SA_WS+8*256;
__device__ __forceinline__ unsigned pk2bf(float lo,float hi){return cvtpk_s(lo,hi);}
__device__ __forceinline__ void sample_unit(int l,int b,int h,int s,const float*cache_k,const float*cache_v,const bf16*Q,const bf16*K,const bf16*V,float*SP,char*shm){
  const int tid=threadIdx.x,lane=tid&63,r32=lane&31,hi=lane>>5; const int wid=__builtin_amdgcn_readfirstlane(tid>>6);
  const unsigned lds0=(unsigned)(uintptr_t)shm;
  float*wsf=(float*)(shm+SA_WS)+wid*64;
  const int c=wid>>1,vh=wid&1;
  const int qrow=16384+b*32;
  bf16x8 qr[4];
  if(wid<4){
    #pragma unroll
    for(int d0=0;d0<4;++d0)qr[d0]=*reinterpret_cast<const bf16x8*>(&Q[(long)(qrow+r32)*DM+h*128+c*64+d0*16+hi*8]);
  }
  float m=-1e30f,lsum=0.f; f32x16 o[2]; o[0]=f32x16{}; o[1]=f32x16{};
  const f32x16 zc=f32x16{};
  const int ntile=(s==7)?5:4;
  const float*ckb=cache_k+((long)(l*8+b)*2048)*1024+h*128; const float*cvb=cache_v+((long)(l*8+b)*2048)*1024+h*128;
  for(int ti=0;ti<ntile;++ti){
    const bool fresh=(ti==4);
    #pragma unroll
    for(int pi=0;pi<2;++pi){
      const int pk=wid*2+pi;
      { const int kc=pk>>3,ch=pk&7; u32x4 wv;
        if(!fresh){ const float*src=ckb+(long)((4*s+ti)*64+lane)*1024+kc*64+ch*8; const f32x4 a=*(const f32x4*)src,bq=*(const f32x4*)(src+4);
          wv.x=pk2bf(a.x,a.y);wv.y=pk2bf(a.z,a.w);wv.z=pk2bf(bq.x,bq.y);wv.w=pk2bf(bq.z,bq.w); }
        else if(lane<32){ wv=*(const u32x4*)(K+(long)(qrow+lane)*DM+h*128+kc*64+ch*8); }
        else { wv=(u32x4){0u,0u,0u,0u}; }
        *(u32x4*)(shm+(kc?SA_K1:SA_K0)+ch*1024+lane*16)=wv; }
      { const int vv=pk>>3,p=pk&7; const int row=16*(p&3)+(lane>>2),col=vv*64+32*(p>>2)+8*(lane&3); u32x4 wv;
        if(!fresh){ const float*src=cvb+(long)((4*s+ti)*64+row)*1024+col; const f32x4 a=*(const f32x4*)src,bq=*(const f32x4*)(src+4);
          wv.x=pk2bf(a.x,a.y);wv.y=pk2bf(a.z,a.w);wv.z=pk2bf(bq.x,bq.y);wv.w=pk2bf(bq.z,bq.w); }
        else if(row<32){ wv=*(const u32x4*)(V+(long)(qrow+row)*DM+h*128+col); }
        else { wv=(u32x4){0u,0u,0u,0u}; }
        *(u32x4*)(shm+(vv?SA_V1:SA_V0)+p*1024+lane*16)=wv; }
    }
    __syncthreads();
    if(wid<4){
      f32x16 p0,p1;
      qkt(p0,p1,shm+(c?SA_K1:SA_K0),qr,zc,r32,hi);
      if(fresh){
        #pragma unroll
        for(int r=0;r<16;++r)p1[r]=-INFINITY;
      }
      float rm=p0[0];
      #pragma unroll
      for(int r=1;r<16;++r)rm=__builtin_fmaxf(rm,p0[r]);
      #pragma unroll
      for(int r=0;r<16;++r)rm=__builtin_fmaxf(rm,p1[r]);
      rm=__builtin_fmaxf(rm,__shfl_xor(rm,32));
      const float mn=__builtin_fmaxf(m,rm),alpha=__builtin_amdgcn_exp2f(m-mn);
      float ps=0.f;
      #pragma unroll
      for(int r=0;r<16;++r){p0[r]=__builtin_amdgcn_exp2f(p0[r]-mn);p1[r]=__builtin_amdgcn_exp2f(p1[r]-mn);ps+=p0[r]+p1[r];}
      lsum=lsum*alpha+ps; m=mn;
      if(hi==0)wsf[r32]=alpha;
      asm volatile("s_waitcnt lgkmcnt(0)":::"memory");
      #pragma unroll
      for(int g=0;g<4;++g){ const f32x4 f4=*(const f32x4*)(wsf+8*g+4*hi);
        #pragma unroll
        for(int i=0;i<4;++i){o[0][4*g+i]*=f4[i];o[1][4*g+i]*=f4[i];} }
      u32x4 pw0,pw1,pw2,pw3;
      pw0=(u32x4){pk2bf(p0[0],p0[1]),pk2bf(p0[2],p0[3]),pk2bf(p0[4],p0[5]),pk2bf(p0[6],p0[7])};
      pw1=(u32x4){pk2bf(p0[8],p0[9]),pk2bf(p0[10],p0[11]),pk2bf(p0[12],p0[13]),pk2bf(p0[14],p0[15])};
      pw2=(u32x4){pk2bf(p1[0],p1[1]),pk2bf(p1[2],p1[3]),pk2bf(p1[4],p1[5]),pk2bf(p1[6],p1[7])};
      pw3=(u32x4){pk2bf(p1[8],p1[9]),pk2bf(p1[10],p1[11]),pk2bf(p1[12],p1[13]),pk2bf(p1[14],p1[15])};
      const int vb=(int)(lds0+(vh?SA_V1:SA_V0))+((lane>>4)&1)*32+(lane&3)*8+(4*hi+((lane&15)>>2))*64;
      pv(o,vb,__builtin_bit_cast(bf16x8,pw0),__builtin_bit_cast(bf16x8,pw1),__builtin_bit_cast(bf16x8,pw2),__builtin_bit_cast(bf16x8,pw3));
    }
    __syncthreads();
  }
  if(wid<4){
    lsum+=__shfl_xor(lsum,32);
    float*sp=SP+((long)(((b*8+h)*2+c)*8+s)*32)*132;
    if(vh==0&&hi==0){sp[r32*132]=m;sp[r32*132+1]=lsum;}
    #pragma unroll
    for(int d0=0;d0<2;++d0)
      #pragma unroll
      for(int r=0;r<16;++r)sp[crow(r,hi)*132+4+vh*64+32*d0+r32]=o[d0][r];
  }
}
constexpr int ATTN_LDS_BYTES=LDS_BYTES;
#undef SBAR
#undef WAIT_BAR
}

#define GAS __attribute__((address_space(1)))
#define LAS __attribute__((address_space(3)))
typedef unsigned short bf16;
typedef unsigned v4u __attribute__((ext_vector_type(4)));
typedef float f32x4 __attribute__((ext_vector_type(4)));
typedef short bf16x8 __attribute__((ext_vector_type(8)));
typedef GAS unsigned gu32;
typedef GAS unsigned long long gu64;
#define RLX_AGENT __ATOMIC_RELAXED, __HIP_MEMORY_SCOPE_AGENT
#define LDS_WAIT() asm volatile("s_waitcnt lgkmcnt(0)" ::: "memory")
#define VM_WAIT() asm volatile("s_waitcnt vmcnt(0)" ::: "memory")
__device__ __forceinline__ unsigned long long rt() { return __builtin_amdgcn_s_memrealtime(); }
__device__ __forceinline__ unsigned f2bf(float f) { unsigned u = __builtin_bit_cast(unsigned, f); return (u + 0x7fffu + ((u >> 16) & 1u)) >> 16; }
__device__ __forceinline__ unsigned pk2(float lo, float hi) { return f2bf(lo) | (f2bf(hi) << 16); }

#define XB_TMO      128
#define XB_XCNT(j)  (256  + 64 * (j))
#define XB_XSUB(j)  (1280 + 64 * (j))
#define XB_XGEN(j)  (2304 + 64 * (j))
#define XB_TOP      3328
#define XB_TOPGEN   3392
#define XCD_BAR_WORDS 3456
#define XB_SPIN_CAP (1u << 22)

__device__ __forceinline__ unsigned xb_ld(unsigned* p)              { return __hip_atomic_load(p, __ATOMIC_RELAXED, __HIP_MEMORY_SCOPE_AGENT); }
__device__ __forceinline__ unsigned xb_add(unsigned* p, unsigned v) { return __hip_atomic_fetch_add(p, v, __ATOMIC_RELAXED, __HIP_MEMORY_SCOPE_AGENT); }
__device__ __forceinline__ unsigned xb_xcc_id() { return (unsigned)__builtin_amdgcn_s_getreg((3 << 11) | 20) & 0xFu; }
#define XB_SPIN(cond, bar) do { unsigned _sp = 0; while (cond) { __builtin_amdgcn_s_sleep(1); \
    if ((++_sp & 255u) == 0u) { if (xb_ld(&(bar)[XB_TMO])) break; if (_sp > XB_SPIN_CAP) { atomicAdd(&(bar)[XB_TMO], 1u); break; } } } } while (0)

struct XcdBarrier {
    unsigned* bar; unsigned x;
    volatile LAS unsigned* st;
};

__device__ __forceinline__ XcdBarrier xcd_barrier_post(unsigned* bar, volatile LAS unsigned* st) {
    XcdBarrier b; b.bar = bar; b.x = xb_xcc_id(); b.st = st;
    if (threadIdx.x == 0) (void)xb_add(&bar[XB_XCNT(b.x)], 1u);
    return b;
}
__device__ __forceinline__ void xcd_barrier_complete(unsigned* bar, unsigned x, unsigned& nloc, unsigned& nx) {
    const unsigned G = gridDim.x * gridDim.y * gridDim.z;
    unsigned sum, cnt, mine, sp = 0u;
    for (;;) {
        sum = 0u; cnt = 0u; mine = 0u;
#pragma unroll
        for (unsigned j = 0; j < 16; ++j) { const unsigned c = xb_ld(&bar[XB_XCNT(j)]); sum += c; cnt += (c > 0u) ? 1u : 0u; mine = (j == x) ? c : mine; }
        if (sum == G) break;
        __builtin_amdgcn_s_sleep(1);
        if ((++sp & 255u) == 0u) { if (xb_ld(&bar[XB_TMO])) break; if (sp > XB_SPIN_CAP) { atomicAdd(&bar[XB_TMO], 1u); break; } }
    }
    nloc = mine > 0u ? mine : 1u; nx = cnt > 0u ? cnt : 1u;
}

__device__ __forceinline__ void xcd_barrier(const XcdBarrier& b) {
    asm volatile("s_waitcnt vmcnt(0)" ::: "memory");
    __syncthreads();
    if (threadIdx.x == 0) {
        unsigned* bar = b.bar;
        __builtin_amdgcn_s_waitcnt(0);
        unsigned nloc = b.st[0], nx = b.st[1];
        if (nloc == 0u) { xcd_barrier_complete(bar, b.x, nloc, nx); b.st[0] = nloc; b.st[1] = nx; }
        const unsigned old = xb_add(&bar[XB_XSUB(b.x)], 1u);
        const unsigned gen = old / nloc;
        if (old + 1u == (gen + 1u) * nloc) {
            __builtin_amdgcn_fence(__ATOMIC_RELEASE, "agent");
            asm volatile("s_waitcnt vmcnt(0)" ::: "memory");
            const unsigned og = xb_add(&bar[XB_TOP], 1u);
            const unsigned tg = og / nx;
            if (og + 1u == (tg + 1u) * nx) xb_add(&bar[XB_TOPGEN], 1u);
            else XB_SPIN(xb_ld(&bar[XB_TOPGEN]) == tg, bar);
            __builtin_amdgcn_fence(__ATOMIC_ACQUIRE, "agent");
            xb_add(&bar[XB_XGEN(b.x)], 1u);
            asm volatile("s_waitcnt vmcnt(0)" ::: "memory");
        } else {
            XB_SPIN(xb_ld(&bar[XB_XGEN(b.x)]) == gen, bar);
            __builtin_amdgcn_fence(__ATOMIC_ACQUIRE, "agent");
            asm volatile("s_waitcnt vmcnt(0)" ::: "memory");
        }
    }
    __syncthreads();
}

struct Args { const GAS float* in[31]; GAS float* out; GAS unsigned char* ws; float rinv[8]; int ph_lo, ph_hi; };
#define GIN(A, i) ((const float*)((A)->in[i]))
typedef const Args __attribute__((address_space(4)))* CArgsP;
struct Frame {
    LAS unsigned char* lds;
    volatile LAS unsigned* MISC;
    gu32* ctl;
    int tid, lane, wave, vcu, G;
    float* out; unsigned char* ws;
};
__device__ __forceinline__ float wave_sum(float v) {
#pragma unroll
    for (int o = 1; o < 64; o <<= 1) v += __shfl_xor(v, o);
    return v;
}
template <int CTRL> __device__ __forceinline__ float dppf(float x) { return __builtin_bit_cast(float, __builtin_amdgcn_update_dpp(0, __builtin_bit_cast(int, x), CTRL, 0xF, 0xF, false)); }
__device__ __forceinline__ float reduce8(float x) { x += dppf<0xB1>(x); x += dppf<0x4E>(x); x += dppf<0x141>(x); return x; }
__device__ __forceinline__ float reduce16(float x) { x = reduce8(x); x += dppf<0x140>(x); return x; }
__device__ __forceinline__ float bf2f(bf16 h) { return __uint_as_float((unsigned)h << 16); }
__device__ __forceinline__ float bflo(unsigned w) { return __uint_as_float(w << 16); }
__device__ __forceinline__ float bfhi(unsigned w) { return __uint_as_float(w & 0xffff0000u); }

__device__ __forceinline__ void p0_transpose_item(const float* W, int N, bf16* WT, int ldk, int koff, int row_off, const float* kscale, LAS float* scr, int item, int lane) {
    const int nblk = N / 32, kb = item / nblk, nb = item % nblk, k0 = 64 * kb, n0 = 32 * nb;
    float wv[32];
#pragma unroll
    for (int i = 0; i < 32; ++i) wv[i] = W[(size_t)(k0 + 2 * i + (lane >> 5)) * N + n0 + (lane & 31)];
#pragma unroll
    for (int i = 0; i < 32; ++i) { const int kk = 2 * i + (lane >> 5); float w = wv[i]; if (kscale) w *= kscale[k0 + kk]; scr[kk * 33 + (lane & 31)] = w; }
    LDS_WAIT(); asm volatile("" ::: "memory");
    const int c = lane & 7;
#pragma unroll
    for (int j = 0; j < 4; ++j) { const int n = (lane >> 3) + 8 * j; const LAS float* s = scr + (8 * c) * 33 + n;
        v4u o; o.x = pk2(s[0 * 33], s[1 * 33]); o.y = pk2(s[2 * 33], s[3 * 33]); o.z = pk2(s[4 * 33], s[5 * 33]); o.w = pk2(s[6 * 33], s[7 * 33]);
        *(GAS v4u*)(WT + (size_t)(row_off + n0 + n) * ldk + koff + k0 + 8 * c) = o; }
    LDS_WAIT(); asm volatile("" ::: "memory");
}
__device__ __forceinline__ void p0_weights(Frame& F, CArgsP A, int l, int gw, int NGW) {
    LAS float* scr = (LAS float*)(F.lds + RING_OFF + F.wave * 16384);
    constexpr int I_IN = (1024 / 64) * (P_TOTAL / 32), I_SQ = (1024 / 64) * (1024 / 32), I_UP = (1024 / 64) * (UPW / 32), I_DN = (D_FF / 64) * (1024 / 32),
                  I_W2 = 1 * (1024 / 32), I_G2 = 2 * (1024 / 32);
    constexpr int I_LAYER = I_IN + 3 * I_SQ + I_UP + I_DN + 2 * I_W2 + I_G2;
    unsigned char* wl = F.ws + WS_W;
    for (int it = gw; it < I_LAYER; it += NGW) {
        int r = it;
        if (r < I_IN) { p0_transpose_item(GIN(A, 8) + (size_t)l * 1024 * P_TOTAL, P_TOTAL, (bf16*)(wl + W_IN), 1024, 0, 0, GIN(A, 7) + l * 1024, scr, r, F.lane); continue; } r -= I_IN;
        if (r < I_SQ) { p0_transpose_item(GIN(A, 11) + (size_t)l * 1024 * 1024, 1024, (bf16*)(wl + W_ODA), 1024, 0, 0, nullptr, scr, r, F.lane); continue; } r -= I_SQ;
        if (r < I_SQ) { p0_transpose_item(GIN(A, 23) + (size_t)l * 1024 * 1024, 1024, (bf16*)(wl + W_ORW), 1024, 0, 0, nullptr, scr, r, F.lane); continue; } r -= I_SQ;
        if (r < I_SQ) { p0_transpose_item(GIN(A, 24) + (size_t)l * 1024 * 1024, 1024, (bf16*)(wl + W_OUT), 1024, 0, 0, nullptr, scr, r, F.lane); continue; } r -= I_SQ;
        if (r < I_UP) { p0_transpose_item(GIN(A, 26) + (size_t)l * 1024 * UPW, UPW, (bf16*)(wl + W_UP), 1024, 0, 0, GIN(A, 25) + l * 1024, scr, r, F.lane); continue; } r -= I_UP;
        if (r < I_DN) { p0_transpose_item(GIN(A, 29) + (size_t)l * D_FF * 1024, 1024, (bf16*)(wl + (l ? W_DN1 : W_DN)), D_FF, 0, 0, nullptr, scr, r, F.lane); continue; } r -= I_DN;
        if (r < I_W2) { p0_transpose_item(GIN(A, 14) + (size_t)l * 64 * 1024, 1024, (bf16*)(wl + W_LORA), 256, 0, 0, nullptr, scr, r, F.lane); continue; } r -= I_W2;
        if (r < I_W2) { p0_transpose_item(GIN(A, 16) + (size_t)l * 64 * 1024, 1024, (bf16*)(wl + W_LORA), 256, 64, 1024, nullptr, scr, r, F.lane); continue; } r -= I_W2;
        p0_transpose_item(GIN(A, 17) + (size_t)l * 128 * 1024, 1024, (bf16*)(wl + W_LORA), 256, 128, 2048, nullptr, scr, r, F.lane);
    }
    for (int i = gw * 64 + F.lane; i < 3072 * 32; i += NGW * 64) {
        const int n = i >> 5, kc = i & 31, blk = n >> 10;
        const bool nz = (blk == 0) ? (kc < 8) : (blk == 1) ? (kc >= 8 && kc < 16) : (kc >= 16);
        if (!nz) *(GAS v4u*)(wl + W_LORA + ((size_t)n * 256 + kc * 8) * 2) = (v4u){0u, 0u, 0u, 0u};
    }
}
__device__ __forceinline__ void p0_prologue(Frame& F, CArgsP A) {
    const int gw = F.vcu * NWAVES + F.wave, NGW = F.G * NWAVES;
    p0_weights(F, A, 0, gw, NGW);
    {
        const int gt = gw * 64 + F.lane, NGT = NGW * 64;
        float* rope = (float*)(F.ws + WS_ROPE);
        for (int i = gt; i < NKEYS_S * 8; i += NGT) {
            const int pos = i >> 3, k = i & 7;
            const float ang = (float)pos * A->rinv[k];
            const float kq = rintf(ang * 0.15915494309189535f);
            float r = fmaf(-kq, 6.2831854820251465f, ang); r = fmaf(-kq, -1.7484555314695172e-7f, r);
            const float rev = r * 0.15915494309189535f;
            rope[pos * 16 + k] = __builtin_amdgcn_cosf(rev); rope[pos * 16 + 8 + k] = __builtin_amdgcn_sinf(rev);
        }
    }
    {
        float* X = F.out + O_YP; bf16* XB = (bf16*)(F.ws + WS_XB); float* SS = (float*)(F.ctl + CW_SS);
        for (int m = gw; m < MT; m += NGW) {
            const float* src = (m < MP) ? GIN(A, 0) + (size_t)m * 1024 : GIN(A, 1) + (size_t)(m - MP) * 1024;
            const GAS f32x4* xr = (const GAS f32x4*)src + F.lane;
            GAS f32x4* xo = (GAS f32x4*)(X + (size_t)m * 1024) + F.lane;
            GAS unsigned long long* o8 = (GAS unsigned long long*)(XB + (size_t)m * 1024) + F.lane;
            float s = 0.f;
#pragma unroll
            for (int j = 0; j < 4; ++j) { const f32x4 v = xr[64 * j]; s += (v.x * v.x + v.y * v.y) + (v.z * v.z + v.w * v.w); xo[64 * j] = v;
                o8[64 * j] = (unsigned long long)pk2(v.x, v.y) | ((unsigned long long)pk2(v.z, v.w) << 32); }
            s = wave_sum(s);
            if (F.lane == 0) SS[m] = s;
        }
    }
    if (gw < DEPTH) {
        const int l = gw; const float* lp = GIN(A, 9) + (size_t)l * 256;
        const float s1 = wave_sum(lp[F.lane] * lp[64 + F.lane]), s2 = wave_sum(lp[128 + F.lane] * lp[192 + F.lane]);
        if (F.lane == 0) ((float*)(F.ctl + CW_LAM))[l] = expf(s1) - expf(s2) + (0.8f - 0.6f * expf(-0.3f * (float)l));
    }
}

__device__ __forceinline__ void ph_attn(Frame& F, CArgsP A, int l, const int a0, const int na) {
    const attn_body::bf16* Q = (const attn_body::bf16*)(F.ws + B_Q); const attn_body::bf16* K = (const attn_body::bf16*)(F.ws + B_K); const attn_body::bf16* V = (const attn_body::bf16*)(F.ws + B_V);
    for (int u = a0; u < 256; u += na) {
        const int b = u >> 5, hv = u & 31, h = hv >> 2, c = (hv >> 1) & 1, vh = hv & 1;
        attn_body::bf16* O = (attn_body::bf16*)(F.ws + B_OC) + (size_t)c * MT * 1024;
        for (int qb = 7; qb >= 0; --qb) attn_body::attn_unit<8>(b, h * 128 + c * 64, h * 128 + vh * 64, qb, Q, K, V, O, (char*)F.lds + RING_OFF);
    }
    { int tv = threadIdx.x; asm volatile("" : "+v"(tv)); F.tid = tv; F.lane = tv & 63; F.wave = __builtin_amdgcn_readfirstlane(tv >> 6); }
    for (int u = a0; u < 512; u += na) attn_body::sample_unit(l, u >> 6, (u >> 3) & 7, u & 7, GIN(A, 2), GIN(A, 3), Q, K, V, (float*)(F.ws + WS_SP), (char*)F.lds + RING_OFF);
}

__device__ __forceinline__ void ph_linprep(Frame& F, CArgsP A, int l) {
    const int gw = F.vcu * NWAVES + F.wave, NGW = F.G * NWAVES;
    const bf16* URW = (const bf16*)(F.ws + B_URW); bf16* LIN = (bf16*)(F.ws + B_LIN);
    const float* mu = GIN(A, 12) + (size_t)l * P_RW + 3072 + 4 * F.lane;
    const float mu0 = mu[0], mu1 = mu[1], mu2 = mu[2], mu3 = mu[3];
    for (int row = gw; row < MT; row += NGW) {
        const bool smp = row >= MP; const int t = smp ? ((row - MP) & 31) : (row & 2047);
        const unsigned long long cw = *(const unsigned long long*)(URW + (size_t)row * P_RW + 3072 + 4 * F.lane);
        float u[4] = {bflo((unsigned)cw), bfhi((unsigned)cw), bflo((unsigned)(cw >> 32)), bfhi((unsigned)(cw >> 32))};
        float p[4];
        if (t > 0) { const unsigned long long pw = *(const unsigned long long*)(URW + (size_t)(row - 1) * P_RW + 3072 + 4 * F.lane);
            p[0] = bflo((unsigned)pw); p[1] = bfhi((unsigned)pw); p[2] = bflo((unsigned)(pw >> 32)); p[3] = bfhi((unsigned)(pw >> 32)); }
        else if (smp) { const float* s0 = GIN(A, 5) + ((size_t)(l * DEC_BATCH) + ((row - MP) >> 5)) * P_RW + 3072 + 4 * F.lane; p[0] = s0[0]; p[1] = s0[1]; p[2] = s0[2]; p[3] = s0[3]; }
        else { p[0] = p[1] = p[2] = p[3] = 0.f; }
        u[0] += (p[0] - u[0]) * mu0; u[1] += (p[1] - u[1]) * mu1; u[2] += (p[2] - u[2]) * mu2; u[3] += (p[3] - u[3]) * mu3;
        if (F.lane < 16) { u[0] = tanhf(u[0]); u[1] = tanhf(u[1]); u[2] = tanhf(u[2]); u[3] = tanhf(u[3]); }
        else if (F.lane >= 32) { u[0] = 1.f / (1.f + expf(-u[0])); u[1] = 1.f / (1.f + expf(-u[1])); u[2] = 1.f / (1.f + expf(-u[2])); u[3] = 1.f / (1.f + expf(-u[3])); }
        *(unsigned long long*)(LIN + (size_t)row * 256 + 4 * F.lane) = (unsigned long long)pk2(u[0], u[1]) | ((unsigned long long)pk2(u[2], u[3]) << 32);
    }
}

__device__ __forceinline__ void ph_combine(Frame& F, CArgsP A, int l) {
    const int gw = F.vcu * NWAVES + F.wave, NGW = F.G * NWAVES;
    const float lam = ((const float*)(F.ctl + CW_LAM))[l], lam_init = 0.8f - 0.6f * expf(-0.3f * (float)l);
    const bf16* OC0 = (const bf16*)(F.ws + B_OC); const bf16* OC1 = OC0 + (size_t)MT * 1024;
    bf16* OA = (bf16*)(F.ws + B_OA);
    const float* subln = GIN(A, 10) + l * 128;
    const float g0 = subln[2 * F.lane], g1 = subln[2 * F.lane + 1];
    {
        const int gt = gw * 64 + F.lane, NGT = NGW * 64;
        const float sc = 1.f - lam_init;
        for (int i = gt; i < MP * 128; i += NGT) {
            const size_t off = (size_t)(i >> 4) * 128 + (i & 15) * 8;
            const v4u w0 = *(const v4u*)(OC0 + off), w1 = *(const v4u*)(OC1 + off);
            float a[8];
            a[0] = bflo(w0.x) - lam * bflo(w1.x); a[1] = bfhi(w0.x) - lam * bfhi(w1.x); a[2] = bflo(w0.y) - lam * bflo(w1.y); a[3] = bfhi(w0.y) - lam * bfhi(w1.y);
            a[4] = bflo(w0.z) - lam * bflo(w1.z); a[5] = bfhi(w0.z) - lam * bfhi(w1.z); a[6] = bflo(w0.w) - lam * bflo(w1.w); a[7] = bfhi(w0.w) - lam * bfhi(w1.w);
            float ss = (a[0] * a[0] + a[1] * a[1]) + (a[2] * a[2] + a[3] * a[3]) + (a[4] * a[4] + a[5] * a[5]) + (a[6] * a[6] + a[7] * a[7]);
            ss = reduce16(ss);
            const float r = (1.0f / sqrtf(ss * (1.0f / 128.f) + EPS)) * sc;
            const f32x4 s0 = *(const f32x4*)(subln + (i & 15) * 8), s1 = *(const f32x4*)(subln + (i & 15) * 8 + 4);
            v4u o; o.x = pk2(a[0] * r * s0.x, a[1] * r * s0.y); o.y = pk2(a[2] * r * s0.z, a[3] * r * s0.w); o.z = pk2(a[4] * r * s1.x, a[5] * r * s1.y); o.w = pk2(a[6] * r * s1.z, a[7] * r * s1.w);
            *(v4u*)(OA + off) = o;
        }
    }
    for (int it = MP * 8 + gw; it < MT * 8; it += NGW) {
        const int row = it >> 3, h = it & 7;
        float a0, a1;
        {
            const int b = (row - MP) >> 5, qi = (row - MP) & 31;
            float oc[2][2];
#pragma unroll
            for (int c = 0; c < 2; ++c) {
                const float* sp = (const float*)(F.ws + WS_SP) + ((size_t)(((b * 8 + h) * 2 + c) * 8) * 32 + qi) * 132;
                float mx = -1e30f;
#pragma unroll
                for (int s = 0; s < 8; ++s) mx = fmaxf(mx, sp[(size_t)s * 32 * 132]);
                float L = 0.f, x0 = 0.f, x1 = 0.f;
#pragma unroll
                for (int s = 0; s < 8; ++s) { const float* p = sp + (size_t)s * 32 * 132; const float w = exp2f(p[0] - mx); L += w * p[1]; x0 += w * p[4 + 2 * F.lane]; x1 += w * p[4 + 2 * F.lane + 1]; }
                oc[c][0] = x0 / L; oc[c][1] = x1 / L;
            }
            a0 = oc[0][0] - lam * oc[1][0]; a1 = oc[0][1] - lam * oc[1][1];
        }
        const float ss = wave_sum(a0 * a0 + a1 * a1);
        const float r = (1.0f / sqrtf(ss * (1.0f / 128.f) + EPS)) * (1.f - lam_init);
        *(unsigned*)(OA + (size_t)row * 1024 + h * 128 + 2 * F.lane) = pk2(a0 * r * g0, a1 * r * g1);
    }
}

typedef float f32x2 __attribute__((ext_vector_type(2)));
constexpr int SC_C = 32;
constexpr int SC_OPB = 0, SC_OPB_SZ = SC_C * 1280;
constexpr int SC_VB = 2 * SC_OPB_SZ, SC_VB_SZ = SC_C * 256;
constexpr int SC_YB = SC_VB + 3 * SC_VB_SZ, SC_YB_SZ = SC_C * 256;
constexpr int SC_BON = SC_YB + 2 * SC_YB_SZ;
static_assert(SC_BON + 3 * SC_C * 4 <= RING_BYTES, "scan LDS");

__device__ __forceinline__ void unpack4(unsigned long long w, float (&o)[4]) { o[0] = bflo((unsigned)w); o[1] = bfhi((unsigned)w); o[2] = bflo((unsigned)(w >> 32)); o[3] = bfhi((unsigned)(w >> 32)); }

__device__ __forceinline__ void scan_fast(Frame& F, CArgsP A, int l, int item) {
    const bool smp = item >= 128; const int bh = item & 127, b = bh >> 4, h = bh & 15;
    const int T = smp ? DEC_SEQ : SEQ, row0 = smp ? MP + b * DEC_SEQ : b * SEQ, nch = T / SC_C;
    const int tid = F.tid, lane = F.lane, w = F.wave;
    const int rho = lane >> 3, kq = lane & 7, r0 = (w & 3) * 16 + rho, r1 = r0 + 8;
    const int pt = tid - 256;
    const int cq = pt & 15, c = h * 64 + 4 * cq;
    const bf16* URW = (const bf16*)(F.ws + B_URW); const bf16* LD = (const bf16*)(F.ws + B_LD); const bf16* LA = (const bf16*)(F.ws + B_LA); const bf16* LG = (const bf16*)(F.ws + B_LG);
    bf16* ORW = (bf16*)(F.ws + B_ORW);
    LAS unsigned char* L = F.lds + RING_OFF;
    f32x2 S2[2][4];
    float mu_r[4], mu_k[4], mu_v[4], k_k[4], k_a[4], r_k[4], ln_w[4], ln_b[4];
    if (w < 4) {
        if (smp) {
#pragma unroll
            for (int q = 0; q < 2; ++q) { const float* s0 = GIN(A, 4) + (((size_t)(l * 8 + b) * 16 + h) * 64 + (q ? r1 : r0)) * 64 + 8 * kq; const f32x4 a0 = *(const f32x4*)s0, a1 = *(const f32x4*)(s0 + 4);
                S2[q][0] = (f32x2){a0.x, a0.y}; S2[q][1] = (f32x2){a0.z, a0.w}; S2[q][2] = (f32x2){a1.x, a1.y}; S2[q][3] = (f32x2){a1.z, a1.w}; } }
        else {
#pragma unroll
            for (int j = 0; j < 4; ++j) { S2[0][j] = (f32x2){0.f, 0.f}; S2[1][j] = (f32x2){0.f, 0.f}; } }
    } else {
        const float* mu = GIN(A, 12) + (size_t)l * P_RW;
#pragma unroll
        for (int j = 0; j < 4; ++j) { mu_r[j] = mu[c + j]; mu_k[j] = mu[1024 + c + j]; mu_v[j] = mu[2048 + c + j]; k_k[j] = GIN(A, 18)[l * 1024 + c + j]; k_a[j] = GIN(A, 19)[l * 1024 + c + j]; r_k[j] = GIN(A, 20)[l * 1024 + c + j];
            ln_w[j] = GIN(A, 21)[l * 1024 + c + j]; ln_b[j] = GIN(A, 22)[l * 1024 + c + j]; }
    }
#define SC_PREP(ch) do { LAS unsigned char* opb_ = L + SC_OPB + ((ch) & 1) * SC_OPB_SZ; LAS float* vb_ = (LAS float*)(L + SC_VB + ((ch) % 3) * SC_VB_SZ); LAS float* bonb_ = (LAS float*)(L + SC_BON) + ((ch) % 3) * SC_C; \
        _Pragma("unroll") for (int rep_ = 0; rep_ < 2; ++rep_) { const int tp = (pt >> 4) + 16 * rep_; const int tseq = (ch) * SC_C + tp; \
            const size_t r_ = (size_t)(row0 + tseq); const bf16* u_ = URW + r_ * P_RW + c; \
            float ur[4], uk[4], uv[4], pr[4], pk[4], pv[4], ld[4], la[4]; \
            unpack4(*(const unsigned long long*)(u_), ur); unpack4(*(const unsigned long long*)(u_ + 1024), uk); unpack4(*(const unsigned long long*)(u_ + 2048), uv); \
            unpack4(*(const unsigned long long*)(LD + r_ * 1024 + c), ld); unpack4(*(const unsigned long long*)(LA + r_ * 1024 + c), la); \
            if (tseq > 0) { unpack4(*(const unsigned long long*)(u_ - P_RW), pr); unpack4(*(const unsigned long long*)(u_ - P_RW + 1024), pk); unpack4(*(const unsigned long long*)(u_ - P_RW + 2048), pv); } \
            else if (smp) { const float* s0 = GIN(A, 5) + (size_t)(l * 8 + b) * P_RW + c; _Pragma("unroll") for (int j = 0; j < 4; ++j) { pr[j] = s0[j]; pk[j] = s0[1024 + j]; pv[j] = s0[2048 + j]; } } \
            else { _Pragma("unroll") for (int j = 0; j < 4; ++j) { pr[j] = 0.f; pk[j] = 0.f; pv[j] = 0.f; } } \
            float r[4], kr[4], vr[4], kk[4], km[4], wd[4], ssq = 0.f, bon = 0.f; \
            _Pragma("unroll") for (int j = 0; j < 4; ++j) { \
                r[j] = ur[j] + (pr[j] - ur[j]) * mu_r[j]; kr[j] = uk[j] + (pk[j] - uk[j]) * mu_k[j]; vr[j] = uv[j] + (pv[j] - uv[j]) * mu_v[j]; \
                wd[j] = __builtin_amdgcn_exp2f(1.4426950408889634f * ld[j]); \
                kk[j] = kr[j] * k_k[j]; ssq += kk[j] * kk[j]; km[j] = kr[j] * (1.f + (la[j] - 1.f) * k_a[j]); bon += r[j] * km[j] * r_k[j]; } \
            ssq = reduce16(ssq); bon = reduce16(bon); \
            const float inv = __builtin_amdgcn_rsqf(fmaxf(ssq, 1e-24f)); \
            LAS float* op = (LAS float*)(opb_ + tp * 1280) + 4 * cq; \
            *(LAS f32x4*)(op) = (f32x4){wd[0], wd[1], wd[2], wd[3]}; \
            *(LAS f32x4*)(op + 64) = (f32x4){kk[0] * inv, kk[1] * inv, kk[2] * inv, kk[3] * inv}; \
            *(LAS f32x4*)(op + 128) = (f32x4){kk[0] * inv * la[0], kk[1] * inv * la[1], kk[2] * inv * la[2], kk[3] * inv * la[3]}; \
            *(LAS f32x4*)(op + 192) = (f32x4){km[0], km[1], km[2], km[3]}; \
            *(LAS f32x4*)(op + 256) = (f32x4){r[0], r[1], r[2], r[3]}; \
            *(LAS f32x4*)(vb_ + tp * 64 + 4 * cq) = (f32x4){vr[0], vr[1], vr[2], vr[3]}; \
            if (cq == 0) bonb_[tp] = bon; } } while (0)
#define SC_POST(ch) do { const LAS float* yb_ = (const LAS float*)(L + SC_YB + ((ch) & 1) * SC_YB_SZ); const LAS float* vb_ = (const LAS float*)(L + SC_VB + ((ch) % 3) * SC_VB_SZ); const LAS float* bonb_ = (const LAS float*)(L + SC_BON) + ((ch) % 3) * SC_C; \
        _Pragma("unroll") for (int rep_ = 0; rep_ < 2; ++rep_) { const int tp = (pt >> 4) + 16 * rep_; const size_t r_ = (size_t)(row0 + (ch) * SC_C + tp); \
            const f32x4 y4 = *(const LAS f32x4*)(yb_ + tp * 64 + 4 * cq); const f32x4 v4 = *(const LAS f32x4*)(vb_ + tp * 64 + 4 * cq); const float bon = bonb_[tp]; \
            float gg[4]; unpack4(*(const unsigned long long*)(LG + r_ * 1024 + c), gg); \
            const float mean = reduce16((y4.x + y4.y) + (y4.z + y4.w)) * (1.f / 64.f); \
            const float d0 = y4.x - mean, d1 = y4.y - mean, d2 = y4.z - mean, d3 = y4.w - mean; \
            const float var = reduce16((d0 * d0 + d1 * d1) + (d2 * d2 + d3 * d3)) * (1.f / 64.f); \
            const float rs = __builtin_amdgcn_rsqf(var + GN_EPS); \
            const float o0 = (d0 * rs * ln_w[0] + ln_b[0] + bon * v4.x) * gg[0], o1 = (d1 * rs * ln_w[1] + ln_b[1] + bon * v4.y) * gg[1]; \
            const float o2 = (d2 * rs * ln_w[2] + ln_b[2] + bon * v4.z) * gg[2], o3 = (d3 * rs * ln_w[3] + ln_b[3] + bon * v4.w) * gg[3]; \
            *(unsigned long long*)(ORW + r_ * 1024 + c) = (unsigned long long)pk2(o0, o1) | ((unsigned long long)pk2(o2, o3) << 32); } } while (0)
    if (w >= 4) SC_PREP(0);
    __syncthreads();
    for (int ch = 0; ch < nch; ++ch) {
        if (w >= 4) {
            if (ch > 0) SC_POST(ch - 1);
            if (ch + 1 < nch) SC_PREP(ch + 1);
        } else {
            const LAS float* ob = (const LAS float*)(L + SC_OPB + (ch & 1) * SC_OPB_SZ) + 8 * kq; const LAS float* vb = (const LAS float*)(L + SC_VB + (ch % 3) * SC_VB_SZ); LAS float* yb = (LAS float*)(L + SC_YB + (ch & 1) * SC_YB_SZ);
            f32x4 wA0, wA1, kA0, kA1, bA0, bA1, mA0, mA1, rA0, rA1, wB0, wB1, kB0, kB1, bB0, bB1, mB0, mB1, rB0, rB1; float vA0, vA1, vB0, vB1;
#define SC_LD(SET, tt) do { const LAS float* p_ = ob + (tt) * 320; w##SET##0 = *(const LAS f32x4*)(p_); w##SET##1 = *(const LAS f32x4*)(p_ + 4); k##SET##0 = *(const LAS f32x4*)(p_ + 64); k##SET##1 = *(const LAS f32x4*)(p_ + 68); \
            b##SET##0 = *(const LAS f32x4*)(p_ + 128); b##SET##1 = *(const LAS f32x4*)(p_ + 132); m##SET##0 = *(const LAS f32x4*)(p_ + 192); m##SET##1 = *(const LAS f32x4*)(p_ + 196); \
            r##SET##0 = *(const LAS f32x4*)(p_ + 256); r##SET##1 = *(const LAS f32x4*)(p_ + 260); v##SET##0 = vb[(tt) * 64 + r0]; v##SET##1 = vb[(tt) * 64 + r1]; } while (0)
#define LO2(x) ((f32x2){(x)[0], (x)[1]})
#define HI2(x) ((f32x2){(x)[2], (x)[3]})
#define SC_DOT(q, X0, X1) (__builtin_elementwise_fma(S2[q][2], LO2(X1), S2[q][0] * LO2(X0)) + __builtin_elementwise_fma(S2[q][3], HI2(X1), S2[q][1] * HI2(X0)))
#define SC_UPD(q, SET, NS, VV) do { \
            S2[q][0] = __builtin_elementwise_fma(S2[q][0], LO2(w##SET##0), __builtin_elementwise_fma(NS, LO2(b##SET##0), VV * LO2(m##SET##0))); \
            S2[q][1] = __builtin_elementwise_fma(S2[q][1], HI2(w##SET##0), __builtin_elementwise_fma(NS, HI2(b##SET##0), VV * HI2(m##SET##0))); \
            S2[q][2] = __builtin_elementwise_fma(S2[q][2], LO2(w##SET##1), __builtin_elementwise_fma(NS, LO2(b##SET##1), VV * LO2(m##SET##1))); \
            S2[q][3] = __builtin_elementwise_fma(S2[q][3], HI2(w##SET##1), __builtin_elementwise_fma(NS, HI2(b##SET##1), VV * HI2(m##SET##1))); } while (0)
#define SC_STEP(SET, tt) do { \
            const f32x2 pa_ = SC_DOT(0, k##SET##0, k##SET##1), pb_ = SC_DOT(1, k##SET##0, k##SET##1); \
            float sa_ = pa_[0] + pa_[1], sb_ = pb_[0] + pb_[1]; \
            sa_ += dppf<0xB1>(sa_); sb_ += dppf<0xB1>(sb_); sa_ += dppf<0x4E>(sa_); sb_ += dppf<0x4E>(sb_); sa_ += dppf<0x141>(sa_); sb_ += dppf<0x141>(sb_); \
            { const float na_ = -sa_, nb_ = -sb_; const f32x2 nsa_ = (f32x2){na_, na_}, nsb_ = (f32x2){nb_, nb_}, va_ = (f32x2){v##SET##0, v##SET##0}, vb2_ = (f32x2){v##SET##1, v##SET##1}; \
              SC_UPD(0, SET, nsa_, va_); SC_UPD(1, SET, nsb_, vb2_); } \
            const f32x2 qa_ = SC_DOT(0, r##SET##0, r##SET##1), qb_ = SC_DOT(1, r##SET##0, r##SET##1); \
            float ya_ = qa_[0] + qa_[1], yb1_ = qb_[0] + qb_[1]; \
            ya_ += dppf<0xB1>(ya_); yb1_ += dppf<0xB1>(yb1_); ya_ += dppf<0x4E>(ya_); yb1_ += dppf<0x4E>(yb1_); ya_ += dppf<0x141>(ya_); yb1_ += dppf<0x141>(yb1_); \
            if (kq == 0) { yb[(tt) * 64 + r0] = ya_; yb[(tt) * 64 + r1] = yb1_; } } while (0)
            SC_LD(A, 0);
            for (int t = 0; t < SC_C; t += 2) {
                SC_LD(B, t + 1);
                SC_STEP(A, t);
                if (t + 2 < SC_C) SC_LD(A, t + 2);
                SC_STEP(B, t + 1);
            }
#undef SC_LD
#undef SC_STEP
#undef SC_DOT
#undef SC_UPD
#undef LO2
#undef HI2
        }
        __syncthreads();
    }
    if (w >= 4) SC_POST(nch - 1);
    else {
#pragma unroll
        for (int q = 0; q < 2; ++q) { float* Sout = F.out + (smp ? O_WKVS : O_WKVP) + (((size_t)(l * 8 + b) * 16 + h) * 64 + (q ? r1 : r0)) * 64 + 8 * kq;
            *(f32x4*)Sout = (f32x4){S2[q][0][0], S2[q][0][1], S2[q][1][0], S2[q][1][1]}; *(f32x4*)(Sout + 4) = (f32x4){S2[q][2][0], S2[q][2][1], S2[q][3][0], S2[q][3][1]}; } }
#undef SC_PREP
#undef SC_POST
    __syncthreads();
}
__device__ __forceinline__ void ph_scan(Frame& F, CArgsP A, int l, const int s0, const int ns) {
    for (int it = s0; it < 256; it += ns) scan_fast(F, A, l, it);
}

__device__ __forceinline__ void unpack8f(const v4u w, float (&o)[8]) { o[0] = bflo(w.x); o[1] = bfhi(w.x); o[2] = bflo(w.y); o[3] = bfhi(w.y); o[4] = bflo(w.z); o[5] = bfhi(w.z); o[6] = bflo(w.w); o[7] = bfhi(w.w); }
__device__ __forceinline__ void ph_conv(Frame& F, CArgsP A, int l) {
    const int gt = (F.vcu * NWAVES + F.wave) * 64 + F.lane, NGT = F.G * NWAVES * 64;
    const bf16* UP = (const bf16*)(F.ws + B_UP); bf16* GT = (bf16*)(F.ws + B_GT);
    const float* cw = GIN(A, 27) + (size_t)l * 3 * UPW; const float* cb = GIN(A, 28) + (size_t)l * UPW;
    constexpr int NJ = D_FF / 8, NRB = MT / 64;
    for (int it = gt; it < NRB * NJ; it += NGT) {
        const int rb = it / NJ, j = (it % NJ) * 8;
        float w0[2][8], w1[2][8], w2[2][8], bi[2][8];
#pragma unroll
        for (int hf = 0; hf < 2; ++hf) { const int col = j + hf * D_FF;
#pragma unroll
            for (int e = 0; e < 8; e += 4) { const f32x4 a = *(const f32x4*)(cw + col + e), b2 = *(const f32x4*)(cw + UPW + col + e), c2 = *(const f32x4*)(cw + 2 * UPW + col + e), d2 = *(const f32x4*)(cb + col + e);
                w0[hf][e] = a.x; w0[hf][e + 1] = a.y; w0[hf][e + 2] = a.z; w0[hf][e + 3] = a.w; w1[hf][e] = b2.x; w1[hf][e + 1] = b2.y; w1[hf][e + 2] = b2.z; w1[hf][e + 3] = b2.w;
                w2[hf][e] = c2.x; w2[hf][e + 1] = c2.y; w2[hf][e + 2] = c2.z; w2[hf][e + 3] = c2.w; bi[hf][e] = d2.x; bi[hf][e + 1] = d2.y; bi[hf][e + 2] = d2.z; bi[hf][e + 3] = d2.w; } }
        float u1[2][8], u2[2][8];
        for (int r4 = 0; r4 < 64; r4 += 4) {
            v4u ld[4][2];
#pragma unroll
            for (int q = 0; q < 4; ++q) { ld[q][0] = *(const v4u*)(UP + (size_t)(rb * 64 + r4 + q) * UPW + j); ld[q][1] = *(const v4u*)(UP + (size_t)(rb * 64 + r4 + q) * UPW + j + D_FF); }
#pragma unroll
            for (int q = 0; q < 4; ++q) {
                const int rr = r4 + q, row = rb * 64 + rr;
                const bool smp = row >= MP; const int t = smp ? ((row - MP) & 31) : (row & 2047); const int b = smp ? ((row - MP) >> 5) : (row >> 11);
                if (t == 0) {
#pragma unroll
                    for (int hf = 0; hf < 2; ++hf) { const int col = j + hf * D_FF;
                        if (smp) { const float* s0 = GIN(A, 6) + ((size_t)(l * 8 + b) * 2) * UPW + col;
#pragma unroll
                            for (int e = 0; e < 8; ++e) { u2[hf][e] = s0[e]; u1[hf][e] = s0[UPW + e]; } }
                        else {
#pragma unroll
                            for (int e = 0; e < 8; ++e) { u2[hf][e] = 0.f; u1[hf][e] = 0.f; } } }
                } else if (rr == 0) {
#pragma unroll
                    for (int hf = 0; hf < 2; ++hf) { const int col = j + hf * D_FF;
                        unpack8f(*(const v4u*)(UP + (size_t)(row - 1) * UPW + col), u1[hf]); unpack8f(*(const v4u*)(UP + (size_t)(row - 2) * UPW + col), u2[hf]); }
                }
                float u0[2][8], cc[2][8];
#pragma unroll
                for (int hf = 0; hf < 2; ++hf) { unpack8f(ld[q][hf], u0[hf]);
#pragma unroll
                    for (int e = 0; e < 8; ++e) { cc[hf][e] = bi[hf][e] + u2[hf][e] * w0[hf][e] + u1[hf][e] * w1[hf][e] + u0[hf][e] * w2[hf][e]; u2[hf][e] = u1[hf][e]; u1[hf][e] = u0[hf][e]; } }
                float gv[8];
#pragma unroll
                for (int e = 0; e < 8; ++e) gv[e] = cc[0][e] * __builtin_amdgcn_rcpf(1.0f + __builtin_amdgcn_exp2f(-1.4426950408889634f * cc[0][e])) * cc[1][e];
                v4u o; o.x = pk2(gv[0], gv[1]); o.y = pk2(gv[2], gv[3]); o.z = pk2(gv[4], gv[5]); o.w = pk2(gv[6], gv[7]);
                *(v4u*)(GT + (size_t)row * D_FF + j) = o;
            }
        }
    }
}

__device__ __forceinline__ void ph_final(Frame& F, CArgsP A) {
    const int gw = F.vcu * NWAVES + F.wave, NGW = F.G * NWAVES;
    float* X = F.out + O_YP; const float* SS = (const float*)(F.ctl + CW_SS) + 4 * MT; const float* g = GIN(A, 30);
    for (int m = gw; m < MT; m += NGW) {
        const float r = 1.0f / sqrtf(SS[m] * (1.0f / 1024.f) + EPS);
        GAS f32x4* xr = (GAS f32x4*)(X + (size_t)m * 1024) + F.lane; const GAS f32x4* gr = (const GAS f32x4*)g + F.lane;
#pragma unroll
        for (int j = 0; j < 4; ++j) { f32x4 v = xr[64 * j]; const f32x4 gg = gr[64 * j]; v = v * r * gg; xr[64 * j] = v; }
    }
}

#define REOPAQUE() do { int tv = threadIdx.x; asm volatile("" : "+v"(tv)); F.tid = tv; F.lane = tv & 63; F.wave = __builtin_amdgcn_readfirstlane(tv >> 6); \
    ap = (CArgsP)__builtin_amdgcn_kernarg_segment_ptr(); asm volatile("" : "+s"(ap)); \
    { GAS unsigned char* w_ = ap->ws; GAS float* o_ = ap->out; asm volatile("" : "+s"(w_), "+s"(o_)); F.ws = (unsigned char*)w_; F.out = (float*)o_; F.ctl = (gu32*)(w_ + WS_CTL); } } while (0)
#define PH_BEGIN(idx) if (lo <= (idx) && (idx) < hi) { REOPAQUE();
#define PH_END(idx) if ((idx) + 1 < hi) xcd_barrier(bar); }

template <int l> __device__ __forceinline__ void layer_phases(Frame& F, CArgsP& ap, const XcdBarrier& bar, const int lo, const int hi) {
    constexpr int P0 = 1 + l * PH_PER_LAYER;
#define WL (F.ws + WS_W)
#define SSP ((float*)(F.ctl + CW_SS))
    PH_BEGIN(P0 + K_G1) {
        int kk_ = 1024; asm volatile("" : "+s"(kk_)); pg8::Gemm g{(const bf16*)(F.ws + WS_XB), (const bf16*)(WL + W_IN), MT, P_DA + P_RW, kk_}; pg8::StaticOrder S; S.init(MT, P_DA + P_RW, F.G, (int)blockIdx.x);
        pg8::EpiIn E{SSP + (size_t)(2 * l) * MT, (const float*)(F.ws + WS_ROPE), (bf16*)(F.ws + B_Q), (bf16*)(F.ws + B_K), (bf16*)(F.ws + B_V), (bf16*)(F.ws + B_URW),
                     F.out + O_KP + (size_t)l * MP * 1024, F.out + O_VP + (size_t)l * MP * 1024, F.out + O_KS + (size_t)l * MS * 1024, F.out + O_VS + (size_t)l * MS * 1024,
                     F.out + O_SHP + (size_t)l * BATCH * P_RW, F.out + O_SHS + (size_t)l * DEC_BATCH * P_RW};
        pg8::gemm_phase<pg8::EpiIn, pg8::StaticOrder, true, true>(F.lds + RING_OFF, g, S, E);
    } PH_END(P0 + K_G1)
    PH_BEGIN(P0 + K_LP) { ph_linprep(F, ap, l); } PH_END(P0 + K_LP)
    PH_BEGIN(P0 + K_LR) {
        int kk_ = 256; asm volatile("" : "+s"(kk_)); pg8::Gemm g{(const bf16*)(F.ws + B_LIN), (const bf16*)(WL + W_LORA), MT, 3072, kk_}; pg8::StaticOrder S; S.init(MT, 3072, F.G, (int)blockIdx.x);
        pg8::EpiLora E{GIN(ap, 13) + l * 1024, GIN(ap, 15) + l * 1024, (bf16*)(F.ws + B_LD), (bf16*)(F.ws + B_LA), (bf16*)(F.ws + B_LG)};
        pg8::gemm_phase<pg8::EpiLora, pg8::StaticOrder, true, true>(F.lds + RING_OFF, g, S, E);
    } PH_END(P0 + K_LR)
    PH_BEGIN(P0 + K_SC) {
        const int NSC = (F.G >= 256) ? 128 : F.G / 2;
        if (F.vcu < NSC) ph_scan(F, ap, l, F.vcu, NSC); else ph_attn(F, ap, l, F.vcu - NSC, F.G - NSC);
    } PH_END(P0 + K_SC)
    PH_BEGIN(P0 + K_CB) {
        ph_combine(F, ap, l);
        int kk_ = 1024; asm volatile("" : "+s"(kk_)); pg8::Gemm g{(const bf16*)(F.ws + WS_XB), (const bf16*)(WL + W_IN) + (size_t)(P_DA + P_RW) * 1024, MT, P_GATE, kk_}; pg8::StaticOrder S; S.init(MT, P_GATE, F.G, (int)blockIdx.x);
        pg8::EpiGate E{SSP + (size_t)(2 * l) * MT, (bf16*)(F.ws + B_GATE)};
        pg8::gemm_phase<pg8::EpiGate, pg8::StaticOrder, true, true>(F.lds + RING_OFF, g, S, E);
    } PH_END(P0 + K_CB)
    PH_BEGIN(P0 + K_M1) {
        int kk_ = 1024; asm volatile("" : "+s"(kk_)); pg8::Gemm g{(const bf16*)(F.ws + B_OA), (const bf16*)(WL + W_ODA), MT, 1024, kk_}; pg8::StaticOrder S; S.init(MT, 1024, F.G, (int)blockIdx.x);
        pg8::EpiGated E{(const bf16*)(F.ws + B_GATE), 0, nullptr, (bf16*)(F.ws + B_MRG)};
        pg8::gemm_phase<pg8::EpiGated, pg8::StaticOrder, true, true>(F.lds + RING_OFF, g, S, E);
    } PH_END(P0 + K_M1)
    PH_BEGIN(P0 + K_M2) {
        int kk_ = 1024; asm volatile("" : "+s"(kk_)); pg8::Gemm g{(const bf16*)(F.ws + B_ORW), (const bf16*)(WL + W_ORW), MT, 1024, kk_}; pg8::StaticOrder S; S.init(MT, 1024, F.G, (int)blockIdx.x);
        pg8::EpiGated E{(const bf16*)(F.ws + B_GATE), 1024, (const bf16*)(F.ws + B_MRG), (bf16*)(F.ws + B_MRG)};
        pg8::gemm_phase<pg8::EpiGated, pg8::StaticOrder, true, true>(F.lds + RING_OFF, g, S, E);
    } PH_END(P0 + K_M2)
    PH_BEGIN(P0 + K_WO) {
        int kk_ = 1024; asm volatile("" : "+s"(kk_)); pg8::Gemm g{(const bf16*)(F.ws + B_MRG), (const bf16*)(WL + W_OUT), MT, 1024, kk_}; pg8::StaticOrder S; S.init(MT, 1024, F.G, (int)blockIdx.x);
        pg8::EpiRes E{F.out + O_YP, (bf16*)(F.ws + WS_XB), SSP + (size_t)(2 * l + 1) * MT};
        pg8::gemm_phase<pg8::EpiRes, pg8::StaticOrder, true, true>(F.lds + RING_OFF, g, S, E);
    } PH_END(P0 + K_WO)
    PH_BEGIN(P0 + K_UP) {
        int kk_ = 1024; asm volatile("" : "+s"(kk_)); pg8::Gemm g{(const bf16*)(F.ws + WS_XB), (const bf16*)(WL + W_UP), MT, UPW, kk_}; pg8::StaticOrder S; S.init(MT, UPW, F.G, (int)blockIdx.x);
        pg8::EpiUp E{SSP + (size_t)(2 * l + 1) * MT, (bf16*)(F.ws + B_UP), F.out + O_CVP + (size_t)l * BATCH * 2 * UPW, F.out + O_CVS + (size_t)l * DEC_BATCH * 2 * UPW};
        pg8::gemm_phase<pg8::EpiUp, pg8::StaticOrder, true, true>(F.lds + RING_OFF, g, S, E);
    } PH_END(P0 + K_UP)
    PH_BEGIN(P0 + K_CV) { ph_conv(F, ap, l); } PH_END(P0 + K_CV)
    PH_BEGIN(P0 + K_DN) {
        int kk_ = D_FF; asm volatile("" : "+s"(kk_)); pg8::Gemm g{(const bf16*)(F.ws + B_GT), (const bf16*)(WL + (l ? W_DN1 : W_DN)), MT, 1024, kk_}; pg8::StaticOrder S; S.init(MT, 1024, F.G, (int)blockIdx.x);
        pg8::EpiRes E{F.out + O_YP, (bf16*)(F.ws + WS_XB), SSP + (size_t)(2 * l + 2) * MT};
        pg8::gemm_phase<pg8::EpiRes, pg8::StaticOrder, true, true>(F.lds + RING_OFF, g, S, E);
        if constexpr (l == 0) {
            const int nu = (MT / 256) * (1024 / 256), rem = nu % F.G, first = rem ? rem : 0, nidle = F.G - first;
            if (rem && (int)blockIdx.x >= first) { REOPAQUE(); p0_weights(F, ap, 1, ((int)blockIdx.x - first) * NWAVES + F.wave, nidle * NWAVES); }
            else if (!rem) { REOPAQUE(); p0_weights(F, ap, 1, (int)blockIdx.x * NWAVES + F.wave, F.G * NWAVES); }
        }
    } PH_END(P0 + K_DN)
#undef WL
#undef SSP
}

__global__ void __launch_bounds__(NWAVES * 64, 2) mk_fwd(Args args) {
    extern __shared__ __attribute__((aligned(16))) unsigned char lds[];
    Frame F;
    F.lds = (LAS unsigned char*)lds;
    F.MISC = (volatile LAS unsigned*)(F.lds + MISC_OFF);
    F.tid = threadIdx.x; F.lane = F.tid & 63; F.wave = __builtin_amdgcn_readfirstlane(F.tid >> 6);
    F.G = gridDim.x; { const int bx = blockIdx.x; F.vcu = (F.G % 8 == 0) ? (bx % 8) * (F.G / 8) + bx / 8 : bx; }
    F.out = (float*)args.out; F.ws = (unsigned char*)args.ws;
    F.ctl = (gu32*)(args.ws + WS_CTL);
    for (int u = F.tid; u < (LDS_BYTES - LDSCTL_OFF) / 4; u += NWAVES * 64) ((LAS unsigned*)(F.lds + LDSCTL_OFF))[u] = 0u;
    __syncthreads();
    XcdBarrier bar; bar.bar = (unsigned*)(F.ctl + CW_BAR); bar.x = 0; bar.st = nullptr;
    if (!MK_PER_PHASE) bar = xcd_barrier_post((unsigned*)(F.ctl + CW_BAR), F.MISC + 8);
    const int lo = args.ph_lo, hi = args.ph_hi;
    CArgsP ap;
    PH_BEGIN(0) { p0_prologue(F, ap); } PH_END(0)
    layer_phases<0>(F, ap, bar, lo, hi);
    layer_phases<1>(F, ap, bar, lo, hi);
    PH_BEGIN(NPHASE - 1) { ph_final(F, ap); } PH_END(NPHASE - 1)
}

extern "C" void kernel_launch(void* const* d_in, const int* in_sizes, int n_in, void* d_out, int out_size, void* d_ws, size_t ws_size, hipStream_t stream) {
    (void)in_sizes;
    static int grid = 0;
    if (grid == 0) {
        if (n_in != 31 || out_size != (int)O_END || ws_size < B_END2) { fprintf(stderr, "kernel_launch: unexpected shapes (n_in %d out %d ws %zu)\n", n_in, out_size, ws_size); grid = -1; return; }
        int dev = 0, cus = 0;
        if (hipGetDevice(&dev) != hipSuccess || hipDeviceGetAttribute(&cus, hipDeviceAttributeMultiprocessorCount, dev) != hipSuccess) { grid = -1; return; }
        if (hipFuncSetAttribute((const void*)mk_fwd, hipFuncAttributeMaxDynamicSharedMemorySize, LDS_BYTES) != hipSuccess) { fprintf(stderr, "kernel_launch: hipFuncSetAttribute failed\n"); grid = -1; return; }
        (void)hipGetLastError();
        grid = cus;
    }
    if (grid < 0) return;
    if (hipMemsetAsync((char*)d_ws + WS_CTL, 0, CTL_ZERO_BYTES, stream) != hipSuccess) { fprintf(stderr, "kernel_launch: memset failed\n"); return; }
    Args a{};
    for (int i = 0; i < 31; ++i) a.in[i] = (const GAS float*)d_in[i];
    a.out = (GAS float*)d_out; a.ws = (GAS unsigned char*)d_ws;
    for (int i = 0; i < 8; ++i) a.rinv[i] = (float)pow(500000.0, -(double)i / 8.0);
#if MK_PER_PHASE
    for (int p = 0; p < NPHASE; ++p) { a.ph_lo = p; a.ph_hi = p + 1; hipLaunchKernelGGL(mk_fwd, dim3(grid), dim3(NWAVES * 64), LDS_BYTES, stream, a); }
#else
    a.ph_lo = 0; a.ph_hi = NPHASE;
    hipLaunchKernelGGL(mk_fwd, dim3(grid), dim3(NWAVES * 64), LDS_BYTES, stream, a);
#endif
    const hipError_t le = hipPeekAtLastError();
    if (le != hipSuccess) fprintf(stderr, "kernel_launch: launch failed: %s\n", hipGetErrorName(le));
}
```

```cpp
#include <hip/hip_runtime.h>
#include <cstdio>
#include <cstdint>
#include <cmath>

#ifndef MK_PER_PHASE
#define MK_PER_PHASE 0
#endif

constexpr int D_MODEL = 1024, BATCH = 8, SEQ = 2048, DEPTH = 2, DEC_BATCH = 8, DEC_SEQ = 32, PAST_LEN = 2048;
constexpr float EPS = 1e-6f, GN_EPS = 64e-5f;
constexpr int DA_HEADS = 8, RW_HEADS = 16;
constexpr int D_FF = 2816, UPW = 2 * D_FF;
constexpr int P_DA = 3072, P_RW = 3328, P_GATE = 2048, P_TOTAL = 8448;
constexpr int MP = BATCH * SEQ, MS = DEC_BATCH * DEC_SEQ, MT = MP + MS;
constexpr int NKEYS_S = PAST_LEN + DEC_SEQ;
constexpr float C2 = 0.125f * 1.4426950408889634f;

constexpr size_t O_YP = 0;
constexpr size_t O_YS = O_YP + (size_t)MP * D_MODEL;
constexpr size_t O_KP = O_YS + (size_t)MS * D_MODEL;
constexpr size_t O_VP = O_KP + (size_t)DEPTH * MP * 1024;
constexpr size_t O_WKVP = O_VP + (size_t)DEPTH * MP * 1024;
constexpr size_t O_SHP = O_WKVP + (size_t)DEPTH * BATCH * RW_HEADS * 64 * 64;
constexpr size_t O_CVP = O_SHP + (size_t)DEPTH * BATCH * P_RW;
constexpr size_t O_KS = O_CVP + (size_t)DEPTH * BATCH * 2 * UPW;
constexpr size_t O_VS = O_KS + (size_t)DEPTH * MS * 1024;
constexpr size_t O_WKVS = O_VS + (size_t)DEPTH * MS * 1024;
constexpr size_t O_SHS = O_WKVS + (size_t)DEPTH * DEC_BATCH * RW_HEADS * 64 * 64;
constexpr size_t O_CVS = O_SHS + (size_t)DEPTH * DEC_BATCH * P_RW;
constexpr size_t O_END = O_CVS + (size_t)DEPTH * DEC_BATCH * 2 * UPW;
static_assert(O_END == 87760896, "output size");

namespace pg8 {
#define PG8_LAS __attribute__((address_space(3)))
typedef unsigned short bf16_t;
typedef short bf16x8 __attribute__((ext_vector_type(8)));
typedef float f32x4 __attribute__((ext_vector_type(4)));
typedef unsigned u32x4 __attribute__((ext_vector_type(4)));
constexpr int BM = 256, BK = 64, HALF = 128, HTB = HALF * BK * 2  , STAGE_BYTES = 8 * HTB, NXCD = 8, WGM = 8;

__host__ __device__ __forceinline__ int lds_byte(int r, int c) { const int st = (r >> 4) * 2 + (c >> 5), rr = r & 15, cc = c & 31, ob = rr * 64 + cc * 2; return st * 1024 + (ob ^ (((ob >> 9) & 1) << 5)); }
__host__ __device__ __forceinline__ void stage_rc(int b, int& R, int& C) { const int st = b / 1024, sb = b % 1024, swz = sb ^ (((sb >> 9) & 1) << 5); R = (st >> 1) * 16 + swz / 64; C = (st & 1) * 32 + (swz % 64) / 2; }
__host__ __device__ __forceinline__ int perm32(int rho) { const int n = rho >> 4, i = rho & 15; return 8 * (i >> 2) + 4 * n + (i & 3); }

struct Unit { int pm, pn; };
struct Gemm { const bf16_t* A; const bf16_t* Bt; int M, N, K; };

struct StaticOrder {
    int nM, nN, nwg, G, c;
    __host__ __device__ void init(int M, int N, int G_, int c_) { nM = M / BM; nN = N / BM; nwg = nM * nN; G = G_; c = c_; }
    __host__ __device__ bool next(int i, Unit& u) const {
        const long L = (long)i * G + c; if (L >= nwg) return false;
        int wgid = (int)L; { const int q = nwg / NXCD, r = nwg % NXCD, xcd = wgid % NXCD, off = wgid / NXCD; wgid = (xcd < r ? xcd * (q + 1) : r * (q + 1) + (xcd - r) * q) + off; }
        const int nig = WGM * nN, gid = wgid / nig, fm = gid * WGM, gsz = (nM - fm) < WGM ? (nM - fm) : WGM;
        u.pm = fm + ((wgid % nig) % gsz); u.pn = (wgid % nig) / gsz; return true;
    }
    __device__ __forceinline__ void a_ready(const Unit&) const {}
    __device__ __forceinline__ void done(const Unit&) const {}
};

typedef float f32x2_cv __attribute__((ext_vector_type(2))); typedef __bf16 bf16x2_cv __attribute__((ext_vector_type(2)));
__device__ __forceinline__ unsigned cvt_pk_bf16(float lo, float hi) { const f32x2_cv v = {lo, hi}; const bf16x2_cv b = __builtin_convertvector(v, bf16x2_cv); return __builtin_bit_cast(unsigned, b); }
typedef float f32x2 __attribute__((ext_vector_type(2)));
__device__ __forceinline__ float bf2f(unsigned short h) { return __uint_as_float((unsigned)h << 16); }
__device__ __forceinline__ float fast_sigmoid(float x) { return __builtin_amdgcn_rcpf(1.0f + __builtin_amdgcn_exp2f(-1.4426950408889634f * x)); }
__device__ __forceinline__ float neg_decay_log(float x) {
    const float y = -x, sp = fmaxf(y, 0.f) + 0.6931471805599453f * __builtin_amdgcn_logf(1.0f + __builtin_amdgcn_exp2f(-1.4426950408889634f * fabsf(y)));
    return -__builtin_amdgcn_exp2f(-1.4426950408889634f * (sp + 0.5f));
}
__device__ __forceinline__ u32x4 pack8(const f32x4 v0, const f32x4 v1) { u32x4 w; w.x = cvt_pk_bf16(v0[0], v0[1]); w.y = cvt_pk_bf16(v0[2], v0[3]); w.z = cvt_pk_bf16(v1[0], v1[1]); w.w = cvt_pk_bf16(v1[2], v1[3]); return w; }
__device__ __forceinline__ void unpack8(const u32x4 w, f32x4& v0, f32x4& v1) {
    v0[0] = __uint_as_float(w.x << 16); v0[1] = __uint_as_float(w.x & 0xffff0000u); v0[2] = __uint_as_float(w.y << 16); v0[3] = __uint_as_float(w.y & 0xffff0000u);
    v1[0] = __uint_as_float(w.z << 16); v1[1] = __uint_as_float(w.z & 0xffff0000u); v1[2] = __uint_as_float(w.w << 16); v1[3] = __uint_as_float(w.w & 0xffff0000u);
}
constexpr int E_MP = 16384, E_MS = 256;

struct EpiIn {
    static constexpr bool PERM = true, AFTER_DRAIN = false;
    const float* ss; const float* rope;
    bf16_t *Q, *K, *V, *URW;
    float *kout_p, *vout_p, *kout_s, *vout_s;
    float *sh_p, *sh_s;
    __device__ __forceinline__ void operator()(const f32x4 (&acc)[2][2][4][2], const Unit& u, int wr, int wc, int fr, int fq) const {
        const int pn = u.pn, rowb = u.pm * BM + wr * 64 + fr, cl = wc * 32 + 8 * fq;
        const bool rope_wave = (pn < 8) && ((wc & 1) == 0);
        const float sgn = (fq == 0) ? -1.f : 1.f;
#pragma unroll
        for (int ai = 0; ai < 2; ++ai)
#pragma unroll
            for (int m = 0; m < 4; ++m) {
                const int row = rowb + ai * HALF + m * 16;
                const float rstd = 1.0f / sqrtf(ss[row] * (1.0f / 1024.f) + 1e-6f);
                const bool smp = row >= E_MP;
                const int t = smp ? ((row - E_MP) & 31) : (row & 2047);
                const int bb = smp ? ((row - E_MP) >> 5) : (row >> 11);
                const int pos = smp ? 2048 + t : t;
                const bool last = smp ? (t == 31) : (t == 2047);
#pragma unroll
                for (int bj = 0; bj < 2; ++bj) {
                    f32x4 v0 = acc[ai][bj][m][0] * rstd, v1 = acc[ai][bj][m][1] * rstd;
                    const int col = pn * BM + bj * HALF + cl;
                    if (pn < 8) {
                        if (rope_wave) {
                            f32x4 p0, p1;
#pragma unroll
                            for (int j = 0; j < 4; ++j) { p0[j] = __shfl_xor(v0[j], 16); p1[j] = __shfl_xor(v1[j], 16); }
                            if (fq < 2) {
                                const float* tb = rope + pos * 16;
                                const f32x4 c0 = *(const f32x4*)(tb), c1 = *(const f32x4*)(tb + 4), s0 = *(const f32x4*)(tb + 8), s1 = *(const f32x4*)(tb + 12);
                                v0 = v0 * c0 + (p0 * s0) * sgn; v1 = v1 * c1 + (p1 * s1) * sgn;
                            }
                        }
                        if (pn < 4) { v0 = v0 * C2; v1 = v1 * C2; *(u32x4*)(Q + (size_t)row * 1024 + col) = pack8(v0, v1); }
                        else {
                            const int c = col - 1024;
                            *(u32x4*)(K + (size_t)row * 1024 + c) = pack8(v0, v1);
                            float* o = smp ? kout_s + (size_t)(row - E_MP) * 1024 + c : kout_p + (size_t)row * 1024 + c;
                            *(f32x4*)o = v0; *(f32x4*)(o + 4) = v1;
                        }
                    } else if (pn < 12) {
                        const int c = col - 2048;
                        *(u32x4*)(V + (size_t)row * 1024 + c) = pack8(v0, v1);
                        float* o = smp ? vout_s + (size_t)(row - E_MP) * 1024 + c : vout_p + (size_t)row * 1024 + c;
                        *(f32x4*)o = v0; *(f32x4*)(o + 4) = v1;
                    } else {
                        const int c = col - 3072;
                        *(u32x4*)(URW + (size_t)row * 3328 + c) = pack8(v0, v1);
                        if (last) { float* o = (smp ? sh_s : sh_p) + (size_t)bb * 3328 + c; *(f32x4*)o = v0; *(f32x4*)(o + 4) = v1; }
                    }
                }
            }
    }
};

struct EpiGate {
    static constexpr bool PERM = true, AFTER_DRAIN = false;
    const float* ss; bf16_t* GATE;
    __device__ __forceinline__ void operator()(const f32x4 (&acc)[2][2][4][2], const Unit& u, int wr, int wc, int fr, int fq) const {
        const int rowb = u.pm * BM + wr * 64 + fr, cl = u.pn * BM + wc * 32 + 8 * fq;
#pragma unroll
        for (int ai = 0; ai < 2; ++ai)
#pragma unroll
            for (int m = 0; m < 4; ++m) {
                const int row = rowb + ai * HALF + m * 16;
                const float rstd = 1.0f / sqrtf(ss[row] * (1.0f / 1024.f) + 1e-6f);
#pragma unroll
                for (int bj = 0; bj < 2; ++bj) {
                    f32x4 v0 = acc[ai][bj][m][0] * rstd, v1 = acc[ai][bj][m][1] * rstd;
#pragma unroll
                    for (int j = 0; j < 4; ++j) { v0[j] = fast_sigmoid(v0[j]); v1[j] = fast_sigmoid(v1[j]); }
                    *(u32x4*)(GATE + (size_t)row * 2048 + cl + bj * HALF) = pack8(v0, v1);
                }
            }
    }
};

struct EpiLora {
    static constexpr bool PERM = true, AFTER_DRAIN = false;
    const float *w0, *a0; bf16_t *LD, *LA, *LG;
    __device__ __forceinline__ void operator()(const f32x4 (&acc)[2][2][4][2], const Unit& u, int wr, int wc, int fr, int fq) const {
        const int pn = u.pn, rowb = u.pm * BM + wr * 64 + fr, cl = wc * 32 + 8 * fq;
        const int seg = pn >> 2;
#pragma unroll
        for (int bj = 0; bj < 2; ++bj) {
            const int c = (pn & 3) * BM + bj * HALF + cl;
            f32x4 b0 = (f32x4){0.f, 0.f, 0.f, 0.f}, b1 = b0;
            if (seg == 0) { b0 = *(const f32x4*)(w0 + c); b1 = *(const f32x4*)(w0 + c + 4); }
            else if (seg == 1) { b0 = *(const f32x4*)(a0 + c); b1 = *(const f32x4*)(a0 + c + 4); }
#pragma unroll
            for (int ai = 0; ai < 2; ++ai)
#pragma unroll
                for (int m = 0; m < 4; ++m) {
                    const int row = rowb + ai * HALF + m * 16;
                    f32x4 v0 = acc[ai][bj][m][0] + b0, v1 = acc[ai][bj][m][1] + b1;
                    if (seg == 0) {
#pragma unroll
                        for (int j = 0; j < 4; ++j) { v0[j] = neg_decay_log(v0[j]); v1[j] = neg_decay_log(v1[j]); }
                        *(u32x4*)(LD + (size_t)row * 1024 + c) = pack8(v0, v1);
                    } else if (seg == 1) {
#pragma unroll
                        for (int j = 0; j < 4; ++j) { v0[j] = fast_sigmoid(v0[j]); v1[j] = fast_sigmoid(v1[j]); }
                        *(u32x4*)(LA + (size_t)row * 1024 + c) = pack8(v0, v1);
                    } else {
                        *(u32x4*)(LG + (size_t)row * 1024 + c) = pack8(v0, v1);
                    }
                    asm volatile("" ::: "memory");
                }
        }
    }
};

struct EpiGated {
    static constexpr bool PERM = true, AFTER_DRAIN = false;
    const bf16_t* G; int goff; const bf16_t* S; bf16_t* O;
    __device__ __forceinline__ void operator()(const f32x4 (&acc)[2][2][4][2], const Unit& u, int wr, int wc, int fr, int fq) const {
        const int rowb = u.pm * BM + wr * 64 + fr, cl = u.pn * BM + wc * 32 + 8 * fq;
#pragma unroll
        for (int ai = 0; ai < 2; ++ai)
#pragma unroll
            for (int m = 0; m < 4; ++m) {
                const int row = rowb + ai * HALF + m * 16;
#pragma unroll
                for (int bj = 0; bj < 2; ++bj) {
                    const int c = cl + bj * HALF;
                    f32x4 g0, g1; unpack8(*(const u32x4*)(G + (size_t)row * 2048 + goff + c), g0, g1);
                    f32x4 v0 = acc[ai][bj][m][0] * g0, v1 = acc[ai][bj][m][1] * g1;
                    if (S) { f32x4 s0, s1; unpack8(*(const u32x4*)(S + (size_t)row * 1024 + c), s0, s1); v0 += s0; v1 += s1; }
                    *(u32x4*)(O + (size_t)row * 1024 + c) = pack8(v0, v1);
                }
            }
    }
};

struct EpiRes {
    static constexpr bool PERM = true, AFTER_DRAIN = false;
    float* X; bf16_t* XB; float* SS;
    __device__ __forceinline__ void operator()(const f32x4 (&acc)[2][2][4][2], const Unit& u, int wr, int wc, int fr, int fq) const {
        const int rowb = u.pm * BM + wr * 64 + fr, cl = u.pn * BM + wc * 32 + 8 * fq;
#pragma unroll
        for (int ai = 0; ai < 2; ++ai)
#pragma unroll
            for (int m = 0; m < 4; ++m) {
                const int row = rowb + ai * HALF + m * 16;
                float sq = 0.f;
#pragma unroll
                for (int bj = 0; bj < 2; ++bj) {
                    const int c = cl + bj * HALF;
                    float* xp = X + (size_t)row * 1024 + c;
                    const f32x4 v0 = *(const f32x4*)xp + acc[ai][bj][m][0], v1 = *(const f32x4*)(xp + 4) + acc[ai][bj][m][1];
                    *(f32x4*)xp = v0; *(f32x4*)(xp + 4) = v1;
                    *(u32x4*)(XB + (size_t)row * 1024 + c) = pack8(v0, v1);
                    sq += (v0[0] * v0[0] + v0[1] * v0[1]) + (v0[2] * v0[2] + v0[3] * v0[3]) + (v1[0] * v1[0] + v1[1] * v1[1]) + (v1[2] * v1[2] + v1[3] * v1[3]);
                }
                sq += __shfl_xor(sq, 16); sq += __shfl_xor(sq, 32);
                if (fq == 0) atomicAdd(SS + row, sq);
            }
    }
};

struct EpiUp {
    static constexpr bool PERM = true, AFTER_DRAIN = false;
    const float* ss; bf16_t* UP; float *cv_p, *cv_s;
    __device__ __forceinline__ void operator()(const f32x4 (&acc)[2][2][4][2], const Unit& u, int wr, int wc, int fr, int fq) const {
        const int rowb = u.pm * BM + wr * 64 + fr, cl = u.pn * BM + wc * 32 + 8 * fq;
#pragma unroll
        for (int ai = 0; ai < 2; ++ai)
#pragma unroll
            for (int m = 0; m < 4; ++m) {
                const int row = rowb + ai * HALF + m * 16;
                const float rstd = 1.0f / sqrtf(ss[row] * (1.0f / 1024.f) + 1e-6f);
                const bool smp = row >= E_MP;
                const int t = smp ? ((row - E_MP) & 31) : (row & 2047);
                const int bb = smp ? ((row - E_MP) >> 5) : (row >> 11);
                const int slot = smp ? t - 30 : t - 2046;
#pragma unroll
                for (int bj = 0; bj < 2; ++bj) {
                    const int c = cl + bj * HALF;
                    const f32x4 v0 = acc[ai][bj][m][0] * rstd, v1 = acc[ai][bj][m][1] * rstd;
                    *(u32x4*)(UP + (size_t)row * 5632 + c) = pack8(v0, v1);
                    if (slot >= 0) { float* o = (smp ? cv_s : cv_p) + ((size_t)bb * 2 + slot) * 5632 + c; *(f32x4*)o = v0; *(f32x4*)(o + 4) = v1; }
                }
            }
    }
};

template <class Epi, class Sched, bool ALIGN_EPI = false, bool SP2 = false>
__device__ __forceinline__ void gemm_phase(PG8_LAS unsigned char* lds, const Gemm g, const Sched& S, const Epi& E) {
    int tid_ = threadIdx.x; asm volatile("" : "+v"(tid_));
    const int tid = tid_, wid = __builtin_amdgcn_readfirstlane(tid >> 6), lane = tid & 63, wr = wid >> 2, wc = wid & 3, fr = lane & 15, fq = lane >> 4;
    const int K = g.K, nt = K / BK;
    unsigned voffA[2], voffB[2];
#pragma unroll
    for (int i = 0; i < 2; ++i) { int R, C; stage_rc(tid * 16 + i * 8192, R, C); const int Rb = Epi::PERM ? ((R & ~31) + perm32(R & 31)) : R;
        voffA[i] = (unsigned)(R * K + C) * 2u; voffB[i] = (unsigned)(Rb * K + C) * 2u; }
    const size_t kstep = (size_t)(BK * 2);
    const size_t hstep = (size_t)HALF * K * 2;
    const size_t tstep = 2 * hstep;
    const unsigned ldsw = (unsigned)wid * 1024u;
    const int aoff = lds_byte(wr * 64 + fr, fq * 8), boff = lds_byte(wc * 32 + fr, fq * 8);
#define PG8_SA(b, h) (((b) * 2 + (h)) * HTB)
#define PG8_SB(b, h) ((4 + (b) * 2 + (h)) * HTB)
#define PG8_STAGE(bufoff, gbase, voff) do { _Pragma("unroll") for (int _i = 0; _i < 2; ++_i) \
        __builtin_amdgcn_global_load_lds((const unsigned*)((const char*)(gbase) + (voff)[_i]), (PG8_LAS unsigned*)(lds + (bufoff) + ldsw + _i * 8192), 16, 0, 0); } while (0)
#define PG8_LDA(dst, b, h) do { _Pragma("unroll") for (int m = 0; m < 4; ++m) _Pragma("unroll") for (int k = 0; k < 2; ++k) dst[m][k] = *(const PG8_LAS bf16x8*)(lds + PG8_SA(b, h) + aoff + m * 2048 + k * 1024); } while (0)
#define PG8_LDB(dst, b, h) do { _Pragma("unroll") for (int n = 0; n < 2; ++n) _Pragma("unroll") for (int k = 0; k < 2; ++k) dst[n][k] = *(const PG8_LAS bf16x8*)(lds + PG8_SB(b, h) + boff + n * 2048 + k * 1024); } while (0)
#define PG8_MMA(ai, bj, At, Bt) do { __builtin_amdgcn_s_setprio(1); _Pragma("unroll") for (int m = 0; m < 4; ++m) _Pragma("unroll") for (int n = 0; n < 2; ++n) _Pragma("unroll") for (int k = 0; k < 2; ++k) \
        acc[ai][bj][m][n] = __builtin_amdgcn_mfma_f32_16x16x32_bf16(Bt[n][k], At[m][k], acc[ai][bj][m][n], 0, 0, 0); __builtin_amdgcn_s_setprio(0); } while (0)
#define PG8_WAIT_V(n) asm volatile("s_waitcnt vmcnt(" #n ")" ::: "memory")
#define PG8_WAIT_L(n) asm volatile("s_waitcnt lgkmcnt(" #n ")" ::: "memory")
#define PG8_BAR __builtin_amdgcn_s_barrier()
#define PG8_SCHED __builtin_amdgcn_sched_barrier(0)
    Unit cur, nxt; int ui = 0;
    if (!S.next(0, cur)) return;
    f32x4 acc[2][2][4][2];
#pragma unroll
    for (int a = 0; a < 2; ++a)
#pragma unroll
        for (int b = 0; b < 2; ++b)
#pragma unroll
            for (int m = 0; m < 4; ++m)
#pragma unroll
                for (int n = 0; n < 2; ++n) acc[a][b][m][n] = (f32x4){0.f, 0.f, 0.f, 0.f};
    bf16x8 At[4][2], B0[2][2], B1[2][2];
    const char* cA = (const char*)g.A + (size_t)cur.pm * tstep; const char* cB = (const char*)g.Bt + (size_t)cur.pn * tstep;
    S.a_ready(cur);
    if constexpr (SP2) {
        PG8_STAGE(PG8_SB(0, 0), cB, voffB); PG8_STAGE(PG8_SB(0, 1), cB + hstep, voffB); PG8_STAGE(PG8_SA(0, 0), cA, voffA); PG8_STAGE(PG8_SA(0, 1), cA + hstep, voffA);
        if (wr == 1) PG8_BAR;
        PG8_WAIT_V(2); PG8_BAR;
        PG8_STAGE(PG8_SB(1, 0), cB + kstep, voffB); PG8_STAGE(PG8_SA(1, 0), cA + kstep, voffA); PG8_STAGE(PG8_SB(1, 1), cB + hstep + kstep, voffB);
        PG8_WAIT_V(6); PG8_BAR;
    } else {
        PG8_STAGE(PG8_SB(0, 0), cB, voffB); PG8_STAGE(PG8_SA(0, 0), cA, voffA); PG8_STAGE(PG8_SB(0, 1), cB + hstep, voffB); PG8_STAGE(PG8_SA(0, 1), cA + hstep, voffA);
        if (wr == 1) PG8_BAR;
        PG8_WAIT_V(4); PG8_BAR;
        PG8_STAGE(PG8_SB(1, 0), cB + kstep, voffB); PG8_STAGE(PG8_SA(1, 0), cA + kstep, voffA); PG8_STAGE(PG8_SB(1, 1), cB + hstep + kstep, voffB);
        PG8_WAIT_V(6); PG8_BAR;
    }
    for (;;) {
        const bool has_next = S.next(ui + 1, nxt);
        const char* nA = has_next ? (const char*)g.A + (size_t)nxt.pm * tstep : cA; const char* nB = has_next ? (const char*)g.Bt + (size_t)nxt.pn * tstep : cB;
        for (int t = 0; t < nt; t += 2) {
            const bool last = (t == nt - 2);
            const char* a1 = cA + (size_t)(t + 1) * kstep;
            const char* a2 = last ? nA : cA + (size_t)(t + 2) * kstep; const char* b2 = last ? nB : cB + (size_t)(t + 2) * kstep;
            const char* a3 = a2 + kstep; const char* b3 = b2 + kstep;
            if (last && has_next) S.a_ready(nxt);
            if constexpr (SP2) {
            PG8_LDB(B0, 0, 0); PG8_LDB(B1, 0, 1); PG8_SCHED; PG8_LDA(At, 0, 0); PG8_STAGE(PG8_SA(1, 1), a1 + hstep, voffA);
            PG8_WAIT_V(8); PG8_WAIT_L(0); PG8_BAR; PG8_MMA(0, 0, At, B0); PG8_MMA(0, 1, At, B1); PG8_BAR; PG8_SCHED;
            PG8_LDA(At, 0, 1); PG8_STAGE(PG8_SB(0, 0), b2, voffB); PG8_STAGE(PG8_SB(0, 1), b2 + hstep, voffB); PG8_STAGE(PG8_SA(0, 0), a2, voffA);
            PG8_WAIT_V(8); PG8_WAIT_L(0); PG8_BAR; PG8_MMA(1, 0, At, B0); PG8_MMA(1, 1, At, B1); PG8_BAR; PG8_SCHED;
            PG8_LDB(B0, 1, 0); PG8_LDB(B1, 1, 1); PG8_SCHED; PG8_LDA(At, 1, 0); PG8_STAGE(PG8_SA(0, 1), a2 + hstep, voffA);
            PG8_WAIT_V(8); PG8_WAIT_L(0); PG8_BAR; PG8_MMA(0, 0, At, B0); PG8_MMA(0, 1, At, B1); PG8_BAR; PG8_SCHED;
            PG8_LDA(At, 1, 1); PG8_STAGE(PG8_SB(1, 0), b3, voffB); PG8_STAGE(PG8_SB(1, 1), b3 + hstep, voffB); PG8_STAGE(PG8_SA(1, 0), a3, voffA);
            PG8_WAIT_V(8); PG8_WAIT_L(0); PG8_BAR; PG8_MMA(1, 0, At, B0); PG8_MMA(1, 1, At, B1); PG8_BAR; PG8_SCHED;
            } else {
            PG8_LDB(B0, 0, 0); PG8_SCHED; PG8_LDA(At, 0, 0); PG8_STAGE(PG8_SA(1, 1), a1 + hstep, voffA);
            PG8_WAIT_L(8); PG8_BAR; PG8_WAIT_L(0); PG8_MMA(0, 0, At, B0); PG8_BAR; PG8_SCHED;
            PG8_LDB(B1, 0, 1); PG8_STAGE(PG8_SB(0, 0), b2, voffB);
            PG8_BAR; PG8_WAIT_L(0); PG8_MMA(0, 1, At, B1); PG8_BAR;
            PG8_LDA(At, 0, 1); PG8_STAGE(PG8_SA(0, 0), a2, voffA);
            PG8_BAR; PG8_WAIT_L(0); PG8_MMA(1, 0, At, B0); PG8_BAR; PG8_SCHED;
            PG8_STAGE(PG8_SB(0, 1), b2 + hstep, voffB);
            PG8_WAIT_V(6); PG8_BAR; PG8_MMA(1, 1, At, B1); PG8_BAR;
            PG8_LDB(B0, 1, 0); PG8_SCHED; PG8_LDA(At, 1, 0); PG8_STAGE(PG8_SA(0, 1), a2 + hstep, voffA);
            PG8_WAIT_L(8); PG8_BAR; PG8_WAIT_L(0); PG8_MMA(0, 0, At, B0); PG8_BAR; PG8_SCHED;
            PG8_LDB(B1, 1, 1); PG8_STAGE(PG8_SB(1, 0), b3, voffB);
            PG8_BAR; PG8_WAIT_L(0); PG8_MMA(0, 1, At, B1); PG8_BAR;
            PG8_LDA(At, 1, 1); PG8_STAGE(PG8_SA(1, 0), a3, voffA);
            PG8_BAR; PG8_WAIT_L(0); PG8_MMA(1, 0, At, B0); PG8_BAR; PG8_SCHED;
            PG8_STAGE(PG8_SB(1, 1), b3 + hstep, voffB);
            PG8_WAIT_V(6); PG8_BAR; PG8_MMA(1, 1, At, B1); PG8_BAR;
            }
        }
        if constexpr (ALIGN_EPI) { if (wr == 0) PG8_BAR; }
        if constexpr (!Epi::AFTER_DRAIN) { E(acc, cur, wr, wc, fr, fq); S.done(cur); }
        if (!has_next) break;
#pragma unroll
        for (int a = 0; a < 2; ++a)
#pragma unroll
            for (int b = 0; b < 2; ++b)
#pragma unroll
                for (int m = 0; m < 4; ++m)
#pragma unroll
                    for (int n = 0; n < 2; ++n) acc[a][b][m][n] = (f32x4){0.f, 0.f, 0.f, 0.f};
        cur = nxt; cA = nA; cB = nB; ++ui;
        if constexpr (ALIGN_EPI) { if (wr == 1) PG8_BAR; }
    }
    PG8_WAIT_V(0);
    if constexpr (!ALIGN_EPI) { if (wr == 0) PG8_BAR; }
    PG8_BAR;
    if constexpr (Epi::AFTER_DRAIN) { E.fused(acc, cur, wr, wc, fr, fq, lds, wid, lane); S.done(cur); }
#undef PG8_SA
#undef PG8_SB
#undef PG8_STAGE
#undef PG8_LDA
#undef PG8_LDB
#undef PG8_MMA
#undef PG8_WAIT_V
#undef PG8_WAIT_L
#undef PG8_BAR
#undef PG8_SCHED
}
}

constexpr int NWAVES = 8;
constexpr size_t MiB = 1u << 20;
constexpr size_t WS_CTL = 0, CTL_ZERO_BYTES = 2 * MiB;
constexpr size_t WS_ROPE = 2 * MiB;
constexpr size_t WS_W = 8 * MiB;
constexpr size_t W_IN = 0, W_ODA = W_IN + (size_t)P_TOTAL * 1024 * 2, W_ORW = W_ODA + 2 * MiB, W_OUT = W_ORW + 2 * MiB, W_UP = W_OUT + 2 * MiB,
                 W_DN = W_UP + (size_t)UPW * 1024 * 2, W_LORA = W_DN + (size_t)1024 * D_FF * 2, W_LAYER = W_LORA + (size_t)3072 * 256 * 2;
static_assert(W_LAYER == 42467328, "weights per layer");
constexpr size_t W_UP1 = W_LAYER;
constexpr size_t WS_DN1 = WS_ROPE + 256 * 1024;
static_assert(WS_DN1 + (size_t)1024 * D_FF * 2 <= WS_W, "W_DN1 slot");
constexpr size_t WS_XB = WS_W + W_LAYER + (size_t)1024 * UPW * 2;
constexpr size_t ACT = (size_t)MT * 1024 * 2;
constexpr size_t WS_POOL = WS_XB + ACT;
constexpr size_t B_Q = WS_POOL, B_K = B_Q + ACT, B_V = B_K + ACT, B_OC = B_V + ACT  , B_ORW = B_OC + 2 * ACT, B_URW = B_ORW + ACT, B_LD = B_URW + (size_t)MT * P_RW * 2, B_LA = B_LD + ACT,
                 B_LG = B_LA + ACT, B_END = B_LG + ACT;
constexpr size_t B_LIN = B_OC;
constexpr size_t B_GATE = B_Q, B_OA = B_V;
constexpr size_t B_MRG = B_URW;
constexpr size_t B_UP = WS_POOL, B_GT = B_URW;
constexpr size_t WS_SP = B_END;
constexpr size_t B_END2 = WS_SP + (size_t)1024 * 32 * 132 * 4;
static_assert(B_UP + (size_t)MT * UPW * 2 <= B_GT && B_GT + (size_t)MT * D_FF * 2 <= B_LD, "FFN overlay");
static_assert(B_END2 <= 512 * MiB, "workspace map");
constexpr int CW_BAR = 4096;
constexpr int CW_LAM = 8192;
constexpr int CW_SS = 16384;
static_assert((CW_SS + 5 * MT) * 4 <= (int)CTL_ZERO_BYTES, "CTL region");
constexpr int RING_OFF = 0, RING_BYTES = 131072;
constexpr int LDSCTL_OFF = RING_BYTES, MISC_OFF = LDSCTL_OFF + 320;
constexpr int LDS_BYTES = 147456;

constexpr int PH_PER_LAYER = 11;
constexpr int NPHASE = 1 + DEPTH * PH_PER_LAYER + 1;
enum { K_G1 = 0, K_LP, K_LR, K_SC, K_CB, K_M1, K_M2, K_WO, K_UP, K_CV, K_DN };

#include <hip/hip_bf16.h>
#include <cmath>
namespace attn_body {
using bf16=__hip_bfloat16;
using bf16x8=__attribute__((ext_vector_type(8)))short;
using s16x4=__attribute__((ext_vector_type(4)))short;
using f32x16=__attribute__((ext_vector_type(16)))float;
using u32x4=__attribute__((ext_vector_type(4)))unsigned;
constexpr int BATCH=8,SEQ=2048,D=64,DM=1024;
constexpr int NW=8,QBLK=32,QB=QBLK*NW,KVBLK=64,NQB=SEQ/QB;
constexpr int ATTN_PITCH=DM, ATTN_UNIT_ROWS=QB;
__device__ __forceinline__ int crow(int r,int hi){return (r&3)+8*(r>>2)+4*hi;}
#define SBAR() __builtin_amdgcn_sched_barrier(0)
__device__ __forceinline__ void cmask(f32x16&p0,f32x16&p1,int jb,int wid){
  const float NEG=-INFINITY;
  if(jb>(wid>>1)){
    #pragma unroll
    for(int r=0;r<16;++r){p0[r]=NEG;p1[r]=NEG;}
  }
}

constexpr int NSLOT=3, SLOTB=8192;
constexpr int LDS_K=0, LDS_V=NSLOT*SLOTB, LDS_WS=2*NSLOT*SLOTB, LDS_OST=LDS_WS+NW*64*4, LDS_BYTES=LDS_OST+NW*4096;
constexpr float C2=0.125f*1.4426950408889634f;
__device__ __forceinline__ void glds16(const void*gsrc,unsigned lds_dst){unsigned keep;
  asm volatile("s_mov_b32 %0, m0\n\ts_mov_b32 m0, %2\n\ts_nop 0\n\tglobal_load_lds_dwordx4 %1, off\n\ts_mov_b32 m0, %0":"=&s"(keep):"v"(gsrc),"s"(lds_dst):"memory");}
__device__ __forceinline__ float max3f(float a,float b,float c){float r;asm("v_max3_f32 %0, %1, %2, %3":"=v"(r):"v"(a),"v"(b),"v"(c));return r;}
__device__ __forceinline__ float max2f(float a,float b){float r;asm("v_max_f32_e32 %0, %1, %2":"=v"(r):"v"(a),"v"(b));return r;}
__device__ __forceinline__ float fadd_s(float a,float b){float r;asm("v_add_f32_e32 %0, %1, %2":"=v"(r):"v"(a),"v"(b));return r;}
__device__ __forceinline__ float fsub_s(float a,float b){float r;asm("v_sub_f32_e32 %0, %1, %2":"=v"(r):"v"(a),"v"(b));return r;}
typedef float f32x2_t __attribute__((ext_vector_type(2))); typedef __bf16 bf16x2_t __attribute__((ext_vector_type(2)));
__device__ __forceinline__ unsigned cvtpk_s(float lo,float hi){f32x2_t v={lo,hi};bf16x2_t b=__builtin_convertvector(v,bf16x2_t);return __builtin_bit_cast(unsigned,b);}
#define WAIT_BAR(N) asm volatile("s_waitcnt vmcnt(" #N ") lgkmcnt(0)\n\ts_barrier":::"memory")

__device__ __forceinline__ void qkt(f32x16&p0,f32x16&p1,const char*Kslot,const bf16x8*qr,const f32x16&negm,int r32,int hi){
  const char*kb=Kslot+hi*1024+r32*16;
  #pragma unroll
  for(int d0=0;d0<4;++d0){
    const bf16x8 b0=*reinterpret_cast<const bf16x8*>(kb+d0*2048);
    const bf16x8 b1=*reinterpret_cast<const bf16x8*>(kb+d0*2048+512);
    if(d0==0){p0=__builtin_amdgcn_mfma_f32_32x32x16_bf16(b0,qr[0],negm,0,0,0);p1=__builtin_amdgcn_mfma_f32_32x32x16_bf16(b1,qr[0],negm,0,0,0);}
    else{p0=__builtin_amdgcn_mfma_f32_32x32x16_bf16(b0,qr[d0],p0,0,0,0);p1=__builtin_amdgcn_mfma_f32_32x32x16_bf16(b1,qr[d0],p1,0,0,0);}}
}
typedef __attribute__((address_space(3))) const char* lds_cptr;
typedef short v4i16_t __attribute__((ext_vector_type(4)));
__device__ __forceinline__ void kload8(bf16x8*kf,lds_cptr kp){
  kf[0]=*(const __attribute__((address_space(3))) bf16x8*)(kp);      kf[1]=*(const __attribute__((address_space(3))) bf16x8*)(kp+512);
  kf[2]=*(const __attribute__((address_space(3))) bf16x8*)(kp+2048); kf[3]=*(const __attribute__((address_space(3))) bf16x8*)(kp+2560);
  kf[4]=*(const __attribute__((address_space(3))) bf16x8*)(kp+4096); kf[5]=*(const __attribute__((address_space(3))) bf16x8*)(kp+4608);
  kf[6]=*(const __attribute__((address_space(3))) bf16x8*)(kp+6144); kf[7]=*(const __attribute__((address_space(3))) bf16x8*)(kp+6656);
}
__device__ __forceinline__ void kload2(bf16x8*kf,lds_cptr kp,int j){ kf[2*j]=*(const __attribute__((address_space(3))) bf16x8*)(kp+j*2048); kf[2*j+1]=*(const __attribute__((address_space(3))) bf16x8*)(kp+j*2048+512); }
__device__ __forceinline__ s16x4 vtr(lds_cptr p){ return __builtin_bit_cast(s16x4,__builtin_amdgcn_ds_read_tr16_b64_v4i16((__attribute__((address_space(3))) v4i16_t*)p)); }
__device__ __forceinline__ float rowmax(const f32x16&p0,const f32x16&p1){
  float a=max3f(p0[0],p0[1],p1[0]),b=max3f(p0[2],p0[3],p1[1]);a=max3f(a,p1[2],p1[3]);
  #pragma unroll
  for(int r=4;r<16;r+=4){a=max3f(a,p0[r],p0[r+1]);b=max3f(b,p0[r+2],p0[r+3]);a=max3f(a,p1[r],p1[r+1]);b=max3f(b,p1[r+2],p1[r+3]);}
  const float m=max2f(a,b);
  auto rr=__builtin_amdgcn_permlane32_swap(__float_as_uint(m),__float_as_uint(m),false,false);
  return max2f(__uint_as_float(rr[0]),__uint_as_float(rr[1]));
}
__device__ __forceinline__ void pv(f32x16*o,int vb,bf16x8 pa0,bf16x8 pa1,bf16x8 pa2,bf16x8 pa3){
  #pragma unroll
  for(int d0=0;d0<2;++d0){s16x4 lo[4],hi[4];
    #pragma unroll
    for(int ks=0;ks<4;++ks){
      asm volatile("ds_read_b64_tr_b16 %0,%1 offset:%c2":"=&v"(lo[ks]):"v"(vb),"i"(d0*4096+ks*1024):"memory");
      asm volatile("ds_read_b64_tr_b16 %0,%1 offset:%c2":"=&v"(hi[ks]):"v"(vb),"i"(d0*4096+ks*1024+512):"memory");}
    asm volatile("s_waitcnt lgkmcnt(0)":::"memory");SBAR();
    #define PK(k) (bf16x8){lo[k][0],lo[k][1],lo[k][2],lo[k][3],hi[k][0],hi[k][1],hi[k][2],hi[k][3]}
    o[d0]=__builtin_amdgcn_mfma_f32_32x32x16_bf16(pa0,PK(0),o[d0],0,0,0);
    o[d0]=__builtin_amdgcn_mfma_f32_32x32x16_bf16(pa1,PK(1),o[d0],0,0,0);
    o[d0]=__builtin_amdgcn_mfma_f32_32x32x16_bf16(pa2,PK(2),o[d0],0,0,0);
    o[d0]=__builtin_amdgcn_mfma_f32_32x32x16_bf16(pa3,PK(3),o[d0],0,0,0);
    #undef PK
  }
}

#ifndef ATTN_STORE16
#define ATTN_STORE16(p,v) (*(u32x4*)(p)=(v))
#endif
template<int THRL> __device__ __forceinline__ void attn_unit(int b,int qcol,int vcol,int qb,const bf16*Q,const bf16*K,const bf16*V,bf16*O,char*shm){
  const int tid=threadIdx.x,lane=tid&63,r32=lane&31,hi=lane>>5; const int wid=__builtin_amdgcn_readfirstlane(tid>>6);
  const long rowbase=(long)b*SEQ; const int q0=qb*QB;
  const bf16*Qw=Q+(rowbase+q0+wid*QBLK)*DM+qcol;
  const bf16*Kh=K+rowbase*DM+qcol,*Vh=V+rowbase*DM+vcol;
  const unsigned lds0=(unsigned)(uintptr_t)shm;
  float*wsf=(float*)(shm+LDS_WS)+wid*64;
  const bf16*ksrc=Kh+(long)lane*DM+wid*8;
  const bf16*vsrc=Vh+(long)(16*(wid&3)+(lane>>2))*DM+(wid>>2)*32+(lane&3)*8;
  const unsigned kdst=lds0+LDS_K+wid*1024, vdst=lds0+LDS_V+wid*1024;
  #define DMA_K(t,slot) glds16(ksrc+(long)(t)*KVBLK*DM,(unsigned)__builtin_amdgcn_readfirstlane(kdst+(slot)))
  #define DMA_V(t,slot) glds16(vsrc+(long)(t)*KVBLK*DM,(unsigned)__builtin_amdgcn_readfirstlane(vdst+(slot)))
  const int vb0=(int)(lds0+LDS_V)+((lane>>4)&1)*32+(lane&3)*8+(4*hi+((lane&15)>>2))*64;
  const char*Kbase=shm+LDS_K; bf16x8 kf[8];
  const lds_cptr shm3=(lds_cptr)shm; const lds_cptr kp0=shm3+LDS_K+hi*1024+r32*16; const lds_cptr vp0=shm3+LDS_V+((lane>>4)&1)*32+(lane&3)*8+(4*hi+((lane&15)>>2))*64;
  const int NT=(q0+QB)/KVBLK;
  DMA_K(0,0);DMA_V(0,0);DMA_K(1,SLOTB);
  bf16x8 qr[4];
  #pragma unroll
  for(int d0=0;d0<4;++d0)qr[d0]=*reinterpret_cast<const bf16x8*>(&Qw[(long)r32*DM+d0*16+hi*8]);
  float mhat=0.f,l_reg=0.f;f32x16 o[2];o[0]=f32x16{};o[1]=f32x16{};const f32x16 zc=f32x16{}; float nm=0.f;
  const int qrel=wid*QBLK+r32;
  #define CMASK(P0,P1,t) do{int jb_=(t)-(NT-4); if(jb_>=0)cmask(P0,P1,jb_,wid);}while(0)
  bool resc=false;
  #define START(P0,P1) do{ const float rm=rowmax(P0,P1); resc=false; \
    { const float dl=rm; mhat=fadd_s(mhat,dl); \
      _Pragma("unroll") for(int r=0;r<16;++r){P0[r]=fsub_s(P0[r],dl);P1[r]=fsub_s(P1[r],dl);} \
      nm=-mhat; } \
    _Pragma("unroll") for(int r=0;r<16;++r)P0[r]=__builtin_amdgcn_exp2f(P0[r]); }while(0)
  #define RESC() do{ if(resc){ asm volatile("s_waitcnt lgkmcnt(0)":::"memory"); \
      _Pragma("unroll") for(int d_=0;d_<2;++d_) _Pragma("unroll") for(int r=0;r<16;++r)o[d_][r]*=wsf[crow(r,hi)]; } }while(0)
  f32x16 pA0,pA1,pB0,pB1;
  int sl_prev=0,sl_cur=0,sl_next=SLOTB;
  #define ROT() do{sl_prev=sl_cur;sl_cur=sl_next;sl_next=(sl_next==(NSLOT-1)*SLOTB)?0:sl_next+SLOTB;}while(0)
  DMA_K(2,2*SLOTB);
  WAIT_BAR(3);
  qkt(pA0,pA1,Kbase,qr,zc,r32,hi);asm volatile("s_nop 15\n\ts_nop 7":"+v"(pA0),"+v"(pA1));CMASK(pA0,pA1,0);
  START(pA0,pA1);
  _Pragma("unroll") for(int r=0;r<16;++r)pA1[r]=__builtin_amdgcn_exp2f(pA1[r]);
  WAIT_BAR(0);
  DMA_K(3,0);DMA_V(1,SLOTB);
  ROT();
  kload8(kf,kp0+sl_cur);
  WAIT_BAR(2);
  s16x4 vlo[8],vhi[8]; u32x4 pw0,pw1,pw2,pw3;
  #define PKW(P,B) cvtpk_s(P[B],P[B+1])
  #define PAF(k) __builtin_bit_cast(bf16x8,pw##k)
  #define VFR(i) (bf16x8){vlo[i][0],vlo[i][1],vlo[i][2],vlo[i][3],vhi[i][0],vhi[i][1],vhi[i][2],vhi[i][3]}
  #define PIN(x) asm volatile("":"+v"(x))
  #define MX3(a,b,c) __builtin_fmaxf(__builtin_fmaxf((a),(b)),(c))
  #define GAPA(MF,A0,A1,A2,A3,W0,W1,PW) do{ MF; sacc+=A0; sacc+=A1; sacc+=A2; sacc+=A3; PIN(sacc); W0; W1; PIN(PW); SBAR(); }while(0)
  #define EX(v) __builtin_amdgcn_exp2f(v)
  #define GAPB(MF,X,B) do{ MF; X[B]=EX(X[B]); X[B+1]=EX(X[B+1]); X[B+2]=EX(X[B+2]); X[B+3]=EX(X[B+3]); PIN(X); SBAR(); }while(0)
  #define VRD(i) do{ vlo[i]=vtr(vp_+(((i)>>2)*4096+((i)&3)*1024)); vhi[i]=vtr(vp_+(((i)>>2)*4096+((i)&3)*1024+512)); }while(0)
  #define KRD(G,j) do{ if(G){ kload2(kf,kp0+sl_next,j); SBAR(); } }while(0)
  #define STEP(C0,C1,P0,P1,t,GK,GV,GL) do{ SBAR(); \
    const lds_cptr vp_=vp0+sl_prev; \
    VRD(0); SBAR(); float sacc=(P0[0]+P0[1]); \
    GAPA(C0=__builtin_amdgcn_mfma_f32_32x32x16_bf16(kf[0],qr[0],zc,0,0,0), P0[2],P0[3],P0[4],P0[5],     pw0[0]=PKW(P0,0), pw0[1]=PKW(P0,2), pw0); \
    VRD(4); SBAR(); GAPA(C1=__builtin_amdgcn_mfma_f32_32x32x16_bf16(kf[1],qr[0],zc,0,0,0), P0[6],P0[7],P0[8],P0[9],     pw0[2]=PKW(P0,4), pw0[3]=PKW(P0,6), pw0); \
    VRD(1); SBAR(); GAPA(C0=__builtin_amdgcn_mfma_f32_32x32x16_bf16(kf[2],qr[1],C0,0,0,0),   P0[10],P0[11],P0[12],P0[13], pw1[0]=PKW(P0,8), pw1[1]=PKW(P0,10), pw1); \
    VRD(5); SBAR(); GAPA(C1=__builtin_amdgcn_mfma_f32_32x32x16_bf16(kf[3],qr[1],C1,0,0,0),   P0[14],P0[15],P1[0],P1[1],   pw1[2]=PKW(P0,12),pw1[3]=PKW(P0,14), pw1); \
    VRD(2); SBAR(); GAPA(C0=__builtin_amdgcn_mfma_f32_32x32x16_bf16(kf[4],qr[2],C0,0,0,0),   P1[2],P1[3],P1[4],P1[5],     pw2[0]=PKW(P1,0), pw2[1]=PKW(P1,2), pw2); \
    VRD(6); SBAR(); GAPA(C1=__builtin_amdgcn_mfma_f32_32x32x16_bf16(kf[5],qr[2],C1,0,0,0),   P1[6],P1[7],P1[8],P1[9],     pw2[2]=PKW(P1,4), pw2[3]=PKW(P1,6), pw2); \
    VRD(3); SBAR(); GAPA(C0=__builtin_amdgcn_mfma_f32_32x32x16_bf16(kf[6],qr[3],C0,0,0,0),   P1[10],P1[11],P1[12],P1[13], pw3[0]=PKW(P1,8), pw3[1]=PKW(P1,10), pw3); \
    VRD(7); SBAR(); GAPA(C1=__builtin_amdgcn_mfma_f32_32x32x16_bf16(kf[7],qr[3],C1,0,0,0),   P1[14],P1[15],0.f,0.f,       pw3[2]=PKW(P1,12),pw3[3]=PKW(P1,14), pw3); \
    l_reg+=sacc; \
    if(GK){DMA_K((t)+3,sl_cur);} if(GV){DMA_V((t)+1,sl_next);} \
    _Pragma("unroll") for(int r=0;r<16;++r){C0[r]+=nm;C1[r]+=nm;} \
    CMASK(C0,C1,t); \
    { float a=MX3(C0[0],C0[1],C1[0]),b=MX3(C0[2],C0[3],C1[1]); a=MX3(a,C1[2],C1[3]); \
      _Pragma("unroll") for(int r=4;r<16;r+=4){a=MX3(a,C0[r],C0[r+1]);b=MX3(b,C0[r+2],C0[r+3]);a=MX3(a,C1[r],C1[r+1]);b=MX3(b,C1[r+2],C1[r+3]);} \
      float rm=__builtin_fmaxf(a,b); { auto rr=__builtin_amdgcn_permlane32_swap(__float_as_uint(rm),__float_as_uint(rm),false,false); rm=__builtin_fmaxf(__uint_as_float(rr[0]),__uint_as_float(rr[1])); } \
      resc=false; \
      if(__builtin_expect(__any(rm>(float)THRL),0)){ const float dl=__builtin_fmaxf(rm,0.f); mhat+=dl; \
        _Pragma("unroll") for(int r=0;r<16;++r){C0[r]-=dl;C1[r]-=dl;} \
        nm=-mhat; \
        const float f=__builtin_amdgcn_exp2f(-dl); l_reg*=f; if(hi==0)wsf[r32]=f; resc=true; } } \
    SBAR(); \
    GAPB(o[0]=__builtin_amdgcn_mfma_f32_32x32x16_bf16(PAF(0),VFR(0),o[0],0,0,0), C0,0); \
    GAPB(o[1]=__builtin_amdgcn_mfma_f32_32x32x16_bf16(PAF(0),VFR(4),o[1],0,0,0), C0,4); \
    KRD(GL,0); GAPB(o[0]=__builtin_amdgcn_mfma_f32_32x32x16_bf16(PAF(1),VFR(1),o[0],0,0,0), C0,8); \
    KRD(GL,1); GAPB(o[1]=__builtin_amdgcn_mfma_f32_32x32x16_bf16(PAF(1),VFR(5),o[1],0,0,0), C0,12); \
    KRD(GL,2); GAPB(o[0]=__builtin_amdgcn_mfma_f32_32x32x16_bf16(PAF(2),VFR(2),o[0],0,0,0), C1,0); \
    KRD(GL,3); GAPB(o[1]=__builtin_amdgcn_mfma_f32_32x32x16_bf16(PAF(2),VFR(6),o[1],0,0,0), C1,4); \
    GAPB(o[0]=__builtin_amdgcn_mfma_f32_32x32x16_bf16(PAF(3),VFR(3),o[0],0,0,0), C1,8); \
    GAPB(o[1]=__builtin_amdgcn_mfma_f32_32x32x16_bf16(PAF(3),VFR(7),o[1],0,0,0), C1,12); \
    }while(0)
  int t=1;
  #undef CMASK
  #define CMASK(P0,P1,t) do{}while(0)
  for(;t+5<NT;t+=2){
    STEP(pB0,pB1,pA0,pA1,t,true,true,true);     WAIT_BAR(2); RESC(); ROT();
    STEP(pA0,pA1,pB0,pB1,t+1,true,true,true);   WAIT_BAR(2); RESC(); ROT();
  }
  #undef CMASK
  #define CMASK(P0,P1,t) do{int jb_=(t)-(NT-4); if(jb_>=0)cmask(P0,P1,jb_,wid);}while(0)
  #define ENDW(tt) do{ if((tt)+3<NT){WAIT_BAR(2);} else if((tt)+2<NT){WAIT_BAR(1);} else {WAIT_BAR(0);} }while(0)
  for(;t+1<NT;t+=2){
    STEP(pB0,pB1,pA0,pA1,t,(t+3<NT),(t+1<NT),(t+1<NT));       ENDW(t);   RESC(); ROT();
    STEP(pA0,pA1,pB0,pB1,t+1,(t+4<NT),(t+2<NT),(t+2<NT));     ENDW(t+1); RESC(); ROT();
  }
  STEP(pB0,pB1,pA0,pA1,NT-1,false,false,false); RESC();
  { float sacc=pB0[0]+pB0[1]; _Pragma("unroll") for(int r=2;r<16;++r)sacc+=pB0[r]; _Pragma("unroll") for(int r=0;r<16;++r)sacc+=pB1[r]; l_reg+=sacc;
    pw0=(u32x4){PKW(pB0,0),PKW(pB0,2),PKW(pB0,4),PKW(pB0,6)};pw1=(u32x4){PKW(pB0,8),PKW(pB0,10),PKW(pB0,12),PKW(pB0,14)};pw2=(u32x4){PKW(pB1,0),PKW(pB1,2),PKW(pB1,4),PKW(pB1,6)};pw3=(u32x4){PKW(pB1,8),PKW(pB1,10),PKW(pB1,12),PKW(pB1,14)};
    SBAR(); pv(o,vb0+sl_cur,PAF(0),PAF(1),PAF(2),PAF(3)); }
  #undef PKW
  #undef PAF
  #undef VFR
  #undef PIN
  #undef MX3
  #undef GAPA
  #undef GAPB
  #undef EX
  #undef VRD
  #undef KRD
  #undef STEP
  #undef ENDW
  {auto rr=__builtin_amdgcn_permlane32_swap(__float_as_uint(l_reg),__float_as_uint(l_reg),false,false);l_reg=__uint_as_float(rr[0])+__uint_as_float(rr[1]);}
  if(hi==0)wsf[32+r32]=l_reg;asm volatile("s_waitcnt lgkmcnt(0)":::"memory");
  float rli[16];
  #pragma unroll
  for(int r=0;r<16;++r)rli[r]=__builtin_amdgcn_rcpf(wsf[32+crow(r,hi)]);
  bf16*Ow=O+(rowbase+q0+wid*QBLK)*DM+vcol;
  { bf16*stg=(bf16*)(shm+LDS_OST)+wid*2048;
    #pragma unroll
    for(int r=0;r<16;++r){const int orow=crow(r,hi);
      #pragma unroll
      for(int d0=0;d0<2;++d0)stg[orow*64+d0*32+r32]=__float2bfloat16(o[d0][r]*rli[r]);}
    asm volatile("s_waitcnt lgkmcnt(0)":::"memory");
    #pragma unroll
    for(int i=0;i<4;++i){const int row=i*8+(lane>>3),ch=lane&7; const u32x4 v=*(const u32x4*)(stg+row*64+ch*8); ATTN_STORE16(Ow+(long)row*DM+ch*8,v);} }
  asm volatile("s_waitcnt lgkmcnt(0)\n\ts_barrier":::"memory");
  #undef DMA_K
  #undef DMA_V
  #undef CMASK
  #undef START
  #undef RESC
  #undef ROT
}
typedef float f32x4 __attribute__((ext_vector_type(4)));
constexpr int SA_K0=0, SA_K1=8192, SA_V0=16384, SA_V1=24576, SA_WS=32768, SA_BYTES=SA_WS+8*256;
__device__ __forceinline__ unsigned pk2bf(float lo,float hi){return cvtpk_s(lo,hi);}
__device__ __forceinline__ void sample_unit(int l,int b,int h,int s,const float*cache_k,const float*cache_v,const bf16*Q,const bf16*K,const bf16*V,float*SP,char*shm){
  const int tid=threadIdx.x,lane=tid&63,r32=lane&31,hi=lane>>5; const int wid=__builtin_amdgcn_readfirstlane(tid>>6);
  const unsigned lds0=(unsigned)(uintptr_t)shm;
  float*wsf=(float*)(shm+SA_WS)+wid*64;
  const int c=wid>>1,vh=wid&1;
  const int qrow=16384+b*32;
  bf16x8 qr[4];
  if(wid<4){
    #pragma unroll
    for(int d0=0;d0<4;++d0)qr[d0]=*reinterpret_cast<const bf16x8*>(&Q[(long)(qrow+r32)*DM+h*128+c*64+d0*16+hi*8]);
  }
  float m=-1e30f,lsum=0.f; f32x16 o[2]; o[0]=f32x16{}; o[1]=f32x16{};
  const f32x16 zc=f32x16{};
  const int ntile=(s==7)?5:4;
  const float*ckb=cache_k+((long)(l*8+b)*2048)*1024+h*128; const float*cvb=cache_v+((long)(l*8+b)*2048)*1024+h*128;
  for(int ti=0;ti<ntile;++ti){
    const bool fresh=(ti==4);
    #pragma unroll
    for(int pi=0;pi<2;++pi){
      const int pk=wid*2+pi;
      { const int kc=pk>>3,ch=pk&7; u32x4 wv;
        if(!fresh){ const float*src=ckb+(long)((4*s+ti)*64+lane)*1024+kc*64+ch*8; const f32x4 a=*(const f32x4*)src,bq=*(const f32x4*)(src+4);
          wv.x=pk2bf(a.x,a.y);wv.y=pk2bf(a.z,a.w);wv.z=pk2bf(bq.x,bq.y);wv.w=pk2bf(bq.z,bq.w); }
        else if(lane<32){ wv=*(const u32x4*)(K+(long)(qrow+lane)*DM+h*128+kc*64+ch*8); }
        else { wv=(u32x4){0u,0u,0u,0u}; }
        *(u32x4*)(shm+(kc?SA_K1:SA_K0)+ch*1024+lane*16)=wv; }
      { const int vv=pk>>3,p=pk&7; const int row=16*(p&3)+(lane>>2),col=vv*64+32*(p>>2)+8*(lane&3); u32x4 wv;
        if(!fresh){ const float*src=cvb+(long)((4*s+ti)*64+row)*1024+col; const f32x4 a=*(const f32x4*)src,bq=*(const f32x4*)(src+4);
          wv.x=pk2bf(a.x,a.y);wv.y=pk2bf(a.z,a.w);wv.z=pk2bf(bq.x,bq.y);wv.w=pk2bf(bq.z,bq.w); }
        else if(row<32){ wv=*(const u32x4*)(V+(long)(qrow+row)*DM+h*128+col); }
        else { wv=(u32x4){0u,0u,0u,0u}; }
        *(u32x4*)(shm+(vv?SA_V1:SA_V0)+p*1024+lane*16)=wv; }
    }
    __syncthreads();
    if(wid<4){
      f32x16 p0,p1;
      qkt(p0,p1,shm+(c?SA_K1:SA_K0),qr,zc,r32,hi);
      if(fresh){
        #pragma unroll
        for(int r=0;r<16;++r)p1[r]=-INFINITY;
      }
      float rm=p0[0];
      #pragma unroll
      for(int r=1;r<16;++r)rm=__builtin_fmaxf(rm,p0[r]);
      #pragma unroll
      for(int r=0;r<16;++r)rm=__builtin_fmaxf(rm,p1[r]);
      rm=__builtin_fmaxf(rm,__shfl_xor(rm,32));
      const float mn=__builtin_fmaxf(m,rm),alpha=__builtin_amdgcn_exp2f(m-mn);
      float ps=0.f;
      #pragma unroll
      for(int r=0;r<16;++r){p0[r]=__builtin_amdgcn_exp2f(p0[r]-mn);p1[r]=__builtin_amdgcn_exp2f(p1[r]-mn);ps+=p0[r]+p1[r];}
      lsum=lsum*alpha+ps; m=mn;
      if(hi==0)wsf[r32]=alpha;
      asm volatile("s_waitcnt lgkmcnt(0)":::"memory");
      #pragma unroll
      for(int g=0;g<4;++g){ const f32x4 f4=*(const f32x4*)(wsf+8*g+4*hi);
        #pragma unroll
        for(int i=0;i<4;++i){o[0][4*g+i]*=f4[i];o[1][4*g+i]*=f4[i];} }
      u32x4 pw0,pw1,pw2,pw3;
      pw0=(u32x4){pk2bf(p0[0],p0[1]),pk2bf(p0[2],p0[3]),pk2bf(p0[4],p0[5]),pk2bf(p0[6],p0[7])};
      pw1=(u32x4){pk2bf(p0[8],p0[9]),pk2bf(p0[10],p0[11]),pk2bf(p0[12],p0[13]),pk2bf(p0[14],p0[15])};
      pw2=(u32x4){pk2bf(p1[0],p1[1]),pk2bf(p1[2],p1[3]),pk2bf(p1[4],p1[5]),pk2bf(p1[6],p1[7])};
      pw3=(u32x4){pk2bf(p1[8],p1[9]),pk2bf(p1[10],p1[11]),pk2bf(p1[12],p1[13]),pk2bf(p1[14],p1[15])};
      const int vb=(int)(lds0+(vh?SA_V1:SA_V0))+((lane>>4)&1)*32+(lane&3)*8+(4*hi+((lane&15)>>2))*64;
      pv(o,vb,__builtin_bit_cast(bf16x8,pw0),__builtin_bit_cast(bf16x8,pw1),__builtin_bit_cast(bf16x8,pw2),__builtin_bit_cast(bf16x8,pw3));
    }
    __syncthreads();
  }
  if(wid<4){
    lsum+=__shfl_xor(lsum,32);
    float*sp=SP+((long)(((b*8+h)*2+c)*8+s)*32)*132;
    if(vh==0&&hi==0){sp[r32*132]=m;sp[r32*132+1]=lsum;}
    #pragma unroll
    for(int d0=0;d0<2;++d0)
      #pragma unroll
      for(int r=0;r<16;++r)sp[crow(r,hi)*132+4+vh*64+32*d0+r32]=o[d0][r];
  }
}
constexpr int ATTN_LDS_BYTES=LDS_BYTES;
#undef SBAR
#undef WAIT_BAR
}

#define GAS __attribute__((address_space(1)))
#define LAS __attribute__((address_space(3)))
typedef unsigned short bf16;
typedef unsigned v4u __attribute__((ext_vector_type(4)));
typedef float f32x4 __attribute__((ext_vector_type(4)));
typedef short bf16x8 __attribute__((ext_vector_type(8)));
typedef GAS unsigned gu32;
typedef GAS unsigned long long gu64;
#define RLX_AGENT __ATOMIC_RELAXED, __HIP_MEMORY_SCOPE_AGENT
#define LDS_WAIT() asm volatile("s_waitcnt lgkmcnt(0)" ::: "memory")
#define VM_WAIT() asm volatile("s_waitcnt vmcnt(0)" ::: "memory")
__device__ __forceinline__ unsigned long long rt() { return __builtin_amdgcn_s_memrealtime(); }
__device__ __forceinline__ unsigned f2bf(float f) { unsigned u = __builtin_bit_cast(unsigned, f); return (u + 0x7fffu + ((u >> 16) & 1u)) >> 16; }
__device__ __forceinline__ unsigned pk2(float lo, float hi) { return f2bf(lo) | (f2bf(hi) << 16); }

#define XB_TMO      128
#define XB_XCNT(j)  (256  + 64 * (j))
#define XB_XSUB(j)  (1280 + 64 * (j))
#define XB_XGEN(j)  (2304 + 64 * (j))
#define XB_TOP      3328
#define XB_TOPGEN   3392
#define XCD_BAR_WORDS 3456
#define XB_SPIN_CAP (1u << 22)

__device__ __forceinline__ unsigned xb_ld(unsigned* p)              { return __hip_atomic_load(p, __ATOMIC_RELAXED, __HIP_MEMORY_SCOPE_AGENT); }
__device__ __forceinline__ unsigned xb_add(unsigned* p, unsigned v) { return __hip_atomic_fetch_add(p, v, __ATOMIC_RELAXED, __HIP_MEMORY_SCOPE_AGENT); }
__device__ __forceinline__ unsigned xb_xcc_id() { return (unsigned)__builtin_amdgcn_s_getreg((3 << 11) | 20) & 0xFu; }
#define XB_SPIN(cond, bar) do { unsigned _sp = 0; while (cond) { __builtin_amdgcn_s_sleep(1); \
    if ((++_sp & 255u) == 0u) { if (xb_ld(&(bar)[XB_TMO])) break; if (_sp > XB_SPIN_CAP) { atomicAdd(&(bar)[XB_TMO], 1u); break; } } } } while (0)

struct XcdBarrier {
    unsigned* bar; unsigned x;
    volatile LAS unsigned* st;
};

__device__ __forceinline__ XcdBarrier xcd_barrier_post(unsigned* bar, volatile LAS unsigned* st) {
    XcdBarrier b; b.bar = bar; b.x = xb_xcc_id(); b.st = st;
    if (threadIdx.x == 0) (void)xb_add(&bar[XB_XCNT(b.x)], 1u);
    return b;
}
__device__ __forceinline__ void xcd_barrier_complete(unsigned* bar, unsigned x, unsigned& nloc, unsigned& nx) {
    const unsigned G = gridDim.x * gridDim.y * gridDim.z;
    unsigned sum, cnt, mine, sp = 0u;
    for (;;) {
        sum = 0u; cnt = 0u; mine = 0u;
#pragma unroll
        for (unsigned j = 0; j < 16; ++j) { const unsigned c = xb_ld(&bar[XB_XCNT(j)]); sum += c; cnt += (c > 0u) ? 1u : 0u; mine = (j == x) ? c : mine; }
        if (sum == G) break;
        __builtin_amdgcn_s_sleep(1);
        if ((++sp & 255u) == 0u) { if (xb_ld(&bar[XB_TMO])) break; if (sp > XB_SPIN_CAP) { atomicAdd(&bar[XB_TMO], 1u); break; } }
    }
    nloc = mine > 0u ? mine : 1u; nx = cnt > 0u ? cnt : 1u;
}

__device__ __forceinline__ void xcd_barrier(const XcdBarrier& b) {
    asm volatile("s_waitcnt vmcnt(0)" ::: "memory");
    __syncthreads();
    if (threadIdx.x == 0) {
        unsigned* bar = b.bar;
        __builtin_amdgcn_s_waitcnt(0);
        unsigned nloc = b.st[0], nx = b.st[1];
        if (nloc == 0u) { xcd_barrier_complete(bar, b.x, nloc, nx); b.st[0] = nloc; b.st[1] = nx; }
        const unsigned old = xb_add(&bar[XB_XSUB(b.x)], 1u);
        const unsigned gen = old / nloc;
        if (old + 1u == (gen + 1u) * nloc) {
            __builtin_amdgcn_fence(__ATOMIC_RELEASE, "agent");
            asm volatile("s_waitcnt vmcnt(0)" ::: "memory");
            const unsigned og = xb_add(&bar[XB_TOP], 1u);
            const unsigned tg = og / nx;
            if (og + 1u == (tg + 1u) * nx) xb_add(&bar[XB_TOPGEN], 1u);
            else XB_SPIN(xb_ld(&bar[XB_TOPGEN]) == tg, bar);
            __builtin_amdgcn_fence(__ATOMIC_ACQUIRE, "agent");
            xb_add(&bar[XB_XGEN(b.x)], 1u);
            asm volatile("s_waitcnt vmcnt(0)" ::: "memory");
        } else {
            XB_SPIN(xb_ld(&bar[XB_XGEN(b.x)]) == gen, bar);
            __builtin_amdgcn_fence(__ATOMIC_ACQUIRE, "agent");
            asm volatile("s_waitcnt vmcnt(0)" ::: "memory");
        }
    }
    __syncthreads();
}

struct Args { const GAS float* in[31]; GAS float* out; GAS unsigned char* ws; float rinv[8]; int ph_lo, ph_hi; };
#define GIN(A, i) ((const float*)((A)->in[i]))
typedef const Args __attribute__((address_space(4)))* CArgsP;
struct Frame {
    LAS unsigned char* lds;
    volatile LAS unsigned* MISC;
    gu32* ctl;
    int tid, lane, wave, vcu, G;
    float* out; unsigned char* ws;
};
__device__ __forceinline__ float wave_sum(float v) {
#pragma unroll
    for (int o = 1; o < 64; o <<= 1) v += __shfl_xor(v, o);
    return v;
}
template <int CTRL> __device__ __forceinline__ float dppf(float x) { return __builtin_bit_cast(float, __builtin_amdgcn_update_dpp(0, __builtin_bit_cast(int, x), CTRL, 0xF, 0xF, false)); }
__device__ __forceinline__ float reduce8(float x) { x += dppf<0xB1>(x); x += dppf<0x4E>(x); x += dppf<0x141>(x); return x; }
__device__ __forceinline__ float reduce16(float x) { x = reduce8(x); x += dppf<0x140>(x); return x; }
__device__ __forceinline__ float bf2f(bf16 h) { return __uint_as_float((unsigned)h << 16); }
__device__ __forceinline__ float bflo(unsigned w) { return __uint_as_float(w << 16); }
__device__ __forceinline__ float bfhi(unsigned w) { return __uint_as_float(w & 0xffff0000u); }

__device__ __forceinline__ void p0_transpose_item(const float* W, int N, bf16* WT, int ldk, int koff, int row_off, const float* kscale, LAS float* scr, int item, int lane) {
    const int nblk = N / 32, kb = item / nblk, nb = item % nblk, k0 = 64 * kb, n0 = 32 * nb;
    float wv[32];
#pragma unroll
    for (int i = 0; i < 32; ++i) wv[i] = W[(size_t)(k0 + 2 * i + (lane >> 5)) * N + n0 + (lane & 31)];
#pragma unroll
    for (int i = 0; i < 32; ++i) { const int kk = 2 * i + (lane >> 5); float w = wv[i]; if (kscale) w *= kscale[k0 + kk]; scr[kk * 33 + (lane & 31)] = w; }
    LDS_WAIT(); asm volatile("" ::: "memory");
    const int c = lane & 7;
#pragma unroll
    for (int j = 0; j < 4; ++j) { const int n = (lane >> 3) + 8 * j; const LAS float* s = scr + (8 * c) * 33 + n;
        v4u o; o.x = pk2(s[0 * 33], s[1 * 33]); o.y = pk2(s[2 * 33], s[3 * 33]); o.z = pk2(s[4 * 33], s[5 * 33]); o.w = pk2(s[6 * 33], s[7 * 33]);
        *(GAS v4u*)(WT + (size_t)(row_off + n0 + n) * ldk + koff + k0 + 8 * c) = o; }
    LDS_WAIT(); asm volatile("" ::: "memory");
}
constexpr int WP_IN = 1, WP_SQ = 2, WP_UP = 4, WP_DN = 8, WP_LORA = 16, WP_ALL = 31;
__device__ __forceinline__ void p0_weights(Frame& F, CArgsP A, int l, int gw, int NGW, const int part) {
    LAS float* scr = (LAS float*)(F.lds + RING_OFF + F.wave * 16384);
    constexpr int I_IN = (1024 / 64) * (P_TOTAL / 32), I_SQ = (1024 / 64) * (1024 / 32), I_UP = (1024 / 64) * (UPW / 32), I_DN = (D_FF / 64) * (1024 / 32),
                  I_W2 = 1 * (1024 / 32), I_G2 = 2 * (1024 / 32);
    unsigned char* wl = F.ws + WS_W;
    int base = 0;
#define WITEMS(NI, CALL) do { int it = (gw - base) % NGW; if (it < 0) it += NGW; for (; it < (NI); it += NGW) { const int r = it; CALL; } base += (NI); } while (0)
    if (part & WP_IN) WITEMS(I_IN, p0_transpose_item(GIN(A, 8) + (size_t)l * 1024 * P_TOTAL, P_TOTAL, (bf16*)(wl + W_IN), 1024, 0, 0, GIN(A, 7) + l * 1024, scr, r, F.lane));
    if (part & WP_SQ) {
        WITEMS(I_SQ, p0_transpose_item(GIN(A, 11) + (size_t)l * 1024 * 1024, 1024, (bf16*)(wl + W_ODA), 1024, 0, 0, nullptr, scr, r, F.lane));
        WITEMS(I_SQ, p0_transpose_item(GIN(A, 23) + (size_t)l * 1024 * 1024, 1024, (bf16*)(wl + W_ORW), 1024, 0, 0, nullptr, scr, r, F.lane));
        WITEMS(I_SQ, p0_transpose_item(GIN(A, 24) + (size_t)l * 1024 * 1024, 1024, (bf16*)(wl + W_OUT), 1024, 0, 0, nullptr, scr, r, F.lane));
    }
    if (part & WP_UP) WITEMS(I_UP, p0_transpose_item(GIN(A, 26) + (size_t)l * 1024 * UPW, UPW, (bf16*)(wl + (l ? W_UP1 : W_UP)), 1024, 0, 0, GIN(A, 25) + l * 1024, scr, r, F.lane));
    if (part & WP_DN) WITEMS(I_DN, p0_transpose_item(GIN(A, 29) + (size_t)l * D_FF * 1024, 1024, (bf16*)(l ? F.ws + WS_DN1 : wl + W_DN), D_FF, 0, 0, nullptr, scr, r, F.lane));
    if (part & WP_LORA) {
        WITEMS(I_W2, p0_transpose_item(GIN(A, 14) + (size_t)l * 64 * 1024, 1024, (bf16*)(wl + W_LORA), 256, 0, 0, nullptr, scr, r, F.lane));
        WITEMS(I_W2, p0_transpose_item(GIN(A, 16) + (size_t)l * 64 * 1024, 1024, (bf16*)(wl + W_LORA), 256, 64, 1024, nullptr, scr, r, F.lane));
        WITEMS(I_G2, p0_transpose_item(GIN(A, 17) + (size_t)l * 128 * 1024, 1024, (bf16*)(wl + W_LORA), 256, 128, 2048, nullptr, scr, r, F.lane));
        for (int i = gw * 64 + F.lane; i < 3072 * 32; i += NGW * 64) {
            const int n = i >> 5, kc = i & 31, blk = n >> 10;
            const bool nz = (blk == 0) ? (kc < 8) : (blk == 1) ? (kc >= 8 && kc < 16) : (kc >= 16);
            if (!nz) *(GAS v4u*)(wl + W_LORA + ((size_t)n * 256 + kc * 8) * 2) = (v4u){0u, 0u, 0u, 0u};
        }
    }
#undef WITEMS
}
__device__ __forceinline__ void p0_prologue(Frame& F, CArgsP A) {
    const int gw = F.vcu * NWAVES + F.wave, NGW = F.G * NWAVES;
    p0_weights(F, A, 0, gw, NGW, WP_ALL);
    {
        const int gt = gw * 64 + F.lane, NGT = NGW * 64;
        float* rope = (float*)(F.ws + WS_ROPE);
        for (int i = gt; i < NKEYS_S * 8; i += NGT) {
            const int pos = i >> 3, k = i & 7;
            const float ang = (float)pos * A->rinv[k];
            const float kq = rintf(ang * 0.15915494309189535f);
            float r = fmaf(-kq, 6.2831854820251465f, ang); r = fmaf(-kq, -1.7484555314695172e-7f, r);
            const float rev = r * 0.15915494309189535f;
            rope[pos * 16 + k] = __builtin_amdgcn_cosf(rev); rope[pos * 16 + 8 + k] = __builtin_amdgcn_sinf(rev);
        }
    }
    {
        float* X = F.out + O_YP; bf16* XB = (bf16*)(F.ws + WS_XB); float* SS = (float*)(F.ctl + CW_SS);
        for (int m = gw; m < MT; m += NGW) {
            const float* src = (m < MP) ? GIN(A, 0) + (size_t)m * 1024 : GIN(A, 1) + (size_t)(m - MP) * 1024;
            const GAS f32x4* xr = (const GAS f32x4*)src + F.lane;
            GAS f32x4* xo = (GAS f32x4*)(X + (size_t)m * 1024) + F.lane;
            GAS unsigned long long* o8 = (GAS unsigned long long*)(XB + (size_t)m * 1024) + F.lane;
            float s = 0.f;
#pragma unroll
            for (int j = 0; j < 4; ++j) { const f32x4 v = xr[64 * j]; s += (v.x * v.x + v.y * v.y) + (v.z * v.z + v.w * v.w); xo[64 * j] = v;
                o8[64 * j] = (unsigned long long)pk2(v.x, v.y) | ((unsigned long long)pk2(v.z, v.w) << 32); }
            s = wave_sum(s);
            if (F.lane == 0) SS[m] = s;
        }
    }
    if (gw < DEPTH) {
        const int l = gw; const float* lp = GIN(A, 9) + (size_t)l * 256;
        const float s1 = wave_sum(lp[F.lane] * lp[64 + F.lane]), s2 = wave_sum(lp[128 + F.lane] * lp[192 + F.lane]);
        if (F.lane == 0) ((float*)(F.ctl + CW_LAM))[l] = expf(s1) - expf(s2) + (0.8f - 0.6f * expf(-0.3f * (float)l));
    }
}

__device__ __forceinline__ void ph_attn(Frame& F, CArgsP A, int l, const int a0, const int na) {
    const attn_body::bf16* Q = (const attn_body::bf16*)(F.ws + B_Q); const attn_body::bf16* K = (const attn_body::bf16*)(F.ws + B_K); const attn_body::bf16* V = (const attn_body::bf16*)(F.ws + B_V);
    for (int u = a0; u < 256; u += na) {
        const int b = u >> 5, hv = u & 31, h = hv >> 2, c = (hv >> 1) & 1, vh = hv & 1;
        attn_body::bf16* O = (attn_body::bf16*)(F.ws + B_OC) + (size_t)c * MT * 1024;
        for (int qb = 7; qb >= 0; --qb) attn_body::attn_unit<8>(b, h * 128 + c * 64, h * 128 + vh * 64, qb, Q, K, V, O, (char*)F.lds + RING_OFF);
    }
    { int tv = threadIdx.x; asm volatile("" : "+v"(tv)); F.tid = tv; F.lane = tv & 63; F.wave = __builtin_amdgcn_readfirstlane(tv >> 6); }
    for (int u = a0; u < 512; u += na) attn_body::sample_unit(l, u >> 6, (u >> 3) & 7, u & 7, GIN(A, 2), GIN(A, 3), Q, K, V, (float*)(F.ws + WS_SP), (char*)F.lds + RING_OFF);
}

__device__ __forceinline__ void ph_linprep(Frame& F, CArgsP A, int l) {
    const int gw = F.vcu * NWAVES + F.wave, NGW = F.G * NWAVES;
    const bf16* URW = (const bf16*)(F.ws + B_URW); bf16* LIN = (bf16*)(F.ws + B_LIN);
    const float* mu = GIN(A, 12) + (size_t)l * P_RW + 3072 + 4 * F.lane;
    const float mu0 = mu[0], mu1 = mu[1], mu2 = mu[2], mu3 = mu[3];
    for (int row = gw; row < MT; row += NGW) {
        const bool smp = row >= MP; const int t = smp ? ((row - MP) & 31) : (row & 2047);
        const unsigned long long cw = *(const unsigned long long*)(URW + (size_t)row * P_RW + 3072 + 4 * F.lane);
        float u[4] = {bflo((unsigned)cw), bfhi((unsigned)cw), bflo((unsigned)(cw >> 32)), bfhi((unsigned)(cw >> 32))};
        float p[4];
        if (t > 0) { const unsigned long long pw = *(const unsigned long long*)(URW + (size_t)(row - 1) * P_RW + 3072 + 4 * F.lane);
            p[0] = bflo((unsigned)pw); p[1] = bfhi((unsigned)pw); p[2] = bflo((unsigned)(pw >> 32)); p[3] = bfhi((unsigned)(pw >> 32)); }
        else if (smp) { const float* s0 = GIN(A, 5) + ((size_t)(l * DEC_BATCH) + ((row - MP) >> 5)) * P_RW + 3072 + 4 * F.lane; p[0] = s0[0]; p[1] = s0[1]; p[2] = s0[2]; p[3] = s0[3]; }
        else { p[0] = p[1] = p[2] = p[3] = 0.f; }
        u[0] += (p[0] - u[0]) * mu0; u[1] += (p[1] - u[1]) * mu1; u[2] += (p[2] - u[2]) * mu2; u[3] += (p[3] - u[3]) * mu3;
        if (F.lane < 16) { u[0] = tanhf(u[0]); u[1] = tanhf(u[1]); u[2] = tanhf(u[2]); u[3] = tanhf(u[3]); }
        else if (F.lane >= 32) { u[0] = 1.f / (1.f + expf(-u[0])); u[1] = 1.f / (1.f + expf(-u[1])); u[2] = 1.f / (1.f + expf(-u[2])); u[3] = 1.f / (1.f + expf(-u[3])); }
        *(unsigned long long*)(LIN + (size_t)row * 256 + 4 * F.lane) = (unsigned long long)pk2(u[0], u[1]) | ((unsigned long long)pk2(u[2], u[3]) << 32);
    }
}

__device__ __forceinline__ void ph_combine(Frame& F, CArgsP A, int l) {
    const int gw = F.vcu * NWAVES + F.wave, NGW = F.G * NWAVES;
    const float lam = ((const float*)(F.ctl + CW_LAM))[l], lam_init = 0.8f - 0.6f * expf(-0.3f * (float)l);
    const bf16* OC0 = (const bf16*)(F.ws + B_OC); const bf16* OC1 = OC0 + (size_t)MT * 1024;
    bf16* OA = (bf16*)(F.ws + B_OA);
    const float* subln = GIN(A, 10) + l * 128;
    const float g0 = subln[2 * F.lane], g1 = subln[2 * F.lane + 1];
    {
        const int gt = gw * 64 + F.lane, NGT = NGW * 64;
        const float sc = 1.f - lam_init;
        for (int i = gt; i < MP * 128; i += NGT) {
            const size_t off = (size_t)(i >> 4) * 128 + (i & 15) * 8;
            const v4u w0 = *(const v4u*)(OC0 + off), w1 = *(const v4u*)(OC1 + off);
            float a[8];
            a[0] = bflo(w0.x) - lam * bflo(w1.x); a[1] = bfhi(w0.x) - lam * bfhi(w1.x); a[2] = bflo(w0.y) - lam * bflo(w1.y); a[3] = bfhi(w0.y) - lam * bfhi(w1.y);
            a[4] = bflo(w0.z) - lam * bflo(w1.z); a[5] = bfhi(w0.z) - lam * bfhi(w1.z); a[6] = bflo(w0.w) - lam * bflo(w1.w); a[7] = bfhi(w0.w) - lam * bfhi(w1.w);
            float ss = (a[0] * a[0] + a[1] * a[1]) + (a[2] * a[2] + a[3] * a[3]) + (a[4] * a[4] + a[5] * a[5]) + (a[6] * a[6] + a[7] * a[7]);
            ss = reduce16(ss);
            const float r = (1.0f / sqrtf(ss * (1.0f / 128.f) + EPS)) * sc;
            const f32x4 s0 = *(const f32x4*)(subln + (i & 15) * 8), s1 = *(const f32x4*)(subln + (i & 15) * 8 + 4);
            v4u o; o.x = pk2(a[0] * r * s0.x, a[1] * r * s0.y); o.y = pk2(a[2] * r * s0.z, a[3] * r * s0.w); o.z = pk2(a[4] * r * s1.x, a[5] * r * s1.y); o.w = pk2(a[6] * r * s1.z, a[7] * r * s1.w);
            *(v4u*)(OA + off) = o;
        }
    }
    for (int it = MP * 8 + gw; it < MT * 8; it += NGW) {
        const int row = it >> 3, h = it & 7;
        float a0, a1;
        {
            const int b = (row - MP) >> 5, qi = (row - MP) & 31;
            float oc[2][2];
#pragma unroll
            for (int c = 0; c < 2; ++c) {
                const float* sp = (const float*)(F.ws + WS_SP) + ((size_t)(((b * 8 + h) * 2 + c) * 8) * 32 + qi) * 132;
                float mx = -1e30f;
#pragma unroll
                for (int s = 0; s < 8; ++s) mx = fmaxf(mx, sp[(size_t)s * 32 * 132]);
                float L = 0.f, x0 = 0.f, x1 = 0.f;
#pragma unroll
                for (int s = 0; s < 8; ++s) { const float* p = sp + (size_t)s * 32 * 132; const float w = exp2f(p[0] - mx); L += w * p[1]; x0 += w * p[4 + 2 * F.lane]; x1 += w * p[4 + 2 * F.lane + 1]; }
                oc[c][0] = x0 / L; oc[c][1] = x1 / L;
            }
            a0 = oc[0][0] - lam * oc[1][0]; a1 = oc[0][1] - lam * oc[1][1];
        }
        const float ss = wave_sum(a0 * a0 + a1 * a1);
        const float r = (1.0f / sqrtf(ss * (1.0f / 128.f) + EPS)) * (1.f - lam_init);
        *(unsigned*)(OA + (size_t)row * 1024 + h * 128 + 2 * F.lane) = pk2(a0 * r * g0, a1 * r * g1);
    }
}

typedef float f32x2 __attribute__((ext_vector_type(2)));
constexpr int SC_C = 32;
constexpr int SC_OPB = 0, SC_OPB_SZ = SC_C * 1280;
constexpr int SC_VB = 2 * SC_OPB_SZ, SC_VB_SZ = SC_C * 256;
constexpr int SC_YB = SC_VB + 3 * SC_VB_SZ, SC_YB_SZ = SC_C * 256;
constexpr int SC_BON = SC_YB + 2 * SC_YB_SZ;
static_assert(SC_BON + 3 * SC_C * 4 <= RING_BYTES, "scan LDS");

__device__ __forceinline__ void unpack4(unsigned long long w, float (&o)[4]) { o[0] = bflo((unsigned)w); o[1] = bfhi((unsigned)w); o[2] = bflo((unsigned)(w >> 32)); o[3] = bfhi((unsigned)(w >> 32)); }

__device__ __forceinline__ void scan_fast(Frame& F, CArgsP A, int l, int item) {
    const bool smp = item >= 128; const int bh = item & 127, b = bh >> 4, h = bh & 15;
    const int T = smp ? DEC_SEQ : SEQ, row0 = smp ? MP + b * DEC_SEQ : b * SEQ, nch = T / SC_C;
    const int tid = F.tid, lane = F.lane, w = F.wave;
    const int rho = lane >> 3, kq = lane & 7, r0 = (w & 3) * 16 + rho, r1 = r0 + 8;
    const int pt = tid - 256;
    const int cq = pt & 15, c = h * 64 + 4 * cq;
    const bf16* URW = (const bf16*)(F.ws + B_URW); const bf16* LD = (const bf16*)(F.ws + B_LD); const bf16* LA = (const bf16*)(F.ws + B_LA); const bf16* LG = (const bf16*)(F.ws + B_LG);
    bf16* ORW = (bf16*)(F.ws + B_ORW);
    LAS unsigned char* L = F.lds + RING_OFF;
    f32x2 S2[2][4];
    float mu_r[4], mu_k[4], mu_v[4], k_k[4], k_a[4], r_k[4], ln_w[4], ln_b[4];
    if (w < 4) {
        if (smp) {
#pragma unroll
            for (int q = 0; q < 2; ++q) { const float* s0 = GIN(A, 4) + (((size_t)(l * 8 + b) * 16 + h) * 64 + (q ? r1 : r0)) * 64 + 8 * kq; const f32x4 a0 = *(const f32x4*)s0, a1 = *(const f32x4*)(s0 + 4);
                S2[q][0] = (f32x2){a0.x, a0.y}; S2[q][1] = (f32x2){a0.z, a0.w}; S2[q][2] = (f32x2){a1.x, a1.y}; S2[q][3] = (f32x2){a1.z, a1.w}; } }
        else {
#pragma unroll
            for (int j = 0; j < 4; ++j) { S2[0][j] = (f32x2){0.f, 0.f}; S2[1][j] = (f32x2){0.f, 0.f}; } }
    } else {
        const float* mu = GIN(A, 12) + (size_t)l * P_RW;
#pragma unroll
        for (int j = 0; j < 4; ++j) { mu_r[j] = mu[c + j]; mu_k[j] = mu[1024 + c + j]; mu_v[j] = mu[2048 + c + j]; k_k[j] = GIN(A, 18)[l * 1024 + c + j]; k_a[j] = GIN(A, 19)[l * 1024 + c + j]; r_k[j] = GIN(A, 20)[l * 1024 + c + j];
            ln_w[j] = GIN(A, 21)[l * 1024 + c + j]; ln_b[j] = GIN(A, 22)[l * 1024 + c + j]; }
    }
#define SC_PREP(ch) do { LAS unsigned char* opb_ = L + SC_OPB + ((ch) & 1) * SC_OPB_SZ; LAS float* vb_ = (LAS float*)(L + SC_VB + ((ch) % 3) * SC_VB_SZ); LAS float* bonb_ = (LAS float*)(L + SC_BON) + ((ch) % 3) * SC_C; \
        _Pragma("unroll") for (int rep_ = 0; rep_ < 2; ++rep_) { const int tp = (pt >> 4) + 16 * rep_; const int tseq = (ch) * SC_C + tp; \
            const size_t r_ = (size_t)(row0 + tseq); const bf16* u_ = URW + r_ * P_RW + c; \
            float ur[4], uk[4], uv[4], pr[4], pk[4], pv[4], ld[4], la[4]; \
            unpack4(*(const unsigned long long*)(u_), ur); unpack4(*(const unsigned long long*)(u_ + 1024), uk); unpack4(*(const unsigned long long*)(u_ + 2048), uv); \
            unpack4(*(const unsigned long long*)(LD + r_ * 1024 + c), ld); unpack4(*(const unsigned long long*)(LA + r_ * 1024 + c), la); \
            if (tseq > 0) { unpack4(*(const unsigned long long*)(u_ - P_RW), pr); unpack4(*(const unsigned long long*)(u_ - P_RW + 1024), pk); unpack4(*(const unsigned long long*)(u_ - P_RW + 2048), pv); } \
            else if (smp) { const float* s0 = GIN(A, 5) + (size_t)(l * 8 + b) * P_RW + c; _Pragma("unroll") for (int j = 0; j < 4; ++j) { pr[j] = s0[j]; pk[j] = s0[1024 + j]; pv[j] = s0[2048 + j]; } } \
            else { _Pragma("unroll") for (int j = 0; j < 4; ++j) { pr[j] = 0.f; pk[j] = 0.f; pv[j] = 0.f; } } \
            float r[4], kr[4], vr[4], kk[4], km[4], wd[4], ssq = 0.f, bon = 0.f; \
            _Pragma("unroll") for (int j = 0; j < 4; ++j) { \
                r[j] = ur[j] + (pr[j] - ur[j]) * mu_r[j]; kr[j] = uk[j] + (pk[j] - uk[j]) * mu_k[j]; vr[j] = uv[j] + (pv[j] - uv[j]) * mu_v[j]; \
                wd[j] = __builtin_amdgcn_exp2f(1.4426950408889634f * ld[j]); \
                kk[j] = kr[j] * k_k[j]; ssq += kk[j] * kk[j]; km[j] = kr[j] * (1.f + (la[j] - 1.f) * k_a[j]); bon += r[j] * km[j] * r_k[j]; } \
            ssq = reduce16(ssq); bon = reduce16(bon); \
            const float inv = __builtin_amdgcn_rsqf(fmaxf(ssq, 1e-24f)); \
            LAS float* op = (LAS float*)(opb_ + tp * 1280) + 4 * cq; \
            *(LAS f32x4*)(op) = (f32x4){wd[0], wd[1], wd[2], wd[3]}; \
            *(LAS f32x4*)(op + 64) = (f32x4){kk[0] * inv, kk[1] * inv, kk[2] * inv, kk[3] * inv}; \
            *(LAS f32x4*)(op + 128) = (f32x4){kk[0] * inv * la[0], kk[1] * inv * la[1], kk[2] * inv * la[2], kk[3] * inv * la[3]}; \
            *(LAS f32x4*)(op + 192) = (f32x4){km[0], km[1], km[2], km[3]}; \
            *(LAS f32x4*)(op + 256) = (f32x4){r[0], r[1], r[2], r[3]}; \
            *(LAS f32x4*)(vb_ + tp * 64 + 4 * cq) = (f32x4){vr[0], vr[1], vr[2], vr[3]}; \
            if (cq == 0) bonb_[tp] = bon; } } while (0)
#define SC_POST(ch) do { const LAS float* yb_ = (const LAS float*)(L + SC_YB + ((ch) & 1) * SC_YB_SZ); const LAS float* vb_ = (const LAS float*)(L + SC_VB + ((ch) % 3) * SC_VB_SZ); const LAS float* bonb_ = (const LAS float*)(L + SC_BON) + ((ch) % 3) * SC_C; \
        _Pragma("unroll") for (int rep_ = 0; rep_ < 2; ++rep_) { const int tp = (pt >> 4) + 16 * rep_; const size_t r_ = (size_t)(row0 + (ch) * SC_C + tp); \
            const f32x4 y4 = *(const LAS f32x4*)(yb_ + tp * 64 + 4 * cq); const f32x4 v4 = *(const LAS f32x4*)(vb_ + tp * 64 + 4 * cq); const float bon = bonb_[tp]; \
            float gg[4]; unpack4(*(const unsigned long long*)(LG + r_ * 1024 + c), gg); \
            const float mean = reduce16((y4.x + y4.y) + (y4.z + y4.w)) * (1.f / 64.f); \
            const float d0 = y4.x - mean, d1 = y4.y - mean, d2 = y4.z - mean, d3 = y4.w - mean; \
            const float var = reduce16((d0 * d0 + d1 * d1) + (d2 * d2 + d3 * d3)) * (1.f / 64.f); \
            const float rs = __builtin_amdgcn_rsqf(var + GN_EPS); \
            const float o0 = (d0 * rs * ln_w[0] + ln_b[0] + bon * v4.x) * gg[0], o1 = (d1 * rs * ln_w[1] + ln_b[1] + bon * v4.y) * gg[1]; \
            const float o2 = (d2 * rs * ln_w[2] + ln_b[2] + bon * v4.z) * gg[2], o3 = (d3 * rs * ln_w[3] + ln_b[3] + bon * v4.w) * gg[3]; \
            *(unsigned long long*)(ORW + r_ * 1024 + c) = (unsigned long long)pk2(o0, o1) | ((unsigned long long)pk2(o2, o3) << 32); } } while (0)
    if (w >= 4) SC_PREP(0);
    __syncthreads();
    for (int ch = 0; ch < nch; ++ch) {
        if (w >= 4) {
            if (ch > 0) SC_POST(ch - 1);
            if (ch + 1 < nch) SC_PREP(ch + 1);
        } else {
            const LAS float* ob = (const LAS float*)(L + SC_OPB + (ch & 1) * SC_OPB_SZ) + 8 * kq; const LAS float* vb = (const LAS float*)(L + SC_VB + (ch % 3) * SC_VB_SZ); LAS float* yb = (LAS float*)(L + SC_YB + (ch & 1) * SC_YB_SZ);
            f32x4 wA0, wA1, kA0, kA1, bA0, bA1, mA0, mA1, rA0, rA1, wB0, wB1, kB0, kB1, bB0, bB1, mB0, mB1, rB0, rB1; float vA0, vA1, vB0, vB1;
#define SC_LD(SET, tt) do { const LAS float* p_ = ob + (tt) * 320; w##SET##0 = *(const LAS f32x4*)(p_); w##SET##1 = *(const LAS f32x4*)(p_ + 4); k##SET##0 = *(const LAS f32x4*)(p_ + 64); k##SET##1 = *(const LAS f32x4*)(p_ + 68); \
            b##SET##0 = *(const LAS f32x4*)(p_ + 128); b##SET##1 = *(const LAS f32x4*)(p_ + 132); m##SET##0 = *(const LAS f32x4*)(p_ + 192); m##SET##1 = *(const LAS f32x4*)(p_ + 196); \
            r##SET##0 = *(const LAS f32x4*)(p_ + 256); r##SET##1 = *(const LAS f32x4*)(p_ + 260); v##SET##0 = vb[(tt) * 64 + r0]; v##SET##1 = vb[(tt) * 64 + r1]; } while (0)
#define LO2(x) ((f32x2){(x)[0], (x)[1]})
#define HI2(x) ((f32x2){(x)[2], (x)[3]})
#define SC_DOT(q, X0, X1) (__builtin_elementwise_fma(S2[q][2], LO2(X1), S2[q][0] * LO2(X0)) + __builtin_elementwise_fma(S2[q][3], HI2(X1), S2[q][1] * HI2(X0)))
#define SC_UPD(q, SET, NS, VV) do { \
            S2[q][0] = __builtin_elementwise_fma(S2[q][0], LO2(w##SET##0), __builtin_elementwise_fma(NS, LO2(b##SET##0), VV * LO2(m##SET##0))); \
            S2[q][1] = __builtin_elementwise_fma(S2[q][1], HI2(w##SET##0), __builtin_elementwise_fma(NS, HI2(b##SET##0), VV * HI2(m##SET##0))); \
            S2[q][2] = __builtin_elementwise_fma(S2[q][2], LO2(w##SET##1), __builtin_elementwise_fma(NS, LO2(b##SET##1), VV * LO2(m##SET##1))); \
            S2[q][3] = __builtin_elementwise_fma(S2[q][3], HI2(w##SET##1), __builtin_elementwise_fma(NS, HI2(b##SET##1), VV * HI2(m##SET##1))); } while (0)
#define SC_STEP(SET, tt) do { \
            const f32x2 pa_ = SC_DOT(0, k##SET##0, k##SET##1), pb_ = SC_DOT(1, k##SET##0, k##SET##1); \
            float sa_ = pa_[0] + pa_[1], sb_ = pb_[0] + pb_[1]; \
            sa_ += dppf<0xB1>(sa_); sb_ += dppf<0xB1>(sb_); sa_ += dppf<0x4E>(sa_); sb_ += dppf<0x4E>(sb_); sa_ += dppf<0x141>(sa_); sb_ += dppf<0x141>(sb_); \
            { const float na_ = -sa_, nb_ = -sb_; const f32x2 nsa_ = (f32x2){na_, na_}, nsb_ = (f32x2){nb_, nb_}, va_ = (f32x2){v##SET##0, v##SET##0}, vb2_ = (f32x2){v##SET##1, v##SET##1}; \
              SC_UPD(0, SET, nsa_, va_); SC_UPD(1, SET, nsb_, vb2_); } \
            const f32x2 qa_ = SC_DOT(0, r##SET##0, r##SET##1), qb_ = SC_DOT(1, r##SET##0, r##SET##1); \
            float ya_ = qa_[0] + qa_[1], yb1_ = qb_[0] + qb_[1]; \
            ya_ += dppf<0xB1>(ya_); yb1_ += dppf<0xB1>(yb1_); ya_ += dppf<0x4E>(ya_); yb1_ += dppf<0x4E>(yb1_); ya_ += dppf<0x141>(ya_); yb1_ += dppf<0x141>(yb1_); \
            if (kq == 0) { yb[(tt) * 64 + r0] = ya_; yb[(tt) * 64 + r1] = yb1_; } } while (0)
            SC_LD(A, 0);
            for (int t = 0; t < SC_C; t += 2) {
                SC_LD(B, t + 1);
                SC_STEP(A, t);
                if (t + 2 < SC_C) SC_LD(A, t + 2);
                SC_STEP(B, t + 1);
            }
#undef SC_LD
#undef SC_STEP
#undef SC_DOT
#undef SC_UPD
#undef LO2
#undef HI2
        }
        __syncthreads();
    }
    if (w >= 4) SC_POST(nch - 1);
    else {
#pragma unroll
        for (int q = 0; q < 2; ++q) { float* Sout = F.out + (smp ? O_WKVS : O_WKVP) + (((size_t)(l * 8 + b) * 16 + h) * 64 + (q ? r1 : r0)) * 64 + 8 * kq;
            *(f32x4*)Sout = (f32x4){S2[q][0][0], S2[q][0][1], S2[q][1][0], S2[q][1][1]}; *(f32x4*)(Sout + 4) = (f32x4){S2[q][2][0], S2[q][2][1], S2[q][3][0], S2[q][3][1]}; } }
#undef SC_PREP
#undef SC_POST
    __syncthreads();
}
__device__ __forceinline__ void ph_scan(Frame& F, CArgsP A, int l, const int s0, const int ns) {
    for (int it = s0; it < 256; it += ns) scan_fast(F, A, l, it);
}

__device__ __forceinline__ void unpack8f(const v4u w, float (&o)[8]) { o[0] = bflo(w.x); o[1] = bfhi(w.x); o[2] = bflo(w.y); o[3] = bfhi(w.y); o[4] = bflo(w.z); o[5] = bfhi(w.z); o[6] = bflo(w.w); o[7] = bfhi(w.w); }
__device__ __forceinline__ void ph_conv(Frame& F, CArgsP A, int l) {
    const int gt = (F.vcu * NWAVES + F.wave) * 64 + F.lane, NGT = F.G * NWAVES * 64;
    const bf16* UP = (const bf16*)(F.ws + B_UP); bf16* GT = (bf16*)(F.ws + B_GT);
    const float* cw = GIN(A, 27) + (size_t)l * 3 * UPW; const float* cb = GIN(A, 28) + (size_t)l * UPW;
    constexpr int NJ = D_FF / 8, NRB = MT / 64;
    for (int it = gt; it < NRB * NJ; it += NGT) {
        const int rb = it / NJ, j = (it % NJ) * 8;
        float w0[2][8], w1[2][8], w2[2][8], bi[2][8];
#pragma unroll
        for (int hf = 0; hf < 2; ++hf) { const int col = j + hf * D_FF;
#pragma unroll
            for (int e = 0; e < 8; e += 4) { const f32x4 a = *(const f32x4*)(cw + col + e), b2 = *(const f32x4*)(cw + UPW + col + e), c2 = *(const f32x4*)(cw + 2 * UPW + col + e), d2 = *(const f32x4*)(cb + col + e);
                w0[hf][e] = a.x; w0[hf][e + 1] = a.y; w0[hf][e + 2] = a.z; w0[hf][e + 3] = a.w; w1[hf][e] = b2.x; w1[hf][e + 1] = b2.y; w1[hf][e + 2] = b2.z; w1[hf][e + 3] = b2.w;
                w2[hf][e] = c2.x; w2[hf][e + 1] = c2.y; w2[hf][e + 2] = c2.z; w2[hf][e + 3] = c2.w; bi[hf][e] = d2.x; bi[hf][e + 1] = d2.y; bi[hf][e + 2] = d2.z; bi[hf][e + 3] = d2.w; } }
        float u1[2][8], u2[2][8];
        for (int r4 = 0; r4 < 64; r4 += 4) {
            v4u ld[4][2];
#pragma unroll
            for (int q = 0; q < 4; ++q) { ld[q][0] = *(const v4u*)(UP + (size_t)(rb * 64 + r4 + q) * UPW + j); ld[q][1] = *(const v4u*)(UP + (size_t)(rb * 64 + r4 + q) * UPW + j + D_FF); }
#pragma unroll
            for (int q = 0; q < 4; ++q) {
                const int rr = r4 + q, row = rb * 64 + rr;
                const bool smp = row >= MP; const int t = smp ? ((row - MP) & 31) : (row & 2047); const int b = smp ? ((row - MP) >> 5) : (row >> 11);
                if (t == 0) {
#pragma unroll
                    for (int hf = 0; hf < 2; ++hf) { const int col = j + hf * D_FF;
                        if (smp) { const float* s0 = GIN(A, 6) + ((size_t)(l * 8 + b) * 2) * UPW + col;
#pragma unroll
                            for (int e = 0; e < 8; ++e) { u2[hf][e] = s0[e]; u1[hf][e] = s0[UPW + e]; } }
                        else {
#pragma unroll
                            for (int e = 0; e < 8; ++e) { u2[hf][e] = 0.f; u1[hf][e] = 0.f; } } }
                } else if (rr == 0) {
#pragma unroll
                    for (int hf = 0; hf < 2; ++hf) { const int col = j + hf * D_FF;
                        unpack8f(*(const v4u*)(UP + (size_t)(row - 1) * UPW + col), u1[hf]); unpack8f(*(const v4u*)(UP + (size_t)(row - 2) * UPW + col), u2[hf]); }
                }
                float u0[2][8], cc[2][8];
#pragma unroll
                for (int hf = 0; hf < 2; ++hf) { unpack8f(ld[q][hf], u0[hf]);
#pragma unroll
                    for (int e = 0; e < 8; ++e) { cc[hf][e] = bi[hf][e] + u2[hf][e] * w0[hf][e] + u1[hf][e] * w1[hf][e] + u0[hf][e] * w2[hf][e]; u2[hf][e] = u1[hf][e]; u1[hf][e] = u0[hf][e]; } }
                float gv[8];
#pragma unroll
                for (int e = 0; e < 8; ++e) gv[e] = cc[0][e] * __builtin_amdgcn_rcpf(1.0f + __builtin_amdgcn_exp2f(-1.4426950408889634f * cc[0][e])) * cc[1][e];
                v4u o; o.x = pk2(gv[0], gv[1]); o.y = pk2(gv[2], gv[3]); o.z = pk2(gv[4], gv[5]); o.w = pk2(gv[6], gv[7]);
                *(v4u*)(GT + (size_t)row * D_FF + j) = o;
            }
        }
    }
}

__device__ __forceinline__ void ph_final(Frame& F, CArgsP A) {
    const int gw = F.vcu * NWAVES + F.wave, NGW = F.G * NWAVES;
    float* X = F.out + O_YP; const float* SS = (const float*)(F.ctl + CW_SS) + 4 * MT; const float* g = GIN(A, 30);
    for (int m = gw; m < MT; m += NGW) {
        const float r = 1.0f / sqrtf(SS[m] * (1.0f / 1024.f) + EPS);
        GAS f32x4* xr = (GAS f32x4*)(X + (size_t)m * 1024) + F.lane; const GAS f32x4* gr = (const GAS f32x4*)g + F.lane;
#pragma unroll
        for (int j = 0; j < 4; ++j) { f32x4 v = xr[64 * j]; const f32x4 gg = gr[64 * j]; v = v * r * gg; xr[64 * j] = v; }
    }
}

typedef float f32x16g __attribute__((ext_vector_type(16)));
template <int NB, class EPI> __device__ __forceinline__ void mini_gemm(Frame& F, const bf16* A, const bf16* Bt, const int K, const int nblk_n, EPI epi) {
    LAS float* red = (LAS float*)(F.lds + RING_OFF);
    const int KW = K / NWAVES, i = F.lane & 31, h = F.lane >> 5;
    for (int bi = F.vcu; bi < 8 * nblk_n; bi += F.G) {
        const int rb = bi & 7, cb = bi >> 3;
        const bf16* ap = A + (size_t)(rb * 32 + i) * K + F.wave * KW + 8 * h;
        const bf16* bp = Bt + (size_t)(cb * 32 + i) * K + F.wave * KW + 8 * h;
        f32x16g acc;
#pragma unroll
        for (int r = 0; r < 16; ++r) acc[r] = 0.f;
        for (int k0 = 0; k0 < KW; k0 += 16 * NB) {
            bf16x8 a[NB], b[NB];
#pragma unroll
            for (int j = 0; j < NB; ++j) { a[j] = *(const bf16x8*)(ap + k0 + 16 * j); b[j] = *(const bf16x8*)(bp + k0 + 16 * j); }
#pragma unroll
            for (int j = 0; j < NB; ++j) acc = __builtin_amdgcn_mfma_f32_32x32x16_bf16(a[j], b[j], acc, 0, 0, 0);
        }
        __syncthreads();
#pragma unroll
        for (int r = 0; r < 16; ++r) red[(F.wave * 16 + r) * 64 + F.lane] = acc[r];
        __syncthreads();
        const int q = F.wave;
        float s0 = 0.f, s1 = 0.f;
#pragma unroll
        for (int w = 0; w < NWAVES; ++w) { s0 += red[(w * 16 + 2 * q) * 64 + F.lane]; s1 += red[(w * 16 + 2 * q + 1) * 64 + F.lane]; }
        epi(rb * 32 + 2 * (q & 1) + 8 * (q >> 1) + 4 * h, cb * 32 + i, s0, s1);
    }
}
__device__ __forceinline__ void mini_gated(Frame& F, const bf16* A, const bf16* Bt, const bf16* G, const int goff, const bf16* S, bf16* O) {
    mini_gemm<8>(F, A + (size_t)MP * 1024, Bt, 1024, 32, [=](int row, int col, float v0, float v1) {
        const size_t r0 = (size_t)(MP + row);
        v0 *= bf2f(G[r0 * 2048 + goff + col]); v1 *= bf2f(G[(r0 + 1) * 2048 + goff + col]);
        if (S) { v0 += bf2f(S[r0 * 1024 + col]); v1 += bf2f(S[(r0 + 1) * 1024 + col]); }
        O[r0 * 1024 + col] = (bf16)f2bf(v0); O[(r0 + 1) * 1024 + col] = (bf16)f2bf(v1);
    });
}
template <int NB> __device__ __forceinline__ void mini_res(Frame& F, const bf16* A, const bf16* Bt, const int K, float* X, bf16* XB, float* SS) {
    mini_gemm<NB>(F, A + (size_t)MP * K, Bt, K, 32, [=](int row, int col, float v0, float v1) {
        const size_t r0 = (size_t)(MP + row);
        v0 += X[r0 * 1024 + col]; v1 += X[(r0 + 1) * 1024 + col];
        X[r0 * 1024 + col] = v0; X[(r0 + 1) * 1024 + col] = v1;
        XB[r0 * 1024 + col] = (bf16)f2bf(v0); XB[(r0 + 1) * 1024 + col] = (bf16)f2bf(v1);
        float q0 = reduce16(v0 * v0), q1 = reduce16(v1 * v1);
        q0 += __shfl_xor(q0, 16); q1 += __shfl_xor(q1, 16);
        if ((col & 31) == 0) { atomicAdd(SS + r0, q0); atomicAdd(SS + r0 + 1, q1); }
    });
}
__device__ __forceinline__ void mini_gate(Frame& F, const bf16* A, const bf16* Bt, const float* ss, bf16* GATE) {
    mini_gemm<8>(F, A + (size_t)MP * 1024, Bt, 1024, 64, [=](int row, int col, float v0, float v1) {
        const size_t r0 = (size_t)(MP + row);
        const float rs0 = 1.0f / sqrtf(ss[r0] * (1.0f / 1024.f) + 1e-6f), rs1 = 1.0f / sqrtf(ss[r0 + 1] * (1.0f / 1024.f) + 1e-6f);
        GATE[r0 * 2048 + col] = (bf16)f2bf(pg8::fast_sigmoid(v0 * rs0)); GATE[(r0 + 1) * 2048 + col] = (bf16)f2bf(pg8::fast_sigmoid(v1 * rs1));
    });
}

#define REOPAQUE() do { int tv = threadIdx.x; asm volatile("" : "+v"(tv)); F.tid = tv; F.lane = tv & 63; F.wave = __builtin_amdgcn_readfirstlane(tv >> 6); \
    ap = (CArgsP)__builtin_amdgcn_kernarg_segment_ptr(); asm volatile("" : "+s"(ap)); \
    { GAS unsigned char* w_ = ap->ws; GAS float* o_ = ap->out; asm volatile("" : "+s"(w_), "+s"(o_)); F.ws = (unsigned char*)w_; F.out = (float*)o_; F.ctl = (gu32*)(w_ + WS_CTL); } } while (0)
#define PH_BEGIN(idx) if (lo <= (idx) && (idx) < hi) { REOPAQUE();
#define PH_END(idx) if ((idx) + 1 < hi) xcd_barrier(bar); }

#define IDLE_CONVERT(nu, part) do { const int rem_ = (nu) % F.G; __syncthreads(); if (rem_ && (int)blockIdx.x >= rem_) { REOPAQUE(); p0_weights(F, ap, 1, ((int)blockIdx.x - rem_) * NWAVES + F.wave, (F.G - rem_) * NWAVES, part); } \
        else if (!rem_) { REOPAQUE(); p0_weights(F, ap, 1, (int)blockIdx.x * NWAVES + F.wave, F.G * NWAVES, part); } } while (0)

template <int l> __device__ __forceinline__ void layer_phases(Frame& F, CArgsP& ap, const XcdBarrier& bar, const int lo, const int hi) {
    constexpr int P0 = 1 + l * PH_PER_LAYER;
#define WL (F.ws + WS_W)
#define SSP ((float*)(F.ctl + CW_SS))
    PH_BEGIN(P0 + K_G1) {
        int kk_ = 1024; asm volatile("" : "+s"(kk_)); pg8::Gemm g{(const bf16*)(F.ws + WS_XB), (const bf16*)(WL + W_IN), MT, P_DA + P_RW, kk_}; pg8::StaticOrder S; S.init(MT, P_DA + P_RW, F.G, (int)blockIdx.x);
        pg8::EpiIn E{SSP + (size_t)(2 * l) * MT, (const float*)(F.ws + WS_ROPE), (bf16*)(F.ws + B_Q), (bf16*)(F.ws + B_K), (bf16*)(F.ws + B_V), (bf16*)(F.ws + B_URW),
                     F.out + O_KP + (size_t)l * MP * 1024, F.out + O_VP + (size_t)l * MP * 1024, F.out + O_KS + (size_t)l * MS * 1024, F.out + O_VS + (size_t)l * MS * 1024,
                     F.out + O_SHP + (size_t)l * BATCH * P_RW, F.out + O_SHS + (size_t)l * DEC_BATCH * P_RW};
        pg8::gemm_phase<pg8::EpiIn, pg8::StaticOrder, true, true>(F.lds + RING_OFF, g, S, E);
        if constexpr (l == 0) IDLE_CONVERT((MT / 256) * ((P_DA + P_RW) / 256), WP_UP | WP_DN);
    } PH_END(P0 + K_G1)
    PH_BEGIN(P0 + K_LP) { ph_linprep(F, ap, l); } PH_END(P0 + K_LP)
    PH_BEGIN(P0 + K_LR) {
        int kk_ = 256; asm volatile("" : "+s"(kk_)); pg8::Gemm g{(const bf16*)(F.ws + B_LIN), (const bf16*)(WL + W_LORA), MT, 3072, kk_}; pg8::StaticOrder S; S.init(MT, 3072, F.G, (int)blockIdx.x);
        pg8::EpiLora E{GIN(ap, 13) + l * 1024, GIN(ap, 15) + l * 1024, (bf16*)(F.ws + B_LD), (bf16*)(F.ws + B_LA), (bf16*)(F.ws + B_LG)};
        pg8::gemm_phase<pg8::EpiLora, pg8::StaticOrder, true, true>(F.lds + RING_OFF, g, S, E);
    } PH_END(P0 + K_LR)
    PH_BEGIN(P0 + K_SC) {
        const int NSC = (F.G >= 256) ? 128 : F.G / 2;
        if (F.vcu < NSC) ph_scan(F, ap, l, F.vcu, NSC); else ph_attn(F, ap, l, F.vcu - NSC, F.G - NSC);
    } PH_END(P0 + K_SC)
    PH_BEGIN(P0 + K_CB) {
        ph_combine(F, ap, l);
        int kk_ = 1024; asm volatile("" : "+s"(kk_)); pg8::Gemm g{(const bf16*)(F.ws + WS_XB), (const bf16*)(WL + W_IN) + (size_t)(P_DA + P_RW) * 1024, MP, P_GATE, kk_}; pg8::StaticOrder S; S.init(MP, P_GATE, F.G, (int)blockIdx.x);
        pg8::EpiGate E{SSP + (size_t)(2 * l) * MT, (bf16*)(F.ws + B_GATE)};
        pg8::gemm_phase<pg8::EpiGate, pg8::StaticOrder, true, true>(F.lds + RING_OFF, g, S, E);
        REOPAQUE(); mini_gate(F, (const bf16*)(F.ws + WS_XB), (const bf16*)(WL + W_IN) + (size_t)(P_DA + P_RW) * 1024, SSP + (size_t)(2 * l) * MT, (bf16*)(F.ws + B_GATE));
    } PH_END(P0 + K_CB)
    PH_BEGIN(P0 + K_M1) {
        int kk_ = 1024; asm volatile("" : "+s"(kk_)); pg8::Gemm g{(const bf16*)(F.ws + B_OA), (const bf16*)(WL + W_ODA), MP, 1024, kk_}; pg8::StaticOrder S; S.init(MP, 1024, F.G, (int)blockIdx.x);
        pg8::EpiGated E{(const bf16*)(F.ws + B_GATE), 0, nullptr, (bf16*)(F.ws + B_MRG)};
        pg8::gemm_phase<pg8::EpiGated, pg8::StaticOrder, true, true>(F.lds + RING_OFF, g, S, E);
        REOPAQUE(); mini_gated(F, (const bf16*)(F.ws + B_OA), (const bf16*)(WL + W_ODA), (const bf16*)(F.ws + B_GATE), 0, nullptr, (bf16*)(F.ws + B_MRG));
    } PH_END(P0 + K_M1)
    PH_BEGIN(P0 + K_M2) {
        int kk_ = 1024; asm volatile("" : "+s"(kk_)); pg8::Gemm g{(const bf16*)(F.ws + B_ORW), (const bf16*)(WL + W_ORW), MP, 1024, kk_}; pg8::StaticOrder S; S.init(MP, 1024, F.G, (int)blockIdx.x);
        pg8::EpiGated E{(const bf16*)(F.ws + B_GATE), 1024, (const bf16*)(F.ws + B_MRG), (bf16*)(F.ws + B_MRG)};
        pg8::gemm_phase<pg8::EpiGated, pg8::StaticOrder, true, true>(F.lds + RING_OFF, g, S, E);
        REOPAQUE(); mini_gated(F, (const bf16*)(F.ws + B_ORW), (const bf16*)(WL + W_ORW), (const bf16*)(F.ws + B_GATE), 1024, (const bf16*)(F.ws + B_MRG), (bf16*)(F.ws + B_MRG));
    } PH_END(P0 + K_M2)
    PH_BEGIN(P0 + K_WO) {
        int kk_ = 1024; asm volatile("" : "+s"(kk_)); pg8::Gemm g{(const bf16*)(F.ws + B_MRG), (const bf16*)(WL + W_OUT), MP, 1024, kk_}; pg8::StaticOrder S; S.init(MP, 1024, F.G, (int)blockIdx.x);
        pg8::EpiRes E{F.out + O_YP, (bf16*)(F.ws + WS_XB), SSP + (size_t)(2 * l + 1) * MT};
        pg8::gemm_phase<pg8::EpiRes, pg8::StaticOrder, true, true>(F.lds + RING_OFF, g, S, E);
        REOPAQUE(); mini_res<8>(F, (const bf16*)(F.ws + B_MRG), (const bf16*)(WL + W_OUT), 1024, F.out + O_YP, (bf16*)(F.ws + WS_XB), SSP + (size_t)(2 * l + 1) * MT);
    } PH_END(P0 + K_WO)
    PH_BEGIN(P0 + K_UP) {
        int kk_ = 1024; asm volatile("" : "+s"(kk_)); pg8::Gemm g{(const bf16*)(F.ws + WS_XB), (const bf16*)(WL + (l ? W_UP1 : W_UP)), MT, UPW, kk_}; pg8::StaticOrder S; S.init(MT, UPW, F.G, (int)blockIdx.x);
        pg8::EpiUp E{SSP + (size_t)(2 * l + 1) * MT, (bf16*)(F.ws + B_UP), F.out + O_CVP + (size_t)l * BATCH * 2 * UPW, F.out + O_CVS + (size_t)l * DEC_BATCH * 2 * UPW};
        pg8::gemm_phase<pg8::EpiUp, pg8::StaticOrder, true, true>(F.lds + RING_OFF, g, S, E);
        if constexpr (l == 0) IDLE_CONVERT((MT / 256) * (UPW / 256), WP_IN | WP_SQ | WP_LORA);
    } PH_END(P0 + K_UP)
    PH_BEGIN(P0 + K_CV) { ph_conv(F, ap, l); } PH_END(P0 + K_CV)
    PH_BEGIN(P0 + K_DN) {
        int kk_ = D_FF; asm volatile("" : "+s"(kk_)); pg8::Gemm g{(const bf16*)(F.ws + B_GT), (const bf16*)(l ? F.ws + WS_DN1 : WL + W_DN), MP, 1024, kk_}; pg8::StaticOrder S; S.init(MP, 1024, F.G, (int)blockIdx.x);
        pg8::EpiRes E{F.out + O_YP, (bf16*)(F.ws + WS_XB), SSP + (size_t)(2 * l + 2) * MT};
        pg8::gemm_phase<pg8::EpiRes, pg8::StaticOrder, true, true>(F.lds + RING_OFF, g, S, E);
        REOPAQUE(); mini_res<11>(F, (const bf16*)(F.ws + B_GT), (const bf16*)(l ? F.ws + WS_DN1 : WL + W_DN), D_FF, F.out + O_YP, (bf16*)(F.ws + WS_XB), SSP + (size_t)(2 * l + 2) * MT);
    } PH_END(P0 + K_DN)
#undef WL
#undef SSP
}

__global__ void __launch_bounds__(NWAVES * 64, 2) mk_fwd(Args args) {
    extern __shared__ __attribute__((aligned(16))) unsigned char lds[];
    Frame F;
    F.lds = (LAS unsigned char*)lds;
    F.MISC = (volatile LAS unsigned*)(F.lds + MISC_OFF);
    F.tid = threadIdx.x; F.lane = F.tid & 63; F.wave = __builtin_amdgcn_readfirstlane(F.tid >> 6);
    F.G = gridDim.x; { const int bx = blockIdx.x; F.vcu = (F.G % 8 == 0) ? (bx % 8) * (F.G / 8) + bx / 8 : bx; }
    F.out = (float*)args.out; F.ws = (unsigned char*)args.ws;
    F.ctl = (gu32*)(args.ws + WS_CTL);
    for (int u = F.tid; u < (LDS_BYTES - LDSCTL_OFF) / 4; u += NWAVES * 64) ((LAS unsigned*)(F.lds + LDSCTL_OFF))[u] = 0u;
    __syncthreads();
    XcdBarrier bar; bar.bar = (unsigned*)(F.ctl + CW_BAR); bar.x = 0; bar.st = nullptr;
    if (!MK_PER_PHASE) bar = xcd_barrier_post((unsigned*)(F.ctl + CW_BAR), F.MISC + 8);
    const int lo = args.ph_lo, hi = args.ph_hi;
    CArgsP ap;
    PH_BEGIN(0) { p0_prologue(F, ap); } PH_END(0)
    layer_phases<0>(F, ap, bar, lo, hi);
    layer_phases<1>(F, ap, bar, lo, hi);
    PH_BEGIN(NPHASE - 1) { ph_final(F, ap); } PH_END(NPHASE - 1)
}

extern "C" void kernel_launch(void* const* d_in, const int* in_sizes, int n_in, void* d_out, int out_size, void* d_ws, size_t ws_size, hipStream_t stream) {
    (void)in_sizes;
    static int grid = 0;
    if (grid == 0) {
        if (n_in != 31 || out_size != (int)O_END || ws_size < B_END2) { fprintf(stderr, "kernel_launch: unexpected shapes (n_in %d out %d ws %zu)\n", n_in, out_size, ws_size); grid = -1; return; }
        int dev = 0, cus = 0;
        if (hipGetDevice(&dev) != hipSuccess || hipDeviceGetAttribute(&cus, hipDeviceAttributeMultiprocessorCount, dev) != hipSuccess) { grid = -1; return; }
        if (hipFuncSetAttribute((const void*)mk_fwd, hipFuncAttributeMaxDynamicSharedMemorySize, LDS_BYTES) != hipSuccess) { fprintf(stderr, "kernel_launch: hipFuncSetAttribute failed\n"); grid = -1; return; }
        (void)hipGetLastError();
        grid = cus;
    }
    if (grid < 0) return;
    if (hipMemsetAsync((char*)d_ws + WS_CTL, 0, CTL_ZERO_BYTES, stream) != hipSuccess) { fprintf(stderr, "kernel_launch: memset failed\n"); return; }
    Args a{};
    for (int i = 0; i < 31; ++i) a.in[i] = (const GAS float*)d_in[i];
    a.out = (GAS float*)d_out; a.ws = (GAS unsigned char*)d_ws;
    for (int i = 0; i < 8; ++i) a.rinv[i] = (float)pow(500000.0, -(double)i / 8.0);
#if MK_PER_PHASE
    for (int p = 0; p < NPHASE; ++p) { a.ph_lo = p; a.ph_hi = p + 1; hipLaunchKernelGGL(mk_fwd, dim3(grid), dim3(NWAVES * 64), LDS_BYTES, stream, a); }
#else
    a.ph_lo = 0; a.ph_hi = NPHASE;
    hipLaunchKernelGGL(mk_fwd, dim3(grid), dim3(NWAVES * 64), LDS_BYTES, stream, a);
#endif
    const hipError_t le = hipPeekAtLastError();
    if (le != hipSuccess) fprintf(stderr, "kernel_launch: launch failed: %s\n", hipGetErrorName(le));
}
```

```cpp
#include <hip/hip_runtime.h>
#include <cstdio>
#include <cstdint>
#include <cmath>

#ifndef MK_PER_PHASE
#define MK_PER_PHASE 0
#endif

constexpr int D_MODEL = 1024, BATCH = 8, SEQ = 2048, DEPTH = 2, DEC_BATCH = 8, DEC_SEQ = 32, PAST_LEN = 2048;
constexpr float EPS = 1e-6f, GN_EPS = 64e-5f;
constexpr int DA_HEADS = 8, RW_HEADS = 16;
constexpr int D_FF = 2816, UPW = 2 * D_FF;
constexpr int P_DA = 3072, P_RW = 3328, P_GATE = 2048, P_TOTAL = 8448;
constexpr int MP = BATCH * SEQ, MS = DEC_BATCH * DEC_SEQ, MT = MP + MS;
constexpr int NKEYS_S = PAST_LEN + DEC_SEQ;
constexpr float C2 = 0.125f * 1.4426950408889634f;

constexpr size_t O_YP = 0;
constexpr size_t O_YS = O_YP + (size_t)MP * D_MODEL;
constexpr size_t O_KP = O_YS + (size_t)MS * D_MODEL;
constexpr size_t O_VP = O_KP + (size_t)DEPTH * MP * 1024;
constexpr size_t O_WKVP = O_VP + (size_t)DEPTH * MP * 1024;
constexpr size_t O_SHP = O_WKVP + (size_t)DEPTH * BATCH * RW_HEADS * 64 * 64;
constexpr size_t O_CVP = O_SHP + (size_t)DEPTH * BATCH * P_RW;
constexpr size_t O_KS = O_CVP + (size_t)DEPTH * BATCH * 2 * UPW;
constexpr size_t O_VS = O_KS + (size_t)DEPTH * MS * 1024;
constexpr size_t O_WKVS = O_VS + (size_t)DEPTH * MS * 1024;
constexpr size_t O_SHS = O_WKVS + (size_t)DEPTH * DEC_BATCH * RW_HEADS * 64 * 64;
constexpr size_t O_CVS = O_SHS + (size_t)DEPTH * DEC_BATCH * P_RW;
constexpr size_t O_END = O_CVS + (size_t)DEPTH * DEC_BATCH * 2 * UPW;
static_assert(O_END == 87760896, "output size");

namespace pg8 {
#define PG8_LAS __attribute__((address_space(3)))
typedef unsigned short bf16_t;
typedef short bf16x8 __attribute__((ext_vector_type(8)));
typedef float f32x4 __attribute__((ext_vector_type(4)));
typedef unsigned u32x4 __attribute__((ext_vector_type(4)));
constexpr int BM = 256, BK = 64, HALF = 128, HTB = HALF * BK * 2  , STAGE_BYTES = 8 * HTB, NXCD = 8, WGM = 8;

__host__ __device__ __forceinline__ int lds_byte(int r, int c) { const int st = (r >> 4) * 2 + (c >> 5), rr = r & 15, cc = c & 31, ob = rr * 64 + cc * 2; return st * 1024 + (ob ^ (((ob >> 9) & 1) << 5)); }
__host__ __device__ __forceinline__ void stage_rc(int b, int& R, int& C) { const int st = b / 1024, sb = b % 1024, swz = sb ^ (((sb >> 9) & 1) << 5); R = (st >> 1) * 16 + swz / 64; C = (st & 1) * 32 + (swz % 64) / 2; }
__host__ __device__ __forceinline__ int perm32(int rho) { const int n = rho >> 4, i = rho & 15; return 8 * (i >> 2) + 4 * n + (i & 3); }

struct Unit { int pm, pn; };
struct Gemm { const bf16_t* A; const bf16_t* Bt; int M, N, K; };

struct StaticOrder {
    int nM, nN, nwg, G, c;
    __host__ __device__ void init(int M, int N, int G_, int c_) { nM = M / BM; nN = N / BM; nwg = nM * nN; G = G_; c = c_; }
    __host__ __device__ bool next(int i, Unit& u) const {
        const long L = (long)i * G + c; if (L >= nwg) return false;
        int wgid = (int)L; { const int q = nwg / NXCD, r = nwg % NXCD, xcd = wgid % NXCD, off = wgid / NXCD; wgid = (xcd < r ? xcd * (q + 1) : r * (q + 1) + (xcd - r) * q) + off; }
        const int nig = WGM * nN, gid = wgid / nig, fm = gid * WGM, gsz = (nM - fm) < WGM ? (nM - fm) : WGM;
        u.pm = fm + ((wgid % nig) % gsz); u.pn = (wgid % nig) / gsz; return true;
    }
    __device__ __forceinline__ void a_ready(const Unit&) const {}
    __device__ __forceinline__ void done(const Unit&) const {}
};

typedef float f32x2_cv __attribute__((ext_vector_type(2))); typedef __bf16 bf16x2_cv __attribute__((ext_vector_type(2)));
__device__ __forceinline__ unsigned cvt_pk_bf16(float lo, float hi) { const f32x2_cv v = {lo, hi}; const bf16x2_cv b = __builtin_convertvector(v, bf16x2_cv); return __builtin_bit_cast(unsigned, b); }
typedef float f32x2 __attribute__((ext_vector_type(2)));
__device__ __forceinline__ float bf2f(unsigned short h) { return __uint_as_float((unsigned)h << 16); }
__device__ __forceinline__ float fast_sigmoid(float x) { return __builtin_amdgcn_rcpf(1.0f + __builtin_amdgcn_exp2f(-1.4426950408889634f * x)); }
__device__ __forceinline__ float neg_decay_log(float x) {
    const float y = -x, sp = fmaxf(y, 0.f) + 0.6931471805599453f * __builtin_amdgcn_logf(1.0f + __builtin_amdgcn_exp2f(-1.4426950408889634f * fabsf(y)));
    return -__builtin_amdgcn_exp2f(-1.4426950408889634f * (sp + 0.5f));
}
__device__ __forceinline__ u32x4 pack8(const f32x4 v0, const f32x4 v1) { u32x4 w; w.x = cvt_pk_bf16(v0[0], v0[1]); w.y = cvt_pk_bf16(v0[2], v0[3]); w.z = cvt_pk_bf16(v1[0], v1[1]); w.w = cvt_pk_bf16(v1[2], v1[3]); return w; }
__device__ __forceinline__ void unpack8(const u32x4 w, f32x4& v0, f32x4& v1) {
    v0[0] = __uint_as_float(w.x << 16); v0[1] = __uint_as_float(w.x & 0xffff0000u); v0[2] = __uint_as_float(w.y << 16); v0[3] = __uint_as_float(w.y & 0xffff0000u);
    v1[0] = __uint_as_float(w.z << 16); v1[1] = __uint_as_float(w.z & 0xffff0000u); v1[2] = __uint_as_float(w.w << 16); v1[3] = __uint_as_float(w.w & 0xffff0000u);
}
constexpr int E_MP = 16384, E_MS = 256;

struct EpiIn {
    static constexpr bool PERM = true, AFTER_DRAIN = false;
    const float* ss; const float* rope;
    bf16_t *Q, *K, *V, *URW;
    float *kout_p, *vout_p, *kout_s, *vout_s;
    float *sh_p, *sh_s;
    __device__ __forceinline__ void operator()(const f32x4 (&acc)[2][2][4][2], const Unit& u, int wr, int wc, int fr, int fq) const {
        const int pn = u.pn, rowb = u.pm * BM + wr * 64 + fr, cl = wc * 32 + 8 * fq;
        const bool rope_wave = (pn < 8) && ((wc & 1) == 0);
        const float sgn = (fq == 0) ? -1.f : 1.f;
#pragma unroll
        for (int ai = 0; ai < 2; ++ai)
#pragma unroll
            for (int m = 0; m < 4; ++m) {
                const int row = rowb + ai * HALF + m * 16;
                const float rstd = 1.0f / sqrtf(ss[row] * (1.0f / 1024.f) + 1e-6f);
                const bool smp = row >= E_MP;
                const int t = smp ? ((row - E_MP) & 31) : (row & 2047);
                const int bb = smp ? ((row - E_MP) >> 5) : (row >> 11);
                const int pos = smp ? 2048 + t : t;
                const bool last = smp ? (t == 31) : (t == 2047);
#pragma unroll
                for (int bj = 0; bj < 2; ++bj) {
                    f32x4 v0 = acc[ai][bj][m][0] * rstd, v1 = acc[ai][bj][m][1] * rstd;
                    const int col = pn * BM + bj * HALF + cl;
                    if (pn < 8) {
                        if (rope_wave) {
                            f32x4 p0, p1;
#pragma unroll
                            for (int j = 0; j < 4; ++j) { p0[j] = __shfl_xor(v0[j], 16); p1[j] = __shfl_xor(v1[j], 16); }
                            if (fq < 2) {
                                const float* tb = rope + pos * 16;
                                const f32x4 c0 = *(const f32x4*)(tb), c1 = *(const f32x4*)(tb + 4), s0 = *(const f32x4*)(tb + 8), s1 = *(const f32x4*)(tb + 12);
                                v0 = v0 * c0 + (p0 * s0) * sgn; v1 = v1 * c1 + (p1 * s1) * sgn;
                            }
                        }
                        if (pn < 4) { v0 = v0 * C2; v1 = v1 * C2; *(u32x4*)(Q + (size_t)row * 1024 + col) = pack8(v0, v1); }
                        else {
                            const int c = col - 1024;
                            *(u32x4*)(K + (size_t)row * 1024 + c) = pack8(v0, v1);
                            float* o = smp ? kout_s + (size_t)(row - E_MP) * 1024 + c : kout_p + (size_t)row * 1024 + c;
                            *(f32x4*)o = v0; *(f32x4*)(o + 4) = v1;
                        }
                    } else if (pn < 12) {
                        const int c = col - 2048;
                        *(u32x4*)(V + (size_t)row * 1024 + c) = pack8(v0, v1);
                        float* o = smp ? vout_s + (size_t)(row - E_MP) * 1024 + c : vout_p + (size_t)row * 1024 + c;
                        *(f32x4*)o = v0; *(f32x4*)(o + 4) = v1;
                    } else {
                        const int c = col - 3072;
                        *(u32x4*)(URW + (size_t)row * 3328 + c) = pack8(v0, v1);
                        if (last) { float* o = (smp ? sh_s : sh_p) + (size_t)bb * 3328 + c; *(f32x4*)o = v0; *(f32x4*)(o + 4) = v1; }
                    }
                }
            }
    }
};

struct EpiGate {
    static constexpr bool PERM = true, AFTER_DRAIN = false;
    const float* ss; bf16_t* GATE;
    __device__ __forceinline__ void operator()(const f32x4 (&acc)[2][2][4][2], const Unit& u, int wr, int wc, int fr, int fq) const {
        const int rowb = u.pm * BM + wr * 64 + fr, cl = u.pn * BM + wc * 32 + 8 * fq;
#pragma unroll
        for (int ai = 0; ai < 2; ++ai)
#pragma unroll
            for (int m = 0; m < 4; ++m) {
                const int row = rowb + ai * HALF + m * 16;
                const float rstd = 1.0f / sqrtf(ss[row] * (1.0f / 1024.f) + 1e-6f);
#pragma unroll
                for (int bj = 0; bj < 2; ++bj) {
                    f32x4 v0 = acc[ai][bj][m][0] * rstd, v1 = acc[ai][bj][m][1] * rstd;
#pragma unroll
                    for (int j = 0; j < 4; ++j) { v0[j] = fast_sigmoid(v0[j]); v1[j] = fast_sigmoid(v1[j]); }
                    *(u32x4*)(GATE + (size_t)row * 2048 + cl + bj * HALF) = pack8(v0, v1);
                }
            }
    }
};

struct EpiLora {
    static constexpr bool PERM = true, AFTER_DRAIN = false;
    const float *w0, *a0; bf16_t *LD, *LA, *LG;
    __device__ __forceinline__ void operator()(const f32x4 (&acc)[2][2][4][2], const Unit& u, int wr, int wc, int fr, int fq) const {
        const int pn = u.pn, rowb = u.pm * BM + wr * 64 + fr, cl = wc * 32 + 8 * fq;
        const int seg = pn >> 2;
#pragma unroll
        for (int bj = 0; bj < 2; ++bj) {
            const int c = (pn & 3) * BM + bj * HALF + cl;
            f32x4 b0 = (f32x4){0.f, 0.f, 0.f, 0.f}, b1 = b0;
            if (seg == 0) { b0 = *(const f32x4*)(w0 + c); b1 = *(const f32x4*)(w0 + c + 4); }
            else if (seg == 1) { b0 = *(const f32x4*)(a0 + c); b1 = *(const f32x4*)(a0 + c + 4); }
#pragma unroll
            for (int ai = 0; ai < 2; ++ai)
#pragma unroll
                for (int m = 0; m < 4; ++m) {
                    const int row = rowb + ai * HALF + m * 16;
                    f32x4 v0 = acc[ai][bj][m][0] + b0, v1 = acc[ai][bj][m][1] + b1;
                    if (seg == 0) {
#pragma unroll
                        for (int j = 0; j < 4; ++j) { v0[j] = neg_decay_log(v0[j]); v1[j] = neg_decay_log(v1[j]); }
                        *(u32x4*)(LD + (size_t)row * 1024 + c) = pack8(v0, v1);
                    } else if (seg == 1) {
#pragma unroll
                        for (int j = 0; j < 4; ++j) { v0[j] = fast_sigmoid(v0[j]); v1[j] = fast_sigmoid(v1[j]); }
                        *(u32x4*)(LA + (size_t)row * 1024 + c) = pack8(v0, v1);
                    } else {
                        *(u32x4*)(LG + (size_t)row * 1024 + c) = pack8(v0, v1);
                    }
                    asm volatile("" ::: "memory");
                }
        }
    }
};

struct EpiGated {
    static constexpr bool PERM = true, AFTER_DRAIN = false;
    const bf16_t* G; int goff; const bf16_t* S; bf16_t* O;
    __device__ __forceinline__ void operator()(const f32x4 (&acc)[2][2][4][2], const Unit& u, int wr, int wc, int fr, int fq) const {
        const int rowb = u.pm * BM + wr * 64 + fr, cl = u.pn * BM + wc * 32 + 8 * fq;
#pragma unroll
        for (int ai = 0; ai < 2; ++ai)
#pragma unroll
            for (int m = 0; m < 4; ++m) {
                const int row = rowb + ai * HALF + m * 16;
#pragma unroll
                for (int bj = 0; bj < 2; ++bj) {
                    const int c = cl + bj * HALF;
                    f32x4 g0, g1; unpack8(*(const u32x4*)(G + (size_t)row * 2048 + goff + c), g0, g1);
                    f32x4 v0 = acc[ai][bj][m][0] * g0, v1 = acc[ai][bj][m][1] * g1;
                    if (S) { f32x4 s0, s1; unpack8(*(const u32x4*)(S + (size_t)row * 1024 + c), s0, s1); v0 += s0; v1 += s1; }
                    *(u32x4*)(O + (size_t)row * 1024 + c) = pack8(v0, v1);
                }
            }
    }
};

struct EpiRes {
    static constexpr bool PERM = true, AFTER_DRAIN = false;
    float* X; bf16_t* XB; float* SS;
    __device__ __forceinline__ void operator()(const f32x4 (&acc)[2][2][4][2], const Unit& u, int wr, int wc, int fr, int fq) const {
        const int rowb = u.pm * BM + wr * 64 + fr, cl = u.pn * BM + wc * 32 + 8 * fq;
#pragma unroll
        for (int ai = 0; ai < 2; ++ai)
#pragma unroll
            for (int m = 0; m < 4; ++m) {
                const int row = rowb + ai * HALF + m * 16;
                float sq = 0.f;
#pragma unroll
                for (int bj = 0; bj < 2; ++bj) {
                    const int c = cl + bj * HALF;
                    float* xp = X + (size_t)row * 1024 + c;
                    const f32x4 v0 = *(const f32x4*)xp + acc[ai][bj][m][0], v1 = *(const f32x4*)(xp + 4) + acc[ai][bj][m][1];
                    *(f32x4*)xp = v0; *(f32x4*)(xp + 4) = v1;
                    *(u32x4*)(XB + (size_t)row * 1024 + c) = pack8(v0, v1);
                    sq += (v0[0] * v0[0] + v0[1] * v0[1]) + (v0[2] * v0[2] + v0[3] * v0[3]) + (v1[0] * v1[0] + v1[1] * v1[1]) + (v1[2] * v1[2] + v1[3] * v1[3]);
                }
                sq += __shfl_xor(sq, 16); sq += __shfl_xor(sq, 32);
                if (fq == 0) atomicAdd(SS + row, sq);
            }
    }
};

struct EpiUp {
    static constexpr bool PERM = true, AFTER_DRAIN = false;
    const float* ss; bf16_t* UP; float *cv_p, *cv_s;
    __device__ __forceinline__ void operator()(const f32x4 (&acc)[2][2][4][2], const Unit& u, int wr, int wc, int fr, int fq) const {
        const int rowb = u.pm * BM + wr * 64 + fr, cl = u.pn * BM + wc * 32 + 8 * fq;
#pragma unroll
        for (int ai = 0; ai < 2; ++ai)
#pragma unroll
            for (int m = 0; m < 4; ++m) {
                const int row = rowb + ai * HALF + m * 16;
                const float rstd = 1.0f / sqrtf(ss[row] * (1.0f / 1024.f) + 1e-6f);
                const bool smp = row >= E_MP;
                const int t = smp ? ((row - E_MP) & 31) : (row & 2047);
                const int bb = smp ? ((row - E_MP) >> 5) : (row >> 11);
                const int slot = smp ? t - 30 : t - 2046;
#pragma unroll
                for (int bj = 0; bj < 2; ++bj) {
                    const int c = cl + bj * HALF;
                    const f32x4 v0 = acc[ai][bj][m][0] * rstd, v1 = acc[ai][bj][m][1] * rstd;
                    *(u32x4*)(UP + (size_t)row * 5632 + c) = pack8(v0, v1);
                    if (slot >= 0) { float* o = (smp ? cv_s : cv_p) + ((size_t)bb * 2 + slot) * 5632 + c; *(f32x4*)o = v0; *(f32x4*)(o + 4) = v1; }
                }
            }
    }
};

template <class Epi, class Sched, bool ALIGN_EPI = false, bool SP2 = false>
__device__ __forceinline__ void gemm_phase(PG8_LAS unsigned char* lds, const Gemm g, const Sched& S, const Epi& E) {
    int tid_ = threadIdx.x; asm volatile("" : "+v"(tid_));
    const int tid = tid_, wid = __builtin_amdgcn_readfirstlane(tid >> 6), lane = tid & 63, wr = wid >> 2, wc = wid & 3, fr = lane & 15, fq = lane >> 4;
    const int K = g.K, nt = K / BK;
    unsigned voffA[2], voffB[2];
#pragma unroll
    for (int i = 0; i < 2; ++i) { int R, C; stage_rc(tid * 16 + i * 8192, R, C); const int Rb = Epi::PERM ? ((R & ~31) + perm32(R & 31)) : R;
        voffA[i] = (unsigned)(R * K + C) * 2u; voffB[i] = (unsigned)(Rb * K + C) * 2u; }
    const size_t kstep = (size_t)(BK * 2);
    const size_t hstep = (size_t)HALF * K * 2;
    const size_t tstep = 2 * hstep;
    const unsigned ldsw = (unsigned)wid * 1024u;
    const int aoff = lds_byte(wr * 64 + fr, fq * 8), boff = lds_byte(wc * 32 + fr, fq * 8);
#define PG8_SA(b, h) (((b) * 2 + (h)) * HTB)
#define PG8_SB(b, h) ((4 + (b) * 2 + (h)) * HTB)
#define PG8_STAGE(bufoff, gbase, voff) do { _Pragma("unroll") for (int _i = 0; _i < 2; ++_i) \
        __builtin_amdgcn_global_load_lds((const unsigned*)((const char*)(gbase) + (voff)[_i]), (PG8_LAS unsigned*)(lds + (bufoff) + ldsw + _i * 8192), 16, 0, 0); } while (0)
#define PG8_LDA(dst, b, h) do { _Pragma("unroll") for (int m = 0; m < 4; ++m) _Pragma("unroll") for (int k = 0; k < 2; ++k) dst[m][k] = *(const PG8_LAS bf16x8*)(lds + PG8_SA(b, h) + aoff + m * 2048 + k * 1024); } while (0)
#define PG8_LDB(dst, b, h) do { _Pragma("unroll") for (int n = 0; n < 2; ++n) _Pragma("unroll") for (int k = 0; k < 2; ++k) dst[n][k] = *(const PG8_LAS bf16x8*)(lds + PG8_SB(b, h) + boff + n * 2048 + k * 1024); } while (0)
#define PG8_MMA(ai, bj, At, Bt) do { __builtin_amdgcn_s_setprio(1); _Pragma("unroll") for (int m = 0; m < 4; ++m) _Pragma("unroll") for (int n = 0; n < 2; ++n) _Pragma("unroll") for (int k = 0; k < 2; ++k) \
        acc[ai][bj][m][n] = __builtin_amdgcn_mfma_f32_16x16x32_bf16(Bt[n][k], At[m][k], acc[ai][bj][m][n], 0, 0, 0); __builtin_amdgcn_s_setprio(0); } while (0)
#define PG8_WAIT_V(n) asm volatile("s_waitcnt vmcnt(" #n ")" ::: "memory")
#define PG8_WAIT_L(n) asm volatile("s_waitcnt lgkmcnt(" #n ")" ::: "memory")
#define PG8_BAR __builtin_amdgcn_s_barrier()
#define PG8_SCHED __builtin_amdgcn_sched_barrier(0)
    Unit cur, nxt; int ui = 0;
    if (!S.next(0, cur)) return;
    f32x4 acc[2][2][4][2];
#pragma unroll
    for (int a = 0; a < 2; ++a)
#pragma unroll
        for (int b = 0; b < 2; ++b)
#pragma unroll
            for (int m = 0; m < 4; ++m)
#pragma unroll
                for (int n = 0; n < 2; ++n) acc[a][b][m][n] = (f32x4){0.f, 0.f, 0.f, 0.f};
    bf16x8 At[4][2], B0[2][2], B1[2][2];
    const char* cA = (const char*)g.A + (size_t)cur.pm * tstep; const char* cB = (const char*)g.Bt + (size_t)cur.pn * tstep;
    S.a_ready(cur);
    if constexpr (SP2) {
        PG8_STAGE(PG8_SB(0, 0), cB, voffB); PG8_STAGE(PG8_SB(0, 1), cB + hstep, voffB); PG8_STAGE(PG8_SA(0, 0), cA, voffA); PG8_STAGE(PG8_SA(0, 1), cA + hstep, voffA);
        if (wr == 1) PG8_BAR;
        PG8_WAIT_V(2); PG8_BAR;
        PG8_STAGE(PG8_SB(1, 0), cB + kstep, voffB); PG8_STAGE(PG8_SA(1, 0), cA + kstep, voffA); PG8_STAGE(PG8_SB(1, 1), cB + hstep + kstep, voffB);
        PG8_WAIT_V(6); PG8_BAR;
    } else {
        PG8_STAGE(PG8_SB(0, 0), cB, voffB); PG8_STAGE(PG8_SA(0, 0), cA, voffA); PG8_STAGE(PG8_SB(0, 1), cB + hstep, voffB); PG8_STAGE(PG8_SA(0, 1), cA + hstep, voffA);
        if (wr == 1) PG8_BAR;
        PG8_WAIT_V(4); PG8_BAR;
        PG8_STAGE(PG8_SB(1, 0), cB + kstep, voffB); PG8_STAGE(PG8_SA(1, 0), cA + kstep, voffA); PG8_STAGE(PG8_SB(1, 1), cB + hstep + kstep, voffB);
        PG8_WAIT_V(6); PG8_BAR;
    }
    for (;;) {
        const bool has_next = S.next(ui + 1, nxt);
        const char* nA = has_next ? (const char*)g.A + (size_t)nxt.pm * tstep : cA; const char* nB = has_next ? (const char*)g.Bt + (size_t)nxt.pn * tstep : cB;
        for (int t = 0; t < nt; t += 2) {
            const bool last = (t == nt - 2);
            const char* a1 = cA + (size_t)(t + 1) * kstep;
            const char* a2 = last ? nA : cA + (size_t)(t + 2) * kstep; const char* b2 = last ? nB : cB + (size_t)(t + 2) * kstep;
            const char* a3 = a2 + kstep; const char* b3 = b2 + kstep;
            if (last && has_next) S.a_ready(nxt);
            if constexpr (SP2) {
            PG8_LDB(B0, 0, 0); PG8_LDB(B1, 0, 1); PG8_SCHED; PG8_LDA(At, 0, 0); PG8_STAGE(PG8_SA(1, 1), a1 + hstep, voffA);
            PG8_WAIT_V(8); PG8_WAIT_L(0); PG8_BAR; PG8_MMA(0, 0, At, B0); PG8_MMA(0, 1, At, B1); PG8_BAR; PG8_SCHED;
            PG8_LDA(At, 0, 1); PG8_STAGE(PG8_SB(0, 0), b2, voffB); PG8_STAGE(PG8_SB(0, 1), b2 + hstep, voffB); PG8_STAGE(PG8_SA(0, 0), a2, voffA);
            PG8_WAIT_V(8); PG8_WAIT_L(0); PG8_BAR; PG8_MMA(1, 0, At, B0); PG8_MMA(1, 1, At, B1); PG8_BAR; PG8_SCHED;
            PG8_LDB(B0, 1, 0); PG8_LDB(B1, 1, 1); PG8_SCHED; PG8_LDA(At, 1, 0); PG8_STAGE(PG8_SA(0, 1), a2 + hstep, voffA);
            PG8_WAIT_V(8); PG8_WAIT_L(0); PG8_BAR; PG8_MMA(0, 0, At, B0); PG8_MMA(0, 1, At, B1); PG8_BAR; PG8_SCHED;
            PG8_LDA(At, 1, 1); PG8_STAGE(PG8_SB(1, 0), b3, voffB); PG8_STAGE(PG8_SB(1, 1), b3 + hstep, voffB); PG8_STAGE(PG8_SA(1, 0), a3, voffA);
            PG8_WAIT_V(8); PG8_WAIT_L(0); PG8_BAR; PG8_MMA(1, 0, At, B0); PG8_MMA(1, 1, At, B1); PG8_BAR; PG8_SCHED;
            } else {
            PG8_LDB(B0, 0, 0); PG8_SCHED; PG8_LDA(At, 0, 0); PG8_STAGE(PG8_SA(1, 1), a1 + hstep, voffA);
            PG8_WAIT_L(8); PG8_BAR; PG8_WAIT_L(0); PG8_MMA(0, 0, At, B0); PG8_BAR; PG8_SCHED;
            PG8_LDB(B1, 0, 1); PG8_STAGE(PG8_SB(0, 0), b2, voffB);
            PG8_BAR; PG8_WAIT_L(0); PG8_MMA(0, 1, At, B1); PG8_BAR;
            PG8_LDA(At, 0, 1); PG8_STAGE(PG8_SA(0, 0), a2, voffA);
            PG8_BAR; PG8_WAIT_L(0); PG8_MMA(1, 0, At, B0); PG8_BAR; PG8_SCHED;
            PG8_STAGE(PG8_SB(0, 1), b2 + hstep, voffB);
            PG8_WAIT_V(6); PG8_BAR; PG8_MMA(1, 1, At, B1); PG8_BAR;
            PG8_LDB(B0, 1, 0); PG8_SCHED; PG8_LDA(At, 1, 0); PG8_STAGE(PG8_SA(0, 1), a2 + hstep, voffA);
            PG8_WAIT_L(8); PG8_BAR; PG8_WAIT_L(0); PG8_MMA(0, 0, At, B0); PG8_BAR; PG8_SCHED;
            PG8_LDB(B1, 1, 1); PG8_STAGE(PG8_SB(1, 0), b3, voffB);
            PG8_BAR; PG8_WAIT_L(0); PG8_MMA(0, 1, At, B1); PG8_BAR;
            PG8_LDA(At, 1, 1); PG8_STAGE(PG8_SA(1, 0), a3, voffA);
            PG8_BAR; PG8_WAIT_L(0); PG8_MMA(1, 0, At, B0); PG8_BAR; PG8_SCHED;
            PG8_STAGE(PG8_SB(1, 1), b3 + hstep, voffB);
            PG8_WAIT_V(6); PG8_BAR; PG8_MMA(1, 1, At, B1); PG8_BAR;
            }
        }
        if constexpr (ALIGN_EPI) { if (wr == 0) PG8_BAR; }
        if constexpr (!Epi::AFTER_DRAIN) { E(acc, cur, wr, wc, fr, fq); S.done(cur); }
        if (!has_next) break;
#pragma unroll
        for (int a = 0; a < 2; ++a)
#pragma unroll
            for (int b = 0; b < 2; ++b)
#pragma unroll
                for (int m = 0; m < 4; ++m)
#pragma unroll
                    for (int n = 0; n < 2; ++n) acc[a][b][m][n] = (f32x4){0.f, 0.f, 0.f, 0.f};
        cur = nxt; cA = nA; cB = nB; ++ui;
        if constexpr (ALIGN_EPI) { if (wr == 1) PG8_BAR; }
    }
    PG8_WAIT_V(0);
    if constexpr (!ALIGN_EPI) { if (wr == 0) PG8_BAR; }
    PG8_BAR;
    if constexpr (Epi::AFTER_DRAIN) { E.fused(acc, cur, wr, wc, fr, fq, lds, wid, lane); S.done(cur); }
#undef PG8_SA
#undef PG8_SB
#undef PG8_STAGE
#undef PG8_LDA
#undef PG8_LDB
#undef PG8_MMA
#undef PG8_WAIT_V
#undef PG8_WAIT_L
#undef PG8_BAR
#undef PG8_SCHED
}
}

constexpr int NWAVES = 8;
constexpr size_t MiB = 1u << 20;
constexpr size_t WS_CTL = 0, CTL_ZERO_BYTES = 2 * MiB;
constexpr size_t WS_ROPE = 2 * MiB;
constexpr size_t WS_W = 8 * MiB;
constexpr size_t W_IN = 0, W_ODA = W_IN + (size_t)P_TOTAL * 1024 * 2, W_ORW = W_ODA + 2 * MiB, W_OUT = W_ORW + 2 * MiB, W_UP = W_OUT + 2 * MiB,
                 W_DN = W_UP + (size_t)UPW * 1024 * 2, W_LORA = W_DN + (size_t)1024 * D_FF * 2, W_LAYER = W_LORA + (size_t)3072 * 256 * 2;
static_assert(W_LAYER == 42467328, "weights per layer");
constexpr size_t W_UP1 = W_LAYER;
constexpr size_t WS_DN1 = WS_ROPE + 256 * 1024;
static_assert(WS_DN1 + (size_t)1024 * D_FF * 2 <= WS_W, "W_DN1 slot");
constexpr size_t WS_XB = WS_W + W_LAYER + (size_t)1024 * UPW * 2;
constexpr size_t ACT = (size_t)MT * 1024 * 2;
constexpr size_t WS_POOL = WS_XB + ACT;
constexpr size_t B_Q = WS_POOL, B_K = B_Q + ACT, B_V = B_K + ACT, B_OC = B_V + ACT  , B_ORW = B_OC + 2 * ACT, B_URW = B_ORW + ACT, B_LD = B_URW + (size_t)MT * P_RW * 2, B_LA = B_LD + ACT,
                 B_LG = B_LA + ACT, B_END = B_LG + ACT;
constexpr size_t B_LIN = B_OC;
constexpr size_t B_GATE = B_Q, B_OA = B_V;
constexpr size_t B_MRG = B_URW;
constexpr size_t B_UP = WS_POOL, B_GT = B_URW;
constexpr size_t WS_SP = B_END;
constexpr size_t B_END2 = WS_SP + (size_t)1024 * 32 * 132 * 4;
static_assert(B_UP + (size_t)MT * UPW * 2 <= B_GT && B_GT + (size_t)MT * D_FF * 2 <= B_LD, "FFN overlay");
static_assert(B_END2 <= 512 * MiB, "workspace map");
constexpr int CW_BAR = 4096;
constexpr int CW_LAM = 8192;
constexpr int CW_SS = 16384;
static_assert((CW_SS + 5 * MT) * 4 <= (int)CTL_ZERO_BYTES, "CTL region");
constexpr int RING_OFF = 0, RING_BYTES = 131072;
constexpr int LDSCTL_OFF = RING_BYTES, MISC_OFF = LDSCTL_OFF + 320;
constexpr int LDS_BYTES = 147456;

constexpr int PH_PER_LAYER = 11;
constexpr int NPHASE = 1 + DEPTH * PH_PER_LAYER + 1;
enum { K_G1 = 0, K_LP, K_LR, K_SC, K_CB, K_M1, K_M2, K_WO, K_UP, K_CV, K_DN };

#include <hip/hip_bf16.h>
#include <cmath>
namespace attn_body {
using bf16=__hip_bfloat16;
using bf16x8=__attribute__((ext_vector_type(8)))short;
using s16x4=__attribute__((ext_vector_type(4)))short;
using f32x16=__attribute__((ext_vector_type(16)))float;
using u32x4=__attribute__((ext_vector_type(4)))unsigned;
constexpr int BATCH=8,SEQ=2048,D=64,DM=1024;
constexpr int NW=8,QBLK=32,QB=QBLK*NW,KVBLK=64,NQB=SEQ/QB;
constexpr int ATTN_PITCH=DM, ATTN_UNIT_ROWS=QB;
__device__ __forceinline__ int crow(int r,int hi){return (r&3)+8*(r>>2)+4*hi;}
#define SBAR() __builtin_amdgcn_sched_barrier(0)
__device__ __forceinline__ void cmask(f32x16&p0,f32x16&p1,int jb,int wid){
  const float NEG=-INFINITY;
  if(jb>(wid>>1)){
    #pragma unroll
    for(int r=0;r<16;++r){p0[r]=NEG;p1[r]=NEG;}
  }
}

constexpr int NSLOT=3, SLOTB=8192;
constexpr int LDS_K=0, LDS_V=NSLOT*SLOTB, LDS_WS=2*NSLOT*SLOTB, LDS_OST=LDS_WS+NW*64*4, LDS_BYTES=LDS_OST+NW*4096;
constexpr float C2=0.125f*1.4426950408889634f;
__device__ __forceinline__ void glds16(const void*gsrc,unsigned lds_dst){unsigned keep;
  asm volatile("s_mov_b32 %0, m0\n\ts_mov_b32 m0, %2\n\ts_nop 0\n\tglobal_load_lds_dwordx4 %1, off\n\ts_mov_b32 m0, %0":"=&s"(keep):"v"(gsrc),"s"(lds_dst):"memory");}
__device__ __forceinline__ float max3f(float a,float b,float c){float r;asm("v_max3_f32 %0, %1, %2, %3":"=v"(r):"v"(a),"v"(b),"v"(c));return r;}
__device__ __forceinline__ float max2f(float a,float b){float r;asm("v_max_f32_e32 %0, %1, %2":"=v"(r):"v"(a),"v"(b));return r;}
__device__ __forceinline__ float fadd_s(float a,float b){float r;asm("v_add_f32_e32 %0, %1, %2":"=v"(r):"v"(a),"v"(b));return r;}
__device__ __forceinline__ float fsub_s(float a,float b){float r;asm("v_sub_f32_e32 %0, %1, %2":"=v"(r):"v"(a),"v"(b));return r;}
typedef float f32x2_t __attribute__((ext_vector_type(2))); typedef __bf16 bf16x2_t __attribute__((ext_vector_type(2)));
__device__ __forceinline__ unsigned cvtpk_s(float lo,float hi){f32x2_t v={lo,hi};bf16x2_t b=__builtin_convertvector(v,bf16x2_t);return __builtin_bit_cast(unsigned,b);}
#define WAIT_BAR(N) asm volatile("s_waitcnt vmcnt(" #N ") lgkmcnt(0)\n\ts_barrier":::"memory")

__device__ __forceinline__ void qkt(f32x16&p0,f32x16&p1,const char*Kslot,const bf16x8*qr,const f32x16&negm,int r32,int hi){
  const char*kb=Kslot+hi*1024+r32*16;
  #pragma unroll
  for(int d0=0;d0<4;++d0){
    const bf16x8 b0=*reinterpret_cast<const bf16x8*>(kb+d0*2048);
    const bf16x8 b1=*reinterpret_cast<const bf16x8*>(kb+d0*2048+512);
    if(d0==0){p0=__builtin_amdgcn_mfma_f32_32x32x16_bf16(b0,qr[0],negm,0,0,0);p1=__builtin_amdgcn_mfma_f32_32x32x16_bf16(b1,qr[0],negm,0,0,0);}
    else{p0=__builtin_amdgcn_mfma_f32_32x32x16_bf16(b0,qr[d0],p0,0,0,0);p1=__builtin_amdgcn_mfma_f32_32x32x16_bf16(b1,qr[d0],p1,0,0,0);}}
}
typedef __attribute__((address_space(3))) const char* lds_cptr;
typedef short v4i16_t __attribute__((ext_vector_type(4)));
__device__ __forceinline__ void kload8(bf16x8*kf,lds_cptr kp){
  kf[0]=*(const __attribute__((address_space(3))) bf16x8*)(kp);      kf[1]=*(const __attribute__((address_space(3))) bf16x8*)(kp+512);
  kf[2]=*(const __attribute__((address_space(3))) bf16x8*)(kp+2048); kf[3]=*(const __attribute__((address_space(3))) bf16x8*)(kp+2560);
  kf[4]=*(const __attribute__((address_space(3))) bf16x8*)(kp+4096); kf[5]=*(const __attribute__((address_space(3))) bf16x8*)(kp+4608);
  kf[6]=*(const __attribute__((address_space(3))) bf16x8*)(kp+6144); kf[7]=*(const __attribute__((address_space(3))) bf16x8*)(kp+6656);
}
__device__ __forceinline__ void kload2(bf16x8*kf,lds_cptr kp,int j){ kf[2*j]=*(const __attribute__((address_space(3))) bf16x8*)(kp+j*2048); kf[2*j+1]=*(const __attribute__((address_space(3))) bf16x8*)(kp+j*2048+512); }
__device__ __forceinline__ s16x4 vtr(lds_cptr p){ return __builtin_bit_cast(s16x4,__builtin_amdgcn_ds_read_tr16_b64_v4i16((__attribute__((address_space(3))) v4i16_t*)p)); }
__device__ __forceinline__ float rowmax(const f32x16&p0,const f32x16&p1){
  float a=max3f(p0[0],p0[1],p1[0]),b=max3f(p0[2],p0[3],p1[1]);a=max3f(a,p1[2],p1[3]);
  #pragma unroll
  for(int r=4;r<16;r+=4){a=max3f(a,p0[r],p0[r+1]);b=max3f(b,p0[r+2],p0[r+3]);a=max3f(a,p1[r],p1[r+1]);b=max3f(b,p1[r+2],p1[r+3]);}
  const float m=max2f(a,b);
  auto rr=__builtin_amdgcn_permlane32_swap(__float_as_uint(m),__float_as_uint(m),false,false);
  return max2f(__uint_as_float(rr[0]),__uint_as_float(rr[1]));
}
__device__ __forceinline__ void pv(f32x16*o,int vb,bf16x8 pa0,bf16x8 pa1,bf16x8 pa2,bf16x8 pa3){
  #pragma unroll
  for(int d0=0;d0<2;++d0){s16x4 lo[4],hi[4];
    #pragma unroll
    for(int ks=0;ks<4;++ks){
      asm volatile("ds_read_b64_tr_b16 %0,%1 offset:%c2":"=&v"(lo[ks]):"v"(vb),"i"(d0*4096+ks*1024):"memory");
      asm volatile("ds_read_b64_tr_b16 %0,%1 offset:%c2":"=&v"(hi[ks]):"v"(vb),"i"(d0*4096+ks*1024+512):"memory");}
    asm volatile("s_waitcnt lgkmcnt(0)":::"memory");SBAR();
    #define PK(k) (bf16x8){lo[k][0],lo[k][1],lo[k][2],lo[k][3],hi[k][0],hi[k][1],hi[k][2],hi[k][3]}
    o[d0]=__builtin_amdgcn_mfma_f32_32x32x16_bf16(pa0,PK(0),o[d0],0,0,0);
    o[d0]=__builtin_amdgcn_mfma_f32_32x32x16_bf16(pa1,PK(1),o[d0],0,0,0);
    o[d0]=__builtin_amdgcn_mfma_f32_32x32x16_bf16(pa2,PK(2),o[d0],0,0,0);
    o[d0]=__builtin_amdgcn_mfma_f32_32x32x16_bf16(pa3,PK(3),o[d0],0,0,0);
    #undef PK
  }
}

#ifndef ATTN_STORE16
#define ATTN_STORE16(p,v) (*(u32x4*)(p)=(v))
#endif
template<int THRL> __device__ __forceinline__ void attn_unit(int b,int qcol,int vcol,int qb,const bf16*Q,const bf16*K,const bf16*V,bf16*O,char*shm){
  const int tid=threadIdx.x,lane=tid&63,r32=lane&31,hi=lane>>5; const int wid=__builtin_amdgcn_readfirstlane(tid>>6);
  const long rowbase=(long)b*SEQ; const int q0=qb*QB;
  const bf16*Qw=Q+(rowbase+q0+wid*QBLK)*DM+qcol;
  const bf16*Kh=K+rowbase*DM+qcol,*Vh=V+rowbase*DM+vcol;
  const unsigned lds0=(unsigned)(uintptr_t)shm;
  float*wsf=(float*)(shm+LDS_WS)+wid*64;
  const bf16*ksrc=Kh+(long)lane*DM+wid*8;
  const bf16*vsrc=Vh+(long)(16*(wid&3)+(lane>>2))*DM+(wid>>2)*32+(lane&3)*8;
  const unsigned kdst=lds0+LDS_K+wid*1024, vdst=lds0+LDS_V+wid*1024;
  #define DMA_K(t,slot) glds16(ksrc+(long)(t)*KVBLK*DM,(unsigned)__builtin_amdgcn_readfirstlane(kdst+(slot)))
  #define DMA_V(t,slot) glds16(vsrc+(long)(t)*KVBLK*DM,(unsigned)__builtin_amdgcn_readfirstlane(vdst+(slot)))
  const int vb0=(int)(lds0+LDS_V)+((lane>>4)&1)*32+(lane&3)*8+(4*hi+((lane&15)>>2))*64;
  const char*Kbase=shm+LDS_K; bf16x8 kf[8];
  const lds_cptr shm3=(lds_cptr)shm; const lds_cptr kp0=shm3+LDS_K+hi*1024+r32*16; const lds_cptr vp0=shm3+LDS_V+((lane>>4)&1)*32+(lane&3)*8+(4*hi+((lane&15)>>2))*64;
  const int NT=(q0+QB)/KVBLK;
  DMA_K(0,0);DMA_V(0,0);DMA_K(1,SLOTB);
  bf16x8 qr[4];
  #pragma unroll
  for(int d0=0;d0<4;++d0)qr[d0]=*reinterpret_cast<const bf16x8*>(&Qw[(long)r32*DM+d0*16+hi*8]);
  float mhat=0.f,l_reg=0.f;f32x16 o[2];o[0]=f32x16{};o[1]=f32x16{};const f32x16 zc=f32x16{}; float nm=0.f;
  const int qrel=wid*QBLK+r32;
  #define CMASK(P0,P1,t) do{int jb_=(t)-(NT-4); if(jb_>=0)cmask(P0,P1,jb_,wid);}while(0)
  bool resc=false;
  #define START(P0,P1) do{ const float rm=rowmax(P0,P1); resc=false; \
    { const float dl=rm; mhat=fadd_s(mhat,dl); \
      _Pragma("unroll") for(int r=0;r<16;++r){P0[r]=fsub_s(P0[r],dl);P1[r]=fsub_s(P1[r],dl);} \
      nm=-mhat; } \
    _Pragma("unroll") for(int r=0;r<16;++r)P0[r]=__builtin_amdgcn_exp2f(P0[r]); }while(0)
  #define RESC() do{ if(resc){ asm volatile("s_waitcnt lgkmcnt(0)":::"memory"); \
      _Pragma("unroll") for(int d_=0;d_<2;++d_) _Pragma("unroll") for(int r=0;r<16;++r)o[d_][r]*=wsf[crow(r,hi)]; } }while(0)
  f32x16 pA0,pA1,pB0,pB1;
  int sl_prev=0,sl_cur=0,sl_next=SLOTB;
  #define ROT() do{sl_prev=sl_cur;sl_cur=sl_next;sl_next=(sl_next==(NSLOT-1)*SLOTB)?0:sl_next+SLOTB;}while(0)
  DMA_K(2,2*SLOTB);
  WAIT_BAR(3);
  qkt(pA0,pA1,Kbase,qr,zc,r32,hi);asm volatile("s_nop 15\n\ts_nop 7":"+v"(pA0),"+v"(pA1));CMASK(pA0,pA1,0);
  START(pA0,pA1);
  _Pragma("unroll") for(int r=0;r<16;++r)pA1[r]=__builtin_amdgcn_exp2f(pA1[r]);
  WAIT_BAR(0);
  DMA_K(3,0);DMA_V(1,SLOTB);
  ROT();
  kload8(kf,kp0+sl_cur);
  WAIT_BAR(2);
  s16x4 vlo[8],vhi[8]; u32x4 pw0,pw1,pw2,pw3;
  #define PKW(P,B) cvtpk_s(P[B],P[B+1])
  #define PAF(k) __builtin_bit_cast(bf16x8,pw##k)
  #define VFR(i) (bf16x8){vlo[i][0],vlo[i][1],vlo[i][2],vlo[i][3],vhi[i][0],vhi[i][1],vhi[i][2],vhi[i][3]}
  #define PIN(x) asm volatile("":"+v"(x))
  #define MX3(a,b,c) __builtin_fmaxf(__builtin_fmaxf((a),(b)),(c))
  #define GAPA(MF,A0,A1,A2,A3,W0,W1,PW) do{ MF; sacc+=A0; sacc+=A1; sacc+=A2; sacc+=A3; PIN(sacc); W0; W1; PIN(PW); SBAR(); }while(0)
  #define EX(v) __builtin_amdgcn_exp2f(v)
  #define GAPB(MF,X,B) do{ MF; X[B]=EX(X[B]); X[B+1]=EX(X[B+1]); X[B+2]=EX(X[B+2]); X[B+3]=EX(X[B+3]); PIN(X); SBAR(); }while(0)
  #define VRD(i) do{ vlo[i]=vtr(vp_+(((i)>>2)*4096+((i)&3)*1024)); vhi[i]=vtr(vp_+(((i)>>2)*4096+((i)&3)*1024+512)); }while(0)
  #define KRD(G,j) do{ if(G){ kload2(kf,kp0+sl_next,j); SBAR(); } }while(0)
  #define STEP(C0,C1,P0,P1,t,GK,GV,GL) do{ SBAR(); \
    const lds_cptr vp_=vp0+sl_prev; \
    VRD(0); SBAR(); float sacc=(P0[0]+P0[1]); \
    GAPA(C0=__builtin_amdgcn_mfma_f32_32x32x16_bf16(kf[0],qr[0],zc,0,0,0), P0[2],P0[3],P0[4],P0[5],     pw0[0]=PKW(P0,0), pw0[1]=PKW(P0,2), pw0); \
    VRD(4); SBAR(); GAPA(C1=__builtin_amdgcn_mfma_f32_32x32x16_bf16(kf[1],qr[0],zc,0,0,0), P0[6],P0[7],P0[8],P0[9],     pw0[2]=PKW(P0,4), pw0[3]=PKW(P0,6), pw0); \
    VRD(1); SBAR(); GAPA(C0=__builtin_amdgcn_mfma_f32_32x32x16_bf16(kf[2],qr[1],C0,0,0,0),   P0[10],P0[11],P0[12],P0[13], pw1[0]=PKW(P0,8), pw1[1]=PKW(P0,10), pw1); \
    VRD(5); SBAR(); GAPA(C1=__builtin_amdgcn_mfma_f32_32x32x16_bf16(kf[3],qr[1],C1,0,0,0),   P0[14],P0[15],P1[0],P1[1],   pw1[2]=PKW(P0,12),pw1[3]=PKW(P0,14), pw1); \
    VRD(2); SBAR(); GAPA(C0=__builtin_amdgcn_mfma_f32_32x32x16_bf16(kf[4],qr[2],C0,0,0,0),   P1[2],P1[3],P1[4],P1[5],     pw2[0]=PKW(P1,0), pw2[1]=PKW(P1,2), pw2); \
    VRD(6); SBAR(); GAPA(C1=__builtin_amdgcn_mfma_f32_32x32x16_bf16(kf[5],qr[2],C1,0,0,0),   P1[6],P1[7],P1[8],P1[9],     pw2[2]=PKW(P1,4), pw2[3]=PKW(P1,6), pw2); \
    VRD(3); SBAR(); GAPA(C0=__builtin_amdgcn_mfma_f32_32x32x16_bf16(kf[6],qr[3],C0,0,0,0),   P1[10],P1[11],P1[12],P1[13], pw3[0]=PKW(P1,8), pw3[1]=PKW(P1,10), pw3); \
    VRD(7); SBAR(); GAPA(C1=__builtin_amdgcn_mfma_f32_32x32x16_bf16(kf[7],qr[3],C1,0,0,0),   P1[14],P1[15],0.f,0.f,       pw3[2]=PKW(P1,12),pw3[3]=PKW(P1,14), pw3); \
    l_reg+=sacc; \
    if(GK){DMA_K((t)+3,sl_cur);} if(GV){DMA_V((t)+1,sl_next);} \
    _Pragma("unroll") for(int r=0;r<16;++r){C0[r]+=nm;C1[r]+=nm;} \
    CMASK(C0,C1,t); \
    { float a=MX3(C0[0],C0[1],C1[0]),b=MX3(C0[2],C0[3],C1[1]); a=MX3(a,C1[2],C1[3]); \
      _Pragma("unroll") for(int r=4;r<16;r+=4){a=MX3(a,C0[r],C0[r+1]);b=MX3(b,C0[r+2],C0[r+3]);a=MX3(a,C1[r],C1[r+1]);b=MX3(b,C1[r+2],C1[r+3]);} \
      float rm=__builtin_fmaxf(a,b); { auto rr=__builtin_amdgcn_permlane32_swap(__float_as_uint(rm),__float_as_uint(rm),false,false); rm=__builtin_fmaxf(__uint_as_float(rr[0]),__uint_as_float(rr[1])); } \
      resc=false; \
      if(__builtin_expect(__any(rm>(float)THRL),0)){ const float dl=__builtin_fmaxf(rm,0.f); mhat+=dl; \
        _Pragma("unroll") for(int r=0;r<16;++r){C0[r]-=dl;C1[r]-=dl;} \
        nm=-mhat; \
        const float f=__builtin_amdgcn_exp2f(-dl); l_reg*=f; if(hi==0)wsf[r32]=f; resc=true; } } \
    SBAR(); \
    GAPB(o[0]=__builtin_amdgcn_mfma_f32_32x32x16_bf16(PAF(0),VFR(0),o[0],0,0,0), C0,0); \
    GAPB(o[1]=__builtin_amdgcn_mfma_f32_32x32x16_bf16(PAF(0),VFR(4),o[1],0,0,0), C0,4); \
    KRD(GL,0); GAPB(o[0]=__builtin_amdgcn_mfma_f32_32x32x16_bf16(PAF(1),VFR(1),o[0],0,0,0), C0,8); \
    KRD(GL,1); GAPB(o[1]=__builtin_amdgcn_mfma_f32_32x32x16_bf16(PAF(1),VFR(5),o[1],0,0,0), C0,12); \
    KRD(GL,2); GAPB(o[0]=__builtin_amdgcn_mfma_f32_32x32x16_bf16(PAF(2),VFR(2),o[0],0,0,0), C1,0); \
    KRD(GL,3); GAPB(o[1]=__builtin_amdgcn_mfma_f32_32x32x16_bf16(PAF(2),VFR(6),o[1],0,0,0), C1,4); \
    GAPB(o[0]=__builtin_amdgcn_mfma_f32_32x32x16_bf16(PAF(3),VFR(3),o[0],0,0,0), C1,8); \
    GAPB(o[1]=__builtin_amdgcn_mfma_f32_32x32x16_bf16(PAF(3),VFR(7),o[1],0,0,0), C1,12); \
    }while(0)
  int t=1;
  #undef CMASK
  #define CMASK(P0,P1,t) do{}while(0)
  for(;t+5<NT;t+=2){
    STEP(pB0,pB1,pA0,pA1,t,true,true,true);     WAIT_BAR(2); RESC(); ROT();
    STEP(pA0,pA1,pB0,pB1,t+1,true,true,true);   WAIT_BAR(2); RESC(); ROT();
  }
  #undef CMASK
  #define CMASK(P0,P1,t) do{int jb_=(t)-(NT-4); if(jb_>=0)cmask(P0,P1,jb_,wid);}while(0)
  #define ENDW(tt) do{ if((tt)+3<NT){WAIT_BAR(2);} else if((tt)+2<NT){WAIT_BAR(1);} else {WAIT_BAR(0);} }while(0)
  for(;t+1<NT;t+=2){
    STEP(pB0,pB1,pA0,pA1,t,(t+3<NT),(t+1<NT),(t+1<NT));       ENDW(t);   RESC(); ROT();
    STEP(pA0,pA1,pB0,pB1,t+1,(t+4<NT),(t+2<NT),(t+2<NT));     ENDW(t+1); RESC(); ROT();
  }
  STEP(pB0,pB1,pA0,pA1,NT-1,false,false,false); RESC();
  { float sacc=pB0[0]+pB0[1]; _Pragma("unroll") for(int r=2;r<16;++r)sacc+=pB0[r]; _Pragma("unroll") for(int r=0;r<16;++r)sacc+=pB1[r]; l_reg+=sacc;
    pw0=(u32x4){PKW(pB0,0),PKW(pB0,2),PKW(pB0,4),PKW(pB0,6)};pw1=(u32x4){PKW(pB0,8),PKW(pB0,10),PKW(pB0,12),PKW(pB0,14)};pw2=(u32x4){PKW(pB1,0),PKW(pB1,2),PKW(pB1,4),PKW(pB1,6)};pw3=(u32x4){PKW(pB1,8),PKW(pB1,10),PKW(pB1,12),PKW(pB1,14)};
    SBAR(); pv(o,vb0+sl_cur,PAF(0),PAF(1),PAF(2),PAF(3)); }
  #undef PKW
  #undef PAF
  #undef VFR
  #undef PIN
  #undef MX3
  #undef GAPA
  #undef GAPB
  #undef EX
  #undef VRD
  #undef KRD
  #undef STEP
  #undef ENDW
  {auto rr=__builtin_amdgcn_permlane32_swap(__float_as_uint(l_reg),__float_as_uint(l_reg),false,false);l_reg=__uint_as_float(rr[0])+__uint_as_float(rr[1]);}
  if(hi==0)wsf[32+r32]=l_reg;asm volatile("s_waitcnt lgkmcnt(0)":::"memory");
  float rli[16];
  #pragma unroll
  for(int r=0;r<16;++r)rli[r]=__builtin_amdgcn_rcpf(wsf[32+crow(r,hi)]);
  bf16*Ow=O+(rowbase+q0+wid*QBLK)*DM+vcol;
  { bf16*stg=(bf16*)(shm+LDS_OST)+wid*2048;
    #pragma unroll
    for(int r=0;r<16;++r){const int orow=crow(r,hi);
      #pragma unroll
      for(int d0=0;d0<2;++d0)stg[orow*64+d0*32+r32]=__float2bfloat16(o[d0][r]*rli[r]);}
    asm volatile("s_waitcnt lgkmcnt(0)":::"memory");
    #pragma unroll
    for(int i=0;i<4;++i){const int row=i*8+(lane>>3),ch=lane&7; const u32x4 v=*(const u32x4*)(stg+row*64+ch*8); ATTN_STORE16(Ow+(long)row*DM+ch*8,v);} }
  asm volatile("s_waitcnt lgkmcnt(0)\n\ts_barrier":::"memory");
  #undef DMA_K
  #undef DMA_V
  #undef CMASK
  #undef START
  #undef RESC
  #undef ROT
}
typedef float f32x4 __attribute__((ext_vector_type(4)));
constexpr int SA_K0=0, SA_K1=8192, SA_V0=16384, SA_V1=24576, SA_WS=32768, SA_BYTES=SA_WS+8*256;
__device__ __forceinline__ unsigned pk2bf(float lo,float hi){return cvtpk_s(lo,hi);}
__device__ __forceinline__ void sample_unit(int l,int b,int h,int s,const float*cache_k,const float*cache_v,const bf16*Q,const bf16*K,const bf16*V,float*SP,char*shm){
  const int tid=threadIdx.x,lane=tid&63,r32=lane&31,hi=lane>>5; const int wid=__builtin_amdgcn_readfirstlane(tid>>6);
  const unsigned lds0=(unsigned)(uintptr_t)shm;
  float*wsf=(float*)(shm+SA_WS)+wid*64;
  const int c=wid>>1,vh=wid&1;
  const int qrow=16384+b*32;
  bf16x8 qr[4];
  if(wid<4){
    #pragma unroll
    for(int d0=0;d0<4;++d0)qr[d0]=*reinterpret_cast<const bf16x8*>(&Q[(long)(qrow+r32)*DM+h*128+c*64+d0*16+hi*8]);
  }
  float m=-1e30f,lsum=0.f; f32x16 o[2]; o[0]=f32x16{}; o[1]=f32x16{};
  const f32x16 zc=f32x16{};
  const int ntile=(s==7)?5:4;
  const float*ckb=cache_k+((long)(l*8+b)*2048)*1024+h*128; const float*cvb=cache_v+((long)(l*8+b)*2048)*1024+h*128;
  for(int ti=0;ti<ntile;++ti){
    const bool fresh=(ti==4);
    #pragma unroll
    for(int pi=0;pi<2;++pi){
      const int pk=wid*2+pi;
      { const int kc=pk>>3,ch=pk&7; u32x4 wv;
        if(!fresh){ const float*src=ckb+(long)((4*s+ti)*64+lane)*1024+kc*64+ch*8; const f32x4 a=*(const f32x4*)src,bq=*(const f32x4*)(src+4);
          wv.x=pk2bf(a.x,a.y);wv.y=pk2bf(a.z,a.w);wv.z=pk2bf(bq.x,bq.y);wv.w=pk2bf(bq.z,bq.w); }
        else if(lane<32){ wv=*(const u32x4*)(K+(long)(qrow+lane)*DM+h*128+kc*64+ch*8); }
        else { wv=(u32x4){0u,0u,0u,0u}; }
        *(u32x4*)(shm+(kc?SA_K1:SA_K0)+ch*1024+lane*16)=wv; }
      { const int vv=pk>>3,p=pk&7; const int row=16*(p&3)+(lane>>2),col=vv*64+32*(p>>2)+8*(lane&3); u32x4 wv;
        if(!fresh){ const float*src=cvb+(long)((4*s+ti)*64+row)*1024+col; const f32x4 a=*(const f32x4*)src,bq=*(const f32x4*)(src+4);
          wv.x=pk2bf(a.x,a.y);wv.y=pk2bf(a.z,a.w);wv.z=pk2bf(bq.x,bq.y);wv.w=pk2bf(bq.z,bq.w); }
        else if(row<32){ wv=*(const u32x4*)(V+(long)(qrow+row)*DM+h*128+col); }
        else { wv=(u32x4){0u,0u,0u,0u}; }
        *(u32x4*)(shm+(vv?SA_V1:SA_V0)+p*1024+lane*16)=wv; }
    }
    __syncthreads();
    if(wid<4){
      f32x16 p0,p1;
      qkt(p0,p1,shm+(c?SA_K1:SA_K0),qr,zc,r32,hi);
      if(fresh){
        #pragma unroll
        for(int r=0;r<16;++r)p1[r]=-INFINITY;
      }
      float rm=p0[0];
      #pragma unroll
      for(int r=1;r<16;++r)rm=__builtin_fmaxf(rm,p0[r]);
      #pragma unroll
      for(int r=0;r<16;++r)rm=__builtin_fmaxf(rm,p1[r]);
      rm=__builtin_fmaxf(rm,__shfl_xor(rm,32));
      const float mn=__builtin_fmaxf(m,rm),alpha=__builtin_amdgcn_exp2f(m-mn);
      float ps=0.f;
      #pragma unroll
      for(int r=0;r<16;++r){p0[r]=__builtin_amdgcn_exp2f(p0[r]-mn);p1[r]=__builtin_amdgcn_exp2f(p1[r]-mn);ps+=p0[r]+p1[r];}
      lsum=lsum*alpha+ps; m=mn;
      if(hi==0)wsf[r32]=alpha;
      asm volatile("s_waitcnt lgkmcnt(0)":::"memory");
      #pragma unroll
      for(int g=0;g<4;++g){ const f32x4 f4=*(const f32x4*)(wsf+8*g+4*hi);
        #pragma unroll
        for(int i=0;i<4;++i){o[0][4*g+i]*=f4[i];o[1][4*g+i]*=f4[i];} }
      u32x4 pw0,pw1,pw2,pw3;
      pw0=(u32x4){pk2bf(p0[0],p0[1]),pk2bf(p0[2],p0[3]),pk2bf(p0[4],p0[5]),pk2bf(p0[6],p0[7])};
      pw1=(u32x4){pk2bf(p0[8],p0[9]),pk2bf(p0[10],p0[11]),pk2bf(p0[12],p0[13]),pk2bf(p0[14],p0[15])};
      pw2=(u32x4){pk2bf(p1[0],p1[1]),pk2bf(p1[2],p1[3]),pk2bf(p1[4],p1[5]),pk2bf(p1[6],p1[7])};
      pw3=(u32x4){pk2bf(p1[8],p1[9]),pk2bf(p1[10],p1[11]),pk2bf(p1[12],p1[13]),pk2bf(p1[14],p1[15])};
      const int vb=(int)(lds0+(vh?SA_V1:SA_V0))+((lane>>4)&1)*32+(lane&3)*8+(4*hi+((lane&15)>>2))*64;
      pv(o,vb,__builtin_bit_cast(bf16x8,pw0),__builtin_bit_cast(bf16x8,pw1),__builtin_bit_cast(bf16x8,pw2),__builtin_bit_cast(bf16x8,pw3));
    }
    __syncthreads();
  }
  if(wid<4){
    lsum+=__shfl_xor(lsum,32);
    float*sp=SP+((long)(((b*8+h)*2+c)*8+s)*32)*132;
    if(vh==0&&hi==0){sp[r32*132]=m;sp[r32*132+1]=lsum;}
    #pragma unroll
    for(int d0=0;d0<2;++d0)
      #pragma unroll
      for(int r=0;r<16;++r)sp[crow(r,hi)*132+4+vh*64+32*d0+r32]=o[d0][r];
  }
}
constexpr int ATTN_LDS_BYTES=LDS_BYTES;
#undef SBAR
#undef WAIT_BAR
}

#define GAS __attribute__((address_space(1)))
#define LAS __attribute__((address_space(3)))
typedef unsigned short bf16;
typedef unsigned v4u __attribute__((ext_vector_type(4)));
typedef float f32x4 __attribute__((ext_vector_type(4)));
typedef short bf16x8 __attribute__((ext_vector_type(8)));
typedef GAS unsigned gu32;
typedef GAS unsigned long long gu64;
#define RLX_AGENT __ATOMIC_RELAXED, __HIP_MEMORY_SCOPE_AGENT
#define LDS_WAIT() asm volatile("s_waitcnt lgkmcnt(0)" ::: "memory")
#define VM_WAIT() asm volatile("s_waitcnt vmcnt(0)" ::: "memory")
__device__ __forceinline__ unsigned long long rt() { return __builtin_amdgcn_s_memrealtime(); }
__device__ __forceinline__ unsigned f2bf(float f) { unsigned u = __builtin_bit_cast(unsigned, f); return (u + 0x7fffu + ((u >> 16) & 1u)) >> 16; }
__device__ __forceinline__ unsigned pk2(float lo, float hi) { return f2bf(lo) | (f2bf(hi) << 16); }

#define XB_TMO      128
#define XB_XCNT(j)  (256  + 64 * (j))
#define XB_XSUB(j)  (1280 + 64 * (j))
#define XB_XGEN(j)  (2304 + 64 * (j))
#define XB_TOP      3328
#define XB_TOPGEN   3392
#define XCD_BAR_WORDS 3456
#define XB_SPIN_CAP (1u << 22)

__device__ __forceinline__ unsigned xb_ld(unsigned* p)              { return __hip_atomic_load(p, __ATOMIC_RELAXED, __HIP_MEMORY_SCOPE_AGENT); }
__device__ __forceinline__ unsigned xb_add(unsigned* p, unsigned v) { return __hip_atomic_fetch_add(p, v, __ATOMIC_RELAXED, __HIP_MEMORY_SCOPE_AGENT); }
__device__ __forceinline__ unsigned xb_xcc_id() { return (unsigned)__builtin_amdgcn_s_getreg((3 << 11) | 20) & 0xFu; }
#define XB_SPIN(cond, bar) do { unsigned _sp = 0; while (cond) { __builtin_amdgcn_s_sleep(1); \
    if ((++_sp & 255u) == 0u) { if (xb_ld(&(bar)[XB_TMO])) break; if (_sp > XB_SPIN_CAP) { atomicAdd(&(bar)[XB_TMO], 1u); break; } } } } while (0)

struct XcdBarrier {
    unsigned* bar; unsigned x;
    volatile LAS unsigned* st;
};

__device__ __forceinline__ XcdBarrier xcd_barrier_post(unsigned* bar, volatile LAS unsigned* st) {
    XcdBarrier b; b.bar = bar; b.x = xb_xcc_id(); b.st = st;
    if (threadIdx.x == 0) (void)xb_add(&bar[XB_XCNT(b.x)], 1u);
    return b;
}
__device__ __forceinline__ void xcd_barrier_complete(unsigned* bar, unsigned x, unsigned& nloc, unsigned& nx) {
    const unsigned G = gridDim.x * gridDim.y * gridDim.z;
    unsigned sum, cnt, mine, sp = 0u;
    for (;;) {
        sum = 0u; cnt = 0u; mine = 0u;
#pragma unroll
        for (unsigned j = 0; j < 16; ++j) { const unsigned c = xb_ld(&bar[XB_XCNT(j)]); sum += c; cnt += (c > 0u) ? 1u : 0u; mine = (j == x) ? c : mine; }
        if (sum == G) break;
        __builtin_amdgcn_s_sleep(1);
        if ((++sp & 255u) == 0u) { if (xb_ld(&bar[XB_TMO])) break; if (sp > XB_SPIN_CAP) { atomicAdd(&bar[XB_TMO], 1u); break; } }
    }
    nloc = mine > 0u ? mine : 1u; nx = cnt > 0u ? cnt : 1u;
}

__device__ __forceinline__ void xcd_barrier(const XcdBarrier& b) {
    asm volatile("s_waitcnt vmcnt(0)" ::: "memory");
    __syncthreads();
    if (threadIdx.x == 0) {
        unsigned* bar = b.bar;
        __builtin_amdgcn_s_waitcnt(0);
        unsigned nloc = b.st[0], nx = b.st[1];
        if (nloc == 0u) { xcd_barrier_complete(bar, b.x, nloc, nx); b.st[0] = nloc; b.st[1] = nx; }
        const unsigned old = xb_add(&bar[XB_XSUB(b.x)], 1u);
        const unsigned gen = old / nloc;
        if (old + 1u == (gen + 1u) * nloc) {
            __builtin_amdgcn_fence(__ATOMIC_RELEASE, "agent");
            asm volatile("s_waitcnt vmcnt(0)" ::: "memory");
            const unsigned og = xb_add(&bar[XB_TOP], 1u);
            const unsigned tg = og / nx;
            if (og + 1u == (tg + 1u) * nx) xb_add(&bar[XB_TOPGEN], 1u);
            else XB_SPIN(xb_ld(&bar[XB_TOPGEN]) == tg, bar);
            __builtin_amdgcn_fence(__ATOMIC_ACQUIRE, "agent");
            xb_add(&bar[XB_XGEN(b.x)], 1u);
            asm volatile("s_waitcnt vmcnt(0)" ::: "memory");
        } else {
            XB_SPIN(xb_ld(&bar[XB_XGEN(b.x)]) == gen, bar);
            __builtin_amdgcn_fence(__ATOMIC_ACQUIRE, "agent");
            asm volatile("s_waitcnt vmcnt(0)" ::: "memory");
        }
    }
    __syncthreads();
}

struct Args { const GAS float* in[31]; GAS float* out; GAS unsigned char* ws; float rinv[8]; int ph_lo, ph_hi; };
#define GIN(A, i) ((const float*)((A)->in[i]))
typedef const Args __attribute__((address_space(4)))* CArgsP;
struct Frame {
    LAS unsigned char* lds;
    volatile LAS unsigned* MISC;
    gu32* ctl;
    int tid, lane, wave, vcu, G;
    float* out; unsigned char* ws;
};
__device__ __forceinline__ float wave_sum(float v) {
#pragma unroll
    for (int o = 1; o < 64; o <<= 1) v += __shfl_xor(v, o);
    return v;
}
template <int CTRL> __device__ __forceinline__ float dppf(float x) { return __builtin_bit_cast(float, __builtin_amdgcn_update_dpp(0, __builtin_bit_cast(int, x), CTRL, 0xF, 0xF, false)); }
__device__ __forceinline__ float reduce8(float x) { x += dppf<0xB1>(x); x += dppf<0x4E>(x); x += dppf<0x141>(x); return x; }
__device__ __forceinline__ float reduce16(float x) { x = reduce8(x); x += dppf<0x140>(x); return x; }
__device__ __forceinline__ float bf2f(bf16 h) { return __uint_as_float((unsigned)h << 16); }
__device__ __forceinline__ float bflo(unsigned w) { return __uint_as_float(w << 16); }
__device__ __forceinline__ float bfhi(unsigned w) { return __uint_as_float(w & 0xffff0000u); }

__device__ __forceinline__ void p0_transpose_item(const float* W, int N, bf16* WT, int ldk, int koff, int row_off, const float* kscale, LAS float* scr, int item, int lane) {
    const int nblk = N / 32, kb = item / nblk, nb = item % nblk, k0 = 64 * kb, n0 = 32 * nb;
    float wv[32];
#pragma unroll
    for (int i = 0; i < 32; ++i) wv[i] = W[(size_t)(k0 + 2 * i + (lane >> 5)) * N + n0 + (lane & 31)];
#pragma unroll
    for (int i = 0; i < 32; ++i) { const int kk = 2 * i + (lane >> 5); float w = wv[i]; if (kscale) w *= kscale[k0 + kk]; scr[kk * 33 + (lane & 31)] = w; }
    LDS_WAIT(); asm volatile("" ::: "memory");
    const int c = lane & 7;
#pragma unroll
    for (int j = 0; j < 4; ++j) { const int n = (lane >> 3) + 8 * j; const LAS float* s = scr + (8 * c) * 33 + n;
        v4u o; o.x = pk2(s[0 * 33], s[1 * 33]); o.y = pk2(s[2 * 33], s[3 * 33]); o.z = pk2(s[4 * 33], s[5 * 33]); o.w = pk2(s[6 * 33], s[7 * 33]);
        *(GAS v4u*)(WT + (size_t)(row_off + n0 + n) * ldk + koff + k0 + 8 * c) = o; }
    LDS_WAIT(); asm volatile("" ::: "memory");
}
constexpr int WP_IN = 1, WP_SQ = 2, WP_UP = 4, WP_DN = 8, WP_LORA = 16, WP_ALL = 31;
__device__ __forceinline__ void p0_weights(Frame& F, CArgsP A, int l, int gw, int NGW, const int part) {
    LAS float* scr = (LAS float*)(F.lds + RING_OFF + F.wave * 16384);
    constexpr int I_IN = (1024 / 64) * (P_TOTAL / 32), I_SQ = (1024 / 64) * (1024 / 32), I_UP = (1024 / 64) * (UPW / 32), I_DN = (D_FF / 64) * (1024 / 32),
                  I_W2 = 1 * (1024 / 32), I_G2 = 2 * (1024 / 32);
    unsigned char* wl = F.ws + WS_W;
    int base = 0;
#define WITEMS(NI, CALL) do { int it = (gw - base) % NGW; if (it < 0) it += NGW; for (; it < (NI); it += NGW) { const int r = it; CALL; } base += (NI); } while (0)
    if (part & WP_IN) WITEMS(I_IN, p0_transpose_item(GIN(A, 8) + (size_t)l * 1024 * P_TOTAL, P_TOTAL, (bf16*)(wl + W_IN), 1024, 0, 0, GIN(A, 7) + l * 1024, scr, r, F.lane));
    if (part & WP_SQ) {
        WITEMS(I_SQ, p0_transpose_item(GIN(A, 11) + (size_t)l * 1024 * 1024, 1024, (bf16*)(wl + W_ODA), 1024, 0, 0, nullptr, scr, r, F.lane));
        WITEMS(I_SQ, p0_transpose_item(GIN(A, 23) + (size_t)l * 1024 * 1024, 1024, (bf16*)(wl + W_ORW), 1024, 0, 0, nullptr, scr, r, F.lane));
        WITEMS(I_SQ, p0_transpose_item(GIN(A, 24) + (size_t)l * 1024 * 1024, 1024, (bf16*)(wl + W_OUT), 1024, 0, 0, nullptr, scr, r, F.lane));
    }
    if (part & WP_UP) WITEMS(I_UP, p0_transpose_item(GIN(A, 26) + (size_t)l * 1024 * UPW, UPW, (bf16*)(wl + (l ? W_UP1 : W_UP)), 1024, 0, 0, GIN(A, 25) + l * 1024, scr, r, F.lane));
    if (part & WP_DN) WITEMS(I_DN, p0_transpose_item(GIN(A, 29) + (size_t)l * D_FF * 1024, 1024, (bf16*)(l ? F.ws + WS_DN1 : wl + W_DN), D_FF, 0, 0, nullptr, scr, r, F.lane));
    if (part & WP_LORA) {
        WITEMS(I_W2, p0_transpose_item(GIN(A, 14) + (size_t)l * 64 * 1024, 1024, (bf16*)(wl + W_LORA), 256, 0, 0, nullptr, scr, r, F.lane));
        WITEMS(I_W2, p0_transpose_item(GIN(A, 16) + (size_t)l * 64 * 1024, 1024, (bf16*)(wl + W_LORA), 256, 64, 1024, nullptr, scr, r, F.lane));
        WITEMS(I_G2, p0_transpose_item(GIN(A, 17) + (size_t)l * 128 * 1024, 1024, (bf16*)(wl + W_LORA), 256, 128, 2048, nullptr, scr, r, F.lane));
        for (int i = gw * 64 + F.lane; i < 3072 * 32; i += NGW * 64) {
            const int n = i >> 5, kc = i & 31, blk = n >> 10;
            const bool nz = (blk == 0) ? (kc < 8) : (blk == 1) ? (kc >= 8 && kc < 16) : (kc >= 16);
            if (!nz) *(GAS v4u*)(wl + W_LORA + ((size_t)n * 256 + kc * 8) * 2) = (v4u){0u, 0u, 0u, 0u};
        }
    }
#undef WITEMS
}
__device__ __forceinline__ void p0_prologue(Frame& F, CArgsP A) {
    const int gw = F.vcu * NWAVES + F.wave, NGW = F.G * NWAVES;
    p0_weights(F, A, 0, gw, NGW, WP_ALL);
    {
        const int gt = gw * 64 + F.lane, NGT = NGW * 64;
        float* rope = (float*)(F.ws + WS_ROPE);
        for (int i = gt; i < NKEYS_S * 8; i += NGT) {
            const int pos = i >> 3, k = i & 7;
            const float ang = (float)pos * A->rinv[k];
            const float kq = rintf(ang * 0.15915494309189535f);
            float r = fmaf(-kq, 6.2831854820251465f, ang); r = fmaf(-kq, -1.7484555314695172e-7f, r);
            const float rev = r * 0.15915494309189535f;
            rope[pos * 16 + k] = __builtin_amdgcn_cosf(rev); rope[pos * 16 + 8 + k] = __builtin_amdgcn_sinf(rev);
        }
    }
    {
        float* X = F.out + O_YP; bf16* XB = (bf16*)(F.ws + WS_XB); float* SS = (float*)(F.ctl + CW_SS);
        for (int m = gw; m < MT; m += NGW) {
            const float* src = (m < MP) ? GIN(A, 0) + (size_t)m * 1024 : GIN(A, 1) + (size_t)(m - MP) * 1024;
            const GAS f32x4* xr = (const GAS f32x4*)src + F.lane;
            GAS f32x4* xo = (GAS f32x4*)(X + (size_t)m * 1024) + F.lane;
            GAS unsigned long long* o8 = (GAS unsigned long long*)(XB + (size_t)m * 1024) + F.lane;
            float s = 0.f;
#pragma unroll
            for (int j = 0; j < 4; ++j) { const f32x4 v = xr[64 * j]; s += (v.x * v.x + v.y * v.y) + (v.z * v.z + v.w * v.w); xo[64 * j] = v;
                o8[64 * j] = (unsigned long long)pk2(v.x, v.y) | ((unsigned long long)pk2(v.z, v.w) << 32); }
            s = wave_sum(s);
            if (F.lane == 0) SS[m] = s;
        }
    }
    if (gw < DEPTH) {
        const int l = gw; const float* lp = GIN(A, 9) + (size_t)l * 256;
        const float s1 = wave_sum(lp[F.lane] * lp[64 + F.lane]), s2 = wave_sum(lp[128 + F.lane] * lp[192 + F.lane]);
        if (F.lane == 0) ((float*)(F.ctl + CW_LAM))[l] = expf(s1) - expf(s2) + (0.8f - 0.6f * expf(-0.3f * (float)l));
    }
}

__device__ __forceinline__ void ph_attn(Frame& F, CArgsP A, int l, const int a0, const int na) {
    const attn_body::bf16* Q = (const attn_body::bf16*)(F.ws + B_Q); const attn_body::bf16* K = (const attn_body::bf16*)(F.ws + B_K); const attn_body::bf16* V = (const attn_body::bf16*)(F.ws + B_V);
    for (int u = a0; u < 256; u += na) {
        const int b = u >> 5, hv = u & 31, h = hv >> 2, c = (hv >> 1) & 1, vh = hv & 1;
        attn_body::bf16* O = (attn_body::bf16*)(F.ws + B_OC) + (size_t)c * MT * 1024;
        for (int qb = 7; qb >= 0; --qb) attn_body::attn_unit<8>(b, h * 128 + c * 64, h * 128 + vh * 64, qb, Q, K, V, O, (char*)F.lds + RING_OFF);
    }
    { int tv = threadIdx.x; asm volatile("" : "+v"(tv)); F.tid = tv; F.lane = tv & 63; F.wave = __builtin_amdgcn_readfirstlane(tv >> 6); }
    for (int u = a0; u < 512; u += na) attn_body::sample_unit(l, u >> 6, (u >> 3) & 7, u & 7, GIN(A, 2), GIN(A, 3), Q, K, V, (float*)(F.ws + WS_SP), (char*)F.lds + RING_OFF);
}

__device__ __forceinline__ void ph_linprep(Frame& F, CArgsP A, int l) {
    const int gw = F.vcu * NWAVES + F.wave, NGW = F.G * NWAVES;
    const bf16* URW = (const bf16*)(F.ws + B_URW); bf16* LIN = (bf16*)(F.ws + B_LIN);
    const float* mu = GIN(A, 12) + (size_t)l * P_RW + 3072 + 4 * F.lane;
    const float mu0 = mu[0], mu1 = mu[1], mu2 = mu[2], mu3 = mu[3];
    for (int row = gw; row < MT; row += NGW) {
        const bool smp = row >= MP; const int t = smp ? ((row - MP) & 31) : (row & 2047);
        const unsigned long long cw = *(const unsigned long long*)(URW + (size_t)row * P_RW + 3072 + 4 * F.lane);
        float u[4] = {bflo((unsigned)cw), bfhi((unsigned)cw), bflo((unsigned)(cw >> 32)), bfhi((unsigned)(cw >> 32))};
        float p[4];
        if (t > 0) { const unsigned long long pw = *(const unsigned long long*)(URW + (size_t)(row - 1) * P_RW + 3072 + 4 * F.lane);
            p[0] = bflo((unsigned)pw); p[1] = bfhi((unsigned)pw); p[2] = bflo((unsigned)(pw >> 32)); p[3] = bfhi((unsigned)(pw >> 32)); }
        else if (smp) { const float* s0 = GIN(A, 5) + ((size_t)(l * DEC_BATCH) + ((row - MP) >> 5)) * P_RW + 3072 + 4 * F.lane; p[0] = s0[0]; p[1] = s0[1]; p[2] = s0[2]; p[3] = s0[3]; }
        else { p[0] = p[1] = p[2] = p[3] = 0.f; }
        u[0] += (p[0] - u[0]) * mu0; u[1] += (p[1] - u[1]) * mu1; u[2] += (p[2] - u[2]) * mu2; u[3] += (p[3] - u[3]) * mu3;
        if (F.lane < 16) { u[0] = tanhf(u[0]); u[1] = tanhf(u[1]); u[2] = tanhf(u[2]); u[3] = tanhf(u[3]); }
        else if (F.lane >= 32) { u[0] = 1.f / (1.f + expf(-u[0])); u[1] = 1.f / (1.f + expf(-u[1])); u[2] = 1.f / (1.f + expf(-u[2])); u[3] = 1.f / (1.f + expf(-u[3])); }
        *(unsigned long long*)(LIN + (size_t)row * 256 + 4 * F.lane) = (unsigned long long)pk2(u[0], u[1]) | ((unsigned long long)pk2(u[2], u[3]) << 32);
    }
}

__device__ __forceinline__ void ph_combine(Frame& F, CArgsP A, int l) {
    const int gw = F.vcu * NWAVES + F.wave, NGW = F.G * NWAVES;
    const float lam = ((const float*)(F.ctl + CW_LAM))[l], lam_init = 0.8f - 0.6f * expf(-0.3f * (float)l);
    const bf16* OC0 = (const bf16*)(F.ws + B_OC); const bf16* OC1 = OC0 + (size_t)MT * 1024;
    bf16* OA = (bf16*)(F.ws + B_OA);
    const float* subln = GIN(A, 10) + l * 128;
    const float g0 = subln[2 * F.lane], g1 = subln[2 * F.lane + 1];
    {
        const int gt = gw * 64 + F.lane, NGT = NGW * 64;
        const float sc = 1.f - lam_init;
        for (int i = gt; i < MP * 128; i += NGT) {
            const size_t off = (size_t)(i >> 4) * 128 + (i & 15) * 8;
            const v4u w0 = *(const v4u*)(OC0 + off), w1 = *(const v4u*)(OC1 + off);
            float a[8];
            a[0] = bflo(w0.x) - lam * bflo(w1.x); a[1] = bfhi(w0.x) - lam * bfhi(w1.x); a[2] = bflo(w0.y) - lam * bflo(w1.y); a[3] = bfhi(w0.y) - lam * bfhi(w1.y);
            a[4] = bflo(w0.z) - lam * bflo(w1.z); a[5] = bfhi(w0.z) - lam * bfhi(w1.z); a[6] = bflo(w0.w) - lam * bflo(w1.w); a[7] = bfhi(w0.w) - lam * bfhi(w1.w);
            float ss = (a[0] * a[0] + a[1] * a[1]) + (a[2] * a[2] + a[3] * a[3]) + (a[4] * a[4] + a[5] * a[5]) + (a[6] * a[6] + a[7] * a[7]);
            ss = reduce16(ss);
            const float r = (1.0f / sqrtf(ss * (1.0f / 128.f) + EPS)) * sc;
            const f32x4 s0 = *(const f32x4*)(subln + (i & 15) * 8), s1 = *(const f32x4*)(subln + (i & 15) * 8 + 4);
            v4u o; o.x = pk2(a[0] * r * s0.x, a[1] * r * s0.y); o.y = pk2(a[2] * r * s0.z, a[3] * r * s0.w); o.z = pk2(a[4] * r * s1.x, a[5] * r * s1.y); o.w = pk2(a[6] * r * s1.z, a[7] * r * s1.w);
            *(v4u*)(OA + off) = o;
        }
    }
    for (int it = MP * 8 + gw; it < MT * 8; it += NGW) {
        const int row = it >> 3, h = it & 7;
        float a0, a1;
        {
            const int b = (row - MP) >> 5, qi = (row - MP) & 31;
            float oc[2][2];
#pragma unroll
            for (int c = 0; c < 2; ++c) {
                const float* sp = (const float*)(F.ws + WS_SP) + ((size_t)(((b * 8 + h) * 2 + c) * 8) * 32 + qi) * 132;
                float mx = -1e30f;
#pragma unroll
                for (int s = 0; s < 8; ++s) mx = fmaxf(mx, sp[(size_t)s * 32 * 132]);
                float L = 0.f, x0 = 0.f, x1 = 0.f;
#pragma unroll
                for (int s = 0; s < 8; ++s) { const float* p = sp + (size_t)s * 32 * 132; const float w = exp2f(p[0] - mx); L += w * p[1]; x0 += w * p[4 + 2 * F.lane]; x1 += w * p[4 + 2 * F.lane + 1]; }
                oc[c][0] = x0 / L; oc[c][1] = x1 / L;
            }
            a0 = oc[0][0] - lam * oc[1][0]; a1 = oc[0][1] - lam * oc[1][1];
        }
        const float ss = wave_sum(a0 * a0 + a1 * a1);
        const float r = (1.0f / sqrtf(ss * (1.0f / 128.f) + EPS)) * (1.f - lam_init);
        *(unsigned*)(OA + (size_t)row * 1024 + h * 128 + 2 * F.lane) = pk2(a0 * r * g0, a1 * r * g1);
    }
}

typedef float f32x2 __attribute__((ext_vector_type(2)));
constexpr int SC_C = 32;
constexpr int SC_OPB = 0, SC_OPB_SZ = SC_C * 1280;
constexpr int SC_VB = 2 * SC_OPB_SZ, SC_VB_SZ = SC_C * 256;
constexpr int SC_YB = SC_VB + 3 * SC_VB_SZ, SC_YB_SZ = SC_C * 256;
constexpr int SC_BON = SC_YB + 2 * SC_YB_SZ;
static_assert(SC_BON + 3 * SC_C * 4 <= RING_BYTES, "scan LDS");

__device__ __forceinline__ void unpack4(unsigned long long w, float (&o)[4]) { o[0] = bflo((unsigned)w); o[1] = bfhi((unsigned)w); o[2] = bflo((unsigned)(w >> 32)); o[3] = bfhi((unsigned)(w >> 32)); }

__device__ __forceinline__ void scan_fast(Frame& F, CArgsP A, int l, int item) {
    const bool smp = item >= 128; const int bh = item & 127, b = bh >> 4, h = bh & 15;
    const int T = smp ? DEC_SEQ : SEQ, row0 = smp ? MP + b * DEC_SEQ : b * SEQ, nch = T / SC_C;
    const int tid = F.tid, lane = F.lane, w = F.wave;
    const int rho = lane >> 3, kq = lane & 7, r0 = (w & 3) * 16 + rho, r1 = r0 + 8;
    const int pt = tid - 256;
    const int cq = pt & 15, c = h * 64 + 4 * cq;
    const bf16* URW = (const bf16*)(F.ws + B_URW); const bf16* LD = (const bf16*)(F.ws + B_LD); const bf16* LA = (const bf16*)(F.ws + B_LA); const bf16* LG = (const bf16*)(F.ws + B_LG);
    bf16* ORW = (bf16*)(F.ws + B_ORW);
    LAS unsigned char* L = F.lds + RING_OFF;
#define SC_RAWLOAD(ch, R) do { _Pragma("unroll") for (int rep_ = 0; rep_ < 2; ++rep_) { const int tp = (pt >> 4) + 16 * rep_; const int tseq = (ch) * SC_C + tp; \
            const size_t r_ = (size_t)(row0 + tseq); const bf16* u_ = URW + r_ * P_RW + c; \
            R[rep_][0] = *(const unsigned long long*)(u_); R[rep_][1] = *(const unsigned long long*)(u_ + 1024); R[rep_][2] = *(const unsigned long long*)(u_ + 2048); \
            R[rep_][3] = *(const unsigned long long*)(LD + r_ * 1024 + c); R[rep_][4] = *(const unsigned long long*)(LA + r_ * 1024 + c); \
            if (tseq > 0) { R[rep_][5] = *(const unsigned long long*)(u_ - P_RW); R[rep_][6] = *(const unsigned long long*)(u_ - P_RW + 1024); R[rep_][7] = *(const unsigned long long*)(u_ - P_RW + 2048); } \
            else { R[rep_][5] = 0ull; R[rep_][6] = 0ull; R[rep_][7] = 0ull; } } } while (0)
#define SC_LGLOAD(ch, G) do { _Pragma("unroll") for (int rep_ = 0; rep_ < 2; ++rep_) { const int tp = (pt >> 4) + 16 * rep_; G[rep_] = *(const unsigned long long*)(LG + (size_t)(row0 + (ch) * SC_C + tp) * 1024 + c); } } while (0)
#define SC_PREP(ch, R) do { LAS unsigned char* opb_ = L + SC_OPB + ((ch) & 1) * SC_OPB_SZ; LAS float* vb_ = (LAS float*)(L + SC_VB + ((ch) % 3) * SC_VB_SZ); LAS float* bonb_ = (LAS float*)(L + SC_BON) + ((ch) % 3) * SC_C; \
        _Pragma("unroll") for (int rep_ = 0; rep_ < 2; ++rep_) { const int tp = (pt >> 4) + 16 * rep_; const int tseq = (ch) * SC_C + tp; \
            float ur[4], uk[4], uv[4], pr[4], pk[4], pv[4], ld[4], la[4]; \
            unpack4(R[rep_][0], ur); unpack4(R[rep_][1], uk); unpack4(R[rep_][2], uv); unpack4(R[rep_][3], ld); unpack4(R[rep_][4], la); unpack4(R[rep_][5], pr); unpack4(R[rep_][6], pk); unpack4(R[rep_][7], pv); \
            if (smp && tseq == 0) { const float* s0 = GIN(A, 5) + (size_t)(l * 8 + b) * P_RW + c; _Pragma("unroll") for (int j = 0; j < 4; ++j) { pr[j] = s0[j]; pk[j] = s0[1024 + j]; pv[j] = s0[2048 + j]; } } \
            float r[4], kr[4], vr[4], kk[4], km[4], wd[4], ssq = 0.f, bon = 0.f; \
            _Pragma("unroll") for (int j = 0; j < 4; ++j) { \
                r[j] = ur[j] + (pr[j] - ur[j]) * mu_r[j]; kr[j] = uk[j] + (pk[j] - uk[j]) * mu_k[j]; vr[j] = uv[j] + (pv[j] - uv[j]) * mu_v[j]; \
                wd[j] = __builtin_amdgcn_exp2f(1.4426950408889634f * ld[j]); \
                kk[j] = kr[j] * k_k[j]; ssq += kk[j] * kk[j]; km[j] = kr[j] * (1.f + (la[j] - 1.f) * k_a[j]); bon += r[j] * km[j] * r_k[j]; } \
            ssq = reduce16(ssq); bon = reduce16(bon); \
            const float inv = __builtin_amdgcn_rsqf(fmaxf(ssq, 1e-24f)); \
            LAS float* op = (LAS float*)(opb_ + tp * 1280) + 4 * cq; \
            *(LAS f32x4*)(op) = (f32x4){wd[0], wd[1], wd[2], wd[3]}; \
            *(LAS f32x4*)(op + 64) = (f32x4){kk[0] * inv, kk[1] * inv, kk[2] * inv, kk[3] * inv}; \
            *(LAS f32x4*)(op + 128) = (f32x4){kk[0] * inv * la[0], kk[1] * inv * la[1], kk[2] * inv * la[2], kk[3] * inv * la[3]}; \
            *(LAS f32x4*)(op + 192) = (f32x4){km[0], km[1], km[2], km[3]}; \
            *(LAS f32x4*)(op + 256) = (f32x4){r[0], r[1], r[2], r[3]}; \
            *(LAS f32x4*)(vb_ + tp * 64 + 4 * cq) = (f32x4){vr[0], vr[1], vr[2], vr[3]}; \
            if (cq == 0) bonb_[tp] = bon; } } while (0)
#define SC_POST(ch, G) do { const LAS float* yb_ = (const LAS float*)(L + SC_YB + ((ch) & 1) * SC_YB_SZ); const LAS float* vb_ = (const LAS float*)(L + SC_VB + ((ch) % 3) * SC_VB_SZ); const LAS float* bonb_ = (const LAS float*)(L + SC_BON) + ((ch) % 3) * SC_C; \
        _Pragma("unroll") for (int rep_ = 0; rep_ < 2; ++rep_) { const int tp = (pt >> 4) + 16 * rep_; const size_t r_ = (size_t)(row0 + (ch) * SC_C + tp); \
            const f32x4 y4 = *(const LAS f32x4*)(yb_ + tp * 64 + 4 * cq); const f32x4 v4 = *(const LAS f32x4*)(vb_ + tp * 64 + 4 * cq); const float bon = bonb_[tp]; \
            float gg[4]; unpack4(G[rep_], gg); \
            const float mean = reduce16((y4.x + y4.y) + (y4.z + y4.w)) * (1.f / 64.f); \
            const float d0 = y4.x - mean, d1 = y4.y - mean, d2 = y4.z - mean, d3 = y4.w - mean; \
            const float var = reduce16((d0 * d0 + d1 * d1) + (d2 * d2 + d3 * d3)) * (1.f / 64.f); \
            const float rs = __builtin_amdgcn_rsqf(var + GN_EPS); \
            const float o0 = (d0 * rs * ln_w[0] + ln_b[0] + bon * v4.x) * gg[0], o1 = (d1 * rs * ln_w[1] + ln_b[1] + bon * v4.y) * gg[1]; \
            const float o2 = (d2 * rs * ln_w[2] + ln_b[2] + bon * v4.z) * gg[2], o3 = (d3 * rs * ln_w[3] + ln_b[3] + bon * v4.w) * gg[3]; \
            *(unsigned long long*)(ORW + r_ * 1024 + c) = (unsigned long long)pk2(o0, o1) | ((unsigned long long)pk2(o2, o3) << 32); } } while (0)
    if (w < 4) {
        f32x2 S2[2][4];
        if (smp) {
#pragma unroll
            for (int q = 0; q < 2; ++q) { const float* s0 = GIN(A, 4) + (((size_t)(l * 8 + b) * 16 + h) * 64 + (q ? r1 : r0)) * 64 + 8 * kq; const f32x4 a0 = *(const f32x4*)s0, a1 = *(const f32x4*)(s0 + 4);
                S2[q][0] = (f32x2){a0.x, a0.y}; S2[q][1] = (f32x2){a0.z, a0.w}; S2[q][2] = (f32x2){a1.x, a1.y}; S2[q][3] = (f32x2){a1.z, a1.w}; } }
        else {
#pragma unroll
            for (int j = 0; j < 4; ++j) { S2[0][j] = (f32x2){0.f, 0.f}; S2[1][j] = (f32x2){0.f, 0.f}; } }
        __syncthreads();
        for (int chx = 0; chx < nch; ++chx) {
            const LAS float* ob = (const LAS float*)(L + SC_OPB + (chx & 1) * SC_OPB_SZ) + 8 * kq; const LAS float* vb = (const LAS float*)(L + SC_VB + (chx % 3) * SC_VB_SZ); LAS float* yb = (LAS float*)(L + SC_YB + (chx & 1) * SC_YB_SZ);
            f32x4 wA0, wA1, kA0, kA1, bA0, bA1, mA0, mA1, rA0, rA1, wB0, wB1, kB0, kB1, bB0, bB1, mB0, mB1, rB0, rB1; float vA0, vA1, vB0, vB1;
#define SC_LD(SET, tt) do { const LAS float* p_ = ob + (tt) * 320; w##SET##0 = *(const LAS f32x4*)(p_); w##SET##1 = *(const LAS f32x4*)(p_ + 4); k##SET##0 = *(const LAS f32x4*)(p_ + 64); k##SET##1 = *(const LAS f32x4*)(p_ + 68); \
            b##SET##0 = *(const LAS f32x4*)(p_ + 128); b##SET##1 = *(const LAS f32x4*)(p_ + 132); m##SET##0 = *(const LAS f32x4*)(p_ + 192); m##SET##1 = *(const LAS f32x4*)(p_ + 196); \
            r##SET##0 = *(const LAS f32x4*)(p_ + 256); r##SET##1 = *(const LAS f32x4*)(p_ + 260); v##SET##0 = vb[(tt) * 64 + r0]; v##SET##1 = vb[(tt) * 64 + r1]; } while (0)
#define LO2(x) ((f32x2){(x)[0], (x)[1]})
#define HI2(x) ((f32x2){(x)[2], (x)[3]})
#define SC_DOT(q, X0, X1) (__builtin_elementwise_fma(S2[q][2], LO2(X1), S2[q][0] * LO2(X0)) + __builtin_elementwise_fma(S2[q][3], HI2(X1), S2[q][1] * HI2(X0)))
#define SC_UPD(q, SET, NS, VV) do { \
            S2[q][0] = __builtin_elementwise_fma(S2[q][0], LO2(w##SET##0), __builtin_elementwise_fma(NS, LO2(b##SET##0), VV * LO2(m##SET##0))); \
            S2[q][1] = __builtin_elementwise_fma(S2[q][1], HI2(w##SET##0), __builtin_elementwise_fma(NS, HI2(b##SET##0), VV * HI2(m##SET##0))); \
            S2[q][2] = __builtin_elementwise_fma(S2[q][2], LO2(w##SET##1), __builtin_elementwise_fma(NS, LO2(b##SET##1), VV * LO2(m##SET##1))); \
            S2[q][3] = __builtin_elementwise_fma(S2[q][3], HI2(w##SET##1), __builtin_elementwise_fma(NS, HI2(b##SET##1), VV * HI2(m##SET##1))); } while (0)
#define SC_STEP(SET, tt) do { \
            const f32x2 pa_ = SC_DOT(0, k##SET##0, k##SET##1), pb_ = SC_DOT(1, k##SET##0, k##SET##1); \
            float sa_ = pa_[0] + pa_[1], sb_ = pb_[0] + pb_[1]; \
            sa_ += dppf<0xB1>(sa_); sb_ += dppf<0xB1>(sb_); sa_ += dppf<0x4E>(sa_); sb_ += dppf<0x4E>(sb_); sa_ += dppf<0x141>(sa_); sb_ += dppf<0x141>(sb_); \
            { const float na_ = -sa_, nb_ = -sb_; const f32x2 nsa_ = (f32x2){na_, na_}, nsb_ = (f32x2){nb_, nb_}, va_ = (f32x2){v##SET##0, v##SET##0}, vb2_ = (f32x2){v##SET##1, v##SET##1}; \
              SC_UPD(0, SET, nsa_, va_); SC_UPD(1, SET, nsb_, vb2_); } \
            const f32x2 qa_ = SC_DOT(0, r##SET##0, r##SET##1), qb_ = SC_DOT(1, r##SET##0, r##SET##1); \
            float ya_ = qa_[0] + qa_[1], yb1_ = qb_[0] + qb_[1]; \
            ya_ += dppf<0xB1>(ya_); yb1_ += dppf<0xB1>(yb1_); ya_ += dppf<0x4E>(ya_); yb1_ += dppf<0x4E>(yb1_); ya_ += dppf<0x141>(ya_); yb1_ += dppf<0x141>(yb1_); \
            if (kq == 0) { yb[(tt) * 64 + r0] = ya_; yb[(tt) * 64 + r1] = yb1_; } } while (0)
            SC_LD(A, 0);
            for (int t = 0; t < SC_C; t += 2) {
                SC_LD(B, t + 1);
                SC_STEP(A, t);
                if (t + 2 < SC_C) SC_LD(A, t + 2);
                SC_STEP(B, t + 1);
            }
            __syncthreads();
        }
#pragma unroll
        for (int q = 0; q < 2; ++q) { float* Sout = F.out + (smp ? O_WKVS : O_WKVP) + (((size_t)(l * 8 + b) * 16 + h) * 64 + (q ? r1 : r0)) * 64 + 8 * kq;
            *(f32x4*)Sout = (f32x4){S2[q][0][0], S2[q][0][1], S2[q][1][0], S2[q][1][1]}; *(f32x4*)(Sout + 4) = (f32x4){S2[q][2][0], S2[q][2][1], S2[q][3][0], S2[q][3][1]}; }
    } else {
        float mu_r[4], mu_k[4], mu_v[4], k_k[4], k_a[4], r_k[4], ln_w[4], ln_b[4];
        {
            const float* mu = GIN(A, 12) + (size_t)l * P_RW;
#pragma unroll
            for (int j = 0; j < 4; ++j) { mu_r[j] = mu[c + j]; mu_k[j] = mu[1024 + c + j]; mu_v[j] = mu[2048 + c + j]; k_k[j] = GIN(A, 18)[l * 1024 + c + j]; k_a[j] = GIN(A, 19)[l * 1024 + c + j]; r_k[j] = GIN(A, 20)[l * 1024 + c + j];
                ln_w[j] = GIN(A, 21)[l * 1024 + c + j]; ln_b[j] = GIN(A, 22)[l * 1024 + c + j]; }
        }
        unsigned long long rawA[2][8], rawB[2][8], lgA[2], lgB[2];
        SC_RAWLOAD(0, rawA); SC_LGLOAD(0, lgA); if (nch > 1) SC_RAWLOAD(1, rawB); SC_PREP(0, rawA); if (nch > 2) SC_RAWLOAD(2, rawA);
        __syncthreads();
        for (int ch = 0; ch < nch; ch += 2) {
            if (ch + 1 < nch) SC_PREP(ch + 1, rawB);
            if (ch + 3 < nch) SC_RAWLOAD(ch + 3, rawB);
            if (ch > 0) SC_POST(ch - 1, lgB);
            if (ch + 1 < nch) SC_LGLOAD(ch + 1, lgB);
            __syncthreads();
            if (ch + 1 < nch) {
                if (ch + 2 < nch) SC_PREP(ch + 2, rawA);
                if (ch + 4 < nch) SC_RAWLOAD(ch + 4, rawA);
                SC_POST(ch, lgA);
                if (ch + 2 < nch) SC_LGLOAD(ch + 2, lgA);
                __syncthreads();
            }
        }
        if (nch & 1) SC_POST(nch - 1, lgA); else SC_POST(nch - 1, lgB);
    }
#undef SC_LD
#undef SC_STEP
#undef SC_DOT
#undef SC_UPD
#undef LO2
#undef HI2
#undef SC_RAWLOAD
#undef SC_LGLOAD
#undef SC_PREP
#undef SC_POST
    __syncthreads();
}
__device__ __forceinline__ void ph_scan(Frame& F, CArgsP A, int l, const int s0, const int ns) {
    for (int it = s0; it < 256; it += ns) scan_fast(F, A, l, it);
}

__device__ __forceinline__ void unpack8f(const v4u w, float (&o)[8]) { o[0] = bflo(w.x); o[1] = bfhi(w.x); o[2] = bflo(w.y); o[3] = bfhi(w.y); o[4] = bflo(w.z); o[5] = bfhi(w.z); o[6] = bflo(w.w); o[7] = bfhi(w.w); }
__device__ __forceinline__ void ph_conv(Frame& F, CArgsP A, int l) {
    const int gt = (F.vcu * NWAVES + F.wave) * 64 + F.lane, NGT = F.G * NWAVES * 64;
    const bf16* UP = (const bf16*)(F.ws + B_UP); bf16* GT = (bf16*)(F.ws + B_GT);
    const float* cw = GIN(A, 27) + (size_t)l * 3 * UPW; const float* cb = GIN(A, 28) + (size_t)l * UPW;
    constexpr int NJ = D_FF / 8, NRB = MT / 64;
    for (int it = gt; it < NRB * NJ; it += NGT) {
        const int rb = it / NJ, j = (it % NJ) * 8;
        float w0[2][8], w1[2][8], w2[2][8], bi[2][8];
#pragma unroll
        for (int hf = 0; hf < 2; ++hf) { const int col = j + hf * D_FF;
#pragma unroll
            for (int e = 0; e < 8; e += 4) { const f32x4 a = *(const f32x4*)(cw + col + e), b2 = *(const f32x4*)(cw + UPW + col + e), c2 = *(const f32x4*)(cw + 2 * UPW + col + e), d2 = *(const f32x4*)(cb + col + e);
                w0[hf][e] = a.x; w0[hf][e + 1] = a.y; w0[hf][e + 2] = a.z; w0[hf][e + 3] = a.w; w1[hf][e] = b2.x; w1[hf][e + 1] = b2.y; w1[hf][e + 2] = b2.z; w1[hf][e + 3] = b2.w;
                w2[hf][e] = c2.x; w2[hf][e + 1] = c2.y; w2[hf][e + 2] = c2.z; w2[hf][e + 3] = c2.w; bi[hf][e] = d2.x; bi[hf][e + 1] = d2.y; bi[hf][e + 2] = d2.z; bi[hf][e + 3] = d2.w; } }
        float u1[2][8], u2[2][8];
        for (int r4 = 0; r4 < 64; r4 += 4) {
            v4u ld[4][2];
#pragma unroll
            for (int q = 0; q < 4; ++q) { ld[q][0] = *(const v4u*)(UP + (size_t)(rb * 64 + r4 + q) * UPW + j); ld[q][1] = *(const v4u*)(UP + (size_t)(rb * 64 + r4 + q) * UPW + j + D_FF); }
#pragma unroll
            for (int q = 0; q < 4; ++q) {
                const int rr = r4 + q, row = rb * 64 + rr;
                const bool smp = row >= MP; const int t = smp ? ((row - MP) & 31) : (row & 2047); const int b = smp ? ((row - MP) >> 5) : (row >> 11);
                if (t == 0) {
#pragma unroll
                    for (int hf = 0; hf < 2; ++hf) { const int col = j + hf * D_FF;
                        if (smp) { const float* s0 = GIN(A, 6) + ((size_t)(l * 8 + b) * 2) * UPW + col;
#pragma unroll
                            for (int e = 0; e < 8; ++e) { u2[hf][e] = s0[e]; u1[hf][e] = s0[UPW + e]; } }
                        else {
#pragma unroll
                            for (int e = 0; e < 8; ++e) { u2[hf][e] = 0.f; u1[hf][e] = 0.f; } } }
                } else if (rr == 0) {
#pragma unroll
                    for (int hf = 0; hf < 2; ++hf) { const int col = j + hf * D_FF;
                        unpack8f(*(const v4u*)(UP + (size_t)(row - 1) * UPW + col), u1[hf]); unpack8f(*(const v4u*)(UP + (size_t)(row - 2) * UPW + col), u2[hf]); }
                }
                float u0[2][8], cc[2][8];
#pragma unroll
                for (int hf = 0; hf < 2; ++hf) { unpack8f(ld[q][hf], u0[hf]);
#pragma unroll
                    for (int e = 0; e < 8; ++e) { cc[hf][e] = bi[hf][e] + u2[hf][e] * w0[hf][e] + u1[hf][e] * w1[hf][e] + u0[hf][e] * w2[hf][e]; u2[hf][e] = u1[hf][e]; u1[hf][e] = u0[hf][e]; } }
                float gv[8];
#pragma unroll
                for (int e = 0; e < 8; ++e) gv[e] = cc[0][e] * __builtin_amdgcn_rcpf(1.0f + __builtin_amdgcn_exp2f(-1.4426950408889634f * cc[0][e])) * cc[1][e];
                v4u o; o.x = pk2(gv[0], gv[1]); o.y = pk2(gv[2], gv[3]); o.z = pk2(gv[4], gv[5]); o.w = pk2(gv[6], gv[7]);
                *(v4u*)(GT + (size_t)row * D_FF + j) = o;
            }
        }
    }
}

__device__ __forceinline__ void ph_final(Frame& F, CArgsP A) {
    const int gw = F.vcu * NWAVES + F.wave, NGW = F.G * NWAVES;
    float* X = F.out + O_YP; const float* SS = (const float*)(F.ctl + CW_SS) + 4 * MT; const float* g = GIN(A, 30);
    for (int m = gw; m < MT; m += NGW) {
        const float r = 1.0f / sqrtf(SS[m] * (1.0f / 1024.f) + EPS);
        GAS f32x4* xr = (GAS f32x4*)(X + (size_t)m * 1024) + F.lane; const GAS f32x4* gr = (const GAS f32x4*)g + F.lane;
#pragma unroll
        for (int j = 0; j < 4; ++j) { f32x4 v = xr[64 * j]; const f32x4 gg = gr[64 * j]; v = v * r * gg; xr[64 * j] = v; }
    }
}

typedef float f32x16g __attribute__((ext_vector_type(16)));
template <int NB, class EPI> __device__ __forceinline__ void mini_gemm(Frame& F, const bf16* A, const bf16* Bt, const int K, const int nblk_n, EPI epi) {
    LAS float* red = (LAS float*)(F.lds + RING_OFF);
    const int KW = K / NWAVES, i = F.lane & 31, h = F.lane >> 5;
    for (int bi = F.vcu; bi < 8 * nblk_n; bi += F.G) {
        const int rb = bi & 7, cb = bi >> 3;
        const bf16* ap = A + (size_t)(rb * 32 + i) * K + F.wave * KW + 8 * h;
        const bf16* bp = Bt + (size_t)(cb * 32 + i) * K + F.wave * KW + 8 * h;
        f32x16g acc;
#pragma unroll
        for (int r = 0; r < 16; ++r) acc[r] = 0.f;
        for (int k0 = 0; k0 < KW; k0 += 16 * NB) {
            bf16x8 a[NB], b[NB];
#pragma unroll
            for (int j = 0; j < NB; ++j) { a[j] = *(const bf16x8*)(ap + k0 + 16 * j); b[j] = *(const bf16x8*)(bp + k0 + 16 * j); }
#pragma unroll
            for (int j = 0; j < NB; ++j) acc = __builtin_amdgcn_mfma_f32_32x32x16_bf16(a[j], b[j], acc, 0, 0, 0);
        }
        __syncthreads();
#pragma unroll
        for (int r = 0; r < 16; ++r) red[(F.wave * 16 + r) * 64 + F.lane] = acc[r];
        __syncthreads();
        const int q = F.wave;
        float s0 = 0.f, s1 = 0.f;
#pragma unroll
        for (int w = 0; w < NWAVES; ++w) { s0 += red[(w * 16 + 2 * q) * 64 + F.lane]; s1 += red[(w * 16 + 2 * q + 1) * 64 + F.lane]; }
        epi(rb * 32 + 2 * (q & 1) + 8 * (q >> 1) + 4 * h, cb * 32 + i, s0, s1);
    }
}
__device__ __forceinline__ void mini_gated(Frame& F, const bf16* A, const bf16* Bt, const bf16* G, const int goff, const bf16* S, bf16* O) {
    mini_gemm<8>(F, A + (size_t)MP * 1024, Bt, 1024, 32, [=](int row, int col, float v0, float v1) {
        const size_t r0 = (size_t)(MP + row);
        v0 *= bf2f(G[r0 * 2048 + goff + col]); v1 *= bf2f(G[(r0 + 1) * 2048 + goff + col]);
        if (S) { v0 += bf2f(S[r0 * 1024 + col]); v1 += bf2f(S[(r0 + 1) * 1024 + col]); }
        O[r0 * 1024 + col] = (bf16)f2bf(v0); O[(r0 + 1) * 1024 + col] = (bf16)f2bf(v1);
    });
}
template <int NB> __device__ __forceinline__ void mini_res(Frame& F, const bf16* A, const bf16* Bt, const int K, float* X, bf16* XB, float* SS) {
    mini_gemm<NB>(F, A + (size_t)MP * K, Bt, K, 32, [=](int row, int col, float v0, float v1) {
        const size_t r0 = (size_t)(MP + row);
        v0 += X[r0 * 1024 + col]; v1 += X[(r0 + 1) * 1024 + col];
        X[r0 * 1024 + col] = v0; X[(r0 + 1) * 1024 + col] = v1;
        XB[r0 * 1024 + col] = (bf16)f2bf(v0); XB[(r0 + 1) * 1024 + col] = (bf16)f2bf(v1);
        float q0 = reduce16(v0 * v0), q1 = reduce16(v1 * v1);
        q0 += __shfl_xor(q0, 16); q1 += __shfl_xor(q1, 16);
        if ((col & 31) == 0) { atomicAdd(SS + r0, q0); atomicAdd(SS + r0 + 1, q1); }
    });
}
__device__ __forceinline__ void mini_gate(Frame& F, const bf16* A, const bf16* Bt, const float* ss, bf16* GATE) {
    mini_gemm<8>(F, A + (size_t)MP * 1024, Bt, 1024, 64, [=](int row, int col, float v0, float v1) {
        const size_t r0 = (size_t)(MP + row);
        const float rs0 = 1.0f / sqrtf(ss[r0] * (1.0f / 1024.f) + 1e-6f), rs1 = 1.0f / sqrtf(ss[r0 + 1] * (1.0f / 1024.f) + 1e-6f);
        GATE[r0 * 2048 + col] = (bf16)f2bf(pg8::fast_sigmoid(v0 * rs0)); GATE[(r0 + 1) * 2048 + col] = (bf16)f2bf(pg8::fast_sigmoid(v1 * rs1));
    });
}

#define REOPAQUE() do { int tv = threadIdx.x; asm volatile("" : "+v"(tv)); F.tid = tv; F.lane = tv & 63; F.wave = __builtin_amdgcn_readfirstlane(tv >> 6); \
    ap = (CArgsP)__builtin_amdgcn_kernarg_segment_ptr(); asm volatile("" : "+s"(ap)); \
    { GAS unsigned char* w_ = ap->ws; GAS float* o_ = ap->out; asm volatile("" : "+s"(w_), "+s"(o_)); F.ws = (unsigned char*)w_; F.out = (float*)o_; F.ctl = (gu32*)(w_ + WS_CTL); } } while (0)
#define PH_BEGIN(idx) if (lo <= (idx) && (idx) < hi) { REOPAQUE();
#define PH_END(idx) if ((idx) + 1 < hi) xcd_barrier(bar); }

#define IDLE_CONVERT(nu, part) do { const int rem_ = (nu) % F.G; __syncthreads(); if (rem_ && (int)blockIdx.x >= rem_) { REOPAQUE(); p0_weights(F, ap, 1, ((int)blockIdx.x - rem_) * NWAVES + F.wave, (F.G - rem_) * NWAVES, part); } \
        else if (!rem_) { REOPAQUE(); p0_weights(F, ap, 1, (int)blockIdx.x * NWAVES + F.wave, F.G * NWAVES, part); } } while (0)

template <int l> __device__ __forceinline__ void layer_phases(Frame& F, CArgsP& ap, const XcdBarrier& bar, const int lo, const int hi) {
    constexpr int P0 = 1 + l * PH_PER_LAYER;
#define WL (F.ws + WS_W)
#define SSP ((float*)(F.ctl + CW_SS))
    PH_BEGIN(P0 + K_G1) {
        int kk_ = 1024; asm volatile("" : "+s"(kk_)); pg8::Gemm g{(const bf16*)(F.ws + WS_XB), (const bf16*)(WL + W_IN), MT, P_DA + P_RW, kk_}; pg8::StaticOrder S; S.init(MT, P_DA + P_RW, F.G, (int)blockIdx.x);
        pg8::EpiIn E{SSP + (size_t)(2 * l) * MT, (const float*)(F.ws + WS_ROPE), (bf16*)(F.ws + B_Q), (bf16*)(F.ws + B_K), (bf16*)(F.ws + B_V), (bf16*)(F.ws + B_URW),
                     F.out + O_KP + (size_t)l * MP * 1024, F.out + O_VP + (size_t)l * MP * 1024, F.out + O_KS + (size_t)l * MS * 1024, F.out + O_VS + (size_t)l * MS * 1024,
                     F.out + O_SHP + (size_t)l * BATCH * P_RW, F.out + O_SHS + (size_t)l * DEC_BATCH * P_RW};
        pg8::gemm_phase<pg8::EpiIn, pg8::StaticOrder, true, true>(F.lds + RING_OFF, g, S, E);
        if constexpr (l == 0) IDLE_CONVERT((MT / 256) * ((P_DA + P_RW) / 256), WP_UP | WP_DN);
    } PH_END(P0 + K_G1)
    PH_BEGIN(P0 + K_LP) { ph_linprep(F, ap, l); } PH_END(P0 + K_LP)
    PH_BEGIN(P0 + K_LR) {
        int kk_ = 256; asm volatile("" : "+s"(kk_)); pg8::Gemm g{(const bf16*)(F.ws + B_LIN), (const bf16*)(WL + W_LORA), MT, 3072, kk_}; pg8::StaticOrder S; S.init(MT, 3072, F.G, (int)blockIdx.x);
        pg8::EpiLora E{GIN(ap, 13) + l * 1024, GIN(ap, 15) + l * 1024, (bf16*)(F.ws + B_LD), (bf16*)(F.ws + B_LA), (bf16*)(F.ws + B_LG)};
        pg8::gemm_phase<pg8::EpiLora, pg8::StaticOrder, true, true>(F.lds + RING_OFF, g, S, E);
    } PH_END(P0 + K_LR)
    PH_BEGIN(P0 + K_SC) {
        const int NSC = (F.G >= 256) ? 128 : F.G / 2;
        if (F.vcu < NSC) ph_scan(F, ap, l, F.vcu, NSC); else ph_attn(F, ap, l, F.vcu - NSC, F.G - NSC);
    } PH_END(P0 + K_SC)
    PH_BEGIN(P0 + K_CB) {
        ph_combine(F, ap, l);
        int kk_ = 1024; asm volatile("" : "+s"(kk_)); pg8::Gemm g{(const bf16*)(F.ws + WS_XB), (const bf16*)(WL + W_IN) + (size_t)(P_DA + P_RW) * 1024, MP, P_GATE, kk_}; pg8::StaticOrder S; S.init(MP, P_GATE, F.G, (int)blockIdx.x);
        pg8::EpiGate E{SSP + (size_t)(2 * l) * MT, (bf16*)(F.ws + B_GATE)};
        pg8::gemm_phase<pg8::EpiGate, pg8::StaticOrder, true, true>(F.lds + RING_OFF, g, S, E);
        REOPAQUE(); mini_gate(F, (const bf16*)(F.ws + WS_XB), (const bf16*)(WL + W_IN) + (size_t)(P_DA + P_RW) * 1024, SSP + (size_t)(2 * l) * MT, (bf16*)(F.ws + B_GATE));
    } PH_END(P0 + K_CB)
    PH_BEGIN(P0 + K_M1) {
        int kk_ = 1024; asm volatile("" : "+s"(kk_)); pg8::Gemm g{(const bf16*)(F.ws + B_OA), (const bf16*)(WL + W_ODA), MP, 1024, kk_}; pg8::StaticOrder S; S.init(MP, 1024, F.G, (int)blockIdx.x);
        pg8::EpiGated E{(const bf16*)(F.ws + B_GATE), 0, nullptr, (bf16*)(F.ws + B_MRG)};
        pg8::gemm_phase<pg8::EpiGated, pg8::StaticOrder, true, true>(F.lds + RING_OFF, g, S, E);
        REOPAQUE(); mini_gated(F, (const bf16*)(F.ws + B_OA), (const bf16*)(WL + W_ODA), (const bf16*)(F.ws + B_GATE), 0, nullptr, (bf16*)(F.ws + B_MRG));
    } PH_END(P0 + K_M1)
    PH_BEGIN(P0 + K_M2) {
        int kk_ = 1024; asm volatile("" : "+s"(kk_)); pg8::Gemm g{(const bf16*)(F.ws + B_ORW), (const bf16*)(WL + W_ORW), MP, 1024, kk_}; pg8::StaticOrder S; S.init(MP, 1024, F.G, (int)blockIdx.x);
        pg8::EpiGated E{(const bf16*)(F.ws + B_GATE), 1024, (const bf16*)(F.ws + B_MRG), (bf16*)(F.ws + B_MRG)};
        pg8::gemm_phase<pg8::EpiGated, pg8::StaticOrder, true, true>(F.lds + RING_OFF, g, S, E);
        REOPAQUE(); mini_gated(F, (const bf16*)(F.ws + B_ORW), (const bf16*)(WL + W_ORW), (const bf16*)(F.ws + B_GATE), 1024, (const bf16*)(F.ws + B_MRG), (bf16*)(F.ws + B_MRG));
    } PH_END(P0 + K_M2)
    PH_BEGIN(P0 + K_WO) {
        int kk_ = 1024; asm volatile("" : "+s"(kk_)); pg8::Gemm g{(const bf16*)(F.ws + B_MRG), (const bf16*)(WL + W_OUT), MP, 1024, kk_}; pg8::StaticOrder S; S.init(MP, 1024, F.G, (int)blockIdx.x);
        pg8::EpiRes E{F.out + O_YP, (bf16*)(F.ws + WS_XB), SSP + (size_t)(2 * l + 1) * MT};
        pg8::gemm_phase<pg8::EpiRes, pg8::StaticOrder, true, true>(F.lds + RING_OFF, g, S, E);
        REOPAQUE(); mini_res<8>(F, (const bf16*)(F.ws + B_MRG), (const bf16*)(WL + W_OUT), 1024, F.out + O_YP, (bf16*)(F.ws + WS_XB), SSP + (size_t)(2 * l + 1) * MT);
    } PH_END(P0 + K_WO)
    PH_BEGIN(P0 + K_UP) {
        int kk_ = 1024; asm volatile("" : "+s"(kk_)); pg8::Gemm g{(const bf16*)(F.ws + WS_XB), (const bf16*)(WL + (l ? W_UP1 : W_UP)), MT, UPW, kk_}; pg8::StaticOrder S; S.init(MT, UPW, F.G, (int)blockIdx.x);
        pg8::EpiUp E{SSP + (size_t)(2 * l + 1) * MT, (bf16*)(F.ws + B_UP), F.out + O_CVP + (size_t)l * BATCH * 2 * UPW, F.out + O_CVS + (size_t)l * DEC_BATCH * 2 * UPW};
        pg8::gemm_phase<pg8::EpiUp, pg8::StaticOrder, true, true>(F.lds + RING_OFF, g, S, E);
        if constexpr (l == 0) IDLE_CONVERT((MT / 256) * (UPW / 256), WP_IN | WP_SQ | WP_LORA);
    } PH_END(P0 + K_UP)
    PH_BEGIN(P0 + K_CV) { ph_conv(F, ap, l); } PH_END(P0 + K_CV)
    PH_BEGIN(P0 + K_DN) {
        int kk_ = D_FF; asm volatile("" : "+s"(kk_)); pg8::Gemm g{(const bf16*)(F.ws + B_GT), (const bf16*)(l ? F.ws + WS_DN1 : WL + W_DN), MP, 1024, kk_}; pg8::StaticOrder S; S.init(MP, 1024, F.G, (int)blockIdx.x);
        pg8::EpiRes E{F.out + O_YP, (bf16*)(F.ws + WS_XB), SSP + (size_t)(2 * l + 2) * MT};
        pg8::gemm_phase<pg8::EpiRes, pg8::StaticOrder, true, true>(F.lds + RING_OFF, g, S, E);
        REOPAQUE(); mini_res<11>(F, (const bf16*)(F.ws + B_GT), (const bf16*)(l ? F.ws + WS_DN1 : WL + W_DN), D_FF, F.out + O_YP, (bf16*)(F.ws + WS_XB), SSP + (size_t)(2 * l + 2) * MT);
    } PH_END(P0 + K_DN)
#undef WL
#undef SSP
}

__global__ void __launch_bounds__(NWAVES * 64, 2) mk_fwd(Args args) {
    extern __shared__ __attribute__((aligned(16))) unsigned char lds[];
    Frame F;
    F.lds = (LAS unsigned char*)lds;
    F.MISC = (volatile LAS unsigned*)(F.lds + MISC_OFF);
    F.tid = threadIdx.x; F.lane = F.tid & 63; F.wave = __builtin_amdgcn_readfirstlane(F.tid >> 6);
    F.G = gridDim.x; { const int bx = blockIdx.x; F.vcu = (F.G % 8 == 0) ? (bx % 8) * (F.G / 8) + bx / 8 : bx; }
    F.out = (float*)args.out; F.ws = (unsigned char*)args.ws;
    F.ctl = (gu32*)(args.ws + WS_CTL);
    for (int u = F.tid; u < (LDS_BYTES - LDSCTL_OFF) / 4; u += NWAVES * 64) ((LAS unsigned*)(F.lds + LDSCTL_OFF))[u] = 0u;
    __syncthreads();
    XcdBarrier bar; bar.bar = (unsigned*)(F.ctl + CW_BAR); bar.x = 0; bar.st = nullptr;
    if (!MK_PER_PHASE) bar = xcd_barrier_post((unsigned*)(F.ctl + CW_BAR), F.MISC + 8);
    const int lo = args.ph_lo, hi = args.ph_hi;
    CArgsP ap;
    PH_BEGIN(0) { p0_prologue(F, ap); } PH_END(0)
    layer_phases<0>(F, ap, bar, lo, hi);
    layer_phases<1>(F, ap, bar, lo, hi);
    PH_BEGIN(NPHASE - 1) { ph_final(F, ap); } PH_END(NPHASE - 1)
}

extern "C" void kernel_launch(void* const* d_in, const int* in_sizes, int n_in, void* d_out, int out_size, void* d_ws, size_t ws_size, hipStream_t stream) {
    (void)in_sizes;
    static int grid = 0;
    if (grid == 0) {
        if (n_in != 31 || out_size != (int)O_END || ws_size < B_END2) { fprintf(stderr, "kernel_launch: unexpected shapes (n_in %d out %d ws %zu)\n", n_in, out_size, ws_size); grid = -1; return; }
        int dev = 0, cus = 0;
        if (hipGetDevice(&dev) != hipSuccess || hipDeviceGetAttribute(&cus, hipDeviceAttributeMultiprocessorCount, dev) != hipSuccess) { grid = -1; return; }
        if (hipFuncSetAttribute((const void*)mk_fwd, hipFuncAttributeMaxDynamicSharedMemorySize, LDS_BYTES) != hipSuccess) { fprintf(stderr, "kernel_launch: hipFuncSetAttribute failed\n"); grid = -1; return; }
        (void)hipGetLastError();
        grid = cus;
    }
    if (grid < 0) return;
    if (hipMemsetAsync((char*)d_ws + WS_CTL, 0, CTL_ZERO_BYTES, stream) != hipSuccess) { fprintf(stderr, "kernel_launch: memset failed\n"); return; }
    Args a{};
    for (int i = 0; i < 31; ++i) a.in[i] = (const GAS float*)d_in[i];
    a.out = (GAS float*)d_out; a.ws = (GAS unsigned char*)d_ws;
    for (int i = 0; i < 8; ++i) a.rinv[i] = (float)pow(500000.0, -(double)i / 8.0);
#if MK_PER_PHASE
    for (int p = 0; p < NPHASE; ++p) { a.ph_lo = p; a.ph_hi = p + 1; hipLaunchKernelGGL(mk_fwd, dim3(grid), dim3(NWAVES * 64), LDS_BYTES, stream, a); }
#else
    a.ph_lo = 0; a.ph_hi = NPHASE;
    hipLaunchKernelGGL(mk_fwd, dim3(grid), dim3(NWAVES * 64), LDS_BYTES, stream, a);
#endif
    const hipError_t le = hipPeekAtLastError();
    if (le != hipSuccess) fprintf(stderr, "kernel_launch: launch failed: %s\n", hipGetErrorName(le));
}
```

```cpp
#include <hip/hip_runtime.h>
#include <cstdio>
#include <cstdint>
#include <cmath>

#ifndef MK_PER_PHASE
#define MK_PER_PHASE 0
#endif

constexpr int D_MODEL = 1024, BATCH = 8, SEQ = 2048, DEPTH = 2, DEC_BATCH = 8, DEC_SEQ = 32, PAST_LEN = 2048;
constexpr float EPS = 1e-6f, GN_EPS = 64e-5f;
constexpr int DA_HEADS = 8, RW_HEADS = 16;
constexpr int D_FF = 2816, UPW = 2 * D_FF;
constexpr int P_DA = 3072, P_RW = 3328, P_GATE = 2048, P_TOTAL = 8448;
constexpr int MP = BATCH * SEQ, MS = DEC_BATCH * DEC_SEQ, MT = MP + MS;
constexpr int NKEYS_S = PAST_LEN + DEC_SEQ;
constexpr float C2 = 0.125f * 1.4426950408889634f;

constexpr size_t O_YP = 0;
constexpr size_t O_YS = O_YP + (size_t)MP * D_MODEL;
constexpr size_t O_KP = O_YS + (size_t)MS * D_MODEL;
constexpr size_t O_VP = O_KP + (size_t)DEPTH * MP * 1024;
constexpr size_t O_WKVP = O_VP + (size_t)DEPTH * MP * 1024;
constexpr size_t O_SHP = O_WKVP + (size_t)DEPTH * BATCH * RW_HEADS * 64 * 64;
constexpr size_t O_CVP = O_SHP + (size_t)DEPTH * BATCH * P_RW;
constexpr size_t O_KS = O_CVP + (size_t)DEPTH * BATCH * 2 * UPW;
constexpr size_t O_VS = O_KS + (size_t)DEPTH * MS * 1024;
constexpr size_t O_WKVS = O_VS + (size_t)DEPTH * MS * 1024;
constexpr size_t O_SHS = O_WKVS + (size_t)DEPTH * DEC_BATCH * RW_HEADS * 64 * 64;
constexpr size_t O_CVS = O_SHS + (size_t)DEPTH * DEC_BATCH * P_RW;
constexpr size_t O_END = O_CVS + (size_t)DEPTH * DEC_BATCH * 2 * UPW;
static_assert(O_END == 87760896, "output size");

namespace pg8 {
#define PG8_LAS __attribute__((address_space(3)))
typedef unsigned short bf16_t;
typedef short bf16x8 __attribute__((ext_vector_type(8)));
typedef float f32x4 __attribute__((ext_vector_type(4)));
typedef unsigned u32x4 __attribute__((ext_vector_type(4)));
constexpr int BM = 256, BK = 64, HALF = 128, HTB = HALF * BK * 2  , STAGE_BYTES = 8 * HTB, NXCD = 8, WGM = 8;

__host__ __device__ __forceinline__ int lds_byte(int r, int c) { const int st = (r >> 4) * 2 + (c >> 5), rr = r & 15, cc = c & 31, ob = rr * 64 + cc * 2; return st * 1024 + (ob ^ (((ob >> 9) & 1) << 5)); }
__host__ __device__ __forceinline__ void stage_rc(int b, int& R, int& C) { const int st = b / 1024, sb = b % 1024, swz = sb ^ (((sb >> 9) & 1) << 5); R = (st >> 1) * 16 + swz / 64; C = (st & 1) * 32 + (swz % 64) / 2; }
__host__ __device__ __forceinline__ int perm32(int rho) { const int n = rho >> 4, i = rho & 15; return 8 * (i >> 2) + 4 * n + (i & 3); }

struct Unit { int pm, pn; };
struct Gemm { const bf16_t* A; const bf16_t* Bt; int M, N, K; int a_rows = 256, a_row0 = 0; };

struct StaticOrder {
    int nM, nN, nwg, G, c;
    __host__ __device__ void init(int M, int N, int G_, int c_) { nM = M / BM; nN = N / BM; nwg = nM * nN; G = G_; c = c_; }
    __host__ __device__ bool next(int i, Unit& u) const {
        const long L = (long)i * G + c; if (L >= nwg) return false;
        int wgid = (int)L; { const int q = nwg / NXCD, r = nwg % NXCD, xcd = wgid % NXCD, off = wgid / NXCD; wgid = (xcd < r ? xcd * (q + 1) : r * (q + 1) + (xcd - r) * q) + off; }
        const int nig = WGM * nN, gid = wgid / nig, fm = gid * WGM, gsz = (nM - fm) < WGM ? (nM - fm) : WGM;
        u.pm = fm + ((wgid % nig) % gsz); u.pn = (wgid % nig) / gsz; return true;
    }
    __device__ __forceinline__ void a_ready(const Unit&) const {}
    __device__ __forceinline__ void done(const Unit&) const {}
};

typedef float f32x2_cv __attribute__((ext_vector_type(2))); typedef __bf16 bf16x2_cv __attribute__((ext_vector_type(2)));
__device__ __forceinline__ unsigned cvt_pk_bf16(float lo, float hi) { const f32x2_cv v = {lo, hi}; const bf16x2_cv b = __builtin_convertvector(v, bf16x2_cv); return __builtin_bit_cast(unsigned, b); }
typedef float f32x2 __attribute__((ext_vector_type(2)));
__device__ __forceinline__ float bf2f(unsigned short h) { return __uint_as_float((unsigned)h << 16); }
__device__ __forceinline__ float fast_sigmoid(float x) { return __builtin_amdgcn_rcpf(1.0f + __builtin_amdgcn_exp2f(-1.4426950408889634f * x)); }
__device__ __forceinline__ float neg_decay_log(float x) {
    const float y = -x, sp = fmaxf(y, 0.f) + 0.6931471805599453f * __builtin_amdgcn_logf(1.0f + __builtin_amdgcn_exp2f(-1.4426950408889634f * fabsf(y)));
    return -__builtin_amdgcn_exp2f(-1.4426950408889634f * (sp + 0.5f));
}
__device__ __forceinline__ u32x4 pack8(const f32x4 v0, const f32x4 v1) { u32x4 w; w.x = cvt_pk_bf16(v0[0], v0[1]); w.y = cvt_pk_bf16(v0[2], v0[3]); w.z = cvt_pk_bf16(v1[0], v1[1]); w.w = cvt_pk_bf16(v1[2], v1[3]); return w; }
__device__ __forceinline__ void unpack8(const u32x4 w, f32x4& v0, f32x4& v1) {
    v0[0] = __uint_as_float(w.x << 16); v0[1] = __uint_as_float(w.x & 0xffff0000u); v0[2] = __uint_as_float(w.y << 16); v0[3] = __uint_as_float(w.y & 0xffff0000u);
    v1[0] = __uint_as_float(w.z << 16); v1[1] = __uint_as_float(w.z & 0xffff0000u); v1[2] = __uint_as_float(w.w << 16); v1[3] = __uint_as_float(w.w & 0xffff0000u);
}
constexpr int E_MP = 16384, E_MS = 256;

struct EpiIn {
    static constexpr bool PERM = true, AFTER_DRAIN = false, PERM_A = false;
    const float* ss; const float* rope;
    bf16_t *Q, *K, *V, *URW;
    float *kout_p, *vout_p, *kout_s, *vout_s;
    float *sh_p, *sh_s;
    __device__ __forceinline__ void operator()(const f32x4 (&acc)[2][2][4][2], const Unit& u, int wr, int wc, int fr, int fq) const {
        const int pn = u.pn, rowb = u.pm * BM + wr * 64 + fr, cl = wc * 32 + 8 * fq;
        const bool rope_wave = (pn < 8) && ((wc & 1) == 0);
        const float sgn = (fq == 0) ? -1.f : 1.f;
#pragma unroll
        for (int ai = 0; ai < 2; ++ai)
#pragma unroll
            for (int m = 0; m < 4; ++m) {
                const int row = rowb + ai * HALF + m * 16;
                const float rstd = 1.0f / sqrtf(ss[row] * (1.0f / 1024.f) + 1e-6f);
                const bool smp = row >= E_MP;
                const int t = smp ? ((row - E_MP) & 31) : (row & 2047);
                const int bb = smp ? ((row - E_MP) >> 5) : (row >> 11);
                const int pos = smp ? 2048 + t : t;
                const bool last = smp ? (t == 31) : (t == 2047);
#pragma unroll
                for (int bj = 0; bj < 2; ++bj) {
                    f32x4 v0 = acc[ai][bj][m][0] * rstd, v1 = acc[ai][bj][m][1] * rstd;
                    const int col = pn * BM + bj * HALF + cl;
                    if (pn < 8) {
                        if (rope_wave) {
                            f32x4 p0, p1;
#pragma unroll
                            for (int j = 0; j < 4; ++j) { p0[j] = __shfl_xor(v0[j], 16); p1[j] = __shfl_xor(v1[j], 16); }
                            if (fq < 2) {
                                const float* tb = rope + pos * 16;
                                const f32x4 c0 = *(const f32x4*)(tb), c1 = *(const f32x4*)(tb + 4), s0 = *(const f32x4*)(tb + 8), s1 = *(const f32x4*)(tb + 12);
                                v0 = v0 * c0 + (p0 * s0) * sgn; v1 = v1 * c1 + (p1 * s1) * sgn;
                            }
                        }
                        if (pn < 4) { v0 = v0 * C2; v1 = v1 * C2; *(u32x4*)(Q + (size_t)row * 1024 + col) = pack8(v0, v1); }
                        else {
                            const int c = col - 1024;
                            *(u32x4*)(K + (size_t)row * 1024 + c) = pack8(v0, v1);
                            float* o = smp ? kout_s + (size_t)(row - E_MP) * 1024 + c : kout_p + (size_t)row * 1024 + c;
                            *(f32x4*)o = v0; *(f32x4*)(o + 4) = v1;
                        }
                    } else if (pn < 12) {
                        const int c = col - 2048;
                        *(u32x4*)(V + (size_t)row * 1024 + c) = pack8(v0, v1);
                        float* o = smp ? vout_s + (size_t)(row - E_MP) * 1024 + c : vout_p + (size_t)row * 1024 + c;
                        *(f32x4*)o = v0; *(f32x4*)(o + 4) = v1;
                    } else {
                        const int c = col - 3072;
                        *(u32x4*)(URW + (size_t)row * 3328 + c) = pack8(v0, v1);
                        if (last) { float* o = (smp ? sh_s : sh_p) + (size_t)bb * 3328 + c; *(f32x4*)o = v0; *(f32x4*)(o + 4) = v1; }
                    }
                }
            }
    }
};

struct EpiGate {
    static constexpr bool PERM = true, AFTER_DRAIN = false, PERM_A = false;
    const float* ss; bf16_t* GATE;
    __device__ __forceinline__ void operator()(const f32x4 (&acc)[2][2][4][2], const Unit& u, int wr, int wc, int fr, int fq) const {
        const int rowb = u.pm * BM + wr * 64 + fr, cl = u.pn * BM + wc * 32 + 8 * fq;
#pragma unroll
        for (int ai = 0; ai < 2; ++ai)
#pragma unroll
            for (int m = 0; m < 4; ++m) {
                const int row = rowb + ai * HALF + m * 16;
                const float rstd = 1.0f / sqrtf(ss[row] * (1.0f / 1024.f) + 1e-6f);
#pragma unroll
                for (int bj = 0; bj < 2; ++bj) {
                    f32x4 v0 = acc[ai][bj][m][0] * rstd, v1 = acc[ai][bj][m][1] * rstd;
#pragma unroll
                    for (int j = 0; j < 4; ++j) { v0[j] = fast_sigmoid(v0[j]); v1[j] = fast_sigmoid(v1[j]); }
                    *(u32x4*)(GATE + (size_t)row * 2048 + cl + bj * HALF) = pack8(v0, v1);
                }
            }
    }
};

struct EpiGated {
    static constexpr bool PERM = true, AFTER_DRAIN = false, PERM_A = false;
    const bf16_t* G; int goff; const bf16_t* S; bf16_t* O;
    __device__ __forceinline__ void operator()(const f32x4 (&acc)[2][2][4][2], const Unit& u, int wr, int wc, int fr, int fq) const {
        const int rowb = u.pm * BM + wr * 64 + fr, cl = u.pn * BM + wc * 32 + 8 * fq;
#pragma unroll
        for (int ai = 0; ai < 2; ++ai)
#pragma unroll
            for (int m = 0; m < 4; ++m) {
                const int row = rowb + ai * HALF + m * 16;
#pragma unroll
                for (int bj = 0; bj < 2; ++bj) {
                    const int c = cl + bj * HALF;
                    f32x4 g0, g1; unpack8(*(const u32x4*)(G + (size_t)row * 2048 + goff + c), g0, g1);
                    f32x4 v0 = acc[ai][bj][m][0] * g0, v1 = acc[ai][bj][m][1] * g1;
                    if (S) { f32x4 s0, s1; unpack8(*(const u32x4*)(S + (size_t)row * 1024 + c), s0, s1); v0 += s0; v1 += s1; }
                    *(u32x4*)(O + (size_t)row * 1024 + c) = pack8(v0, v1);
                }
            }
    }
};

struct EpiRes {
    static constexpr bool PERM = true, AFTER_DRAIN = false, PERM_A = false;
    const float* Xr; float* X; bf16_t* XB; float* SS;
    __device__ __forceinline__ void operator()(const f32x4 (&acc)[2][2][4][2], const Unit& u, int wr, int wc, int fr, int fq) const {
        const int rowb = u.pm * BM + wr * 64 + fr, cl = u.pn * BM + wc * 32 + 8 * fq;
#pragma unroll
        for (int ai = 0; ai < 2; ++ai)
#pragma unroll
            for (int m = 0; m < 4; ++m) {
                const int row = rowb + ai * HALF + m * 16;
                float sq = 0.f;
#pragma unroll
                for (int bj = 0; bj < 2; ++bj) {
                    const int c = cl + bj * HALF;
                    float* xp = X + (size_t)row * 1024 + c; const float* xq = Xr + (size_t)row * 1024 + c;
                    const f32x4 v0 = *(const f32x4*)xq + acc[ai][bj][m][0], v1 = *(const f32x4*)(xq + 4) + acc[ai][bj][m][1];
                    *(f32x4*)xp = v0; *(f32x4*)(xp + 4) = v1;
                    *(u32x4*)(XB + (size_t)row * 1024 + c) = pack8(v0, v1);
                    sq += (v0[0] * v0[0] + v0[1] * v0[1]) + (v0[2] * v0[2] + v0[3] * v0[3]) + (v1[0] * v1[0] + v1[1] * v1[1]) + (v1[2] * v1[2] + v1[3] * v1[3]);
                }
                sq += __shfl_xor(sq, 16); sq += __shfl_xor(sq, 32);
                if (fq == 0) atomicAdd(SS + row, sq);
            }
    }
};

constexpr int E_MT = 16640, E_DFF = 2816, UC_ROWS = 254, UC_TILES = 66;
__device__ __forceinline__ float silu_mul(float a, float g) { return a * __builtin_amdgcn_rcpf(1.0f + __builtin_amdgcn_exp2f(-1.4426950408889634f * a)) * g; }
__device__ __forceinline__ float dpp_shr1s(float v, float lane0) { return __builtin_bit_cast(float, __builtin_amdgcn_update_dpp(__builtin_bit_cast(int, lane0), __builtin_bit_cast(int, v), 0x111, 0xF, 0xF, false)); }
__device__ __forceinline__ f32x4 dpp_shr1(const f32x4 v, const f32x4 lane0) { f32x4 r; r.x = dpp_shr1s(v.x, lane0.x); r.y = dpp_shr1s(v.y, lane0.y); r.z = dpp_shr1s(v.z, lane0.z); r.w = dpp_shr1s(v.w, lane0.w); return r; }
struct EpiUpConv {
    static constexpr bool PERM = true, AFTER_DRAIN = false, PERM_A = true;
    const float* ss; bf16_t* GT; const float *cw, *cb; PG8_LAS float* halo;
    template <int ai, int bj, int n> __device__ __forceinline__ void conv_cols(f32x4 (&x)[2][2][4][2], const int wid, const int wr, int fq, const int cb0) const {
        asm volatile("" : "+v"(fq));
        const int ca = cb0 + 8 * fq, col = bj * E_DFF + ca + 4 * n;
        const f32x4 w0 = *(const f32x4*)(cw + col), w1 = *(const f32x4*)(cw + 5632 + col), w2 = *(const f32x4*)(cw + 2 * 5632 + col), bi = *(const f32x4*)(cb + col);
        f32x4 h1 = (f32x4){0.f, 0.f, 0.f, 0.f}, h2 = h1;
        if (wr == 1 || ai == 1) { const int pw = wr ? wid - 4 : wid + 4, pai = wr ? ai : 0;
            const PG8_LAS float* hp = halo + ((((pw * 2 + pai) * 2 + 0) * 2 + bj) * 32 + fq * 8 + 4 * n);
            h2 = *(const PG8_LAS f32x4*)hp; h1 = *(const PG8_LAS f32x4*)(hp + 64); }
        const f32x4 a0 = x[ai][bj][0][n], a1 = x[ai][bj][1][n], a2 = x[ai][bj][2][n], a3 = x[ai][bj][3][n];
        const f32x4 vm1 = dpp_shr1(a3, h1), vm2 = dpp_shr1(a2, h2);
        x[ai][bj][3][n] = bi + a1 * w0 + a2 * w1 + a3 * w2;
        x[ai][bj][2][n] = bi + a0 * w0 + a1 * w1 + a2 * w2;
        x[ai][bj][1][n] = bi + vm1 * w0 + a0 * w1 + a1 * w2;
        x[ai][bj][0][n] = bi + vm2 * w0 + vm1 * w1 + a0 * w2;
    }
    template <int ai> __device__ __forceinline__ void block_out(f32x4 (&x)[2][2][4][2], const Unit& u, const int wid, const int wr, const int wc, int fr, int fq, const int R0) const {
        const int cb0 = 128 * u.pn + wc * 32;
        conv_cols<ai, 0, 0>(x, wid, wr, fq, cb0); conv_cols<ai, 0, 1>(x, wid, wr, fq, cb0); conv_cols<ai, 1, 0>(x, wid, wr, fq, cb0); conv_cols<ai, 1, 1>(x, wid, wr, fq, cb0);
        asm volatile("" : "+v"(fr), "+v"(fq));
        const int lrb = wr * 64 + 4 * fr, ca = cb0 + 8 * fq;
#pragma unroll
        for (int m = 0; m < 4; ++m) {
            const int lr = lrb + ai * HALF + m, row = R0 + lr;
            const int tq = (row >= E_MP) ? ((row - E_MP) & 31) : (row & 2047);
            if (lr >= 2 && (unsigned)row < (unsigned)E_MT && tq >= 2) {
                f32x4 g0, g1;
                g0.x = silu_mul(x[ai][0][m][0].x, x[ai][1][m][0].x); g0.y = silu_mul(x[ai][0][m][0].y, x[ai][1][m][0].y); g0.z = silu_mul(x[ai][0][m][0].z, x[ai][1][m][0].z); g0.w = silu_mul(x[ai][0][m][0].w, x[ai][1][m][0].w);
                g1.x = silu_mul(x[ai][0][m][1].x, x[ai][1][m][1].x); g1.y = silu_mul(x[ai][0][m][1].y, x[ai][1][m][1].y); g1.z = silu_mul(x[ai][0][m][1].z, x[ai][1][m][1].z); g1.w = silu_mul(x[ai][0][m][1].w, x[ai][1][m][1].w);
                *(u32x4*)(GT + (size_t)row * E_DFF + ca) = pack8(g0, g1);
            }
        }
    }
    __device__ __forceinline__ void operator()(f32x4 (&x)[2][2][4][2], const Unit& u, int wr, int wc, int fr, int fq) const {
        asm volatile("" : "+v"(fr), "+v"(fq), "+s"(wr), "+s"(wc));
        const int wid = wr * 4 + wc, R0 = UC_ROWS * u.pm - 2, lrb = wr * 64 + 4 * fr, ca = 128 * u.pn + wc * 32 + 8 * fq;
#pragma unroll
        for (int ai = 0; ai < 2; ++ai)
#pragma unroll
            for (int m = 0; m < 4; ++m) {
                const int lr = lrb + ai * HALF + m, row = R0 + lr;
                const bool valid = (unsigned)row < (unsigned)E_MT;
                const float rstd = valid ? __builtin_amdgcn_rsqf(ss[valid ? row : 0] * (1.0f / 1024.f) + 1e-6f) : 0.f;
#pragma unroll
                for (int bj = 0; bj < 2; ++bj) { x[ai][bj][m][0] = x[ai][bj][m][0] * rstd; x[ai][bj][m][1] = x[ai][bj][m][1] * rstd; }
            }
        if (fr == 15) {
#pragma unroll
            for (int ai = 0; ai < 2; ++ai)
#pragma unroll
                for (int rr = 0; rr < 2; ++rr)
#pragma unroll
                    for (int bj = 0; bj < 2; ++bj) { PG8_LAS float* hp = halo + ((((wid * 2 + ai) * 2 + rr) * 2 + bj) * 32 + fq * 8);
                        *(PG8_LAS f32x4*)hp = x[ai][bj][2 + rr][0]; *(PG8_LAS f32x4*)(hp + 4) = x[ai][bj][2 + rr][1]; }
        }
        asm volatile("s_waitcnt lgkmcnt(0)" ::: "memory"); __builtin_amdgcn_s_barrier(); asm volatile("" ::: "memory");
        unsigned xp[2][4][4];
#pragma unroll
        for (int bj = 0; bj < 2; ++bj)
#pragma unroll
            for (int m = 0; m < 4; ++m) { const u32x4 w = pack8(x[1][bj][m][0], x[1][bj][m][1]); xp[bj][m][0] = w.x; xp[bj][m][1] = w.y; xp[bj][m][2] = w.z; xp[bj][m][3] = w.w; }
        asm volatile("" ::: "memory");
        block_out<0>(x, u, wid, wr, wc, fr, fq, R0);
        asm volatile("" ::: "memory");
#pragma unroll
        for (int bj = 0; bj < 2; ++bj)
#pragma unroll
            for (int m = 0; m < 4; ++m) { u32x4 w; w.x = xp[bj][m][0]; w.y = xp[bj][m][1]; w.z = xp[bj][m][2]; w.w = xp[bj][m][3]; unpack8(w, x[1][bj][m][0], x[1][bj][m][1]); }
        block_out<1>(x, u, wid, wr, wc, fr, fq, R0);
    }
};

template <class Epi, class Sched, bool ALIGN_EPI = false, bool SP2 = false>
__device__ __forceinline__ void gemm_phase(PG8_LAS unsigned char* lds, const Gemm g, const Sched& S, const Epi& E) {
    int tid_ = threadIdx.x; asm volatile("" : "+v"(tid_));
    const int tid = tid_, wid = __builtin_amdgcn_readfirstlane(tid >> 6), lane = tid & 63, wr = wid >> 2, wc = wid & 3, fr = lane & 15, fq = lane >> 4;
    const int K = g.K, nt = K / BK;
    unsigned voffA[2], voffB[2];
#define PG8_VOFF(tv) do { _Pragma("unroll") for (int i = 0; i < 2; ++i) { int R, C; stage_rc((tv) * 16 + i * 8192, R, C); const int Rb = Epi::PERM ? ((R & ~31) + perm32(R & 31)) : R; \
        const int Ra = Epi::PERM_A ? ((R & ~63) + 4 * (R & 15) + ((R >> 4) & 3)) : R;     \
        voffA[i] = (unsigned)(Ra * K + C) * 2u; voffB[i] = (unsigned)(Rb * K + C) * 2u; } } while (0)
    PG8_VOFF(tid);
    const size_t kstep = (size_t)(BK * 2);
    const size_t hstep = (size_t)HALF * K * 2;
    const size_t tstep = 2 * hstep;
    const unsigned ldsw = (unsigned)wid * 1024u;
    int aoff = lds_byte(wr * 64 + fr, fq * 8), boff = lds_byte(wc * 32 + fr, fq * 8);
#define PG8_SA(b, h) (((b) * 2 + (h)) * HTB)
#define PG8_SB(b, h) ((4 + (b) * 2 + (h)) * HTB)
#define PG8_STAGE(bufoff, gbase, voff) do { _Pragma("unroll") for (int _i = 0; _i < 2; ++_i) \
        __builtin_amdgcn_global_load_lds((const unsigned*)((const char*)(gbase) + (voff)[_i]), (PG8_LAS unsigned*)(lds + (bufoff) + ldsw + _i * 8192), 16, 0, 0); } while (0)
#define PG8_LDA(dst, b, h) do { _Pragma("unroll") for (int m = 0; m < 4; ++m) _Pragma("unroll") for (int k = 0; k < 2; ++k) dst[m][k] = *(const PG8_LAS bf16x8*)(lds + PG8_SA(b, h) + aoff + m * 2048 + k * 1024); } while (0)
#define PG8_LDB(dst, b, h) do { _Pragma("unroll") for (int n = 0; n < 2; ++n) _Pragma("unroll") for (int k = 0; k < 2; ++k) dst[n][k] = *(const PG8_LAS bf16x8*)(lds + PG8_SB(b, h) + boff + n * 2048 + k * 1024); } while (0)
#define PG8_MMA(ai, bj, At, Bt) do { __builtin_amdgcn_s_setprio(1); _Pragma("unroll") for (int m = 0; m < 4; ++m) _Pragma("unroll") for (int n = 0; n < 2; ++n) _Pragma("unroll") for (int k = 0; k < 2; ++k) \
        acc[ai][bj][m][n] = __builtin_amdgcn_mfma_f32_16x16x32_bf16(Bt[n][k], At[m][k], acc[ai][bj][m][n], 0, 0, 0); __builtin_amdgcn_s_setprio(0); } while (0)
#define PG8_WAIT_V(n) asm volatile("s_waitcnt vmcnt(" #n ")" ::: "memory")
#define PG8_WAIT_L(n) asm volatile("s_waitcnt lgkmcnt(" #n ")" ::: "memory")
#define PG8_BAR __builtin_amdgcn_s_barrier()
#define PG8_SCHED __builtin_amdgcn_sched_barrier(0)
    Unit cur, nxt; int ui = 0;
    if (!S.next(0, cur)) return;
    f32x4 acc[2][2][4][2];
#pragma unroll
    for (int a = 0; a < 2; ++a)
#pragma unroll
        for (int b = 0; b < 2; ++b)
#pragma unroll
            for (int m = 0; m < 4; ++m)
#pragma unroll
                for (int n = 0; n < 2; ++n) acc[a][b][m][n] = (f32x4){0.f, 0.f, 0.f, 0.f};
    bf16x8 At[4][2], B0[2][2], B1[2][2];
    const long arow = (long)K * 2;
    const char* cA = (const char*)g.A + ((long)cur.pm * g.a_rows + g.a_row0) * arow; const char* cB = (const char*)g.Bt + (size_t)cur.pn * tstep;
    S.a_ready(cur);
    if constexpr (SP2) {
        PG8_STAGE(PG8_SB(0, 0), cB, voffB); PG8_STAGE(PG8_SB(0, 1), cB + hstep, voffB); PG8_STAGE(PG8_SA(0, 0), cA, voffA); PG8_STAGE(PG8_SA(0, 1), cA + hstep, voffA);
        if (wr == 1) PG8_BAR;
        PG8_WAIT_V(2); PG8_BAR;
        PG8_STAGE(PG8_SB(1, 0), cB + kstep, voffB); PG8_STAGE(PG8_SA(1, 0), cA + kstep, voffA); PG8_STAGE(PG8_SB(1, 1), cB + hstep + kstep, voffB);
        PG8_WAIT_V(6); PG8_BAR;
    } else {
        PG8_STAGE(PG8_SB(0, 0), cB, voffB); PG8_STAGE(PG8_SA(0, 0), cA, voffA); PG8_STAGE(PG8_SB(0, 1), cB + hstep, voffB); PG8_STAGE(PG8_SA(0, 1), cA + hstep, voffA);
        if (wr == 1) PG8_BAR;
        PG8_WAIT_V(4); PG8_BAR;
        PG8_STAGE(PG8_SB(1, 0), cB + kstep, voffB); PG8_STAGE(PG8_SA(1, 0), cA + kstep, voffA); PG8_STAGE(PG8_SB(1, 1), cB + hstep + kstep, voffB);
        PG8_WAIT_V(6); PG8_BAR;
    }
    for (;;) {
        const bool has_next = S.next(ui + 1, nxt);
        const char* nA = has_next ? (const char*)g.A + ((long)nxt.pm * g.a_rows + g.a_row0) * arow : cA; const char* nB = has_next ? (const char*)g.Bt + (size_t)nxt.pn * tstep : cB;
        for (int t = 0; t < nt; t += 2) {
            const bool last = (t == nt - 2);
            const char* a1 = cA + (size_t)(t + 1) * kstep;
            const char* a2 = last ? nA : cA + (size_t)(t + 2) * kstep; const char* b2 = last ? nB : cB + (size_t)(t + 2) * kstep;
            const char* a3 = a2 + kstep; const char* b3 = b2 + kstep;
            if (last && has_next) S.a_ready(nxt);
            if constexpr (SP2) {
            PG8_LDB(B0, 0, 0); PG8_LDB(B1, 0, 1); PG8_SCHED; PG8_LDA(At, 0, 0); PG8_STAGE(PG8_SA(1, 1), a1 + hstep, voffA);
            PG8_WAIT_V(8); PG8_WAIT_L(0); PG8_BAR; PG8_MMA(0, 0, At, B0); PG8_MMA(0, 1, At, B1); PG8_BAR; PG8_SCHED;
            PG8_LDA(At, 0, 1); PG8_STAGE(PG8_SB(0, 0), b2, voffB); PG8_STAGE(PG8_SB(0, 1), b2 + hstep, voffB); PG8_STAGE(PG8_SA(0, 0), a2, voffA);
            PG8_WAIT_V(8); PG8_WAIT_L(0); PG8_BAR; PG8_MMA(1, 0, At, B0); PG8_MMA(1, 1, At, B1); PG8_BAR; PG8_SCHED;
            PG8_LDB(B0, 1, 0); PG8_LDB(B1, 1, 1); PG8_SCHED; PG8_LDA(At, 1, 0); PG8_STAGE(PG8_SA(0, 1), a2 + hstep, voffA);
            PG8_WAIT_V(8); PG8_WAIT_L(0); PG8_BAR; PG8_MMA(0, 0, At, B0); PG8_MMA(0, 1, At, B1); PG8_BAR; PG8_SCHED;
            PG8_LDA(At, 1, 1); PG8_STAGE(PG8_SB(1, 0), b3, voffB); PG8_STAGE(PG8_SB(1, 1), b3 + hstep, voffB); PG8_STAGE(PG8_SA(1, 0), a3, voffA);
            PG8_WAIT_V(8); PG8_WAIT_L(0); PG8_BAR; PG8_MMA(1, 0, At, B0); PG8_MMA(1, 1, At, B1); PG8_BAR; PG8_SCHED;
            } else {
            PG8_LDB(B0, 0, 0); PG8_SCHED; PG8_LDA(At, 0, 0); PG8_STAGE(PG8_SA(1, 1), a1 + hstep, voffA);
            PG8_WAIT_L(8); PG8_BAR; PG8_WAIT_L(0); PG8_MMA(0, 0, At, B0); PG8_BAR; PG8_SCHED;
            PG8_LDB(B1, 0, 1); PG8_STAGE(PG8_SB(0, 0), b2, voffB);
            PG8_BAR; PG8_WAIT_L(0); PG8_MMA(0, 1, At, B1); PG8_BAR;
            PG8_LDA(At, 0, 1); PG8_STAGE(PG8_SA(0, 0), a2, voffA);
            PG8_BAR; PG8_WAIT_L(0); PG8_MMA(1, 0, At, B0); PG8_BAR; PG8_SCHED;
            PG8_STAGE(PG8_SB(0, 1), b2 + hstep, voffB);
            PG8_WAIT_V(6); PG8_BAR; PG8_MMA(1, 1, At, B1); PG8_BAR;
            PG8_LDB(B0, 1, 0); PG8_SCHED; PG8_LDA(At, 1, 0); PG8_STAGE(PG8_SA(0, 1), a2 + hstep, voffA);
            PG8_WAIT_L(8); PG8_BAR; PG8_WAIT_L(0); PG8_MMA(0, 0, At, B0); PG8_BAR; PG8_SCHED;
            PG8_LDB(B1, 1, 1); PG8_STAGE(PG8_SB(1, 0), b3, voffB);
            PG8_BAR; PG8_WAIT_L(0); PG8_MMA(0, 1, At, B1); PG8_BAR;
            PG8_LDA(At, 1, 1); PG8_STAGE(PG8_SA(1, 0), a3, voffA);
            PG8_BAR; PG8_WAIT_L(0); PG8_MMA(1, 0, At, B0); PG8_BAR; PG8_SCHED;
            PG8_STAGE(PG8_SB(1, 1), b3 + hstep, voffB);
            PG8_WAIT_V(6); PG8_BAR; PG8_MMA(1, 1, At, B1); PG8_BAR;
            }
        }
        if constexpr (ALIGN_EPI) { if (wr == 0) PG8_BAR; }
        if constexpr (Epi::PERM_A) {
            { int tv_ = threadIdx.x; asm volatile("" : "+v"(tv_)); const int ln_ = tv_ & 63; E(acc, cur, wr, wc, ln_ & 15, ln_ >> 4); S.done(cur); }
            { int tv_ = threadIdx.x; asm volatile("" : "+v"(tv_)); PG8_VOFF(tv_); const int ln_ = tv_ & 63, fr_ = ln_ & 15, fq_ = ln_ >> 4; aoff = lds_byte(wr * 64 + fr_, fq_ * 8); boff = lds_byte(wc * 32 + fr_, fq_ * 8); }
        } else
        if constexpr (!Epi::AFTER_DRAIN) { E(acc, cur, wr, wc, fr, fq); S.done(cur); }
        if (!has_next) break;
#pragma unroll
        for (int a = 0; a < 2; ++a)
#pragma unroll
            for (int b = 0; b < 2; ++b)
#pragma unroll
                for (int m = 0; m < 4; ++m)
#pragma unroll
                    for (int n = 0; n < 2; ++n) acc[a][b][m][n] = (f32x4){0.f, 0.f, 0.f, 0.f};
        cur = nxt; cA = nA; cB = nB; ++ui;
        if constexpr (ALIGN_EPI) { if (wr == 1) PG8_BAR; }
    }
    PG8_WAIT_V(0);
    if constexpr (!ALIGN_EPI) { if (wr == 0) PG8_BAR; }
    PG8_BAR;
    if constexpr (Epi::AFTER_DRAIN) { E.fused(acc, cur, wr, wc, fr, fq, lds, wid, lane); S.done(cur); }
#undef PG8_VOFF
#undef PG8_SA
#undef PG8_SB
#undef PG8_STAGE
#undef PG8_LDA
#undef PG8_LDB
#undef PG8_MMA
#undef PG8_WAIT_V
#undef PG8_WAIT_L
#undef PG8_BAR
#undef PG8_SCHED
}
}

constexpr int NWAVES = 8;
constexpr size_t MiB = 1u << 20;
constexpr size_t WS_CTL = 0, CTL_ZERO_BYTES = 2 * MiB;
constexpr size_t WS_ROPE = 2 * MiB;
constexpr size_t WS_W = 8 * MiB;
constexpr size_t W_IN = 0, W_ODA = W_IN + (size_t)P_TOTAL * 1024 * 2, W_ORW = W_ODA + 2 * MiB, W_OUT = W_ORW + 2 * MiB, W_UP = W_OUT + 2 * MiB,
                 W_DN = W_UP + (size_t)UPW * 1024 * 2, W_LORA = W_DN + (size_t)1024 * D_FF * 2, W_LAYER = W_LORA + (size_t)3072 * 256 * 2;
static_assert(W_LAYER == 42467328, "weights per layer");
constexpr size_t W_UP1 = W_LAYER;
constexpr size_t WS_DN1 = WS_ROPE + 256 * 1024;
static_assert(WS_DN1 + (size_t)1024 * D_FF * 2 <= WS_W, "W_DN1 slot");
constexpr size_t WS_XB = WS_W + W_LAYER + (size_t)1024 * UPW * 2;
constexpr size_t ACT = (size_t)MT * 1024 * 2;
constexpr size_t WS_POOL = WS_XB + ACT;
constexpr size_t B_Q = WS_POOL, B_K = B_Q + ACT, B_V = B_K + ACT, B_OC = B_V + ACT  , B_ORW = B_OC + 2 * ACT, B_URW = B_ORW + ACT, B_LD = B_URW + (size_t)MT * P_RW * 2, B_LA = B_LD + ACT,
                 B_LG = B_LA + ACT, B_END = B_LG + ACT;
constexpr size_t B_LIN = B_LD;
constexpr size_t B_GATE = B_Q, B_OA = B_V;
constexpr size_t B_MRG = B_URW;
constexpr size_t B_UP = WS_POOL, B_GT = B_URW;
constexpr size_t WS_SP = B_END;
constexpr size_t B_END2 = WS_SP + (size_t)1024 * 32 * 132 * 4;
static_assert(B_UP + (size_t)MT * UPW * 2 <= B_GT && B_GT + (size_t)MT * D_FF * 2 <= B_LD, "FFN overlay");
static_assert(B_END2 <= 512 * MiB, "workspace map");
constexpr int CW_BAR = 4096;
constexpr int CW_LAM = 8192;
constexpr int CW_AQ = 8256;
constexpr int CW_SS = 16384;
static_assert((CW_SS + 5 * MT) * 4 <= (int)CTL_ZERO_BYTES, "CTL region");
constexpr int RING_OFF = 0, RING_BYTES = 131072;
constexpr int LDSCTL_OFF = RING_BYTES, MISC_OFF = LDSCTL_OFF + 320;
constexpr int LDS_BYTES = 147456;
constexpr int UC_HALO_OFF = LDSCTL_OFF + 1024;
static_assert(UC_HALO_OFF + 8192 <= LDS_BYTES && MISC_OFF + 64 <= UC_HALO_OFF, "halo region");

constexpr int PH_PER_LAYER = 11;
constexpr int NPHASE = 1 + DEPTH * PH_PER_LAYER + 1;
enum { K_G1 = 0, K_LP, K_LR, K_SC, K_CB, K_M1, K_M2, K_WO, K_UP, K_CV, K_DN };

#include <hip/hip_bf16.h>
#include <cmath>
namespace attn_body {
using bf16=__hip_bfloat16;
using bf16x8=__attribute__((ext_vector_type(8)))short;
using s16x4=__attribute__((ext_vector_type(4)))short;
using f32x16=__attribute__((ext_vector_type(16)))float;
using u32x4=__attribute__((ext_vector_type(4)))unsigned;
constexpr int BATCH=8,SEQ=2048,D=64,DM=1024;
constexpr int NW=8,QBLK=32,QB=QBLK*NW,KVBLK=64,NQB=SEQ/QB;
constexpr int ATTN_PITCH=DM, ATTN_UNIT_ROWS=QB;
__device__ __forceinline__ int crow(int r,int hi){return (r&3)+8*(r>>2)+4*hi;}
#define SBAR() __builtin_amdgcn_sched_barrier(0)
__device__ __forceinline__ void cmask(f32x16&p0,f32x16&p1,int jb,int wid){
  const float NEG=-INFINITY;
  if(jb>(wid>>1)){
    #pragma unroll
    for(int r=0;r<16;++r){p0[r]=NEG;p1[r]=NEG;}
  }
}

constexpr int NSLOT=3, SLOTB=8192;
constexpr int LDS_K=0, LDS_V=NSLOT*SLOTB, LDS_WS=2*NSLOT*SLOTB, LDS_OST=LDS_WS+NW*64*4, LDS_BYTES=LDS_OST+NW*4096;
constexpr float C2=0.125f*1.4426950408889634f;
__device__ __forceinline__ void glds16(const void*gsrc,unsigned lds_dst){unsigned keep;
  asm volatile("s_mov_b32 %0, m0\n\ts_mov_b32 m0, %2\n\ts_nop 0\n\tglobal_load_lds_dwordx4 %1, off\n\ts_mov_b32 m0, %0":"=&s"(keep):"v"(gsrc),"s"(lds_dst):"memory");}
__device__ __forceinline__ float max3f(float a,float b,float c){float r;asm("v_max3_f32 %0, %1, %2, %3":"=v"(r):"v"(a),"v"(b),"v"(c));return r;}
__device__ __forceinline__ float max2f(float a,float b){float r;asm("v_max_f32_e32 %0, %1, %2":"=v"(r):"v"(a),"v"(b));return r;}
__device__ __forceinline__ float fadd_s(float a,float b){float r;asm("v_add_f32_e32 %0, %1, %2":"=v"(r):"v"(a),"v"(b));return r;}
__device__ __forceinline__ float fsub_s(float a,float b){float r;asm("v_sub_f32_e32 %0, %1, %2":"=v"(r):"v"(a),"v"(b));return r;}
typedef float f32x2_t __attribute__((ext_vector_type(2))); typedef __bf16 bf16x2_t __attribute__((ext_vector_type(2)));
__device__ __forceinline__ unsigned cvtpk_s(float lo,float hi){f32x2_t v={lo,hi};bf16x2_t b=__builtin_convertvector(v,bf16x2_t);return __builtin_bit_cast(unsigned,b);}
#define WAIT_BAR(N) asm volatile("s_waitcnt vmcnt(" #N ") lgkmcnt(0)\n\ts_barrier":::"memory")

__device__ __forceinline__ void qkt(f32x16&p0,f32x16&p1,const char*Kslot,const bf16x8*qr,const f32x16&negm,int r32,int hi){
  const char*kb=Kslot+hi*1024+r32*16;
  #pragma unroll
  for(int d0=0;d0<4;++d0){
    const bf16x8 b0=*reinterpret_cast<const bf16x8*>(kb+d0*2048);
    const bf16x8 b1=*reinterpret_cast<const bf16x8*>(kb+d0*2048+512);
    if(d0==0){p0=__builtin_amdgcn_mfma_f32_32x32x16_bf16(b0,qr[0],negm,0,0,0);p1=__builtin_amdgcn_mfma_f32_32x32x16_bf16(b1,qr[0],negm,0,0,0);}
    else{p0=__builtin_amdgcn_mfma_f32_32x32x16_bf16(b0,qr[d0],p0,0,0,0);p1=__builtin_amdgcn_mfma_f32_32x32x16_bf16(b1,qr[d0],p1,0,0,0);}}
}
typedef __attribute__((address_space(3))) const char* lds_cptr;
typedef short v4i16_t __attribute__((ext_vector_type(4)));
__device__ __forceinline__ void kload8(bf16x8*kf,lds_cptr kp){
  kf[0]=*(const __attribute__((address_space(3))) bf16x8*)(kp);      kf[1]=*(const __attribute__((address_space(3))) bf16x8*)(kp+512);
  kf[2]=*(const __attribute__((address_space(3))) bf16x8*)(kp+2048); kf[3]=*(const __attribute__((address_space(3))) bf16x8*)(kp+2560);
  kf[4]=*(const __attribute__((address_space(3))) bf16x8*)(kp+4096); kf[5]=*(const __attribute__((address_space(3))) bf16x8*)(kp+4608);
  kf[6]=*(const __attribute__((address_space(3))) bf16x8*)(kp+6144); kf[7]=*(const __attribute__((address_space(3))) bf16x8*)(kp+6656);
}
__device__ __forceinline__ void kload2(bf16x8*kf,lds_cptr kp,int j){ kf[2*j]=*(const __attribute__((address_space(3))) bf16x8*)(kp+j*2048); kf[2*j+1]=*(const __attribute__((address_space(3))) bf16x8*)(kp+j*2048+512); }
__device__ __forceinline__ s16x4 vtr(lds_cptr p){ return __builtin_bit_cast(s16x4,__builtin_amdgcn_ds_read_tr16_b64_v4i16((__attribute__((address_space(3))) v4i16_t*)p)); }
__device__ __forceinline__ float rowmax(const f32x16&p0,const f32x16&p1){
  float a=max3f(p0[0],p0[1],p1[0]),b=max3f(p0[2],p0[3],p1[1]);a=max3f(a,p1[2],p1[3]);
  #pragma unroll
  for(int r=4;r<16;r+=4){a=max3f(a,p0[r],p0[r+1]);b=max3f(b,p0[r+2],p0[r+3]);a=max3f(a,p1[r],p1[r+1]);b=max3f(b,p1[r+2],p1[r+3]);}
  const float m=max2f(a,b);
  auto rr=__builtin_amdgcn_permlane32_swap(__float_as_uint(m),__float_as_uint(m),false,false);
  return max2f(__uint_as_float(rr[0]),__uint_as_float(rr[1]));
}
__device__ __forceinline__ void pv(f32x16*o,int vb,bf16x8 pa0,bf16x8 pa1,bf16x8 pa2,bf16x8 pa3){
  #pragma unroll
  for(int d0=0;d0<2;++d0){s16x4 lo[4],hi[4];
    #pragma unroll
    for(int ks=0;ks<4;++ks){
      asm volatile("ds_read_b64_tr_b16 %0,%1 offset:%c2":"=&v"(lo[ks]):"v"(vb),"i"(d0*4096+ks*1024):"memory");
      asm volatile("ds_read_b64_tr_b16 %0,%1 offset:%c2":"=&v"(hi[ks]):"v"(vb),"i"(d0*4096+ks*1024+512):"memory");}
    asm volatile("s_waitcnt lgkmcnt(0)":::"memory");SBAR();
    #define PK(k) (bf16x8){lo[k][0],lo[k][1],lo[k][2],lo[k][3],hi[k][0],hi[k][1],hi[k][2],hi[k][3]}
    o[d0]=__builtin_amdgcn_mfma_f32_32x32x16_bf16(pa0,PK(0),o[d0],0,0,0);
    o[d0]=__builtin_amdgcn_mfma_f32_32x32x16_bf16(pa1,PK(1),o[d0],0,0,0);
    o[d0]=__builtin_amdgcn_mfma_f32_32x32x16_bf16(pa2,PK(2),o[d0],0,0,0);
    o[d0]=__builtin_amdgcn_mfma_f32_32x32x16_bf16(pa3,PK(3),o[d0],0,0,0);
    #undef PK
  }
}

#ifndef ATTN_STORE16
#define ATTN_STORE16(p,v) (*(u32x4*)(p)=(v))
#endif
template<int THRL> __device__ __forceinline__ void attn_unit(int b,int qcol,int vcol,int qb,const bf16*Q,const bf16*K,const bf16*V,bf16*O,char*shm){
  int tid_=threadIdx.x; asm volatile("" : "+v"(tid_)); const int tid=tid_,lane=tid&63,r32=lane&31,hi=lane>>5; const int wid=__builtin_amdgcn_readfirstlane(tid>>6);
  const long rowbase=(long)b*SEQ; const int q0=qb*QB;
  const bf16*Qw=Q+(rowbase+q0+wid*QBLK)*DM+qcol;
  const bf16*Kh=K+rowbase*DM+qcol,*Vh=V+rowbase*DM+vcol;
  const unsigned lds0=(unsigned)(uintptr_t)shm;
  float*wsf=(float*)(shm+LDS_WS)+wid*64;
  const bf16*ksrc=Kh+(long)lane*DM+wid*8;
  const bf16*vsrc=Vh+(long)(16*(wid&3)+(lane>>2))*DM+(wid>>2)*32+(lane&3)*8;
  const unsigned kdst=lds0+LDS_K+wid*1024, vdst=lds0+LDS_V+wid*1024;
  #define DMA_K(t,slot) glds16(ksrc+(long)(t)*KVBLK*DM,(unsigned)__builtin_amdgcn_readfirstlane(kdst+(slot)))
  #define DMA_V(t,slot) glds16(vsrc+(long)(t)*KVBLK*DM,(unsigned)__builtin_amdgcn_readfirstlane(vdst+(slot)))
  const int vb0=(int)(lds0+LDS_V)+((lane>>4)&1)*32+(lane&3)*8+(4*hi+((lane&15)>>2))*64;
  const char*Kbase=shm+LDS_K; bf16x8 kf[8];
  const lds_cptr shm3=(lds_cptr)shm; const lds_cptr kp0=shm3+LDS_K+hi*1024+r32*16; const lds_cptr vp0=shm3+LDS_V+((lane>>4)&1)*32+(lane&3)*8+(4*hi+((lane&15)>>2))*64;
  const int NT=(q0+QB)/KVBLK;
  DMA_K(0,0);DMA_V(0,0);DMA_K(1,SLOTB);
  bf16x8 qr[4];
  #pragma unroll
  for(int d0=0;d0<4;++d0)qr[d0]=*reinterpret_cast<const bf16x8*>(&Qw[(long)r32*DM+d0*16+hi*8]);
  float mhat=0.f,l_reg=0.f;f32x16 o[2];o[0]=f32x16{};o[1]=f32x16{};const f32x16 zc=f32x16{}; float nm=0.f;
  const int qrel=wid*QBLK+r32;
  #define CMASK(P0,P1,t) do{int jb_=(t)-(NT-4); if(jb_>=0)cmask(P0,P1,jb_,wid);}while(0)
  bool resc=false;
  #define START(P0,P1) do{ const float rm=rowmax(P0,P1); resc=false; \
    { const float dl=rm; mhat=fadd_s(mhat,dl); \
      _Pragma("unroll") for(int r=0;r<16;++r){P0[r]=fsub_s(P0[r],dl);P1[r]=fsub_s(P1[r],dl);} \
      nm=-mhat; } \
    _Pragma("unroll") for(int r=0;r<16;++r)P0[r]=__builtin_amdgcn_exp2f(P0[r]); }while(0)
  #define RESC() do{ if(resc){ asm volatile("s_waitcnt lgkmcnt(0)":::"memory"); \
      _Pragma("unroll") for(int d_=0;d_<2;++d_) _Pragma("unroll") for(int r=0;r<16;++r)o[d_][r]*=wsf[crow(r,hi)]; } }while(0)
  f32x16 pA0,pA1,pB0,pB1;
  int sl_prev=0,sl_cur=0,sl_next=SLOTB;
  #define ROT() do{sl_prev=sl_cur;sl_cur=sl_next;sl_next=(sl_next==(NSLOT-1)*SLOTB)?0:sl_next+SLOTB;}while(0)
  DMA_K(2,2*SLOTB);
  WAIT_BAR(3);
  qkt(pA0,pA1,Kbase,qr,zc,r32,hi);asm volatile("s_nop 15\n\ts_nop 7":"+v"(pA0),"+v"(pA1));CMASK(pA0,pA1,0);
  START(pA0,pA1);
  _Pragma("unroll") for(int r=0;r<16;++r)pA1[r]=__builtin_amdgcn_exp2f(pA1[r]);
  WAIT_BAR(0);
  DMA_K(3,0);DMA_V(1,SLOTB);
  ROT();
  kload8(kf,kp0+sl_cur);
  WAIT_BAR(2);
  s16x4 vlo[8],vhi[8]; u32x4 pw0,pw1,pw2,pw3;
  #define PKW(P,B) cvtpk_s(P[B],P[B+1])
  #define PAF(k) __builtin_bit_cast(bf16x8,pw##k)
  #define VFR(i) (bf16x8){vlo[i][0],vlo[i][1],vlo[i][2],vlo[i][3],vhi[i][0],vhi[i][1],vhi[i][2],vhi[i][3]}
  #define PIN(x) asm volatile("":"+v"(x))
  #define MX3(a,b,c) __builtin_fmaxf(__builtin_fmaxf((a),(b)),(c))
  #define GAPA(MF,A0,A1,A2,A3,W0,W1,PW) do{ MF; sacc+=A0; sacc+=A1; sacc+=A2; sacc+=A3; PIN(sacc); W0; W1; PIN(PW); SBAR(); }while(0)
  #define EX(v) __builtin_amdgcn_exp2f(v)
  #define GAPB(MF,X,B) do{ MF; X[B]=EX(X[B]); X[B+1]=EX(X[B+1]); X[B+2]=EX(X[B+2]); X[B+3]=EX(X[B+3]); PIN(X); SBAR(); }while(0)
  #define VRD(i) do{ vlo[i]=vtr(vp_+(((i)>>2)*4096+((i)&3)*1024)); vhi[i]=vtr(vp_+(((i)>>2)*4096+((i)&3)*1024+512)); }while(0)
  #define KRD(G,j) do{ if(G){ kload2(kf,kp0+sl_next,j); SBAR(); } }while(0)
  #define STEP(C0,C1,P0,P1,t,GK,GV,GL) do{ SBAR(); \
    const lds_cptr vp_=vp0+sl_prev; \
    VRD(0); SBAR(); float sacc=(P0[0]+P0[1]); \
    GAPA(C0=__builtin_amdgcn_mfma_f32_32x32x16_bf16(kf[0],qr[0],zc,0,0,0), P0[2],P0[3],P0[4],P0[5],     pw0[0]=PKW(P0,0), pw0[1]=PKW(P0,2), pw0); \
    VRD(4); SBAR(); GAPA(C1=__builtin_amdgcn_mfma_f32_32x32x16_bf16(kf[1],qr[0],zc,0,0,0), P0[6],P0[7],P0[8],P0[9],     pw0[2]=PKW(P0,4), pw0[3]=PKW(P0,6), pw0); \
    VRD(1); SBAR(); GAPA(C0=__builtin_amdgcn_mfma_f32_32x32x16_bf16(kf[2],qr[1],C0,0,0,0),   P0[10],P0[11],P0[12],P0[13], pw1[0]=PKW(P0,8), pw1[1]=PKW(P0,10), pw1); \
    VRD(5); SBAR(); GAPA(C1=__builtin_amdgcn_mfma_f32_32x32x16_bf16(kf[3],qr[1],C1,0,0,0),   P0[14],P0[15],P1[0],P1[1],   pw1[2]=PKW(P0,12),pw1[3]=PKW(P0,14), pw1); \
    VRD(2); SBAR(); GAPA(C0=__builtin_amdgcn_mfma_f32_32x32x16_bf16(kf[4],qr[2],C0,0,0,0),   P1[2],P1[3],P1[4],P1[5],     pw2[0]=PKW(P1,0), pw2[1]=PKW(P1,2), pw2); \
    VRD(6); SBAR(); GAPA(C1=__builtin_amdgcn_mfma_f32_32x32x16_bf16(kf[5],qr[2],C1,0,0,0),   P1[6],P1[7],P1[8],P1[9],     pw2[2]=PKW(P1,4), pw2[3]=PKW(P1,6), pw2); \
    VRD(3); SBAR(); GAPA(C0=__builtin_amdgcn_mfma_f32_32x32x16_bf16(kf[6],qr[3],C0,0,0,0),   P1[10],P1[11],P1[12],P1[13], pw3[0]=PKW(P1,8), pw3[1]=PKW(P1,10), pw3); \
    VRD(7); SBAR(); GAPA(C1=__builtin_amdgcn_mfma_f32_32x32x16_bf16(kf[7],qr[3],C1,0,0,0),   P1[14],P1[15],0.f,0.f,       pw3[2]=PKW(P1,12),pw3[3]=PKW(P1,14), pw3); \
    l_reg+=sacc; \
    if(GK){DMA_K((t)+3,sl_cur);} if(GV){DMA_V((t)+1,sl_next);} \
    _Pragma("unroll") for(int r=0;r<16;++r){C0[r]+=nm;C1[r]+=nm;} \
    CMASK(C0,C1,t); \
    { float a=MX3(C0[0],C0[1],C1[0]),b=MX3(C0[2],C0[3],C1[1]); a=MX3(a,C1[2],C1[3]); \
      _Pragma("unroll") for(int r=4;r<16;r+=4){a=MX3(a,C0[r],C0[r+1]);b=MX3(b,C0[r+2],C0[r+3]);a=MX3(a,C1[r],C1[r+1]);b=MX3(b,C1[r+2],C1[r+3]);} \
      float rm=__builtin_fmaxf(a,b); { auto rr=__builtin_amdgcn_permlane32_swap(__float_as_uint(rm),__float_as_uint(rm),false,false); rm=__builtin_fmaxf(__uint_as_float(rr[0]),__uint_as_float(rr[1])); } \
      resc=false; \
      if(__builtin_expect(__any(rm>(float)THRL),0)){ const float dl=__builtin_fmaxf(rm,0.f); mhat+=dl; \
        _Pragma("unroll") for(int r=0;r<16;++r){C0[r]-=dl;C1[r]-=dl;} \
        nm=-mhat; \
        const float f=__builtin_amdgcn_exp2f(-dl); l_reg*=f; if(hi==0)wsf[r32]=f; resc=true; } } \
    SBAR(); \
    GAPB(o[0]=__builtin_amdgcn_mfma_f32_32x32x16_bf16(PAF(0),VFR(0),o[0],0,0,0), C0,0); \
    GAPB(o[1]=__builtin_amdgcn_mfma_f32_32x32x16_bf16(PAF(0),VFR(4),o[1],0,0,0), C0,4); \
    KRD(GL,0); GAPB(o[0]=__builtin_amdgcn_mfma_f32_32x32x16_bf16(PAF(1),VFR(1),o[0],0,0,0), C0,8); \
    KRD(GL,1); GAPB(o[1]=__builtin_amdgcn_mfma_f32_32x32x16_bf16(PAF(1),VFR(5),o[1],0,0,0), C0,12); \
    KRD(GL,2); GAPB(o[0]=__builtin_amdgcn_mfma_f32_32x32x16_bf16(PAF(2),VFR(2),o[0],0,0,0), C1,0); \
    KRD(GL,3); GAPB(o[1]=__builtin_amdgcn_mfma_f32_32x32x16_bf16(PAF(2),VFR(6),o[1],0,0,0), C1,4); \
    GAPB(o[0]=__builtin_amdgcn_mfma_f32_32x32x16_bf16(PAF(3),VFR(3),o[0],0,0,0), C1,8); \
    GAPB(o[1]=__builtin_amdgcn_mfma_f32_32x32x16_bf16(PAF(3),VFR(7),o[1],0,0,0), C1,12); \
    }while(0)
  int t=1;
  #undef CMASK
  #define CMASK(P0,P1,t) do{}while(0)
  for(;t+5<NT;t+=2){
    STEP(pB0,pB1,pA0,pA1,t,true,true,true);     WAIT_BAR(2); RESC(); ROT();
    STEP(pA0,pA1,pB0,pB1,t+1,true,true,true);   WAIT_BAR(2); RESC(); ROT();
  }
  #undef CMASK
  #define CMASK(P0,P1,t) do{int jb_=(t)-(NT-4); if(jb_>=0)cmask(P0,P1,jb_,wid);}while(0)
  #define ENDW(tt) do{ if((tt)+3<NT){WAIT_BAR(2);} else if((tt)+2<NT){WAIT_BAR(1);} else {WAIT_BAR(0);} }while(0)
  for(;t+1<NT;t+=2){
    STEP(pB0,pB1,pA0,pA1,t,(t+3<NT),(t+1<NT),(t+1<NT));       ENDW(t);   RESC(); ROT();
    STEP(pA0,pA1,pB0,pB1,t+1,(t+4<NT),(t+2<NT),(t+2<NT));     ENDW(t+1); RESC(); ROT();
  }
  STEP(pB0,pB1,pA0,pA1,NT-1,false,false,false); RESC();
  { float sacc=pB0[0]+pB0[1]; _Pragma("unroll") for(int r=2;r<16;++r)sacc+=pB0[r]; _Pragma("unroll") for(int r=0;r<16;++r)sacc+=pB1[r]; l_reg+=sacc;
    pw0=(u32x4){PKW(pB0,0),PKW(pB0,2),PKW(pB0,4),PKW(pB0,6)};pw1=(u32x4){PKW(pB0,8),PKW(pB0,10),PKW(pB0,12),PKW(pB0,14)};pw2=(u32x4){PKW(pB1,0),PKW(pB1,2),PKW(pB1,4),PKW(pB1,6)};pw3=(u32x4){PKW(pB1,8),PKW(pB1,10),PKW(pB1,12),PKW(pB1,14)};
    SBAR(); pv(o,vb0+sl_cur,PAF(0),PAF(1),PAF(2),PAF(3)); }
  #undef PKW
  #undef PAF
  #undef VFR
  #undef PIN
  #undef MX3
  #undef GAPA
  #undef GAPB
  #undef EX
  #undef VRD
  #undef KRD
  #undef STEP
  #undef ENDW
  {auto rr=__builtin_amdgcn_permlane32_swap(__float_as_uint(l_reg),__float_as_uint(l_reg),false,false);l_reg=__uint_as_float(rr[0])+__uint_as_float(rr[1]);}
  if(hi==0)wsf[32+r32]=l_reg;asm volatile("s_waitcnt lgkmcnt(0)":::"memory");
  float rli[16];
  #pragma unroll
  for(int r=0;r<16;++r)rli[r]=__builtin_amdgcn_rcpf(wsf[32+crow(r,hi)]);
  bf16*Ow=O+(rowbase+q0+wid*QBLK)*DM+vcol;
  { bf16*stg=(bf16*)(shm+LDS_OST)+wid*2048;
    #pragma unroll
    for(int r=0;r<16;++r){const int orow=crow(r,hi);
      #pragma unroll
      for(int d0=0;d0<2;++d0)stg[orow*64+d0*32+r32]=__float2bfloat16(o[d0][r]*rli[r]);}
    asm volatile("s_waitcnt lgkmcnt(0)":::"memory");
    #pragma unroll
    for(int i=0;i<4;++i){const int row=i*8+(lane>>3),ch=lane&7; const u32x4 v=*(const u32x4*)(stg+row*64+ch*8); ATTN_STORE16(Ow+(long)row*DM+ch*8,v);} }
  asm volatile("s_waitcnt lgkmcnt(0)\n\ts_barrier":::"memory");
  #undef DMA_K
  #undef DMA_V
  #undef CMASK
  #undef START
  #undef RESC
  #undef ROT
}
typedef float f32x4 __attribute__((ext_vector_type(4)));
constexpr int SA_K0=0, SA_K1=8192, SA_V0=16384, SA_V1=24576, SA_WS=32768, SA_BYTES=SA_WS+8*256;
__device__ __forceinline__ unsigned pk2bf(float lo,float hi){return cvtpk_s(lo,hi);}
__device__ __forceinline__ void sample_unit(int l,int b,int h,int s,const float*cache_k,const float*cache_v,const bf16*Q,const bf16*K,const bf16*V,float*SP,char*shm){
  int tid_=threadIdx.x; asm volatile("" : "+v"(tid_)); const int tid=tid_,lane=tid&63,r32=lane&31,hi=lane>>5; const int wid=__builtin_amdgcn_readfirstlane(tid>>6);
  const unsigned lds0=(unsigned)(uintptr_t)shm;
  float*wsf=(float*)(shm+SA_WS)+wid*64;
  const int c=wid>>1,vh=wid&1;
  const int qrow=16384+b*32;
  bf16x8 qr[4];
  if(wid<4){
    #pragma unroll
    for(int d0=0;d0<4;++d0)qr[d0]=*reinterpret_cast<const bf16x8*>(&Q[(long)(qrow+r32)*DM+h*128+c*64+d0*16+hi*8]);
  }
  float m=-1e30f,lsum=0.f; f32x16 o[2]; o[0]=f32x16{}; o[1]=f32x16{};
  const f32x16 zc=f32x16{};
  const int ntile=(s==7)?5:4;
  const float*ckb=cache_k+((long)(l*8+b)*2048)*1024+h*128; const float*cvb=cache_v+((long)(l*8+b)*2048)*1024+h*128;
  for(int ti=0;ti<ntile;++ti){
    const bool fresh=(ti==4);
    #pragma unroll
    for(int pi=0;pi<2;++pi){
      const int pk=wid*2+pi;
      { const int kc=pk>>3,ch=pk&7; u32x4 wv;
        if(!fresh){ const float*src=ckb+(long)((4*s+ti)*64+lane)*1024+kc*64+ch*8; const f32x4 a=*(const f32x4*)src,bq=*(const f32x4*)(src+4);
          wv.x=pk2bf(a.x,a.y);wv.y=pk2bf(a.z,a.w);wv.z=pk2bf(bq.x,bq.y);wv.w=pk2bf(bq.z,bq.w); }
        else if(lane<32){ wv=*(const u32x4*)(K+(long)(qrow+lane)*DM+h*128+kc*64+ch*8); }
        else { wv=(u32x4){0u,0u,0u,0u}; }
        *(u32x4*)(shm+(kc?SA_K1:SA_K0)+ch*1024+lane*16)=wv; }
      { const int vv=pk>>3,p=pk&7; const int row=16*(p&3)+(lane>>2),col=vv*64+32*(p>>2)+8*(lane&3); u32x4 wv;
        if(!fresh){ const float*src=cvb+(long)((4*s+ti)*64+row)*1024+col; const f32x4 a=*(const f32x4*)src,bq=*(const f32x4*)(src+4);
          wv.x=pk2bf(a.x,a.y);wv.y=pk2bf(a.z,a.w);wv.z=pk2bf(bq.x,bq.y);wv.w=pk2bf(bq.z,bq.w); }
        else if(row<32){ wv=*(const u32x4*)(V+(long)(qrow+row)*DM+h*128+col); }
        else { wv=(u32x4){0u,0u,0u,0u}; }
        *(u32x4*)(shm+(vv?SA_V1:SA_V0)+p*1024+lane*16)=wv; }
    }
    __syncthreads();
    if(wid<4){
      f32x16 p0,p1;
      qkt(p0,p1,shm+(c?SA_K1:SA_K0),qr,zc,r32,hi);
      if(fresh){
        #pragma unroll
        for(int r=0;r<16;++r)p1[r]=-INFINITY;
      }
      float rm=p0[0];
      #pragma unroll
      for(int r=1;r<16;++r)rm=__builtin_fmaxf(rm,p0[r]);
      #pragma unroll
      for(int r=0;r<16;++r)rm=__builtin_fmaxf(rm,p1[r]);
      rm=__builtin_fmaxf(rm,__shfl_xor(rm,32));
      const float mn=__builtin_fmaxf(m,rm),alpha=__builtin_amdgcn_exp2f(m-mn);
      float ps=0.f;
      #pragma unroll
      for(int r=0;r<16;++r){p0[r]=__builtin_amdgcn_exp2f(p0[r]-mn);p1[r]=__builtin_amdgcn_exp2f(p1[r]-mn);ps+=p0[r]+p1[r];}
      lsum=lsum*alpha+ps; m=mn;
      if(hi==0)wsf[r32]=alpha;
      asm volatile("s_waitcnt lgkmcnt(0)":::"memory");
      #pragma unroll
      for(int g=0;g<4;++g){ const f32x4 f4=*(const f32x4*)(wsf+8*g+4*hi);
        #pragma unroll
        for(int i=0;i<4;++i){o[0][4*g+i]*=f4[i];o[1][4*g+i]*=f4[i];} }
      u32x4 pw0,pw1,pw2,pw3;
      pw0=(u32x4){pk2bf(p0[0],p0[1]),pk2bf(p0[2],p0[3]),pk2bf(p0[4],p0[5]),pk2bf(p0[6],p0[7])};
      pw1=(u32x4){pk2bf(p0[8],p0[9]),pk2bf(p0[10],p0[11]),pk2bf(p0[12],p0[13]),pk2bf(p0[14],p0[15])};
      pw2=(u32x4){pk2bf(p1[0],p1[1]),pk2bf(p1[2],p1[3]),pk2bf(p1[4],p1[5]),pk2bf(p1[6],p1[7])};
      pw3=(u32x4){pk2bf(p1[8],p1[9]),pk2bf(p1[10],p1[11]),pk2bf(p1[12],p1[13]),pk2bf(p1[14],p1[15])};
      const int vb=(int)(lds0+(vh?SA_V1:SA_V0))+((lane>>4)&1)*32+(lane&3)*8+(4*hi+((lane&15)>>2))*64;
      pv(o,vb,__builtin_bit_cast(bf16x8,pw0),__builtin_bit_cast(bf16x8,pw1),__builtin_bit_cast(bf16x8,pw2),__builtin_bit_cast(bf16x8,pw3));
    }
    __syncthreads();
  }
  if(wid<4){
    lsum+=__shfl_xor(lsum,32);
    float*sp=SP+((long)(((b*8+h)*2+c)*8+s)*32)*132;
    if(vh==0&&hi==0){sp[r32*132]=m;sp[r32*132+1]=lsum;}
    #pragma unroll
    for(int d0=0;d0<2;++d0)
      #pragma unroll
      for(int r=0;r<16;++r)sp[crow(r,hi)*132+4+vh*64+32*d0+r32]=o[d0][r];
  }
}
constexpr int ATTN_LDS_BYTES=LDS_BYTES;
#undef SBAR
#undef WAIT_BAR
}

#define GAS __attribute__((address_space(1)))
#define LAS __attribute__((address_space(3)))
typedef unsigned short bf16;
typedef unsigned v4u __attribute__((ext_vector_type(4)));
typedef float f32x4 __attribute__((ext_vector_type(4)));
typedef short bf16x8 __attribute__((ext_vector_type(8)));
typedef GAS unsigned gu32;
typedef GAS unsigned long long gu64;
#define RLX_AGENT __ATOMIC_RELAXED, __HIP_MEMORY_SCOPE_AGENT
#define LDS_WAIT() asm volatile("s_waitcnt lgkmcnt(0)" ::: "memory")
#define VM_WAIT() asm volatile("s_waitcnt vmcnt(0)" ::: "memory")
__device__ __forceinline__ unsigned long long rt() { return __builtin_amdgcn_s_memrealtime(); }
__device__ __forceinline__ unsigned f2bf(float f) { unsigned u = __builtin_bit_cast(unsigned, f); return (u + 0x7fffu + ((u >> 16) & 1u)) >> 16; }
__device__ __forceinline__ unsigned pk2(float lo, float hi) { return f2bf(lo) | (f2bf(hi) << 16); }

#define XB_TMO      128
#define XB_XCNT(j)  (256  + 64 * (j))
#define XB_XSUB(j)  (1280 + 64 * (j))
#define XB_XGEN(j)  (2304 + 64 * (j))
#define XB_TOP      3328
#define XB_TOPGEN   3392
#define XCD_BAR_WORDS 3456
#define XB_SPIN_CAP (1u << 22)

__device__ __forceinline__ unsigned xb_ld(unsigned* p)              { return __hip_atomic_load(p, __ATOMIC_RELAXED, __HIP_MEMORY_SCOPE_AGENT); }
__device__ __forceinline__ unsigned xb_add(unsigned* p, unsigned v) { return __hip_atomic_fetch_add(p, v, __ATOMIC_RELAXED, __HIP_MEMORY_SCOPE_AGENT); }
__device__ __forceinline__ unsigned xb_xcc_id() { return (unsigned)__builtin_amdgcn_s_getreg((3 << 11) | 20) & 0xFu; }
#define XB_SPIN(cond, bar) do { unsigned _sp = 0; while (cond) { __builtin_amdgcn_s_sleep(1); \
    if ((++_sp & 255u) == 0u) { if (xb_ld(&(bar)[XB_TMO])) break; if (_sp > XB_SPIN_CAP) { atomicAdd(&(bar)[XB_TMO], 1u); break; } } } } while (0)

struct XcdBarrier {
    unsigned* bar; unsigned x;
    volatile LAS unsigned* st;
};

__device__ __forceinline__ XcdBarrier xcd_barrier_post(unsigned* bar, volatile LAS unsigned* st) {
    XcdBarrier b; b.bar = bar; b.x = xb_xcc_id(); b.st = st;
    if (threadIdx.x == 0) (void)xb_add(&bar[XB_XCNT(b.x)], 1u);
    return b;
}
__device__ __forceinline__ void xcd_barrier_complete(unsigned* bar, unsigned x, unsigned& nloc, unsigned& nx) {
    const unsigned G = gridDim.x * gridDim.y * gridDim.z;
    unsigned sum, cnt, mine, sp = 0u;
    for (;;) {
        sum = 0u; cnt = 0u; mine = 0u;
#pragma unroll
        for (unsigned j = 0; j < 16; ++j) { const unsigned c = xb_ld(&bar[XB_XCNT(j)]); sum += c; cnt += (c > 0u) ? 1u : 0u; mine = (j == x) ? c : mine; }
        if (sum == G) break;
        __builtin_amdgcn_s_sleep(1);
        if ((++sp & 255u) == 0u) { if (xb_ld(&bar[XB_TMO])) break; if (sp > XB_SPIN_CAP) { atomicAdd(&bar[XB_TMO], 1u); break; } }
    }
    nloc = mine > 0u ? mine : 1u; nx = cnt > 0u ? cnt : 1u;
}

__device__ __forceinline__ void xcd_barrier(const XcdBarrier& b) {
    asm volatile("s_waitcnt vmcnt(0)" ::: "memory");
    __syncthreads();
    if (threadIdx.x == 0) {
        unsigned* bar = b.bar;
        __builtin_amdgcn_s_waitcnt(0);
        unsigned nloc = b.st[0], nx = b.st[1];
        if (nloc == 0u) { xcd_barrier_complete(bar, b.x, nloc, nx); b.st[0] = nloc; b.st[1] = nx; }
        const unsigned old = xb_add(&bar[XB_XSUB(b.x)], 1u);
        const unsigned gen = old / nloc;
        if (old + 1u == (gen + 1u) * nloc) {
            __builtin_amdgcn_fence(__ATOMIC_RELEASE, "agent");
            asm volatile("s_waitcnt vmcnt(0)" ::: "memory");
            const unsigned og = xb_add(&bar[XB_TOP], 1u);
            const unsigned tg = og / nx;
            if (og + 1u == (tg + 1u) * nx) xb_add(&bar[XB_TOPGEN], 1u);
            else XB_SPIN(xb_ld(&bar[XB_TOPGEN]) == tg, bar);
            __builtin_amdgcn_fence(__ATOMIC_ACQUIRE, "agent");
            xb_add(&bar[XB_XGEN(b.x)], 1u);
            asm volatile("s_waitcnt vmcnt(0)" ::: "memory");
        } else {
            XB_SPIN(xb_ld(&bar[XB_XGEN(b.x)]) == gen, bar);
            __builtin_amdgcn_fence(__ATOMIC_ACQUIRE, "agent");
            asm volatile("s_waitcnt vmcnt(0)" ::: "memory");
        }
    }
    __syncthreads();
}

struct Args { const GAS float* in[31]; GAS float* out; GAS unsigned char* ws; float rinv[8]; int ph_lo, ph_hi; };
#define GIN(A, i) ((const float*)((A)->in[i]))
typedef const Args __attribute__((address_space(4)))* CArgsP;
struct Frame {
    LAS unsigned char* lds;
    volatile LAS unsigned* MISC;
    gu32* ctl;
    int tid, lane, wave, vcu, G;
    float* out; unsigned char* ws;
};
__device__ __forceinline__ float wave_sum(float v) {
#pragma unroll
    for (int o = 1; o < 64; o <<= 1) v += __shfl_xor(v, o);
    return v;
}
template <int CTRL> __device__ __forceinline__ float dppf(float x) { return __builtin_bit_cast(float, __builtin_amdgcn_update_dpp(0, __builtin_bit_cast(int, x), CTRL, 0xF, 0xF, false)); }
__device__ __forceinline__ float reduce8(float x) { x += dppf<0xB1>(x); x += dppf<0x4E>(x); x += dppf<0x141>(x); return x; }
__device__ __forceinline__ float reduce16(float x) { x = reduce8(x); x += dppf<0x140>(x); return x; }
__device__ __forceinline__ float bf2f(bf16 h) { return __uint_as_float((unsigned)h << 16); }
__device__ __forceinline__ float bflo(unsigned w) { return __uint_as_float(w << 16); }
__device__ __forceinline__ float bfhi(unsigned w) { return __uint_as_float(w & 0xffff0000u); }

__device__ __forceinline__ void p0_transpose_item(const float* W, int N, bf16* WT, int ldk, int koff, int row_off, const float* kscale, LAS float* scr, int item, int lane) {
    const int nblk = N / 32, kb = item / nblk, nb = item % nblk, k0 = 64 * kb, n0 = 32 * nb;
    float wv[32];
#pragma unroll
    for (int i = 0; i < 32; ++i) wv[i] = W[(size_t)(k0 + 2 * i + (lane >> 5)) * N + n0 + (lane & 31)];
#pragma unroll
    for (int i = 0; i < 32; ++i) { const int kk = 2 * i + (lane >> 5); float w = wv[i]; if (kscale) w *= kscale[k0 + kk]; scr[kk * 33 + (lane & 31)] = w; }
    LDS_WAIT(); asm volatile("" ::: "memory");
    const int c = lane & 7;
#pragma unroll
    for (int j = 0; j < 4; ++j) { const int n = (lane >> 3) + 8 * j; const LAS float* s = scr + (8 * c) * 33 + n;
        v4u o; o.x = pk2(s[0 * 33], s[1 * 33]); o.y = pk2(s[2 * 33], s[3 * 33]); o.z = pk2(s[4 * 33], s[5 * 33]); o.w = pk2(s[6 * 33], s[7 * 33]);
        *(GAS v4u*)(WT + (size_t)(row_off + n0 + n) * ldk + koff + k0 + 8 * c) = o; }
    LDS_WAIT(); asm volatile("" ::: "memory");
}
__device__ __forceinline__ int up_row_off(int item) { const int n0 = 32 * (item % (UPW / 32)), hf = n0 >= D_FF ? 1 : 0, j = n0 - hf * D_FF; return (j >> 7) * 256 + hf * 128 + (j & 127) - n0; }
constexpr int WP_IN = 1, WP_SQ = 2, WP_UP = 4, WP_DN = 8, WP_LORA = 16, WP_ALL = 31;
__device__ __forceinline__ void p0_weights(Frame& F, CArgsP A, int l, int gw, int NGW, const int part) {
    LAS float* scr = (LAS float*)(F.lds + RING_OFF + F.wave * 16384);
    constexpr int I_IN = (1024 / 64) * (P_TOTAL / 32), I_SQ = (1024 / 64) * (1024 / 32), I_UP = (1024 / 64) * (UPW / 32), I_DN = (D_FF / 64) * (1024 / 32),
                  I_W2 = 1 * (1024 / 32), I_G2 = 2 * (1024 / 32);
    unsigned char* wl = F.ws + WS_W;
    int base = 0;
#define WITEMS(NI, CALL) do { int it = (gw - base) % NGW; if (it < 0) it += NGW; for (; it < (NI); it += NGW) { const int r = it; CALL; } base += (NI); } while (0)
    if (part & WP_IN) WITEMS(I_IN, p0_transpose_item(GIN(A, 8) + (size_t)l * 1024 * P_TOTAL, P_TOTAL, (bf16*)(wl + W_IN), 1024, 0, 0, GIN(A, 7) + l * 1024, scr, r, F.lane));
    if (part & WP_SQ) {
        WITEMS(I_SQ, p0_transpose_item(GIN(A, 11) + (size_t)l * 1024 * 1024, 1024, (bf16*)(wl + W_ODA), 1024, 0, 0, nullptr, scr, r, F.lane));
        WITEMS(I_SQ, p0_transpose_item(GIN(A, 23) + (size_t)l * 1024 * 1024, 1024, (bf16*)(wl + W_ORW), 1024, 0, 0, nullptr, scr, r, F.lane));
        WITEMS(I_SQ, p0_transpose_item(GIN(A, 24) + (size_t)l * 1024 * 1024, 1024, (bf16*)(wl + W_OUT), 1024, 0, 0, nullptr, scr, r, F.lane));
    }
    if (part & WP_UP) WITEMS(I_UP, p0_transpose_item(GIN(A, 26) + (size_t)l * 1024 * UPW, UPW, (bf16*)(wl + (l ? W_UP1 : W_UP)), 1024, 0, up_row_off(r), GIN(A, 25) + l * 1024, scr, r, F.lane));
    if (part & WP_DN) WITEMS(I_DN, p0_transpose_item(GIN(A, 29) + (size_t)l * D_FF * 1024, 1024, (bf16*)(l ? F.ws + WS_DN1 : wl + W_DN), D_FF, 0, 0, nullptr, scr, r, F.lane));
    if (part & WP_LORA) {
        WITEMS(I_W2, p0_transpose_item(GIN(A, 14) + (size_t)l * 64 * 1024, 1024, (bf16*)(wl + W_LORA), 256, 0, 0, nullptr, scr, r, F.lane));
        WITEMS(I_W2, p0_transpose_item(GIN(A, 16) + (size_t)l * 64 * 1024, 1024, (bf16*)(wl + W_LORA), 256, 64, 1024, nullptr, scr, r, F.lane));
        WITEMS(I_G2, p0_transpose_item(GIN(A, 17) + (size_t)l * 128 * 1024, 1024, (bf16*)(wl + W_LORA), 256, 128, 2048, nullptr, scr, r, F.lane));
        for (int i = gw * 64 + F.lane; i < 3072 * 32; i += NGW * 64) {
            const int n = i >> 5, kc = i & 31, blk = n >> 10;
            const bool nz = (blk == 0) ? (kc < 8) : (blk == 1) ? (kc >= 8 && kc < 16) : (kc >= 16);
            if (!nz) *(GAS v4u*)(wl + W_LORA + ((size_t)n * 256 + kc * 8) * 2) = (v4u){0u, 0u, 0u, 0u};
        }
    }
#undef WITEMS
}
__device__ __forceinline__ void p0_prologue(Frame& F, CArgsP A) {
    const int gw = F.vcu * NWAVES + F.wave, NGW = F.G * NWAVES;
    p0_weights(F, A, 0, gw, NGW, WP_ALL);
    {
        const int gt = gw * 64 + F.lane, NGT = NGW * 64;
        float* rope = (float*)(F.ws + WS_ROPE);
        for (int i = gt; i < NKEYS_S * 8; i += NGT) {
            const int pos = i >> 3, k = i & 7;
            const float ang = (float)pos * A->rinv[k];
            const float kq = rintf(ang * 0.15915494309189535f);
            float r = fmaf(-kq, 6.2831854820251465f, ang); r = fmaf(-kq, -1.7484555314695172e-7f, r);
            const float rev = r * 0.15915494309189535f;
            rope[pos * 16 + k] = __builtin_amdgcn_cosf(rev); rope[pos * 16 + 8 + k] = __builtin_amdgcn_sinf(rev);
        }
    }
    {
        float* X = F.out + O_YP; bf16* XB = (bf16*)(F.ws + WS_XB); float* SS = (float*)(F.ctl + CW_SS);
        for (int m = gw; m < MT; m += NGW) {
            const float* src = (m < MP) ? GIN(A, 0) + (size_t)m * 1024 : GIN(A, 1) + (size_t)(m - MP) * 1024;
            const GAS f32x4* xr = (const GAS f32x4*)src + F.lane;
            GAS f32x4* xo = (GAS f32x4*)(X + (size_t)m * 1024) + F.lane;
            GAS unsigned long long* o8 = (GAS unsigned long long*)(XB + (size_t)m * 1024) + F.lane;
            float s = 0.f;
#pragma unroll
            for (int j = 0; j < 4; ++j) { const f32x4 v = xr[64 * j]; s += (v.x * v.x + v.y * v.y) + (v.z * v.z + v.w * v.w);
                o8[64 * j] = (unsigned long long)pk2(v.x, v.y) | ((unsigned long long)pk2(v.z, v.w) << 32); }
            s = wave_sum(s);
            if (F.lane == 0) SS[m] = s;
        }
    }
    if (gw < DEPTH) {
        const int l = gw; const float* lp = GIN(A, 9) + (size_t)l * 256;
        const float s1 = wave_sum(lp[F.lane] * lp[64 + F.lane]), s2 = wave_sum(lp[128 + F.lane] * lp[192 + F.lane]);
        if (F.lane == 0) ((float*)(F.ctl + CW_LAM))[l] = expf(s1) - expf(s2) + (0.8f - 0.6f * expf(-0.3f * (float)l));
    }
}

constexpr int AQ_PROMPT = 256 * 8, AQ_TOTAL = AQ_PROMPT + 512;
__device__ __forceinline__ void ph_attn(Frame& F, CArgsP A, int l) {
    const attn_body::bf16* Q = (const attn_body::bf16*)(F.ws + B_Q); const attn_body::bf16* K = (const attn_body::bf16*)(F.ws + B_K); const attn_body::bf16* V = (const attn_body::bf16*)(F.ws + B_V);
    gu32* ctr = F.ctl + CW_AQ + 64 * l;
    for (;;) {
        __syncthreads();
        if (F.tid == 0) F.MISC[12] = __hip_atomic_fetch_add(ctr, 1u, RLX_AGENT);
        __syncthreads();
        const int idx = __builtin_amdgcn_readfirstlane((int)F.MISC[12]);
        if (idx >= AQ_TOTAL) break;
        if (idx < AQ_PROMPT) {
            const int qb = 7 - (idx >> 8), u = idx & 255, b = u >> 5, hv = u & 31, h = hv >> 2, c = (hv >> 1) & 1, vh = hv & 1;
            attn_body::bf16* O = (attn_body::bf16*)(F.ws + B_OC) + (size_t)c * MT * 1024;
            attn_body::attn_unit<8>(b, h * 128 + c * 64, h * 128 + vh * 64, qb, Q, K, V, O, (char*)F.lds + RING_OFF);
        } else {
            const int u = idx - AQ_PROMPT;
            attn_body::sample_unit(l, u >> 6, (u >> 3) & 7, u & 7, GIN(A, 2), GIN(A, 3), Q, K, V, (float*)(F.ws + WS_SP), (char*)F.lds + RING_OFF);
        }
        { int tv = threadIdx.x; asm volatile("" : "+v"(tv)); F.tid = tv; F.lane = tv & 63; F.wave = __builtin_amdgcn_readfirstlane(tv >> 6); }
    }
}

__device__ __forceinline__ void ph_linprep(Frame& F, CArgsP A, int l) {
    const int gw = F.vcu * NWAVES + F.wave, NGW = F.G * NWAVES;
    const bf16* URW = (const bf16*)(F.ws + B_URW); bf16* LIN = (bf16*)(F.ws + B_LIN);
    const float* mu = GIN(A, 12) + (size_t)l * P_RW + 3072 + 4 * F.lane;
    const float mu0 = mu[0], mu1 = mu[1], mu2 = mu[2], mu3 = mu[3];
    for (int row0 = gw; row0 < MT; row0 += 4 * NGW) {
        unsigned long long cw[4], pw[4];
#pragma unroll
        for (int q = 0; q < 4; ++q) { const int row = row0 + q * NGW; const bool ok = row < MT; const int rr = ok ? row : 0;
            const bool smp = rr >= MP; const int t = smp ? ((rr - MP) & 31) : (rr & 2047);
            cw[q] = *(const unsigned long long*)(URW + (size_t)rr * P_RW + 3072 + 4 * F.lane);
            pw[q] = *(const unsigned long long*)(URW + (size_t)(t > 0 ? rr - 1 : rr) * P_RW + 3072 + 4 * F.lane); }
#pragma unroll
        for (int q = 0; q < 4; ++q) { const int row = row0 + q * NGW;
            if (row < MT) {
                const bool smp = row >= MP; const int t = smp ? ((row - MP) & 31) : (row & 2047);
                float u[4] = {bflo((unsigned)cw[q]), bfhi((unsigned)cw[q]), bflo((unsigned)(cw[q] >> 32)), bfhi((unsigned)(cw[q] >> 32))};
                float p[4] = {bflo((unsigned)pw[q]), bfhi((unsigned)pw[q]), bflo((unsigned)(pw[q] >> 32)), bfhi((unsigned)(pw[q] >> 32))};
                if (t == 0) {
                    if (smp) { const float* s0 = GIN(A, 5) + ((size_t)(l * DEC_BATCH) + ((row - MP) >> 5)) * P_RW + 3072 + 4 * F.lane; p[0] = s0[0]; p[1] = s0[1]; p[2] = s0[2]; p[3] = s0[3]; }
                    else { p[0] = p[1] = p[2] = p[3] = 0.f; } }
                u[0] += (p[0] - u[0]) * mu0; u[1] += (p[1] - u[1]) * mu1; u[2] += (p[2] - u[2]) * mu2; u[3] += (p[3] - u[3]) * mu3;
                if (F.lane < 16) {
#pragma unroll
                    for (int j = 0; j < 4; ++j) u[j] = 1.f - 2.f * __builtin_amdgcn_rcpf(1.f + __builtin_amdgcn_exp2f(2.8853900817779268f * u[j])); }
                else if (F.lane >= 32) {
#pragma unroll
                    for (int j = 0; j < 4; ++j) u[j] = pg8::fast_sigmoid(u[j]); }
                *(unsigned long long*)(LIN + (size_t)row * 256 + 4 * F.lane) = (unsigned long long)pg8::cvt_pk_bf16(u[0], u[1]) | ((unsigned long long)pg8::cvt_pk_bf16(u[2], u[3]) << 32);
            }
        }
    }
}

__device__ __forceinline__ void ph_combine(Frame& F, CArgsP A, int l) {
    const int gw = F.vcu * NWAVES + F.wave, NGW = F.G * NWAVES;
    const float lam = ((const float*)(F.ctl + CW_LAM))[l], lam_init = 0.8f - 0.6f * expf(-0.3f * (float)l);
    const bf16* OC0 = (const bf16*)(F.ws + B_OC); const bf16* OC1 = OC0 + (size_t)MT * 1024;
    bf16* OA = (bf16*)(F.ws + B_OA);
    const float* subln = GIN(A, 10) + l * 128;
    const float g0 = subln[2 * F.lane], g1 = subln[2 * F.lane + 1];
    {
        const int gt = gw * 64 + F.lane, NGT = NGW * 64;
        const float sc = 1.f - lam_init;
        for (int i = gt; i < MP * 128; i += NGT) {
            const size_t off = (size_t)(i >> 4) * 128 + (i & 15) * 8;
            const v4u w0 = *(const v4u*)(OC0 + off), w1 = *(const v4u*)(OC1 + off);
            float a[8];
            a[0] = bflo(w0.x) - lam * bflo(w1.x); a[1] = bfhi(w0.x) - lam * bfhi(w1.x); a[2] = bflo(w0.y) - lam * bflo(w1.y); a[3] = bfhi(w0.y) - lam * bfhi(w1.y);
            a[4] = bflo(w0.z) - lam * bflo(w1.z); a[5] = bfhi(w0.z) - lam * bfhi(w1.z); a[6] = bflo(w0.w) - lam * bflo(w1.w); a[7] = bfhi(w0.w) - lam * bfhi(w1.w);
            float ss = (a[0] * a[0] + a[1] * a[1]) + (a[2] * a[2] + a[3] * a[3]) + (a[4] * a[4] + a[5] * a[5]) + (a[6] * a[6] + a[7] * a[7]);
            ss = reduce16(ss);
            const float r = (1.0f / sqrtf(ss * (1.0f / 128.f) + EPS)) * sc;
            const f32x4 s0 = *(const f32x4*)(subln + (i & 15) * 8), s1 = *(const f32x4*)(subln + (i & 15) * 8 + 4);
            v4u o; o.x = pk2(a[0] * r * s0.x, a[1] * r * s0.y); o.y = pk2(a[2] * r * s0.z, a[3] * r * s0.w); o.z = pk2(a[4] * r * s1.x, a[5] * r * s1.y); o.w = pk2(a[6] * r * s1.z, a[7] * r * s1.w);
            *(v4u*)(OA + off) = o;
        }
    }
    for (int it = MP * 8 + gw; it < MT * 8; it += NGW) {
        const int row = it >> 3, h = it & 7;
        float a0, a1;
        {
            const int b = (row - MP) >> 5, qi = (row - MP) & 31;
            float oc[2][2];
#pragma unroll
            for (int c = 0; c < 2; ++c) {
                const float* sp = (const float*)(F.ws + WS_SP) + ((size_t)(((b * 8 + h) * 2 + c) * 8) * 32 + qi) * 132;
                float mx = -1e30f;
#pragma unroll
                for (int s = 0; s < 8; ++s) mx = fmaxf(mx, sp[(size_t)s * 32 * 132]);
                float L = 0.f, x0 = 0.f, x1 = 0.f;
#pragma unroll
                for (int s = 0; s < 8; ++s) { const float* p = sp + (size_t)s * 32 * 132; const float w = exp2f(p[0] - mx); L += w * p[1]; x0 += w * p[4 + 2 * F.lane]; x1 += w * p[4 + 2 * F.lane + 1]; }
                oc[c][0] = x0 / L; oc[c][1] = x1 / L;
            }
            a0 = oc[0][0] - lam * oc[1][0]; a1 = oc[0][1] - lam * oc[1][1];
        }
        const float ss = wave_sum(a0 * a0 + a1 * a1);
        const float r = (1.0f / sqrtf(ss * (1.0f / 128.f) + EPS)) * (1.f - lam_init);
        *(unsigned*)(OA + (size_t)row * 1024 + h * 128 + 2 * F.lane) = pk2(a0 * r * g0, a1 * r * g1);
    }
}

constexpr int CK_L = 32;
constexpr int CK_LDF = 0;
constexpr int CK_AT = CK_LDF + 2048, CK_RT = CK_AT + 32 * 144, CK_BT = CK_RT + 32 * 144, CK_KT = CK_BT + 32 * 144;
constexpr int CK_TR = CK_KT + 32 * 144, CK_TR_SZ = 3 * 64 * 80;
constexpr int CK_BTT = 0, CK_KTT = 64 * 80, CK_VT = 2 * 64 * 80;
constexpr int CK_MM = CK_TR + 2 * CK_TR_SZ, CK_MM_SZ = 32 * 144 + 3 * 32 * 80;
constexpr int CK_MBA = 0, CK_MKA = 32 * 144, CK_MBR = CK_MKA + 32 * 80, CK_MKR = CK_MBR + 32 * 80;
constexpr int CK_RHS = CK_MM + 2 * CK_MM_SZ;
constexpr int CK_U = CK_RHS + 8192;
constexpr int CK_SB = CK_U + 64 * 80;
constexpr int CK_YB = CK_SB + 64 * 144;
constexpr int CK_EXPL = CK_YB + 8192;
constexpr int CK_SH = CK_EXPL + 512;
constexpr int CK_LOR = CK_SH + 768;
static_assert(CK_LOR + 3 * 4096 <= RING_BYTES, "scan LDS");
typedef float f32x16s __attribute__((ext_vector_type(16)));
typedef float f32x2 __attribute__((ext_vector_type(2)));

__device__ __forceinline__ void unpack4(unsigned long long w, float (&o)[4]) { o[0] = bflo((unsigned)w); o[1] = bfhi((unsigned)w); o[2] = bflo((unsigned)(w >> 32)); o[3] = bfhi((unsigned)(w >> 32)); }
__device__ __forceinline__ unsigned long long pack4bf(float a, float b, float c, float d) { return (unsigned long long)pg8::cvt_pk_bf16(a, b) | ((unsigned long long)pg8::cvt_pk_bf16(c, d) << 32); }
#define CK_FRAG(base, stride, R0, ks) (*(const LAS bf16x8*)(L + (base) + ((R0) + r32) * (stride) + (16 * (ks) + 8 * hh) * 2))
#define CK_FRAGT(base, R0, ks) (*(const LAS bf16x8*)(L + (base) + ((R0) + r32) * 80 + (((2 * (ks) + hh) ^ ((((R0) + r32) >> 3) & 3)) * 16)))
#define CK_MFMA(acc, a, b) acc = __builtin_amdgcn_mfma_f32_32x32x16_bf16(a, b, acc, 0, 0, 0)
#define CK_BAR() do { asm volatile("s_waitcnt lgkmcnt(0)" ::: "memory"); __builtin_amdgcn_s_barrier(); asm volatile("" ::: "memory"); } while (0)

__device__ __forceinline__ void scan_chunked(Frame& F, CArgsP A, int l, int item, const bf16* WLORA, const bf16* LINP) {
    const bool smp = item >= 128; const int bh = item & 127, b = bh >> 4, h = bh & 15;
    const int T = smp ? DEC_SEQ : SEQ, row0 = smp ? MP + b * DEC_SEQ : b * SEQ, nch = T / CK_L;
    const int w = F.wave;
    LAS unsigned char* L = F.lds + RING_OFF;
    { int tid = threadIdx.x; asm volatile("" : "+v"(tid)); if (tid < 192) { const int part = tid >> 6, ch_ = tid & 63; *(LAS float*)(L + CK_SH + tid * 4) = smp ? GIN(A, 5)[(size_t)(l * 8 + b) * P_RW + part * 1024 + h * 64 + ch_] : 0.f; } }
    __builtin_amdgcn_sched_barrier(0);
    if (w < 4) {
        const int kh = (w >> 1) & 1, ih = w & 1;
        f32x16s Sacc;
#pragma unroll
        for (int r = 0; r < 16; ++r) Sacc[r] = 0.f;
        {
            const int lane = F.lane, r32 = lane & 31, hh = lane >> 5;
            if (smp) {
                const float* s0 = GIN(A, 4) + (((size_t)(l * 8 + b) * 16 + h) * 64 + 32 * ih + r32) * 64 + 32 * kh + 4 * hh;
#pragma unroll
                for (int g = 0; g < 4; ++g) { const f32x4 v = *(const f32x4*)(s0 + 8 * g); Sacc[4 * g] = v.x; Sacc[4 * g + 1] = v.y; Sacc[4 * g + 2] = v.z; Sacc[4 * g + 3] = v.w; }
            }
#pragma unroll
            for (int g = 0; g < 4; ++g) *(LAS unsigned long long*)(L + CK_SB + (32 * ih + r32) * 144 + (32 * kh + 8 * g + 4 * hh) * 2) = pack4bf(Sacc[4 * g], Sacc[4 * g + 1], Sacc[4 * g + 2], Sacc[4 * g + 3]);
        }
        const int lor = w - 1, lkb = (lor == 2) ? 128 : 64 * lor;
        bf16x8 wfr[16], afr[8];
        auto lora_loadw = [&](const int lane) __attribute__((always_inline)) {
            if (w >= 1) { const int r32 = lane & 31, hh = lane >> 5;
                const bf16* wr_ = WLORA + (size_t)(lor * 1024 + h * 64 + r32) * 256 + lkb + 8 * hh;
#pragma unroll
                for (int ks = 0; ks < 4; ++ks) { wfr[ks] = *(const bf16x8*)(wr_ + 16 * ks); wfr[8 + ks] = *(const bf16x8*)(wr_ + 32 * 256 + 16 * ks); }
                if (lor == 2) {
#pragma unroll
                    for (int ks = 4; ks < 8; ++ks) { wfr[ks] = *(const bf16x8*)(wr_ + 16 * ks); wfr[8 + ks] = *(const bf16x8*)(wr_ + 32 * 256 + 16 * ks); } }
            }
        };
        auto lora_load = [&](const int chx, const int lane) __attribute__((always_inline)) {
            if (w >= 1 && chx < nch) { const int r32 = lane & 31, hh = lane >> 5;
                const bf16* ar_ = LINP + (size_t)(row0 + chx * CK_L + r32) * 256 + lkb + 8 * hh;
#pragma unroll
                for (int ks = 0; ks < 4; ++ks) afr[ks] = *(const bf16x8*)(ar_ + 16 * ks);
                if (lor == 2) {
#pragma unroll
                    for (int ks = 4; ks < 8; ++ks) afr[ks] = *(const bf16x8*)(ar_ + 16 * ks); }
            }
        };
        auto lora_compute = [&](const int chx, const int lane) __attribute__((always_inline)) {
            if (w >= 1 && chx < nch) { const int r32 = lane & 31, hh = lane >> 5;
#pragma unroll
                for (int cbk = 0; cbk < 2; ++cbk) {
                    f32x16s a_;
#pragma unroll
                    for (int q = 0; q < 16; ++q) a_[q] = 0.f;
#pragma unroll
                    for (int ks = 0; ks < 4; ++ks) CK_MFMA(a_, afr[ks], wfr[cbk * 8 + ks]);
                    if (lor == 2) {
#pragma unroll
                        for (int ks = 4; ks < 8; ++ks) CK_MFMA(a_, afr[ks], wfr[cbk * 8 + ks]); }
                    const int chn_ = l * 1024 + h * 64 + 32 * cbk + r32;
                    LAS unsigned short* op_ = (LAS unsigned short*)(L + CK_LOR + lor * 4096 + (4 * hh * 64 + 32 * cbk + r32) * 2);
                    if (lor == 0) { const float lb_ = GIN(A, 13)[chn_];
#pragma unroll
                        for (int q = 0; q < 16; ++q) op_[((q & 3) + 8 * (q >> 2)) * 64] = (unsigned short)f2bf(pg8::neg_decay_log(a_[q] + lb_)); }
                    else if (lor == 1) { const float lb_ = GIN(A, 15)[chn_];
#pragma unroll
                        for (int q = 0; q < 16; ++q) op_[((q & 3) + 8 * (q >> 2)) * 64] = (unsigned short)f2bf(pg8::fast_sigmoid(a_[q] + lb_)); }
                    else {
#pragma unroll
                        for (int q = 0; q < 16; ++q) op_[((q & 3) + 8 * (q >> 2)) * 64] = (unsigned short)f2bf(a_[q]); }
                }
            }
        };
        { int tl_ = threadIdx.x; asm volatile("" : "+v"(tl_)); tl_ &= 63; lora_load(0, tl_); lora_loadw(tl_); lora_compute(0, tl_); lora_load(1, tl_); }
        __syncthreads();
        CK_BAR();
        { int tl_ = threadIdx.x; asm volatile("" : "+v"(tl_)); tl_ &= 63; lora_loadw(tl_); lora_compute(1, tl_); }
        CK_BAR(); CK_BAR();
        for (int ch = 0; ch < nch; ++ch) {
            int tid_ = threadIdx.x; asm volatile("" : "+v"(tid_));
            const int lane = tid_ & 63, r32 = lane & 31, hh = lane >> 5;
            const int TR = CK_TR + (ch & 1) * CK_TR_SZ, MM = CK_MM + (ch & 1) * CK_MM_SZ;
            lora_load(ch + 2, lane);
            f32x16s acc;
#pragma unroll
            for (int q = 0; q < 16; ++q) acc[q] = 0.f;
            {
                const int abase = (w & 2) ? CK_RT : CK_AT;
#pragma unroll
                for (int ks = 0; ks < 4; ++ks) CK_MFMA(acc, CK_FRAG(abase, 144, 0, ks), CK_FRAG(CK_SB, 144, 32 * ih, ks));
            }
            CK_BAR();
            if (ch + 2 < nch) lora_loadw(lane);
            if (w < 2) {
#pragma unroll
                for (int ks = 0; ks < 2; ++ks) CK_MFMA(acc, CK_FRAG(MM + CK_MKA, 80, 0, ks), CK_FRAGT(TR + CK_VT, 32 * ih, ks));
#pragma unroll
                for (int q = 0; q < 16; ++q) *(LAS float*)(L + CK_RHS + (((q & 3) + 8 * (q >> 2) + 4 * hh) * 64 + 32 * ih + r32) * 4) = acc[q];
            }
            CK_BAR();
            lora_compute(ch + 2, lane);
            if (w == 0) {
                f32x2 xx[CK_L / 2];
#pragma unroll
                for (int j = 0; j < CK_L / 2; ++j) xx[j] = (f32x2){*(const LAS float*)(L + CK_RHS + ((2 * j) * 64 + lane) * 4), *(const LAS float*)(L + CK_RHS + ((2 * j + 1) * 64 + lane) * 4)};
                const LAS unsigned char* mb = L + MM + CK_MBA;
                f32x4 ring[15]; f32x2 x2;
                ring[0] = *(const LAS f32x4*)(mb + 0); ring[1] = *(const LAS f32x4*)(mb + 16); ring[2] = *(const LAS f32x4*)(mb + 32); ring[3] = *(const LAS f32x4*)(mb + 48); ring[4] = *(const LAS f32x4*)(mb + 64); ring[5] = *(const LAS f32x4*)(mb + 80); ring[6] = *(const LAS f32x4*)(mb + 96); ring[7] = *(const LAS f32x4*)(mb + 112); ring[8] = *(const LAS f32x4*)(mb + 144); ring[9] = *(const LAS f32x4*)(mb + 160); ring[10] = *(const LAS f32x4*)(mb + 176); ring[11] = *(const LAS f32x4*)(mb + 192); ring[12] = *(const LAS f32x4*)(mb + 208); ring[13] = *(const LAS f32x4*)(mb + 224); ring[14] = *(const LAS f32x4*)(mb + 240);
                __builtin_amdgcn_sched_barrier(0);
                x2 = (f32x2){xx[0][0], xx[0][0]}; xx[0] = __builtin_elementwise_fma(x2, (f32x2){ring[0].x, ring[0].y}, xx[0]); xx[1] = __builtin_elementwise_fma(x2, (f32x2){ring[0].z, ring[0].w}, xx[1]); ring[0] = *(const LAS f32x4*)(mb + 256); __builtin_amdgcn_sched_barrier(0);
                xx[2] = __builtin_elementwise_fma(x2, (f32x2){ring[1].x, ring[1].y}, xx[2]); xx[3] = __builtin_elementwise_fma(x2, (f32x2){ring[1].z, ring[1].w}, xx[3]); ring[1] = *(const LAS f32x4*)(mb + 288); __builtin_amdgcn_sched_barrier(0);
                xx[4] = __builtin_elementwise_fma(x2, (f32x2){ring[2].x, ring[2].y}, xx[4]); xx[5] = __builtin_elementwise_fma(x2, (f32x2){ring[2].z, ring[2].w}, xx[5]); ring[2] = *(const LAS f32x4*)(mb + 304); __builtin_amdgcn_sched_barrier(0);
                xx[6] = __builtin_elementwise_fma(x2, (f32x2){ring[3].x, ring[3].y}, xx[6]); xx[7] = __builtin_elementwise_fma(x2, (f32x2){ring[3].z, ring[3].w}, xx[7]); ring[3] = *(const LAS f32x4*)(mb + 320); __builtin_amdgcn_sched_barrier(0);
                xx[8] = __builtin_elementwise_fma(x2, (f32x2){ring[4].x, ring[4].y}, xx[8]); xx[9] = __builtin_elementwise_fma(x2, (f32x2){ring[4].z, ring[4].w}, xx[9]); ring[4] = *(const LAS f32x4*)(mb + 336); __builtin_amdgcn_sched_barrier(0);
                xx[10] = __builtin_elementwise_fma(x2, (f32x2){ring[5].x, ring[5].y}, xx[10]); xx[11] = __builtin_elementwise_fma(x2, (f32x2){ring[5].z, ring[5].w}, xx[11]); ring[5] = *(const LAS f32x4*)(mb + 352); __builtin_amdgcn_sched_barrier(0);
                xx[12] = __builtin_elementwise_fma(x2, (f32x2){ring[6].x, ring[6].y}, xx[12]); xx[13] = __builtin_elementwise_fma(x2, (f32x2){ring[6].z, ring[6].w}, xx[13]); ring[6] = *(const LAS f32x4*)(mb + 368); __builtin_amdgcn_sched_barrier(0);
                xx[14] = __builtin_elementwise_fma(x2, (f32x2){ring[7].x, ring[7].y}, xx[14]); xx[15] = __builtin_elementwise_fma(x2, (f32x2){ring[7].z, ring[7].w}, xx[15]); ring[7] = *(const LAS f32x4*)(mb + 384); __builtin_amdgcn_sched_barrier(0);
                x2 = (f32x2){xx[0][1], xx[0][1]}; xx[0] = __builtin_elementwise_fma(x2, (f32x2){ring[8].x, ring[8].y}, xx[0]); xx[1] = __builtin_elementwise_fma(x2, (f32x2){ring[8].z, ring[8].w}, xx[1]); ring[8] = *(const LAS f32x4*)(mb + 400); __builtin_amdgcn_sched_barrier(0);
                xx[2] = __builtin_elementwise_fma(x2, (f32x2){ring[9].x, ring[9].y}, xx[2]); xx[3] = __builtin_elementwise_fma(x2, (f32x2){ring[9].z, ring[9].w}, xx[3]); ring[9] = *(const LAS f32x4*)(mb + 448); __builtin_amdgcn_sched_barrier(0);
                xx[4] = __builtin_elementwise_fma(x2, (f32x2){ring[10].x, ring[10].y}, xx[4]); xx[5] = __builtin_elementwise_fma(x2, (f32x2){ring[10].z, ring[10].w}, xx[5]); ring[10] = *(const LAS f32x4*)(mb + 464); __builtin_amdgcn_sched_barrier(0);
                xx[6] = __builtin_elementwise_fma(x2, (f32x2){ring[11].x, ring[11].y}, xx[6]); xx[7] = __builtin_elementwise_fma(x2, (f32x2){ring[11].z, ring[11].w}, xx[7]); ring[11] = *(const LAS f32x4*)(mb + 480); __builtin_amdgcn_sched_barrier(0);
                xx[8] = __builtin_elementwise_fma(x2, (f32x2){ring[12].x, ring[12].y}, xx[8]); xx[9] = __builtin_elementwise_fma(x2, (f32x2){ring[12].z, ring[12].w}, xx[9]); ring[12] = *(const LAS f32x4*)(mb + 496); __builtin_amdgcn_sched_barrier(0);
                xx[10] = __builtin_elementwise_fma(x2, (f32x2){ring[13].x, ring[13].y}, xx[10]); xx[11] = __builtin_elementwise_fma(x2, (f32x2){ring[13].z, ring[13].w}, xx[11]); ring[13] = *(const LAS f32x4*)(mb + 512); __builtin_amdgcn_sched_barrier(0);
                xx[12] = __builtin_elementwise_fma(x2, (f32x2){ring[14].x, ring[14].y}, xx[12]); xx[13] = __builtin_elementwise_fma(x2, (f32x2){ring[14].z, ring[14].w}, xx[13]); ring[14] = *(const LAS f32x4*)(mb + 528); __builtin_amdgcn_sched_barrier(0);
                xx[14] = __builtin_elementwise_fma(x2, (f32x2){ring[0].x, ring[0].y}, xx[14]); xx[15] = __builtin_elementwise_fma(x2, (f32x2){ring[0].z, ring[0].w}, xx[15]); ring[0] = *(const LAS f32x4*)(mb + 544); __builtin_amdgcn_sched_barrier(0);
                x2 = (f32x2){xx[1][0], xx[1][0]}; xx[0] = __builtin_elementwise_fma(x2, (f32x2){ring[1].x, ring[1].y}, xx[0]); xx[1] = __builtin_elementwise_fma(x2, (f32x2){ring[1].z, ring[1].w}, xx[1]); ring[1] = *(const LAS f32x4*)(mb + 592); __builtin_amdgcn_sched_barrier(0);
                xx[2] = __builtin_elementwise_fma(x2, (f32x2){ring[2].x, ring[2].y}, xx[2]); xx[3] = __builtin_elementwise_fma(x2, (f32x2){ring[2].z, ring[2].w}, xx[3]); ring[2] = *(const LAS f32x4*)(mb + 608); __builtin_amdgcn_sched_barrier(0);
                xx[4] = __builtin_elementwise_fma(x2, (f32x2){ring[3].x, ring[3].y}, xx[4]); xx[5] = __builtin_elementwise_fma(x2, (f32x2){ring[3].z, ring[3].w}, xx[5]); ring[3] = *(const LAS f32x4*)(mb + 624); __builtin_amdgcn_sched_barrier(0);
                xx[6] = __builtin_elementwise_fma(x2, (f32x2){ring[4].x, ring[4].y}, xx[6]); xx[7] = __builtin_elementwise_fma(x2, (f32x2){ring[4].z, ring[4].w}, xx[7]); ring[4] = *(const LAS f32x4*)(mb + 640); __builtin_amdgcn_sched_barrier(0);
                xx[8] = __builtin_elementwise_fma(x2, (f32x2){ring[5].x, ring[5].y}, xx[8]); xx[9] = __builtin_elementwise_fma(x2, (f32x2){ring[5].z, ring[5].w}, xx[9]); ring[5] = *(const LAS f32x4*)(mb + 656); __builtin_amdgcn_sched_barrier(0);
                xx[10] = __builtin_elementwise_fma(x2, (f32x2){ring[6].x, ring[6].y}, xx[10]); xx[11] = __builtin_elementwise_fma(x2, (f32x2){ring[6].z, ring[6].w}, xx[11]); ring[6] = *(const LAS f32x4*)(mb + 672); __builtin_amdgcn_sched_barrier(0);
                xx[12] = __builtin_elementwise_fma(x2, (f32x2){ring[7].x, ring[7].y}, xx[12]); xx[13] = __builtin_elementwise_fma(x2, (f32x2){ring[7].z, ring[7].w}, xx[13]); ring[7] = *(const LAS f32x4*)(mb + 688); __builtin_amdgcn_sched_barrier(0);
                xx[14] = __builtin_elementwise_fma(x2, (f32x2){ring[8].x, ring[8].y}, xx[14]); xx[15] = __builtin_elementwise_fma(x2, (f32x2){ring[8].z, ring[8].w}, xx[15]); ring[8] = *(const LAS f32x4*)(mb + 736); __builtin_amdgcn_sched_barrier(0);
                x2 = (f32x2){xx[1][1], xx[1][1]}; xx[2] = __builtin_elementwise_fma(x2, (f32x2){ring[9].x, ring[9].y}, xx[2]); xx[3] = __builtin_elementwise_fma(x2, (f32x2){ring[9].z, ring[9].w}, xx[3]); ring[9] = *(const LAS f32x4*)(mb + 752); __builtin_amdgcn_sched_barrier(0);
                xx[4] = __builtin_elementwise_fma(x2, (f32x2){ring[10].x, ring[10].y}, xx[4]); xx[5] = __builtin_elementwise_fma(x2, (f32x2){ring[10].z, ring[10].w}, xx[5]); ring[10] = *(const LAS f32x4*)(mb + 768); __builtin_amdgcn_sched_barrier(0);
                xx[6] = __builtin_elementwise_fma(x2, (f32x2){ring[11].x, ring[11].y}, xx[6]); xx[7] = __builtin_elementwise_fma(x2, (f32x2){ring[11].z, ring[11].w}, xx[7]); ring[11] = *(const LAS f32x4*)(mb + 784); __builtin_amdgcn_sched_barrier(0);
                xx[8] = __builtin_elementwise_fma(x2, (f32x2){ring[12].x, ring[12].y}, xx[8]); xx[9] = __builtin_elementwise_fma(x2, (f32x2){ring[12].z, ring[12].w}, xx[9]); ring[12] = *(const LAS f32x4*)(mb + 800); __builtin_amdgcn_sched_barrier(0);
                xx[10] = __builtin_elementwise_fma(x2, (f32x2){ring[13].x, ring[13].y}, xx[10]); xx[11] = __builtin_elementwise_fma(x2, (f32x2){ring[13].z, ring[13].w}, xx[11]); ring[13] = *(const LAS f32x4*)(mb + 816); __builtin_amdgcn_sched_barrier(0);
                xx[12] = __builtin_elementwise_fma(x2, (f32x2){ring[14].x, ring[14].y}, xx[12]); xx[13] = __builtin_elementwise_fma(x2, (f32x2){ring[14].z, ring[14].w}, xx[13]); ring[14] = *(const LAS f32x4*)(mb + 832); __builtin_amdgcn_sched_barrier(0);
                xx[14] = __builtin_elementwise_fma(x2, (f32x2){ring[0].x, ring[0].y}, xx[14]); xx[15] = __builtin_elementwise_fma(x2, (f32x2){ring[0].z, ring[0].w}, xx[15]); ring[0] = *(const LAS f32x4*)(mb + 880); __builtin_amdgcn_sched_barrier(0);
                x2 = (f32x2){xx[2][0], xx[2][0]}; xx[2] = __builtin_elementwise_fma(x2, (f32x2){ring[1].x, ring[1].y}, xx[2]); xx[3] = __builtin_elementwise_fma(x2, (f32x2){ring[1].z, ring[1].w}, xx[3]); ring[1] = *(const LAS f32x4*)(mb + 896); __builtin_amdgcn_sched_barrier(0);
                xx[4] = __builtin_elementwise_fma(x2, (f32x2){ring[2].x, ring[2].y}, xx[4]); xx[5] = __builtin_elementwise_fma(x2, (f32x2){ring[2].z, ring[2].w}, xx[5]); ring[2] = *(const LAS f32x4*)(mb + 912); __builtin_amdgcn_sched_barrier(0);
                xx[6] = __builtin_elementwise_fma(x2, (f32x2){ring[3].x, ring[3].y}, xx[6]); xx[7] = __builtin_elementwise_fma(x2, (f32x2){ring[3].z, ring[3].w}, xx[7]); ring[3] = *(const LAS f32x4*)(mb + 928); __builtin_amdgcn_sched_barrier(0);
                xx[8] = __builtin_elementwise_fma(x2, (f32x2){ring[4].x, ring[4].y}, xx[8]); xx[9] = __builtin_elementwise_fma(x2, (f32x2){ring[4].z, ring[4].w}, xx[9]); ring[4] = *(const LAS f32x4*)(mb + 944); __builtin_amdgcn_sched_barrier(0);
                xx[10] = __builtin_elementwise_fma(x2, (f32x2){ring[5].x, ring[5].y}, xx[10]); xx[11] = __builtin_elementwise_fma(x2, (f32x2){ring[5].z, ring[5].w}, xx[11]); ring[5] = *(const LAS f32x4*)(mb + 960); __builtin_amdgcn_sched_barrier(0);
                xx[12] = __builtin_elementwise_fma(x2, (f32x2){ring[6].x, ring[6].y}, xx[12]); xx[13] = __builtin_elementwise_fma(x2, (f32x2){ring[6].z, ring[6].w}, xx[13]); ring[6] = *(const LAS f32x4*)(mb + 976); __builtin_amdgcn_sched_barrier(0);
                xx[14] = __builtin_elementwise_fma(x2, (f32x2){ring[7].x, ring[7].y}, xx[14]); xx[15] = __builtin_elementwise_fma(x2, (f32x2){ring[7].z, ring[7].w}, xx[15]); ring[7] = *(const LAS f32x4*)(mb + 1040); __builtin_amdgcn_sched_barrier(0);
                x2 = (f32x2){xx[2][1], xx[2][1]}; xx[2] = __builtin_elementwise_fma(x2, (f32x2){ring[8].x, ring[8].y}, xx[2]); xx[3] = __builtin_elementwise_fma(x2, (f32x2){ring[8].z, ring[8].w}, xx[3]); ring[8] = *(const LAS f32x4*)(mb + 1056); __builtin_amdgcn_sched_barrier(0);
                xx[4] = __builtin_elementwise_fma(x2, (f32x2){ring[9].x, ring[9].y}, xx[4]); xx[5] = __builtin_elementwise_fma(x2, (f32x2){ring[9].z, ring[9].w}, xx[5]); ring[9] = *(const LAS f32x4*)(mb + 1072); __builtin_amdgcn_sched_barrier(0);
                xx[6] = __builtin_elementwise_fma(x2, (f32x2){ring[10].x, ring[10].y}, xx[6]); xx[7] = __builtin_elementwise_fma(x2, (f32x2){ring[10].z, ring[10].w}, xx[7]); ring[10] = *(const LAS f32x4*)(mb + 1088); __builtin_amdgcn_sched_barrier(0);
                xx[8] = __builtin_elementwise_fma(x2, (f32x2){ring[11].x, ring[11].y}, xx[8]); xx[9] = __builtin_elementwise_fma(x2, (f32x2){ring[11].z, ring[11].w}, xx[9]); ring[11] = *(const LAS f32x4*)(mb + 1104); __builtin_amdgcn_sched_barrier(0);
                xx[10] = __builtin_elementwise_fma(x2, (f32x2){ring[12].x, ring[12].y}, xx[10]); xx[11] = __builtin_elementwise_fma(x2, (f32x2){ring[12].z, ring[12].w}, xx[11]); ring[12] = *(const LAS f32x4*)(mb + 1120); __builtin_amdgcn_sched_barrier(0);
                xx[12] = __builtin_elementwise_fma(x2, (f32x2){ring[13].x, ring[13].y}, xx[12]); xx[13] = __builtin_elementwise_fma(x2, (f32x2){ring[13].z, ring[13].w}, xx[13]); ring[13] = *(const LAS f32x4*)(mb + 1184); __builtin_amdgcn_sched_barrier(0);
                xx[14] = __builtin_elementwise_fma(x2, (f32x2){ring[14].x, ring[14].y}, xx[14]); xx[15] = __builtin_elementwise_fma(x2, (f32x2){ring[14].z, ring[14].w}, xx[15]); ring[14] = *(const LAS f32x4*)(mb + 1200); __builtin_amdgcn_sched_barrier(0);
                x2 = (f32x2){xx[3][0], xx[3][0]}; xx[2] = __builtin_elementwise_fma(x2, (f32x2){ring[0].x, ring[0].y}, xx[2]); xx[3] = __builtin_elementwise_fma(x2, (f32x2){ring[0].z, ring[0].w}, xx[3]); ring[0] = *(const LAS f32x4*)(mb + 1216); __builtin_amdgcn_sched_barrier(0);
                xx[4] = __builtin_elementwise_fma(x2, (f32x2){ring[1].x, ring[1].y}, xx[4]); xx[5] = __builtin_elementwise_fma(x2, (f32x2){ring[1].z, ring[1].w}, xx[5]); ring[1] = *(const LAS f32x4*)(mb + 1232); __builtin_amdgcn_sched_barrier(0);
                xx[6] = __builtin_elementwise_fma(x2, (f32x2){ring[2].x, ring[2].y}, xx[6]); xx[7] = __builtin_elementwise_fma(x2, (f32x2){ring[2].z, ring[2].w}, xx[7]); ring[2] = *(const LAS f32x4*)(mb + 1248); __builtin_amdgcn_sched_barrier(0);
                xx[8] = __builtin_elementwise_fma(x2, (f32x2){ring[3].x, ring[3].y}, xx[8]); xx[9] = __builtin_elementwise_fma(x2, (f32x2){ring[3].z, ring[3].w}, xx[9]); ring[3] = *(const LAS f32x4*)(mb + 1264); __builtin_amdgcn_sched_barrier(0);
                xx[10] = __builtin_elementwise_fma(x2, (f32x2){ring[4].x, ring[4].y}, xx[10]); xx[11] = __builtin_elementwise_fma(x2, (f32x2){ring[4].z, ring[4].w}, xx[11]); ring[4] = *(const LAS f32x4*)(mb + 1328); __builtin_amdgcn_sched_barrier(0);
                xx[12] = __builtin_elementwise_fma(x2, (f32x2){ring[5].x, ring[5].y}, xx[12]); xx[13] = __builtin_elementwise_fma(x2, (f32x2){ring[5].z, ring[5].w}, xx[13]); ring[5] = *(const LAS f32x4*)(mb + 1344); __builtin_amdgcn_sched_barrier(0);
                xx[14] = __builtin_elementwise_fma(x2, (f32x2){ring[6].x, ring[6].y}, xx[14]); xx[15] = __builtin_elementwise_fma(x2, (f32x2){ring[6].z, ring[6].w}, xx[15]); ring[6] = *(const LAS f32x4*)(mb + 1360); __builtin_amdgcn_sched_barrier(0);
                x2 = (f32x2){xx[3][1], xx[3][1]}; xx[4] = __builtin_elementwise_fma(x2, (f32x2){ring[7].x, ring[7].y}, xx[4]); xx[5] = __builtin_elementwise_fma(x2, (f32x2){ring[7].z, ring[7].w}, xx[5]); ring[7] = *(const LAS f32x4*)(mb + 1376); __builtin_amdgcn_sched_barrier(0);
                xx[6] = __builtin_elementwise_fma(x2, (f32x2){ring[8].x, ring[8].y}, xx[6]); xx[7] = __builtin_elementwise_fma(x2, (f32x2){ring[8].z, ring[8].w}, xx[7]); ring[8] = *(const LAS f32x4*)(mb + 1392); __builtin_amdgcn_sched_barrier(0);
                xx[8] = __builtin_elementwise_fma(x2, (f32x2){ring[9].x, ring[9].y}, xx[8]); xx[9] = __builtin_elementwise_fma(x2, (f32x2){ring[9].z, ring[9].w}, xx[9]); ring[9] = *(const LAS f32x4*)(mb + 1408); __builtin_amdgcn_sched_barrier(0);
                xx[10] = __builtin_elementwise_fma(x2, (f32x2){ring[10].x, ring[10].y}, xx[10]); xx[11] = __builtin_elementwise_fma(x2, (f32x2){ring[10].z, ring[10].w}, xx[11]); ring[10] = *(const LAS f32x4*)(mb + 1472); __builtin_amdgcn_sched_barrier(0);
                xx[12] = __builtin_elementwise_fma(x2, (f32x2){ring[11].x, ring[11].y}, xx[12]); xx[13] = __builtin_elementwise_fma(x2, (f32x2){ring[11].z, ring[11].w}, xx[13]); ring[11] = *(const LAS f32x4*)(mb + 1488); __builtin_amdgcn_sched_barrier(0);
                xx[14] = __builtin_elementwise_fma(x2, (f32x2){ring[12].x, ring[12].y}, xx[14]); xx[15] = __builtin_elementwise_fma(x2, (f32x2){ring[12].z, ring[12].w}, xx[15]); ring[12] = *(const LAS f32x4*)(mb + 1504); __builtin_amdgcn_sched_barrier(0);
                x2 = (f32x2){xx[4][0], xx[4][0]}; xx[4] = __builtin_elementwise_fma(x2, (f32x2){ring[13].x, ring[13].y}, xx[4]); xx[5] = __builtin_elementwise_fma(x2, (f32x2){ring[13].z, ring[13].w}, xx[5]); ring[13] = *(const LAS f32x4*)(mb + 1520); __builtin_amdgcn_sched_barrier(0);
                xx[6] = __builtin_elementwise_fma(x2, (f32x2){ring[14].x, ring[14].y}, xx[6]); xx[7] = __builtin_elementwise_fma(x2, (f32x2){ring[14].z, ring[14].w}, xx[7]); ring[14] = *(const LAS f32x4*)(mb + 1536); __builtin_amdgcn_sched_barrier(0);
                xx[8] = __builtin_elementwise_fma(x2, (f32x2){ring[0].x, ring[0].y}, xx[8]); xx[9] = __builtin_elementwise_fma(x2, (f32x2){ring[0].z, ring[0].w}, xx[9]); ring[0] = *(const LAS f32x4*)(mb + 1552); __builtin_amdgcn_sched_barrier(0);
                xx[10] = __builtin_elementwise_fma(x2, (f32x2){ring[1].x, ring[1].y}, xx[10]); xx[11] = __builtin_elementwise_fma(x2, (f32x2){ring[1].z, ring[1].w}, xx[11]); ring[1] = *(const LAS f32x4*)(mb + 1632); __builtin_amdgcn_sched_barrier(0);
                xx[12] = __builtin_elementwise_fma(x2, (f32x2){ring[2].x, ring[2].y}, xx[12]); xx[13] = __builtin_elementwise_fma(x2, (f32x2){ring[2].z, ring[2].w}, xx[13]); ring[2] = *(const LAS f32x4*)(mb + 1648); __builtin_amdgcn_sched_barrier(0);
                xx[14] = __builtin_elementwise_fma(x2, (f32x2){ring[3].x, ring[3].y}, xx[14]); xx[15] = __builtin_elementwise_fma(x2, (f32x2){ring[3].z, ring[3].w}, xx[15]); ring[3] = *(const LAS f32x4*)(mb + 1664); __builtin_amdgcn_sched_barrier(0);
                x2 = (f32x2){xx[4][1], xx[4][1]}; xx[4] = __builtin_elementwise_fma(x2, (f32x2){ring[4].x, ring[4].y}, xx[4]); xx[5] = __builtin_elementwise_fma(x2, (f32x2){ring[4].z, ring[4].w}, xx[5]); ring[4] = *(const LAS f32x4*)(mb + 1680); __builtin_amdgcn_sched_barrier(0);
                xx[6] = __builtin_elementwise_fma(x2, (f32x2){ring[5].x, ring[5].y}, xx[6]); xx[7] = __builtin_elementwise_fma(x2, (f32x2){ring[5].z, ring[5].w}, xx[7]); ring[5] = *(const LAS f32x4*)(mb + 1696); __builtin_amdgcn_sched_barrier(0);
                xx[8] = __builtin_elementwise_fma(x2, (f32x2){ring[6].x, ring[6].y}, xx[8]); xx[9] = __builtin_elementwise_fma(x2, (f32x2){ring[6].z, ring[6].w}, xx[9]); ring[6] = *(const LAS f32x4*)(mb + 1776); __builtin_amdgcn_sched_barrier(0);
                xx[10] = __builtin_elementwise_fma(x2, (f32x2){ring[7].x, ring[7].y}, xx[10]); xx[11] = __builtin_elementwise_fma(x2, (f32x2){ring[7].z, ring[7].w}, xx[11]); ring[7] = *(const LAS f32x4*)(mb + 1792); __builtin_amdgcn_sched_barrier(0);
                xx[12] = __builtin_elementwise_fma(x2, (f32x2){ring[8].x, ring[8].y}, xx[12]); xx[13] = __builtin_elementwise_fma(x2, (f32x2){ring[8].z, ring[8].w}, xx[13]); ring[8] = *(const LAS f32x4*)(mb + 1808); __builtin_amdgcn_sched_barrier(0);
                xx[14] = __builtin_elementwise_fma(x2, (f32x2){ring[9].x, ring[9].y}, xx[14]); xx[15] = __builtin_elementwise_fma(x2, (f32x2){ring[9].z, ring[9].w}, xx[15]); ring[9] = *(const LAS f32x4*)(mb + 1824); __builtin_amdgcn_sched_barrier(0);
                x2 = (f32x2){xx[5][0], xx[5][0]}; xx[4] = __builtin_elementwise_fma(x2, (f32x2){ring[10].x, ring[10].y}, xx[4]); xx[5] = __builtin_elementwise_fma(x2, (f32x2){ring[10].z, ring[10].w}, xx[5]); ring[10] = *(const LAS f32x4*)(mb + 1840); __builtin_amdgcn_sched_barrier(0);
                xx[6] = __builtin_elementwise_fma(x2, (f32x2){ring[11].x, ring[11].y}, xx[6]); xx[7] = __builtin_elementwise_fma(x2, (f32x2){ring[11].z, ring[11].w}, xx[7]); ring[11] = *(const LAS f32x4*)(mb + 1920); __builtin_amdgcn_sched_barrier(0);
                xx[8] = __builtin_elementwise_fma(x2, (f32x2){ring[12].x, ring[12].y}, xx[8]); xx[9] = __builtin_elementwise_fma(x2, (f32x2){ring[12].z, ring[12].w}, xx[9]); ring[12] = *(const LAS f32x4*)(mb + 1936); __builtin_amdgcn_sched_barrier(0);
                xx[10] = __builtin_elementwise_fma(x2, (f32x2){ring[13].x, ring[13].y}, xx[10]); xx[11] = __builtin_elementwise_fma(x2, (f32x2){ring[13].z, ring[13].w}, xx[11]); ring[13] = *(const LAS f32x4*)(mb + 1952); __builtin_amdgcn_sched_barrier(0);
                xx[12] = __builtin_elementwise_fma(x2, (f32x2){ring[14].x, ring[14].y}, xx[12]); xx[13] = __builtin_elementwise_fma(x2, (f32x2){ring[14].z, ring[14].w}, xx[13]); ring[14] = *(const LAS f32x4*)(mb + 1968); __builtin_amdgcn_sched_barrier(0);
                xx[14] = __builtin_elementwise_fma(x2, (f32x2){ring[0].x, ring[0].y}, xx[14]); xx[15] = __builtin_elementwise_fma(x2, (f32x2){ring[0].z, ring[0].w}, xx[15]); ring[0] = *(const LAS f32x4*)(mb + 1984); __builtin_amdgcn_sched_barrier(0);
                x2 = (f32x2){xx[5][1], xx[5][1]}; xx[6] = __builtin_elementwise_fma(x2, (f32x2){ring[1].x, ring[1].y}, xx[6]); xx[7] = __builtin_elementwise_fma(x2, (f32x2){ring[1].z, ring[1].w}, xx[7]); ring[1] = *(const LAS f32x4*)(mb + 2064); __builtin_amdgcn_sched_barrier(0);
                xx[8] = __builtin_elementwise_fma(x2, (f32x2){ring[2].x, ring[2].y}, xx[8]); xx[9] = __builtin_elementwise_fma(x2, (f32x2){ring[2].z, ring[2].w}, xx[9]); ring[2] = *(const LAS f32x4*)(mb + 2080); __builtin_amdgcn_sched_barrier(0);
                xx[10] = __builtin_elementwise_fma(x2, (f32x2){ring[3].x, ring[3].y}, xx[10]); xx[11] = __builtin_elementwise_fma(x2, (f32x2){ring[3].z, ring[3].w}, xx[11]); ring[3] = *(const LAS f32x4*)(mb + 2096); __builtin_amdgcn_sched_barrier(0);
                xx[12] = __builtin_elementwise_fma(x2, (f32x2){ring[4].x, ring[4].y}, xx[12]); xx[13] = __builtin_elementwise_fma(x2, (f32x2){ring[4].z, ring[4].w}, xx[13]); ring[4] = *(const LAS f32x4*)(mb + 2112); __builtin_amdgcn_sched_barrier(0);
                xx[14] = __builtin_elementwise_fma(x2, (f32x2){ring[5].x, ring[5].y}, xx[14]); xx[15] = __builtin_elementwise_fma(x2, (f32x2){ring[5].z, ring[5].w}, xx[15]); ring[5] = *(const LAS f32x4*)(mb + 2128); __builtin_amdgcn_sched_barrier(0);
                x2 = (f32x2){xx[6][0], xx[6][0]}; xx[6] = __builtin_elementwise_fma(x2, (f32x2){ring[6].x, ring[6].y}, xx[6]); xx[7] = __builtin_elementwise_fma(x2, (f32x2){ring[6].z, ring[6].w}, xx[7]); ring[6] = *(const LAS f32x4*)(mb + 2224); __builtin_amdgcn_sched_barrier(0);
                xx[8] = __builtin_elementwise_fma(x2, (f32x2){ring[7].x, ring[7].y}, xx[8]); xx[9] = __builtin_elementwise_fma(x2, (f32x2){ring[7].z, ring[7].w}, xx[9]); ring[7] = *(const LAS f32x4*)(mb + 2240); __builtin_amdgcn_sched_barrier(0);
                xx[10] = __builtin_elementwise_fma(x2, (f32x2){ring[8].x, ring[8].y}, xx[10]); xx[11] = __builtin_elementwise_fma(x2, (f32x2){ring[8].z, ring[8].w}, xx[11]); ring[8] = *(const LAS f32x4*)(mb + 2256); __builtin_amdgcn_sched_barrier(0);
                xx[12] = __builtin_elementwise_fma(x2, (f32x2){ring[9].x, ring[9].y}, xx[12]); xx[13] = __builtin_elementwise_fma(x2, (f32x2){ring[9].z, ring[9].w}, xx[13]); ring[9] = *(const LAS f32x4*)(mb + 2272); __builtin_amdgcn_sched_barrier(0);
                xx[14] = __builtin_elementwise_fma(x2, (f32x2){ring[10].x, ring[10].y}, xx[14]); xx[15] = __builtin_elementwise_fma(x2, (f32x2){ring[10].z, ring[10].w}, xx[15]); ring[10] = *(const LAS f32x4*)(mb + 2368); __builtin_amdgcn_sched_barrier(0);
                x2 = (f32x2){xx[6][1], xx[6][1]}; xx[6] = __builtin_elementwise_fma(x2, (f32x2){ring[11].x, ring[11].y}, xx[6]); xx[7] = __builtin_elementwise_fma(x2, (f32x2){ring[11].z, ring[11].w}, xx[7]); ring[11] = *(const LAS f32x4*)(mb + 2384); __builtin_amdgcn_sched_barrier(0);
                xx[8] = __builtin_elementwise_fma(x2, (f32x2){ring[12].x, ring[12].y}, xx[8]); xx[9] = __builtin_elementwise_fma(x2, (f32x2){ring[12].z, ring[12].w}, xx[9]); ring[12] = *(const LAS f32x4*)(mb + 2400); __builtin_amdgcn_sched_barrier(0);
                xx[10] = __builtin_elementwise_fma(x2, (f32x2){ring[13].x, ring[13].y}, xx[10]); xx[11] = __builtin_elementwise_fma(x2, (f32x2){ring[13].z, ring[13].w}, xx[11]); ring[13] = *(const LAS f32x4*)(mb + 2416); __builtin_amdgcn_sched_barrier(0);
                xx[12] = __builtin_elementwise_fma(x2, (f32x2){ring[14].x, ring[14].y}, xx[12]); xx[13] = __builtin_elementwise_fma(x2, (f32x2){ring[14].z, ring[14].w}, xx[13]); ring[14] = *(const LAS f32x4*)(mb + 2512); __builtin_amdgcn_sched_barrier(0);
                xx[14] = __builtin_elementwise_fma(x2, (f32x2){ring[0].x, ring[0].y}, xx[14]); xx[15] = __builtin_elementwise_fma(x2, (f32x2){ring[0].z, ring[0].w}, xx[15]); ring[0] = *(const LAS f32x4*)(mb + 2528); __builtin_amdgcn_sched_barrier(0);
                x2 = (f32x2){xx[7][0], xx[7][0]}; xx[6] = __builtin_elementwise_fma(x2, (f32x2){ring[1].x, ring[1].y}, xx[6]); xx[7] = __builtin_elementwise_fma(x2, (f32x2){ring[1].z, ring[1].w}, xx[7]); ring[1] = *(const LAS f32x4*)(mb + 2544); __builtin_amdgcn_sched_barrier(0);
                xx[8] = __builtin_elementwise_fma(x2, (f32x2){ring[2].x, ring[2].y}, xx[8]); xx[9] = __builtin_elementwise_fma(x2, (f32x2){ring[2].z, ring[2].w}, xx[9]); ring[2] = *(const LAS f32x4*)(mb + 2560); __builtin_amdgcn_sched_barrier(0);
                xx[10] = __builtin_elementwise_fma(x2, (f32x2){ring[3].x, ring[3].y}, xx[10]); xx[11] = __builtin_elementwise_fma(x2, (f32x2){ring[3].z, ring[3].w}, xx[11]); ring[3] = *(const LAS f32x4*)(mb + 2656); __builtin_amdgcn_sched_barrier(0);
                xx[12] = __builtin_elementwise_fma(x2, (f32x2){ring[4].x, ring[4].y}, xx[12]); xx[13] = __builtin_elementwise_fma(x2, (f32x2){ring[4].z, ring[4].w}, xx[13]); ring[4] = *(const LAS f32x4*)(mb + 2672); __builtin_amdgcn_sched_barrier(0);
                xx[14] = __builtin_elementwise_fma(x2, (f32x2){ring[5].x, ring[5].y}, xx[14]); xx[15] = __builtin_elementwise_fma(x2, (f32x2){ring[5].z, ring[5].w}, xx[15]); ring[5] = *(const LAS f32x4*)(mb + 2688); __builtin_amdgcn_sched_barrier(0);
                x2 = (f32x2){xx[7][1], xx[7][1]}; xx[8] = __builtin_elementwise_fma(x2, (f32x2){ring[6].x, ring[6].y}, xx[8]); xx[9] = __builtin_elementwise_fma(x2, (f32x2){ring[6].z, ring[6].w}, xx[9]); ring[6] = *(const LAS f32x4*)(mb + 2704); __builtin_amdgcn_sched_barrier(0);
                xx[10] = __builtin_elementwise_fma(x2, (f32x2){ring[7].x, ring[7].y}, xx[10]); xx[11] = __builtin_elementwise_fma(x2, (f32x2){ring[7].z, ring[7].w}, xx[11]); ring[7] = *(const LAS f32x4*)(mb + 2816); __builtin_amdgcn_sched_barrier(0);
                xx[12] = __builtin_elementwise_fma(x2, (f32x2){ring[8].x, ring[8].y}, xx[12]); xx[13] = __builtin_elementwise_fma(x2, (f32x2){ring[8].z, ring[8].w}, xx[13]); ring[8] = *(const LAS f32x4*)(mb + 2832); __builtin_amdgcn_sched_barrier(0);
                xx[14] = __builtin_elementwise_fma(x2, (f32x2){ring[9].x, ring[9].y}, xx[14]); xx[15] = __builtin_elementwise_fma(x2, (f32x2){ring[9].z, ring[9].w}, xx[15]); ring[9] = *(const LAS f32x4*)(mb + 2848); __builtin_amdgcn_sched_barrier(0);
                x2 = (f32x2){xx[8][0], xx[8][0]}; xx[8] = __builtin_elementwise_fma(x2, (f32x2){ring[10].x, ring[10].y}, xx[8]); xx[9] = __builtin_elementwise_fma(x2, (f32x2){ring[10].z, ring[10].w}, xx[9]); ring[10] = *(const LAS f32x4*)(mb + 2960); __builtin_amdgcn_sched_barrier(0);
                xx[10] = __builtin_elementwise_fma(x2, (f32x2){ring[11].x, ring[11].y}, xx[10]); xx[11] = __builtin_elementwise_fma(x2, (f32x2){ring[11].z, ring[11].w}, xx[11]); ring[11] = *(const LAS f32x4*)(mb + 2976); __builtin_amdgcn_sched_barrier(0);
                xx[12] = __builtin_elementwise_fma(x2, (f32x2){ring[12].x, ring[12].y}, xx[12]); xx[13] = __builtin_elementwise_fma(x2, (f32x2){ring[12].z, ring[12].w}, xx[13]); ring[12] = *(const LAS f32x4*)(mb + 2992); __builtin_amdgcn_sched_barrier(0);
                xx[14] = __builtin_elementwise_fma(x2, (f32x2){ring[13].x, ring[13].y}, xx[14]); xx[15] = __builtin_elementwise_fma(x2, (f32x2){ring[13].z, ring[13].w}, xx[15]); ring[13] = *(const LAS f32x4*)(mb + 3104); __builtin_amdgcn_sched_barrier(0);
                x2 = (f32x2){xx[8][1], xx[8][1]}; xx[8] = __builtin_elementwise_fma(x2, (f32x2){ring[14].x, ring[14].y}, xx[8]); xx[9] = __builtin_elementwise_fma(x2, (f32x2){ring[14].z, ring[14].w}, xx[9]); ring[14] = *(const LAS f32x4*)(mb + 3120); __builtin_amdgcn_sched_barrier(0);
                xx[10] = __builtin_elementwise_fma(x2, (f32x2){ring[0].x, ring[0].y}, xx[10]); xx[11] = __builtin_elementwise_fma(x2, (f32x2){ring[0].z, ring[0].w}, xx[11]); ring[0] = *(const LAS f32x4*)(mb + 3136); __builtin_amdgcn_sched_barrier(0);
                xx[12] = __builtin_elementwise_fma(x2, (f32x2){ring[1].x, ring[1].y}, xx[12]); xx[13] = __builtin_elementwise_fma(x2, (f32x2){ring[1].z, ring[1].w}, xx[13]); ring[1] = *(const LAS f32x4*)(mb + 3248); __builtin_amdgcn_sched_barrier(0);
                xx[14] = __builtin_elementwise_fma(x2, (f32x2){ring[2].x, ring[2].y}, xx[14]); xx[15] = __builtin_elementwise_fma(x2, (f32x2){ring[2].z, ring[2].w}, xx[15]); ring[2] = *(const LAS f32x4*)(mb + 3264); __builtin_amdgcn_sched_barrier(0);
                x2 = (f32x2){xx[9][0], xx[9][0]}; xx[8] = __builtin_elementwise_fma(x2, (f32x2){ring[3].x, ring[3].y}, xx[8]); xx[9] = __builtin_elementwise_fma(x2, (f32x2){ring[3].z, ring[3].w}, xx[9]); ring[3] = *(const LAS f32x4*)(mb + 3280); __builtin_amdgcn_sched_barrier(0);
                xx[10] = __builtin_elementwise_fma(x2, (f32x2){ring[4].x, ring[4].y}, xx[10]); xx[11] = __builtin_elementwise_fma(x2, (f32x2){ring[4].z, ring[4].w}, xx[11]); ring[4] = *(const LAS f32x4*)(mb + 3408); __builtin_amdgcn_sched_barrier(0);
                xx[12] = __builtin_elementwise_fma(x2, (f32x2){ring[5].x, ring[5].y}, xx[12]); xx[13] = __builtin_elementwise_fma(x2, (f32x2){ring[5].z, ring[5].w}, xx[13]); ring[5] = *(const LAS f32x4*)(mb + 3424); __builtin_amdgcn_sched_barrier(0);
                xx[14] = __builtin_elementwise_fma(x2, (f32x2){ring[6].x, ring[6].y}, xx[14]); xx[15] = __builtin_elementwise_fma(x2, (f32x2){ring[6].z, ring[6].w}, xx[15]); ring[6] = *(const LAS f32x4*)(mb + 3552); __builtin_amdgcn_sched_barrier(0);
                x2 = (f32x2){xx[9][1], xx[9][1]}; xx[10] = __builtin_elementwise_fma(x2, (f32x2){ring[7].x, ring[7].y}, xx[10]); xx[11] = __builtin_elementwise_fma(x2, (f32x2){ring[7].z, ring[7].w}, xx[11]); ring[7] = *(const LAS f32x4*)(mb + 3568); __builtin_amdgcn_sched_barrier(0);
                xx[12] = __builtin_elementwise_fma(x2, (f32x2){ring[8].x, ring[8].y}, xx[12]); xx[13] = __builtin_elementwise_fma(x2, (f32x2){ring[8].z, ring[8].w}, xx[13]); ring[8] = *(const LAS f32x4*)(mb + 3696); __builtin_amdgcn_sched_barrier(0);
                xx[14] = __builtin_elementwise_fma(x2, (f32x2){ring[9].x, ring[9].y}, xx[14]); xx[15] = __builtin_elementwise_fma(x2, (f32x2){ring[9].z, ring[9].w}, xx[15]); ring[9] = *(const LAS f32x4*)(mb + 3712); __builtin_amdgcn_sched_barrier(0);
                x2 = (f32x2){xx[10][0], xx[10][0]}; xx[10] = __builtin_elementwise_fma(x2, (f32x2){ring[10].x, ring[10].y}, xx[10]); xx[11] = __builtin_elementwise_fma(x2, (f32x2){ring[10].z, ring[10].w}, xx[11]); ring[10] = *(const LAS f32x4*)(mb + 3840); __builtin_amdgcn_sched_barrier(0);
                xx[12] = __builtin_elementwise_fma(x2, (f32x2){ring[11].x, ring[11].y}, xx[12]); xx[13] = __builtin_elementwise_fma(x2, (f32x2){ring[11].z, ring[11].w}, xx[13]); ring[11] = *(const LAS f32x4*)(mb + 3856); __builtin_amdgcn_sched_barrier(0);
                xx[14] = __builtin_elementwise_fma(x2, (f32x2){ring[12].x, ring[12].y}, xx[14]); xx[15] = __builtin_elementwise_fma(x2, (f32x2){ring[12].z, ring[12].w}, xx[15]); ring[12] = *(const LAS f32x4*)(mb + 4000); __builtin_amdgcn_sched_barrier(0);
                x2 = (f32x2){xx[10][1], xx[10][1]}; xx[10] = __builtin_elementwise_fma(x2, (f32x2){ring[13].x, ring[13].y}, xx[10]); xx[11] = __builtin_elementwise_fma(x2, (f32x2){ring[13].z, ring[13].w}, xx[11]); ring[13] = *(const LAS f32x4*)(mb + 4144); __builtin_amdgcn_sched_barrier(0);
                xx[12] = __builtin_elementwise_fma(x2, (f32x2){ring[14].x, ring[14].y}, xx[12]); xx[13] = __builtin_elementwise_fma(x2, (f32x2){ring[14].z, ring[14].w}, xx[13]); ring[14] = *(const LAS f32x4*)(mb + 4288); __builtin_amdgcn_sched_barrier(0);
                xx[14] = __builtin_elementwise_fma(x2, (f32x2){ring[0].x, ring[0].y}, xx[14]); xx[15] = __builtin_elementwise_fma(x2, (f32x2){ring[0].z, ring[0].w}, xx[15]); ring[0] = *(const LAS f32x4*)(mb + 4432); __builtin_amdgcn_sched_barrier(0);
                x2 = (f32x2){xx[11][0], xx[11][0]}; xx[10] = __builtin_elementwise_fma(x2, (f32x2){ring[1].x, ring[1].y}, xx[10]); xx[11] = __builtin_elementwise_fma(x2, (f32x2){ring[1].z, ring[1].w}, xx[11]); __builtin_amdgcn_sched_barrier(0);
                xx[12] = __builtin_elementwise_fma(x2, (f32x2){ring[2].x, ring[2].y}, xx[12]); xx[13] = __builtin_elementwise_fma(x2, (f32x2){ring[2].z, ring[2].w}, xx[13]); __builtin_amdgcn_sched_barrier(0);
                xx[14] = __builtin_elementwise_fma(x2, (f32x2){ring[3].x, ring[3].y}, xx[14]); xx[15] = __builtin_elementwise_fma(x2, (f32x2){ring[3].z, ring[3].w}, xx[15]); __builtin_amdgcn_sched_barrier(0);
                x2 = (f32x2){xx[11][1], xx[11][1]}; xx[12] = __builtin_elementwise_fma(x2, (f32x2){ring[4].x, ring[4].y}, xx[12]); xx[13] = __builtin_elementwise_fma(x2, (f32x2){ring[4].z, ring[4].w}, xx[13]); __builtin_amdgcn_sched_barrier(0);
                xx[14] = __builtin_elementwise_fma(x2, (f32x2){ring[5].x, ring[5].y}, xx[14]); xx[15] = __builtin_elementwise_fma(x2, (f32x2){ring[5].z, ring[5].w}, xx[15]); __builtin_amdgcn_sched_barrier(0);
                x2 = (f32x2){xx[12][0], xx[12][0]}; xx[12] = __builtin_elementwise_fma(x2, (f32x2){ring[6].x, ring[6].y}, xx[12]); xx[13] = __builtin_elementwise_fma(x2, (f32x2){ring[6].z, ring[6].w}, xx[13]); __builtin_amdgcn_sched_barrier(0);
                xx[14] = __builtin_elementwise_fma(x2, (f32x2){ring[7].x, ring[7].y}, xx[14]); xx[15] = __builtin_elementwise_fma(x2, (f32x2){ring[7].z, ring[7].w}, xx[15]); __builtin_amdgcn_sched_barrier(0);
                x2 = (f32x2){xx[12][1], xx[12][1]}; xx[12] = __builtin_elementwise_fma(x2, (f32x2){ring[8].x, ring[8].y}, xx[12]); xx[13] = __builtin_elementwise_fma(x2, (f32x2){ring[8].z, ring[8].w}, xx[13]); __builtin_amdgcn_sched_barrier(0);
                xx[14] = __builtin_elementwise_fma(x2, (f32x2){ring[9].x, ring[9].y}, xx[14]); xx[15] = __builtin_elementwise_fma(x2, (f32x2){ring[9].z, ring[9].w}, xx[15]); __builtin_amdgcn_sched_barrier(0);
                x2 = (f32x2){xx[13][0], xx[13][0]}; xx[12] = __builtin_elementwise_fma(x2, (f32x2){ring[10].x, ring[10].y}, xx[12]); xx[13] = __builtin_elementwise_fma(x2, (f32x2){ring[10].z, ring[10].w}, xx[13]); __builtin_amdgcn_sched_barrier(0);
                xx[14] = __builtin_elementwise_fma(x2, (f32x2){ring[11].x, ring[11].y}, xx[14]); xx[15] = __builtin_elementwise_fma(x2, (f32x2){ring[11].z, ring[11].w}, xx[15]); __builtin_amdgcn_sched_barrier(0);
                x2 = (f32x2){xx[13][1], xx[13][1]}; xx[14] = __builtin_elementwise_fma(x2, (f32x2){ring[12].x, ring[12].y}, xx[14]); xx[15] = __builtin_elementwise_fma(x2, (f32x2){ring[12].z, ring[12].w}, xx[15]); __builtin_amdgcn_sched_barrier(0);
                x2 = (f32x2){xx[14][0], xx[14][0]}; xx[14] = __builtin_elementwise_fma(x2, (f32x2){ring[13].x, ring[13].y}, xx[14]); xx[15] = __builtin_elementwise_fma(x2, (f32x2){ring[13].z, ring[13].w}, xx[15]); __builtin_amdgcn_sched_barrier(0);
                x2 = (f32x2){xx[14][1], xx[14][1]}; xx[14] = __builtin_elementwise_fma(x2, (f32x2){ring[14].x, ring[14].y}, xx[14]); xx[15] = __builtin_elementwise_fma(x2, (f32x2){ring[14].z, ring[14].w}, xx[15]); __builtin_amdgcn_sched_barrier(0);
                x2 = (f32x2){xx[15][0], xx[15][0]}; xx[14] = __builtin_elementwise_fma(x2, (f32x2){ring[0].x, ring[0].y}, xx[14]); xx[15] = __builtin_elementwise_fma(x2, (f32x2){ring[0].z, ring[0].w}, xx[15]); __builtin_amdgcn_sched_barrier(0);
#pragma unroll
                for (int g = 0; g < 4; ++g) { v4u o; o.x = pg8::cvt_pk_bf16(xx[4 * g][0], xx[4 * g][1]); o.y = pg8::cvt_pk_bf16(xx[4 * g + 1][0], xx[4 * g + 1][1]);
                    o.z = pg8::cvt_pk_bf16(xx[4 * g + 2][0], xx[4 * g + 2][1]); o.w = pg8::cvt_pk_bf16(xx[4 * g + 3][0], xx[4 * g + 3][1]); *(LAS v4u*)(L + CK_U + lane * 80 + 16 * g) = o; }
            }
            CK_BAR();
            if (w >= 2) {
#pragma unroll
                for (int ks = 0; ks < 2; ++ks) { CK_MFMA(acc, CK_FRAG(MM + CK_MBR, 80, 0, ks), CK_FRAG(CK_U, 80, 32 * ih, ks)); CK_MFMA(acc, CK_FRAG(MM + CK_MKR, 80, 0, ks), CK_FRAGT(TR + CK_VT, 32 * ih, ks)); }
#pragma unroll
                for (int q = 0; q < 16; ++q) *(LAS float*)(L + CK_YB + (((q & 3) + 8 * (q >> 2) + 4 * hh) * 64 + 32 * ih + r32) * 4) = acc[q];
            }
            {
#pragma unroll
                for (int ks = 0; ks < 2; ++ks) { CK_MFMA(Sacc, CK_FRAGT(TR + CK_BTT, 32 * kh, ks), CK_FRAG(CK_U, 80, 32 * ih, ks)); CK_MFMA(Sacc, CK_FRAGT(TR + CK_KTT, 32 * kh, ks), CK_FRAGT(TR + CK_VT, 32 * ih, ks)); }
#pragma unroll
                for (int g = 0; g < 4; ++g) { const f32x4 pl = *(const LAS f32x4*)(L + CK_EXPL + (ch & 1) * 256 + (32 * kh + 8 * g + 4 * hh) * 4);
                    Sacc[4 * g] *= pl.x; Sacc[4 * g + 1] *= pl.y; Sacc[4 * g + 2] *= pl.z; Sacc[4 * g + 3] *= pl.w;
                    *(LAS unsigned long long*)(L + CK_SB + (32 * ih + r32) * 144 + (32 * kh + 8 * g + 4 * hh) * 2) = pack4bf(Sacc[4 * g], Sacc[4 * g + 1], Sacc[4 * g + 2], Sacc[4 * g + 3]); }
            }
            CK_BAR();
        }
        {
            const int lane = F.lane, r32 = lane & 31, hh = lane >> 5;
            float* so = F.out + (smp ? O_WKVS : O_WKVP) + (((size_t)(l * 8 + b) * 16 + h) * 64 + 32 * ih + r32) * 64 + 32 * kh + 4 * hh;
#pragma unroll
            for (int g = 0; g < 4; ++g) *(f32x4*)(so + 8 * g) = (f32x4){Sacc[4 * g], Sacc[4 * g + 1], Sacc[4 * g + 2], Sacc[4 * g + 3]};
        }
    } else {
        const bf16* URW = (const bf16*)(F.ws + B_URW);
        bf16* ORW = (bf16*)(F.ws + B_ORW);
        float mu_r[4], mu_k[4], mu_v[4], k_k[4], k_a[4], r_k[4], ln_w[4], ln_b[4];
        {
            const int c = h * 64 + 4 * (F.tid & 15); const float* mu = GIN(A, 12) + (size_t)l * P_RW;
#pragma unroll
            for (int j = 0; j < 4; ++j) { mu_r[j] = mu[c + j]; mu_k[j] = mu[1024 + c + j]; mu_v[j] = mu[2048 + c + j]; k_k[j] = GIN(A, 18)[l * 1024 + c + j]; k_a[j] = GIN(A, 19)[l * 1024 + c + j]; r_k[j] = GIN(A, 20)[l * 1024 + c + j];
                ln_w[j] = GIN(A, 21)[l * 1024 + c + j]; ln_b[j] = GIN(A, 22)[l * 1024 + c + j]; }
        }
        unsigned long long raw[2][9];
#define CK_RAWLOAD(ch) do { _Pragma("unroll") for (int rep_ = 0; rep_ < 2; ++rep_) { const int tt_ = (pt >> 4) + 16 * rep_; const int tseq = (ch) * CK_L + tt_; const size_t ru_ = (size_t)(row0 + (ch) * CK_L); \
            const int vo_ = tt_ * P_RW + c, vp_ = (tseq > 0) ? vo_ - P_RW : vo_; \
            const bf16* u_ = URW + ru_ * P_RW;     \
            raw[rep_][0] = *(const unsigned long long*)(u_ + vo_); raw[rep_][1] = *(const unsigned long long*)(u_ + vo_ + 1024); raw[rep_][2] = *(const unsigned long long*)(u_ + vo_ + 2048); \
            raw[rep_][5] = *(const unsigned long long*)(u_ + vp_); raw[rep_][6] = *(const unsigned long long*)(u_ + vp_ + 1024); raw[rep_][7] = *(const unsigned long long*)(u_ + vp_ + 2048); } } while (0)
        float r[2][4], kk[2][4], km[2][4], bb[2][4], ld[2][4], vr[2][4], cp[2][4];
        unsigned long long bv1[2], bv2[2], bv3[2], g1[2], g2[2], g3[2];
#pragma unroll
        for (int rep = 0; rep < 2; ++rep) { bv1[rep] = bv2[rep] = bv3[rep] = 0ull; g1[rep] = g2[rep] = g3[rep] = 0ull; }
        auto post = [&](const int ch, const int pt, const int gen) __attribute__((always_inline)) {
            const int cq = pt & 15, c = h * 64 + 4 * cq;
#pragma unroll
            for (int rep = 0; rep < 2; ++rep) {
                const int tt = (pt >> 4) + 16 * rep; const size_t r_ = (size_t)(row0 + ch * CK_L + tt);
                const f32x4 y4 = *(const LAS f32x4*)(L + CK_YB + (tt * 64 + 4 * cq) * 4);
                float gg[4], vv[4]; unpack4(gen == 1 ? g1[rep] : gen == 2 ? g2[rep] : g3[rep], gg); unpack4(gen == 1 ? bv1[rep] : gen == 2 ? bv2[rep] : bv3[rep], vv);
                const float mean = reduce16((y4.x + y4.y) + (y4.z + y4.w)) * (1.f / 64.f);
                const float d0 = y4.x - mean, d1 = y4.y - mean, d2 = y4.z - mean, d3 = y4.w - mean;
                const float var = reduce16((d0 * d0 + d1 * d1) + (d2 * d2 + d3 * d3)) * (1.f / 64.f);
                const float rs = __builtin_amdgcn_rsqf(var + GN_EPS);
                const float o0 = (d0 * rs * ln_w[0] + ln_b[0] + vv[0]) * gg[0], o1 = (d1 * rs * ln_w[1] + ln_b[1] + vv[1]) * gg[1];
                const float o2 = (d2 * rs * ln_w[2] + ln_b[2] + vv[2]) * gg[2], o3 = (d3 * rs * ln_w[3] + ln_b[3] + vv[3]) * gg[3];
                *(unsigned long long*)(ORW + r_ * 1024 + c) = pack4bf(o0, o1, o2, o3);
            }
        };
        auto prep1 = [&](const int chp, const int pt, const int lane) __attribute__((always_inline)) {
            const int cq = pt & 15, c = h * 64 + 4 * cq;
            float ur[2][4], uk[2][4], uv[2][4], pr[2][4], pk[2][4], pv[2][4], la[2][4]; unsigned long long gcur[2];
#pragma unroll
            for (int rep = 0; rep < 2; ++rep) { unpack4(raw[rep][0], ur[rep]); unpack4(raw[rep][1], uk[rep]); unpack4(raw[rep][2], uv[rep]);
                unpack4(raw[rep][5], pr[rep]); unpack4(raw[rep][6], pk[rep]); unpack4(raw[rep][7], pv[rep]);
                const int lo_ = (((pt >> 4) + 16 * rep) * 64 + 4 * cq) * 2;
                unpack4(*(const LAS unsigned long long*)(L + CK_LOR + lo_), ld[rep]); unpack4(*(const LAS unsigned long long*)(L + CK_LOR + 4096 + lo_), la[rep]); gcur[rep] = *(const LAS unsigned long long*)(L + CK_LOR + 8192 + lo_); }
            __builtin_amdgcn_sched_barrier(0);
            { const int chn = (chp + 1 < nch) ? chp + 1 : nch - 1; CK_RAWLOAD(chn); }
            __builtin_amdgcn_sched_barrier(0);
#pragma unroll
            for (int rep = 0; rep < 2; ++rep) {
                const int tt = (pt >> 4) + 16 * rep, tseq = chp * CK_L + tt;
                if (tseq == 0) {
                    const f32x4 a0 = *(const LAS f32x4*)(L + CK_SH + 16 * cq), a1 = *(const LAS f32x4*)(L + CK_SH + 256 + 16 * cq), a2 = *(const LAS f32x4*)(L + CK_SH + 512 + 16 * cq);
#pragma unroll
                    for (int j = 0; j < 4; ++j) { pr[rep][j] = a0[j]; pk[rep][j] = a1[j]; pv[rep][j] = a2[j]; }
                }
                float ssq = 0.f, bon = 0.f, kr[4];
#pragma unroll
                for (int j = 0; j < 4; ++j) {
                    r[rep][j] = ur[rep][j] + (pr[rep][j] - ur[rep][j]) * mu_r[j]; kr[j] = uk[rep][j] + (pk[rep][j] - uk[rep][j]) * mu_k[j]; vr[rep][j] = uv[rep][j] + (pv[rep][j] - uv[rep][j]) * mu_v[j];
                    kk[rep][j] = kr[j] * k_k[j]; ssq += kk[rep][j] * kk[rep][j]; km[rep][j] = kr[j] * (1.f + (la[rep][j] - 1.f) * k_a[j]); bon += r[rep][j] * km[rep][j] * r_k[j]; }
                ssq = reduce16(ssq); bon = reduce16(bon);
                const float inv = __builtin_amdgcn_rsqf(fmaxf(ssq, 1e-24f));
#pragma unroll
                for (int j = 0; j < 4; ++j) { kk[rep][j] *= inv; bb[rep][j] = kk[rep][j] * la[rep][j]; }
#pragma unroll
                for (int j = 0; j < 4; ++j) { float x = ld[rep][j]; const float u1 = __shfl_up(x, 16); x += (lane >= 16) ? u1 : 0.f; const float u2 = __shfl_up(x, 32); x += (lane >= 32) ? u2 : 0.f; cp[rep][j] = x; }
                if (lane >= 48) *(LAS f32x4*)(L + CK_LDF + ((tt >> 2) * 64 + 4 * cq) * 4) = (f32x4){cp[rep][0], cp[rep][1], cp[rep][2], cp[rep][3]};
                bv3[rep] = bv2[rep]; g3[rep] = g2[rep]; bv2[rep] = bv1[rep]; g2[rep] = g1[rep]; bv1[rep] = pack4bf(bon * vr[rep][0], bon * vr[rep][1], bon * vr[rep][2], bon * vr[rep][3]); g1[rep] = gcur[rep];
            }
        };
        auto prep3 = [&](const int chp, const int pt) __attribute__((always_inline)) {
            const int cq = pt & 15; const int TR = CK_TR + (chp & 1) * CK_TR_SZ;
#pragma unroll
            for (int rep = 0; rep < 2; ++rep) {
                const int tt = (pt >> 4) + 16 * rep, grp = tt >> 2;
                f32x4 cum = (f32x4){cp[rep][0], cp[rep][1], cp[rep][2], cp[rep][3]}, cumL = (f32x4){0.f, 0.f, 0.f, 0.f};
#pragma unroll
                for (int g2_ = 0; g2_ < 8; ++g2_) { const f32x4 t4 = *(const LAS f32x4*)(L + CK_LDF + (g2_ * 64 + 4 * cq) * 4); cumL += t4; if (g2_ < grp) cum += t4; }
                float at[4], bt[4], kt[4], rt[4];
#pragma unroll
                for (int j = 0; j < 4; ++j) {
                    const float e1 = __builtin_amdgcn_exp2f(1.4426950408889634f * cum[j]), e2 = __builtin_amdgcn_exp2f(-1.4426950408889634f * cum[j]), ep = __builtin_amdgcn_exp2f(1.4426950408889634f * (cum[j] - ld[rep][j]));
                    at[j] = -kk[rep][j] * ep; bt[j] = bb[rep][j] * e2; kt[j] = km[rep][j] * e2; rt[j] = r[rep][j] * e1; }
                const unsigned long long pa = pack4bf(at[0], at[1], at[2], at[3]), pb = pack4bf(bt[0], bt[1], bt[2], bt[3]), pkk = pack4bf(kt[0], kt[1], kt[2], kt[3]), prr = pack4bf(rt[0], rt[1], rt[2], rt[3]),
                                         pvv = pack4bf(vr[rep][0], vr[rep][1], vr[rep][2], vr[rep][3]);
                *(LAS unsigned long long*)(L + CK_AT + tt * 144 + 8 * cq) = pa; *(LAS unsigned long long*)(L + CK_BT + tt * 144 + 8 * cq) = pb;
                *(LAS unsigned long long*)(L + CK_KT + tt * 144 + 8 * cq) = pkk; *(LAS unsigned long long*)(L + CK_RT + tt * 144 + 8 * cq) = prr;
#pragma unroll
                for (int j = 0; j < 4; ++j) {
                    const int to = (4 * cq + j) * 80 + (((tt >> 3) ^ ((cq >> 1) & 3)) * 16) + (tt & 7) * 2;
                    *(LAS unsigned short*)(L + TR + CK_BTT + to) = (unsigned short)(pb >> (16 * j));
                    *(LAS unsigned short*)(L + TR + CK_KTT + to) = (unsigned short)(pkk >> (16 * j));
                    *(LAS unsigned short*)(L + TR + CK_VT + to) = (unsigned short)(pvv >> (16 * j)); }
                if (tt == 0) *(LAS f32x4*)(L + CK_EXPL + (chp & 1) * 256 + 16 * cq) = (f32x4){__builtin_amdgcn_exp2f(1.4426950408889634f * cumL[0]), __builtin_amdgcn_exp2f(1.4426950408889634f * cumL[1]),
                                                                                          __builtin_amdgcn_exp2f(1.4426950408889634f * cumL[2]), __builtin_amdgcn_exp2f(1.4426950408889634f * cumL[3])};
            }
        };
        auto prep4 = [&](const int chp, const int lane) __attribute__((always_inline)) {
            const int r32 = lane & 31, hh = lane >> 5, wt = w - 4; const int MM = CK_MM + (chp & 1) * CK_MM_SZ;
            f32x16s acc;
#pragma unroll
            for (int q = 0; q < 16; ++q) acc[q] = 0.f;
            const int abase = (wt & 1) ? CK_KT : CK_BT, bbase = (wt & 2) ? CK_RT : CK_AT;
#pragma unroll
            for (int ks = 0; ks < 4; ++ks) CK_MFMA(acc, CK_FRAG(abase, 144, 0, ks), CK_FRAG(bbase, 144, 0, ks));
#pragma unroll
            for (int q = 0; q < 16; ++q) { const int s = (q & 3) + 8 * (q >> 2) + 4 * hh; const bool keep = (wt & 2) ? (s <= r32) : (s < r32); acc[q] = keep ? acc[q] : 0.f; }
            if (wt == 0) {
#pragma unroll
                for (int q = 0; q < 16; ++q) *(LAS float*)(L + MM + CK_MBA + ((q & 3) + 8 * (q >> 2) + 4 * hh) * 144 + r32 * 4) = acc[q];
            } else {
                const int obase = MM + ((wt == 1) ? CK_MKA : (wt == 2) ? CK_MBR : CK_MKR);
#pragma unroll
                for (int g = 0; g < 4; ++g) *(LAS unsigned long long*)(L + obase + r32 * 80 + (8 * g + 4 * hh) * 2) = pack4bf(acc[4 * g], acc[4 * g + 1], acc[4 * g + 2], acc[4 * g + 3]);
            }
        };
        { const int pt = F.tid - 256, c = h * 64 + 4 * (pt & 15); CK_RAWLOAD(0); }
        __syncthreads();
        { int tv = threadIdx.x; asm volatile("" : "+v"(tv)); prep1(0, tv - 256, tv & 63); }
        CK_BAR();
        { int tv = threadIdx.x; asm volatile("" : "+v"(tv)); prep3(0, tv - 256); }
        CK_BAR();
        { int tv = threadIdx.x; asm volatile("" : "+v"(tv)); prep4(0, tv & 63); }
        CK_BAR();
        for (int ch = 0; ch < nch; ++ch) {
            int tv = threadIdx.x; asm volatile("" : "+v"(tv));
            const int pt = tv - 256, lane = tv & 63; const bool more = ch + 1 < nch;
            if (more) prep1(ch + 1, pt, lane);
            CK_BAR();
            if (ch > 0) { if (more) post(ch - 1, pt, 3); else post(ch - 1, pt, 2); }
            CK_BAR();
            if (more) prep3(ch + 1, pt);
            CK_BAR();
            if (more) prep4(ch + 1, lane);
            CK_BAR();
        }
        { int tv = threadIdx.x; asm volatile("" : "+v"(tv)); post(nch - 1, tv - 256, 1); }
#undef CK_RAWLOAD
    }
    __syncthreads();
}
__device__ __forceinline__ void ph_scan(Frame& F, CArgsP A, int l, const int s0, const int ns) {
    for (int it = s0; it < 256; it += ns) scan_chunked(F, A, l, it, (const bf16*)(F.ws + WS_W + W_LORA), (const bf16*)(F.ws + B_LIN));
}

__device__ __forceinline__ void ph_final(Frame& F, CArgsP A) {
    const int gw = F.vcu * NWAVES + F.wave, NGW = F.G * NWAVES;
    float* X = F.out + O_YP; const float* SS = (const float*)(F.ctl + CW_SS) + 4 * MT; const float* g = GIN(A, 30);
    const GAS f32x4* gr = (const GAS f32x4*)g + F.lane;
    f32x4 gg[4];
#pragma unroll
    for (int j = 0; j < 4; ++j) gg[j] = gr[64 * j];
    for (int m0 = gw; m0 < MT; m0 += 3 * NGW) {
        f32x4 v[3][4]; float r[3];
#pragma unroll
        for (int q = 0; q < 3; ++q) { const int m = m0 + q * NGW, mm = (m < MT) ? m : 0; r[q] = SS[mm];
            const GAS f32x4* xr = (const GAS f32x4*)(X + (size_t)mm * 1024) + F.lane;
#pragma unroll
            for (int j = 0; j < 4; ++j) v[q][j] = xr[64 * j]; }
#pragma unroll
        for (int q = 0; q < 3; ++q) { const int m = m0 + q * NGW;
            if (m < MT) { const float rs = 1.0f / sqrtf(r[q] * (1.0f / 1024.f) + EPS);
                GAS f32x4* xo = (GAS f32x4*)(X + (size_t)m * 1024) + F.lane;
#pragma unroll
                for (int j = 0; j < 4; ++j) xo[64 * j] = v[q][j] * rs * gg[j]; } }
    }
}

typedef float f32x16g __attribute__((ext_vector_type(16)));
template <int NB, class EPI> __device__ __forceinline__ void mini_gemm(Frame& F, const bf16* A, const bf16* Bt, const int K, const int nblk_n, EPI epi) {
    LAS float* red = (LAS float*)(F.lds + RING_OFF);
    const int KW = K / NWAVES, i = F.lane & 31, h = F.lane >> 5;
    for (int bi = F.vcu; bi < 8 * nblk_n; bi += F.G) {
        const int rb = bi & 7, cb = bi >> 3;
        const bf16* ap = A + (size_t)(rb * 32 + i) * K + F.wave * KW + 8 * h;
        const bf16* bp = Bt + (size_t)(cb * 32 + i) * K + F.wave * KW + 8 * h;
        f32x16g acc;
#pragma unroll
        for (int r = 0; r < 16; ++r) acc[r] = 0.f;
        for (int k0 = 0; k0 < KW; k0 += 16 * NB) {
            bf16x8 a[NB], b[NB];
#pragma unroll
            for (int j = 0; j < NB; ++j) { a[j] = *(const bf16x8*)(ap + k0 + 16 * j); b[j] = *(const bf16x8*)(bp + k0 + 16 * j); }
#pragma unroll
            for (int j = 0; j < NB; ++j) acc = __builtin_amdgcn_mfma_f32_32x32x16_bf16(a[j], b[j], acc, 0, 0, 0);
        }
        __syncthreads();
#pragma unroll
        for (int r = 0; r < 16; ++r) red[(F.wave * 16 + r) * 64 + F.lane] = acc[r];
        __syncthreads();
        const int q = F.wave;
        float s0 = 0.f, s1 = 0.f;
#pragma unroll
        for (int w = 0; w < NWAVES; ++w) { s0 += red[(w * 16 + 2 * q) * 64 + F.lane]; s1 += red[(w * 16 + 2 * q + 1) * 64 + F.lane]; }
        epi(rb * 32 + 2 * (q & 1) + 8 * (q >> 1) + 4 * h, cb * 32 + i, s0, s1);
    }
}
__device__ __forceinline__ void mini_gated(Frame& F, const bf16* A, const bf16* Bt, const bf16* G, const int goff, const bf16* S, bf16* O) {
    mini_gemm<8>(F, A + (size_t)MP * 1024, Bt, 1024, 32, [=](int row, int col, float v0, float v1) {
        const size_t r0 = (size_t)(MP + row);
        v0 *= bf2f(G[r0 * 2048 + goff + col]); v1 *= bf2f(G[(r0 + 1) * 2048 + goff + col]);
        if (S) { v0 += bf2f(S[r0 * 1024 + col]); v1 += bf2f(S[(r0 + 1) * 1024 + col]); }
        O[r0 * 1024 + col] = (bf16)f2bf(v0); O[(r0 + 1) * 1024 + col] = (bf16)f2bf(v1);
    });
}
template <int NB> __device__ __forceinline__ void mini_res(Frame& F, const bf16* A, const bf16* Bt, const int K, const float* Xr, float* X, bf16* XB, float* SS) {
    mini_gemm<NB>(F, A + (size_t)MP * K, Bt, K, 32, [=](int row, int col, float v0, float v1) {
        const size_t r0 = (size_t)(MP + row);
        v0 += Xr[(size_t)row * 1024 + col]; v1 += Xr[(size_t)(row + 1) * 1024 + col];
        X[r0 * 1024 + col] = v0; X[(r0 + 1) * 1024 + col] = v1;
        XB[r0 * 1024 + col] = (bf16)f2bf(v0); XB[(r0 + 1) * 1024 + col] = (bf16)f2bf(v1);
        float q0 = reduce16(v0 * v0), q1 = reduce16(v1 * v1);
        q0 += __shfl_xor(q0, 16); q1 += __shfl_xor(q1, 16);
        if ((col & 31) == 0) { atomicAdd(SS + r0, q0); atomicAdd(SS + r0 + 1, q1); }
    });
}
__device__ __forceinline__ void mini_gate(Frame& F, const bf16* A, const bf16* Bt, const float* ss, bf16* GATE) {
    mini_gemm<8>(F, A + (size_t)MP * 1024, Bt, 1024, 64, [=](int row, int col, float v0, float v1) {
        const size_t r0 = (size_t)(MP + row);
        const float rs0 = 1.0f / sqrtf(ss[r0] * (1.0f / 1024.f) + 1e-6f), rs1 = 1.0f / sqrtf(ss[r0 + 1] * (1.0f / 1024.f) + 1e-6f);
        GATE[r0 * 2048 + col] = (bf16)f2bf(pg8::fast_sigmoid(v0 * rs0)); GATE[(r0 + 1) * 2048 + col] = (bf16)f2bf(pg8::fast_sigmoid(v1 * rs1));
    });
}

__device__ __forceinline__ int edge_row(int idx) { const int j = idx & 31, q = j >> 1, e = j & 1; const int base = (q < 8) ? q * SEQ : MP + (q - 8) * DEC_SEQ, len = (q < 8) ? SEQ : DEC_SEQ; return base + ((idx >= 32) ? len - 2 + e : e); }
__device__ __forceinline__ void up_edge_rows(Frame& F, CArgsP A, int l, const bf16* XB, const bf16* Bt, const float* ss, bf16* GT, float* cv_p, float* cv_s) {
    LAS float* red = (LAS float*)(F.lds + RING_OFF);
    const int KW = 1024 / NWAVES, i = F.lane & 31, h = F.lane >> 5;
    const float* cw = GIN(A, 27) + (size_t)l * 3 * UPW; const float* cb = GIN(A, 28) + (size_t)l * UPW;
    for (int bi = F.vcu; bi < 2 * (D_FF / 32); bi += F.G) {
        const int rb = bi & 1, cq = bi >> 1, nbA = (cq >> 2) * 256 + (cq & 3) * 32;
        const bf16* ap = XB + (size_t)edge_row(rb * 32 + i) * 1024 + F.wave * KW + 8 * h;
        const bf16* bp = Bt + (size_t)(nbA + i) * 1024 + F.wave * KW + 8 * h;
        f32x16g accA, accG;
#pragma unroll
        for (int r = 0; r < 16; ++r) { accA[r] = 0.f; accG[r] = 0.f; }
        { bf16x8 a[8], b0[8], b1[8];
#pragma unroll
            for (int j = 0; j < 8; ++j) { a[j] = *(const bf16x8*)(ap + 16 * j); b0[j] = *(const bf16x8*)(bp + 16 * j); b1[j] = *(const bf16x8*)(bp + 128 * 1024 + 16 * j); }
#pragma unroll
            for (int j = 0; j < 8; ++j) { accA = __builtin_amdgcn_mfma_f32_32x32x16_bf16(a[j], b0[j], accA, 0, 0, 0); accG = __builtin_amdgcn_mfma_f32_32x32x16_bf16(a[j], b1[j], accG, 0, 0, 0); } }
        __syncthreads();
#pragma unroll
        for (int r = 0; r < 16; ++r) { red[(F.wave * 16 + r) * 64 + F.lane] = accA[r]; red[8192 + (F.wave * 16 + r) * 64 + F.lane] = accG[r]; }
        __syncthreads();
        const int q = F.wave;
        float a0 = 0.f, a1 = 0.f, g0 = 0.f, g1 = 0.f;
#pragma unroll
        for (int w = 0; w < NWAVES; ++w) { a0 += red[(w * 16 + 2 * q) * 64 + F.lane]; a1 += red[(w * 16 + 2 * q + 1) * 64 + F.lane]; g0 += red[8192 + (w * 16 + 2 * q) * 64 + F.lane]; g1 += red[8192 + (w * 16 + 2 * q + 1) * 64 + F.lane]; }
        const int idx = rb * 32 + 2 * (q & 1) + 8 * (q >> 1) + 4 * h;
        const int j = (cq >> 2) * 128 + (cq & 3) * 32 + i, sq = (idx & 31) >> 1;
        const int row = edge_row(idx);
        const float r0 = 1.0f / sqrtf(ss[row] * (1.0f / 1024.f) + EPS), r1 = 1.0f / sqrtf(ss[row + 1] * (1.0f / 1024.f) + EPS);
        a0 *= r0; g0 *= r0; a1 *= r1; g1 *= r1;
        if (rb == 1) { float* o = (sq < 8) ? cv_p + (size_t)sq * 2 * UPW : cv_s + (size_t)(sq - 8) * 2 * UPW; o[j] = a0; o[D_FF + j] = g0; o[UPW + j] = a1; o[UPW + D_FF + j] = g1; }
        else {
            float c0[2], c1[2];
#pragma unroll
            for (int hf = 0; hf < 2; ++hf) { const int col = j + hf * D_FF; const float x0 = hf ? g0 : a0, x1 = hf ? g1 : a1;
                float s2 = 0.f, s1 = 0.f;
                if (sq >= 8) { const float* st = GIN(A, 6) + ((size_t)(l * 8 + sq - 8) * 2) * UPW + col; s2 = st[0]; s1 = st[UPW]; }
                const float w0 = cw[col], w1 = cw[UPW + col], w2 = cw[2 * UPW + col], bs = cb[col];
                c0[hf] = bs + s2 * w0 + s1 * w1 + x0 * w2; c1[hf] = bs + s1 * w0 + x0 * w1 + x1 * w2; }
            GT[(size_t)row * D_FF + j] = (bf16)f2bf(c0[0] * __builtin_amdgcn_rcpf(1.0f + __builtin_amdgcn_exp2f(-1.4426950408889634f * c0[0])) * c0[1]);
            GT[(size_t)(row + 1) * D_FF + j] = (bf16)f2bf(c1[0] * __builtin_amdgcn_rcpf(1.0f + __builtin_amdgcn_exp2f(-1.4426950408889634f * c1[0])) * c1[1]);
        }
    }
}

#define REOPAQUE() do { int tv = threadIdx.x; asm volatile("" : "+v"(tv)); F.tid = tv; F.lane = tv & 63; F.wave = __builtin_amdgcn_readfirstlane(tv >> 6); \
    ap = (CArgsP)__builtin_amdgcn_kernarg_segment_ptr(); asm volatile("" : "+s"(ap)); \
    { GAS unsigned char* w_ = ap->ws; GAS float* o_ = ap->out; asm volatile("" : "+s"(w_), "+s"(o_)); F.ws = (unsigned char*)w_; F.out = (float*)o_; F.ctl = (gu32*)(w_ + WS_CTL); } } while (0)
#ifndef MK_PROBE_MASK
#define MK_PROBE_MASK 0u
#endif
#define MK_PROBE_AMP 4u
#define PH_BEGIN(idx) if (lo <= (idx) && (idx) < hi) { REOPAQUE(); if ((MK_PROBE_MASK >> (idx)) & 1u) { if (F.tid == 0) F.MISC[14] = (unsigned)rt(); }
#define PH_END(idx) if ((idx) + 1 < hi) xcd_barrier(bar); if ((MK_PROBE_MASK >> (idx)) & 1u) { if (threadIdx.x == 0) F.MISC[13] += (unsigned)rt() - F.MISC[14]; } }
#define PH_END_NOBAR(idx) if (MK_PER_PHASE && (idx) + 1 < hi) xcd_barrier(bar); if ((MK_PROBE_MASK >> (idx)) & 1u) { if (threadIdx.x == 0) F.MISC[13] += (unsigned)rt() - F.MISC[14]; } }

#define IDLE_CONVERT(nu, part) do { const int rem_ = (nu) % F.G; __syncthreads(); if (rem_ && (int)blockIdx.x >= rem_) { REOPAQUE(); p0_weights(F, ap, 1, ((int)blockIdx.x - rem_) * NWAVES + F.wave, (F.G - rem_) * NWAVES, part); } \
        else if (!rem_) { REOPAQUE(); p0_weights(F, ap, 1, (int)blockIdx.x * NWAVES + F.wave, F.G * NWAVES, part); } } while (0)

template <int l> __device__ __forceinline__ void layer_phases(Frame& F, CArgsP& ap, const XcdBarrier& bar, const int lo, const int hi) {
    constexpr int P0 = 1 + l * PH_PER_LAYER;
#define WL (F.ws + WS_W)
#define SSP ((float*)(F.ctl + CW_SS))
    PH_BEGIN(P0 + K_G1) {
        int kk_ = 1024; asm volatile("" : "+s"(kk_)); pg8::Gemm g{(const bf16*)(F.ws + WS_XB), (const bf16*)(WL + W_IN), MT, P_DA + P_RW, kk_}; pg8::StaticOrder S; S.init(MT, P_DA + P_RW, F.G, (int)blockIdx.x);
        pg8::EpiIn E{SSP + (size_t)(2 * l) * MT, (const float*)(F.ws + WS_ROPE), (bf16*)(F.ws + B_Q), (bf16*)(F.ws + B_K), (bf16*)(F.ws + B_V), (bf16*)(F.ws + B_URW),
                     F.out + O_KP + (size_t)l * MP * 1024, F.out + O_VP + (size_t)l * MP * 1024, F.out + O_KS + (size_t)l * MS * 1024, F.out + O_VS + (size_t)l * MS * 1024,
                     F.out + O_SHP + (size_t)l * BATCH * P_RW, F.out + O_SHS + (size_t)l * DEC_BATCH * P_RW};
        pg8::gemm_phase<pg8::EpiIn, pg8::StaticOrder, true, true>(F.lds + RING_OFF, g, S, E);
        if constexpr (l == 0) IDLE_CONVERT((MT / 256) * ((P_DA + P_RW) / 256), WP_UP | WP_DN);
    } PH_END(P0 + K_G1)
    PH_BEGIN(P0 + K_LP) { ph_linprep(F, ap, l); } PH_END(P0 + K_LP)
    PH_BEGIN(P0 + K_LR) { } PH_END_NOBAR(P0 + K_LR)
    PH_BEGIN(P0 + K_SC) {
        const int NSC = (F.G >= 256) ? 128 : F.G / 2;
        if (!(F.vcu & 1) && (F.vcu >> 1) < NSC) { ph_scan(F, ap, l, F.vcu >> 1, NSC); REOPAQUE(); }
        ph_attn(F, ap, l);
    } PH_END(P0 + K_SC)
    PH_BEGIN(P0 + K_CB) {
        ph_combine(F, ap, l);
        int kk_ = 1024; asm volatile("" : "+s"(kk_)); pg8::Gemm g{(const bf16*)(F.ws + WS_XB), (const bf16*)(WL + W_IN) + (size_t)(P_DA + P_RW) * 1024, MP, P_GATE, kk_}; pg8::StaticOrder S; S.init(MP, P_GATE, F.G, (int)blockIdx.x);
        pg8::EpiGate E{SSP + (size_t)(2 * l) * MT, (bf16*)(F.ws + B_GATE)};
        pg8::gemm_phase<pg8::EpiGate, pg8::StaticOrder, true, true>(F.lds + RING_OFF, g, S, E);
        REOPAQUE(); mini_gate(F, (const bf16*)(F.ws + WS_XB), (const bf16*)(WL + W_IN) + (size_t)(P_DA + P_RW) * 1024, SSP + (size_t)(2 * l) * MT, (bf16*)(F.ws + B_GATE));
    } PH_END(P0 + K_CB)
    PH_BEGIN(P0 + K_M1) {
        int kk_ = 1024; asm volatile("" : "+s"(kk_)); pg8::Gemm g{(const bf16*)(F.ws + B_OA), (const bf16*)(WL + W_ODA), MP, 1024, kk_}; pg8::StaticOrder S; S.init(MP, 1024, F.G, (int)blockIdx.x);
        pg8::EpiGated E{(const bf16*)(F.ws + B_GATE), 0, nullptr, (bf16*)(F.ws + B_MRG)};
        pg8::gemm_phase<pg8::EpiGated, pg8::StaticOrder, true, true>(F.lds + RING_OFF, g, S, E);
        REOPAQUE(); mini_gated(F, (const bf16*)(F.ws + B_OA), (const bf16*)(WL + W_ODA), (const bf16*)(F.ws + B_GATE), 0, nullptr, (bf16*)(F.ws + B_MRG));
    } PH_END_NOBAR(P0 + K_M1)
    PH_BEGIN(P0 + K_M2) {
        int kk_ = 1024; asm volatile("" : "+s"(kk_)); pg8::Gemm g{(const bf16*)(F.ws + B_ORW), (const bf16*)(WL + W_ORW), MP, 1024, kk_}; pg8::StaticOrder S; S.init(MP, 1024, F.G, (int)blockIdx.x);
        pg8::EpiGated E{(const bf16*)(F.ws + B_GATE), 1024, (const bf16*)(F.ws + B_MRG), (bf16*)(F.ws + B_MRG)};
        pg8::gemm_phase<pg8::EpiGated, pg8::StaticOrder, true, true>(F.lds + RING_OFF, g, S, E);
        REOPAQUE(); mini_gated(F, (const bf16*)(F.ws + B_ORW), (const bf16*)(WL + W_ORW), (const bf16*)(F.ws + B_GATE), 1024, (const bf16*)(F.ws + B_MRG), (bf16*)(F.ws + B_MRG));
    } PH_END(P0 + K_M2)
    PH_BEGIN(P0 + K_WO) {
        int kk_ = 1024; asm volatile("" : "+s"(kk_)); pg8::Gemm g{(const bf16*)(F.ws + B_MRG), (const bf16*)(WL + W_OUT), MP, 1024, kk_}; pg8::StaticOrder S; S.init(MP, 1024, F.G, (int)blockIdx.x);
        pg8::EpiRes E{l == 0 ? GIN(ap, 0) : (const float*)(F.out + O_YP), F.out + O_YP, (bf16*)(F.ws + WS_XB), SSP + (size_t)(2 * l + 1) * MT};
        pg8::gemm_phase<pg8::EpiRes, pg8::StaticOrder, true, true>(F.lds + RING_OFF, g, S, E);
        REOPAQUE(); mini_res<8>(F, (const bf16*)(F.ws + B_MRG), (const bf16*)(WL + W_OUT), 1024, l == 0 ? GIN(ap, 1) : (const float*)(F.out + O_YP + (size_t)MP * 1024), F.out + O_YP, (bf16*)(F.ws + WS_XB), SSP + (size_t)(2 * l + 1) * MT);
    } PH_END(P0 + K_WO)
    PH_BEGIN(P0 + K_UP) {
        int kk_ = 1024; asm volatile("" : "+s"(kk_)); pg8::Gemm g{(const bf16*)(F.ws + WS_XB), (const bf16*)(WL + (l ? W_UP1 : W_UP)), pg8::UC_TILES * 256, UPW, kk_, pg8::UC_ROWS, -2};
        pg8::StaticOrder S; S.init(pg8::UC_TILES * 256, UPW, F.G, (int)blockIdx.x);
        pg8::EpiUpConv E{SSP + (size_t)(2 * l + 1) * MT, (bf16*)(F.ws + B_GT), GIN(ap, 27) + (size_t)l * 3 * UPW, GIN(ap, 28) + (size_t)l * UPW, (LAS float*)(F.lds + UC_HALO_OFF)};
        pg8::gemm_phase<pg8::EpiUpConv, pg8::StaticOrder, true, true>(F.lds + RING_OFF, g, S, E);
        REOPAQUE(); up_edge_rows(F, ap, l, (const bf16*)(F.ws + WS_XB), (const bf16*)(WL + (l ? W_UP1 : W_UP)), SSP + (size_t)(2 * l + 1) * MT, (bf16*)(F.ws + B_GT),
                                 F.out + O_CVP + (size_t)l * BATCH * 2 * UPW, F.out + O_CVS + (size_t)l * DEC_BATCH * 2 * UPW);
        if constexpr (l == 0) IDLE_CONVERT(pg8::UC_TILES * (UPW / 256), WP_IN | WP_SQ | WP_LORA);
    } PH_END(P0 + K_UP)
    PH_BEGIN(P0 + K_CV) { } PH_END_NOBAR(P0 + K_CV)
    PH_BEGIN(P0 + K_DN) {
        int kk_ = D_FF; asm volatile("" : "+s"(kk_)); pg8::Gemm g{(const bf16*)(F.ws + B_GT), (const bf16*)(l ? F.ws + WS_DN1 : WL + W_DN), MP, 1024, kk_}; pg8::StaticOrder S; S.init(MP, 1024, F.G, (int)blockIdx.x);
        pg8::EpiRes E{F.out + O_YP, F.out + O_YP, (bf16*)(F.ws + WS_XB), SSP + (size_t)(2 * l + 2) * MT};
        pg8::gemm_phase<pg8::EpiRes, pg8::StaticOrder, true, true>(F.lds + RING_OFF, g, S, E);
        REOPAQUE(); mini_res<11>(F, (const bf16*)(F.ws + B_GT), (const bf16*)(l ? F.ws + WS_DN1 : WL + W_DN), D_FF, F.out + O_YP + (size_t)MP * 1024, F.out + O_YP, (bf16*)(F.ws + WS_XB), SSP + (size_t)(2 * l + 2) * MT);
    } PH_END(P0 + K_DN)
#undef WL
#undef SSP
}

__global__ void __launch_bounds__(NWAVES * 64, 2) mk_fwd(Args args) {
    extern __shared__ __attribute__((aligned(16))) unsigned char lds[];
    Frame F;
    F.lds = (LAS unsigned char*)lds;
    F.MISC = (volatile LAS unsigned*)(F.lds + MISC_OFF);
    F.tid = threadIdx.x; F.lane = F.tid & 63; F.wave = __builtin_amdgcn_readfirstlane(F.tid >> 6);
    F.G = gridDim.x; { const int bx = blockIdx.x; F.vcu = (F.G % 8 == 0) ? (bx % 8) * (F.G / 8) + bx / 8 : bx; }
    F.out = (float*)args.out; F.ws = (unsigned char*)args.ws;
    F.ctl = (gu32*)(args.ws + WS_CTL);
    for (int u = F.tid; u < (LDS_BYTES - LDSCTL_OFF) / 4; u += NWAVES * 64) ((LAS unsigned*)(F.lds + LDSCTL_OFF))[u] = 0u;
    __syncthreads();
    XcdBarrier bar; bar.bar = (unsigned*)(F.ctl + CW_BAR); bar.x = 0; bar.st = nullptr;
    if (!MK_PER_PHASE) bar = xcd_barrier_post((unsigned*)(F.ctl + CW_BAR), F.MISC + 8);
    const int lo = args.ph_lo, hi = args.ph_hi;
    CArgsP ap;
    PH_BEGIN(0) { p0_prologue(F, ap); } PH_END(0)
    layer_phases<0>(F, ap, bar, lo, hi);
    layer_phases<1>(F, ap, bar, lo, hi);
    PH_BEGIN(NPHASE - 1) { ph_final(F, ap); } PH_END(NPHASE - 1)
    if (MK_PROBE_MASK) { __syncthreads(); if (threadIdx.x == 0) { const unsigned t0 = (unsigned)rt(), dt = F.MISC[13] * MK_PROBE_AMP; while ((unsigned)rt() - t0 < dt) __builtin_amdgcn_s_sleep(8); } __syncthreads(); }
}

extern "C" void kernel_launch(void* const* d_in, const int* in_sizes, int n_in, void* d_out, int out_size, void* d_ws, size_t ws_size, hipStream_t stream) {
    (void)in_sizes;
    static int grid = 0;
    if (grid == 0) {
        if (n_in != 31 || out_size != (int)O_END || ws_size < B_END2) { fprintf(stderr, "kernel_launch: unexpected shapes (n_in %d out %d ws %zu)\n", n_in, out_size, ws_size); grid = -1; return; }
        int dev = 0, cus = 0;
        if (hipGetDevice(&dev) != hipSuccess || hipDeviceGetAttribute(&cus, hipDeviceAttributeMultiprocessorCount, dev) != hipSuccess) { grid = -1; return; }
        if (hipFuncSetAttribute((const void*)mk_fwd, hipFuncAttributeMaxDynamicSharedMemorySize, LDS_BYTES) != hipSuccess) { fprintf(stderr, "kernel_launch: hipFuncSetAttribute failed\n"); grid = -1; return; }
        (void)hipGetLastError();
        grid = cus;
    }
    if (grid < 0) return;
    if (hipMemsetAsync((char*)d_ws + WS_CTL, 0, CTL_ZERO_BYTES, stream) != hipSuccess) { fprintf(stderr, "kernel_launch: memset failed\n"); return; }
    Args a{};
    for (int i = 0; i < 31; ++i) a.in[i] = (const GAS float*)d_in[i];
    a.out = (GAS float*)d_out; a.ws = (GAS unsigned char*)d_ws;
    for (int i = 0; i < 8; ++i) a.rinv[i] = (float)pow(500000.0, -(double)i / 8.0);
#if MK_PER_PHASE
    for (int p = 0; p < NPHASE; ++p) { a.ph_lo = p; a.ph_hi = p + 1; hipLaunchKernelGGL(mk_fwd, dim3(grid), dim3(NWAVES * 64), LDS_BYTES, stream, a); }
#else
    a.ph_lo = 0; a.ph_hi = NPHASE;
    hipLaunchKernelGGL(mk_fwd, dim3(grid), dim3(NWAVES * 64), LDS_BYTES, stream, a);
#endif
    const hipError_t le = hipPeekAtLastError();
    if (le != hipSuccess) fprintf(stderr, "kernel_launch: launch failed: %s\n", hipGetErrorName(le));
}
```

```cpp
#include <hip/hip_runtime.h>
#include <cstdio>
#include <cstdint>
#include <cmath>

#ifndef MK_PER_PHASE
#define MK_PER_PHASE 0
#endif

constexpr int D_MODEL = 1024, BATCH = 8, SEQ = 2048, DEPTH = 2, DEC_BATCH = 8, DEC_SEQ = 32, PAST_LEN = 2048;
constexpr float EPS = 1e-6f, GN_EPS = 64e-5f;
constexpr int DA_HEADS = 8, RW_HEADS = 16;
constexpr int D_FF = 2816, UPW = 2 * D_FF;
constexpr int P_DA = 3072, P_RW = 3328, P_GATE = 2048, P_TOTAL = 8448;
constexpr int MP = BATCH * SEQ, MS = DEC_BATCH * DEC_SEQ, MT = MP + MS;
constexpr int NKEYS_S = PAST_LEN + DEC_SEQ;
constexpr float C2 = 0.125f * 1.4426950408889634f;

constexpr size_t O_YP = 0;
constexpr size_t O_YS = O_YP + (size_t)MP * D_MODEL;
constexpr size_t O_KP = O_YS + (size_t)MS * D_MODEL;
constexpr size_t O_VP = O_KP + (size_t)DEPTH * MP * 1024;
constexpr size_t O_WKVP = O_VP + (size_t)DEPTH * MP * 1024;
constexpr size_t O_SHP = O_WKVP + (size_t)DEPTH * BATCH * RW_HEADS * 64 * 64;
constexpr size_t O_CVP = O_SHP + (size_t)DEPTH * BATCH * P_RW;
constexpr size_t O_KS = O_CVP + (size_t)DEPTH * BATCH * 2 * UPW;
constexpr size_t O_VS = O_KS + (size_t)DEPTH * MS * 1024;
constexpr size_t O_WKVS = O_VS + (size_t)DEPTH * MS * 1024;
constexpr size_t O_SHS = O_WKVS + (size_t)DEPTH * DEC_BATCH * RW_HEADS * 64 * 64;
constexpr size_t O_CVS = O_SHS + (size_t)DEPTH * DEC_BATCH * P_RW;
constexpr size_t O_END = O_CVS + (size_t)DEPTH * DEC_BATCH * 2 * UPW;
static_assert(O_END == 87760896, "output size");

namespace pg8 {
#define PG8_LAS __attribute__((address_space(3)))
typedef unsigned short bf16_t;
typedef short bf16x8 __attribute__((ext_vector_type(8)));
typedef float f32x4 __attribute__((ext_vector_type(4)));
typedef unsigned u32x4 __attribute__((ext_vector_type(4)));
constexpr int BM = 256, BK = 64, HALF = 128, HTB = HALF * BK * 2  , STAGE_BYTES = 8 * HTB, NXCD = 8, WGM = 8;

__host__ __device__ __forceinline__ int lds_byte(int r, int c) { const int st = (r >> 4) * 2 + (c >> 5), rr = r & 15, cc = c & 31, ob = rr * 64 + cc * 2; return st * 1024 + (ob ^ (((ob >> 9) & 1) << 5)); }
__host__ __device__ __forceinline__ void stage_rc(int b, int& R, int& C) { const int st = b / 1024, sb = b % 1024, swz = sb ^ (((sb >> 9) & 1) << 5); R = (st >> 1) * 16 + swz / 64; C = (st & 1) * 32 + (swz % 64) / 2; }
__host__ __device__ __forceinline__ int perm32(int rho) { const int n = rho >> 4, i = rho & 15; return 8 * (i >> 2) + 4 * n + (i & 3); }

struct Unit { int pm, pn; };
struct Gemm { const bf16_t* A; const bf16_t* Bt; int M, N, K; int a_rows = 256, a_row0 = 0; };

struct StaticOrder {
    int nM, nN, nwg, G, c;
    __host__ __device__ void init(int M, int N, int G_, int c_) { nM = M / BM; nN = N / BM; nwg = nM * nN; G = G_; c = c_; }
    __host__ __device__ bool next(int i, Unit& u) const {
        const long L = (long)i * G + c; if (L >= nwg) return false;
        int wgid = (int)L; { const int q = nwg / NXCD, r = nwg % NXCD, xcd = wgid % NXCD, off = wgid / NXCD; wgid = (xcd < r ? xcd * (q + 1) : r * (q + 1) + (xcd - r) * q) + off; }
        const int nig = WGM * nN, gid = wgid / nig, fm = gid * WGM, gsz = (nM - fm) < WGM ? (nM - fm) : WGM;
        u.pm = fm + ((wgid % nig) % gsz); u.pn = (wgid % nig) / gsz; return true;
    }
    __device__ __forceinline__ void a_ready(const Unit&) const {}
    __device__ __forceinline__ void done(const Unit&) const {}
};

typedef float f32x2_cv __attribute__((ext_vector_type(2))); typedef __bf16 bf16x2_cv __attribute__((ext_vector_type(2)));
__device__ __forceinline__ unsigned cvt_pk_bf16(float lo, float hi) { const f32x2_cv v = {lo, hi}; const bf16x2_cv b = __builtin_convertvector(v, bf16x2_cv); return __builtin_bit_cast(unsigned, b); }
typedef float f32x2 __attribute__((ext_vector_type(2)));
__device__ __forceinline__ float bf2f(unsigned short h) { return __uint_as_float((unsigned)h << 16); }
__device__ __forceinline__ float fast_sigmoid(float x) { return __builtin_amdgcn_rcpf(1.0f + __builtin_amdgcn_exp2f(-1.4426950408889634f * x)); }
__device__ __forceinline__ float neg_decay_log(float x) {
    const float y = -x, sp = fmaxf(y, 0.f) + 0.6931471805599453f * __builtin_amdgcn_logf(1.0f + __builtin_amdgcn_exp2f(-1.4426950408889634f * fabsf(y)));
    return -__builtin_amdgcn_exp2f(-1.4426950408889634f * (sp + 0.5f));
}
__device__ __forceinline__ u32x4 pack8(const f32x4 v0, const f32x4 v1) { u32x4 w; w.x = cvt_pk_bf16(v0[0], v0[1]); w.y = cvt_pk_bf16(v0[2], v0[3]); w.z = cvt_pk_bf16(v1[0], v1[1]); w.w = cvt_pk_bf16(v1[2], v1[3]); return w; }
__device__ __forceinline__ void unpack8(const u32x4 w, f32x4& v0, f32x4& v1) {
    v0[0] = __uint_as_float(w.x << 16); v0[1] = __uint_as_float(w.x & 0xffff0000u); v0[2] = __uint_as_float(w.y << 16); v0[3] = __uint_as_float(w.y & 0xffff0000u);
    v1[0] = __uint_as_float(w.z << 16); v1[1] = __uint_as_float(w.z & 0xffff0000u); v1[2] = __uint_as_float(w.w << 16); v1[3] = __uint_as_float(w.w & 0xffff0000u);
}
constexpr int E_MP = 16384, E_MS = 256;

struct EpiIn {
    static constexpr bool PERM = true, AFTER_DRAIN = false, PERM_A = false;
    const float* ss; const float* rope;
    bf16_t *Q, *K, *V, *URW;
    float *kout_p, *vout_p, *kout_s, *vout_s;
    float *sh_p, *sh_s;
    __device__ __forceinline__ void operator()(const f32x4 (&acc)[2][2][4][2], const Unit& u, int wr, int wc, int fr, int fq) const {
        const int pn = u.pn, rowb = u.pm * BM + wr * 64 + fr, cl = wc * 32 + 8 * fq;
        const bool rope_wave = (pn < 8) && ((wc & 1) == 0);
        const float sgn = (fq == 0) ? -1.f : 1.f;
#pragma unroll
        for (int ai = 0; ai < 2; ++ai)
#pragma unroll
            for (int m = 0; m < 4; ++m) {
                const int row = rowb + ai * HALF + m * 16;
                const float rstd = 1.0f / sqrtf(ss[row] * (1.0f / 1024.f) + 1e-6f);
                const bool smp = row >= E_MP;
                const int t = smp ? ((row - E_MP) & 31) : (row & 2047);
                const int bb = smp ? ((row - E_MP) >> 5) : (row >> 11);
                const int pos = smp ? 2048 + t : t;
                const bool last = smp ? (t == 31) : (t == 2047);
#pragma unroll
                for (int bj = 0; bj < 2; ++bj) {
                    f32x4 v0 = acc[ai][bj][m][0] * rstd, v1 = acc[ai][bj][m][1] * rstd;
                    const int col = pn * BM + bj * HALF + cl;
                    if (pn < 8) {
                        if (rope_wave) {
                            f32x4 p0, p1;
#pragma unroll
                            for (int j = 0; j < 4; ++j) { p0[j] = __shfl_xor(v0[j], 16); p1[j] = __shfl_xor(v1[j], 16); }
                            if (fq < 2) {
                                const float* tb = rope + pos * 16;
                                const f32x4 c0 = *(const f32x4*)(tb), c1 = *(const f32x4*)(tb + 4), s0 = *(const f32x4*)(tb + 8), s1 = *(const f32x4*)(tb + 12);
                                v0 = v0 * c0 + (p0 * s0) * sgn; v1 = v1 * c1 + (p1 * s1) * sgn;
                            }
                        }
                        if (pn < 4) { v0 = v0 * C2; v1 = v1 * C2; *(u32x4*)(Q + (size_t)row * 1024 + col) = pack8(v0, v1); }
                        else {
                            const int c = col - 1024;
                            *(u32x4*)(K + (size_t)row * 1024 + c) = pack8(v0, v1);
                            float* o = smp ? kout_s + (size_t)(row - E_MP) * 1024 + c : kout_p + (size_t)row * 1024 + c;
                            *(f32x4*)o = v0; *(f32x4*)(o + 4) = v1;
                        }
                    } else if (pn < 12) {
                        const int c = col - 2048;
                        *(u32x4*)(V + (size_t)row * 1024 + c) = pack8(v0, v1);
                        float* o = smp ? vout_s + (size_t)(row - E_MP) * 1024 + c : vout_p + (size_t)row * 1024 + c;
                        *(f32x4*)o = v0; *(f32x4*)(o + 4) = v1;
                    } else {
                        const int c = col - 3072;
                        *(u32x4*)(URW + (size_t)row * 3328 + c) = pack8(v0, v1);
                        if (last) { float* o = (smp ? sh_s : sh_p) + (size_t)bb * 3328 + c; *(f32x4*)o = v0; *(f32x4*)(o + 4) = v1; }
                    }
                }
            }
    }
};

struct EpiGate {
    static constexpr bool PERM = true, AFTER_DRAIN = false, PERM_A = false;
    const float* ss; bf16_t* GATE;
    __device__ __forceinline__ void operator()(const f32x4 (&acc)[2][2][4][2], const Unit& u, int wr, int wc, int fr, int fq) const {
        const int rowb = u.pm * BM + wr * 64 + fr, cl = u.pn * BM + wc * 32 + 8 * fq;
#pragma unroll
        for (int ai = 0; ai < 2; ++ai)
#pragma unroll
            for (int m = 0; m < 4; ++m) {
                const int row = rowb + ai * HALF + m * 16;
                const float rstd = 1.0f / sqrtf(ss[row] * (1.0f / 1024.f) + 1e-6f);
#pragma unroll
                for (int bj = 0; bj < 2; ++bj) {
                    f32x4 v0 = acc[ai][bj][m][0] * rstd, v1 = acc[ai][bj][m][1] * rstd;
#pragma unroll
                    for (int j = 0; j < 4; ++j) { v0[j] = fast_sigmoid(v0[j]); v1[j] = fast_sigmoid(v1[j]); }
                    *(u32x4*)(GATE + (size_t)row * 2048 + cl + bj * HALF) = pack8(v0, v1);
                }
            }
    }
};

struct EpiGated {
    static constexpr bool PERM = true, AFTER_DRAIN = false, PERM_A = false;
    const bf16_t* G; int goff; const bf16_t* S; bf16_t* O;
    __device__ __forceinline__ void operator()(const f32x4 (&acc)[2][2][4][2], const Unit& u, int wr, int wc, int fr, int fq) const {
        const int rowb = u.pm * BM + wr * 64 + fr, cl = u.pn * BM + wc * 32 + 8 * fq;
#pragma unroll
        for (int ai = 0; ai < 2; ++ai)
#pragma unroll
            for (int m = 0; m < 4; ++m) {
                const int row = rowb + ai * HALF + m * 16;
#pragma unroll
                for (int bj = 0; bj < 2; ++bj) {
                    const int c = cl + bj * HALF;
                    f32x4 g0, g1; unpack8(*(const u32x4*)(G + (size_t)row * 2048 + goff + c), g0, g1);
                    f32x4 v0 = acc[ai][bj][m][0] * g0, v1 = acc[ai][bj][m][1] * g1;
                    if (S) { f32x4 s0, s1; unpack8(*(const u32x4*)(S + (size_t)row * 1024 + c), s0, s1); v0 += s0; v1 += s1; }
                    *(u32x4*)(O + (size_t)row * 1024 + c) = pack8(v0, v1);
                }
            }
    }
};

struct EpiRes {
    static constexpr bool PERM = true, AFTER_DRAIN = false, PERM_A = false;
    const float* Xr; float* X; bf16_t* XB; float* SS;
    __device__ __forceinline__ void operator()(const f32x4 (&acc)[2][2][4][2], const Unit& u, int wr, int wc, int fr, int fq) const {
        const int rowb = u.pm * BM + wr * 64 + fr, cl = u.pn * BM + wc * 32 + 8 * fq;
#pragma unroll
        for (int ai = 0; ai < 2; ++ai)
#pragma unroll
            for (int m = 0; m < 4; ++m) {
                const int row = rowb + ai * HALF + m * 16;
                float sq = 0.f;
#pragma unroll
                for (int bj = 0; bj < 2; ++bj) {
                    const int c = cl + bj * HALF;
                    float* xp = X + (size_t)row * 1024 + c; const float* xq = Xr + (size_t)row * 1024 + c;
                    const f32x4 v0 = *(const f32x4*)xq + acc[ai][bj][m][0], v1 = *(const f32x4*)(xq + 4) + acc[ai][bj][m][1];
                    *(f32x4*)xp = v0; *(f32x4*)(xp + 4) = v1;
                    *(u32x4*)(XB + (size_t)row * 1024 + c) = pack8(v0, v1);
                    sq += (v0[0] * v0[0] + v0[1] * v0[1]) + (v0[2] * v0[2] + v0[3] * v0[3]) + (v1[0] * v1[0] + v1[1] * v1[1]) + (v1[2] * v1[2] + v1[3] * v1[3]);
                }
                sq += __shfl_xor(sq, 16); sq += __shfl_xor(sq, 32);
                if (fq == 0) atomicAdd(SS + row, sq);
            }
    }
};

constexpr int E_MT = 16640, E_DFF = 2816, UC_ROWS = 254, UC_TILES = 66;
__device__ __forceinline__ float silu_mul(float a, float g) { return a * __builtin_amdgcn_rcpf(1.0f + __builtin_amdgcn_exp2f(-1.4426950408889634f * a)) * g; }
__device__ __forceinline__ float dpp_shr1s(float v, float lane0) { return __builtin_bit_cast(float, __builtin_amdgcn_update_dpp(__builtin_bit_cast(int, lane0), __builtin_bit_cast(int, v), 0x111, 0xF, 0xF, false)); }
__device__ __forceinline__ f32x4 dpp_shr1(const f32x4 v, const f32x4 lane0) { f32x4 r; r.x = dpp_shr1s(v.x, lane0.x); r.y = dpp_shr1s(v.y, lane0.y); r.z = dpp_shr1s(v.z, lane0.z); r.w = dpp_shr1s(v.w, lane0.w); return r; }
struct EpiUpConv {
    static constexpr bool PERM = true, AFTER_DRAIN = false, PERM_A = true;
    const float* ss; bf16_t* GT; const float *cw, *cb; PG8_LAS float* halo;
    template <int ai, int bj, int n> __device__ __forceinline__ void conv_cols(f32x4 (&x)[2][2][4][2], const int wid, const int wr, int fq, const int cb0) const {
        asm volatile("" : "+v"(fq));
        const int ca = cb0 + 8 * fq, col = bj * E_DFF + ca + 4 * n;
        const f32x4 w0 = *(const f32x4*)(cw + col), w1 = *(const f32x4*)(cw + 5632 + col), w2 = *(const f32x4*)(cw + 2 * 5632 + col), bi = *(const f32x4*)(cb + col);
        f32x4 h1 = (f32x4){0.f, 0.f, 0.f, 0.f}, h2 = h1;
        if (wr == 1 || ai == 1) { const int pw = wr ? wid - 4 : wid + 4, pai = wr ? ai : 0;
            const PG8_LAS float* hp = halo + ((((pw * 2 + pai) * 2 + 0) * 2 + bj) * 32 + fq * 8 + 4 * n);
            h2 = *(const PG8_LAS f32x4*)hp; h1 = *(const PG8_LAS f32x4*)(hp + 64); }
        const f32x4 a0 = x[ai][bj][0][n], a1 = x[ai][bj][1][n], a2 = x[ai][bj][2][n], a3 = x[ai][bj][3][n];
        const f32x4 vm1 = dpp_shr1(a3, h1), vm2 = dpp_shr1(a2, h2);
        x[ai][bj][3][n] = bi + a1 * w0 + a2 * w1 + a3 * w2;
        x[ai][bj][2][n] = bi + a0 * w0 + a1 * w1 + a2 * w2;
        x[ai][bj][1][n] = bi + vm1 * w0 + a0 * w1 + a1 * w2;
        x[ai][bj][0][n] = bi + vm2 * w0 + vm1 * w1 + a0 * w2;
    }
    template <int ai> __device__ __forceinline__ void block_out(f32x4 (&x)[2][2][4][2], const Unit& u, const int wid, const int wr, const int wc, int fr, int fq, const int R0) const {
        const int cb0 = 128 * u.pn + wc * 32;
        conv_cols<ai, 0, 0>(x, wid, wr, fq, cb0); conv_cols<ai, 0, 1>(x, wid, wr, fq, cb0); conv_cols<ai, 1, 0>(x, wid, wr, fq, cb0); conv_cols<ai, 1, 1>(x, wid, wr, fq, cb0);
        asm volatile("" : "+v"(fr), "+v"(fq));
        const int lrb = wr * 64 + 4 * fr, ca = cb0 + 8 * fq;
#pragma unroll
        for (int m = 0; m < 4; ++m) {
            const int lr = lrb + ai * HALF + m, row = R0 + lr;
            const int tq = (row >= E_MP) ? ((row - E_MP) & 31) : (row & 2047);
            if (lr >= 2 && (unsigned)row < (unsigned)E_MT && tq >= 2) {
                f32x4 g0, g1;
                g0.x = silu_mul(x[ai][0][m][0].x, x[ai][1][m][0].x); g0.y = silu_mul(x[ai][0][m][0].y, x[ai][1][m][0].y); g0.z = silu_mul(x[ai][0][m][0].z, x[ai][1][m][0].z); g0.w = silu_mul(x[ai][0][m][0].w, x[ai][1][m][0].w);
                g1.x = silu_mul(x[ai][0][m][1].x, x[ai][1][m][1].x); g1.y = silu_mul(x[ai][0][m][1].y, x[ai][1][m][1].y); g1.z = silu_mul(x[ai][0][m][1].z, x[ai][1][m][1].z); g1.w = silu_mul(x[ai][0][m][1].w, x[ai][1][m][1].w);
                *(u32x4*)(GT + (size_t)row * E_DFF + ca) = pack8(g0, g1);
            }
        }
    }
    __device__ __forceinline__ void operator()(f32x4 (&x)[2][2][4][2], const Unit& u, int wr, int wc, int fr, int fq) const {
        asm volatile("" : "+v"(fr), "+v"(fq), "+s"(wr), "+s"(wc));
        const int wid = wr * 4 + wc, R0 = UC_ROWS * u.pm - 2, lrb = wr * 64 + 4 * fr, ca = 128 * u.pn + wc * 32 + 8 * fq;
#pragma unroll
        for (int ai = 0; ai < 2; ++ai)
#pragma unroll
            for (int m = 0; m < 4; ++m) {
                const int lr = lrb + ai * HALF + m, row = R0 + lr;
                const bool valid = (unsigned)row < (unsigned)E_MT;
                const float rstd = valid ? __builtin_amdgcn_rsqf(ss[valid ? row : 0] * (1.0f / 1024.f) + 1e-6f) : 0.f;
#pragma unroll
                for (int bj = 0; bj < 2; ++bj) { x[ai][bj][m][0] = x[ai][bj][m][0] * rstd; x[ai][bj][m][1] = x[ai][bj][m][1] * rstd; }
            }
        if (fr == 15) {
#pragma unroll
            for (int ai = 0; ai < 2; ++ai)
#pragma unroll
                for (int rr = 0; rr < 2; ++rr)
#pragma unroll
                    for (int bj = 0; bj < 2; ++bj) { PG8_LAS float* hp = halo + ((((wid * 2 + ai) * 2 + rr) * 2 + bj) * 32 + fq * 8);
                        *(PG8_LAS f32x4*)hp = x[ai][bj][2 + rr][0]; *(PG8_LAS f32x4*)(hp + 4) = x[ai][bj][2 + rr][1]; }
        }
        asm volatile("s_waitcnt lgkmcnt(0)" ::: "memory"); __builtin_amdgcn_s_barrier(); asm volatile("" ::: "memory");
        unsigned xp[2][4][4];
#pragma unroll
        for (int bj = 0; bj < 2; ++bj)
#pragma unroll
            for (int m = 0; m < 4; ++m) { const u32x4 w = pack8(x[1][bj][m][0], x[1][bj][m][1]); xp[bj][m][0] = w.x; xp[bj][m][1] = w.y; xp[bj][m][2] = w.z; xp[bj][m][3] = w.w; }
        asm volatile("" ::: "memory");
        block_out<0>(x, u, wid, wr, wc, fr, fq, R0);
        asm volatile("" ::: "memory");
#pragma unroll
        for (int bj = 0; bj < 2; ++bj)
#pragma unroll
            for (int m = 0; m < 4; ++m) { u32x4 w; w.x = xp[bj][m][0]; w.y = xp[bj][m][1]; w.z = xp[bj][m][2]; w.w = xp[bj][m][3]; unpack8(w, x[1][bj][m][0], x[1][bj][m][1]); }
        block_out<1>(x, u, wid, wr, wc, fr, fq, R0);
    }
};

template <class Epi, class Sched, bool ALIGN_EPI = false, bool SP2 = false>
__device__ __forceinline__ void gemm_phase(PG8_LAS unsigned char* lds, const Gemm g, const Sched& S, const Epi& E) {
    int tid_ = threadIdx.x; asm volatile("" : "+v"(tid_));
    const int tid = tid_, wid = __builtin_amdgcn_readfirstlane(tid >> 6), lane = tid & 63, wr = wid >> 2, wc = wid & 3, fr = lane & 15, fq = lane >> 4;
    const int K = g.K, nt = K / BK;
    unsigned voffA[2], voffB[2];
#define PG8_VOFF(tv) do { _Pragma("unroll") for (int i = 0; i < 2; ++i) { int R, C; stage_rc((tv) * 16 + i * 8192, R, C); const int Rb = Epi::PERM ? ((R & ~31) + perm32(R & 31)) : R; \
        const int Ra = Epi::PERM_A ? ((R & ~63) + 4 * (R & 15) + ((R >> 4) & 3)) : R;     \
        voffA[i] = (unsigned)(Ra * K + C) * 2u; voffB[i] = (unsigned)(Rb * K + C) * 2u; } } while (0)
    PG8_VOFF(tid);
    const size_t kstep = (size_t)(BK * 2);
    const size_t hstep = (size_t)HALF * K * 2;
    const size_t tstep = 2 * hstep;
    const unsigned ldsw = (unsigned)wid * 1024u;
    int aoff = lds_byte(wr * 64 + fr, fq * 8), boff = lds_byte(wc * 32 + fr, fq * 8);
#define PG8_SA(b, h) (((b) * 2 + (h)) * HTB)
#define PG8_SB(b, h) ((4 + (b) * 2 + (h)) * HTB)
#define PG8_STAGE(bufoff, gbase, voff) do { _Pragma("unroll") for (int _i = 0; _i < 2; ++_i) \
        __builtin_amdgcn_global_load_lds((const unsigned*)((const char*)(gbase) + (voff)[_i]), (PG8_LAS unsigned*)(lds + (bufoff) + ldsw + _i * 8192), 16, 0, 0); } while (0)
#define PG8_LDA(dst, b, h) do { _Pragma("unroll") for (int m = 0; m < 4; ++m) _Pragma("unroll") for (int k = 0; k < 2; ++k) dst[m][k] = *(const PG8_LAS bf16x8*)(lds + PG8_SA(b, h) + aoff + m * 2048 + k * 1024); } while (0)
#define PG8_LDB(dst, b, h) do { _Pragma("unroll") for (int n = 0; n < 2; ++n) _Pragma("unroll") for (int k = 0; k < 2; ++k) dst[n][k] = *(const PG8_LAS bf16x8*)(lds + PG8_SB(b, h) + boff + n * 2048 + k * 1024); } while (0)
#define PG8_MMA(ai, bj, At, Bt) do { __builtin_amdgcn_s_setprio(1); _Pragma("unroll") for (int m = 0; m < 4; ++m) _Pragma("unroll") for (int n = 0; n < 2; ++n) _Pragma("unroll") for (int k = 0; k < 2; ++k) \
        acc[ai][bj][m][n] = __builtin_amdgcn_mfma_f32_16x16x32_bf16(Bt[n][k], At[m][k], acc[ai][bj][m][n], 0, 0, 0); __builtin_amdgcn_s_setprio(0); } while (0)
#define PG8_WAIT_V(n) asm volatile("s_waitcnt vmcnt(" #n ")" ::: "memory")
#define PG8_WAIT_L(n) asm volatile("s_waitcnt lgkmcnt(" #n ")" ::: "memory")
#define PG8_BAR __builtin_amdgcn_s_barrier()
#define PG8_SCHED __builtin_amdgcn_sched_barrier(0)
    Unit cur, nxt; int ui = 0;
    if (!S.next(0, cur)) return;
    f32x4 acc[2][2][4][2];
#pragma unroll
    for (int a = 0; a < 2; ++a)
#pragma unroll
        for (int b = 0; b < 2; ++b)
#pragma unroll
            for (int m = 0; m < 4; ++m)
#pragma unroll
                for (int n = 0; n < 2; ++n) acc[a][b][m][n] = (f32x4){0.f, 0.f, 0.f, 0.f};
    bf16x8 At[4][2], B0[2][2], B1[2][2];
    const long arow = (long)K * 2;
    const char* cA = (const char*)g.A + ((long)cur.pm * g.a_rows + g.a_row0) * arow; const char* cB = (const char*)g.Bt + (size_t)cur.pn * tstep;
    S.a_ready(cur);
    if constexpr (SP2) {
        PG8_STAGE(PG8_SB(0, 0), cB, voffB); PG8_STAGE(PG8_SB(0, 1), cB + hstep, voffB); PG8_STAGE(PG8_SA(0, 0), cA, voffA); PG8_STAGE(PG8_SA(0, 1), cA + hstep, voffA);
        if (wr == 1) PG8_BAR;
        PG8_WAIT_V(2); PG8_BAR;
        PG8_STAGE(PG8_SB(1, 0), cB + kstep, voffB); PG8_STAGE(PG8_SA(1, 0), cA + kstep, voffA); PG8_STAGE(PG8_SB(1, 1), cB + hstep + kstep, voffB);
        PG8_WAIT_V(6); PG8_BAR;
    } else {
        PG8_STAGE(PG8_SB(0, 0), cB, voffB); PG8_STAGE(PG8_SA(0, 0), cA, voffA); PG8_STAGE(PG8_SB(0, 1), cB + hstep, voffB); PG8_STAGE(PG8_SA(0, 1), cA + hstep, voffA);
        if (wr == 1) PG8_BAR;
        PG8_WAIT_V(4); PG8_BAR;
        PG8_STAGE(PG8_SB(1, 0), cB + kstep, voffB); PG8_STAGE(PG8_SA(1, 0), cA + kstep, voffA); PG8_STAGE(PG8_SB(1, 1), cB + hstep + kstep, voffB);
        PG8_WAIT_V(6); PG8_BAR;
    }
    for (;;) {
        const bool has_next = S.next(ui + 1, nxt);
        const char* nA = has_next ? (const char*)g.A + ((long)nxt.pm * g.a_rows + g.a_row0) * arow : cA; const char* nB = has_next ? (const char*)g.Bt + (size_t)nxt.pn * tstep : cB;
        for (int t = 0; t < nt; t += 2) {
            const bool last = (t == nt - 2);
            const char* a1 = cA + (size_t)(t + 1) * kstep;
            const char* a2 = last ? nA : cA + (size_t)(t + 2) * kstep; const char* b2 = last ? nB : cB + (size_t)(t + 2) * kstep;
            const char* a3 = a2 + kstep; const char* b3 = b2 + kstep;
            if (last && has_next) S.a_ready(nxt);
            if constexpr (SP2) {
            PG8_LDB(B0, 0, 0); PG8_LDB(B1, 0, 1); PG8_SCHED; PG8_LDA(At, 0, 0); PG8_STAGE(PG8_SA(1, 1), a1 + hstep, voffA);
            PG8_WAIT_V(8); PG8_WAIT_L(0); PG8_BAR; PG8_MMA(0, 0, At, B0); PG8_MMA(0, 1, At, B1); PG8_BAR; PG8_SCHED;
            PG8_LDA(At, 0, 1); PG8_STAGE(PG8_SB(0, 0), b2, voffB); PG8_STAGE(PG8_SB(0, 1), b2 + hstep, voffB); PG8_STAGE(PG8_SA(0, 0), a2, voffA);
            PG8_WAIT_V(8); PG8_WAIT_L(0); PG8_BAR; PG8_MMA(1, 0, At, B0); PG8_MMA(1, 1, At, B1); PG8_BAR; PG8_SCHED;
            PG8_LDB(B0, 1, 0); PG8_LDB(B1, 1, 1); PG8_SCHED; PG8_LDA(At, 1, 0); PG8_STAGE(PG8_SA(0, 1), a2 + hstep, voffA);
            PG8_WAIT_V(8); PG8_WAIT_L(0); PG8_BAR; PG8_MMA(0, 0, At, B0); PG8_MMA(0, 1, At, B1); PG8_BAR; PG8_SCHED;
            PG8_LDA(At, 1, 1); PG8_STAGE(PG8_SB(1, 0), b3, voffB); PG8_STAGE(PG8_SB(1, 1), b3 + hstep, voffB); PG8_STAGE(PG8_SA(1, 0), a3, voffA);
            PG8_WAIT_V(8); PG8_WAIT_L(0); PG8_BAR; PG8_MMA(1, 0, At, B0); PG8_MMA(1, 1, At, B1); PG8_BAR; PG8_SCHED;
            } else {
            PG8_LDB(B0, 0, 0); PG8_SCHED; PG8_LDA(At, 0, 0); PG8_STAGE(PG8_SA(1, 1), a1 + hstep, voffA);
            PG8_WAIT_L(8); PG8_BAR; PG8_WAIT_L(0); PG8_MMA(0, 0, At, B0); PG8_BAR; PG8_SCHED;
            PG8_LDB(B1, 0, 1); PG8_STAGE(PG8_SB(0, 0), b2, voffB);
            PG8_BAR; PG8_WAIT_L(0); PG8_MMA(0, 1, At, B1); PG8_BAR;
            PG8_LDA(At, 0, 1); PG8_STAGE(PG8_SA(0, 0), a2, voffA);
            PG8_BAR; PG8_WAIT_L(0); PG8_MMA(1, 0, At, B0); PG8_BAR; PG8_SCHED;
            PG8_STAGE(PG8_SB(0, 1), b2 + hstep, voffB);
            PG8_WAIT_V(6); PG8_BAR; PG8_MMA(1, 1, At, B1); PG8_BAR;
            PG8_LDB(B0, 1, 0); PG8_SCHED; PG8_LDA(At, 1, 0); PG8_STAGE(PG8_SA(0, 1), a2 + hstep, voffA);
            PG8_WAIT_L(8); PG8_BAR; PG8_WAIT_L(0); PG8_MMA(0, 0, At, B0); PG8_BAR; PG8_SCHED;
            PG8_LDB(B1, 1, 1); PG8_STAGE(PG8_SB(1, 0), b3, voffB);
            PG8_BAR; PG8_WAIT_L(0); PG8_MMA(0, 1, At, B1); PG8_BAR;
            PG8_LDA(At, 1, 1); PG8_STAGE(PG8_SA(1, 0), a3, voffA);
            PG8_BAR; PG8_WAIT_L(0); PG8_MMA(1, 0, At, B0); PG8_BAR; PG8_SCHED;
            PG8_STAGE(PG8_SB(1, 1), b3 + hstep, voffB);
            PG8_WAIT_V(6); PG8_BAR; PG8_MMA(1, 1, At, B1); PG8_BAR;
            }
        }
        if constexpr (ALIGN_EPI) { if (wr == 0) PG8_BAR; }
        if constexpr (Epi::PERM_A) {
            { int tv_ = threadIdx.x; asm volatile("" : "+v"(tv_)); const int ln_ = tv_ & 63; E(acc, cur, wr, wc, ln_ & 15, ln_ >> 4); S.done(cur); }
            { int tv_ = threadIdx.x; asm volatile("" : "+v"(tv_)); PG8_VOFF(tv_); const int ln_ = tv_ & 63, fr_ = ln_ & 15, fq_ = ln_ >> 4; aoff = lds_byte(wr * 64 + fr_, fq_ * 8); boff = lds_byte(wc * 32 + fr_, fq_ * 8); }
        } else
        if constexpr (!Epi::AFTER_DRAIN) { E(acc, cur, wr, wc, fr, fq); S.done(cur); }
        if (!has_next) break;
#pragma unroll
        for (int a = 0; a < 2; ++a)
#pragma unroll
            for (int b = 0; b < 2; ++b)
#pragma unroll
                for (int m = 0; m < 4; ++m)
#pragma unroll
                    for (int n = 0; n < 2; ++n) acc[a][b][m][n] = (f32x4){0.f, 0.f, 0.f, 0.f};
        cur = nxt; cA = nA; cB = nB; ++ui;
        if constexpr (ALIGN_EPI) { if (wr == 1) PG8_BAR; }
    }
    PG8_WAIT_V(0);
    if constexpr (!ALIGN_EPI) { if (wr == 0) PG8_BAR; }
    PG8_BAR;
    if constexpr (Epi::AFTER_DRAIN) { E.fused(acc, cur, wr, wc, fr, fq, lds, wid, lane); S.done(cur); }
#undef PG8_VOFF
#undef PG8_SA
#undef PG8_SB
#undef PG8_STAGE
#undef PG8_LDA
#undef PG8_LDB
#undef PG8_MMA
#undef PG8_WAIT_V
#undef PG8_WAIT_L
#undef PG8_BAR
#undef PG8_SCHED
}
}

constexpr int NWAVES = 8;
constexpr size_t MiB = 1u << 20;
constexpr size_t WS_CTL = 0, CTL_ZERO_BYTES = 2 * MiB;
constexpr size_t WS_ROPE = 2 * MiB;
constexpr size_t WS_W = 8 * MiB;
constexpr size_t W_IN = 0, W_ODA = W_IN + (size_t)P_TOTAL * 1024 * 2, W_ORW = W_ODA + 2 * MiB, W_OUT = W_ORW + 2 * MiB, W_UP = W_OUT + 2 * MiB,
                 W_DN = W_UP + (size_t)UPW * 1024 * 2, W_LORA = W_DN + (size_t)1024 * D_FF * 2, W_LAYER = W_LORA + (size_t)3072 * 256 * 2;
static_assert(W_LAYER == 42467328, "weights per layer");
constexpr size_t W_UP1 = W_LAYER;
constexpr size_t WS_DN1 = WS_ROPE + 256 * 1024;
static_assert(WS_DN1 + (size_t)1024 * D_FF * 2 <= WS_W, "W_DN1 slot");
constexpr size_t WS_XB = WS_W + W_LAYER + (size_t)1024 * UPW * 2;
constexpr size_t ACT = (size_t)MT * 1024 * 2;
constexpr size_t WS_POOL = WS_XB + ACT;
constexpr size_t B_Q = WS_POOL, B_K = B_Q + ACT, B_V = B_K + ACT, B_OC = B_V + ACT  , B_ORW = B_OC + 2 * ACT, B_URW = B_ORW + ACT, B_LD = B_URW + (size_t)MT * P_RW * 2, B_LA = B_LD + ACT,
                 B_LG = B_LA + ACT, B_END = B_LG + ACT;
constexpr size_t B_LIN = B_LD;
constexpr size_t B_GATE = B_Q, B_OA = B_V;
constexpr size_t B_MRG = B_URW;
constexpr size_t B_UP = WS_POOL, B_GT = B_URW;
constexpr size_t WS_SP = B_END;
constexpr size_t B_END2 = WS_SP + (size_t)1024 * 32 * 132 * 4;
static_assert(B_UP + (size_t)MT * UPW * 2 <= B_GT && B_GT + (size_t)MT * D_FF * 2 <= B_LD, "FFN overlay");
static_assert(B_END2 <= 512 * MiB, "workspace map");
constexpr int CW_BAR = 4096;
constexpr int CW_LAM = 8192;
constexpr int CW_AQ = 8256;
constexpr int CW_SS = 16384;
static_assert((CW_SS + 5 * MT) * 4 <= (int)CTL_ZERO_BYTES, "CTL region");
constexpr int RING_OFF = 0, RING_BYTES = 131072;
constexpr int LDSCTL_OFF = RING_BYTES, MISC_OFF = LDSCTL_OFF + 320;
constexpr int LDS_BYTES = 147456;
constexpr int UC_HALO_OFF = LDSCTL_OFF + 1024;
static_assert(UC_HALO_OFF + 8192 <= LDS_BYTES && MISC_OFF + 64 <= UC_HALO_OFF, "halo region");

constexpr int PH_PER_LAYER = 11;
constexpr int NPHASE = 1 + DEPTH * PH_PER_LAYER + 1;
enum { K_G1 = 0, K_LP, K_LR, K_SC, K_CB, K_M1, K_M2, K_WO, K_UP, K_CV, K_DN };

#include <hip/hip_bf16.h>
#include <cmath>
namespace attn_body {
using bf16=__hip_bfloat16;
using bf16x8=__attribute__((ext_vector_type(8)))short;
using s16x4=__attribute__((ext_vector_type(4)))short;
using f32x16=__attribute__((ext_vector_type(16)))float;
using u32x4=__attribute__((ext_vector_type(4)))unsigned;
constexpr int BATCH=8,SEQ=2048,D=64,DM=1024;
constexpr int NW=8,QBLK=32,QB=QBLK*NW,KVBLK=64,NQB=SEQ/QB;
constexpr int ATTN_PITCH=DM, ATTN_UNIT_ROWS=QB;
__device__ __forceinline__ int crow(int r,int hi){return (r&3)+8*(r>>2)+4*hi;}
#define SBAR() __builtin_amdgcn_sched_barrier(0)
__device__ __forceinline__ void cmask(f32x16&p0,f32x16&p1,int jb,int wid){
  const float NEG=-INFINITY;
  if(jb>(wid>>1)){
    #pragma unroll
    for(int r=0;r<16;++r){p0[r]=NEG;p1[r]=NEG;}
  }
}

constexpr int NSLOT=3, SLOTB=8192;
constexpr int LDS_K=0, LDS_V=NSLOT*SLOTB, LDS_WS=2*NSLOT*SLOTB, LDS_OST=LDS_WS+NW*64*4, LDS_BYTES=LDS_OST+NW*4096;
constexpr float C2=0.125f*1.4426950408889634f;
__device__ __forceinline__ void glds16(const void*gsrc,unsigned lds_dst){unsigned keep;
  asm volatile("s_mov_b32 %0, m0\n\ts_mov_b32 m0, %2\n\ts_nop 0\n\tglobal_load_lds_dwordx4 %1, off\n\ts_mov_b32 m0, %0":"=&s"(keep):"v"(gsrc),"s"(lds_dst):"memory");}
__device__ __forceinline__ float max3f(float a,float b,float c){float r;asm("v_max3_f32 %0, %1, %2, %3":"=v"(r):"v"(a),"v"(b),"v"(c));return r;}
__device__ __forceinline__ float max2f(float a,float b){float r;asm("v_max_f32_e32 %0, %1, %2":"=v"(r):"v"(a),"v"(b));return r;}
__device__ __forceinline__ float fadd_s(float a,float b){float r;asm("v_add_f32_e32 %0, %1, %2":"=v"(r):"v"(a),"v"(b));return r;}
__device__ __forceinline__ float fsub_s(float a,float b){float r;asm("v_sub_f32_e32 %0, %1, %2":"=v"(r):"v"(a),"v"(b));return r;}
typedef float f32x2_t __attribute__((ext_vector_type(2))); typedef __bf16 bf16x2_t __attribute__((ext_vector_type(2)));
__device__ __forceinline__ unsigned cvtpk_s(float lo,float hi){f32x2_t v={lo,hi};bf16x2_t b=__builtin_convertvector(v,bf16x2_t);return __builtin_bit_cast(unsigned,b);}
#define WAIT_BAR(N) asm volatile("s_waitcnt vmcnt(" #N ") lgkmcnt(0)\n\ts_barrier":::"memory")

__device__ __forceinline__ void qkt(f32x16&p0,f32x16&p1,const char*Kslot,const bf16x8*qr,const f32x16&negm,int r32,int hi){
  const char*kb=Kslot+hi*1024+r32*16;
  #pragma unroll
  for(int d0=0;d0<4;++d0){
    const bf16x8 b0=*reinterpret_cast<const bf16x8*>(kb+d0*2048);
    const bf16x8 b1=*reinterpret_cast<const bf16x8*>(kb+d0*2048+512);
    if(d0==0){p0=__builtin_amdgcn_mfma_f32_32x32x16_bf16(b0,qr[0],negm,0,0,0);p1=__builtin_amdgcn_mfma_f32_32x32x16_bf16(b1,qr[0],negm,0,0,0);}
    else{p0=__builtin_amdgcn_mfma_f32_32x32x16_bf16(b0,qr[d0],p0,0,0,0);p1=__builtin_amdgcn_mfma_f32_32x32x16_bf16(b1,qr[d0],p1,0,0,0);}}
}
typedef __attribute__((address_space(3))) const char* lds_cptr;
typedef short v4i16_t __attribute__((ext_vector_type(4)));
__device__ __forceinline__ void kload8(bf16x8*kf,lds_cptr kp){
  kf[0]=*(const __attribute__((address_space(3))) bf16x8*)(kp);      kf[1]=*(const __attribute__((address_space(3))) bf16x8*)(kp+512);
  kf[2]=*(const __attribute__((address_space(3))) bf16x8*)(kp+2048); kf[3]=*(const __attribute__((address_space(3))) bf16x8*)(kp+2560);
  kf[4]=*(const __attribute__((address_space(3))) bf16x8*)(kp+4096); kf[5]=*(const __attribute__((address_space(3))) bf16x8*)(kp+4608);
  kf[6]=*(const __attribute__((address_space(3))) bf16x8*)(kp+6144); kf[7]=*(const __attribute__((address_space(3))) bf16x8*)(kp+6656);
}
__device__ __forceinline__ void kload2(bf16x8*kf,lds_cptr kp,int j){ kf[2*j]=*(const __attribute__((address_space(3))) bf16x8*)(kp+j*2048); kf[2*j+1]=*(const __attribute__((address_space(3))) bf16x8*)(kp+j*2048+512); }
__device__ __forceinline__ s16x4 vtr(lds_cptr p){ return __builtin_bit_cast(s16x4,__builtin_amdgcn_ds_read_tr16_b64_v4i16((__attribute__((address_space(3))) v4i16_t*)p)); }
__device__ __forceinline__ float rowmax(const f32x16&p0,const f32x16&p1){
  float a=max3f(p0[0],p0[1],p1[0]),b=max3f(p0[2],p0[3],p1[1]);a=max3f(a,p1[2],p1[3]);
  #pragma unroll
  for(int r=4;r<16;r+=4){a=max3f(a,p0[r],p0[r+1]);b=max3f(b,p0[r+2],p0[r+3]);a=max3f(a,p1[r],p1[r+1]);b=max3f(b,p1[r+2],p1[r+3]);}
  const float m=max2f(a,b);
  auto rr=__builtin_amdgcn_permlane32_swap(__float_as_uint(m),__float_as_uint(m),false,false);
  return max2f(__uint_as_float(rr[0]),__uint_as_float(rr[1]));
}
__device__ __forceinline__ void pv(f32x16*o,int vb,bf16x8 pa0,bf16x8 pa1,bf16x8 pa2,bf16x8 pa3){
  #pragma unroll
  for(int d0=0;d0<2;++d0){s16x4 lo[4],hi[4];
    #pragma unroll
    for(int ks=0;ks<4;++ks){
      asm volatile("ds_read_b64_tr_b16 %0,%1 offset:%c2":"=&v"(lo[ks]):"v"(vb),"i"(d0*4096+ks*1024):"memory");
      asm volatile("ds_read_b64_tr_b16 %0,%1 offset:%c2":"=&v"(hi[ks]):"v"(vb),"i"(d0*4096+ks*1024+512):"memory");}
    asm volatile("s_waitcnt lgkmcnt(0)":::"memory");SBAR();
    #define PK(k) (bf16x8){lo[k][0],lo[k][1],lo[k][2],lo[k][3],hi[k][0],hi[k][1],hi[k][2],hi[k][3]}
    o[d0]=__builtin_amdgcn_mfma_f32_32x32x16_bf16(pa0,PK(0),o[d0],0,0,0);
    o[d0]=__builtin_amdgcn_mfma_f32_32x32x16_bf16(pa1,PK(1),o[d0],0,0,0);
    o[d0]=__builtin_amdgcn_mfma_f32_32x32x16_bf16(pa2,PK(2),o[d0],0,0,0);
    o[d0]=__builtin_amdgcn_mfma_f32_32x32x16_bf16(pa3,PK(3),o[d0],0,0,0);
    #undef PK
  }
}

#ifndef ATTN_STORE16
#define ATTN_STORE16(p,v) (*(u32x4*)(p)=(v))
#endif
template<int THRL> __device__ __forceinline__ void attn_unit(int b,int qcol,int vcol,int qb,const bf16*Q,const bf16*K,const bf16*V,bf16*O,char*shm){
  int tid_=threadIdx.x; asm volatile("" : "+v"(tid_)); const int tid=tid_,lane=tid&63,r32=lane&31,hi=lane>>5; const int wid=__builtin_amdgcn_readfirstlane(tid>>6);
  const long rowbase=(long)b*SEQ; const int q0=qb*QB;
  const bf16*Qw=Q+(rowbase+q0+wid*QBLK)*DM+qcol;
  const bf16*Kh=K+rowbase*DM+qcol,*Vh=V+rowbase*DM+vcol;
  const unsigned lds0=(unsigned)(uintptr_t)shm;
  float*wsf=(float*)(shm+LDS_WS)+wid*64;
  const bf16*ksrc=Kh+(long)lane*DM+wid*8;
  const bf16*vsrc=Vh+(long)(16*(wid&3)+(lane>>2))*DM+(wid>>2)*32+(lane&3)*8;
  const unsigned kdst=lds0+LDS_K+wid*1024, vdst=lds0+LDS_V+wid*1024;
  #define DMA_K(t,slot) glds16(ksrc+(long)(t)*KVBLK*DM,(unsigned)__builtin_amdgcn_readfirstlane(kdst+(slot)))
  #define DMA_V(t,slot) glds16(vsrc+(long)(t)*KVBLK*DM,(unsigned)__builtin_amdgcn_readfirstlane(vdst+(slot)))
  const int vb0=(int)(lds0+LDS_V)+((lane>>4)&1)*32+(lane&3)*8+(4*hi+((lane&15)>>2))*64;
  const char*Kbase=shm+LDS_K; bf16x8 kf[8];
  const lds_cptr shm3=(lds_cptr)shm; const lds_cptr kp0=shm3+LDS_K+hi*1024+r32*16; const lds_cptr vp0=shm3+LDS_V+((lane>>4)&1)*32+(lane&3)*8+(4*hi+((lane&15)>>2))*64;
  const int NT=(q0+QB)/KVBLK;
  DMA_K(0,0);DMA_V(0,0);DMA_K(1,SLOTB);
  bf16x8 qr[4];
  #pragma unroll
  for(int d0=0;d0<4;++d0)qr[d0]=*reinterpret_cast<const bf16x8*>(&Qw[(long)r32*DM+d0*16+hi*8]);
  float mhat=0.f,l_reg=0.f;f32x16 o[2];o[0]=f32x16{};o[1]=f32x16{};const f32x16 zc=f32x16{}; float nm=0.f;
  const int qrel=wid*QBLK+r32;
  #define CMASK(P0,P1,t) do{int jb_=(t)-(NT-4); if(jb_>=0)cmask(P0,P1,jb_,wid);}while(0)
  bool resc=false;
  #define START(P0,P1) do{ const float rm=rowmax(P0,P1); resc=false; \
    { const float dl=rm; mhat=fadd_s(mhat,dl); \
      _Pragma("unroll") for(int r=0;r<16;++r){P0[r]=fsub_s(P0[r],dl);P1[r]=fsub_s(P1[r],dl);} \
      nm=-mhat; } \
    _Pragma("unroll") for(int r=0;r<16;++r)P0[r]=__builtin_amdgcn_exp2f(P0[r]); }while(0)
  #define RESC() do{ if(resc){ asm volatile("s_waitcnt lgkmcnt(0)":::"memory"); \
      _Pragma("unroll") for(int d_=0;d_<2;++d_) _Pragma("unroll") for(int r=0;r<16;++r)o[d_][r]*=wsf[crow(r,hi)]; } }while(0)
  f32x16 pA0,pA1,pB0,pB1;
  int sl_prev=0,sl_cur=0,sl_next=SLOTB;
  #define ROT() do{sl_prev=sl_cur;sl_cur=sl_next;sl_next=(sl_next==(NSLOT-1)*SLOTB)?0:sl_next+SLOTB;}while(0)
  DMA_K(2,2*SLOTB);
  WAIT_BAR(3);
  qkt(pA0,pA1,Kbase,qr,zc,r32,hi);asm volatile("s_nop 15\n\ts_nop 7":"+v"(pA0),"+v"(pA1));CMASK(pA0,pA1,0);
  START(pA0,pA1);
  _Pragma("unroll") for(int r=0;r<16;++r)pA1[r]=__builtin_amdgcn_exp2f(pA1[r]);
  WAIT_BAR(0);
  DMA_K(3,0);DMA_V(1,SLOTB);
  ROT();
  kload8(kf,kp0+sl_cur);
  WAIT_BAR(2);
  s16x4 vlo[8],vhi[8]; u32x4 pw0,pw1,pw2,pw3;
  #define PKW(P,B) cvtpk_s(P[B],P[B+1])
  #define PAF(k) __builtin_bit_cast(bf16x8,pw##k)
  #define VFR(i) (bf16x8){vlo[i][0],vlo[i][1],vlo[i][2],vlo[i][3],vhi[i][0],vhi[i][1],vhi[i][2],vhi[i][3]}
  #define PIN(x) asm volatile("":"+v"(x))
  #define MX3(a,b,c) __builtin_fmaxf(__builtin_fmaxf((a),(b)),(c))
  #define GAPA(MF,A0,A1,A2,A3,W0,W1,PW) do{ MF; sacc+=A0; sacc+=A1; sacc+=A2; sacc+=A3; PIN(sacc); W0; W1; PIN(PW); SBAR(); }while(0)
  #define EX(v) __builtin_amdgcn_exp2f(v)
  #define GAPB(MF,X,B) do{ MF; X[B]=EX(X[B]); X[B+1]=EX(X[B+1]); X[B+2]=EX(X[B+2]); X[B+3]=EX(X[B+3]); PIN(X); SBAR(); }while(0)
  #define VRD(i) do{ vlo[i]=vtr(vp_+(((i)>>2)*4096+((i)&3)*1024)); vhi[i]=vtr(vp_+(((i)>>2)*4096+((i)&3)*1024+512)); }while(0)
  #define KRD(G,j) do{ if(G){ kload2(kf,kp0+sl_next,j); SBAR(); } }while(0)
  #define STEP(C0,C1,P0,P1,t,GK,GV,GL) do{ SBAR(); \
    const lds_cptr vp_=vp0+sl_prev; \
    VRD(0); SBAR(); float sacc=(P0[0]+P0[1]); \
    GAPA(C0=__builtin_amdgcn_mfma_f32_32x32x16_bf16(kf[0],qr[0],zc,0,0,0), P0[2],P0[3],P0[4],P0[5],     pw0[0]=PKW(P0,0), pw0[1]=PKW(P0,2), pw0); \
    VRD(4); SBAR(); GAPA(C1=__builtin_amdgcn_mfma_f32_32x32x16_bf16(kf[1],qr[0],zc,0,0,0), P0[6],P0[7],P0[8],P0[9],     pw0[2]=PKW(P0,4), pw0[3]=PKW(P0,6), pw0); \
    VRD(1); SBAR(); GAPA(C0=__builtin_amdgcn_mfma_f32_32x32x16_bf16(kf[2],qr[1],C0,0,0,0),   P0[10],P0[11],P0[12],P0[13], pw1[0]=PKW(P0,8), pw1[1]=PKW(P0,10), pw1); \
    VRD(5); SBAR(); GAPA(C1=__builtin_amdgcn_mfma_f32_32x32x16_bf16(kf[3],qr[1],C1,0,0,0),   P0[14],P0[15],P1[0],P1[1],   pw1[2]=PKW(P0,12),pw1[3]=PKW(P0,14), pw1); \
    VRD(2); SBAR(); GAPA(C0=__builtin_amdgcn_mfma_f32_32x32x16_bf16(kf[4],qr[2],C0,0,0,0),   P1[2],P1[3],P1[4],P1[5],     pw2[0]=PKW(P1,0), pw2[1]=PKW(P1,2), pw2); \
    VRD(6); SBAR(); GAPA(C1=__builtin_amdgcn_mfma_f32_32x32x16_bf16(kf[5],qr[2],C1,0,0,0),   P1[6],P1[7],P1[8],P1[9],     pw2[2]=PKW(P1,4), pw2[3]=PKW(P1,6), pw2); \
    VRD(3); SBAR(); GAPA(C0=__builtin_amdgcn_mfma_f32_32x32x16_bf16(kf[6],qr[3],C0,0,0,0),   P1[10],P1[11],P1[12],P1[13], pw3[0]=PKW(P1,8), pw3[1]=PKW(P1,10), pw3); \
    VRD(7); SBAR(); GAPA(C1=__builtin_amdgcn_mfma_f32_32x32x16_bf16(kf[7],qr[3],C1,0,0,0),   P1[14],P1[15],0.f,0.f,       pw3[2]=PKW(P1,12),pw3[3]=PKW(P1,14), pw3); \
    l_reg+=sacc; \
    if(GK){DMA_K((t)+3,sl_cur);} if(GV){DMA_V((t)+1,sl_next);} \
    _Pragma("unroll") for(int r=0;r<16;++r){C0[r]+=nm;C1[r]+=nm;} \
    CMASK(C0,C1,t); \
    { float a=MX3(C0[0],C0[1],C1[0]),b=MX3(C0[2],C0[3],C1[1]); a=MX3(a,C1[2],C1[3]); \
      _Pragma("unroll") for(int r=4;r<16;r+=4){a=MX3(a,C0[r],C0[r+1]);b=MX3(b,C0[r+2],C0[r+3]);a=MX3(a,C1[r],C1[r+1]);b=MX3(b,C1[r+2],C1[r+3]);} \
      float rm=__builtin_fmaxf(a,b); { auto rr=__builtin_amdgcn_permlane32_swap(__float_as_uint(rm),__float_as_uint(rm),false,false); rm=__builtin_fmaxf(__uint_as_float(rr[0]),__uint_as_float(rr[1])); } \
      resc=false; \
      if(__builtin_expect(__any(rm>(float)THRL),0)){ const float dl=__builtin_fmaxf(rm,0.f); mhat+=dl; \
        _Pragma("unroll") for(int r=0;r<16;++r){C0[r]-=dl;C1[r]-=dl;} \
        nm=-mhat; \
        const float f=__builtin_amdgcn_exp2f(-dl); l_reg*=f; if(hi==0)wsf[r32]=f; resc=true; } } \
    SBAR(); \
    GAPB(o[0]=__builtin_amdgcn_mfma_f32_32x32x16_bf16(PAF(0),VFR(0),o[0],0,0,0), C0,0); \
    GAPB(o[1]=__builtin_amdgcn_mfma_f32_32x32x16_bf16(PAF(0),VFR(4),o[1],0,0,0), C0,4); \
    KRD(GL,0); GAPB(o[0]=__builtin_amdgcn_mfma_f32_32x32x16_bf16(PAF(1),VFR(1),o[0],0,0,0), C0,8); \
    KRD(GL,1); GAPB(o[1]=__builtin_amdgcn_mfma_f32_32x32x16_bf16(PAF(1),VFR(5),o[1],0,0,0), C0,12); \
    KRD(GL,2); GAPB(o[0]=__builtin_amdgcn_mfma_f32_32x32x16_bf16(PAF(2),VFR(2),o[0],0,0,0), C1,0); \
    KRD(GL,3); GAPB(o[1]=__builtin_amdgcn_mfma_f32_32x32x16_bf16(PAF(2),VFR(6),o[1],0,0,0), C1,4); \
    GAPB(o[0]=__builtin_amdgcn_mfma_f32_32x32x16_bf16(PAF(3),VFR(3),o[0],0,0,0), C1,8); \
    GAPB(o[1]=__builtin_amdgcn_mfma_f32_32x32x16_bf16(PAF(3),VFR(7),o[1],0,0,0), C1,12); \
    }while(0)
  int t=1;
  #undef CMASK
  #define CMASK(P0,P1,t) do{}while(0)
  for(;t+5<NT;t+=2){
    STEP(pB0,pB1,pA0,pA1,t,true,true,true);     WAIT_BAR(2); RESC(); ROT();
    STEP(pA0,pA1,pB0,pB1,t+1,true,true,true);   WAIT_BAR(2); RESC(); ROT();
  }
  #undef CMASK
  #define CMASK(P0,P1,t) do{int jb_=(t)-(NT-4); if(jb_>=0)cmask(P0,P1,jb_,wid);}while(0)
  #define ENDW(tt) do{ if((tt)+3<NT){WAIT_BAR(2);} else if((tt)+2<NT){WAIT_BAR(1);} else {WAIT_BAR(0);} }while(0)
  for(;t+1<NT;t+=2){
    STEP(pB0,pB1,pA0,pA1,t,(t+3<NT),(t+1<NT),(t+1<NT));       ENDW(t);   RESC(); ROT();
    STEP(pA0,pA1,pB0,pB1,t+1,(t+4<NT),(t+2<NT),(t+2<NT));     ENDW(t+1); RESC(); ROT();
  }
  STEP(pB0,pB1,pA0,pA1,NT-1,false,false,false); RESC();
  { float sacc=pB0[0]+pB0[1]; _Pragma("unroll") for(int r=2;r<16;++r)sacc+=pB0[r]; _Pragma("unroll") for(int r=0;r<16;++r)sacc+=pB1[r]; l_reg+=sacc;
    pw0=(u32x4){PKW(pB0,0),PKW(pB0,2),PKW(pB0,4),PKW(pB0,6)};pw1=(u32x4){PKW(pB0,8),PKW(pB0,10),PKW(pB0,12),PKW(pB0,14)};pw2=(u32x4){PKW(pB1,0),PKW(pB1,2),PKW(pB1,4),PKW(pB1,6)};pw3=(u32x4){PKW(pB1,8),PKW(pB1,10),PKW(pB1,12),PKW(pB1,14)};
    SBAR(); pv(o,vb0+sl_cur,PAF(0),PAF(1),PAF(2),PAF(3)); }
  #undef PKW
  #undef PAF
  #undef VFR
  #undef PIN
  #undef MX3
  #undef GAPA
  #undef GAPB
  #undef EX
  #undef VRD
  #undef KRD
  #undef STEP
  #undef ENDW
  {auto rr=__builtin_amdgcn_permlane32_swap(__float_as_uint(l_reg),__float_as_uint(l_reg),false,false);l_reg=__uint_as_float(rr[0])+__uint_as_float(rr[1]);}
  if(hi==0)wsf[32+r32]=l_reg;asm volatile("s_waitcnt lgkmcnt(0)":::"memory");
  float rli[16];
  #pragma unroll
  for(int r=0;r<16;++r)rli[r]=__builtin_amdgcn_rcpf(wsf[32+crow(r,hi)]);
  bf16*Ow=O+(rowbase+q0+wid*QBLK)*DM+vcol;
  { bf16*stg=(bf16*)(shm+LDS_OST)+wid*2048;
    #pragma unroll
    for(int r=0;r<16;++r){const int orow=crow(r,hi);
      #pragma unroll
      for(int d0=0;d0<2;++d0)stg[orow*64+d0*32+r32]=__float2bfloat16(o[d0][r]*rli[r]);}
    asm volatile("s_waitcnt lgkmcnt(0)":::"memory");
    #pragma unroll
    for(int i=0;i<4;++i){const int row=i*8+(lane>>3),ch=lane&7; const u32x4 v=*(const u32x4*)(stg+row*64+ch*8); ATTN_STORE16(Ow+(long)row*DM+ch*8,v);} }
  asm volatile("s_waitcnt lgkmcnt(0)\n\ts_barrier":::"memory");
  #undef DMA_K
  #undef DMA_V
  #undef CMASK
  #undef START
  #undef RESC
  #undef ROT
}
typedef float f32x4 __attribute__((ext_vector_type(4)));
constexpr int SA_K0=0, SA_K1=8192, SA_V0=16384, SA_V1=24576, SA_WS=32768, SA_BYTES=SA_WS+8*256;
__device__ __forceinline__ unsigned pk2bf(float lo,float hi){return cvtpk_s(lo,hi);}
__device__ __forceinline__ void sample_unit(int l,int b,int h,int s,const float*cache_k,const float*cache_v,const bf16*Q,const bf16*K,const bf16*V,float*SP,char*shm){
  int tid_=threadIdx.x; asm volatile("" : "+v"(tid_)); const int tid=tid_,lane=tid&63,r32=lane&31,hi=lane>>5; const int wid=__builtin_amdgcn_readfirstlane(tid>>6);
  const unsigned lds0=(unsigned)(uintptr_t)shm;
  float*wsf=(float*)(shm+SA_WS)+wid*64;
  const int c=wid>>1,vh=wid&1;
  const int qrow=16384+b*32;
  bf16x8 qr[4];
  if(wid<4){
    #pragma unroll
    for(int d0=0;d0<4;++d0)qr[d0]=*reinterpret_cast<const bf16x8*>(&Q[(long)(qrow+r32)*DM+h*128+c*64+d0*16+hi*8]);
  }
  float m=-1e30f,lsum=0.f; f32x16 o[2]; o[0]=f32x16{}; o[1]=f32x16{};
  const f32x16 zc=f32x16{};
  const int ntile=(s==7)?5:4;
  const float*ckb=cache_k+((long)(l*8+b)*2048)*1024+h*128; const float*cvb=cache_v+((long)(l*8+b)*2048)*1024+h*128;
  for(int ti=0;ti<ntile;++ti){
    const bool fresh=(ti==4);
    #pragma unroll
    for(int pi=0;pi<2;++pi){
      const int pk=wid*2+pi;
      { const int kc=pk>>3,ch=pk&7; u32x4 wv;
        if(!fresh){ const float*src=ckb+(long)((4*s+ti)*64+lane)*1024+kc*64+ch*8; const f32x4 a=*(const f32x4*)src,bq=*(const f32x4*)(src+4);
          wv.x=pk2bf(a.x,a.y);wv.y=pk2bf(a.z,a.w);wv.z=pk2bf(bq.x,bq.y);wv.w=pk2bf(bq.z,bq.w); }
        else if(lane<32){ wv=*(const u32x4*)(K+(long)(qrow+lane)*DM+h*128+kc*64+ch*8); }
        else { wv=(u32x4){0u,0u,0u,0u}; }
        *(u32x4*)(shm+(kc?SA_K1:SA_K0)+ch*1024+lane*16)=wv; }
      { const int vv=pk>>3,p=pk&7; const int row=16*(p&3)+(lane>>2),col=vv*64+32*(p>>2)+8*(lane&3); u32x4 wv;
        if(!fresh){ const float*src=cvb+(long)((4*s+ti)*64+row)*1024+col; const f32x4 a=*(const f32x4*)src,bq=*(const f32x4*)(src+4);
          wv.x=pk2bf(a.x,a.y);wv.y=pk2bf(a.z,a.w);wv.z=pk2bf(bq.x,bq.y);wv.w=pk2bf(bq.z,bq.w); }
        else if(row<32){ wv=*(const u32x4*)(V+(long)(qrow+row)*DM+h*128+col); }
        else { wv=(u32x4){0u,0u,0u,0u}; }
        *(u32x4*)(shm+(vv?SA_V1:SA_V0)+p*1024+lane*16)=wv; }
    }
    __syncthreads();
    if(wid<4){
      f32x16 p0,p1;
      qkt(p0,p1,shm+(c?SA_K1:SA_K0),qr,zc,r32,hi);
      if(fresh){
        #pragma unroll
        for(int r=0;r<16;++r)p1[r]=-INFINITY;
      }
      float rm=p0[0];
      #pragma unroll
      for(int r=1;r<16;++r)rm=__builtin_fmaxf(rm,p0[r]);
      #pragma unroll
      for(int r=0;r<16;++r)rm=__builtin_fmaxf(rm,p1[r]);
      rm=__builtin_fmaxf(rm,__shfl_xor(rm,32));
      const float mn=__builtin_fmaxf(m,rm),alpha=__builtin_amdgcn_exp2f(m-mn);
      float ps=0.f;
      #pragma unroll
      for(int r=0;r<16;++r){p0[r]=__builtin_amdgcn_exp2f(p0[r]-mn);p1[r]=__builtin_amdgcn_exp2f(p1[r]-mn);ps+=p0[r]+p1[r];}
      lsum=lsum*alpha+ps; m=mn;
      if(hi==0)wsf[r32]=alpha;
      asm volatile("s_waitcnt lgkmcnt(0)":::"memory");
      #pragma unroll
      for(int g=0;g<4;++g){ const f32x4 f4=*(const f32x4*)(wsf+8*g+4*hi);
        #pragma unroll
        for(int i=0;i<4;++i){o[0][4*g+i]*=f4[i];o[1][4*g+i]*=f4[i];} }
      u32x4 pw0,pw1,pw2,pw3;
      pw0=(u32x4){pk2bf(p0[0],p0[1]),pk2bf(p0[2],p0[3]),pk2bf(p0[4],p0[5]),pk2bf(p0[6],p0[7])};
      pw1=(u32x4){pk2bf(p0[8],p0[9]),pk2bf(p0[10],p0[11]),pk2bf(p0[12],p0[13]),pk2bf(p0[14],p0[15])};
      pw2=(u32x4){pk2bf(p1[0],p1[1]),pk2bf(p1[2],p1[3]),pk2bf(p1[4],p1[5]),pk2bf(p1[6],p1[7])};
      pw3=(u32x4){pk2bf(p1[8],p1[9]),pk2bf(p1[10],p1[11]),pk2bf(p1[12],p1[13]),pk2bf(p1[14],p1[15])};
      const int vb=(int)(lds0+(vh?SA_V1:SA_V0))+((lane>>4)&1)*32+(lane&3)*8+(4*hi+((lane&15)>>2))*64;
      pv(o,vb,__builtin_bit_cast(bf16x8,pw0),__builtin_bit_cast(bf16x8,pw1),__builtin_bit_cast(bf16x8,pw2),__builtin_bit_cast(bf16x8,pw3));
    }
    __syncthreads();
  }
  if(wid<4){
    lsum+=__shfl_xor(lsum,32);
    float*sp=SP+((long)(((b*8+h)*2+c)*8+s)*32)*132;
    if(vh==0&&hi==0){sp[r32*132]=m;sp[r32*132+1]=lsum;}
    #pragma unroll
    for(int d0=0;d0<2;++d0)
      #pragma unroll
      for(int r=0;r<16;++r)sp[crow(r,hi)*132+4+vh*64+32*d0+r32]=o[d0][r];
  }
}
constexpr int ATTN_LDS_BYTES=LDS_BYTES;
#undef SBAR
#undef WAIT_BAR
}

#define GAS __attribute__((address_space(1)))
#define LAS __attribute__((address_space(3)))
typedef unsigned short bf16;
typedef unsigned v4u __attribute__((ext_vector_type(4)));
typedef float f32x4 __attribute__((ext_vector_type(4)));
typedef short bf16x8 __attribute__((ext_vector_type(8)));
typedef GAS unsigned gu32;
typedef GAS unsigned long long gu64;
#define RLX_AGENT __ATOMIC_RELAXED, __HIP_MEMORY_SCOPE_AGENT
#define LDS_WAIT() asm volatile("s_waitcnt lgkmcnt(0)" ::: "memory")
#define VM_WAIT() asm volatile("s_waitcnt vmcnt(0)" ::: "memory")
__device__ __forceinline__ unsigned long long rt() { return __builtin_amdgcn_s_memrealtime(); }
__device__ __forceinline__ unsigned f2bf(float f) { unsigned u = __builtin_bit_cast(unsigned, f); return (u + 0x7fffu + ((u >> 16) & 1u)) >> 16; }
__device__ __forceinline__ unsigned pk2(float lo, float hi) { return f2bf(lo) | (f2bf(hi) << 16); }

#define XB_TMO      128
#define XB_XCNT(j)  (256  + 64 * (j))
#define XB_XSUB(j)  (1280 + 64 * (j))
#define XB_XGEN(j)  (2304 + 64 * (j))
#define XB_TOP      3328
#define XB_TOPGEN   3392
#define XCD_BAR_WORDS 3456
#define XB_SPIN_CAP (1u << 22)

__device__ __forceinline__ unsigned xb_ld(unsigned* p)              { return __hip_atomic_load(p, __ATOMIC_RELAXED, __HIP_MEMORY_SCOPE_AGENT); }
__device__ __forceinline__ unsigned xb_add(unsigned* p, unsigned v) { return __hip_atomic_fetch_add(p, v, __ATOMIC_RELAXED, __HIP_MEMORY_SCOPE_AGENT); }
__device__ __forceinline__ unsigned xb_xcc_id() { return (unsigned)__builtin_amdgcn_s_getreg((3 << 11) | 20) & 0xFu; }
#define XB_SPIN(cond, bar) do { unsigned _sp = 0; while (cond) { __builtin_amdgcn_s_sleep(1); \
    if ((++_sp & 255u) == 0u) { if (xb_ld(&(bar)[XB_TMO])) break; if (_sp > XB_SPIN_CAP) { atomicAdd(&(bar)[XB_TMO], 1u); break; } } } } while (0)

struct XcdBarrier {
    unsigned* bar; unsigned x;
    volatile LAS unsigned* st;
};

__device__ __forceinline__ XcdBarrier xcd_barrier_post(unsigned* bar, volatile LAS unsigned* st) {
    XcdBarrier b; b.bar = bar; b.x = xb_xcc_id(); b.st = st;
    if (threadIdx.x == 0) (void)xb_add(&bar[XB_XCNT(b.x)], 1u);
    return b;
}
__device__ __forceinline__ void xcd_barrier_complete(unsigned* bar, unsigned x, unsigned& nloc, unsigned& nx) {
    const unsigned G = gridDim.x * gridDim.y * gridDim.z;
    unsigned sum, cnt, mine, sp = 0u;
    for (;;) {
        sum = 0u; cnt = 0u; mine = 0u;
#pragma unroll
        for (unsigned j = 0; j < 16; ++j) { const unsigned c = xb_ld(&bar[XB_XCNT(j)]); sum += c; cnt += (c > 0u) ? 1u : 0u; mine = (j == x) ? c : mine; }
        if (sum == G) break;
        __builtin_amdgcn_s_sleep(1);
        if ((++sp & 255u) == 0u) { if (xb_ld(&bar[XB_TMO])) break; if (sp > XB_SPIN_CAP) { atomicAdd(&bar[XB_TMO], 1u); break; } }
    }
    nloc = mine > 0u ? mine : 1u; nx = cnt > 0u ? cnt : 1u;
}

__device__ __forceinline__ void xcd_barrier(const XcdBarrier& b) {
    asm volatile("s_waitcnt vmcnt(0)" ::: "memory");
    __syncthreads();
    if (threadIdx.x == 0) {
        unsigned* bar = b.bar;
        __builtin_amdgcn_s_waitcnt(0);
        unsigned nloc = b.st[0], nx = b.st[1];
        if (nloc == 0u) { xcd_barrier_complete(bar, b.x, nloc, nx); b.st[0] = nloc; b.st[1] = nx; }
        const unsigned old = xb_add(&bar[XB_XSUB(b.x)], 1u);
        const unsigned gen = old / nloc;
        if (old + 1u == (gen + 1u) * nloc) {
            __builtin_amdgcn_fence(__ATOMIC_RELEASE, "agent");
            asm volatile("s_waitcnt vmcnt(0)" ::: "memory");
            const unsigned og = xb_add(&bar[XB_TOP], 1u);
            const unsigned tg = og / nx;
            if (og + 1u == (tg + 1u) * nx) xb_add(&bar[XB_TOPGEN], 1u);
            else XB_SPIN(xb_ld(&bar[XB_TOPGEN]) == tg, bar);
            __builtin_amdgcn_fence(__ATOMIC_ACQUIRE, "agent");
            xb_add(&bar[XB_XGEN(b.x)], 1u);
            asm volatile("s_waitcnt vmcnt(0)" ::: "memory");
        } else {
            XB_SPIN(xb_ld(&bar[XB_XGEN(b.x)]) == gen, bar);
            __builtin_amdgcn_fence(__ATOMIC_ACQUIRE, "agent");
            asm volatile("s_waitcnt vmcnt(0)" ::: "memory");
        }
    }
    __syncthreads();
}

struct Args { const GAS float* in[31]; GAS float* out; GAS unsigned char* ws; float rinv[8]; int ph_lo, ph_hi; };
#define GIN(A, i) ((const float*)((A)->in[i]))
typedef const Args __attribute__((address_space(4)))* CArgsP;
struct Frame {
    LAS unsigned char* lds;
    volatile LAS unsigned* MISC;
    gu32* ctl;
    int tid, lane, wave, vcu, G;
    float* out; unsigned char* ws;
};
__device__ __forceinline__ float wave_sum(float v) {
#pragma unroll
    for (int o = 1; o < 64; o <<= 1) v += __shfl_xor(v, o);
    return v;
}
template <int CTRL> __device__ __forceinline__ float dppf(float x) { return __builtin_bit_cast(float, __builtin_amdgcn_update_dpp(0, __builtin_bit_cast(int, x), CTRL, 0xF, 0xF, false)); }
__device__ __forceinline__ float reduce8(float x) { x += dppf<0xB1>(x); x += dppf<0x4E>(x); x += dppf<0x141>(x); return x; }
__device__ __forceinline__ float reduce16(float x) { x = reduce8(x); x += dppf<0x140>(x); return x; }
__device__ __forceinline__ float bf2f(bf16 h) { return __uint_as_float((unsigned)h << 16); }
__device__ __forceinline__ float bflo(unsigned w) { return __uint_as_float(w << 16); }
__device__ __forceinline__ float bfhi(unsigned w) { return __uint_as_float(w & 0xffff0000u); }

__device__ __forceinline__ void p0_transpose_item(const float* W, int N, bf16* WT, int ldk, int koff, int row_off, const float* kscale, LAS float* scr, int item, int lane) {
    const int nblk = N / 32, kb = item / nblk, nb = item % nblk, k0 = 64 * kb, n0 = 32 * nb;
    float wv[32];
#pragma unroll
    for (int i = 0; i < 32; ++i) wv[i] = W[(size_t)(k0 + 2 * i + (lane >> 5)) * N + n0 + (lane & 31)];
#pragma unroll
    for (int i = 0; i < 32; ++i) { const int kk = 2 * i + (lane >> 5); float w = wv[i]; if (kscale) w *= kscale[k0 + kk]; scr[kk * 33 + (lane & 31)] = w; }
    LDS_WAIT(); asm volatile("" ::: "memory");
    const int c = lane & 7;
#pragma unroll
    for (int j = 0; j < 4; ++j) { const int n = (lane >> 3) + 8 * j; const LAS float* s = scr + (8 * c) * 33 + n;
        v4u o; o.x = pk2(s[0 * 33], s[1 * 33]); o.y = pk2(s[2 * 33], s[3 * 33]); o.z = pk2(s[4 * 33], s[5 * 33]); o.w = pk2(s[6 * 33], s[7 * 33]);
        *(GAS v4u*)(WT + (size_t)(row_off + n0 + n) * ldk + koff + k0 + 8 * c) = o; }
    LDS_WAIT(); asm volatile("" ::: "memory");
}
__device__ __forceinline__ int up_row_off(int item) { const int n0 = 32 * (item % (UPW / 32)), hf = n0 >= D_FF ? 1 : 0, j = n0 - hf * D_FF; return (j >> 7) * 256 + hf * 128 + (j & 127) - n0; }
constexpr int WP_IN = 1, WP_SQ = 2, WP_UP = 4, WP_DN = 8, WP_LORA = 16, WP_ALL = 31;
__device__ __forceinline__ void p0_weights(Frame& F, CArgsP A, int l, int gw, int NGW, const int part) {
    LAS float* scr = (LAS float*)(F.lds + RING_OFF + F.wave * 16384);
    constexpr int I_IN = (1024 / 64) * (P_TOTAL / 32), I_SQ = (1024 / 64) * (1024 / 32), I_UP = (1024 / 64) * (UPW / 32), I_DN = (D_FF / 64) * (1024 / 32),
                  I_W2 = 1 * (1024 / 32), I_G2 = 2 * (1024 / 32);
    unsigned char* wl = F.ws + WS_W;
    int base = 0;
#define WITEMS(NI, CALL) do { int it = (gw - base) % NGW; if (it < 0) it += NGW; for (; it < (NI); it += NGW) { const int r = it; CALL; } base += (NI); } while (0)
    if (part & WP_IN) WITEMS(I_IN, p0_transpose_item(GIN(A, 8) + (size_t)l * 1024 * P_TOTAL, P_TOTAL, (bf16*)(wl + W_IN), 1024, 0, 0, GIN(A, 7) + l * 1024, scr, r, F.lane));
    if (part & WP_SQ) {
        WITEMS(I_SQ, p0_transpose_item(GIN(A, 11) + (size_t)l * 1024 * 1024, 1024, (bf16*)(wl + W_ODA), 1024, 0, 0, nullptr, scr, r, F.lane));
        WITEMS(I_SQ, p0_transpose_item(GIN(A, 23) + (size_t)l * 1024 * 1024, 1024, (bf16*)(wl + W_ORW), 1024, 0, 0, nullptr, scr, r, F.lane));
        WITEMS(I_SQ, p0_transpose_item(GIN(A, 24) + (size_t)l * 1024 * 1024, 1024, (bf16*)(wl + W_OUT), 1024, 0, 0, nullptr, scr, r, F.lane));
    }
    if (part & WP_UP) WITEMS(I_UP, p0_transpose_item(GIN(A, 26) + (size_t)l * 1024 * UPW, UPW, (bf16*)(wl + (l ? W_UP1 : W_UP)), 1024, 0, up_row_off(r), GIN(A, 25) + l * 1024, scr, r, F.lane));
    if (part & WP_DN) WITEMS(I_DN, p0_transpose_item(GIN(A, 29) + (size_t)l * D_FF * 1024, 1024, (bf16*)(l ? F.ws + WS_DN1 : wl + W_DN), D_FF, 0, 0, nullptr, scr, r, F.lane));
    if (part & WP_LORA) {
        WITEMS(I_W2, p0_transpose_item(GIN(A, 14) + (size_t)l * 64 * 1024, 1024, (bf16*)(wl + W_LORA), 256, 0, 0, nullptr, scr, r, F.lane));
        WITEMS(I_W2, p0_transpose_item(GIN(A, 16) + (size_t)l * 64 * 1024, 1024, (bf16*)(wl + W_LORA), 256, 64, 1024, nullptr, scr, r, F.lane));
        WITEMS(I_G2, p0_transpose_item(GIN(A, 17) + (size_t)l * 128 * 1024, 1024, (bf16*)(wl + W_LORA), 256, 128, 2048, nullptr, scr, r, F.lane));
        for (int i = gw * 64 + F.lane; i < 3072 * 32; i += NGW * 64) {
            const int n = i >> 5, kc = i & 31, blk = n >> 10;
            const bool nz = (blk == 0) ? (kc < 8) : (blk == 1) ? (kc >= 8 && kc < 16) : (kc >= 16);
            if (!nz) *(GAS v4u*)(wl + W_LORA + ((size_t)n * 256 + kc * 8) * 2) = (v4u){0u, 0u, 0u, 0u};
        }
    }
#undef WITEMS
}
__device__ __forceinline__ void p0_prologue(Frame& F, CArgsP A) {
    const int gw = F.vcu * NWAVES + F.wave, NGW = F.G * NWAVES;
    p0_weights(F, A, 0, gw, NGW, WP_ALL);
    {
        const int gt = gw * 64 + F.lane, NGT = NGW * 64;
        float* rope = (float*)(F.ws + WS_ROPE);
        for (int i = gt; i < NKEYS_S * 8; i += NGT) {
            const int pos = i >> 3, k = i & 7;
            const float ang = (float)pos * A->rinv[k];
            const float kq = rintf(ang * 0.15915494309189535f);
            float r = fmaf(-kq, 6.2831854820251465f, ang); r = fmaf(-kq, -1.7484555314695172e-7f, r);
            const float rev = r * 0.15915494309189535f;
            rope[pos * 16 + k] = __builtin_amdgcn_cosf(rev); rope[pos * 16 + 8 + k] = __builtin_amdgcn_sinf(rev);
        }
    }
    {
        bf16* XB = (bf16*)(F.ws + WS_XB); float* SS = (float*)(F.ctl + CW_SS);
        for (int m0 = gw; m0 < MT; m0 += 3 * NGW) {
            f32x4 v[3][4];
#pragma unroll
            for (int q = 0; q < 3; ++q) { const int m = m0 + q * NGW, mm = (m < MT) ? m : 0;
                const float* src = (mm < MP) ? GIN(A, 0) + (size_t)mm * 1024 : GIN(A, 1) + (size_t)(mm - MP) * 1024;
                const GAS f32x4* xr = (const GAS f32x4*)src + F.lane;
#pragma unroll
                for (int j = 0; j < 4; ++j) v[q][j] = xr[64 * j]; }
#pragma unroll
            for (int q = 0; q < 3; ++q) { const int m = m0 + q * NGW;
                if (m < MT) {
                    GAS unsigned long long* o8 = (GAS unsigned long long*)(XB + (size_t)m * 1024) + F.lane;
                    float s_ = 0.f;
#pragma unroll
                    for (int j = 0; j < 4; ++j) { const f32x4 w = v[q][j]; s_ += (w.x * w.x + w.y * w.y) + (w.z * w.z + w.w * w.w);
                        o8[64 * j] = (unsigned long long)pg8::cvt_pk_bf16(w.x, w.y) | ((unsigned long long)pg8::cvt_pk_bf16(w.z, w.w) << 32); }
                    s_ = wave_sum(s_);
                    if (F.lane == 0) SS[m] = s_;
                } }
        }
    }
    if (gw < DEPTH) {
        const int l = gw; const float* lp = GIN(A, 9) + (size_t)l * 256;
        const float s1 = wave_sum(lp[F.lane] * lp[64 + F.lane]), s2 = wave_sum(lp[128 + F.lane] * lp[192 + F.lane]);
        if (F.lane == 0) ((float*)(F.ctl + CW_LAM))[l] = expf(s1) - expf(s2) + (0.8f - 0.6f * expf(-0.3f * (float)l));
    }
}

constexpr int AQ_PROMPT = 256 * 8, AQ_TOTAL = AQ_PROMPT + 512;
__device__ __forceinline__ void ph_attn(Frame& F, CArgsP A, int l) {
    const attn_body::bf16* Q = (const attn_body::bf16*)(F.ws + B_Q); const attn_body::bf16* K = (const attn_body::bf16*)(F.ws + B_K); const attn_body::bf16* V = (const attn_body::bf16*)(F.ws + B_V);
    gu32* ctr = F.ctl + CW_AQ + 64 * l;
    for (;;) {
        __syncthreads();
        if (F.tid == 0) F.MISC[12] = __hip_atomic_fetch_add(ctr, 1u, RLX_AGENT);
        __syncthreads();
        const int idx = __builtin_amdgcn_readfirstlane((int)F.MISC[12]);
        if (idx >= AQ_TOTAL) break;
        if (idx < AQ_PROMPT) {
            const int qb = 7 - (idx >> 8), u = idx & 255, b = u >> 5, hv = u & 31, h = hv >> 2, c = (hv >> 1) & 1, vh = hv & 1;
            attn_body::bf16* O = (attn_body::bf16*)(F.ws + B_OC) + (size_t)c * MT * 1024;
            attn_body::attn_unit<8>(b, h * 128 + c * 64, h * 128 + vh * 64, qb, Q, K, V, O, (char*)F.lds + RING_OFF);
        } else {
            const int u = idx - AQ_PROMPT;
            attn_body::sample_unit(l, u >> 6, (u >> 3) & 7, u & 7, GIN(A, 2), GIN(A, 3), Q, K, V, (float*)(F.ws + WS_SP), (char*)F.lds + RING_OFF);
        }
        { int tv = threadIdx.x; asm volatile("" : "+v"(tv)); F.tid = tv; F.lane = tv & 63; F.wave = __builtin_amdgcn_readfirstlane(tv >> 6); }
    }
}

__device__ __forceinline__ void ph_linprep(Frame& F, CArgsP A, int l) {
    const int gw = F.vcu * NWAVES + F.wave, NGW = F.G * NWAVES;
    const bf16* URW = (const bf16*)(F.ws + B_URW); bf16* LIN = (bf16*)(F.ws + B_LIN);
    const float* mu = GIN(A, 12) + (size_t)l * P_RW + 3072 + 4 * F.lane;
    const float mu0 = mu[0], mu1 = mu[1], mu2 = mu[2], mu3 = mu[3];
    for (int row0 = gw; row0 < MT; row0 += 4 * NGW) {
        unsigned long long cw[4], pw[4];
#pragma unroll
        for (int q = 0; q < 4; ++q) { const int row = row0 + q * NGW; const bool ok = row < MT; const int rr = ok ? row : 0;
            const bool smp = rr >= MP; const int t = smp ? ((rr - MP) & 31) : (rr & 2047);
            cw[q] = *(const unsigned long long*)(URW + (size_t)rr * P_RW + 3072 + 4 * F.lane);
            pw[q] = *(const unsigned long long*)(URW + (size_t)(t > 0 ? rr - 1 : rr) * P_RW + 3072 + 4 * F.lane); }
#pragma unroll
        for (int q = 0; q < 4; ++q) { const int row = row0 + q * NGW;
            if (row < MT) {
                const bool smp = row >= MP; const int t = smp ? ((row - MP) & 31) : (row & 2047);
                float u[4] = {bflo((unsigned)cw[q]), bfhi((unsigned)cw[q]), bflo((unsigned)(cw[q] >> 32)), bfhi((unsigned)(cw[q] >> 32))};
                float p[4] = {bflo((unsigned)pw[q]), bfhi((unsigned)pw[q]), bflo((unsigned)(pw[q] >> 32)), bfhi((unsigned)(pw[q] >> 32))};
                if (t == 0) {
                    if (smp) { const float* s0 = GIN(A, 5) + ((size_t)(l * DEC_BATCH) + ((row - MP) >> 5)) * P_RW + 3072 + 4 * F.lane; p[0] = s0[0]; p[1] = s0[1]; p[2] = s0[2]; p[3] = s0[3]; }
                    else { p[0] = p[1] = p[2] = p[3] = 0.f; } }
                u[0] += (p[0] - u[0]) * mu0; u[1] += (p[1] - u[1]) * mu1; u[2] += (p[2] - u[2]) * mu2; u[3] += (p[3] - u[3]) * mu3;
                if (F.lane < 16) {
#pragma unroll
                    for (int j = 0; j < 4; ++j) u[j] = 1.f - 2.f * __builtin_amdgcn_rcpf(1.f + __builtin_amdgcn_exp2f(2.8853900817779268f * u[j])); }
                else if (F.lane >= 32) {
#pragma unroll
                    for (int j = 0; j < 4; ++j) u[j] = pg8::fast_sigmoid(u[j]); }
                *(unsigned long long*)(LIN + (size_t)row * 256 + 4 * F.lane) = (unsigned long long)pg8::cvt_pk_bf16(u[0], u[1]) | ((unsigned long long)pg8::cvt_pk_bf16(u[2], u[3]) << 32);
            }
        }
    }
}

__device__ __forceinline__ void ph_combine(Frame& F, CArgsP A, int l) {
    const int gw = F.vcu * NWAVES + F.wave, NGW = F.G * NWAVES;
    const float lam = ((const float*)(F.ctl + CW_LAM))[l], lam_init = 0.8f - 0.6f * expf(-0.3f * (float)l);
    const bf16* OC0 = (const bf16*)(F.ws + B_OC); const bf16* OC1 = OC0 + (size_t)MT * 1024;
    bf16* OA = (bf16*)(F.ws + B_OA);
    const float* subln = GIN(A, 10) + l * 128;
    const float g0 = subln[2 * F.lane], g1 = subln[2 * F.lane + 1];
    {
        const int gt = gw * 64 + F.lane, NGT = NGW * 64;
        const float sc = 1.f - lam_init;
        for (int i = gt; i < MP * 128; i += NGT) {
            const size_t off = (size_t)(i >> 4) * 128 + (i & 15) * 8;
            const v4u w0 = *(const v4u*)(OC0 + off), w1 = *(const v4u*)(OC1 + off);
            float a[8];
            a[0] = bflo(w0.x) - lam * bflo(w1.x); a[1] = bfhi(w0.x) - lam * bfhi(w1.x); a[2] = bflo(w0.y) - lam * bflo(w1.y); a[3] = bfhi(w0.y) - lam * bfhi(w1.y);
            a[4] = bflo(w0.z) - lam * bflo(w1.z); a[5] = bfhi(w0.z) - lam * bfhi(w1.z); a[6] = bflo(w0.w) - lam * bflo(w1.w); a[7] = bfhi(w0.w) - lam * bfhi(w1.w);
            float ss = (a[0] * a[0] + a[1] * a[1]) + (a[2] * a[2] + a[3] * a[3]) + (a[4] * a[4] + a[5] * a[5]) + (a[6] * a[6] + a[7] * a[7]);
            ss = reduce16(ss);
            const float r = (1.0f / sqrtf(ss * (1.0f / 128.f) + EPS)) * sc;
            const f32x4 s0 = *(const f32x4*)(subln + (i & 15) * 8), s1 = *(const f32x4*)(subln + (i & 15) * 8 + 4);
            v4u o; o.x = pk2(a[0] * r * s0.x, a[1] * r * s0.y); o.y = pk2(a[2] * r * s0.z, a[3] * r * s0.w); o.z = pk2(a[4] * r * s1.x, a[5] * r * s1.y); o.w = pk2(a[6] * r * s1.z, a[7] * r * s1.w);
            *(v4u*)(OA + off) = o;
        }
    }
    for (int it = MP * 8 + gw; it < MT * 8; it += NGW) {
        const int row = it >> 3, h = it & 7;
        float a0, a1;
        {
            const int b = (row - MP) >> 5, qi = (row - MP) & 31;
            float oc[2][2];
#pragma unroll
            for (int c = 0; c < 2; ++c) {
                const float* sp = (const float*)(F.ws + WS_SP) + ((size_t)(((b * 8 + h) * 2 + c) * 8) * 32 + qi) * 132;
                float mx = -1e30f;
#pragma unroll
                for (int s = 0; s < 8; ++s) mx = fmaxf(mx, sp[(size_t)s * 32 * 132]);
                float L = 0.f, x0 = 0.f, x1 = 0.f;
#pragma unroll
                for (int s = 0; s < 8; ++s) { const float* p = sp + (size_t)s * 32 * 132; const float w = exp2f(p[0] - mx); L += w * p[1]; x0 += w * p[4 + 2 * F.lane]; x1 += w * p[4 + 2 * F.lane + 1]; }
                oc[c][0] = x0 / L; oc[c][1] = x1 / L;
            }
            a0 = oc[0][0] - lam * oc[1][0]; a1 = oc[0][1] - lam * oc[1][1];
        }
        const float ss = wave_sum(a0 * a0 + a1 * a1);
        const float r = (1.0f / sqrtf(ss * (1.0f / 128.f) + EPS)) * (1.f - lam_init);
        *(unsigned*)(OA + (size_t)row * 1024 + h * 128 + 2 * F.lane) = pk2(a0 * r * g0, a1 * r * g1);
    }
}

constexpr int CK_L = 32;
constexpr int CK_LDF = 0;
constexpr int CK_AT = CK_LDF + 2048, CK_RT = CK_AT + 32 * 144, CK_BT = CK_RT + 32 * 144, CK_KT = CK_BT + 32 * 144;
constexpr int CK_TR = CK_KT + 32 * 144, CK_TR_SZ = 3 * 64 * 80;
constexpr int CK_BTT = 0, CK_KTT = 64 * 80, CK_VT = 2 * 64 * 80;
constexpr int CK_MM = CK_TR + 2 * CK_TR_SZ, CK_MM_SZ = 32 * 144 + 3 * 32 * 80;
constexpr int CK_MBA = 0, CK_MKA = 32 * 144, CK_MBR = CK_MKA + 32 * 80, CK_MKR = CK_MBR + 32 * 80;
constexpr int CK_RHS = CK_MM + 2 * CK_MM_SZ;
constexpr int CK_U = CK_RHS + 8192;
constexpr int CK_SB = CK_U + 64 * 80;
constexpr int CK_YB = CK_SB + 64 * 144;
constexpr int CK_EXPL = CK_YB + 8192;
constexpr int CK_SH = CK_EXPL + 512;
constexpr int CK_LOR = CK_SH + 768;
static_assert(CK_LOR + 3 * 4096 <= RING_BYTES, "scan LDS");
typedef float f32x16s __attribute__((ext_vector_type(16)));
typedef float f32x2 __attribute__((ext_vector_type(2)));

__device__ __forceinline__ void unpack4(unsigned long long w, float (&o)[4]) { o[0] = bflo((unsigned)w); o[1] = bfhi((unsigned)w); o[2] = bflo((unsigned)(w >> 32)); o[3] = bfhi((unsigned)(w >> 32)); }
__device__ __forceinline__ unsigned long long pack4bf(float a, float b, float c, float d) { return (unsigned long long)pg8::cvt_pk_bf16(a, b) | ((unsigned long long)pg8::cvt_pk_bf16(c, d) << 32); }
#define CK_FRAG(base, stride, R0, ks) (*(const LAS bf16x8*)(L + (base) + ((R0) + r32) * (stride) + (16 * (ks) + 8 * hh) * 2))
#define CK_FRAGT(base, R0, ks) (*(const LAS bf16x8*)(L + (base) + ((R0) + r32) * 80 + (((2 * (ks) + hh) ^ ((((R0) + r32) >> 3) & 3)) * 16)))
#define CK_MFMA(acc, a, b) acc = __builtin_amdgcn_mfma_f32_32x32x16_bf16(a, b, acc, 0, 0, 0)
#define CK_BAR() do { asm volatile("s_waitcnt lgkmcnt(0)" ::: "memory"); __builtin_amdgcn_s_barrier(); asm volatile("" ::: "memory"); } while (0)

__device__ __forceinline__ void scan_chunked(Frame& F, CArgsP A, int l, int item, const bf16* WLORA, const bf16* LINP) {
    const bool smp = item >= 128; const int bh = item & 127, b = bh >> 4, h = bh & 15;
    const int T = smp ? DEC_SEQ : SEQ, row0 = smp ? MP + b * DEC_SEQ : b * SEQ, nch = T / CK_L;
    const int w = F.wave;
    LAS unsigned char* L = F.lds + RING_OFF;
    { int tid = threadIdx.x; asm volatile("" : "+v"(tid)); if (tid < 192) { const int part = tid >> 6, ch_ = tid & 63; *(LAS float*)(L + CK_SH + tid * 4) = smp ? GIN(A, 5)[(size_t)(l * 8 + b) * P_RW + part * 1024 + h * 64 + ch_] : 0.f; } }
    __builtin_amdgcn_sched_barrier(0);
    if (w < 4) {
        const int kh = (w >> 1) & 1, ih = w & 1;
        f32x16s Sacc;
#pragma unroll
        for (int r = 0; r < 16; ++r) Sacc[r] = 0.f;
        {
            const int lane = F.lane, r32 = lane & 31, hh = lane >> 5;
            if (smp) {
                const float* s0 = GIN(A, 4) + (((size_t)(l * 8 + b) * 16 + h) * 64 + 32 * ih + r32) * 64 + 32 * kh + 4 * hh;
#pragma unroll
                for (int g = 0; g < 4; ++g) { const f32x4 v = *(const f32x4*)(s0 + 8 * g); Sacc[4 * g] = v.x; Sacc[4 * g + 1] = v.y; Sacc[4 * g + 2] = v.z; Sacc[4 * g + 3] = v.w; }
            }
#pragma unroll
            for (int g = 0; g < 4; ++g) *(LAS unsigned long long*)(L + CK_SB + (32 * ih + r32) * 144 + (32 * kh + 8 * g + 4 * hh) * 2) = pack4bf(Sacc[4 * g], Sacc[4 * g + 1], Sacc[4 * g + 2], Sacc[4 * g + 3]);
        }
        const int lor = w - 1, lkb = (lor == 2) ? 128 : 64 * lor;
        bf16x8 wfr[16], afr[8];
        auto lora_loadw = [&](const int lane) __attribute__((always_inline)) {
            if (w >= 1) { const int r32 = lane & 31, hh = lane >> 5;
                const bf16* wr_ = WLORA + (size_t)(lor * 1024 + h * 64 + r32) * 256 + lkb + 8 * hh;
#pragma unroll
                for (int ks = 0; ks < 4; ++ks) { wfr[ks] = *(const bf16x8*)(wr_ + 16 * ks); wfr[8 + ks] = *(const bf16x8*)(wr_ + 32 * 256 + 16 * ks); }
                if (lor == 2) {
#pragma unroll
                    for (int ks = 4; ks < 8; ++ks) { wfr[ks] = *(const bf16x8*)(wr_ + 16 * ks); wfr[8 + ks] = *(const bf16x8*)(wr_ + 32 * 256 + 16 * ks); } }
            }
        };
        auto lora_load = [&](const int chx, const int lane) __attribute__((always_inline)) {
            if (w >= 1 && chx < nch) { const int r32 = lane & 31, hh = lane >> 5;
                const bf16* ar_ = LINP + (size_t)(row0 + chx * CK_L + r32) * 256 + lkb + 8 * hh;
#pragma unroll
                for (int ks = 0; ks < 4; ++ks) afr[ks] = *(const bf16x8*)(ar_ + 16 * ks);
                if (lor == 2) {
#pragma unroll
                    for (int ks = 4; ks < 8; ++ks) afr[ks] = *(const bf16x8*)(ar_ + 16 * ks); }
            }
        };
        auto lora_compute = [&](const int chx, const int lane) __attribute__((always_inline)) {
            if (w >= 1 && chx < nch) { const int r32 = lane & 31, hh = lane >> 5;
#pragma unroll
                for (int cbk = 0; cbk < 2; ++cbk) {
                    f32x16s a_;
#pragma unroll
                    for (int q = 0; q < 16; ++q) a_[q] = 0.f;
#pragma unroll
                    for (int ks = 0; ks < 4; ++ks) CK_MFMA(a_, afr[ks], wfr[cbk * 8 + ks]);
                    if (lor == 2) {
#pragma unroll
                        for (int ks = 4; ks < 8; ++ks) CK_MFMA(a_, afr[ks], wfr[cbk * 8 + ks]); }
                    const int chn_ = l * 1024 + h * 64 + 32 * cbk + r32;
                    LAS unsigned short* op_ = (LAS unsigned short*)(L + CK_LOR + lor * 4096 + (4 * hh * 64 + 32 * cbk + r32) * 2);
                    if (lor == 0) { const float lb_ = GIN(A, 13)[chn_];
#pragma unroll
                        for (int q = 0; q < 16; ++q) op_[((q & 3) + 8 * (q >> 2)) * 64] = (unsigned short)f2bf(pg8::neg_decay_log(a_[q] + lb_)); }
                    else if (lor == 1) { const float lb_ = GIN(A, 15)[chn_];
#pragma unroll
                        for (int q = 0; q < 16; ++q) op_[((q & 3) + 8 * (q >> 2)) * 64] = (unsigned short)f2bf(pg8::fast_sigmoid(a_[q] + lb_)); }
                    else {
#pragma unroll
                        for (int q = 0; q < 16; ++q) op_[((q & 3) + 8 * (q >> 2)) * 64] = (unsigned short)f2bf(a_[q]); }
                }
            }
        };
        { int tl_ = threadIdx.x; asm volatile("" : "+v"(tl_)); tl_ &= 63; lora_load(0, tl_); lora_loadw(tl_); lora_compute(0, tl_); lora_load(1, tl_); }
        __syncthreads();
        CK_BAR();
        { int tl_ = threadIdx.x; asm volatile("" : "+v"(tl_)); tl_ &= 63; lora_loadw(tl_); lora_compute(1, tl_); }
        CK_BAR(); CK_BAR();
        for (int ch = 0; ch < nch; ++ch) {
            int tid_ = threadIdx.x; asm volatile("" : "+v"(tid_));
            const int lane = tid_ & 63, r32 = lane & 31, hh = lane >> 5;
            const int TR = CK_TR + (ch & 1) * CK_TR_SZ, MM = CK_MM + (ch & 1) * CK_MM_SZ;
            lora_load(ch + 2, lane);
            f32x16s acc;
#pragma unroll
            for (int q = 0; q < 16; ++q) acc[q] = 0.f;
            {
                const int abase = (w & 2) ? CK_RT : CK_AT;
#pragma unroll
                for (int ks = 0; ks < 4; ++ks) CK_MFMA(acc, CK_FRAG(abase, 144, 0, ks), CK_FRAG(CK_SB, 144, 32 * ih, ks));
            }
            CK_BAR();
            if (ch + 2 < nch) lora_loadw(lane);
            if (w < 2) {
#pragma unroll
                for (int ks = 0; ks < 2; ++ks) CK_MFMA(acc, CK_FRAG(MM + CK_MKA, 80, 0, ks), CK_FRAGT(TR + CK_VT, 32 * ih, ks));
#pragma unroll
                for (int q = 0; q < 16; ++q) *(LAS float*)(L + CK_RHS + (((q & 3) + 8 * (q >> 2) + 4 * hh) * 64 + 32 * ih + r32) * 4) = acc[q];
            }
            CK_BAR();
            lora_compute(ch + 2, lane);
            if (w == 0) {
                f32x2 xx[CK_L / 2];
#pragma unroll
                for (int j = 0; j < CK_L / 2; ++j) xx[j] = (f32x2){*(const LAS float*)(L + CK_RHS + ((2 * j) * 64 + lane) * 4), *(const LAS float*)(L + CK_RHS + ((2 * j + 1) * 64 + lane) * 4)};
                const LAS unsigned char* mb = L + MM + CK_MBA;
                f32x4 ring[15]; f32x2 x2;
                ring[0] = *(const LAS f32x4*)(mb + 0); ring[1] = *(const LAS f32x4*)(mb + 16); ring[2] = *(const LAS f32x4*)(mb + 32); ring[3] = *(const LAS f32x4*)(mb + 48); ring[4] = *(const LAS f32x4*)(mb + 64); ring[5] = *(const LAS f32x4*)(mb + 80); ring[6] = *(const LAS f32x4*)(mb + 96); ring[7] = *(const LAS f32x4*)(mb + 112); ring[8] = *(const LAS f32x4*)(mb + 144); ring[9] = *(const LAS f32x4*)(mb + 160); ring[10] = *(const LAS f32x4*)(mb + 176); ring[11] = *(const LAS f32x4*)(mb + 192); ring[12] = *(const LAS f32x4*)(mb + 208); ring[13] = *(const LAS f32x4*)(mb + 224); ring[14] = *(const LAS f32x4*)(mb + 240);
                __builtin_amdgcn_sched_barrier(0);
                x2 = (f32x2){xx[0][0], xx[0][0]}; xx[0] = __builtin_elementwise_fma(x2, (f32x2){ring[0].x, ring[0].y}, xx[0]); xx[1] = __builtin_elementwise_fma(x2, (f32x2){ring[0].z, ring[0].w}, xx[1]); ring[0] = *(const LAS f32x4*)(mb + 256); __builtin_amdgcn_sched_barrier(0);
                xx[2] = __builtin_elementwise_fma(x2, (f32x2){ring[1].x, ring[1].y}, xx[2]); xx[3] = __builtin_elementwise_fma(x2, (f32x2){ring[1].z, ring[1].w}, xx[3]); ring[1] = *(const LAS f32x4*)(mb + 288); __builtin_amdgcn_sched_barrier(0);
                xx[4] = __builtin_elementwise_fma(x2, (f32x2){ring[2].x, ring[2].y}, xx[4]); xx[5] = __builtin_elementwise_fma(x2, (f32x2){ring[2].z, ring[2].w}, xx[5]); ring[2] = *(const LAS f32x4*)(mb + 304); __builtin_amdgcn_sched_barrier(0);
                xx[6] = __builtin_elementwise_fma(x2, (f32x2){ring[3].x, ring[3].y}, xx[6]); xx[7] = __builtin_elementwise_fma(x2, (f32x2){ring[3].z, ring[3].w}, xx[7]); ring[3] = *(const LAS f32x4*)(mb + 320); __builtin_amdgcn_sched_barrier(0);
                xx[8] = __builtin_elementwise_fma(x2, (f32x2){ring[4].x, ring[4].y}, xx[8]); xx[9] = __builtin_elementwise_fma(x2, (f32x2){ring[4].z, ring[4].w}, xx[9]); ring[4] = *(const LAS f32x4*)(mb + 336); __builtin_amdgcn_sched_barrier(0);
                xx[10] = __builtin_elementwise_fma(x2, (f32x2){ring[5].x, ring[5].y}, xx[10]); xx[11] = __builtin_elementwise_fma(x2, (f32x2){ring[5].z, ring[5].w}, xx[11]); ring[5] = *(const LAS f32x4*)(mb + 352); __builtin_amdgcn_sched_barrier(0);
                xx[12] = __builtin_elementwise_fma(x2, (f32x2){ring[6].x, ring[6].y}, xx[12]); xx[13] = __builtin_elementwise_fma(x2, (f32x2){ring[6].z, ring[6].w}, xx[13]); ring[6] = *(const LAS f32x4*)(mb + 368); __builtin_amdgcn_sched_barrier(0);
                xx[14] = __builtin_elementwise_fma(x2, (f32x2){ring[7].x, ring[7].y}, xx[14]); xx[15] = __builtin_elementwise_fma(x2, (f32x2){ring[7].z, ring[7].w}, xx[15]); ring[7] = *(const LAS f32x4*)(mb + 384); __builtin_amdgcn_sched_barrier(0);
                x2 = (f32x2){xx[0][1], xx[0][1]}; xx[0] = __builtin_elementwise_fma(x2, (f32x2){ring[8].x, ring[8].y}, xx[0]); xx[1] = __builtin_elementwise_fma(x2, (f32x2){ring[8].z, ring[8].w}, xx[1]); ring[8] = *(const LAS f32x4*)(mb + 400); __builtin_amdgcn_sched_barrier(0);
                xx[2] = __builtin_elementwise_fma(x2, (f32x2){ring[9].x, ring[9].y}, xx[2]); xx[3] = __builtin_elementwise_fma(x2, (f32x2){ring[9].z, ring[9].w}, xx[3]); ring[9] = *(const LAS f32x4*)(mb + 448); __builtin_amdgcn_sched_barrier(0);
                xx[4] = __builtin_elementwise_fma(x2, (f32x2){ring[10].x, ring[10].y}, xx[4]); xx[5] = __builtin_elementwise_fma(x2, (f32x2){ring[10].z, ring[10].w}, xx[5]); ring[10] = *(const LAS f32x4*)(mb + 464); __builtin_amdgcn_sched_barrier(0);
                xx[6] = __builtin_elementwise_fma(x2, (f32x2){ring[11].x, ring[11].y}, xx[6]); xx[7] = __builtin_elementwise_fma(x2, (f32x2){ring[11].z, ring[11].w}, xx[7]); ring[11] = *(const LAS f32x4*)(mb + 480); __builtin_amdgcn_sched_barrier(0);
                xx[8] = __builtin_elementwise_fma(x2, (f32x2){ring[12].x, ring[12].y}, xx[8]); xx[9] = __builtin_elementwise_fma(x2, (f32x2){ring[12].z, ring[12].w}, xx[9]); ring[12] = *(const LAS f32x4*)(mb + 496); __builtin_amdgcn_sched_barrier(0);
                xx[10] = __builtin_elementwise_fma(x2, (f32x2){ring[13].x, ring[13].y}, xx[10]); xx[11] = __builtin_elementwise_fma(x2, (f32x2){ring[13].z, ring[13].w}, xx[11]); ring[13] = *(const LAS f32x4*)(mb + 512); __builtin_amdgcn_sched_barrier(0);
                xx[12] = __builtin_elementwise_fma(x2, (f32x2){ring[14].x, ring[14].y}, xx[12]); xx[13] = __builtin_elementwise_fma(x2, (f32x2){ring[14].z, ring[14].w}, xx[13]); ring[14] = *(const LAS f32x4*)(mb + 528); __builtin_amdgcn_sched_barrier(0);
                xx[14] = __builtin_elementwise_fma(x2, (f32x2){ring[0].x, ring[0].y}, xx[14]); xx[15] = __builtin_elementwise_fma(x2, (f32x2){ring[0].z, ring[0].w}, xx[15]); ring[0] = *(const LAS f32x4*)(mb + 544); __builtin_amdgcn_sched_barrier(0);
                x2 = (f32x2){xx[1][0], xx[1][0]}; xx[0] = __builtin_elementwise_fma(x2, (f32x2){ring[1].x, ring[1].y}, xx[0]); xx[1] = __builtin_elementwise_fma(x2, (f32x2){ring[1].z, ring[1].w}, xx[1]); ring[1] = *(const LAS f32x4*)(mb + 592); __builtin_amdgcn_sched_barrier(0);
                xx[2] = __builtin_elementwise_fma(x2, (f32x2){ring[2].x, ring[2].y}, xx[2]); xx[3] = __builtin_elementwise_fma(x2, (f32x2){ring[2].z, ring[2].w}, xx[3]); ring[2] = *(const LAS f32x4*)(mb + 608); __builtin_amdgcn_sched_barrier(0);
                xx[4] = __builtin_elementwise_fma(x2, (f32x2){ring[3].x, ring[3].y}, xx[4]); xx[5] = __builtin_elementwise_fma(x2, (f32x2){ring[3].z, ring[3].w}, xx[5]); ring[3] = *(const LAS f32x4*)(mb + 624); __builtin_amdgcn_sched_barrier(0);
                xx[6] = __builtin_elementwise_fma(x2, (f32x2){ring[4].x, ring[4].y}, xx[6]); xx[7] = __builtin_elementwise_fma(x2, (f32x2){ring[4].z, ring[4].w}, xx[7]); ring[4] = *(const LAS f32x4*)(mb + 640); __builtin_amdgcn_sched_barrier(0);
                xx[8] = __builtin_elementwise_fma(x2, (f32x2){ring[5].x, ring[5].y}, xx[8]); xx[9] = __builtin_elementwise_fma(x2, (f32x2){ring[5].z, ring[5].w}, xx[9]); ring[5] = *(const LAS f32x4*)(mb + 656); __builtin_amdgcn_sched_barrier(0);
                xx[10] = __builtin_elementwise_fma(x2, (f32x2){ring[6].x, ring[6].y}, xx[10]); xx[11] = __builtin_elementwise_fma(x2, (f32x2){ring[6].z, ring[6].w}, xx[11]); ring[6] = *(const LAS f32x4*)(mb + 672); __builtin_amdgcn_sched_barrier(0);
                xx[12] = __builtin_elementwise_fma(x2, (f32x2){ring[7].x, ring[7].y}, xx[12]); xx[13] = __builtin_elementwise_fma(x2, (f32x2){ring[7].z, ring[7].w}, xx[13]); ring[7] = *(const LAS f32x4*)(mb + 688); __builtin_amdgcn_sched_barrier(0);
                xx[14] = __builtin_elementwise_fma(x2, (f32x2){ring[8].x, ring[8].y}, xx[14]); xx[15] = __builtin_elementwise_fma(x2, (f32x2){ring[8].z, ring[8].w}, xx[15]); ring[8] = *(const LAS f32x4*)(mb + 736); __builtin_amdgcn_sched_barrier(0);
                x2 = (f32x2){xx[1][1], xx[1][1]}; xx[2] = __builtin_elementwise_fma(x2, (f32x2){ring[9].x, ring[9].y}, xx[2]); xx[3] = __builtin_elementwise_fma(x2, (f32x2){ring[9].z, ring[9].w}, xx[3]); ring[9] = *(const LAS f32x4*)(mb + 752); __builtin_amdgcn_sched_barrier(0);
                xx[4] = __builtin_elementwise_fma(x2, (f32x2){ring[10].x, ring[10].y}, xx[4]); xx[5] = __builtin_elementwise_fma(x2, (f32x2){ring[10].z, ring[10].w}, xx[5]); ring[10] = *(const LAS f32x4*)(mb + 768); __builtin_amdgcn_sched_barrier(0);
                xx[6] = __builtin_elementwise_fma(x2, (f32x2){ring[11].x, ring[11].y}, xx[6]); xx[7] = __builtin_elementwise_fma(x2, (f32x2){ring[11].z, ring[11].w}, xx[7]); ring[11] = *(const LAS f32x4*)(mb + 784); __builtin_amdgcn_sched_barrier(0);
                xx[8] = __builtin_elementwise_fma(x2, (f32x2){ring[12].x, ring[12].y}, xx[8]); xx[9] = __builtin_elementwise_fma(x2, (f32x2){ring[12].z, ring[12].w}, xx[9]); ring[12] = *(const LAS f32x4*)(mb + 800); __builtin_amdgcn_sched_barrier(0);
                xx[10] = __builtin_elementwise_fma(x2, (f32x2){ring[13].x, ring[13].y}, xx[10]); xx[11] = __builtin_elementwise_fma(x2, (f32x2){ring[13].z, ring[13].w}, xx[11]); ring[13] = *(const LAS f32x4*)(mb + 816); __builtin_amdgcn_sched_barrier(0);
                xx[12] = __builtin_elementwise_fma(x2, (f32x2){ring[14].x, ring[14].y}, xx[12]); xx[13] = __builtin_elementwise_fma(x2, (f32x2){ring[14].z, ring[14].w}, xx[13]); ring[14] = *(const LAS f32x4*)(mb + 832); __builtin_amdgcn_sched_barrier(0);
                xx[14] = __builtin_elementwise_fma(x2, (f32x2){ring[0].x, ring[0].y}, xx[14]); xx[15] = __builtin_elementwise_fma(x2, (f32x2){ring[0].z, ring[0].w}, xx[15]); ring[0] = *(const LAS f32x4*)(mb + 880); __builtin_amdgcn_sched_barrier(0);
                x2 = (f32x2){xx[2][0], xx[2][0]}; xx[2] = __builtin_elementwise_fma(x2, (f32x2){ring[1].x, ring[1].y}, xx[2]); xx[3] = __builtin_elementwise_fma(x2, (f32x2){ring[1].z, ring[1].w}, xx[3]); ring[1] = *(const LAS f32x4*)(mb + 896); __builtin_amdgcn_sched_barrier(0);
                xx[4] = __builtin_elementwise_fma(x2, (f32x2){ring[2].x, ring[2].y}, xx[4]); xx[5] = __builtin_elementwise_fma(x2, (f32x2){ring[2].z, ring[2].w}, xx[5]); ring[2] = *(const LAS f32x4*)(mb + 912); __builtin_amdgcn_sched_barrier(0);
                xx[6] = __builtin_elementwise_fma(x2, (f32x2){ring[3].x, ring[3].y}, xx[6]); xx[7] = __builtin_elementwise_fma(x2, (f32x2){ring[3].z, ring[3].w}, xx[7]); ring[3] = *(const LAS f32x4*)(mb + 928); __builtin_amdgcn_sched_barrier(0);
                xx[8] = __builtin_elementwise_fma(x2, (f32x2){ring[4].x, ring[4].y}, xx[8]); xx[9] = __builtin_elementwise_fma(x2, (f32x2){ring[4].z, ring[4].w}, xx[9]); ring[4] = *(const LAS f32x4*)(mb + 944); __builtin_amdgcn_sched_barrier(0);
                xx[10] = __builtin_elementwise_fma(x2, (f32x2){ring[5].x, ring[5].y}, xx[10]); xx[11] = __builtin_elementwise_fma(x2, (f32x2){ring[5].z, ring[5].w}, xx[11]); ring[5] = *(const LAS f32x4*)(mb + 960); __builtin_amdgcn_sched_barrier(0);
                xx[12] = __builtin_elementwise_fma(x2, (f32x2){ring[6].x, ring[6].y}, xx[12]); xx[13] = __builtin_elementwise_fma(x2, (f32x2){ring[6].z, ring[6].w}, xx[13]); ring[6] = *(const LAS f32x4*)(mb + 976); __builtin_amdgcn_sched_barrier(0);
                xx[14] = __builtin_elementwise_fma(x2, (f32x2){ring[7].x, ring[7].y}, xx[14]); xx[15] = __builtin_elementwise_fma(x2, (f32x2){ring[7].z, ring[7].w}, xx[15]); ring[7] = *(const LAS f32x4*)(mb + 1040); __builtin_amdgcn_sched_barrier(0);
                x2 = (f32x2){xx[2][1], xx[2][1]}; xx[2] = __builtin_elementwise_fma(x2, (f32x2){ring[8].x, ring[8].y}, xx[2]); xx[3] = __builtin_elementwise_fma(x2, (f32x2){ring[8].z, ring[8].w}, xx[3]); ring[8] = *(const LAS f32x4*)(mb + 1056); __builtin_amdgcn_sched_barrier(0);
                xx[4] = __builtin_elementwise_fma(x2, (f32x2){ring[9].x, ring[9].y}, xx[4]); xx[5] = __builtin_elementwise_fma(x2, (f32x2){ring[9].z, ring[9].w}, xx[5]); ring[9] = *(const LAS f32x4*)(mb + 1072); __builtin_amdgcn_sched_barrier(0);
                xx[6] = __builtin_elementwise_fma(x2, (f32x2){ring[10].x, ring[10].y}, xx[6]); xx[7] = __builtin_elementwise_fma(x2, (f32x2){ring[10].z, ring[10].w}, xx[7]); ring[10] = *(const LAS f32x4*)(mb + 1088); __builtin_amdgcn_sched_barrier(0);
                xx[8] = __builtin_elementwise_fma(x2, (f32x2){ring[11].x, ring[11].y}, xx[8]); xx[9] = __builtin_elementwise_fma(x2, (f32x2){ring[11].z, ring[11].w}, xx[9]); ring[11] = *(const LAS f32x4*)(mb + 1104); __builtin_amdgcn_sched_barrier(0);
                xx[10] = __builtin_elementwise_fma(x2, (f32x2){ring[12].x, ring[12].y}, xx[10]); xx[11] = __builtin_elementwise_fma(x2, (f32x2){ring[12].z, ring[12].w}, xx[11]); ring[12] = *(const LAS f32x4*)(mb + 1120); __builtin_amdgcn_sched_barrier(0);
                xx[12] = __builtin_elementwise_fma(x2, (f32x2){ring[13].x, ring[13].y}, xx[12]); xx[13] = __builtin_elementwise_fma(x2, (f32x2){ring[13].z, ring[13].w}, xx[13]); ring[13] = *(const LAS f32x4*)(mb + 1184); __builtin_amdgcn_sched_barrier(0);
                xx[14] = __builtin_elementwise_fma(x2, (f32x2){ring[14].x, ring[14].y}, xx[14]); xx[15] = __builtin_elementwise_fma(x2, (f32x2){ring[14].z, ring[14].w}, xx[15]); ring[14] = *(const LAS f32x4*)(mb + 1200); __builtin_amdgcn_sched_barrier(0);
                x2 = (f32x2){xx[3][0], xx[3][0]}; xx[2] = __builtin_elementwise_fma(x2, (f32x2){ring[0].x, ring[0].y}, xx[2]); xx[3] = __builtin_elementwise_fma(x2, (f32x2){ring[0].z, ring[0].w}, xx[3]); ring[0] = *(const LAS f32x4*)(mb + 1216); __builtin_amdgcn_sched_barrier(0);
                xx[4] = __builtin_elementwise_fma(x2, (f32x2){ring[1].x, ring[1].y}, xx[4]); xx[5] = __builtin_elementwise_fma(x2, (f32x2){ring[1].z, ring[1].w}, xx[5]); ring[1] = *(const LAS f32x4*)(mb + 1232); __builtin_amdgcn_sched_barrier(0);
                xx[6] = __builtin_elementwise_fma(x2, (f32x2){ring[2].x, ring[2].y}, xx[6]); xx[7] = __builtin_elementwise_fma(x2, (f32x2){ring[2].z, ring[2].w}, xx[7]); ring[2] = *(const LAS f32x4*)(mb + 1248); __builtin_amdgcn_sched_barrier(0);
                xx[8] = __builtin_elementwise_fma(x2, (f32x2){ring[3].x, ring[3].y}, xx[8]); xx[9] = __builtin_elementwise_fma(x2, (f32x2){ring[3].z, ring[3].w}, xx[9]); ring[3] = *(const LAS f32x4*)(mb + 1264); __builtin_amdgcn_sched_barrier(0);
                xx[10] = __builtin_elementwise_fma(x2, (f32x2){ring[4].x, ring[4].y}, xx[10]); xx[11] = __builtin_elementwise_fma(x2, (f32x2){ring[4].z, ring[4].w}, xx[11]); ring[4] = *(const LAS f32x4*)(mb + 1328); __builtin_amdgcn_sched_barrier(0);
                xx[12] = __builtin_elementwise_fma(x2, (f32x2){ring[5].x, ring[5].y}, xx[12]); xx[13] = __builtin_elementwise_fma(x2, (f32x2){ring[5].z, ring[5].w}, xx[13]); ring[5] = *(const LAS f32x4*)(mb + 1344); __builtin_amdgcn_sched_barrier(0);
                xx[14] = __builtin_elementwise_fma(x2, (f32x2){ring[6].x, ring[6].y}, xx[14]); xx[15] = __builtin_elementwise_fma(x2, (f32x2){ring[6].z, ring[6].w}, xx[15]); ring[6] = *(const LAS f32x4*)(mb + 1360); __builtin_amdgcn_sched_barrier(0);
                x2 = (f32x2){xx[3][1], xx[3][1]}; xx[4] = __builtin_elementwise_fma(x2, (f32x2){ring[7].x, ring[7].y}, xx[4]); xx[5] = __builtin_elementwise_fma(x2, (f32x2){ring[7].z, ring[7].w}, xx[5]); ring[7] = *(const LAS f32x4*)(mb + 1376); __builtin_amdgcn_sched_barrier(0);
                xx[6] = __builtin_elementwise_fma(x2, (f32x2){ring[8].x, ring[8].y}, xx[6]); xx[7] = __builtin_elementwise_fma(x2, (f32x2){ring[8].z, ring[8].w}, xx[7]); ring[8] = *(const LAS f32x4*)(mb + 1392); __builtin_amdgcn_sched_barrier(0);
                xx[8] = __builtin_elementwise_fma(x2, (f32x2){ring[9].x, ring[9].y}, xx[8]); xx[9] = __builtin_elementwise_fma(x2, (f32x2){ring[9].z, ring[9].w}, xx[9]); ring[9] = *(const LAS f32x4*)(mb + 1408); __builtin_amdgcn_sched_barrier(0);
                xx[10] = __builtin_elementwise_fma(x2, (f32x2){ring[10].x, ring[10].y}, xx[10]); xx[11] = __builtin_elementwise_fma(x2, (f32x2){ring[10].z, ring[10].w}, xx[11]); ring[10] = *(const LAS f32x4*)(mb + 1472); __builtin_amdgcn_sched_barrier(0);
                xx[12] = __builtin_elementwise_fma(x2, (f32x2){ring[11].x, ring[11].y}, xx[12]); xx[13] = __builtin_elementwise_fma(x2, (f32x2){ring[11].z, ring[11].w}, xx[13]); ring[11] = *(const LAS f32x4*)(mb + 1488); __builtin_amdgcn_sched_barrier(0);
                xx[14] = __builtin_elementwise_fma(x2, (f32x2){ring[12].x, ring[12].y}, xx[14]); xx[15] = __builtin_elementwise_fma(x2, (f32x2){ring[12].z, ring[12].w}, xx[15]); ring[12] = *(const LAS f32x4*)(mb + 1504); __builtin_amdgcn_sched_barrier(0);
                x2 = (f32x2){xx[4][0], xx[4][0]}; xx[4] = __builtin_elementwise_fma(x2, (f32x2){ring[13].x, ring[13].y}, xx[4]); xx[5] = __builtin_elementwise_fma(x2, (f32x2){ring[13].z, ring[13].w}, xx[5]); ring[13] = *(const LAS f32x4*)(mb + 1520); __builtin_amdgcn_sched_barrier(0);
                xx[6] = __builtin_elementwise_fma(x2, (f32x2){ring[14].x, ring[14].y}, xx[6]); xx[7] = __builtin_elementwise_fma(x2, (f32x2){ring[14].z, ring[14].w}, xx[7]); ring[14] = *(const LAS f32x4*)(mb + 1536); __builtin_amdgcn_sched_barrier(0);
                xx[8] = __builtin_elementwise_fma(x2, (f32x2){ring[0].x, ring[0].y}, xx[8]); xx[9] = __builtin_elementwise_fma(x2, (f32x2){ring[0].z, ring[0].w}, xx[9]); ring[0] = *(const LAS f32x4*)(mb + 1552); __builtin_amdgcn_sched_barrier(0);
                xx[10] = __builtin_elementwise_fma(x2, (f32x2){ring[1].x, ring[1].y}, xx[10]); xx[11] = __builtin_elementwise_fma(x2, (f32x2){ring[1].z, ring[1].w}, xx[11]); ring[1] = *(const LAS f32x4*)(mb + 1632); __builtin_amdgcn_sched_barrier(0);
                xx[12] = __builtin_elementwise_fma(x2, (f32x2){ring[2].x, ring[2].y}, xx[12]); xx[13] = __builtin_elementwise_fma(x2, (f32x2){ring[2].z, ring[2].w}, xx[13]); ring[2] = *(const LAS f32x4*)(mb + 1648); __builtin_amdgcn_sched_barrier(0);
                xx[14] = __builtin_elementwise_fma(x2, (f32x2){ring[3].x, ring[3].y}, xx[14]); xx[15] = __builtin_elementwise_fma(x2, (f32x2){ring[3].z, ring[3].w}, xx[15]); ring[3] = *(const LAS f32x4*)(mb + 1664); __builtin_amdgcn_sched_barrier(0);
                x2 = (f32x2){xx[4][1], xx[4][1]}; xx[4] = __builtin_elementwise_fma(x2, (f32x2){ring[4].x, ring[4].y}, xx[4]); xx[5] = __builtin_elementwise_fma(x2, (f32x2){ring[4].z, ring[4].w}, xx[5]); ring[4] = *(const LAS f32x4*)(mb + 1680); __builtin_amdgcn_sched_barrier(0);
                xx[6] = __builtin_elementwise_fma(x2, (f32x2){ring[5].x, ring[5].y}, xx[6]); xx[7] = __builtin_elementwise_fma(x2, (f32x2){ring[5].z, ring[5].w}, xx[7]); ring[5] = *(const LAS f32x4*)(mb + 1696); __builtin_amdgcn_sched_barrier(0);
                xx[8] = __builtin_elementwise_fma(x2, (f32x2){ring[6].x, ring[6].y}, xx[8]); xx[9] = __builtin_elementwise_fma(x2, (f32x2){ring[6].z, ring[6].w}, xx[9]); ring[6] = *(const LAS f32x4*)(mb + 1776); __builtin_amdgcn_sched_barrier(0);
                xx[10] = __builtin_elementwise_fma(x2, (f32x2){ring[7].x, ring[7].y}, xx[10]); xx[11] = __builtin_elementwise_fma(x2, (f32x2){ring[7].z, ring[7].w}, xx[11]); ring[7] = *(const LAS f32x4*)(mb + 1792); __builtin_amdgcn_sched_barrier(0);
                xx[12] = __builtin_elementwise_fma(x2, (f32x2){ring[8].x, ring[8].y}, xx[12]); xx[13] = __builtin_elementwise_fma(x2, (f32x2){ring[8].z, ring[8].w}, xx[13]); ring[8] = *(const LAS f32x4*)(mb + 1808); __builtin_amdgcn_sched_barrier(0);
                xx[14] = __builtin_elementwise_fma(x2, (f32x2){ring[9].x, ring[9].y}, xx[14]); xx[15] = __builtin_elementwise_fma(x2, (f32x2){ring[9].z, ring[9].w}, xx[15]); ring[9] = *(const LAS f32x4*)(mb + 1824); __builtin_amdgcn_sched_barrier(0);
                x2 = (f32x2){xx[5][0], xx[5][0]}; xx[4] = __builtin_elementwise_fma(x2, (f32x2){ring[10].x, ring[10].y}, xx[4]); xx[5] = __builtin_elementwise_fma(x2, (f32x2){ring[10].z, ring[10].w}, xx[5]); ring[10] = *(const LAS f32x4*)(mb + 1840); __builtin_amdgcn_sched_barrier(0);
                xx[6] = __builtin_elementwise_fma(x2, (f32x2){ring[11].x, ring[11].y}, xx[6]); xx[7] = __builtin_elementwise_fma(x2, (f32x2){ring[11].z, ring[11].w}, xx[7]); ring[11] = *(const LAS f32x4*)(mb + 1920); __builtin_amdgcn_sched_barrier(0);
                xx[8] = __builtin_elementwise_fma(x2, (f32x2){ring[12].x, ring[12].y}, xx[8]); xx[9] = __builtin_elementwise_fma(x2, (f32x2){ring[12].z, ring[12].w}, xx[9]); ring[12] = *(const LAS f32x4*)(mb + 1936); __builtin_amdgcn_sched_barrier(0);
                xx[10] = __builtin_elementwise_fma(x2, (f32x2){ring[13].x, ring[13].y}, xx[10]); xx[11] = __builtin_elementwise_fma(x2, (f32x2){ring[13].z, ring[13].w}, xx[11]); ring[13] = *(const LAS f32x4*)(mb + 1952); __builtin_amdgcn_sched_barrier(0);
                xx[12] = __builtin_elementwise_fma(x2, (f32x2){ring[14].x, ring[14].y}, xx[12]); xx[13] = __builtin_elementwise_fma(x2, (f32x2){ring[14].z, ring[14].w}, xx[13]); ring[14] = *(const LAS f32x4*)(mb + 1968); __builtin_amdgcn_sched_barrier(0);
                xx[14] = __builtin_elementwise_fma(x2, (f32x2){ring[0].x, ring[0].y}, xx[14]); xx[15] = __builtin_elementwise_fma(x2, (f32x2){ring[0].z, ring[0].w}, xx[15]); ring[0] = *(const LAS f32x4*)(mb + 1984); __builtin_amdgcn_sched_barrier(0);
                x2 = (f32x2){xx[5][1], xx[5][1]}; xx[6] = __builtin_elementwise_fma(x2, (f32x2){ring[1].x, ring[1].y}, xx[6]); xx[7] = __builtin_elementwise_fma(x2, (f32x2){ring[1].z, ring[1].w}, xx[7]); ring[1] = *(const LAS f32x4*)(mb + 2064); __builtin_amdgcn_sched_barrier(0);
                xx[8] = __builtin_elementwise_fma(x2, (f32x2){ring[2].x, ring[2].y}, xx[8]); xx[9] = __builtin_elementwise_fma(x2, (f32x2){ring[2].z, ring[2].w}, xx[9]); ring[2] = *(const LAS f32x4*)(mb + 2080); __builtin_amdgcn_sched_barrier(0);
                xx[10] = __builtin_elementwise_fma(x2, (f32x2){ring[3].x, ring[3].y}, xx[10]); xx[11] = __builtin_elementwise_fma(x2, (f32x2){ring[3].z, ring[3].w}, xx[11]); ring[3] = *(const LAS f32x4*)(mb + 2096); __builtin_amdgcn_sched_barrier(0);
                xx[12] = __builtin_elementwise_fma(x2, (f32x2){ring[4].x, ring[4].y}, xx[12]); xx[13] = __builtin_elementwise_fma(x2, (f32x2){ring[4].z, ring[4].w}, xx[13]); ring[4] = *(const LAS f32x4*)(mb + 2112); __builtin_amdgcn_sched_barrier(0);
                xx[14] = __builtin_elementwise_fma(x2, (f32x2){ring[5].x, ring[5].y}, xx[14]); xx[15] = __builtin_elementwise_fma(x2, (f32x2){ring[5].z, ring[5].w}, xx[15]); ring[5] = *(const LAS f32x4*)(mb + 2128); __builtin_amdgcn_sched_barrier(0);
                x2 = (f32x2){xx[6][0], xx[6][0]}; xx[6] = __builtin_elementwise_fma(x2, (f32x2){ring[6].x, ring[6].y}, xx[6]); xx[7] = __builtin_elementwise_fma(x2, (f32x2){ring[6].z, ring[6].w}, xx[7]); ring[6] = *(const LAS f32x4*)(mb + 2224); __builtin_amdgcn_sched_barrier(0);
                xx[8] = __builtin_elementwise_fma(x2, (f32x2){ring[7].x, ring[7].y}, xx[8]); xx[9] = __builtin_elementwise_fma(x2, (f32x2){ring[7].z, ring[7].w}, xx[9]); ring[7] = *(const LAS f32x4*)(mb + 2240); __builtin_amdgcn_sched_barrier(0);
                xx[10] = __builtin_elementwise_fma(x2, (f32x2){ring[8].x, ring[8].y}, xx[10]); xx[11] = __builtin_elementwise_fma(x2, (f32x2){ring[8].z, ring[8].w}, xx[11]); ring[8] = *(const LAS f32x4*)(mb + 2256); __builtin_amdgcn_sched_barrier(0);
                xx[12] = __builtin_elementwise_fma(x2, (f32x2){ring[9].x, ring[9].y}, xx[12]); xx[13] = __builtin_elementwise_fma(x2, (f32x2){ring[9].z, ring[9].w}, xx[13]); ring[9] = *(const LAS f32x4*)(mb + 2272); __builtin_amdgcn_sched_barrier(0);
                xx[14] = __builtin_elementwise_fma(x2, (f32x2){ring[10].x, ring[10].y}, xx[14]); xx[15] = __builtin_elementwise_fma(x2, (f32x2){ring[10].z, ring[10].w}, xx[15]); ring[10] = *(const LAS f32x4*)(mb + 2368); __builtin_amdgcn_sched_barrier(0);
                x2 = (f32x2){xx[6][1], xx[6][1]}; xx[6] = __builtin_elementwise_fma(x2, (f32x2){ring[11].x, ring[11].y}, xx[6]); xx[7] = __builtin_elementwise_fma(x2, (f32x2){ring[11].z, ring[11].w}, xx[7]); ring[11] = *(const LAS f32x4*)(mb + 2384); __builtin_amdgcn_sched_barrier(0);
                xx[8] = __builtin_elementwise_fma(x2, (f32x2){ring[12].x, ring[12].y}, xx[8]); xx[9] = __builtin_elementwise_fma(x2, (f32x2){ring[12].z, ring[12].w}, xx[9]); ring[12] = *(const LAS f32x4*)(mb + 2400); __builtin_amdgcn_sched_barrier(0);
                xx[10] = __builtin_elementwise_fma(x2, (f32x2){ring[13].x, ring[13].y}, xx[10]); xx[11] = __builtin_elementwise_fma(x2, (f32x2){ring[13].z, ring[13].w}, xx[11]); ring[13] = *(const LAS f32x4*)(mb + 2416); __builtin_amdgcn_sched_barrier(0);
                xx[12] = __builtin_elementwise_fma(x2, (f32x2){ring[14].x, ring[14].y}, xx[12]); xx[13] = __builtin_elementwise_fma(x2, (f32x2){ring[14].z, ring[14].w}, xx[13]); ring[14] = *(const LAS f32x4*)(mb + 2512); __builtin_amdgcn_sched_barrier(0);
                xx[14] = __builtin_elementwise_fma(x2, (f32x2){ring[0].x, ring[0].y}, xx[14]); xx[15] = __builtin_elementwise_fma(x2, (f32x2){ring[0].z, ring[0].w}, xx[15]); ring[0] = *(const LAS f32x4*)(mb + 2528); __builtin_amdgcn_sched_barrier(0);
                x2 = (f32x2){xx[7][0], xx[7][0]}; xx[6] = __builtin_elementwise_fma(x2, (f32x2){ring[1].x, ring[1].y}, xx[6]); xx[7] = __builtin_elementwise_fma(x2, (f32x2){ring[1].z, ring[1].w}, xx[7]); ring[1] = *(const LAS f32x4*)(mb + 2544); __builtin_amdgcn_sched_barrier(0);
                xx[8] = __builtin_elementwise_fma(x2, (f32x2){ring[2].x, ring[2].y}, xx[8]); xx[9] = __builtin_elementwise_fma(x2, (f32x2){ring[2].z, ring[2].w}, xx[9]); ring[2] = *(const LAS f32x4*)(mb + 2560); __builtin_amdgcn_sched_barrier(0);
                xx[10] = __builtin_elementwise_fma(x2, (f32x2){ring[3].x, ring[3].y}, xx[10]); xx[11] = __builtin_elementwise_fma(x2, (f32x2){ring[3].z, ring[3].w}, xx[11]); ring[3] = *(const LAS f32x4*)(mb + 2656); __builtin_amdgcn_sched_barrier(0);
                xx[12] = __builtin_elementwise_fma(x2, (f32x2){ring[4].x, ring[4].y}, xx[12]); xx[13] = __builtin_elementwise_fma(x2, (f32x2){ring[4].z, ring[4].w}, xx[13]); ring[4] = *(const LAS f32x4*)(mb + 2672); __builtin_amdgcn_sched_barrier(0);
                xx[14] = __builtin_elementwise_fma(x2, (f32x2){ring[5].x, ring[5].y}, xx[14]); xx[15] = __builtin_elementwise_fma(x2, (f32x2){ring[5].z, ring[5].w}, xx[15]); ring[5] = *(const LAS f32x4*)(mb + 2688); __builtin_amdgcn_sched_barrier(0);
                x2 = (f32x2){xx[7][1], xx[7][1]}; xx[8] = __builtin_elementwise_fma(x2, (f32x2){ring[6].x, ring[6].y}, xx[8]); xx[9] = __builtin_elementwise_fma(x2, (f32x2){ring[6].z, ring[6].w}, xx[9]); ring[6] = *(const LAS f32x4*)(mb + 2704); __builtin_amdgcn_sched_barrier(0);
                xx[10] = __builtin_elementwise_fma(x2, (f32x2){ring[7].x, ring[7].y}, xx[10]); xx[11] = __builtin_elementwise_fma(x2, (f32x2){ring[7].z, ring[7].w}, xx[11]); ring[7] = *(const LAS f32x4*)(mb + 2816); __builtin_amdgcn_sched_barrier(0);
                xx[12] = __builtin_elementwise_fma(x2, (f32x2){ring[8].x, ring[8].y}, xx[12]); xx[13] = __builtin_elementwise_fma(x2, (f32x2){ring[8].z, ring[8].w}, xx[13]); ring[8] = *(const LAS f32x4*)(mb + 2832); __builtin_amdgcn_sched_barrier(0);
                xx[14] = __builtin_elementwise_fma(x2, (f32x2){ring[9].x, ring[9].y}, xx[14]); xx[15] = __builtin_elementwise_fma(x2, (f32x2){ring[9].z, ring[9].w}, xx[15]); ring[9] = *(const LAS f32x4*)(mb + 2848); __builtin_amdgcn_sched_barrier(0);
                x2 = (f32x2){xx[8][0], xx[8][0]}; xx[8] = __builtin_elementwise_fma(x2, (f32x2){ring[10].x, ring[10].y}, xx[8]); xx[9] = __builtin_elementwise_fma(x2, (f32x2){ring[10].z, ring[10].w}, xx[9]); ring[10] = *(const LAS f32x4*)(mb + 2960); __builtin_amdgcn_sched_barrier(0);
                xx[10] = __builtin_elementwise_fma(x2, (f32x2){ring[11].x, ring[11].y}, xx[10]); xx[11] = __builtin_elementwise_fma(x2, (f32x2){ring[11].z, ring[11].w}, xx[11]); ring[11] = *(const LAS f32x4*)(mb + 2976); __builtin_amdgcn_sched_barrier(0);
                xx[12] = __builtin_elementwise_fma(x2, (f32x2){ring[12].x, ring[12].y}, xx[12]); xx[13] = __builtin_elementwise_fma(x2, (f32x2){ring[12].z, ring[12].w}, xx[13]); ring[12] = *(const LAS f32x4*)(mb + 2992); __builtin_amdgcn_sched_barrier(0);
                xx[14] = __builtin_elementwise_fma(x2, (f32x2){ring[13].x, ring[13].y}, xx[14]); xx[15] = __builtin_elementwise_fma(x2, (f32x2){ring[13].z, ring[13].w}, xx[15]); ring[13] = *(const LAS f32x4*)(mb + 3104); __builtin_amdgcn_sched_barrier(0);
                x2 = (f32x2){xx[8][1], xx[8][1]}; xx[8] = __builtin_elementwise_fma(x2, (f32x2){ring[14].x, ring[14].y}, xx[8]); xx[9] = __builtin_elementwise_fma(x2, (f32x2){ring[14].z, ring[14].w}, xx[9]); ring[14] = *(const LAS f32x4*)(mb + 3120); __builtin_amdgcn_sched_barrier(0);
                xx[10] = __builtin_elementwise_fma(x2, (f32x2){ring[0].x, ring[0].y}, xx[10]); xx[11] = __builtin_elementwise_fma(x2, (f32x2){ring[0].z, ring[0].w}, xx[11]); ring[0] = *(const LAS f32x4*)(mb + 3136); __builtin_amdgcn_sched_barrier(0);
                xx[12] = __builtin_elementwise_fma(x2, (f32x2){ring[1].x, ring[1].y}, xx[12]); xx[13] = __builtin_elementwise_fma(x2, (f32x2){ring[1].z, ring[1].w}, xx[13]); ring[1] = *(const LAS f32x4*)(mb + 3248); __builtin_amdgcn_sched_barrier(0);
                xx[14] = __builtin_elementwise_fma(x2, (f32x2){ring[2].x, ring[2].y}, xx[14]); xx[15] = __builtin_elementwise_fma(x2, (f32x2){ring[2].z, ring[2].w}, xx[15]); ring[2] = *(const LAS f32x4*)(mb + 3264); __builtin_amdgcn_sched_barrier(0);
                x2 = (f32x2){xx[9][0], xx[9][0]}; xx[8] = __builtin_elementwise_fma(x2, (f32x2){ring[3].x, ring[3].y}, xx[8]); xx[9] = __builtin_elementwise_fma(x2, (f32x2){ring[3].z, ring[3].w}, xx[9]); ring[3] = *(const LAS f32x4*)(mb + 3280); __builtin_amdgcn_sched_barrier(0);
                xx[10] = __builtin_elementwise_fma(x2, (f32x2){ring[4].x, ring[4].y}, xx[10]); xx[11] = __builtin_elementwise_fma(x2, (f32x2){ring[4].z, ring[4].w}, xx[11]); ring[4] = *(const LAS f32x4*)(mb + 3408); __builtin_amdgcn_sched_barrier(0);
                xx[12] = __builtin_elementwise_fma(x2, (f32x2){ring[5].x, ring[5].y}, xx[12]); xx[13] = __builtin_elementwise_fma(x2, (f32x2){ring[5].z, ring[5].w}, xx[13]); ring[5] = *(const LAS f32x4*)(mb + 3424); __builtin_amdgcn_sched_barrier(0);
                xx[14] = __builtin_elementwise_fma(x2, (f32x2){ring[6].x, ring[6].y}, xx[14]); xx[15] = __builtin_elementwise_fma(x2, (f32x2){ring[6].z, ring[6].w}, xx[15]); ring[6] = *(const LAS f32x4*)(mb + 3552); __builtin_amdgcn_sched_barrier(0);
                x2 = (f32x2){xx[9][1], xx[9][1]}; xx[10] = __builtin_elementwise_fma(x2, (f32x2){ring[7].x, ring[7].y}, xx[10]); xx[11] = __builtin_elementwise_fma(x2, (f32x2){ring[7].z, ring[7].w}, xx[11]); ring[7] = *(const LAS f32x4*)(mb + 3568); __builtin_amdgcn_sched_barrier(0);
                xx[12] = __builtin_elementwise_fma(x2, (f32x2){ring[8].x, ring[8].y}, xx[12]); xx[13] = __builtin_elementwise_fma(x2, (f32x2){ring[8].z, ring[8].w}, xx[13]); ring[8] = *(const LAS f32x4*)(mb + 3696); __builtin_amdgcn_sched_barrier(0);
                xx[14] = __builtin_elementwise_fma(x2, (f32x2){ring[9].x, ring[9].y}, xx[14]); xx[15] = __builtin_elementwise_fma(x2, (f32x2){ring[9].z, ring[9].w}, xx[15]); ring[9] = *(const LAS f32x4*)(mb + 3712); __builtin_amdgcn_sched_barrier(0);
                x2 = (f32x2){xx[10][0], xx[10][0]}; xx[10] = __builtin_elementwise_fma(x2, (f32x2){ring[10].x, ring[10].y}, xx[10]); xx[11] = __builtin_elementwise_fma(x2, (f32x2){ring[10].z, ring[10].w}, xx[11]); ring[10] = *(const LAS f32x4*)(mb + 3840); __builtin_amdgcn_sched_barrier(0);
                xx[12] = __builtin_elementwise_fma(x2, (f32x2){ring[11].x, ring[11].y}, xx[12]); xx[13] = __builtin_elementwise_fma(x2, (f32x2){ring[11].z, ring[11].w}, xx[13]); ring[11] = *(const LAS f32x4*)(mb + 3856); __builtin_amdgcn_sched_barrier(0);
                xx[14] = __builtin_elementwise_fma(x2, (f32x2){ring[12].x, ring[12].y}, xx[14]); xx[15] = __builtin_elementwise_fma(x2, (f32x2){ring[12].z, ring[12].w}, xx[15]); ring[12] = *(const LAS f32x4*)(mb + 4000); __builtin_amdgcn_sched_barrier(0);
                x2 = (f32x2){xx[10][1], xx[10][1]}; xx[10] = __builtin_elementwise_fma(x2, (f32x2){ring[13].x, ring[13].y}, xx[10]); xx[11] = __builtin_elementwise_fma(x2, (f32x2){ring[13].z, ring[13].w}, xx[11]); ring[13] = *(const LAS f32x4*)(mb + 4144); __builtin_amdgcn_sched_barrier(0);
                xx[12] = __builtin_elementwise_fma(x2, (f32x2){ring[14].x, ring[14].y}, xx[12]); xx[13] = __builtin_elementwise_fma(x2, (f32x2){ring[14].z, ring[14].w}, xx[13]); ring[14] = *(const LAS f32x4*)(mb + 4288); __builtin_amdgcn_sched_barrier(0);
                xx[14] = __builtin_elementwise_fma(x2, (f32x2){ring[0].x, ring[0].y}, xx[14]); xx[15] = __builtin_elementwise_fma(x2, (f32x2){ring[0].z, ring[0].w}, xx[15]); ring[0] = *(const LAS f32x4*)(mb + 4432); __builtin_amdgcn_sched_barrier(0);
                x2 = (f32x2){xx[11][0], xx[11][0]}; xx[10] = __builtin_elementwise_fma(x2, (f32x2){ring[1].x, ring[1].y}, xx[10]); xx[11] = __builtin_elementwise_fma(x2, (f32x2){ring[1].z, ring[1].w}, xx[11]); __builtin_amdgcn_sched_barrier(0);
                xx[12] = __builtin_elementwise_fma(x2, (f32x2){ring[2].x, ring[2].y}, xx[12]); xx[13] = __builtin_elementwise_fma(x2, (f32x2){ring[2].z, ring[2].w}, xx[13]); __builtin_amdgcn_sched_barrier(0);
                xx[14] = __builtin_elementwise_fma(x2, (f32x2){ring[3].x, ring[3].y}, xx[14]); xx[15] = __builtin_elementwise_fma(x2, (f32x2){ring[3].z, ring[3].w}, xx[15]); __builtin_amdgcn_sched_barrier(0);
                x2 = (f32x2){xx[11][1], xx[11][1]}; xx[12] = __builtin_elementwise_fma(x2, (f32x2){ring[4].x, ring[4].y}, xx[12]); xx[13] = __builtin_elementwise_fma(x2, (f32x2){ring[4].z, ring[4].w}, xx[13]); __builtin_amdgcn_sched_barrier(0);
                xx[14] = __builtin_elementwise_fma(x2, (f32x2){ring[5].x, ring[5].y}, xx[14]); xx[15] = __builtin_elementwise_fma(x2, (f32x2){ring[5].z, ring[5].w}, xx[15]); __builtin_amdgcn_sched_barrier(0);
                x2 = (f32x2){xx[12][0], xx[12][0]}; xx[12] = __builtin_elementwise_fma(x2, (f32x2){ring[6].x, ring[6].y}, xx[12]); xx[13] = __builtin_elementwise_fma(x2, (f32x2){ring[6].z, ring[6].w}, xx[13]); __builtin_amdgcn_sched_barrier(0);
                xx[14] = __builtin_elementwise_fma(x2, (f32x2){ring[7].x, ring[7].y}, xx[14]); xx[15] = __builtin_elementwise_fma(x2, (f32x2){ring[7].z, ring[7].w}, xx[15]); __builtin_amdgcn_sched_barrier(0);
                x2 = (f32x2){xx[12][1], xx[12][1]}; xx[12] = __builtin_elementwise_fma(x2, (f32x2){ring[8].x, ring[8].y}, xx[12]); xx[13] = __builtin_elementwise_fma(x2, (f32x2){ring[8].z, ring[8].w}, xx[13]); __builtin_amdgcn_sched_barrier(0);
                xx[14] = __builtin_elementwise_fma(x2, (f32x2){ring[9].x, ring[9].y}, xx[14]); xx[15] = __builtin_elementwise_fma(x2, (f32x2){ring[9].z, ring[9].w}, xx[15]); __builtin_amdgcn_sched_barrier(0);
                x2 = (f32x2){xx[13][0], xx[13][0]}; xx[12] = __builtin_elementwise_fma(x2, (f32x2){ring[10].x, ring[10].y}, xx[12]); xx[13] = __builtin_elementwise_fma(x2, (f32x2){ring[10].z, ring[10].w}, xx[13]); __builtin_amdgcn_sched_barrier(0);
                xx[14] = __builtin_elementwise_fma(x2, (f32x2){ring[11].x, ring[11].y}, xx[14]); xx[15] = __builtin_elementwise_fma(x2, (f32x2){ring[11].z, ring[11].w}, xx[15]); __builtin_amdgcn_sched_barrier(0);
                x2 = (f32x2){xx[13][1], xx[13][1]}; xx[14] = __builtin_elementwise_fma(x2, (f32x2){ring[12].x, ring[12].y}, xx[14]); xx[15] = __builtin_elementwise_fma(x2, (f32x2){ring[12].z, ring[12].w}, xx[15]); __builtin_amdgcn_sched_barrier(0);
                x2 = (f32x2){xx[14][0], xx[14][0]}; xx[14] = __builtin_elementwise_fma(x2, (f32x2){ring[13].x, ring[13].y}, xx[14]); xx[15] = __builtin_elementwise_fma(x2, (f32x2){ring[13].z, ring[13].w}, xx[15]); __builtin_amdgcn_sched_barrier(0);
                x2 = (f32x2){xx[14][1], xx[14][1]}; xx[14] = __builtin_elementwise_fma(x2, (f32x2){ring[14].x, ring[14].y}, xx[14]); xx[15] = __builtin_elementwise_fma(x2, (f32x2){ring[14].z, ring[14].w}, xx[15]); __builtin_amdgcn_sched_barrier(0);
                x2 = (f32x2){xx[15][0], xx[15][0]}; xx[14] = __builtin_elementwise_fma(x2, (f32x2){ring[0].x, ring[0].y}, xx[14]); xx[15] = __builtin_elementwise_fma(x2, (f32x2){ring[0].z, ring[0].w}, xx[15]); __builtin_amdgcn_sched_barrier(0);
#pragma unroll
                for (int g = 0; g < 4; ++g) { v4u o; o.x = pg8::cvt_pk_bf16(xx[4 * g][0], xx[4 * g][1]); o.y = pg8::cvt_pk_bf16(xx[4 * g + 1][0], xx[4 * g + 1][1]);
                    o.z = pg8::cvt_pk_bf16(xx[4 * g + 2][0], xx[4 * g + 2][1]); o.w = pg8::cvt_pk_bf16(xx[4 * g + 3][0], xx[4 * g + 3][1]); *(LAS v4u*)(L + CK_U + lane * 80 + 16 * g) = o; }
            }
            CK_BAR();
            if (w >= 2) {
#pragma unroll
                for (int ks = 0; ks < 2; ++ks) { CK_MFMA(acc, CK_FRAG(MM + CK_MBR, 80, 0, ks), CK_FRAG(CK_U, 80, 32 * ih, ks)); CK_MFMA(acc, CK_FRAG(MM + CK_MKR, 80, 0, ks), CK_FRAGT(TR + CK_VT, 32 * ih, ks)); }
#pragma unroll
                for (int q = 0; q < 16; ++q) *(LAS float*)(L + CK_YB + (((q & 3) + 8 * (q >> 2) + 4 * hh) * 64 + 32 * ih + r32) * 4) = acc[q];
            }
            {
#pragma unroll
                for (int ks = 0; ks < 2; ++ks) { CK_MFMA(Sacc, CK_FRAGT(TR + CK_BTT, 32 * kh, ks), CK_FRAG(CK_U, 80, 32 * ih, ks)); CK_MFMA(Sacc, CK_FRAGT(TR + CK_KTT, 32 * kh, ks), CK_FRAGT(TR + CK_VT, 32 * ih, ks)); }
#pragma unroll
                for (int g = 0; g < 4; ++g) { const f32x4 pl = *(const LAS f32x4*)(L + CK_EXPL + (ch & 1) * 256 + (32 * kh + 8 * g + 4 * hh) * 4);
                    Sacc[4 * g] *= pl.x; Sacc[4 * g + 1] *= pl.y; Sacc[4 * g + 2] *= pl.z; Sacc[4 * g + 3] *= pl.w;
                    *(LAS unsigned long long*)(L + CK_SB + (32 * ih + r32) * 144 + (32 * kh + 8 * g + 4 * hh) * 2) = pack4bf(Sacc[4 * g], Sacc[4 * g + 1], Sacc[4 * g + 2], Sacc[4 * g + 3]); }
            }
            CK_BAR();
        }
        {
            const int lane = F.lane, r32 = lane & 31, hh = lane >> 5;
            float* so = F.out + (smp ? O_WKVS : O_WKVP) + (((size_t)(l * 8 + b) * 16 + h) * 64 + 32 * ih + r32) * 64 + 32 * kh + 4 * hh;
#pragma unroll
            for (int g = 0; g < 4; ++g) *(f32x4*)(so + 8 * g) = (f32x4){Sacc[4 * g], Sacc[4 * g + 1], Sacc[4 * g + 2], Sacc[4 * g + 3]};
        }
    } else {
        const bf16* URW = (const bf16*)(F.ws + B_URW);
        bf16* ORW = (bf16*)(F.ws + B_ORW);
        float mu_r[4], mu_k[4], mu_v[4], k_k[4], k_a[4], r_k[4], ln_w[4], ln_b[4];
        {
            const int c = h * 64 + 4 * (F.tid & 15); const float* mu = GIN(A, 12) + (size_t)l * P_RW;
#pragma unroll
            for (int j = 0; j < 4; ++j) { mu_r[j] = mu[c + j]; mu_k[j] = mu[1024 + c + j]; mu_v[j] = mu[2048 + c + j]; k_k[j] = GIN(A, 18)[l * 1024 + c + j]; k_a[j] = GIN(A, 19)[l * 1024 + c + j]; r_k[j] = GIN(A, 20)[l * 1024 + c + j];
                ln_w[j] = GIN(A, 21)[l * 1024 + c + j]; ln_b[j] = GIN(A, 22)[l * 1024 + c + j]; }
        }
        unsigned long long raw[2][9];
#define CK_RAWLOAD(ch) do { _Pragma("unroll") for (int rep_ = 0; rep_ < 2; ++rep_) { const int tt_ = (pt >> 4) + 16 * rep_; const int tseq = (ch) * CK_L + tt_; const size_t ru_ = (size_t)(row0 + (ch) * CK_L); \
            const int vo_ = tt_ * P_RW + c, vp_ = (tseq > 0) ? vo_ - P_RW : vo_; \
            const bf16* u_ = URW + ru_ * P_RW;     \
            raw[rep_][0] = *(const unsigned long long*)(u_ + vo_); raw[rep_][1] = *(const unsigned long long*)(u_ + vo_ + 1024); raw[rep_][2] = *(const unsigned long long*)(u_ + vo_ + 2048); \
            raw[rep_][5] = *(const unsigned long long*)(u_ + vp_); raw[rep_][6] = *(const unsigned long long*)(u_ + vp_ + 1024); raw[rep_][7] = *(const unsigned long long*)(u_ + vp_ + 2048); } } while (0)
        float r[2][4], kk[2][4], km[2][4], bb[2][4], ld[2][4], vr[2][4], cp[2][4];
        unsigned long long bv1[2], bv2[2], bv3[2], g1[2], g2[2], g3[2];
#pragma unroll
        for (int rep = 0; rep < 2; ++rep) { bv1[rep] = bv2[rep] = bv3[rep] = 0ull; g1[rep] = g2[rep] = g3[rep] = 0ull; }
        auto post = [&](const int ch, const int pt, const int gen) __attribute__((always_inline)) {
            const int cq = pt & 15, c = h * 64 + 4 * cq;
#pragma unroll
            for (int rep = 0; rep < 2; ++rep) {
                const int tt = (pt >> 4) + 16 * rep; const size_t r_ = (size_t)(row0 + ch * CK_L + tt);
                const f32x4 y4 = *(const LAS f32x4*)(L + CK_YB + (tt * 64 + 4 * cq) * 4);
                float gg[4], vv[4]; unpack4(gen == 1 ? g1[rep] : gen == 2 ? g2[rep] : g3[rep], gg); unpack4(gen == 1 ? bv1[rep] : gen == 2 ? bv2[rep] : bv3[rep], vv);
                const float mean = reduce16((y4.x + y4.y) + (y4.z + y4.w)) * (1.f / 64.f);
                const float d0 = y4.x - mean, d1 = y4.y - mean, d2 = y4.z - mean, d3 = y4.w - mean;
                const float var = reduce16((d0 * d0 + d1 * d1) + (d2 * d2 + d3 * d3)) * (1.f / 64.f);
                const float rs = __builtin_amdgcn_rsqf(var + GN_EPS);
                const float o0 = (d0 * rs * ln_w[0] + ln_b[0] + vv[0]) * gg[0], o1 = (d1 * rs * ln_w[1] + ln_b[1] + vv[1]) * gg[1];
                const float o2 = (d2 * rs * ln_w[2] + ln_b[2] + vv[2]) * gg[2], o3 = (d3 * rs * ln_w[3] + ln_b[3] + vv[3]) * gg[3];
                *(unsigned long long*)(ORW + r_ * 1024 + c) = pack4bf(o0, o1, o2, o3);
            }
        };
        auto prep1 = [&](const int chp, const int pt, const int lane) __attribute__((always_inline)) {
            const int cq = pt & 15, c = h * 64 + 4 * cq;
            float ur[2][4], uk[2][4], uv[2][4], pr[2][4], pk[2][4], pv[2][4], la[2][4]; unsigned long long gcur[2];
#pragma unroll
            for (int rep = 0; rep < 2; ++rep) { unpack4(raw[rep][0], ur[rep]); unpack4(raw[rep][1], uk[rep]); unpack4(raw[rep][2], uv[rep]);
                unpack4(raw[rep][5], pr[rep]); unpack4(raw[rep][6], pk[rep]); unpack4(raw[rep][7], pv[rep]);
                const int lo_ = (((pt >> 4) + 16 * rep) * 64 + 4 * cq) * 2;
                unpack4(*(const LAS unsigned long long*)(L + CK_LOR + lo_), ld[rep]); unpack4(*(const LAS unsigned long long*)(L + CK_LOR + 4096 + lo_), la[rep]); gcur[rep] = *(const LAS unsigned long long*)(L + CK_LOR + 8192 + lo_); }
            __builtin_amdgcn_sched_barrier(0);
            { const int chn = (chp + 1 < nch) ? chp + 1 : nch - 1; CK_RAWLOAD(chn); }
            __builtin_amdgcn_sched_barrier(0);
#pragma unroll
            for (int rep = 0; rep < 2; ++rep) {
                const int tt = (pt >> 4) + 16 * rep, tseq = chp * CK_L + tt;
                if (tseq == 0) {
                    const f32x4 a0 = *(const LAS f32x4*)(L + CK_SH + 16 * cq), a1 = *(const LAS f32x4*)(L + CK_SH + 256 + 16 * cq), a2 = *(const LAS f32x4*)(L + CK_SH + 512 + 16 * cq);
#pragma unroll
                    for (int j = 0; j < 4; ++j) { pr[rep][j] = a0[j]; pk[rep][j] = a1[j]; pv[rep][j] = a2[j]; }
                }
                float ssq = 0.f, bon = 0.f, kr[4];
#pragma unroll
                for (int j = 0; j < 4; ++j) {
                    r[rep][j] = ur[rep][j] + (pr[rep][j] - ur[rep][j]) * mu_r[j]; kr[j] = uk[rep][j] + (pk[rep][j] - uk[rep][j]) * mu_k[j]; vr[rep][j] = uv[rep][j] + (pv[rep][j] - uv[rep][j]) * mu_v[j];
                    kk[rep][j] = kr[j] * k_k[j]; ssq += kk[rep][j] * kk[rep][j]; km[rep][j] = kr[j] * (1.f + (la[rep][j] - 1.f) * k_a[j]); bon += r[rep][j] * km[rep][j] * r_k[j]; }
                ssq = reduce16(ssq); bon = reduce16(bon);
                const float inv = __builtin_amdgcn_rsqf(fmaxf(ssq, 1e-24f));
#pragma unroll
                for (int j = 0; j < 4; ++j) { kk[rep][j] *= inv; bb[rep][j] = kk[rep][j] * la[rep][j]; }
#pragma unroll
                for (int j = 0; j < 4; ++j) { float x = ld[rep][j]; const float u1 = __shfl_up(x, 16); x += (lane >= 16) ? u1 : 0.f; const float u2 = __shfl_up(x, 32); x += (lane >= 32) ? u2 : 0.f; cp[rep][j] = x; }
                if (lane >= 48) *(LAS f32x4*)(L + CK_LDF + ((tt >> 2) * 64 + 4 * cq) * 4) = (f32x4){cp[rep][0], cp[rep][1], cp[rep][2], cp[rep][3]};
                bv3[rep] = bv2[rep]; g3[rep] = g2[rep]; bv2[rep] = bv1[rep]; g2[rep] = g1[rep]; bv1[rep] = pack4bf(bon * vr[rep][0], bon * vr[rep][1], bon * vr[rep][2], bon * vr[rep][3]); g1[rep] = gcur[rep];
            }
        };
        auto prep3 = [&](const int chp, const int pt) __attribute__((always_inline)) {
            const int cq = pt & 15; const int TR = CK_TR + (chp & 1) * CK_TR_SZ;
#pragma unroll
            for (int rep = 0; rep < 2; ++rep) {
                const int tt = (pt >> 4) + 16 * rep, grp = tt >> 2;
                f32x4 cum = (f32x4){cp[rep][0], cp[rep][1], cp[rep][2], cp[rep][3]}, cumL = (f32x4){0.f, 0.f, 0.f, 0.f};
#pragma unroll
                for (int g2_ = 0; g2_ < 8; ++g2_) { const f32x4 t4 = *(const LAS f32x4*)(L + CK_LDF + (g2_ * 64 + 4 * cq) * 4); cumL += t4; if (g2_ < grp) cum += t4; }
                float at[4], bt[4], kt[4], rt[4];
#pragma unroll
                for (int j = 0; j < 4; ++j) {
                    const float e1 = __builtin_amdgcn_exp2f(1.4426950408889634f * cum[j]), e2 = __builtin_amdgcn_exp2f(-1.4426950408889634f * cum[j]), ep = __builtin_amdgcn_exp2f(1.4426950408889634f * (cum[j] - ld[rep][j]));
                    at[j] = -kk[rep][j] * ep; bt[j] = bb[rep][j] * e2; kt[j] = km[rep][j] * e2; rt[j] = r[rep][j] * e1; }
                const unsigned long long pa = pack4bf(at[0], at[1], at[2], at[3]), pb = pack4bf(bt[0], bt[1], bt[2], bt[3]), pkk = pack4bf(kt[0], kt[1], kt[2], kt[3]), prr = pack4bf(rt[0], rt[1], rt[2], rt[3]),
                                         pvv = pack4bf(vr[rep][0], vr[rep][1], vr[rep][2], vr[rep][3]);
                *(LAS unsigned long long*)(L + CK_AT + tt * 144 + 8 * cq) = pa; *(LAS unsigned long long*)(L + CK_BT + tt * 144 + 8 * cq) = pb;
                *(LAS unsigned long long*)(L + CK_KT + tt * 144 + 8 * cq) = pkk; *(LAS unsigned long long*)(L + CK_RT + tt * 144 + 8 * cq) = prr;
#pragma unroll
                for (int j = 0; j < 4; ++j) {
                    const int to = (4 * cq + j) * 80 + (((tt >> 3) ^ ((cq >> 1) & 3)) * 16) + (tt & 7) * 2;
                    *(LAS unsigned short*)(L + TR + CK_BTT + to) = (unsigned short)(pb >> (16 * j));
                    *(LAS unsigned short*)(L + TR + CK_KTT + to) = (unsigned short)(pkk >> (16 * j));
                    *(LAS unsigned short*)(L + TR + CK_VT + to) = (unsigned short)(pvv >> (16 * j)); }
                if (tt == 0) *(LAS f32x4*)(L + CK_EXPL + (chp & 1) * 256 + 16 * cq) = (f32x4){__builtin_amdgcn_exp2f(1.4426950408889634f * cumL[0]), __builtin_amdgcn_exp2f(1.4426950408889634f * cumL[1]),
                                                                                          __builtin_amdgcn_exp2f(1.4426950408889634f * cumL[2]), __builtin_amdgcn_exp2f(1.4426950408889634f * cumL[3])};
            }
        };
        auto prep4 = [&](const int chp, const int lane) __attribute__((always_inline)) {
            const int r32 = lane & 31, hh = lane >> 5, wt = w - 4; const int MM = CK_MM + (chp & 1) * CK_MM_SZ;
            f32x16s acc;
#pragma unroll
            for (int q = 0; q < 16; ++q) acc[q] = 0.f;
            const int abase = (wt & 1) ? CK_KT : CK_BT, bbase = (wt & 2) ? CK_RT : CK_AT;
#pragma unroll
            for (int ks = 0; ks < 4; ++ks) CK_MFMA(acc, CK_FRAG(abase, 144, 0, ks), CK_FRAG(bbase, 144, 0, ks));
#pragma unroll
            for (int q = 0; q < 16; ++q) { const int s = (q & 3) + 8 * (q >> 2) + 4 * hh; const bool keep = (wt & 2) ? (s <= r32) : (s < r32); acc[q] = keep ? acc[q] : 0.f; }
            if (wt == 0) {
#pragma unroll
                for (int q = 0; q < 16; ++q) *(LAS float*)(L + MM + CK_MBA + ((q & 3) + 8 * (q >> 2) + 4 * hh) * 144 + r32 * 4) = acc[q];
            } else {
                const int obase = MM + ((wt == 1) ? CK_MKA : (wt == 2) ? CK_MBR : CK_MKR);
#pragma unroll
                for (int g = 0; g < 4; ++g) *(LAS unsigned long long*)(L + obase + r32 * 80 + (8 * g + 4 * hh) * 2) = pack4bf(acc[4 * g], acc[4 * g + 1], acc[4 * g + 2], acc[4 * g + 3]);
            }
        };
        { const int pt = F.tid - 256, c = h * 64 + 4 * (pt & 15); CK_RAWLOAD(0); }
        __syncthreads();
        { int tv = threadIdx.x; asm volatile("" : "+v"(tv)); prep1(0, tv - 256, tv & 63); }
        CK_BAR();
        { int tv = threadIdx.x; asm volatile("" : "+v"(tv)); prep3(0, tv - 256); }
        CK_BAR();
        { int tv = threadIdx.x; asm volatile("" : "+v"(tv)); prep4(0, tv & 63); }
        CK_BAR();
        for (int ch = 0; ch < nch; ++ch) {
            int tv = threadIdx.x; asm volatile("" : "+v"(tv));
            const int pt = tv - 256, lane = tv & 63; const bool more = ch + 1 < nch;
            if (more) prep1(ch + 1, pt, lane);
            CK_BAR();
            if (ch > 0) { if (more) post(ch - 1, pt, 3); else post(ch - 1, pt, 2); }
            CK_BAR();
            if (more) prep3(ch + 1, pt);
            CK_BAR();
            if (more) prep4(ch + 1, lane);
            CK_BAR();
        }
        { int tv = threadIdx.x; asm volatile("" : "+v"(tv)); post(nch - 1, tv - 256, 1); }
#undef CK_RAWLOAD
    }
    __syncthreads();
}
__device__ __forceinline__ void ph_scan(Frame& F, CArgsP A, int l, const int s0, const int ns) {
    for (int it = s0; it < 256; it += ns) scan_chunked(F, A, l, it, (const bf16*)(F.ws + WS_W + W_LORA), (const bf16*)(F.ws + B_LIN));
}

__device__ __forceinline__ void ph_final(Frame& F, CArgsP A) {
    const int gw = F.vcu * NWAVES + F.wave, NGW = F.G * NWAVES;
    float* X = F.out + O_YP; const float* SS = (const float*)(F.ctl + CW_SS) + 4 * MT; const float* g = GIN(A, 30);
    const GAS f32x4* gr = (const GAS f32x4*)g + F.lane;
    f32x4 gg[4];
#pragma unroll
    for (int j = 0; j < 4; ++j) gg[j] = gr[64 * j];
    for (int m0 = gw; m0 < MT; m0 += 3 * NGW) {
        f32x4 v[3][4]; float r[3];
#pragma unroll
        for (int q = 0; q < 3; ++q) { const int m = m0 + q * NGW, mm = (m < MT) ? m : 0; r[q] = SS[mm];
            const GAS f32x4* xr = (const GAS f32x4*)(X + (size_t)mm * 1024) + F.lane;
#pragma unroll
            for (int j = 0; j < 4; ++j) v[q][j] = xr[64 * j]; }
#pragma unroll
        for (int q = 0; q < 3; ++q) { const int m = m0 + q * NGW;
            if (m < MT) { const float rs = 1.0f / sqrtf(r[q] * (1.0f / 1024.f) + EPS);
                GAS f32x4* xo = (GAS f32x4*)(X + (size_t)m * 1024) + F.lane;
#pragma unroll
                for (int j = 0; j < 4; ++j) xo[64 * j] = v[q][j] * rs * gg[j]; } }
    }
}

typedef float f32x16g __attribute__((ext_vector_type(16)));
template <int NB, class EPI> __device__ __forceinline__ void mini_gemm(Frame& F, const bf16* A, const bf16* Bt, const int K, const int nblk_n, EPI epi) {
    LAS float* red = (LAS float*)(F.lds + RING_OFF);
    const int KW = K / NWAVES, i = F.lane & 31, h = F.lane >> 5;
    for (int bi = F.vcu; bi < 8 * nblk_n; bi += F.G) {
        const int rb = bi & 7, cb = bi >> 3;
        const bf16* ap = A + (size_t)(rb * 32 + i) * K + F.wave * KW + 8 * h;
        const bf16* bp = Bt + (size_t)(cb * 32 + i) * K + F.wave * KW + 8 * h;
        f32x16g acc;
#pragma unroll
        for (int r = 0; r < 16; ++r) acc[r] = 0.f;
        for (int k0 = 0; k0 < KW; k0 += 16 * NB) {
            bf16x8 a[NB], b[NB];
#pragma unroll
            for (int j = 0; j < NB; ++j) { a[j] = *(const bf16x8*)(ap + k0 + 16 * j); b[j] = *(const bf16x8*)(bp + k0 + 16 * j); }
#pragma unroll
            for (int j = 0; j < NB; ++j) acc = __builtin_amdgcn_mfma_f32_32x32x16_bf16(a[j], b[j], acc, 0, 0, 0);
        }
        __syncthreads();
#pragma unroll
        for (int r = 0; r < 16; ++r) red[(F.wave * 16 + r) * 64 + F.lane] = acc[r];
        __syncthreads();
        const int q = F.wave;
        float s0 = 0.f, s1 = 0.f;
#pragma unroll
        for (int w = 0; w < NWAVES; ++w) { s0 += red[(w * 16 + 2 * q) * 64 + F.lane]; s1 += red[(w * 16 + 2 * q + 1) * 64 + F.lane]; }
        epi(rb * 32 + 2 * (q & 1) + 8 * (q >> 1) + 4 * h, cb * 32 + i, s0, s1);
    }
}
__device__ __forceinline__ void mini_gated(Frame& F, const bf16* A, const bf16* Bt, const bf16* G, const int goff, const bf16* S, bf16* O) {
    mini_gemm<8>(F, A + (size_t)MP * 1024, Bt, 1024, 32, [=](int row, int col, float v0, float v1) {
        const size_t r0 = (size_t)(MP + row);
        v0 *= bf2f(G[r0 * 2048 + goff + col]); v1 *= bf2f(G[(r0 + 1) * 2048 + goff + col]);
        if (S) { v0 += bf2f(S[r0 * 1024 + col]); v1 += bf2f(S[(r0 + 1) * 1024 + col]); }
        O[r0 * 1024 + col] = (bf16)f2bf(v0); O[(r0 + 1) * 1024 + col] = (bf16)f2bf(v1);
    });
}
template <int NB> __device__ __forceinline__ void mini_res(Frame& F, const bf16* A, const bf16* Bt, const int K, const float* Xr, float* X, bf16* XB, float* SS) {
    mini_gemm<NB>(F, A + (size_t)MP * K, Bt, K, 32, [=](int row, int col, float v0, float v1) {
        const size_t r0 = (size_t)(MP + row);
        v0 += Xr[(size_t)row * 1024 + col]; v1 += Xr[(size_t)(row + 1) * 1024 + col];
        X[r0 * 1024 + col] = v0; X[(r0 + 1) * 1024 + col] = v1;
        XB[r0 * 1024 + col] = (bf16)f2bf(v0); XB[(r0 + 1) * 1024 + col] = (bf16)f2bf(v1);
        float q0 = reduce16(v0 * v0), q1 = reduce16(v1 * v1);
        q0 += __shfl_xor(q0, 16); q1 += __shfl_xor(q1, 16);
        if ((col & 31) == 0) { atomicAdd(SS + r0, q0); atomicAdd(SS + r0 + 1, q1); }
    });
}
__device__ __forceinline__ void mini_gate(Frame& F, const bf16* A, const bf16* Bt, const float* ss, bf16* GATE) {
    mini_gemm<8>(F, A + (size_t)MP * 1024, Bt, 1024, 64, [=](int row, int col, float v0, float v1) {
        const size_t r0 = (size_t)(MP + row);
        const float rs0 = 1.0f / sqrtf(ss[r0] * (1.0f / 1024.f) + 1e-6f), rs1 = 1.0f / sqrtf(ss[r0 + 1] * (1.0f / 1024.f) + 1e-6f);
        GATE[r0 * 2048 + col] = (bf16)f2bf(pg8::fast_sigmoid(v0 * rs0)); GATE[(r0 + 1) * 2048 + col] = (bf16)f2bf(pg8::fast_sigmoid(v1 * rs1));
    });
}

__device__ __forceinline__ int edge_row(int idx) { const int j = idx & 31, q = j >> 1, e = j & 1; const int base = (q < 8) ? q * SEQ : MP + (q - 8) * DEC_SEQ, len = (q < 8) ? SEQ : DEC_SEQ; return base + ((idx >= 32) ? len - 2 + e : e); }
__device__ __forceinline__ void up_edge_rows(Frame& F, CArgsP A, int l, const bf16* XB, const bf16* Bt, const float* ss, bf16* GT, float* cv_p, float* cv_s) {
    LAS float* red = (LAS float*)(F.lds + RING_OFF);
    const int KW = 1024 / NWAVES, i = F.lane & 31, h = F.lane >> 5;
    const float* cw = GIN(A, 27) + (size_t)l * 3 * UPW; const float* cb = GIN(A, 28) + (size_t)l * UPW;
    for (int bi = F.vcu; bi < 2 * (D_FF / 32); bi += F.G) {
        const int rb = bi & 1, cq = bi >> 1, nbA = (cq >> 2) * 256 + (cq & 3) * 32;
        const bf16* ap = XB + (size_t)edge_row(rb * 32 + i) * 1024 + F.wave * KW + 8 * h;
        const bf16* bp = Bt + (size_t)(nbA + i) * 1024 + F.wave * KW + 8 * h;
        f32x16g accA, accG;
#pragma unroll
        for (int r = 0; r < 16; ++r) { accA[r] = 0.f; accG[r] = 0.f; }
        { bf16x8 a[8], b0[8], b1[8];
#pragma unroll
            for (int j = 0; j < 8; ++j) { a[j] = *(const bf16x8*)(ap + 16 * j); b0[j] = *(const bf16x8*)(bp + 16 * j); b1[j] = *(const bf16x8*)(bp + 128 * 1024 + 16 * j); }
#pragma unroll
            for (int j = 0; j < 8; ++j) { accA = __builtin_amdgcn_mfma_f32_32x32x16_bf16(a[j], b0[j], accA, 0, 0, 0); accG = __builtin_amdgcn_mfma_f32_32x32x16_bf16(a[j], b1[j], accG, 0, 0, 0); } }
        __syncthreads();
#pragma unroll
        for (int r = 0; r < 16; ++r) { red[(F.wave * 16 + r) * 64 + F.lane] = accA[r]; red[8192 + (F.wave * 16 + r) * 64 + F.lane] = accG[r]; }
        __syncthreads();
        const int q = F.wave;
        float a0 = 0.f, a1 = 0.f, g0 = 0.f, g1 = 0.f;
#pragma unroll
        for (int w = 0; w < NWAVES; ++w) { a0 += red[(w * 16 + 2 * q) * 64 + F.lane]; a1 += red[(w * 16 + 2 * q + 1) * 64 + F.lane]; g0 += red[8192 + (w * 16 + 2 * q) * 64 + F.lane]; g1 += red[8192 + (w * 16 + 2 * q + 1) * 64 + F.lane]; }
        const int idx = rb * 32 + 2 * (q & 1) + 8 * (q >> 1) + 4 * h;
        const int j = (cq >> 2) * 128 + (cq & 3) * 32 + i, sq = (idx & 31) >> 1;
        const int row = edge_row(idx);
        const float r0 = 1.0f / sqrtf(ss[row] * (1.0f / 1024.f) + EPS), r1 = 1.0f / sqrtf(ss[row + 1] * (1.0f / 1024.f) + EPS);
        a0 *= r0; g0 *= r0; a1 *= r1; g1 *= r1;
        if (rb == 1) { float* o = (sq < 8) ? cv_p + (size_t)sq * 2 * UPW : cv_s + (size_t)(sq - 8) * 2 * UPW; o[j] = a0; o[D_FF + j] = g0; o[UPW + j] = a1; o[UPW + D_FF + j] = g1; }
        else {
            float c0[2], c1[2];
#pragma unroll
            for (int hf = 0; hf < 2; ++hf) { const int col = j + hf * D_FF; const float x0 = hf ? g0 : a0, x1 = hf ? g1 : a1;
                float s2 = 0.f, s1 = 0.f;
                if (sq >= 8) { const float* st = GIN(A, 6) + ((size_t)(l * 8 + sq - 8) * 2) * UPW + col; s2 = st[0]; s1 = st[UPW]; }
                const float w0 = cw[col], w1 = cw[UPW + col], w2 = cw[2 * UPW + col], bs = cb[col];
                c0[hf] = bs + s2 * w0 + s1 * w1 + x0 * w2; c1[hf] = bs + s1 * w0 + x0 * w1 + x1 * w2; }
            GT[(size_t)row * D_FF + j] = (bf16)f2bf(c0[0] * __builtin_amdgcn_rcpf(1.0f + __builtin_amdgcn_exp2f(-1.4426950408889634f * c0[0])) * c0[1]);
            GT[(size_t)(row + 1) * D_FF + j] = (bf16)f2bf(c1[0] * __builtin_amdgcn_rcpf(1.0f + __builtin_amdgcn_exp2f(-1.4426950408889634f * c1[0])) * c1[1]);
        }
    }
}

#define REOPAQUE() do { int tv = threadIdx.x; asm volatile("" : "+v"(tv)); F.tid = tv; F.lane = tv & 63; F.wave = __builtin_amdgcn_readfirstlane(tv >> 6); \
    ap = (CArgsP)__builtin_amdgcn_kernarg_segment_ptr(); asm volatile("" : "+s"(ap)); \
    { GAS unsigned char* w_ = ap->ws; GAS float* o_ = ap->out; asm volatile("" : "+s"(w_), "+s"(o_)); F.ws = (unsigned char*)w_; F.out = (float*)o_; F.ctl = (gu32*)(w_ + WS_CTL); } } while (0)
#ifndef MK_PROBE_MASK
#define MK_PROBE_MASK 0u
#endif
#define MK_PROBE_AMP 4u
#define PH_BEGIN(idx) if (lo <= (idx) && (idx) < hi) { REOPAQUE(); if ((MK_PROBE_MASK >> (idx)) & 1u) { if (F.tid == 0) F.MISC[14] = (unsigned)rt(); }
#define PH_END(idx) if ((idx) + 1 < hi) xcd_barrier(bar); if ((MK_PROBE_MASK >> (idx)) & 1u) { if (threadIdx.x == 0) F.MISC[13] += (unsigned)rt() - F.MISC[14]; } }
#define PH_END_NOBAR(idx) if (MK_PER_PHASE && (idx) + 1 < hi) xcd_barrier(bar); if ((MK_PROBE_MASK >> (idx)) & 1u) { if (threadIdx.x == 0) F.MISC[13] += (unsigned)rt() - F.MISC[14]; } }

#define IDLE_CONVERT(nu, part) do { const int rem_ = (nu) % F.G; __syncthreads(); if (rem_ && (int)blockIdx.x >= rem_) { REOPAQUE(); p0_weights(F, ap, 1, ((int)blockIdx.x - rem_) * NWAVES + F.wave, (F.G - rem_) * NWAVES, part); } \
        else if (!rem_) { REOPAQUE(); p0_weights(F, ap, 1, (int)blockIdx.x * NWAVES + F.wave, F.G * NWAVES, part); } } while (0)

template <int l> __device__ __forceinline__ void layer_phases(Frame& F, CArgsP& ap, const XcdBarrier& bar, const int lo, const int hi) {
    constexpr int P0 = 1 + l * PH_PER_LAYER;
#define WL (F.ws + WS_W)
#define SSP ((float*)(F.ctl + CW_SS))
    PH_BEGIN(P0 + K_G1) {
        int kk_ = 1024; asm volatile("" : "+s"(kk_)); pg8::Gemm g{(const bf16*)(F.ws + WS_XB), (const bf16*)(WL + W_IN), MT, P_DA + P_RW, kk_}; pg8::StaticOrder S; S.init(MT, P_DA + P_RW, F.G, (int)blockIdx.x);
        pg8::EpiIn E{SSP + (size_t)(2 * l) * MT, (const float*)(F.ws + WS_ROPE), (bf16*)(F.ws + B_Q), (bf16*)(F.ws + B_K), (bf16*)(F.ws + B_V), (bf16*)(F.ws + B_URW),
                     F.out + O_KP + (size_t)l * MP * 1024, F.out + O_VP + (size_t)l * MP * 1024, F.out + O_KS + (size_t)l * MS * 1024, F.out + O_VS + (size_t)l * MS * 1024,
                     F.out + O_SHP + (size_t)l * BATCH * P_RW, F.out + O_SHS + (size_t)l * DEC_BATCH * P_RW};
        pg8::gemm_phase<pg8::EpiIn, pg8::StaticOrder, true, true>(F.lds + RING_OFF, g, S, E);
        if constexpr (l == 0) IDLE_CONVERT((MT / 256) * ((P_DA + P_RW) / 256), WP_UP | WP_DN);
    } PH_END(P0 + K_G1)
    PH_BEGIN(P0 + K_LP) { ph_linprep(F, ap, l); } PH_END(P0 + K_LP)
    PH_BEGIN(P0 + K_LR) { } PH_END_NOBAR(P0 + K_LR)
    PH_BEGIN(P0 + K_SC) {
        const int NSC = (F.G >= 256) ? 128 : F.G / 2;
        if (!(F.vcu & 1) && (F.vcu >> 1) < NSC) { ph_scan(F, ap, l, F.vcu >> 1, NSC); REOPAQUE(); }
        ph_attn(F, ap, l);
    } PH_END(P0 + K_SC)
    PH_BEGIN(P0 + K_CB) {
        ph_combine(F, ap, l);
        int kk_ = 1024; asm volatile("" : "+s"(kk_)); pg8::Gemm g{(const bf16*)(F.ws + WS_XB), (const bf16*)(WL + W_IN) + (size_t)(P_DA + P_RW) * 1024, MP, P_GATE, kk_}; pg8::StaticOrder S; S.init(MP, P_GATE, F.G, (int)blockIdx.x);
        pg8::EpiGate E{SSP + (size_t)(2 * l) * MT, (bf16*)(F.ws + B_GATE)};
        pg8::gemm_phase<pg8::EpiGate, pg8::StaticOrder, true, true>(F.lds + RING_OFF, g, S, E);
        REOPAQUE(); mini_gate(F, (const bf16*)(F.ws + WS_XB), (const bf16*)(WL + W_IN) + (size_t)(P_DA + P_RW) * 1024, SSP + (size_t)(2 * l) * MT, (bf16*)(F.ws + B_GATE));
    } PH_END(P0 + K_CB)
    PH_BEGIN(P0 + K_M1) {
        int kk_ = 1024; asm volatile("" : "+s"(kk_)); pg8::Gemm g{(const bf16*)(F.ws + B_OA), (const bf16*)(WL + W_ODA), MP, 1024, kk_}; pg8::StaticOrder S; S.init(MP, 1024, F.G, (int)blockIdx.x);
        pg8::EpiGated E{(const bf16*)(F.ws + B_GATE), 0, nullptr, (bf16*)(F.ws + B_MRG)};
        pg8::gemm_phase<pg8::EpiGated, pg8::StaticOrder, true, true>(F.lds + RING_OFF, g, S, E);
        REOPAQUE(); mini_gated(F, (const bf16*)(F.ws + B_OA), (const bf16*)(WL + W_ODA), (const bf16*)(F.ws + B_GATE), 0, nullptr, (bf16*)(F.ws + B_MRG));
    } PH_END_NOBAR(P0 + K_M1)
    PH_BEGIN(P0 + K_M2) {
        int kk_ = 1024; asm volatile("" : "+s"(kk_)); pg8::Gemm g{(const bf16*)(F.ws + B_ORW), (const bf16*)(WL + W_ORW), MP, 1024, kk_}; pg8::StaticOrder S; S.init(MP, 1024, F.G, (int)blockIdx.x);
        pg8::EpiGated E{(const bf16*)(F.ws + B_GATE), 1024, (const bf16*)(F.ws + B_MRG), (bf16*)(F.ws + B_MRG)};
        pg8::gemm_phase<pg8::EpiGated, pg8::StaticOrder, true, true>(F.lds + RING_OFF, g, S, E);
        REOPAQUE(); mini_gated(F, (const bf16*)(F.ws + B_ORW), (const bf16*)(WL + W_ORW), (const bf16*)(F.ws + B_GATE), 1024, (const bf16*)(F.ws + B_MRG), (bf16*)(F.ws + B_MRG));
    } PH_END(P0 + K_M2)
    PH_BEGIN(P0 + K_WO) {
        int kk_ = 1024; asm volatile("" : "+s"(kk_)); pg8::Gemm g{(const bf16*)(F.ws + B_MRG), (const bf16*)(WL + W_OUT), MP, 1024, kk_}; pg8::StaticOrder S; S.init(MP, 1024, F.G, (int)blockIdx.x);
        pg8::EpiRes E{l == 0 ? GIN(ap, 0) : (const float*)(F.out + O_YP), F.out + O_YP, (bf16*)(F.ws + WS_XB), SSP + (size_t)(2 * l + 1) * MT};
        pg8::gemm_phase<pg8::EpiRes, pg8::StaticOrder, true, true>(F.lds + RING_OFF, g, S, E);
        REOPAQUE(); mini_res<8>(F, (const bf16*)(F.ws + B_MRG), (const bf16*)(WL + W_OUT), 1024, l == 0 ? GIN(ap, 1) : (const float*)(F.out + O_YP + (size_t)MP * 1024), F.out + O_YP, (bf16*)(F.ws + WS_XB), SSP + (size_t)(2 * l + 1) * MT);
    } PH_END(P0 + K_WO)
    PH_BEGIN(P0 + K_UP) {
        int kk_ = 1024; asm volatile("" : "+s"(kk_)); pg8::Gemm g{(const bf16*)(F.ws + WS_XB), (const bf16*)(WL + (l ? W_UP1 : W_UP)), pg8::UC_TILES * 256, UPW, kk_, pg8::UC_ROWS, -2};
        pg8::StaticOrder S; S.init(pg8::UC_TILES * 256, UPW, F.G, (int)blockIdx.x);
        pg8::EpiUpConv E{SSP + (size_t)(2 * l + 1) * MT, (bf16*)(F.ws + B_GT), GIN(ap, 27) + (size_t)l * 3 * UPW, GIN(ap, 28) + (size_t)l * UPW, (LAS float*)(F.lds + UC_HALO_OFF)};
        pg8::gemm_phase<pg8::EpiUpConv, pg8::StaticOrder, true, true>(F.lds + RING_OFF, g, S, E);
        REOPAQUE(); up_edge_rows(F, ap, l, (const bf16*)(F.ws + WS_XB), (const bf16*)(WL + (l ? W_UP1 : W_UP)), SSP + (size_t)(2 * l + 1) * MT, (bf16*)(F.ws + B_GT),
                                 F.out + O_CVP + (size_t)l * BATCH * 2 * UPW, F.out + O_CVS + (size_t)l * DEC_BATCH * 2 * UPW);
        if constexpr (l == 0) IDLE_CONVERT(pg8::UC_TILES * (UPW / 256), WP_IN | WP_SQ | WP_LORA);
    } PH_END(P0 + K_UP)
    PH_BEGIN(P0 + K_CV) { } PH_END_NOBAR(P0 + K_CV)
    PH_BEGIN(P0 + K_DN) {
        int kk_ = D_FF; asm volatile("" : "+s"(kk_)); pg8::Gemm g{(const bf16*)(F.ws + B_GT), (const bf16*)(l ? F.ws + WS_DN1 : WL + W_DN), MP, 1024, kk_}; pg8::StaticOrder S; S.init(MP, 1024, F.G, (int)blockIdx.x);
        pg8::EpiRes E{F.out + O_YP, F.out + O_YP, (bf16*)(F.ws + WS_XB), SSP + (size_t)(2 * l + 2) * MT};
        pg8::gemm_phase<pg8::EpiRes, pg8::StaticOrder, true, true>(F.lds + RING_OFF, g, S, E);
        REOPAQUE(); mini_res<11>(F, (const bf16*)(F.ws + B_GT), (const bf16*)(l ? F.ws + WS_DN1 : WL + W_DN), D_FF, F.out + O_YP + (size_t)MP * 1024, F.out + O_YP, (bf16*)(F.ws + WS_XB), SSP + (size_t)(2 * l + 2) * MT);
    } PH_END(P0 + K_DN)
#undef WL
#undef SSP
}

__global__ void __launch_bounds__(NWAVES * 64, 2) mk_fwd(Args args) {
    extern __shared__ __attribute__((aligned(16))) unsigned char lds[];
    Frame F;
    F.lds = (LAS unsigned char*)lds;
    F.MISC = (volatile LAS unsigned*)(F.lds + MISC_OFF);
    F.tid = threadIdx.x; F.lane = F.tid & 63; F.wave = __builtin_amdgcn_readfirstlane(F.tid >> 6);
    F.G = gridDim.x; { const int bx = blockIdx.x; F.vcu = (F.G % 8 == 0) ? (bx % 8) * (F.G / 8) + bx / 8 : bx; }
    F.out = (float*)args.out; F.ws = (unsigned char*)args.ws;
    F.ctl = (gu32*)(args.ws + WS_CTL);
    for (int u = F.tid; u < (LDS_BYTES - LDSCTL_OFF) / 4; u += NWAVES * 64) ((LAS unsigned*)(F.lds + LDSCTL_OFF))[u] = 0u;
    __syncthreads();
    XcdBarrier bar; bar.bar = (unsigned*)(F.ctl + CW_BAR); bar.x = 0; bar.st = nullptr;
    if (!MK_PER_PHASE) bar = xcd_barrier_post((unsigned*)(F.ctl + CW_BAR), F.MISC + 8);
    const int lo = args.ph_lo, hi = args.ph_hi;
    CArgsP ap;
    PH_BEGIN(0) { p0_prologue(F, ap); } PH_END(0)
    layer_phases<0>(F, ap, bar, lo, hi);
    layer_phases<1>(F, ap, bar, lo, hi);
    PH_BEGIN(NPHASE - 1) { ph_final(F, ap); } PH_END(NPHASE - 1)
    if (MK_PROBE_MASK) { __syncthreads(); if (threadIdx.x == 0) { const unsigned t0 = (unsigned)rt(), dt = F.MISC[13] * MK_PROBE_AMP; while ((unsigned)rt() - t0 < dt) __builtin_amdgcn_s_sleep(8); } __syncthreads(); }
}

extern "C" void kernel_launch(void* const* d_in, const int* in_sizes, int n_in, void* d_out, int out_size, void* d_ws, size_t ws_size, hipStream_t stream) {
    (void)in_sizes;
    static int grid = 0;
    if (grid == 0) {
        if (n_in != 31 || out_size != (int)O_END || ws_size < B_END2) { fprintf(stderr, "kernel_launch: unexpected shapes (n_in %d out %d ws %zu)\n", n_in, out_size, ws_size); grid = -1; return; }
        int dev = 0, cus = 0;
        if (hipGetDevice(&dev) != hipSuccess || hipDeviceGetAttribute(&cus, hipDeviceAttributeMultiprocessorCount, dev) != hipSuccess) { grid = -1; return; }
        if (hipFuncSetAttribute((const void*)mk_fwd, hipFuncAttributeMaxDynamicSharedMemorySize, LDS_BYTES) != hipSuccess) { fprintf(stderr, "kernel_launch: hipFuncSetAttribute failed\n"); grid = -1; return; }
        (void)hipGetLastError();
        grid = cus;
    }
    if (grid < 0) return;
    if (hipMemsetAsync((char*)d_ws + WS_CTL, 0, CTL_ZERO_BYTES, stream) != hipSuccess) { fprintf(stderr, "kernel_launch: memset failed\n"); return; }
    Args a{};
    for (int i = 0; i < 31; ++i) a.in[i] = (const GAS float*)d_in[i];
    a.out = (GAS float*)d_out; a.ws = (GAS unsigned char*)d_ws;
    for (int i = 0; i < 8; ++i) a.rinv[i] = (float)pow(500000.0, -(double)i / 8.0);
#if MK_PER_PHASE
    for (int p = 0; p < NPHASE; ++p) { a.ph_lo = p; a.ph_hi = p + 1; hipLaunchKernelGGL(mk_fwd, dim3(grid), dim3(NWAVES * 64), LDS_BYTES, stream, a); }
#else
    a.ph_lo = 0; a.ph_hi = NPHASE;
    hipLaunchKernelGGL(mk_fwd, dim3(grid), dim3(NWAVES * 64), LDS_BYTES, stream, a);
#endif
    const hipError_t le = hipPeekAtLastError();
    if (le != hipSuccess) fprintf(stderr, "kernel_launch: launch failed: %s\n", hipGetErrorName(le));
}
```

```cpp
#include <hip/hip_runtime.h>
#include <cstdio>
#include <cstdint>
#include <cmath>

#ifndef MK_PER_PHASE
#define MK_PER_PHASE 0
#endif

constexpr int D_MODEL = 1024, BATCH = 8, SEQ = 2048, DEPTH = 2, DEC_BATCH = 8, DEC_SEQ = 32, PAST_LEN = 2048;
constexpr float EPS = 1e-6f, GN_EPS = 64e-5f;
constexpr int DA_HEADS = 8, RW_HEADS = 16;
constexpr int D_FF = 2816, UPW = 2 * D_FF;
constexpr int P_DA = 3072, P_RW = 3328, P_GATE = 2048, P_TOTAL = 8448;
constexpr int MP = BATCH * SEQ, MS = DEC_BATCH * DEC_SEQ, MT = MP + MS;
constexpr int NKEYS_S = PAST_LEN + DEC_SEQ;
constexpr float C2 = 0.125f * 1.4426950408889634f;

constexpr size_t O_YP = 0;
constexpr size_t O_YS = O_YP + (size_t)MP * D_MODEL;
constexpr size_t O_KP = O_YS + (size_t)MS * D_MODEL;
constexpr size_t O_VP = O_KP + (size_t)DEPTH * MP * 1024;
constexpr size_t O_WKVP = O_VP + (size_t)DEPTH * MP * 1024;
constexpr size_t O_SHP = O_WKVP + (size_t)DEPTH * BATCH * RW_HEADS * 64 * 64;
constexpr size_t O_CVP = O_SHP + (size_t)DEPTH * BATCH * P_RW;
constexpr size_t O_KS = O_CVP + (size_t)DEPTH * BATCH * 2 * UPW;
constexpr size_t O_VS = O_KS + (size_t)DEPTH * MS * 1024;
constexpr size_t O_WKVS = O_VS + (size_t)DEPTH * MS * 1024;
constexpr size_t O_SHS = O_WKVS + (size_t)DEPTH * DEC_BATCH * RW_HEADS * 64 * 64;
constexpr size_t O_CVS = O_SHS + (size_t)DEPTH * DEC_BATCH * P_RW;
constexpr size_t O_END = O_CVS + (size_t)DEPTH * DEC_BATCH * 2 * UPW;
static_assert(O_END == 87760896, "output size");

namespace pg8 {
#define PG8_LAS __attribute__((address_space(3)))
typedef unsigned short bf16_t;
typedef short bf16x8 __attribute__((ext_vector_type(8)));
typedef float f32x4 __attribute__((ext_vector_type(4)));
typedef unsigned u32x4 __attribute__((ext_vector_type(4)));
constexpr int BM = 256, BK = 64, HALF = 128, HTB = HALF * BK * 2  , STAGE_BYTES = 8 * HTB, NXCD = 8, WGM = 8;

__host__ __device__ __forceinline__ int lds_byte(int r, int c) { const int st = (r >> 4) * 2 + (c >> 5), rr = r & 15, cc = c & 31, ob = rr * 64 + cc * 2; return st * 1024 + (ob ^ (((ob >> 9) & 1) << 5)); }
__host__ __device__ __forceinline__ void stage_rc(int b, int& R, int& C) { const int st = b / 1024, sb = b % 1024, swz = sb ^ (((sb >> 9) & 1) << 5); R = (st >> 1) * 16 + swz / 64; C = (st & 1) * 32 + (swz % 64) / 2; }
__host__ __device__ __forceinline__ int perm32(int rho) { const int n = rho >> 4, i = rho & 15; return 8 * (i >> 2) + 4 * n + (i & 3); }

struct Unit { int pm, pn; };
struct Gemm { const bf16_t* A; const bf16_t* Bt; int M, N, K; int a_rows = 256, a_row0 = 0; };

struct StaticOrder {
    int nM, nN, nwg, G, c;
    __host__ __device__ void init(int M, int N, int G_, int c_) { nM = M / BM; nN = N / BM; nwg = nM * nN; G = G_; c = c_; }
    __host__ __device__ bool next(int i, Unit& u) const {
        const long L = (long)i * G + c; if (L >= nwg) return false;
        int wgid = (int)L; { const int q = nwg / NXCD, r = nwg % NXCD, xcd = wgid % NXCD, off = wgid / NXCD; wgid = (xcd < r ? xcd * (q + 1) : r * (q + 1) + (xcd - r) * q) + off; }
        const int nig = WGM * nN, gid = wgid / nig, fm = gid * WGM, gsz = (nM - fm) < WGM ? (nM - fm) : WGM;
        u.pm = fm + ((wgid % nig) % gsz); u.pn = (wgid % nig) / gsz; return true;
    }
    __device__ __forceinline__ void a_ready(const Unit&) const {}
    __device__ __forceinline__ void done(const Unit&) const {}
};

typedef float f32x2_cv __attribute__((ext_vector_type(2))); typedef __bf16 bf16x2_cv __attribute__((ext_vector_type(2)));
__device__ __forceinline__ unsigned cvt_pk_bf16(float lo, float hi) { const f32x2_cv v = {lo, hi}; const bf16x2_cv b = __builtin_convertvector(v, bf16x2_cv); return __builtin_bit_cast(unsigned, b); }
typedef float f32x2 __attribute__((ext_vector_type(2)));
__device__ __forceinline__ float bf2f(unsigned short h) { return __uint_as_float((unsigned)h << 16); }
__device__ __forceinline__ float fast_sigmoid(float x) { return __builtin_amdgcn_rcpf(1.0f + __builtin_amdgcn_exp2f(-1.4426950408889634f * x)); }
__device__ __forceinline__ float neg_decay_log(float x) {
    const float y = -x, sp = fmaxf(y, 0.f) + 0.6931471805599453f * __builtin_amdgcn_logf(1.0f + __builtin_amdgcn_exp2f(-1.4426950408889634f * fabsf(y)));
    return -__builtin_amdgcn_exp2f(-1.4426950408889634f * (sp + 0.5f));
}
__device__ __forceinline__ u32x4 pack8(const f32x4 v0, const f32x4 v1) { u32x4 w; w.x = cvt_pk_bf16(v0[0], v0[1]); w.y = cvt_pk_bf16(v0[2], v0[3]); w.z = cvt_pk_bf16(v1[0], v1[1]); w.w = cvt_pk_bf16(v1[2], v1[3]); return w; }
__device__ __forceinline__ void unpack8(const u32x4 w, f32x4& v0, f32x4& v1) {
    v0[0] = __uint_as_float(w.x << 16); v0[1] = __uint_as_float(w.x & 0xffff0000u); v0[2] = __uint_as_float(w.y << 16); v0[3] = __uint_as_float(w.y & 0xffff0000u);
    v1[0] = __uint_as_float(w.z << 16); v1[1] = __uint_as_float(w.z & 0xffff0000u); v1[2] = __uint_as_float(w.w << 16); v1[3] = __uint_as_float(w.w & 0xffff0000u);
}
constexpr int E_MP = 16384, E_MS = 256;

struct EpiIn {
    static constexpr bool PERM = true, AFTER_DRAIN = false, PERM_A = false;
    const float* ss; const float* rope;
    bf16_t *Q, *K, *V, *URW;
    float *kout_p, *vout_p, *kout_s, *vout_s;
    float *sh_p, *sh_s;
    __device__ __forceinline__ void operator()(const f32x4 (&acc)[2][2][4][2], const Unit& u, int wr, int wc, int fr, int fq) const {
        const int pn = u.pn, rowb = u.pm * BM + wr * 64 + fr, cl = wc * 32 + 8 * fq;
        const bool rope_wave = (pn < 8) && ((wc & 1) == 0);
        const float sgn = (fq == 0) ? -1.f : 1.f;
#pragma unroll
        for (int ai = 0; ai < 2; ++ai)
#pragma unroll
            for (int m = 0; m < 4; ++m) {
                const int row = rowb + ai * HALF + m * 16;
                const float rstd = __builtin_amdgcn_rsqf(ss[row] * (1.0f / 1024.f) + 1e-6f);
                const bool smp = row >= E_MP;
                const int t = smp ? ((row - E_MP) & 31) : (row & 2047);
                const int bb = smp ? ((row - E_MP) >> 5) : (row >> 11);
                const int pos = smp ? 2048 + t : t;
                const bool last = smp ? (t == 31) : (t == 2047);
#pragma unroll
                for (int bj = 0; bj < 2; ++bj) {
                    f32x4 v0 = acc[ai][bj][m][0] * rstd, v1 = acc[ai][bj][m][1] * rstd;
                    const int col = pn * BM + bj * HALF + cl;
                    if (pn < 8) {
                        if (rope_wave) {
                            f32x4 p0, p1;
#pragma unroll
                            for (int j = 0; j < 4; ++j) { p0[j] = __shfl_xor(v0[j], 16); p1[j] = __shfl_xor(v1[j], 16); }
                            if (fq < 2) {
                                const float* tb = rope + pos * 16;
                                const f32x4 c0 = *(const f32x4*)(tb), c1 = *(const f32x4*)(tb + 4), s0 = *(const f32x4*)(tb + 8), s1 = *(const f32x4*)(tb + 12);
                                v0 = v0 * c0 + (p0 * s0) * sgn; v1 = v1 * c1 + (p1 * s1) * sgn;
                            }
                        }
                        if (pn < 4) { v0 = v0 * C2; v1 = v1 * C2; *(u32x4*)(Q + (size_t)row * 1024 + col) = pack8(v0, v1); }
                        else {
                            const int c = col - 1024;
                            *(u32x4*)(K + (size_t)row * 1024 + c) = pack8(v0, v1);
                            float* o = smp ? kout_s + (size_t)(row - E_MP) * 1024 + c : kout_p + (size_t)row * 1024 + c;
                            *(f32x4*)o = v0; *(f32x4*)(o + 4) = v1;
                        }
                    } else if (pn < 12) {
                        const int c = col - 2048;
                        *(u32x4*)(V + (size_t)row * 1024 + c) = pack8(v0, v1);
                        float* o = smp ? vout_s + (size_t)(row - E_MP) * 1024 + c : vout_p + (size_t)row * 1024 + c;
                        *(f32x4*)o = v0; *(f32x4*)(o + 4) = v1;
                    } else {
                        const int c = col - 3072;
                        *(u32x4*)(URW + (size_t)row * 3328 + c) = pack8(v0, v1);
                        if (last) { float* o = (smp ? sh_s : sh_p) + (size_t)bb * 3328 + c; *(f32x4*)o = v0; *(f32x4*)(o + 4) = v1; }
                    }
                }
            }
    }
};

struct EpiGate {
    static constexpr bool PERM = true, AFTER_DRAIN = false, PERM_A = false;
    const float* ss; bf16_t* GATE;
    __device__ __forceinline__ void operator()(const f32x4 (&acc)[2][2][4][2], const Unit& u, int wr, int wc, int fr, int fq) const {
        const int rowb = u.pm * BM + wr * 64 + fr, cl = u.pn * BM + wc * 32 + 8 * fq;
#pragma unroll
        for (int ai = 0; ai < 2; ++ai)
#pragma unroll
            for (int m = 0; m < 4; ++m) {
                const int row = rowb + ai * HALF + m * 16;
                const float rstd = __builtin_amdgcn_rsqf(ss[row] * (1.0f / 1024.f) + 1e-6f);
#pragma unroll
                for (int bj = 0; bj < 2; ++bj) {
                    f32x4 v0 = acc[ai][bj][m][0] * rstd, v1 = acc[ai][bj][m][1] * rstd;
#pragma unroll
                    for (int j = 0; j < 4; ++j) { v0[j] = fast_sigmoid(v0[j]); v1[j] = fast_sigmoid(v1[j]); }
                    *(u32x4*)(GATE + (size_t)row * 2048 + cl + bj * HALF) = pack8(v0, v1);
                }
            }
    }
};

struct EpiGated {
    static constexpr bool PERM = true, AFTER_DRAIN = false, PERM_A = false;
    const bf16_t* G; int goff; const bf16_t* S; bf16_t* O;
    __device__ __forceinline__ void operator()(const f32x4 (&acc)[2][2][4][2], const Unit& u, int wr, int wc, int fr, int fq) const {
        const int rowb = u.pm * BM + wr * 64 + fr, cl = u.pn * BM + wc * 32 + 8 * fq;
#pragma unroll
        for (int ai = 0; ai < 2; ++ai)
#pragma unroll
            for (int m = 0; m < 4; ++m) {
                const int row = rowb + ai * HALF + m * 16;
#pragma unroll
                for (int bj = 0; bj < 2; ++bj) {
                    const int c = cl + bj * HALF;
                    f32x4 g0, g1; unpack8(*(const u32x4*)(G + (size_t)row * 2048 + goff + c), g0, g1);
                    f32x4 v0 = acc[ai][bj][m][0] * g0, v1 = acc[ai][bj][m][1] * g1;
                    if (S) { f32x4 s0, s1; unpack8(*(const u32x4*)(S + (size_t)row * 1024 + c), s0, s1); v0 += s0; v1 += s1; }
                    *(u32x4*)(O + (size_t)row * 1024 + c) = pack8(v0, v1);
                }
            }
    }
};

struct EpiRes {
    static constexpr bool PERM = true, AFTER_DRAIN = false, PERM_A = false;
    const float* Xr; float* X; bf16_t* XB; float* SS;
    __device__ __forceinline__ void operator()(const f32x4 (&acc)[2][2][4][2], const Unit& u, int wr, int wc, int fr, int fq) const {
        const int rowb = u.pm * BM + wr * 64 + fr, cl = u.pn * BM + wc * 32 + 8 * fq;
#pragma unroll
        for (int ai = 0; ai < 2; ++ai)
#pragma unroll
            for (int m = 0; m < 4; ++m) {
                const int row = rowb + ai * HALF + m * 16;
                float sq = 0.f;
#pragma unroll
                for (int bj = 0; bj < 2; ++bj) {
                    const int c = cl + bj * HALF;
                    float* xp = X + (size_t)row * 1024 + c; const float* xq = Xr + (size_t)row * 1024 + c;
                    const f32x4 v0 = *(const f32x4*)xq + acc[ai][bj][m][0], v1 = *(const f32x4*)(xq + 4) + acc[ai][bj][m][1];
                    *(f32x4*)xp = v0; *(f32x4*)(xp + 4) = v1;
                    *(u32x4*)(XB + (size_t)row * 1024 + c) = pack8(v0, v1);
                    sq += (v0[0] * v0[0] + v0[1] * v0[1]) + (v0[2] * v0[2] + v0[3] * v0[3]) + (v1[0] * v1[0] + v1[1] * v1[1]) + (v1[2] * v1[2] + v1[3] * v1[3]);
                }
                sq += __shfl_xor(sq, 16); sq += __shfl_xor(sq, 32);
                if (fq == 0) atomicAdd(SS + row, sq);
            }
    }
};

constexpr int E_MT = 16640, E_DFF = 2816, UC_ROWS = 254, UC_TILES = 66;
__device__ __forceinline__ float silu_mul(float a, float g) { return a * __builtin_amdgcn_rcpf(1.0f + __builtin_amdgcn_exp2f(-1.4426950408889634f * a)) * g; }
__device__ __forceinline__ float dpp_shr1s(float v, float lane0) { return __builtin_bit_cast(float, __builtin_amdgcn_update_dpp(__builtin_bit_cast(int, lane0), __builtin_bit_cast(int, v), 0x111, 0xF, 0xF, false)); }
__device__ __forceinline__ f32x4 dpp_shr1(const f32x4 v, const f32x4 lane0) { f32x4 r; r.x = dpp_shr1s(v.x, lane0.x); r.y = dpp_shr1s(v.y, lane0.y); r.z = dpp_shr1s(v.z, lane0.z); r.w = dpp_shr1s(v.w, lane0.w); return r; }
struct EpiUpConv {
    static constexpr bool PERM = true, AFTER_DRAIN = false, PERM_A = true;
    const float* ss; bf16_t* GT; const float *cw, *cb; PG8_LAS float* halo;
    template <int ai, int bj, int n> __device__ __forceinline__ void conv_cols(f32x4 (&x)[2][2][4][2], const int wid, const int wr, int fq, const int cb0) const {
        asm volatile("" : "+v"(fq));
        const int ca = cb0 + 8 * fq, col = bj * E_DFF + ca + 4 * n;
        const f32x4 w0 = *(const f32x4*)(cw + col), w1 = *(const f32x4*)(cw + 5632 + col), w2 = *(const f32x4*)(cw + 2 * 5632 + col), bi = *(const f32x4*)(cb + col);
        f32x4 h1 = (f32x4){0.f, 0.f, 0.f, 0.f}, h2 = h1;
        if (wr == 1 || ai == 1) { const int pw = wr ? wid - 4 : wid + 4, pai = wr ? ai : 0;
            const PG8_LAS float* hp = halo + ((((pw * 2 + pai) * 2 + 0) * 2 + bj) * 32 + fq * 8 + 4 * n);
            h2 = *(const PG8_LAS f32x4*)hp; h1 = *(const PG8_LAS f32x4*)(hp + 64); }
        const f32x4 a0 = x[ai][bj][0][n], a1 = x[ai][bj][1][n], a2 = x[ai][bj][2][n], a3 = x[ai][bj][3][n];
        const f32x4 vm1 = dpp_shr1(a3, h1), vm2 = dpp_shr1(a2, h2);
        x[ai][bj][3][n] = bi + a1 * w0 + a2 * w1 + a3 * w2;
        x[ai][bj][2][n] = bi + a0 * w0 + a1 * w1 + a2 * w2;
        x[ai][bj][1][n] = bi + vm1 * w0 + a0 * w1 + a1 * w2;
        x[ai][bj][0][n] = bi + vm2 * w0 + vm1 * w1 + a0 * w2;
    }
    template <int ai> __device__ __forceinline__ void block_out(f32x4 (&x)[2][2][4][2], const Unit& u, const int wid, const int wr, const int wc, int fr, int fq, const int R0) const {
        const int cb0 = 128 * u.pn + wc * 32;
        conv_cols<ai, 0, 0>(x, wid, wr, fq, cb0); conv_cols<ai, 0, 1>(x, wid, wr, fq, cb0); conv_cols<ai, 1, 0>(x, wid, wr, fq, cb0); conv_cols<ai, 1, 1>(x, wid, wr, fq, cb0);
        asm volatile("" : "+v"(fr), "+v"(fq));
        const int lrb = wr * 64 + 4 * fr, ca = cb0 + 8 * fq;
#pragma unroll
        for (int m = 0; m < 4; ++m) {
            const int lr = lrb + ai * HALF + m, row = R0 + lr;
            const int tq = (row >= E_MP) ? ((row - E_MP) & 31) : (row & 2047);
            if (lr >= 2 && (unsigned)row < (unsigned)E_MT && tq >= 2) {
                f32x4 g0, g1;
                g0.x = silu_mul(x[ai][0][m][0].x, x[ai][1][m][0].x); g0.y = silu_mul(x[ai][0][m][0].y, x[ai][1][m][0].y); g0.z = silu_mul(x[ai][0][m][0].z, x[ai][1][m][0].z); g0.w = silu_mul(x[ai][0][m][0].w, x[ai][1][m][0].w);
                g1.x = silu_mul(x[ai][0][m][1].x, x[ai][1][m][1].x); g1.y = silu_mul(x[ai][0][m][1].y, x[ai][1][m][1].y); g1.z = silu_mul(x[ai][0][m][1].z, x[ai][1][m][1].z); g1.w = silu_mul(x[ai][0][m][1].w, x[ai][1][m][1].w);
                *(u32x4*)(GT + (size_t)row * E_DFF + ca) = pack8(g0, g1);
            }
        }
    }
    __device__ __forceinline__ void operator()(f32x4 (&x)[2][2][4][2], const Unit& u, int wr, int wc, int fr, int fq) const {
        asm volatile("" : "+v"(fr), "+v"(fq), "+s"(wr), "+s"(wc));
        const int wid = wr * 4 + wc, R0 = UC_ROWS * u.pm - 2, lrb = wr * 64 + 4 * fr, ca = 128 * u.pn + wc * 32 + 8 * fq;
#pragma unroll
        for (int ai = 0; ai < 2; ++ai)
#pragma unroll
            for (int m = 0; m < 4; ++m) {
                const int lr = lrb + ai * HALF + m, row = R0 + lr;
                const bool valid = (unsigned)row < (unsigned)E_MT;
                const float rstd = valid ? __builtin_amdgcn_rsqf(ss[valid ? row : 0] * (1.0f / 1024.f) + 1e-6f) : 0.f;
#pragma unroll
                for (int bj = 0; bj < 2; ++bj) { x[ai][bj][m][0] = x[ai][bj][m][0] * rstd; x[ai][bj][m][1] = x[ai][bj][m][1] * rstd; }
            }
        if (fr == 15) {
#pragma unroll
            for (int ai = 0; ai < 2; ++ai)
#pragma unroll
                for (int rr = 0; rr < 2; ++rr)
#pragma unroll
                    for (int bj = 0; bj < 2; ++bj) { PG8_LAS float* hp = halo + ((((wid * 2 + ai) * 2 + rr) * 2 + bj) * 32 + fq * 8);
                        *(PG8_LAS f32x4*)hp = x[ai][bj][2 + rr][0]; *(PG8_LAS f32x4*)(hp + 4) = x[ai][bj][2 + rr][1]; }
        }
        asm volatile("s_waitcnt lgkmcnt(0)" ::: "memory"); __builtin_amdgcn_s_barrier(); asm volatile("" ::: "memory");
        unsigned xp[2][4][4];
#pragma unroll
        for (int bj = 0; bj < 2; ++bj)
#pragma unroll
            for (int m = 0; m < 4; ++m) { const u32x4 w = pack8(x[1][bj][m][0], x[1][bj][m][1]); xp[bj][m][0] = w.x; xp[bj][m][1] = w.y; xp[bj][m][2] = w.z; xp[bj][m][3] = w.w; }
        asm volatile("" ::: "memory");
        block_out<0>(x, u, wid, wr, wc, fr, fq, R0);
        asm volatile("" ::: "memory");
#pragma unroll
        for (int bj = 0; bj < 2; ++bj)
#pragma unroll
            for (int m = 0; m < 4; ++m) { u32x4 w; w.x = xp[bj][m][0]; w.y = xp[bj][m][1]; w.z = xp[bj][m][2]; w.w = xp[bj][m][3]; unpack8(w, x[1][bj][m][0], x[1][bj][m][1]); }
        block_out<1>(x, u, wid, wr, wc, fr, fq, R0);
    }
};

template <class Epi, class Sched, bool ALIGN_EPI = false, bool SP2 = false>
__device__ __forceinline__ void gemm_phase(PG8_LAS unsigned char* lds, const Gemm g, const Sched& S, const Epi& E) {
    int tid_ = threadIdx.x; asm volatile("" : "+v"(tid_));
    const int tid = tid_, wid = __builtin_amdgcn_readfirstlane(tid >> 6), lane = tid & 63, wr = wid >> 2, wc = wid & 3, fr = lane & 15, fq = lane >> 4;
    const int K = g.K, nt = K / BK;
    unsigned voffA[2], voffB[2];
#define PG8_VOFF(tv) do { _Pragma("unroll") for (int i = 0; i < 2; ++i) { int R, C; stage_rc((tv) * 16 + i * 8192, R, C); const int Rb = Epi::PERM ? ((R & ~31) + perm32(R & 31)) : R; \
        const int Ra = Epi::PERM_A ? ((R & ~63) + 4 * (R & 15) + ((R >> 4) & 3)) : R;     \
        voffA[i] = (unsigned)(Ra * K + C) * 2u; voffB[i] = (unsigned)(Rb * K + C) * 2u; } } while (0)
    PG8_VOFF(tid);
    const size_t kstep = (size_t)(BK * 2);
    const size_t hstep = (size_t)HALF * K * 2;
    const size_t tstep = 2 * hstep;
    const unsigned ldsw = (unsigned)wid * 1024u;
    int aoff = lds_byte(wr * 64 + fr, fq * 8), boff = lds_byte(wc * 32 + fr, fq * 8);
#define PG8_SA(b, h) (((b) * 2 + (h)) * HTB)
#define PG8_SB(b, h) ((4 + (b) * 2 + (h)) * HTB)
#define PG8_STAGE(bufoff, gbase, voff) do { _Pragma("unroll") for (int _i = 0; _i < 2; ++_i) \
        __builtin_amdgcn_global_load_lds((const unsigned*)((const char*)(gbase) + (voff)[_i]), (PG8_LAS unsigned*)(lds + (bufoff) + ldsw + _i * 8192), 16, 0, 0); } while (0)
#define PG8_LDA(dst, b, h) do { _Pragma("unroll") for (int m = 0; m < 4; ++m) _Pragma("unroll") for (int k = 0; k < 2; ++k) dst[m][k] = *(const PG8_LAS bf16x8*)(lds + PG8_SA(b, h) + aoff + m * 2048 + k * 1024); } while (0)
#define PG8_LDB(dst, b, h) do { _Pragma("unroll") for (int n = 0; n < 2; ++n) _Pragma("unroll") for (int k = 0; k < 2; ++k) dst[n][k] = *(const PG8_LAS bf16x8*)(lds + PG8_SB(b, h) + boff + n * 2048 + k * 1024); } while (0)
#define PG8_MMA(ai, bj, At, Bt) do { __builtin_amdgcn_s_setprio(1); _Pragma("unroll") for (int m = 0; m < 4; ++m) _Pragma("unroll") for (int n = 0; n < 2; ++n) _Pragma("unroll") for (int k = 0; k < 2; ++k) \
        acc[ai][bj][m][n] = __builtin_amdgcn_mfma_f32_16x16x32_bf16(Bt[n][k], At[m][k], acc[ai][bj][m][n], 0, 0, 0); __builtin_amdgcn_s_setprio(0); } while (0)
#define PG8_WAIT_V(n) asm volatile("s_waitcnt vmcnt(" #n ")" ::: "memory")
#define PG8_WAIT_L(n) asm volatile("s_waitcnt lgkmcnt(" #n ")" ::: "memory")
#define PG8_BAR __builtin_amdgcn_s_barrier()
#define PG8_SCHED __builtin_amdgcn_sched_barrier(0)
    Unit cur, nxt; int ui = 0;
    if (!S.next(0, cur)) return;
    f32x4 acc[2][2][4][2];
#pragma unroll
    for (int a = 0; a < 2; ++a)
#pragma unroll
        for (int b = 0; b < 2; ++b)
#pragma unroll
            for (int m = 0; m < 4; ++m)
#pragma unroll
                for (int n = 0; n < 2; ++n) acc[a][b][m][n] = (f32x4){0.f, 0.f, 0.f, 0.f};
    bf16x8 At[4][2], B0[2][2], B1[2][2];
    const long arow = (long)K * 2;
    const char* cA = (const char*)g.A + ((long)cur.pm * g.a_rows + g.a_row0) * arow; const char* cB = (const char*)g.Bt + (size_t)cur.pn * tstep;
    S.a_ready(cur);
    if constexpr (SP2) {
        PG8_STAGE(PG8_SB(0, 0), cB, voffB); PG8_STAGE(PG8_SB(0, 1), cB + hstep, voffB); PG8_STAGE(PG8_SA(0, 0), cA, voffA); PG8_STAGE(PG8_SA(0, 1), cA + hstep, voffA);
        if (wr == 1) PG8_BAR;
        PG8_WAIT_V(2); PG8_BAR;
        PG8_STAGE(PG8_SB(1, 0), cB + kstep, voffB); PG8_STAGE(PG8_SA(1, 0), cA + kstep, voffA); PG8_STAGE(PG8_SB(1, 1), cB + hstep + kstep, voffB);
        PG8_WAIT_V(6); PG8_BAR;
    } else {
        PG8_STAGE(PG8_SB(0, 0), cB, voffB); PG8_STAGE(PG8_SA(0, 0), cA, voffA); PG8_STAGE(PG8_SB(0, 1), cB + hstep, voffB); PG8_STAGE(PG8_SA(0, 1), cA + hstep, voffA);
        if (wr == 1) PG8_BAR;
        PG8_WAIT_V(4); PG8_BAR;
        PG8_STAGE(PG8_SB(1, 0), cB + kstep, voffB); PG8_STAGE(PG8_SA(1, 0), cA + kstep, voffA); PG8_STAGE(PG8_SB(1, 1), cB + hstep + kstep, voffB);
        PG8_WAIT_V(6); PG8_BAR;
    }
    for (;;) {
        const bool has_next = S.next(ui + 1, nxt);
        const char* nA = has_next ? (const char*)g.A + ((long)nxt.pm * g.a_rows + g.a_row0) * arow : cA; const char* nB = has_next ? (const char*)g.Bt + (size_t)nxt.pn * tstep : cB;
        for (int t = 0; t < nt; t += 2) {
            const bool last = (t == nt - 2);
            const char* a1 = cA + (size_t)(t + 1) * kstep;
            const char* a2 = last ? nA : cA + (size_t)(t + 2) * kstep; const char* b2 = last ? nB : cB + (size_t)(t + 2) * kstep;
            const char* a3 = a2 + kstep; const char* b3 = b2 + kstep;
            if (last && has_next) S.a_ready(nxt);
            if constexpr (SP2) {
            PG8_LDB(B0, 0, 0); PG8_LDB(B1, 0, 1); PG8_SCHED; PG8_LDA(At, 0, 0); PG8_STAGE(PG8_SA(1, 1), a1 + hstep, voffA);
            PG8_WAIT_V(8); PG8_WAIT_L(0); PG8_BAR; PG8_MMA(0, 0, At, B0); PG8_MMA(0, 1, At, B1); PG8_BAR; PG8_SCHED;
            PG8_LDA(At, 0, 1); PG8_STAGE(PG8_SB(0, 0), b2, voffB); PG8_STAGE(PG8_SB(0, 1), b2 + hstep, voffB); PG8_STAGE(PG8_SA(0, 0), a2, voffA);
            PG8_WAIT_V(8); PG8_WAIT_L(0); PG8_BAR; PG8_MMA(1, 0, At, B0); PG8_MMA(1, 1, At, B1); PG8_BAR; PG8_SCHED;
            PG8_LDB(B0, 1, 0); PG8_LDB(B1, 1, 1); PG8_SCHED; PG8_LDA(At, 1, 0); PG8_STAGE(PG8_SA(0, 1), a2 + hstep, voffA);
            PG8_WAIT_V(8); PG8_WAIT_L(0); PG8_BAR; PG8_MMA(0, 0, At, B0); PG8_MMA(0, 1, At, B1); PG8_BAR; PG8_SCHED;
            PG8_LDA(At, 1, 1); PG8_STAGE(PG8_SB(1, 0), b3, voffB); PG8_STAGE(PG8_SB(1, 1), b3 + hstep, voffB); PG8_STAGE(PG8_SA(1, 0), a3, voffA);
            PG8_WAIT_V(8); PG8_WAIT_L(0); PG8_BAR; PG8_MMA(1, 0, At, B0); PG8_MMA(1, 1, At, B1); PG8_BAR; PG8_SCHED;
            } else {
            PG8_LDB(B0, 0, 0); PG8_SCHED; PG8_LDA(At, 0, 0); PG8_STAGE(PG8_SA(1, 1), a1 + hstep, voffA);
            PG8_WAIT_L(8); PG8_BAR; PG8_WAIT_L(0); PG8_MMA(0, 0, At, B0); PG8_BAR; PG8_SCHED;
            PG8_LDB(B1, 0, 1); PG8_STAGE(PG8_SB(0, 0), b2, voffB);
            PG8_BAR; PG8_WAIT_L(0); PG8_MMA(0, 1, At, B1); PG8_BAR;
            PG8_LDA(At, 0, 1); PG8_STAGE(PG8_SA(0, 0), a2, voffA);
            PG8_BAR; PG8_WAIT_L(0); PG8_MMA(1, 0, At, B0); PG8_BAR; PG8_SCHED;
            PG8_STAGE(PG8_SB(0, 1), b2 + hstep, voffB);
            PG8_WAIT_V(6); PG8_BAR; PG8_MMA(1, 1, At, B1); PG8_BAR;
            PG8_LDB(B0, 1, 0); PG8_SCHED; PG8_LDA(At, 1, 0); PG8_STAGE(PG8_SA(0, 1), a2 + hstep, voffA);
            PG8_WAIT_L(8); PG8_BAR; PG8_WAIT_L(0); PG8_MMA(0, 0, At, B0); PG8_BAR; PG8_SCHED;
            PG8_LDB(B1, 1, 1); PG8_STAGE(PG8_SB(1, 0), b3, voffB);
            PG8_BAR; PG8_WAIT_L(0); PG8_MMA(0, 1, At, B1); PG8_BAR;
            PG8_LDA(At, 1, 1); PG8_STAGE(PG8_SA(1, 0), a3, voffA);
            PG8_BAR; PG8_WAIT_L(0); PG8_MMA(1, 0, At, B0); PG8_BAR; PG8_SCHED;
            PG8_STAGE(PG8_SB(1, 1), b3 + hstep, voffB);
            PG8_WAIT_V(6); PG8_BAR; PG8_MMA(1, 1, At, B1); PG8_BAR;
            }
        }
        if constexpr (ALIGN_EPI) { if (wr == 0) PG8_BAR; }
        if constexpr (Epi::PERM_A) {
            { int tv_ = threadIdx.x; asm volatile("" : "+v"(tv_)); const int ln_ = tv_ & 63; E(acc, cur, wr, wc, ln_ & 15, ln_ >> 4); S.done(cur); }
            { int tv_ = threadIdx.x; asm volatile("" : "+v"(tv_)); PG8_VOFF(tv_); const int ln_ = tv_ & 63, fr_ = ln_ & 15, fq_ = ln_ >> 4; aoff = lds_byte(wr * 64 + fr_, fq_ * 8); boff = lds_byte(wc * 32 + fr_, fq_ * 8); }
        } else
        if constexpr (!Epi::AFTER_DRAIN) { E(acc, cur, wr, wc, fr, fq); S.done(cur); }
        if (!has_next) break;
#pragma unroll
        for (int a = 0; a < 2; ++a)
#pragma unroll
            for (int b = 0; b < 2; ++b)
#pragma unroll
                for (int m = 0; m < 4; ++m)
#pragma unroll
                    for (int n = 0; n < 2; ++n) acc[a][b][m][n] = (f32x4){0.f, 0.f, 0.f, 0.f};
        cur = nxt; cA = nA; cB = nB; ++ui;
        if constexpr (ALIGN_EPI) { if (wr == 1) PG8_BAR; }
    }
    PG8_WAIT_V(0);
    if constexpr (!ALIGN_EPI) { if (wr == 0) PG8_BAR; }
    PG8_BAR;
    if constexpr (Epi::AFTER_DRAIN) { E.fused(acc, cur, wr, wc, fr, fq, lds, wid, lane); S.done(cur); }
#undef PG8_VOFF
#undef PG8_SA
#undef PG8_SB
#undef PG8_STAGE
#undef PG8_LDA
#undef PG8_LDB
#undef PG8_MMA
#undef PG8_WAIT_V
#undef PG8_WAIT_L
#undef PG8_BAR
#undef PG8_SCHED
}
}

constexpr int NWAVES = 8;
constexpr size_t MiB = 1u << 20;
constexpr size_t WS_CTL = 0, CTL_ZERO_BYTES = 2 * MiB;
constexpr size_t WS_ROPE = 2 * MiB;
constexpr size_t WS_W = 8 * MiB;
constexpr size_t W_IN = 0, W_ODA = W_IN + (size_t)P_TOTAL * 1024 * 2, W_ORW = W_ODA + 2 * MiB, W_OUT = W_ORW + 2 * MiB, W_UP = W_OUT + 2 * MiB,
                 W_DN = W_UP + (size_t)UPW * 1024 * 2, W_LORA = W_DN + (size_t)1024 * D_FF * 2, W_LAYER = W_LORA + (size_t)3072 * 256 * 2;
static_assert(W_LAYER == 42467328, "weights per layer");
constexpr size_t W_UP1 = W_LAYER;
constexpr size_t WS_DN1 = WS_ROPE + 256 * 1024;
static_assert(WS_DN1 + (size_t)1024 * D_FF * 2 <= WS_W, "W_DN1 slot");
constexpr size_t WS_XB = WS_W + W_LAYER + (size_t)1024 * UPW * 2;
constexpr size_t ACT = (size_t)MT * 1024 * 2;
constexpr size_t WS_POOL = WS_XB + ACT;
constexpr size_t B_Q = WS_POOL, B_K = B_Q + ACT, B_V = B_K + ACT, B_OC = B_V + ACT  , B_ORW = B_OC + 2 * ACT, B_URW = B_ORW + ACT, B_LD = B_URW + (size_t)MT * P_RW * 2, B_LA = B_LD + ACT,
                 B_LG = B_LA + ACT, B_END = B_LG + ACT;
constexpr size_t B_LIN = B_LD;
constexpr size_t B_GATE = B_Q, B_OA = B_V;
constexpr size_t B_MRG = B_URW;
constexpr size_t B_UP = WS_POOL, B_GT = B_URW;
constexpr size_t WS_SP = B_END;
constexpr size_t B_END2 = WS_SP + (size_t)1024 * 32 * 132 * 4;
static_assert(B_UP + (size_t)MT * UPW * 2 <= B_GT && B_GT + (size_t)MT * D_FF * 2 <= B_LD, "FFN overlay");
static_assert(B_END2 <= 512 * MiB, "workspace map");
constexpr int CW_BAR = 4096;
constexpr int CW_LAM = 8192;
constexpr int CW_AQ = 8256;
constexpr int CW_SS = 16384;
static_assert((CW_SS + 5 * MT) * 4 <= (int)CTL_ZERO_BYTES, "CTL region");
constexpr int RING_OFF = 0, RING_BYTES = 131072;
constexpr int LDSCTL_OFF = RING_BYTES, MISC_OFF = LDSCTL_OFF + 320;
constexpr int LDS_BYTES = 147456;
constexpr int UC_HALO_OFF = LDSCTL_OFF + 1024;
static_assert(UC_HALO_OFF + 8192 <= LDS_BYTES && MISC_OFF + 64 <= UC_HALO_OFF, "halo region");

constexpr int PH_PER_LAYER = 11;
constexpr int NPHASE = 1 + DEPTH * PH_PER_LAYER + 1;
enum { K_G1 = 0, K_LP, K_LR, K_SC, K_CB, K_M1, K_M2, K_WO, K_UP, K_CV, K_DN };

#include <hip/hip_bf16.h>
#include <cmath>
namespace attn_body {
using bf16=__hip_bfloat16;
using bf16x8=__attribute__((ext_vector_type(8)))short;
using s16x4=__attribute__((ext_vector_type(4)))short;
using f32x16=__attribute__((ext_vector_type(16)))float;
using u32x4=__attribute__((ext_vector_type(4)))unsigned;
constexpr int BATCH=8,SEQ=2048,D=64,DM=1024;
constexpr int NW=8,QBLK=32,QB=QBLK*NW,KVBLK=64,NQB=SEQ/QB;
constexpr int ATTN_PITCH=DM, ATTN_UNIT_ROWS=QB;
__device__ __forceinline__ int crow(int r,int hi){return (r&3)+8*(r>>2)+4*hi;}
#define SBAR() __builtin_amdgcn_sched_barrier(0)
__device__ __forceinline__ void cmask(f32x16&p0,f32x16&p1,int jb,int wid){
  const float NEG=-INFINITY;
  if(jb>(wid>>1)){
    #pragma unroll
    for(int r=0;r<16;++r){p0[r]=NEG;p1[r]=NEG;}
  }
}

constexpr int NSLOT=3, SLOTB=8192;
constexpr int LDS_K=0, LDS_V=NSLOT*SLOTB, LDS_WS=2*NSLOT*SLOTB, LDS_OST=LDS_WS+NW*64*4, LDS_BYTES=LDS_OST+NW*4096;
constexpr float C2=0.125f*1.4426950408889634f;
__device__ __forceinline__ void glds16(const void*gsrc,unsigned lds_dst){unsigned keep;
  asm volatile("s_mov_b32 %0, m0\n\ts_mov_b32 m0, %2\n\ts_nop 0\n\tglobal_load_lds_dwordx4 %1, off\n\ts_mov_b32 m0, %0":"=&s"(keep):"v"(gsrc),"s"(lds_dst):"memory");}
__device__ __forceinline__ float max3f(float a,float b,float c){float r;asm("v_max3_f32 %0, %1, %2, %3":"=v"(r):"v"(a),"v"(b),"v"(c));return r;}
__device__ __forceinline__ float max2f(float a,float b){float r;asm("v_max_f32_e32 %0, %1, %2":"=v"(r):"v"(a),"v"(b));return r;}
__device__ __forceinline__ float fadd_s(float a,float b){float r;asm("v_add_f32_e32 %0, %1, %2":"=v"(r):"v"(a),"v"(b));return r;}
__device__ __forceinline__ float fsub_s(float a,float b){float r;asm("v_sub_f32_e32 %0, %1, %2":"=v"(r):"v"(a),"v"(b));return r;}
typedef float f32x2_t __attribute__((ext_vector_type(2))); typedef __bf16 bf16x2_t __attribute__((ext_vector_type(2)));
__device__ __forceinline__ unsigned cvtpk_s(float lo,float hi){f32x2_t v={lo,hi};bf16x2_t b=__builtin_convertvector(v,bf16x2_t);return __builtin_bit_cast(unsigned,b);}
#define WAIT_BAR(N) asm volatile("s_waitcnt vmcnt(" #N ") lgkmcnt(0)\n\ts_barrier":::"memory")

__device__ __forceinline__ void qkt(f32x16&p0,f32x16&p1,const char*Kslot,const bf16x8*qr,const f32x16&negm,int r32,int hi){
  const char*kb=Kslot+hi*1024+r32*16;
  #pragma unroll
  for(int d0=0;d0<4;++d0){
    const bf16x8 b0=*reinterpret_cast<const bf16x8*>(kb+d0*2048);
    const bf16x8 b1=*reinterpret_cast<const bf16x8*>(kb+d0*2048+512);
    if(d0==0){p0=__builtin_amdgcn_mfma_f32_32x32x16_bf16(b0,qr[0],negm,0,0,0);p1=__builtin_amdgcn_mfma_f32_32x32x16_bf16(b1,qr[0],negm,0,0,0);}
    else{p0=__builtin_amdgcn_mfma_f32_32x32x16_bf16(b0,qr[d0],p0,0,0,0);p1=__builtin_amdgcn_mfma_f32_32x32x16_bf16(b1,qr[d0],p1,0,0,0);}}
}
typedef __attribute__((address_space(3))) const char* lds_cptr;
typedef short v4i16_t __attribute__((ext_vector_type(4)));
__device__ __forceinline__ void kload8(bf16x8*kf,lds_cptr kp){
  kf[0]=*(const __attribute__((address_space(3))) bf16x8*)(kp);      kf[1]=*(const __attribute__((address_space(3))) bf16x8*)(kp+512);
  kf[2]=*(const __attribute__((address_space(3))) bf16x8*)(kp+2048); kf[3]=*(const __attribute__((address_space(3))) bf16x8*)(kp+2560);
  kf[4]=*(const __attribute__((address_space(3))) bf16x8*)(kp+4096); kf[5]=*(const __attribute__((address_space(3))) bf16x8*)(kp+4608);
  kf[6]=*(const __attribute__((address_space(3))) bf16x8*)(kp+6144); kf[7]=*(const __attribute__((address_space(3))) bf16x8*)(kp+6656);
}
__device__ __forceinline__ void kload2(bf16x8*kf,lds_cptr kp,int j){ kf[2*j]=*(const __attribute__((address_space(3))) bf16x8*)(kp+j*2048); kf[2*j+1]=*(const __attribute__((address_space(3))) bf16x8*)(kp+j*2048+512); }
__device__ __forceinline__ s16x4 vtr(lds_cptr p){ return __builtin_bit_cast(s16x4,__builtin_amdgcn_ds_read_tr16_b64_v4i16((__attribute__((address_space(3))) v4i16_t*)p)); }
__device__ __forceinline__ float rowmax(const f32x16&p0,const f32x16&p1){
  float a=max3f(p0[0],p0[1],p1[0]),b=max3f(p0[2],p0[3],p1[1]);a=max3f(a,p1[2],p1[3]);
  #pragma unroll
  for(int r=4;r<16;r+=4){a=max3f(a,p0[r],p0[r+1]);b=max3f(b,p0[r+2],p0[r+3]);a=max3f(a,p1[r],p1[r+1]);b=max3f(b,p1[r+2],p1[r+3]);}
  const float m=max2f(a,b);
  auto rr=__builtin_amdgcn_permlane32_swap(__float_as_uint(m),__float_as_uint(m),false,false);
  return max2f(__uint_as_float(rr[0]),__uint_as_float(rr[1]));
}
__device__ __forceinline__ void pv(f32x16*o,int vb,bf16x8 pa0,bf16x8 pa1,bf16x8 pa2,bf16x8 pa3){
  #pragma unroll
  for(int d0=0;d0<2;++d0){s16x4 lo[4],hi[4];
    #pragma unroll
    for(int ks=0;ks<4;++ks){
      asm volatile("ds_read_b64_tr_b16 %0,%1 offset:%c2":"=&v"(lo[ks]):"v"(vb),"i"(d0*4096+ks*1024):"memory");
      asm volatile("ds_read_b64_tr_b16 %0,%1 offset:%c2":"=&v"(hi[ks]):"v"(vb),"i"(d0*4096+ks*1024+512):"memory");}
    asm volatile("s_waitcnt lgkmcnt(0)":::"memory");SBAR();
    #define PK(k) (bf16x8){lo[k][0],lo[k][1],lo[k][2],lo[k][3],hi[k][0],hi[k][1],hi[k][2],hi[k][3]}
    o[d0]=__builtin_amdgcn_mfma_f32_32x32x16_bf16(pa0,PK(0),o[d0],0,0,0);
    o[d0]=__builtin_amdgcn_mfma_f32_32x32x16_bf16(pa1,PK(1),o[d0],0,0,0);
    o[d0]=__builtin_amdgcn_mfma_f32_32x32x16_bf16(pa2,PK(2),o[d0],0,0,0);
    o[d0]=__builtin_amdgcn_mfma_f32_32x32x16_bf16(pa3,PK(3),o[d0],0,0,0);
    #undef PK
  }
}

#ifndef ATTN_STORE16
#define ATTN_STORE16(p,v) (*(u32x4*)(p)=(v))
#endif
template<int THRL> __device__ __forceinline__ void attn_unit(int b,int qcol,int vcol,int qb,const bf16*Q,const bf16*K,const bf16*V,bf16*O,char*shm){
  int tid_=threadIdx.x; asm volatile("" : "+v"(tid_)); const int tid=tid_,lane=tid&63,r32=lane&31,hi=lane>>5; const int wid=__builtin_amdgcn_readfirstlane(tid>>6);
  const long rowbase=(long)b*SEQ; const int q0=qb*QB;
  const bf16*Qw=Q+(rowbase+q0+wid*QBLK)*DM+qcol;
  const bf16*Kh=K+rowbase*DM+qcol,*Vh=V+rowbase*DM+vcol;
  const unsigned lds0=(unsigned)(uintptr_t)shm;
  float*wsf=(float*)(shm+LDS_WS)+wid*64;
  const bf16*ksrc=Kh+(long)lane*DM+wid*8;
  const bf16*vsrc=Vh+(long)(16*(wid&3)+(lane>>2))*DM+(wid>>2)*32+(lane&3)*8;
  const unsigned kdst=lds0+LDS_K+wid*1024, vdst=lds0+LDS_V+wid*1024;
  #define DMA_K(t,slot) glds16(ksrc+(long)(t)*KVBLK*DM,(unsigned)__builtin_amdgcn_readfirstlane(kdst+(slot)))
  #define DMA_V(t,slot) glds16(vsrc+(long)(t)*KVBLK*DM,(unsigned)__builtin_amdgcn_readfirstlane(vdst+(slot)))
  const int vb0=(int)(lds0+LDS_V)+((lane>>4)&1)*32+(lane&3)*8+(4*hi+((lane&15)>>2))*64;
  const char*Kbase=shm+LDS_K; bf16x8 kf[8];
  const lds_cptr shm3=(lds_cptr)shm; const lds_cptr kp0=shm3+LDS_K+hi*1024+r32*16; const lds_cptr vp0=shm3+LDS_V+((lane>>4)&1)*32+(lane&3)*8+(4*hi+((lane&15)>>2))*64;
  const int NT=(q0+QB)/KVBLK;
  DMA_K(0,0);DMA_V(0,0);DMA_K(1,SLOTB);
  bf16x8 qr[4];
  #pragma unroll
  for(int d0=0;d0<4;++d0)qr[d0]=*reinterpret_cast<const bf16x8*>(&Qw[(long)r32*DM+d0*16+hi*8]);
  float mhat=0.f,l_reg=0.f;f32x16 o[2];o[0]=f32x16{};o[1]=f32x16{};const f32x16 zc=f32x16{}; float nm=0.f;
  const int qrel=wid*QBLK+r32;
  #define CMASK(P0,P1,t) do{int jb_=(t)-(NT-4); if(jb_>=0)cmask(P0,P1,jb_,wid);}while(0)
  bool resc=false;
  #define START(P0,P1) do{ const float rm=rowmax(P0,P1); resc=false; \
    { const float dl=rm; mhat=fadd_s(mhat,dl); \
      _Pragma("unroll") for(int r=0;r<16;++r){P0[r]=fsub_s(P0[r],dl);P1[r]=fsub_s(P1[r],dl);} \
      nm=-mhat; } \
    _Pragma("unroll") for(int r=0;r<16;++r)P0[r]=__builtin_amdgcn_exp2f(P0[r]); }while(0)
  #define RESC() do{ if(resc){ asm volatile("s_waitcnt lgkmcnt(0)":::"memory"); \
      _Pragma("unroll") for(int d_=0;d_<2;++d_) _Pragma("unroll") for(int r=0;r<16;++r)o[d_][r]*=wsf[crow(r,hi)]; } }while(0)
  f32x16 pA0,pA1,pB0,pB1;
  int sl_prev=0,sl_cur=0,sl_next=SLOTB;
  #define ROT() do{sl_prev=sl_cur;sl_cur=sl_next;sl_next=(sl_next==(NSLOT-1)*SLOTB)?0:sl_next+SLOTB;}while(0)
  DMA_K(2,2*SLOTB);
  WAIT_BAR(3);
  qkt(pA0,pA1,Kbase,qr,zc,r32,hi);asm volatile("s_nop 15\n\ts_nop 7":"+v"(pA0),"+v"(pA1));CMASK(pA0,pA1,0);
  START(pA0,pA1);
  _Pragma("unroll") for(int r=0;r<16;++r)pA1[r]=__builtin_amdgcn_exp2f(pA1[r]);
  WAIT_BAR(0);
  DMA_K(3,0);DMA_V(1,SLOTB);
  ROT();
  kload8(kf,kp0+sl_cur);
  WAIT_BAR(2);
  s16x4 vlo[8],vhi[8]; u32x4 pw0,pw1,pw2,pw3;
  #define PKW(P,B) cvtpk_s(P[B],P[B+1])
  #define PAF(k) __builtin_bit_cast(bf16x8,pw##k)
  #define VFR(i) (bf16x8){vlo[i][0],vlo[i][1],vlo[i][2],vlo[i][3],vhi[i][0],vhi[i][1],vhi[i][2],vhi[i][3]}
  #define PIN(x) asm volatile("":"+v"(x))
  #define MX3(a,b,c) __builtin_fmaxf(__builtin_fmaxf((a),(b)),(c))
  #define GAPA(MF,A0,A1,A2,A3,W0,W1,PW) do{ MF; sacc+=A0; sacc+=A1; sacc+=A2; sacc+=A3; PIN(sacc); W0; W1; PIN(PW); SBAR(); }while(0)
  #define EX(v) __builtin_amdgcn_exp2f(v)
  #define GAPB(MF,X,B) do{ MF; X[B]=EX(X[B]); X[B+1]=EX(X[B+1]); X[B+2]=EX(X[B+2]); X[B+3]=EX(X[B+3]); PIN(X); SBAR(); }while(0)
  #define VRD(i) do{ vlo[i]=vtr(vp_+(((i)>>2)*4096+((i)&3)*1024)); vhi[i]=vtr(vp_+(((i)>>2)*4096+((i)&3)*1024+512)); }while(0)
  #define KRD(G,j) do{ if(G){ kload2(kf,kp0+sl_next,j); SBAR(); } }while(0)
  #define STEP(C0,C1,P0,P1,t,GK,GV,GL) do{ SBAR(); \
    const lds_cptr vp_=vp0+sl_prev; \
    VRD(0); SBAR(); float sacc=(P0[0]+P0[1]); \
    GAPA(C0=__builtin_amdgcn_mfma_f32_32x32x16_bf16(kf[0],qr[0],zc,0,0,0), P0[2],P0[3],P0[4],P0[5],     pw0[0]=PKW(P0,0), pw0[1]=PKW(P0,2), pw0); \
    VRD(4); SBAR(); GAPA(C1=__builtin_amdgcn_mfma_f32_32x32x16_bf16(kf[1],qr[0],zc,0,0,0), P0[6],P0[7],P0[8],P0[9],     pw0[2]=PKW(P0,4), pw0[3]=PKW(P0,6), pw0); \
    VRD(1); SBAR(); GAPA(C0=__builtin_amdgcn_mfma_f32_32x32x16_bf16(kf[2],qr[1],C0,0,0,0),   P0[10],P0[11],P0[12],P0[13], pw1[0]=PKW(P0,8), pw1[1]=PKW(P0,10), pw1); \
    VRD(5); SBAR(); GAPA(C1=__builtin_amdgcn_mfma_f32_32x32x16_bf16(kf[3],qr[1],C1,0,0,0),   P0[14],P0[15],P1[0],P1[1],   pw1[2]=PKW(P0,12),pw1[3]=PKW(P0,14), pw1); \
    VRD(2); SBAR(); GAPA(C0=__builtin_amdgcn_mfma_f32_32x32x16_bf16(kf[4],qr[2],C0,0,0,0),   P1[2],P1[3],P1[4],P1[5],     pw2[0]=PKW(P1,0), pw2[1]=PKW(P1,2), pw2); \
    VRD(6); SBAR(); GAPA(C1=__builtin_amdgcn_mfma_f32_32x32x16_bf16(kf[5],qr[2],C1,0,0,0),   P1[6],P1[7],P1[8],P1[9],     pw2[2]=PKW(P1,4), pw2[3]=PKW(P1,6), pw2); \
    VRD(3); SBAR(); GAPA(C0=__builtin_amdgcn_mfma_f32_32x32x16_bf16(kf[6],qr[3],C0,0,0,0),   P1[10],P1[11],P1[12],P1[13], pw3[0]=PKW(P1,8), pw3[1]=PKW(P1,10), pw3); \
    VRD(7); SBAR(); GAPA(C1=__builtin_amdgcn_mfma_f32_32x32x16_bf16(kf[7],qr[3],C1,0,0,0),   P1[14],P1[15],0.f,0.f,       pw3[2]=PKW(P1,12),pw3[3]=PKW(P1,14), pw3); \
    l_reg+=sacc; \
    if(GK){DMA_K((t)+3,sl_cur);} if(GV){DMA_V((t)+1,sl_next);} \
    _Pragma("unroll") for(int r=0;r<16;++r){C0[r]+=nm;C1[r]+=nm;} \
    CMASK(C0,C1,t); \
    { float a=MX3(C0[0],C0[1],C1[0]),b=MX3(C0[2],C0[3],C1[1]); a=MX3(a,C1[2],C1[3]); \
      _Pragma("unroll") for(int r=4;r<16;r+=4){a=MX3(a,C0[r],C0[r+1]);b=MX3(b,C0[r+2],C0[r+3]);a=MX3(a,C1[r],C1[r+1]);b=MX3(b,C1[r+2],C1[r+3]);} \
      float rm=__builtin_fmaxf(a,b); { auto rr=__builtin_amdgcn_permlane32_swap(__float_as_uint(rm),__float_as_uint(rm),false,false); rm=__builtin_fmaxf(__uint_as_float(rr[0]),__uint_as_float(rr[1])); } \
      resc=false; \
      if(__builtin_expect(__any(rm>(float)THRL),0)){ const float dl=__builtin_fmaxf(rm,0.f); mhat+=dl; \
        _Pragma("unroll") for(int r=0;r<16;++r){C0[r]-=dl;C1[r]-=dl;} \
        nm=-mhat; \
        const float f=__builtin_amdgcn_exp2f(-dl); l_reg*=f; if(hi==0)wsf[r32]=f; resc=true; } } \
    SBAR(); \
    GAPB(o[0]=__builtin_amdgcn_mfma_f32_32x32x16_bf16(PAF(0),VFR(0),o[0],0,0,0), C0,0); \
    GAPB(o[1]=__builtin_amdgcn_mfma_f32_32x32x16_bf16(PAF(0),VFR(4),o[1],0,0,0), C0,4); \
    KRD(GL,0); GAPB(o[0]=__builtin_amdgcn_mfma_f32_32x32x16_bf16(PAF(1),VFR(1),o[0],0,0,0), C0,8); \
    KRD(GL,1); GAPB(o[1]=__builtin_amdgcn_mfma_f32_32x32x16_bf16(PAF(1),VFR(5),o[1],0,0,0), C0,12); \
    KRD(GL,2); GAPB(o[0]=__builtin_amdgcn_mfma_f32_32x32x16_bf16(PAF(2),VFR(2),o[0],0,0,0), C1,0); \
    KRD(GL,3); GAPB(o[1]=__builtin_amdgcn_mfma_f32_32x32x16_bf16(PAF(2),VFR(6),o[1],0,0,0), C1,4); \
    GAPB(o[0]=__builtin_amdgcn_mfma_f32_32x32x16_bf16(PAF(3),VFR(3),o[0],0,0,0), C1,8); \
    GAPB(o[1]=__builtin_amdgcn_mfma_f32_32x32x16_bf16(PAF(3),VFR(7),o[1],0,0,0), C1,12); \
    }while(0)
  int t=1;
  #undef CMASK
  #define CMASK(P0,P1,t) do{}while(0)
  for(;t+5<NT;t+=2){
    STEP(pB0,pB1,pA0,pA1,t,true,true,true);     WAIT_BAR(2); RESC(); ROT();
    STEP(pA0,pA1,pB0,pB1,t+1,true,true,true);   WAIT_BAR(2); RESC(); ROT();
  }
  #undef CMASK
  #define CMASK(P0,P1,t) do{int jb_=(t)-(NT-4); if(jb_>=0)cmask(P0,P1,jb_,wid);}while(0)
  #define ENDW(tt) do{ if((tt)+3<NT){WAIT_BAR(2);} else if((tt)+2<NT){WAIT_BAR(1);} else {WAIT_BAR(0);} }while(0)
  for(;t+1<NT;t+=2){
    STEP(pB0,pB1,pA0,pA1,t,(t+3<NT),(t+1<NT),(t+1<NT));       ENDW(t);   RESC(); ROT();
    STEP(pA0,pA1,pB0,pB1,t+1,(t+4<NT),(t+2<NT),(t+2<NT));     ENDW(t+1); RESC(); ROT();
  }
  STEP(pB0,pB1,pA0,pA1,NT-1,false,false,false); RESC();
  { float sacc=pB0[0]+pB0[1]; _Pragma("unroll") for(int r=2;r<16;++r)sacc+=pB0[r]; _Pragma("unroll") for(int r=0;r<16;++r)sacc+=pB1[r]; l_reg+=sacc;
    pw0=(u32x4){PKW(pB0,0),PKW(pB0,2),PKW(pB0,4),PKW(pB0,6)};pw1=(u32x4){PKW(pB0,8),PKW(pB0,10),PKW(pB0,12),PKW(pB0,14)};pw2=(u32x4){PKW(pB1,0),PKW(pB1,2),PKW(pB1,4),PKW(pB1,6)};pw3=(u32x4){PKW(pB1,8),PKW(pB1,10),PKW(pB1,12),PKW(pB1,14)};
    SBAR(); pv(o,vb0+sl_cur,PAF(0),PAF(1),PAF(2),PAF(3)); }
  #undef PKW
  #undef PAF
  #undef VFR
  #undef PIN
  #undef MX3
  #undef GAPA
  #undef GAPB
  #undef EX
  #undef VRD
  #undef KRD
  #undef STEP
  #undef ENDW
  {auto rr=__builtin_amdgcn_permlane32_swap(__float_as_uint(l_reg),__float_as_uint(l_reg),false,false);l_reg=__uint_as_float(rr[0])+__uint_as_float(rr[1]);}
  if(hi==0)wsf[32+r32]=l_reg;asm volatile("s_waitcnt lgkmcnt(0)":::"memory");
  float rli[16];
  #pragma unroll
  for(int r=0;r<16;++r)rli[r]=__builtin_amdgcn_rcpf(wsf[32+crow(r,hi)]);
  bf16*Ow=O+(rowbase+q0+wid*QBLK)*DM+vcol;
  { bf16*stg=(bf16*)(shm+LDS_OST)+wid*2048;
    #pragma unroll
    for(int r=0;r<16;++r){const int orow=crow(r,hi);
      #pragma unroll
      for(int d0=0;d0<2;++d0)stg[orow*64+d0*32+r32]=__float2bfloat16(o[d0][r]*rli[r]);}
    asm volatile("s_waitcnt lgkmcnt(0)":::"memory");
    #pragma unroll
    for(int i=0;i<4;++i){const int row=i*8+(lane>>3),ch=lane&7; const u32x4 v=*(const u32x4*)(stg+row*64+ch*8); ATTN_STORE16(Ow+(long)row*DM+ch*8,v);} }
  asm volatile("s_waitcnt lgkmcnt(0)\n\ts_barrier":::"memory");
  #undef DMA_K
  #undef DMA_V
  #undef CMASK
  #undef START
  #undef RESC
  #undef ROT
}
typedef float f32x4 __attribute__((ext_vector_type(4)));
constexpr int SA_K0=0, SA_K1=8192, SA_V0=16384, SA_V1=24576, SA_WS=32768, SA_BYTES=SA_WS+8*256;
__device__ __forceinline__ unsigned pk2bf(float lo,float hi){return cvtpk_s(lo,hi);}
__device__ __forceinline__ void sample_unit(int l,int b,int h,int s,const float*cache_k,const float*cache_v,const bf16*Q,const bf16*K,const bf16*V,float*SP,char*shm){
  int tid_=threadIdx.x; asm volatile("" : "+v"(tid_)); const int tid=tid_,lane=tid&63,r32=lane&31,hi=lane>>5; const int wid=__builtin_amdgcn_readfirstlane(tid>>6);
  const unsigned lds0=(unsigned)(uintptr_t)shm;
  float*wsf=(float*)(shm+SA_WS)+wid*64;
  const int c=wid>>1,vh=wid&1;
  const int qrow=16384+b*32;
  bf16x8 qr[4];
  if(wid<4){
    #pragma unroll
    for(int d0=0;d0<4;++d0)qr[d0]=*reinterpret_cast<const bf16x8*>(&Q[(long)(qrow+r32)*DM+h*128+c*64+d0*16+hi*8]);
  }
  float m=-1e30f,lsum=0.f; f32x16 o[2]; o[0]=f32x16{}; o[1]=f32x16{};
  const f32x16 zc=f32x16{};
  const int ntile=(s==7)?5:4;
  const float*ckb=cache_k+((long)(l*8+b)*2048)*1024+h*128; const float*cvb=cache_v+((long)(l*8+b)*2048)*1024+h*128;
  for(int ti=0;ti<ntile;++ti){
    const bool fresh=(ti==4);
    #pragma unroll
    for(int pi=0;pi<2;++pi){
      const int pk=wid*2+pi;
      { const int kc=pk>>3,ch=pk&7; u32x4 wv;
        if(!fresh){ const float*src=ckb+(long)((4*s+ti)*64+lane)*1024+kc*64+ch*8; const f32x4 a=*(const f32x4*)src,bq=*(const f32x4*)(src+4);
          wv.x=pk2bf(a.x,a.y);wv.y=pk2bf(a.z,a.w);wv.z=pk2bf(bq.x,bq.y);wv.w=pk2bf(bq.z,bq.w); }
        else if(lane<32){ wv=*(const u32x4*)(K+(long)(qrow+lane)*DM+h*128+kc*64+ch*8); }
        else { wv=(u32x4){0u,0u,0u,0u}; }
        *(u32x4*)(shm+(kc?SA_K1:SA_K0)+ch*1024+lane*16)=wv; }
      { const int vv=pk>>3,p=pk&7; const int row=16*(p&3)+(lane>>2),col=vv*64+32*(p>>2)+8*(lane&3); u32x4 wv;
        if(!fresh){ const float*src=cvb+(long)((4*s+ti)*64+row)*1024+col; const f32x4 a=*(const f32x4*)src,bq=*(const f32x4*)(src+4);
          wv.x=pk2bf(a.x,a.y);wv.y=pk2bf(a.z,a.w);wv.z=pk2bf(bq.x,bq.y);wv.w=pk2bf(bq.z,bq.w); }
        else if(row<32){ wv=*(const u32x4*)(V+(long)(qrow+row)*DM+h*128+col); }
        else { wv=(u32x4){0u,0u,0u,0u}; }
        *(u32x4*)(shm+(vv?SA_V1:SA_V0)+p*1024+lane*16)=wv; }
    }
    __syncthreads();
    if(wid<4){
      f32x16 p0,p1;
      qkt(p0,p1,shm+(c?SA_K1:SA_K0),qr,zc,r32,hi);
      if(fresh){
        #pragma unroll
        for(int r=0;r<16;++r)p1[r]=-INFINITY;
      }
      float rm=p0[0];
      #pragma unroll
      for(int r=1;r<16;++r)rm=__builtin_fmaxf(rm,p0[r]);
      #pragma unroll
      for(int r=0;r<16;++r)rm=__builtin_fmaxf(rm,p1[r]);
      rm=__builtin_fmaxf(rm,__shfl_xor(rm,32));
      const float mn=__builtin_fmaxf(m,rm),alpha=__builtin_amdgcn_exp2f(m-mn);
      float ps=0.f;
      #pragma unroll
      for(int r=0;r<16;++r){p0[r]=__builtin_amdgcn_exp2f(p0[r]-mn);p1[r]=__builtin_amdgcn_exp2f(p1[r]-mn);ps+=p0[r]+p1[r];}
      lsum=lsum*alpha+ps; m=mn;
      if(hi==0)wsf[r32]=alpha;
      asm volatile("s_waitcnt lgkmcnt(0)":::"memory");
      #pragma unroll
      for(int g=0;g<4;++g){ const f32x4 f4=*(const f32x4*)(wsf+8*g+4*hi);
        #pragma unroll
        for(int i=0;i<4;++i){o[0][4*g+i]*=f4[i];o[1][4*g+i]*=f4[i];} }
      u32x4 pw0,pw1,pw2,pw3;
      pw0=(u32x4){pk2bf(p0[0],p0[1]),pk2bf(p0[2],p0[3]),pk2bf(p0[4],p0[5]),pk2bf(p0[6],p0[7])};
      pw1=(u32x4){pk2bf(p0[8],p0[9]),pk2bf(p0[10],p0[11]),pk2bf(p0[12],p0[13]),pk2bf(p0[14],p0[15])};
      pw2=(u32x4){pk2bf(p1[0],p1[1]),pk2bf(p1[2],p1[3]),pk2bf(p1[4],p1[5]),pk2bf(p1[6],p1[7])};
      pw3=(u32x4){pk2bf(p1[8],p1[9]),pk2bf(p1[10],p1[11]),pk2bf(p1[12],p1[13]),pk2bf(p1[14],p1[15])};
      const int vb=(int)(lds0+(vh?SA_V1:SA_V0))+((lane>>4)&1)*32+(lane&3)*8+(4*hi+((lane&15)>>2))*64;
      pv(o,vb,__builtin_bit_cast(bf16x8,pw0),__builtin_bit_cast(bf16x8,pw1),__builtin_bit_cast(bf16x8,pw2),__builtin_bit_cast(bf16x8,pw3));
    }
    __syncthreads();
  }
  if(wid<4){
    lsum+=__shfl_xor(lsum,32);
    float*sp=SP+((long)(((b*8+h)*2+c)*8+s)*32)*132;
    if(vh==0&&hi==0){sp[r32*132]=m;sp[r32*132+1]=lsum;}
    #pragma unroll
    for(int d0=0;d0<2;++d0)
      #pragma unroll
      for(int r=0;r<16;++r)sp[crow(r,hi)*132+4+vh*64+32*d0+r32]=o[d0][r];
  }
}
constexpr int ATTN_LDS_BYTES=LDS_BYTES;
#undef SBAR
#undef WAIT_BAR
}

#define GAS __attribute__((address_space(1)))
#define LAS __attribute__((address_space(3)))
typedef unsigned short bf16;
typedef unsigned v4u __attribute__((ext_vector_type(4)));
typedef float f32x4 __attribute__((ext_vector_type(4)));
typedef short bf16x8 __attribute__((ext_vector_type(8)));
typedef GAS unsigned gu32;
typedef GAS unsigned long long gu64;
#define RLX_AGENT __ATOMIC_RELAXED, __HIP_MEMORY_SCOPE_AGENT
#define LDS_WAIT() asm volatile("s_waitcnt lgkmcnt(0)" ::: "memory")
#define VM_WAIT() asm volatile("s_waitcnt vmcnt(0)" ::: "memory")
__device__ __forceinline__ unsigned long long rt() { return __builtin_amdgcn_s_memrealtime(); }
__device__ __forceinline__ unsigned f2bf(float f) { unsigned u = __builtin_bit_cast(unsigned, f); return (u + 0x7fffu + ((u >> 16) & 1u)) >> 16; }
__device__ __forceinline__ unsigned pk2(float lo, float hi) { return f2bf(lo) | (f2bf(hi) << 16); }

#define XB_TMO      128
#define XB_XCNT(j)  (256  + 64 * (j))
#define XB_XSUB(j)  (1280 + 64 * (j))
#define XB_XGEN(j)  (2304 + 64 * (j))
#define XB_TOP      3328
#define XB_TOPGEN   3392
#define XCD_BAR_WORDS 3456
#define XB_SPIN_CAP (1u << 22)

__device__ __forceinline__ unsigned xb_ld(unsigned* p)              { return __hip_atomic_load(p, __ATOMIC_RELAXED, __HIP_MEMORY_SCOPE_AGENT); }
__device__ __forceinline__ unsigned xb_add(unsigned* p, unsigned v) { return __hip_atomic_fetch_add(p, v, __ATOMIC_RELAXED, __HIP_MEMORY_SCOPE_AGENT); }
__device__ __forceinline__ unsigned xb_xcc_id() { return (unsigned)__builtin_amdgcn_s_getreg((3 << 11) | 20) & 0xFu; }
#define XB_SPIN(cond, bar) do { unsigned _sp = 0; while (cond) { __builtin_amdgcn_s_sleep(1); \
    if ((++_sp & 255u) == 0u) { if (xb_ld(&(bar)[XB_TMO])) break; if (_sp > XB_SPIN_CAP) { atomicAdd(&(bar)[XB_TMO], 1u); break; } } } } while (0)

struct XcdBarrier {
    unsigned* bar; unsigned x;
    volatile LAS unsigned* st;
};

__device__ __forceinline__ XcdBarrier xcd_barrier_post(unsigned* bar, volatile LAS unsigned* st) {
    XcdBarrier b; b.bar = bar; b.x = xb_xcc_id(); b.st = st;
    if (threadIdx.x == 0) (void)xb_add(&bar[XB_XCNT(b.x)], 1u);
    return b;
}
__device__ __forceinline__ void xcd_barrier_complete(unsigned* bar, unsigned x, unsigned& nloc, unsigned& nx) {
    const unsigned G = gridDim.x * gridDim.y * gridDim.z;
    unsigned sum, cnt, mine, sp = 0u;
    for (;;) {
        sum = 0u; cnt = 0u; mine = 0u;
#pragma unroll
        for (unsigned j = 0; j < 16; ++j) { const unsigned c = xb_ld(&bar[XB_XCNT(j)]); sum += c; cnt += (c > 0u) ? 1u : 0u; mine = (j == x) ? c : mine; }
        if (sum == G) break;
        __builtin_amdgcn_s_sleep(1);
        if ((++sp & 255u) == 0u) { if (xb_ld(&bar[XB_TMO])) break; if (sp > XB_SPIN_CAP) { atomicAdd(&bar[XB_TMO], 1u); break; } }
    }
    nloc = mine > 0u ? mine : 1u; nx = cnt > 0u ? cnt : 1u;
}

__device__ __forceinline__ void xcd_barrier(const XcdBarrier& b) {
    asm volatile("s_waitcnt vmcnt(0)" ::: "memory");
    __syncthreads();
    if (threadIdx.x == 0) {
        unsigned* bar = b.bar;
        __builtin_amdgcn_s_waitcnt(0);
        unsigned nloc = b.st[0], nx = b.st[1];
        if (nloc == 0u) { xcd_barrier_complete(bar, b.x, nloc, nx); b.st[0] = nloc; b.st[1] = nx; }
        const unsigned old = xb_add(&bar[XB_XSUB(b.x)], 1u);
        const unsigned gen = old / nloc;
        if (old + 1u == (gen + 1u) * nloc) {
            __builtin_amdgcn_fence(__ATOMIC_RELEASE, "agent");
            asm volatile("s_waitcnt vmcnt(0)" ::: "memory");
            const unsigned og = xb_add(&bar[XB_TOP], 1u);
            const unsigned tg = og / nx;
            if (og + 1u == (tg + 1u) * nx) xb_add(&bar[XB_TOPGEN], 1u);
            else XB_SPIN(xb_ld(&bar[XB_TOPGEN]) == tg, bar);
            __builtin_amdgcn_fence(__ATOMIC_ACQUIRE, "agent");
            xb_add(&bar[XB_XGEN(b.x)], 1u);
            asm volatile("s_waitcnt vmcnt(0)" ::: "memory");
        } else {
            XB_SPIN(xb_ld(&bar[XB_XGEN(b.x)]) == gen, bar);
            __builtin_amdgcn_fence(__ATOMIC_ACQUIRE, "agent");
            asm volatile("s_waitcnt vmcnt(0)" ::: "memory");
        }
    }
    __syncthreads();
}

struct Args { const GAS float* in[31]; GAS float* out; GAS unsigned char* ws; float rinv[8]; int ph_lo, ph_hi; };
#define GIN(A, i) ((const float*)((A)->in[i]))
typedef const Args __attribute__((address_space(4)))* CArgsP;
struct Frame {
    LAS unsigned char* lds;
    volatile LAS unsigned* MISC;
    gu32* ctl;
    int tid, lane, wave, vcu, G;
    float* out; unsigned char* ws;
};
__device__ __forceinline__ float wave_sum(float v) {
#pragma unroll
    for (int o = 1; o < 64; o <<= 1) v += __shfl_xor(v, o);
    return v;
}
template <int CTRL> __device__ __forceinline__ float dppf(float x) { return __builtin_bit_cast(float, __builtin_amdgcn_update_dpp(0, __builtin_bit_cast(int, x), CTRL, 0xF, 0xF, false)); }
__device__ __forceinline__ float reduce8(float x) { x += dppf<0xB1>(x); x += dppf<0x4E>(x); x += dppf<0x141>(x); return x; }
__device__ __forceinline__ float reduce16(float x) { x = reduce8(x); x += dppf<0x140>(x); return x; }
__device__ __forceinline__ float bf2f(bf16 h) { return __uint_as_float((unsigned)h << 16); }
__device__ __forceinline__ float bflo(unsigned w) { return __uint_as_float(w << 16); }
__device__ __forceinline__ float bfhi(unsigned w) { return __uint_as_float(w & 0xffff0000u); }

__device__ __forceinline__ void p0_transpose_item(const float* W, int N, bf16* WT, int ldk, int koff, int row_off, const float* kscale, LAS float* scr, int item, int lane) {
    const int nblk = N / 32, kb = item / nblk, nb = item % nblk, k0 = 64 * kb, n0 = 32 * nb;
    float wv[32];
#pragma unroll
    for (int i = 0; i < 32; ++i) wv[i] = W[(size_t)(k0 + 2 * i + (lane >> 5)) * N + n0 + (lane & 31)];
#pragma unroll
    for (int i = 0; i < 32; ++i) { const int kk = 2 * i + (lane >> 5); float w = wv[i]; if (kscale) w *= kscale[k0 + kk]; scr[kk * 33 + (lane & 31)] = w; }
    LDS_WAIT(); asm volatile("" ::: "memory");
    const int c = lane & 7;
#pragma unroll
    for (int j = 0; j < 4; ++j) { const int n = (lane >> 3) + 8 * j; const LAS float* s = scr + (8 * c) * 33 + n;
        v4u o; o.x = pk2(s[0 * 33], s[1 * 33]); o.y = pk2(s[2 * 33], s[3 * 33]); o.z = pk2(s[4 * 33], s[5 * 33]); o.w = pk2(s[6 * 33], s[7 * 33]);
        *(GAS v4u*)(WT + (size_t)(row_off + n0 + n) * ldk + koff + k0 + 8 * c) = o; }
    LDS_WAIT(); asm volatile("" ::: "memory");
}
__device__ __forceinline__ int up_row_off(int item) { const int n0 = 32 * (item % (UPW / 32)), hf = n0 >= D_FF ? 1 : 0, j = n0 - hf * D_FF; return (j >> 7) * 256 + hf * 128 + (j & 127) - n0; }
constexpr int WP_IN = 1, WP_SQ = 2, WP_UP = 4, WP_DN = 8, WP_LORA = 16, WP_ALL = 31;
__device__ __forceinline__ void p0_weights(Frame& F, CArgsP A, int l, int gw, int NGW, const int part) {
    LAS float* scr = (LAS float*)(F.lds + RING_OFF + F.wave * 16384);
    constexpr int I_IN = (1024 / 64) * (P_TOTAL / 32), I_SQ = (1024 / 64) * (1024 / 32), I_UP = (1024 / 64) * (UPW / 32), I_DN = (D_FF / 64) * (1024 / 32),
                  I_W2 = 1 * (1024 / 32), I_G2 = 2 * (1024 / 32);
    unsigned char* wl = F.ws + WS_W;
    int base = 0;
#define WITEMS(NI, CALL) do { int it = (gw - base) % NGW; if (it < 0) it += NGW; for (; it < (NI); it += NGW) { const int r = it; CALL; } base += (NI); } while (0)
    if (part & WP_IN) WITEMS(I_IN, p0_transpose_item(GIN(A, 8) + (size_t)l * 1024 * P_TOTAL, P_TOTAL, (bf16*)(wl + W_IN), 1024, 0, 0, GIN(A, 7) + l * 1024, scr, r, F.lane));
    if (part & WP_SQ) {
        WITEMS(I_SQ, p0_transpose_item(GIN(A, 11) + (size_t)l * 1024 * 1024, 1024, (bf16*)(wl + W_ODA), 1024, 0, 0, nullptr, scr, r, F.lane));
        WITEMS(I_SQ, p0_transpose_item(GIN(A, 23) + (size_t)l * 1024 * 1024, 1024, (bf16*)(wl + W_ORW), 1024, 0, 0, nullptr, scr, r, F.lane));
        WITEMS(I_SQ, p0_transpose_item(GIN(A, 24) + (size_t)l * 1024 * 1024, 1024, (bf16*)(wl + W_OUT), 1024, 0, 0, nullptr, scr, r, F.lane));
    }
    if (part & WP_UP) WITEMS(I_UP, p0_transpose_item(GIN(A, 26) + (size_t)l * 1024 * UPW, UPW, (bf16*)(wl + (l ? W_UP1 : W_UP)), 1024, 0, up_row_off(r), GIN(A, 25) + l * 1024, scr, r, F.lane));
    if (part & WP_DN) WITEMS(I_DN, p0_transpose_item(GIN(A, 29) + (size_t)l * D_FF * 1024, 1024, (bf16*)(l ? F.ws + WS_DN1 : wl + W_DN), D_FF, 0, 0, nullptr, scr, r, F.lane));
    if (part & WP_LORA) {
        WITEMS(I_W2, p0_transpose_item(GIN(A, 14) + (size_t)l * 64 * 1024, 1024, (bf16*)(wl + W_LORA), 256, 0, 0, nullptr, scr, r, F.lane));
        WITEMS(I_W2, p0_transpose_item(GIN(A, 16) + (size_t)l * 64 * 1024, 1024, (bf16*)(wl + W_LORA), 256, 64, 1024, nullptr, scr, r, F.lane));
        WITEMS(I_G2, p0_transpose_item(GIN(A, 17) + (size_t)l * 128 * 1024, 1024, (bf16*)(wl + W_LORA), 256, 128, 2048, nullptr, scr, r, F.lane));
        for (int i = gw * 64 + F.lane; i < 3072 * 32; i += NGW * 64) {
            const int n = i >> 5, kc = i & 31, blk = n >> 10;
            const bool nz = (blk == 0) ? (kc < 8) : (blk == 1) ? (kc >= 8 && kc < 16) : (kc >= 16);
            if (!nz) *(GAS v4u*)(wl + W_LORA + ((size_t)n * 256 + kc * 8) * 2) = (v4u){0u, 0u, 0u, 0u};
        }
    }
#undef WITEMS
}
__device__ __forceinline__ void p0_prologue(Frame& F, CArgsP A) {
    const int gw = F.vcu * NWAVES + F.wave, NGW = F.G * NWAVES;
    p0_weights(F, A, 0, gw, NGW, WP_ALL);
    {
        const int gt = gw * 64 + F.lane, NGT = NGW * 64;
        float* rope = (float*)(F.ws + WS_ROPE);
        for (int i = gt; i < NKEYS_S * 8; i += NGT) {
            const int pos = i >> 3, k = i & 7;
            const float ang = (float)pos * A->rinv[k];
            const float kq = rintf(ang * 0.15915494309189535f);
            float r = fmaf(-kq, 6.2831854820251465f, ang); r = fmaf(-kq, -1.7484555314695172e-7f, r);
            const float rev = r * 0.15915494309189535f;
            rope[pos * 16 + k] = __builtin_amdgcn_cosf(rev); rope[pos * 16 + 8 + k] = __builtin_amdgcn_sinf(rev);
        }
    }
    {
        bf16* XB = (bf16*)(F.ws + WS_XB); float* SS = (float*)(F.ctl + CW_SS);
        for (int m0 = gw; m0 < MT; m0 += 3 * NGW) {
            f32x4 v[3][4];
#pragma unroll
            for (int q = 0; q < 3; ++q) { const int m = m0 + q * NGW, mm = (m < MT) ? m : 0;
                const float* src = (mm < MP) ? GIN(A, 0) + (size_t)mm * 1024 : GIN(A, 1) + (size_t)(mm - MP) * 1024;
                const GAS f32x4* xr = (const GAS f32x4*)src + F.lane;
#pragma unroll
                for (int j = 0; j < 4; ++j) v[q][j] = xr[64 * j]; }
#pragma unroll
            for (int q = 0; q < 3; ++q) { const int m = m0 + q * NGW;
                if (m < MT) {
                    GAS unsigned long long* o8 = (GAS unsigned long long*)(XB + (size_t)m * 1024) + F.lane;
                    float s_ = 0.f;
#pragma unroll
                    for (int j = 0; j < 4; ++j) { const f32x4 w = v[q][j]; s_ += (w.x * w.x + w.y * w.y) + (w.z * w.z + w.w * w.w);
                        o8[64 * j] = (unsigned long long)pg8::cvt_pk_bf16(w.x, w.y) | ((unsigned long long)pg8::cvt_pk_bf16(w.z, w.w) << 32); }
                    s_ = wave_sum(s_);
                    if (F.lane == 0) SS[m] = s_;
                } }
        }
    }
    if (gw < DEPTH) {
        const int l = gw; const float* lp = GIN(A, 9) + (size_t)l * 256;
        const float s1 = wave_sum(lp[F.lane] * lp[64 + F.lane]), s2 = wave_sum(lp[128 + F.lane] * lp[192 + F.lane]);
        if (F.lane == 0) ((float*)(F.ctl + CW_LAM))[l] = expf(s1) - expf(s2) + (0.8f - 0.6f * expf(-0.3f * (float)l));
    }
}

constexpr int AQ_PROMPT = 256 * 8, AQ_TOTAL = AQ_PROMPT + 512;
__device__ __forceinline__ void ph_attn(Frame& F, CArgsP A, int l) {
    const attn_body::bf16* Q = (const attn_body::bf16*)(F.ws + B_Q); const attn_body::bf16* K = (const attn_body::bf16*)(F.ws + B_K); const attn_body::bf16* V = (const attn_body::bf16*)(F.ws + B_V);
    gu32* ctr = F.ctl + CW_AQ + 64 * l;
    for (;;) {
        __syncthreads();
        if (F.tid == 0) F.MISC[12] = __hip_atomic_fetch_add(ctr, 1u, RLX_AGENT);
        __syncthreads();
        const int idx = __builtin_amdgcn_readfirstlane((int)F.MISC[12]);
        if (idx >= AQ_TOTAL) break;
        if (idx < AQ_PROMPT) {
            const int qb = 7 - (idx >> 8), u = idx & 255, b = u >> 5, hv = u & 31, h = hv >> 2, c = (hv >> 1) & 1, vh = hv & 1;
            attn_body::bf16* O = (attn_body::bf16*)(F.ws + B_OC) + (size_t)c * MT * 1024;
            attn_body::attn_unit<8>(b, h * 128 + c * 64, h * 128 + vh * 64, qb, Q, K, V, O, (char*)F.lds + RING_OFF);
        } else {
            const int u = idx - AQ_PROMPT;
            attn_body::sample_unit(l, u >> 6, (u >> 3) & 7, u & 7, GIN(A, 2), GIN(A, 3), Q, K, V, (float*)(F.ws + WS_SP), (char*)F.lds + RING_OFF);
        }
        { int tv = threadIdx.x; asm volatile("" : "+v"(tv)); F.tid = tv; F.lane = tv & 63; F.wave = __builtin_amdgcn_readfirstlane(tv >> 6); }
    }
}

__device__ __forceinline__ void ph_linprep(Frame& F, CArgsP A, int l) {
    const int gw = F.vcu * NWAVES + F.wave, NGW = F.G * NWAVES;
    const bf16* URW = (const bf16*)(F.ws + B_URW); bf16* LIN = (bf16*)(F.ws + B_LIN);
    const float* mu = GIN(A, 12) + (size_t)l * P_RW + 3072 + 4 * F.lane;
    const float mu0 = mu[0], mu1 = mu[1], mu2 = mu[2], mu3 = mu[3];
    for (int row0 = gw; row0 < MT; row0 += 4 * NGW) {
        unsigned long long cw[4], pw[4];
#pragma unroll
        for (int q = 0; q < 4; ++q) { const int row = row0 + q * NGW; const bool ok = row < MT; const int rr = ok ? row : 0;
            const bool smp = rr >= MP; const int t = smp ? ((rr - MP) & 31) : (rr & 2047);
            cw[q] = *(const unsigned long long*)(URW + (size_t)rr * P_RW + 3072 + 4 * F.lane);
            pw[q] = *(const unsigned long long*)(URW + (size_t)(t > 0 ? rr - 1 : rr) * P_RW + 3072 + 4 * F.lane); }
#pragma unroll
        for (int q = 0; q < 4; ++q) { const int row = row0 + q * NGW;
            if (row < MT) {
                const bool smp = row >= MP; const int t = smp ? ((row - MP) & 31) : (row & 2047);
                float u[4] = {bflo((unsigned)cw[q]), bfhi((unsigned)cw[q]), bflo((unsigned)(cw[q] >> 32)), bfhi((unsigned)(cw[q] >> 32))};
                float p[4] = {bflo((unsigned)pw[q]), bfhi((unsigned)pw[q]), bflo((unsigned)(pw[q] >> 32)), bfhi((unsigned)(pw[q] >> 32))};
                if (t == 0) {
                    if (smp) { const float* s0 = GIN(A, 5) + ((size_t)(l * DEC_BATCH) + ((row - MP) >> 5)) * P_RW + 3072 + 4 * F.lane; p[0] = s0[0]; p[1] = s0[1]; p[2] = s0[2]; p[3] = s0[3]; }
                    else { p[0] = p[1] = p[2] = p[3] = 0.f; } }
                u[0] += (p[0] - u[0]) * mu0; u[1] += (p[1] - u[1]) * mu1; u[2] += (p[2] - u[2]) * mu2; u[3] += (p[3] - u[3]) * mu3;
                if (F.lane < 16) {
#pragma unroll
                    for (int j = 0; j < 4; ++j) u[j] = 1.f - 2.f * __builtin_amdgcn_rcpf(1.f + __builtin_amdgcn_exp2f(2.8853900817779268f * u[j])); }
                else if (F.lane >= 32) {
#pragma unroll
                    for (int j = 0; j < 4; ++j) u[j] = pg8::fast_sigmoid(u[j]); }
                *(unsigned long long*)(LIN + (size_t)row * 256 + 4 * F.lane) = (unsigned long long)pg8::cvt_pk_bf16(u[0], u[1]) | ((unsigned long long)pg8::cvt_pk_bf16(u[2], u[3]) << 32);
            }
        }
    }
}

__device__ __forceinline__ void ph_combine(Frame& F, CArgsP A, int l) {
    const int gw = F.vcu * NWAVES + F.wave, NGW = F.G * NWAVES;
    const float lam = ((const float*)(F.ctl + CW_LAM))[l], lam_init = 0.8f - 0.6f * expf(-0.3f * (float)l);
    const bf16* OC0 = (const bf16*)(F.ws + B_OC); const bf16* OC1 = OC0 + (size_t)MT * 1024;
    bf16* OA = (bf16*)(F.ws + B_OA);
    const float* subln = GIN(A, 10) + l * 128;
    const float g0 = subln[2 * F.lane], g1 = subln[2 * F.lane + 1];
    {
        const int gt = gw * 64 + F.lane, NGT = NGW * 64;
        const float sc = 1.f - lam_init;
        for (int i = gt; i < MP * 128; i += NGT) {
            const size_t off = (size_t)(i >> 4) * 128 + (i & 15) * 8;
            const v4u w0 = *(const v4u*)(OC0 + off), w1 = *(const v4u*)(OC1 + off);
            float a[8];
            a[0] = bflo(w0.x) - lam * bflo(w1.x); a[1] = bfhi(w0.x) - lam * bfhi(w1.x); a[2] = bflo(w0.y) - lam * bflo(w1.y); a[3] = bfhi(w0.y) - lam * bfhi(w1.y);
            a[4] = bflo(w0.z) - lam * bflo(w1.z); a[5] = bfhi(w0.z) - lam * bfhi(w1.z); a[6] = bflo(w0.w) - lam * bflo(w1.w); a[7] = bfhi(w0.w) - lam * bfhi(w1.w);
            float ss = (a[0] * a[0] + a[1] * a[1]) + (a[2] * a[2] + a[3] * a[3]) + (a[4] * a[4] + a[5] * a[5]) + (a[6] * a[6] + a[7] * a[7]);
            ss = reduce16(ss);
            const float r = __builtin_amdgcn_rsqf(ss * (1.0f / 128.f) + EPS) * sc;
            const f32x4 s0 = *(const f32x4*)(subln + (i & 15) * 8), s1 = *(const f32x4*)(subln + (i & 15) * 8 + 4);
            v4u o; o.x = pk2(a[0] * r * s0.x, a[1] * r * s0.y); o.y = pk2(a[2] * r * s0.z, a[3] * r * s0.w); o.z = pk2(a[4] * r * s1.x, a[5] * r * s1.y); o.w = pk2(a[6] * r * s1.z, a[7] * r * s1.w);
            *(v4u*)(OA + off) = o;
        }
    }
    for (int it = MP * 8 + gw; it < MT * 8; it += NGW) {
        const int row = it >> 3, h = it & 7;
        float a0, a1;
        {
            const int b = (row - MP) >> 5, qi = (row - MP) & 31;
            float oc[2][2];
#pragma unroll
            for (int c = 0; c < 2; ++c) {
                const float* sp = (const float*)(F.ws + WS_SP) + ((size_t)(((b * 8 + h) * 2 + c) * 8) * 32 + qi) * 132;
                float mx = -1e30f;
#pragma unroll
                for (int s = 0; s < 8; ++s) mx = fmaxf(mx, sp[(size_t)s * 32 * 132]);
                float L = 0.f, x0 = 0.f, x1 = 0.f;
#pragma unroll
                for (int s = 0; s < 8; ++s) { const float* p = sp + (size_t)s * 32 * 132; const float w = exp2f(p[0] - mx); L += w * p[1]; x0 += w * p[4 + 2 * F.lane]; x1 += w * p[4 + 2 * F.lane + 1]; }
                oc[c][0] = x0 / L; oc[c][1] = x1 / L;
            }
            a0 = oc[0][0] - lam * oc[1][0]; a1 = oc[0][1] - lam * oc[1][1];
        }
        const float ss = wave_sum(a0 * a0 + a1 * a1);
        const float r = __builtin_amdgcn_rsqf(ss * (1.0f / 128.f) + EPS) * (1.f - lam_init);
        *(unsigned*)(OA + (size_t)row * 1024 + h * 128 + 2 * F.lane) = pk2(a0 * r * g0, a1 * r * g1);
    }
}

constexpr int CK_L = 32;
constexpr int CK_LDF = 0;
constexpr int CK_AT = CK_LDF + 2048, CK_RT = CK_AT + 32 * 144, CK_BT = CK_RT + 32 * 144, CK_KT = CK_BT + 32 * 144;
constexpr int CK_TR = CK_KT + 32 * 144, CK_TR_SZ = 3 * 64 * 80;
constexpr int CK_BTT = 0, CK_KTT = 64 * 80, CK_VT = 2 * 64 * 80;
constexpr int CK_MM = CK_TR + 2 * CK_TR_SZ, CK_MM_SZ = 32 * 144 + 3 * 32 * 80;
constexpr int CK_MBA = 0, CK_MKA = 32 * 144, CK_MBR = CK_MKA + 32 * 80, CK_MKR = CK_MBR + 32 * 80;
constexpr int CK_RHS = CK_MM + 2 * CK_MM_SZ;
constexpr int CK_U = CK_RHS + 8192;
constexpr int CK_SB = CK_U + 64 * 80;
constexpr int CK_YB = CK_SB + 64 * 144;
constexpr int CK_EXPL = CK_YB + 8192;
constexpr int CK_SH = CK_EXPL + 512;
constexpr int CK_LOR = CK_SH + 768;
static_assert(CK_LOR + 3 * 4096 <= RING_BYTES, "scan LDS");
typedef float f32x16s __attribute__((ext_vector_type(16)));
typedef float f32x2 __attribute__((ext_vector_type(2)));

__device__ __forceinline__ void unpack4(unsigned long long w, float (&o)[4]) { o[0] = bflo((unsigned)w); o[1] = bfhi((unsigned)w); o[2] = bflo((unsigned)(w >> 32)); o[3] = bfhi((unsigned)(w >> 32)); }
__device__ __forceinline__ unsigned long long pack4bf(float a, float b, float c, float d) { return (unsigned long long)pg8::cvt_pk_bf16(a, b) | ((unsigned long long)pg8::cvt_pk_bf16(c, d) << 32); }
#define CK_FRAG(base, stride, R0, ks) (*(const LAS bf16x8*)(L + (base) + ((R0) + r32) * (stride) + (16 * (ks) + 8 * hh) * 2))
#define CK_FRAGT(base, R0, ks) (*(const LAS bf16x8*)(L + (base) + ((R0) + r32) * 80 + (((2 * (ks) + hh) ^ ((((R0) + r32) >> 3) & 3)) * 16)))
#define CK_MFMA(acc, a, b) acc = __builtin_amdgcn_mfma_f32_32x32x16_bf16(a, b, acc, 0, 0, 0)
#define CK_BAR() do { asm volatile("s_waitcnt lgkmcnt(0)" ::: "memory"); __builtin_amdgcn_s_barrier(); asm volatile("" ::: "memory"); } while (0)

__device__ __forceinline__ void scan_chunked(Frame& F, CArgsP A, int l, int item, const bf16* WLORA, const bf16* LINP) {
    const bool smp = item >= 128; const int bh = item & 127, b = bh >> 4, h = bh & 15;
    const int T = smp ? DEC_SEQ : SEQ, row0 = smp ? MP + b * DEC_SEQ : b * SEQ, nch = T / CK_L;
    const int w = F.wave;
    LAS unsigned char* L = F.lds + RING_OFF;
    { int tid = threadIdx.x; asm volatile("" : "+v"(tid)); if (tid < 192) { const int part = tid >> 6, ch_ = tid & 63; *(LAS float*)(L + CK_SH + tid * 4) = smp ? GIN(A, 5)[(size_t)(l * 8 + b) * P_RW + part * 1024 + h * 64 + ch_] : 0.f; } }
    __builtin_amdgcn_sched_barrier(0);
    if (w < 4) {
        const int kh = (w >> 1) & 1, ih = w & 1;
        f32x16s Sacc;
#pragma unroll
        for (int r = 0; r < 16; ++r) Sacc[r] = 0.f;
        {
            const int lane = F.lane, r32 = lane & 31, hh = lane >> 5;
            if (smp) {
                const float* s0 = GIN(A, 4) + (((size_t)(l * 8 + b) * 16 + h) * 64 + 32 * ih + r32) * 64 + 32 * kh + 4 * hh;
#pragma unroll
                for (int g = 0; g < 4; ++g) { const f32x4 v = *(const f32x4*)(s0 + 8 * g); Sacc[4 * g] = v.x; Sacc[4 * g + 1] = v.y; Sacc[4 * g + 2] = v.z; Sacc[4 * g + 3] = v.w; }
            }
#pragma unroll
            for (int g = 0; g < 4; ++g) *(LAS unsigned long long*)(L + CK_SB + (32 * ih + r32) * 144 + (32 * kh + 8 * g + 4 * hh) * 2) = pack4bf(Sacc[4 * g], Sacc[4 * g + 1], Sacc[4 * g + 2], Sacc[4 * g + 3]);
        }
        const int lor = w - 1, lkb = (lor == 2) ? 128 : 64 * lor;
        bf16x8 wfr[16], afr[8];
        auto lora_loadw = [&](const int lane) __attribute__((always_inline)) {
            if (w >= 1) { const int r32 = lane & 31, hh = lane >> 5;
                const bf16* wr_ = WLORA + (size_t)(lor * 1024 + h * 64 + r32) * 256 + lkb + 8 * hh;
#pragma unroll
                for (int ks = 0; ks < 4; ++ks) { wfr[ks] = *(const bf16x8*)(wr_ + 16 * ks); wfr[8 + ks] = *(const bf16x8*)(wr_ + 32 * 256 + 16 * ks); }
                if (lor == 2) {
#pragma unroll
                    for (int ks = 4; ks < 8; ++ks) { wfr[ks] = *(const bf16x8*)(wr_ + 16 * ks); wfr[8 + ks] = *(const bf16x8*)(wr_ + 32 * 256 + 16 * ks); } }
            }
        };
        auto lora_load = [&](const int chx, const int lane) __attribute__((always_inline)) {
            if (w >= 1 && chx < nch) { const int r32 = lane & 31, hh = lane >> 5;
                const bf16* ar_ = LINP + (size_t)(row0 + chx * CK_L + r32) * 256 + lkb + 8 * hh;
#pragma unroll
                for (int ks = 0; ks < 4; ++ks) afr[ks] = *(const bf16x8*)(ar_ + 16 * ks);
                if (lor == 2) {
#pragma unroll
                    for (int ks = 4; ks < 8; ++ks) afr[ks] = *(const bf16x8*)(ar_ + 16 * ks); }
            }
        };
        auto lora_compute = [&](const int chx, const int lane) __attribute__((always_inline)) {
            if (w >= 1 && chx < nch) { const int r32 = lane & 31, hh = lane >> 5;
#pragma unroll
                for (int cbk = 0; cbk < 2; ++cbk) {
                    f32x16s a_;
#pragma unroll
                    for (int q = 0; q < 16; ++q) a_[q] = 0.f;
#pragma unroll
                    for (int ks = 0; ks < 4; ++ks) CK_MFMA(a_, afr[ks], wfr[cbk * 8 + ks]);
                    if (lor == 2) {
#pragma unroll
                        for (int ks = 4; ks < 8; ++ks) CK_MFMA(a_, afr[ks], wfr[cbk * 8 + ks]); }
                    const int chn_ = l * 1024 + h * 64 + 32 * cbk + r32;
                    LAS unsigned short* op_ = (LAS unsigned short*)(L + CK_LOR + lor * 4096 + (4 * hh * 64 + 32 * cbk + r32) * 2);
                    if (lor == 0) { const float lb_ = GIN(A, 13)[chn_];
#pragma unroll
                        for (int q = 0; q < 16; ++q) op_[((q & 3) + 8 * (q >> 2)) * 64] = (unsigned short)f2bf(pg8::neg_decay_log(a_[q] + lb_)); }
                    else if (lor == 1) { const float lb_ = GIN(A, 15)[chn_];
#pragma unroll
                        for (int q = 0; q < 16; ++q) op_[((q & 3) + 8 * (q >> 2)) * 64] = (unsigned short)f2bf(pg8::fast_sigmoid(a_[q] + lb_)); }
                    else {
#pragma unroll
                        for (int q = 0; q < 16; ++q) op_[((q & 3) + 8 * (q >> 2)) * 64] = (unsigned short)f2bf(a_[q]); }
                }
            }
        };
        { int tl_ = threadIdx.x; asm volatile("" : "+v"(tl_)); tl_ &= 63; lora_load(0, tl_); lora_loadw(tl_); lora_compute(0, tl_); lora_load(1, tl_); }
        __syncthreads();
        CK_BAR();
        { int tl_ = threadIdx.x; asm volatile("" : "+v"(tl_)); tl_ &= 63; lora_loadw(tl_); lora_compute(1, tl_); }
        CK_BAR(); CK_BAR();
        for (int ch = 0; ch < nch; ++ch) {
            int tid_ = threadIdx.x; asm volatile("" : "+v"(tid_));
            const int lane = tid_ & 63, r32 = lane & 31, hh = lane >> 5;
            const int TR = CK_TR + (ch & 1) * CK_TR_SZ, MM = CK_MM + (ch & 1) * CK_MM_SZ;
            lora_load(ch + 2, lane);
            f32x16s acc;
#pragma unroll
            for (int q = 0; q < 16; ++q) acc[q] = 0.f;
            {
                const int abase = (w & 2) ? CK_RT : CK_AT;
#pragma unroll
                for (int ks = 0; ks < 4; ++ks) CK_MFMA(acc, CK_FRAG(abase, 144, 0, ks), CK_FRAG(CK_SB, 144, 32 * ih, ks));
            }
            CK_BAR();
            if (ch + 2 < nch) lora_loadw(lane);
            if (w < 2) {
#pragma unroll
                for (int ks = 0; ks < 2; ++ks) CK_MFMA(acc, CK_FRAG(MM + CK_MKA, 80, 0, ks), CK_FRAGT(TR + CK_VT, 32 * ih, ks));
#pragma unroll
                for (int q = 0; q < 16; ++q) *(LAS float*)(L + CK_RHS + (((q & 3) + 8 * (q >> 2) + 4 * hh) * 64 + 32 * ih + r32) * 4) = acc[q];
            }
            CK_BAR();
            lora_compute(ch + 2, lane);
            if (w == 0) {
                f32x2 xx[CK_L / 2];
#pragma unroll
                for (int j = 0; j < CK_L / 2; ++j) xx[j] = (f32x2){*(const LAS float*)(L + CK_RHS + ((2 * j) * 64 + lane) * 4), *(const LAS float*)(L + CK_RHS + ((2 * j + 1) * 64 + lane) * 4)};
                const LAS unsigned char* mb = L + MM + CK_MBA;
                f32x4 ring[15]; f32x2 x2;
                ring[0] = *(const LAS f32x4*)(mb + 0); ring[1] = *(const LAS f32x4*)(mb + 16); ring[2] = *(const LAS f32x4*)(mb + 32); ring[3] = *(const LAS f32x4*)(mb + 48); ring[4] = *(const LAS f32x4*)(mb + 64); ring[5] = *(const LAS f32x4*)(mb + 80); ring[6] = *(const LAS f32x4*)(mb + 96); ring[7] = *(const LAS f32x4*)(mb + 112); ring[8] = *(const LAS f32x4*)(mb + 144); ring[9] = *(const LAS f32x4*)(mb + 160); ring[10] = *(const LAS f32x4*)(mb + 176); ring[11] = *(const LAS f32x4*)(mb + 192); ring[12] = *(const LAS f32x4*)(mb + 208); ring[13] = *(const LAS f32x4*)(mb + 224); ring[14] = *(const LAS f32x4*)(mb + 240);
                __builtin_amdgcn_sched_barrier(0);
                x2 = (f32x2){xx[0][0], xx[0][0]}; xx[0] = __builtin_elementwise_fma(x2, (f32x2){ring[0].x, ring[0].y}, xx[0]); xx[1] = __builtin_elementwise_fma(x2, (f32x2){ring[0].z, ring[0].w}, xx[1]); ring[0] = *(const LAS f32x4*)(mb + 256); __builtin_amdgcn_sched_barrier(0);
                xx[2] = __builtin_elementwise_fma(x2, (f32x2){ring[1].x, ring[1].y}, xx[2]); xx[3] = __builtin_elementwise_fma(x2, (f32x2){ring[1].z, ring[1].w}, xx[3]); ring[1] = *(const LAS f32x4*)(mb + 288); __builtin_amdgcn_sched_barrier(0);
                xx[4] = __builtin_elementwise_fma(x2, (f32x2){ring[2].x, ring[2].y}, xx[4]); xx[5] = __builtin_elementwise_fma(x2, (f32x2){ring[2].z, ring[2].w}, xx[5]); ring[2] = *(const LAS f32x4*)(mb + 304); __builtin_amdgcn_sched_barrier(0);
                xx[6] = __builtin_elementwise_fma(x2, (f32x2){ring[3].x, ring[3].y}, xx[6]); xx[7] = __builtin_elementwise_fma(x2, (f32x2){ring[3].z, ring[3].w}, xx[7]); ring[3] = *(const LAS f32x4*)(mb + 320); __builtin_amdgcn_sched_barrier(0);
                xx[8] = __builtin_elementwise_fma(x2, (f32x2){ring[4].x, ring[4].y}, xx[8]); xx[9] = __builtin_elementwise_fma(x2, (f32x2){ring[4].z, ring[4].w}, xx[9]); ring[4] = *(const LAS f32x4*)(mb + 336); __builtin_amdgcn_sched_barrier(0);
                xx[10] = __builtin_elementwise_fma(x2, (f32x2){ring[5].x, ring[5].y}, xx[10]); xx[11] = __builtin_elementwise_fma(x2, (f32x2){ring[5].z, ring[5].w}, xx[11]); ring[5] = *(const LAS f32x4*)(mb + 352); __builtin_amdgcn_sched_barrier(0);
                xx[12] = __builtin_elementwise_fma(x2, (f32x2){ring[6].x, ring[6].y}, xx[12]); xx[13] = __builtin_elementwise_fma(x2, (f32x2){ring[6].z, ring[6].w}, xx[13]); ring[6] = *(const LAS f32x4*)(mb + 368); __builtin_amdgcn_sched_barrier(0);
                xx[14] = __builtin_elementwise_fma(x2, (f32x2){ring[7].x, ring[7].y}, xx[14]); xx[15] = __builtin_elementwise_fma(x2, (f32x2){ring[7].z, ring[7].w}, xx[15]); ring[7] = *(const LAS f32x4*)(mb + 384); __builtin_amdgcn_sched_barrier(0);
                x2 = (f32x2){xx[0][1], xx[0][1]}; xx[0] = __builtin_elementwise_fma(x2, (f32x2){ring[8].x, ring[8].y}, xx[0]); xx[1] = __builtin_elementwise_fma(x2, (f32x2){ring[8].z, ring[8].w}, xx[1]); ring[8] = *(const LAS f32x4*)(mb + 400); __builtin_amdgcn_sched_barrier(0);
                xx[2] = __builtin_elementwise_fma(x2, (f32x2){ring[9].x, ring[9].y}, xx[2]); xx[3] = __builtin_elementwise_fma(x2, (f32x2){ring[9].z, ring[9].w}, xx[3]); ring[9] = *(const LAS f32x4*)(mb + 448); __builtin_amdgcn_sched_barrier(0);
                xx[4] = __builtin_elementwise_fma(x2, (f32x2){ring[10].x, ring[10].y}, xx[4]); xx[5] = __builtin_elementwise_fma(x2, (f32x2){ring[10].z, ring[10].w}, xx[5]); ring[10] = *(const LAS f32x4*)(mb + 464); __builtin_amdgcn_sched_barrier(0);
                xx[6] = __builtin_elementwise_fma(x2, (f32x2){ring[11].x, ring[11].y}, xx[6]); xx[7] = __builtin_elementwise_fma(x2, (f32x2){ring[11].z, ring[11].w}, xx[7]); ring[11] = *(const LAS f32x4*)(mb + 480); __builtin_amdgcn_sched_barrier(0);
                xx[8] = __builtin_elementwise_fma(x2, (f32x2){ring[12].x, ring[12].y}, xx[8]); xx[9] = __builtin_elementwise_fma(x2, (f32x2){ring[12].z, ring[12].w}, xx[9]); ring[12] = *(const LAS f32x4*)(mb + 496); __builtin_amdgcn_sched_barrier(0);
                xx[10] = __builtin_elementwise_fma(x2, (f32x2){ring[13].x, ring[13].y}, xx[10]); xx[11] = __builtin_elementwise_fma(x2, (f32x2){ring[13].z, ring[13].w}, xx[11]); ring[13] = *(const LAS f32x4*)(mb + 512); __builtin_amdgcn_sched_barrier(0);
                xx[12] = __builtin_elementwise_fma(x2, (f32x2){ring[14].x, ring[14].y}, xx[12]); xx[13] = __builtin_elementwise_fma(x2, (f32x2){ring[14].z, ring[14].w}, xx[13]); ring[14] = *(const LAS f32x4*)(mb + 528); __builtin_amdgcn_sched_barrier(0);
                xx[14] = __builtin_elementwise_fma(x2, (f32x2){ring[0].x, ring[0].y}, xx[14]); xx[15] = __builtin_elementwise_fma(x2, (f32x2){ring[0].z, ring[0].w}, xx[15]); ring[0] = *(const LAS f32x4*)(mb + 544); __builtin_amdgcn_sched_barrier(0);
                x2 = (f32x2){xx[1][0], xx[1][0]}; xx[0] = __builtin_elementwise_fma(x2, (f32x2){ring[1].x, ring[1].y}, xx[0]); xx[1] = __builtin_elementwise_fma(x2, (f32x2){ring[1].z, ring[1].w}, xx[1]); ring[1] = *(const LAS f32x4*)(mb + 592); __builtin_amdgcn_sched_barrier(0);
                xx[2] = __builtin_elementwise_fma(x2, (f32x2){ring[2].x, ring[2].y}, xx[2]); xx[3] = __builtin_elementwise_fma(x2, (f32x2){ring[2].z, ring[2].w}, xx[3]); ring[2] = *(const LAS f32x4*)(mb + 608); __builtin_amdgcn_sched_barrier(0);
                xx[4] = __builtin_elementwise_fma(x2, (f32x2){ring[3].x, ring[3].y}, xx[4]); xx[5] = __builtin_elementwise_fma(x2, (f32x2){ring[3].z, ring[3].w}, xx[5]); ring[3] = *(const LAS f32x4*)(mb + 624); __builtin_amdgcn_sched_barrier(0);
                xx[6] = __builtin_elementwise_fma(x2, (f32x2){ring[4].x, ring[4].y}, xx[6]); xx[7] = __builtin_elementwise_fma(x2, (f32x2){ring[4].z, ring[4].w}, xx[7]); ring[4] = *(const LAS f32x4*)(mb + 640); __builtin_amdgcn_sched_barrier(0);
                xx[8] = __builtin_elementwise_fma(x2, (f32x2){ring[5].x, ring[5].y}, xx[8]); xx[9] = __builtin_elementwise_fma(x2, (f32x2){ring[5].z, ring[5].w}, xx[9]); ring[5] = *(const LAS f32x4*)(mb + 656); __builtin_amdgcn_sched_barrier(0);
                xx[10] = __builtin_elementwise_fma(x2, (f32x2){ring[6].x, ring[6].y}, xx[10]); xx[11] = __builtin_elementwise_fma(x2, (f32x2){ring[6].z, ring[6].w}, xx[11]); ring[6] = *(const LAS f32x4*)(mb + 672); __builtin_amdgcn_sched_barrier(0);
                xx[12] = __builtin_elementwise_fma(x2, (f32x2){ring[7].x, ring[7].y}, xx[12]); xx[13] = __builtin_elementwise_fma(x2, (f32x2){ring[7].z, ring[7].w}, xx[13]); ring[7] = *(const LAS f32x4*)(mb + 688); __builtin_amdgcn_sched_barrier(0);
                xx[14] = __builtin_elementwise_fma(x2, (f32x2){ring[8].x, ring[8].y}, xx[14]); xx[15] = __builtin_elementwise_fma(x2, (f32x2){ring[8].z, ring[8].w}, xx[15]); ring[8] = *(const LAS f32x4*)(mb + 736); __builtin_amdgcn_sched_barrier(0);
                x2 = (f32x2){xx[1][1], xx[1][1]}; xx[2] = __builtin_elementwise_fma(x2, (f32x2){ring[9].x, ring[9].y}, xx[2]); xx[3] = __builtin_elementwise_fma(x2, (f32x2){ring[9].z, ring[9].w}, xx[3]); ring[9] = *(const LAS f32x4*)(mb + 752); __builtin_amdgcn_sched_barrier(0);
                xx[4] = __builtin_elementwise_fma(x2, (f32x2){ring[10].x, ring[10].y}, xx[4]); xx[5] = __builtin_elementwise_fma(x2, (f32x2){ring[10].z, ring[10].w}, xx[5]); ring[10] = *(const LAS f32x4*)(mb + 768); __builtin_amdgcn_sched_barrier(0);
                xx[6] = __builtin_elementwise_fma(x2, (f32x2){ring[11].x, ring[11].y}, xx[6]); xx[7] = __builtin_elementwise_fma(x2, (f32x2){ring[11].z, ring[11].w}, xx[7]); ring[11] = *(const LAS f32x4*)(mb + 784); __builtin_amdgcn_sched_barrier(0);
                xx[8] = __builtin_elementwise_fma(x2, (f32x2){ring[12].x, ring[12].y}, xx[8]); xx[9] = __builtin_elementwise_fma(x2, (f32x2){ring[12].z, ring[12].w}, xx[9]); ring[12] = *(const LAS f32x4*)(mb + 800); __builtin_amdgcn_sched_barrier(0);
                xx[10] = __builtin_elementwise_fma(x2, (f32x2){ring[13].x, ring[13].y}, xx[10]); xx[11] = __builtin_elementwise_fma(x2, (f32x2){ring[13].z, ring[13].w}, xx[11]); ring[13] = *(const LAS f32x4*)(mb + 816); __builtin_amdgcn_sched_barrier(0);
                xx[12] = __builtin_elementwise_fma(x2, (f32x2){ring[14].x, ring[14].y}, xx[12]); xx[13] = __builtin_elementwise_fma(x2, (f32x2){ring[14].z, ring[14].w}, xx[13]); ring[14] = *(const LAS f32x4*)(mb + 832); __builtin_amdgcn_sched_barrier(0);
                xx[14] = __builtin_elementwise_fma(x2, (f32x2){ring[0].x, ring[0].y}, xx[14]); xx[15] = __builtin_elementwise_fma(x2, (f32x2){ring[0].z, ring[0].w}, xx[15]); ring[0] = *(const LAS f32x4*)(mb + 880); __builtin_amdgcn_sched_barrier(0);
                x2 = (f32x2){xx[2][0], xx[2][0]}; xx[2] = __builtin_elementwise_fma(x2, (f32x2){ring[1].x, ring[1].y}, xx[2]); xx[3] = __builtin_elementwise_fma(x2, (f32x2){ring[1].z, ring[1].w}, xx[3]); ring[1] = *(const LAS f32x4*)(mb + 896); __builtin_amdgcn_sched_barrier(0);
                xx[4] = __builtin_elementwise_fma(x2, (f32x2){ring[2].x, ring[2].y}, xx[4]); xx[5] = __builtin_elementwise_fma(x2, (f32x2){ring[2].z, ring[2].w}, xx[5]); ring[2] = *(const LAS f32x4*)(mb + 912); __builtin_amdgcn_sched_barrier(0);
                xx[6] = __builtin_elementwise_fma(x2, (f32x2){ring[3].x, ring[3].y}, xx[6]); xx[7] = __builtin_elementwise_fma(x2, (f32x2){ring[3].z, ring[3].w}, xx[7]); ring[3] = *(const LAS f32x4*)(mb + 928); __builtin_amdgcn_sched_barrier(0);
                xx[8] = __builtin_elementwise_fma(x2, (f32x2){ring[4].x, ring[4].y}, xx[8]); xx[9] = __builtin_elementwise_fma(x2, (f32x2){ring[4].z, ring[4].w}, xx[9]); ring[4] = *(const LAS f32x4*)(mb + 944); __builtin_amdgcn_sched_barrier(0);
                xx[10] = __builtin_elementwise_fma(x2, (f32x2){ring[5].x, ring[5].y}, xx[10]); xx[11] = __builtin_elementwise_fma(x2, (f32x2){ring[5].z, ring[5].w}, xx[11]); ring[5] = *(const LAS f32x4*)(mb + 960); __builtin_amdgcn_sched_barrier(0);
                xx[12] = __builtin_elementwise_fma(x2, (f32x2){ring[6].x, ring[6].y}, xx[12]); xx[13] = __builtin_elementwise_fma(x2, (f32x2){ring[6].z, ring[6].w}, xx[13]); ring[6] = *(const LAS f32x4*)(mb + 976); __builtin_amdgcn_sched_barrier(0);
                xx[14] = __builtin_elementwise_fma(x2, (f32x2){ring[7].x, ring[7].y}, xx[14]); xx[15] = __builtin_elementwise_fma(x2, (f32x2){ring[7].z, ring[7].w}, xx[15]); ring[7] = *(const LAS f32x4*)(mb + 1040); __builtin_amdgcn_sched_barrier(0);
                x2 = (f32x2){xx[2][1], xx[2][1]}; xx[2] = __builtin_elementwise_fma(x2, (f32x2){ring[8].x, ring[8].y}, xx[2]); xx[3] = __builtin_elementwise_fma(x2, (f32x2){ring[8].z, ring[8].w}, xx[3]); ring[8] = *(const LAS f32x4*)(mb + 1056); __builtin_amdgcn_sched_barrier(0);
                xx[4] = __builtin_elementwise_fma(x2, (f32x2){ring[9].x, ring[9].y}, xx[4]); xx[5] = __builtin_elementwise_fma(x2, (f32x2){ring[9].z, ring[9].w}, xx[5]); ring[9] = *(const LAS f32x4*)(mb + 1072); __builtin_amdgcn_sched_barrier(0);
                xx[6] = __builtin_elementwise_fma(x2, (f32x2){ring[10].x, ring[10].y}, xx[6]); xx[7] = __builtin_elementwise_fma(x2, (f32x2){ring[10].z, ring[10].w}, xx[7]); ring[10] = *(const LAS f32x4*)(mb + 1088); __builtin_amdgcn_sched_barrier(0);
                xx[8] = __builtin_elementwise_fma(x2, (f32x2){ring[11].x, ring[11].y}, xx[8]); xx[9] = __builtin_elementwise_fma(x2, (f32x2){ring[11].z, ring[11].w}, xx[9]); ring[11] = *(const LAS f32x4*)(mb + 1104); __builtin_amdgcn_sched_barrier(0);
                xx[10] = __builtin_elementwise_fma(x2, (f32x2){ring[12].x, ring[12].y}, xx[10]); xx[11] = __builtin_elementwise_fma(x2, (f32x2){ring[12].z, ring[12].w}, xx[11]); ring[12] = *(const LAS f32x4*)(mb + 1120); __builtin_amdgcn_sched_barrier(0);
                xx[12] = __builtin_elementwise_fma(x2, (f32x2){ring[13].x, ring[13].y}, xx[12]); xx[13] = __builtin_elementwise_fma(x2, (f32x2){ring[13].z, ring[13].w}, xx[13]); ring[13] = *(const LAS f32x4*)(mb + 1184); __builtin_amdgcn_sched_barrier(0);
                xx[14] = __builtin_elementwise_fma(x2, (f32x2){ring[14].x, ring[14].y}, xx[14]); xx[15] = __builtin_elementwise_fma(x2, (f32x2){ring[14].z, ring[14].w}, xx[15]); ring[14] = *(const LAS f32x4*)(mb + 1200); __builtin_amdgcn_sched_barrier(0);
                x2 = (f32x2){xx[3][0], xx[3][0]}; xx[2] = __builtin_elementwise_fma(x2, (f32x2){ring[0].x, ring[0].y}, xx[2]); xx[3] = __builtin_elementwise_fma(x2, (f32x2){ring[0].z, ring[0].w}, xx[3]); ring[0] = *(const LAS f32x4*)(mb + 1216); __builtin_amdgcn_sched_barrier(0);
                xx[4] = __builtin_elementwise_fma(x2, (f32x2){ring[1].x, ring[1].y}, xx[4]); xx[5] = __builtin_elementwise_fma(x2, (f32x2){ring[1].z, ring[1].w}, xx[5]); ring[1] = *(const LAS f32x4*)(mb + 1232); __builtin_amdgcn_sched_barrier(0);
                xx[6] = __builtin_elementwise_fma(x2, (f32x2){ring[2].x, ring[2].y}, xx[6]); xx[7] = __builtin_elementwise_fma(x2, (f32x2){ring[2].z, ring[2].w}, xx[7]); ring[2] = *(const LAS f32x4*)(mb + 1248); __builtin_amdgcn_sched_barrier(0);
                xx[8] = __builtin_elementwise_fma(x2, (f32x2){ring[3].x, ring[3].y}, xx[8]); xx[9] = __builtin_elementwise_fma(x2, (f32x2){ring[3].z, ring[3].w}, xx[9]); ring[3] = *(const LAS f32x4*)(mb + 1264); __builtin_amdgcn_sched_barrier(0);
                xx[10] = __builtin_elementwise_fma(x2, (f32x2){ring[4].x, ring[4].y}, xx[10]); xx[11] = __builtin_elementwise_fma(x2, (f32x2){ring[4].z, ring[4].w}, xx[11]); ring[4] = *(const LAS f32x4*)(mb + 1328); __builtin_amdgcn_sched_barrier(0);
                xx[12] = __builtin_elementwise_fma(x2, (f32x2){ring[5].x, ring[5].y}, xx[12]); xx[13] = __builtin_elementwise_fma(x2, (f32x2){ring[5].z, ring[5].w}, xx[13]); ring[5] = *(const LAS f32x4*)(mb + 1344); __builtin_amdgcn_sched_barrier(0);
                xx[14] = __builtin_elementwise_fma(x2, (f32x2){ring[6].x, ring[6].y}, xx[14]); xx[15] = __builtin_elementwise_fma(x2, (f32x2){ring[6].z, ring[6].w}, xx[15]); ring[6] = *(const LAS f32x4*)(mb + 1360); __builtin_amdgcn_sched_barrier(0);
                x2 = (f32x2){xx[3][1], xx[3][1]}; xx[4] = __builtin_elementwise_fma(x2, (f32x2){ring[7].x, ring[7].y}, xx[4]); xx[5] = __builtin_elementwise_fma(x2, (f32x2){ring[7].z, ring[7].w}, xx[5]); ring[7] = *(const LAS f32x4*)(mb + 1376); __builtin_amdgcn_sched_barrier(0);
                xx[6] = __builtin_elementwise_fma(x2, (f32x2){ring[8].x, ring[8].y}, xx[6]); xx[7] = __builtin_elementwise_fma(x2, (f32x2){ring[8].z, ring[8].w}, xx[7]); ring[8] = *(const LAS f32x4*)(mb + 1392); __builtin_amdgcn_sched_barrier(0);
                xx[8] = __builtin_elementwise_fma(x2, (f32x2){ring[9].x, ring[9].y}, xx[8]); xx[9] = __builtin_elementwise_fma(x2, (f32x2){ring[9].z, ring[9].w}, xx[9]); ring[9] = *(const LAS f32x4*)(mb + 1408); __builtin_amdgcn_sched_barrier(0);
                xx[10] = __builtin_elementwise_fma(x2, (f32x2){ring[10].x, ring[10].y}, xx[10]); xx[11] = __builtin_elementwise_fma(x2, (f32x2){ring[10].z, ring[10].w}, xx[11]); ring[10] = *(const LAS f32x4*)(mb + 1472); __builtin_amdgcn_sched_barrier(0);
                xx[12] = __builtin_elementwise_fma(x2, (f32x2){ring[11].x, ring[11].y}, xx[12]); xx[13] = __builtin_elementwise_fma(x2, (f32x2){ring[11].z, ring[11].w}, xx[13]); ring[11] = *(const LAS f32x4*)(mb + 1488); __builtin_amdgcn_sched_barrier(0);
                xx[14] = __builtin_elementwise_fma(x2, (f32x2){ring[12].x, ring[12].y}, xx[14]); xx[15] = __builtin_elementwise_fma(x2, (f32x2){ring[12].z, ring[12].w}, xx[15]); ring[12] = *(const LAS f32x4*)(mb + 1504); __builtin_amdgcn_sched_barrier(0);
                x2 = (f32x2){xx[4][0], xx[4][0]}; xx[4] = __builtin_elementwise_fma(x2, (f32x2){ring[13].x, ring[13].y}, xx[4]); xx[5] = __builtin_elementwise_fma(x2, (f32x2){ring[13].z, ring[13].w}, xx[5]); ring[13] = *(const LAS f32x4*)(mb + 1520); __builtin_amdgcn_sched_barrier(0);
                xx[6] = __builtin_elementwise_fma(x2, (f32x2){ring[14].x, ring[14].y}, xx[6]); xx[7] = __builtin_elementwise_fma(x2, (f32x2){ring[14].z, ring[14].w}, xx[7]); ring[14] = *(const LAS f32x4*)(mb + 1536); __builtin_amdgcn_sched_barrier(0);
                xx[8] = __builtin_elementwise_fma(x2, (f32x2){ring[0].x, ring[0].y}, xx[8]); xx[9] = __builtin_elementwise_fma(x2, (f32x2){ring[0].z, ring[0].w}, xx[9]); ring[0] = *(const LAS f32x4*)(mb + 1552); __builtin_amdgcn_sched_barrier(0);
                xx[10] = __builtin_elementwise_fma(x2, (f32x2){ring[1].x, ring[1].y}, xx[10]); xx[11] = __builtin_elementwise_fma(x2, (f32x2){ring[1].z, ring[1].w}, xx[11]); ring[1] = *(const LAS f32x4*)(mb + 1632); __builtin_amdgcn_sched_barrier(0);
                xx[12] = __builtin_elementwise_fma(x2, (f32x2){ring[2].x, ring[2].y}, xx[12]); xx[13] = __builtin_elementwise_fma(x2, (f32x2){ring[2].z, ring[2].w}, xx[13]); ring[2] = *(const LAS f32x4*)(mb + 1648); __builtin_amdgcn_sched_barrier(0);
                xx[14] = __builtin_elementwise_fma(x2, (f32x2){ring[3].x, ring[3].y}, xx[14]); xx[15] = __builtin_elementwise_fma(x2, (f32x2){ring[3].z, ring[3].w}, xx[15]); ring[3] = *(const LAS f32x4*)(mb + 1664); __builtin_amdgcn_sched_barrier(0);
                x2 = (f32x2){xx[4][1], xx[4][1]}; xx[4] = __builtin_elementwise_fma(x2, (f32x2){ring[4].x, ring[4].y}, xx[4]); xx[5] = __builtin_elementwise_fma(x2, (f32x2){ring[4].z, ring[4].w}, xx[5]); ring[4] = *(const LAS f32x4*)(mb + 1680); __builtin_amdgcn_sched_barrier(0);
                xx[6] = __builtin_elementwise_fma(x2, (f32x2){ring[5].x, ring[5].y}, xx[6]); xx[7] = __builtin_elementwise_fma(x2, (f32x2){ring[5].z, ring[5].w}, xx[7]); ring[5] = *(const LAS f32x4*)(mb + 1696); __builtin_amdgcn_sched_barrier(0);
                xx[8] = __builtin_elementwise_fma(x2, (f32x2){ring[6].x, ring[6].y}, xx[8]); xx[9] = __builtin_elementwise_fma(x2, (f32x2){ring[6].z, ring[6].w}, xx[9]); ring[6] = *(const LAS f32x4*)(mb + 1776); __builtin_amdgcn_sched_barrier(0);
                xx[10] = __builtin_elementwise_fma(x2, (f32x2){ring[7].x, ring[7].y}, xx[10]); xx[11] = __builtin_elementwise_fma(x2, (f32x2){ring[7].z, ring[7].w}, xx[11]); ring[7] = *(const LAS f32x4*)(mb + 1792); __builtin_amdgcn_sched_barrier(0);
                xx[12] = __builtin_elementwise_fma(x2, (f32x2){ring[8].x, ring[8].y}, xx[12]); xx[13] = __builtin_elementwise_fma(x2, (f32x2){ring[8].z, ring[8].w}, xx[13]); ring[8] = *(const LAS f32x4*)(mb + 1808); __builtin_amdgcn_sched_barrier(0);
                xx[14] = __builtin_elementwise_fma(x2, (f32x2){ring[9].x, ring[9].y}, xx[14]); xx[15] = __builtin_elementwise_fma(x2, (f32x2){ring[9].z, ring[9].w}, xx[15]); ring[9] = *(const LAS f32x4*)(mb + 1824); __builtin_amdgcn_sched_barrier(0);
                x2 = (f32x2){xx[5][0], xx[5][0]}; xx[4] = __builtin_elementwise_fma(x2, (f32x2){ring[10].x, ring[10].y}, xx[4]); xx[5] = __builtin_elementwise_fma(x2, (f32x2){ring[10].z, ring[10].w}, xx[5]); ring[10] = *(const LAS f32x4*)(mb + 1840); __builtin_amdgcn_sched_barrier(0);
                xx[6] = __builtin_elementwise_fma(x2, (f32x2){ring[11].x, ring[11].y}, xx[6]); xx[7] = __builtin_elementwise_fma(x2, (f32x2){ring[11].z, ring[11].w}, xx[7]); ring[11] = *(const LAS f32x4*)(mb + 1920); __builtin_amdgcn_sched_barrier(0);
                xx[8] = __builtin_elementwise_fma(x2, (f32x2){ring[12].x, ring[12].y}, xx[8]); xx[9] = __builtin_elementwise_fma(x2, (f32x2){ring[12].z, ring[12].w}, xx[9]); ring[12] = *(const LAS f32x4*)(mb + 1936); __builtin_amdgcn_sched_barrier(0);
                xx[10] = __builtin_elementwise_fma(x2, (f32x2){ring[13].x, ring[13].y}, xx[10]); xx[11] = __builtin_elementwise_fma(x2, (f32x2){ring[13].z, ring[13].w}, xx[11]); ring[13] = *(const LAS f32x4*)(mb + 1952); __builtin_amdgcn_sched_barrier(0);
                xx[12] = __builtin_elementwise_fma(x2, (f32x2){ring[14].x, ring[14].y}, xx[12]); xx[13] = __builtin_elementwise_fma(x2, (f32x2){ring[14].z, ring[14].w}, xx[13]); ring[14] = *(const LAS f32x4*)(mb + 1968); __builtin_amdgcn_sched_barrier(0);
                xx[14] = __builtin_elementwise_fma(x2, (f32x2){ring[0].x, ring[0].y}, xx[14]); xx[15] = __builtin_elementwise_fma(x2, (f32x2){ring[0].z, ring[0].w}, xx[15]); ring[0] = *(const LAS f32x4*)(mb + 1984); __builtin_amdgcn_sched_barrier(0);
                x2 = (f32x2){xx[5][1], xx[5][1]}; xx[6] = __builtin_elementwise_fma(x2, (f32x2){ring[1].x, ring[1].y}, xx[6]); xx[7] = __builtin_elementwise_fma(x2, (f32x2){ring[1].z, ring[1].w}, xx[7]); ring[1] = *(const LAS f32x4*)(mb + 2064); __builtin_amdgcn_sched_barrier(0);
                xx[8] = __builtin_elementwise_fma(x2, (f32x2){ring[2].x, ring[2].y}, xx[8]); xx[9] = __builtin_elementwise_fma(x2, (f32x2){ring[2].z, ring[2].w}, xx[9]); ring[2] = *(const LAS f32x4*)(mb + 2080); __builtin_amdgcn_sched_barrier(0);
                xx[10] = __builtin_elementwise_fma(x2, (f32x2){ring[3].x, ring[3].y}, xx[10]); xx[11] = __builtin_elementwise_fma(x2, (f32x2){ring[3].z, ring[3].w}, xx[11]); ring[3] = *(const LAS f32x4*)(mb + 2096); __builtin_amdgcn_sched_barrier(0);
                xx[12] = __builtin_elementwise_fma(x2, (f32x2){ring[4].x, ring[4].y}, xx[12]); xx[13] = __builtin_elementwise_fma(x2, (f32x2){ring[4].z, ring[4].w}, xx[13]); ring[4] = *(const LAS f32x4*)(mb + 2112); __builtin_amdgcn_sched_barrier(0);
                xx[14] = __builtin_elementwise_fma(x2, (f32x2){ring[5].x, ring[5].y}, xx[14]); xx[15] = __builtin_elementwise_fma(x2, (f32x2){ring[5].z, ring[5].w}, xx[15]); ring[5] = *(const LAS f32x4*)(mb + 2128); __builtin_amdgcn_sched_barrier(0);
                x2 = (f32x2){xx[6][0], xx[6][0]}; xx[6] = __builtin_elementwise_fma(x2, (f32x2){ring[6].x, ring[6].y}, xx[6]); xx[7] = __builtin_elementwise_fma(x2, (f32x2){ring[6].z, ring[6].w}, xx[7]); ring[6] = *(const LAS f32x4*)(mb + 2224); __builtin_amdgcn_sched_barrier(0);
                xx[8] = __builtin_elementwise_fma(x2, (f32x2){ring[7].x, ring[7].y}, xx[8]); xx[9] = __builtin_elementwise_fma(x2, (f32x2){ring[7].z, ring[7].w}, xx[9]); ring[7] = *(const LAS f32x4*)(mb + 2240); __builtin_amdgcn_sched_barrier(0);
                xx[10] = __builtin_elementwise_fma(x2, (f32x2){ring[8].x, ring[8].y}, xx[10]); xx[11] = __builtin_elementwise_fma(x2, (f32x2){ring[8].z, ring[8].w}, xx[11]); ring[8] = *(const LAS f32x4*)(mb + 2256); __builtin_amdgcn_sched_barrier(0);
                xx[12] = __builtin_elementwise_fma(x2, (f32x2){ring[9].x, ring[9].y}, xx[12]); xx[13] = __builtin_elementwise_fma(x2, (f32x2){ring[9].z, ring[9].w}, xx[13]); ring[9] = *(const LAS f32x4*)(mb + 2272); __builtin_amdgcn_sched_barrier(0);
                xx[14] = __builtin_elementwise_fma(x2, (f32x2){ring[10].x, ring[10].y}, xx[14]); xx[15] = __builtin_elementwise_fma(x2, (f32x2){ring[10].z, ring[10].w}, xx[15]); ring[10] = *(const LAS f32x4*)(mb + 2368); __builtin_amdgcn_sched_barrier(0);
                x2 = (f32x2){xx[6][1], xx[6][1]}; xx[6] = __builtin_elementwise_fma(x2, (f32x2){ring[11].x, ring[11].y}, xx[6]); xx[7] = __builtin_elementwise_fma(x2, (f32x2){ring[11].z, ring[11].w}, xx[7]); ring[11] = *(const LAS f32x4*)(mb + 2384); __builtin_amdgcn_sched_barrier(0);
                xx[8] = __builtin_elementwise_fma(x2, (f32x2){ring[12].x, ring[12].y}, xx[8]); xx[9] = __builtin_elementwise_fma(x2, (f32x2){ring[12].z, ring[12].w}, xx[9]); ring[12] = *(const LAS f32x4*)(mb + 2400); __builtin_amdgcn_sched_barrier(0);
                xx[10] = __builtin_elementwise_fma(x2, (f32x2){ring[13].x, ring[13].y}, xx[10]); xx[11] = __builtin_elementwise_fma(x2, (f32x2){ring[13].z, ring[13].w}, xx[11]); ring[13] = *(const LAS f32x4*)(mb + 2416); __builtin_amdgcn_sched_barrier(0);
                xx[12] = __builtin_elementwise_fma(x2, (f32x2){ring[14].x, ring[14].y}, xx[12]); xx[13] = __builtin_elementwise_fma(x2, (f32x2){ring[14].z, ring[14].w}, xx[13]); ring[14] = *(const LAS f32x4*)(mb + 2512); __builtin_amdgcn_sched_barrier(0);
                xx[14] = __builtin_elementwise_fma(x2, (f32x2){ring[0].x, ring[0].y}, xx[14]); xx[15] = __builtin_elementwise_fma(x2, (f32x2){ring[0].z, ring[0].w}, xx[15]); ring[0] = *(const LAS f32x4*)(mb + 2528); __builtin_amdgcn_sched_barrier(0);
                x2 = (f32x2){xx[7][0], xx[7][0]}; xx[6] = __builtin_elementwise_fma(x2, (f32x2){ring[1].x, ring[1].y}, xx[6]); xx[7] = __builtin_elementwise_fma(x2, (f32x2){ring[1].z, ring[1].w}, xx[7]); ring[1] = *(const LAS f32x4*)(mb + 2544); __builtin_amdgcn_sched_barrier(0);
                xx[8] = __builtin_elementwise_fma(x2, (f32x2){ring[2].x, ring[2].y}, xx[8]); xx[9] = __builtin_elementwise_fma(x2, (f32x2){ring[2].z, ring[2].w}, xx[9]); ring[2] = *(const LAS f32x4*)(mb + 2560); __builtin_amdgcn_sched_barrier(0);
                xx[10] = __builtin_elementwise_fma(x2, (f32x2){ring[3].x, ring[3].y}, xx[10]); xx[11] = __builtin_elementwise_fma(x2, (f32x2){ring[3].z, ring[3].w}, xx[11]); ring[3] = *(const LAS f32x4*)(mb + 2656); __builtin_amdgcn_sched_barrier(0);
                xx[12] = __builtin_elementwise_fma(x2, (f32x2){ring[4].x, ring[4].y}, xx[12]); xx[13] = __builtin_elementwise_fma(x2, (f32x2){ring[4].z, ring[4].w}, xx[13]); ring[4] = *(const LAS f32x4*)(mb + 2672); __builtin_amdgcn_sched_barrier(0);
                xx[14] = __builtin_elementwise_fma(x2, (f32x2){ring[5].x, ring[5].y}, xx[14]); xx[15] = __builtin_elementwise_fma(x2, (f32x2){ring[5].z, ring[5].w}, xx[15]); ring[5] = *(const LAS f32x4*)(mb + 2688); __builtin_amdgcn_sched_barrier(0);
                x2 = (f32x2){xx[7][1], xx[7][1]}; xx[8] = __builtin_elementwise_fma(x2, (f32x2){ring[6].x, ring[6].y}, xx[8]); xx[9] = __builtin_elementwise_fma(x2, (f32x2){ring[6].z, ring[6].w}, xx[9]); ring[6] = *(const LAS f32x4*)(mb + 2704); __builtin_amdgcn_sched_barrier(0);
                xx[10] = __builtin_elementwise_fma(x2, (f32x2){ring[7].x, ring[7].y}, xx[10]); xx[11] = __builtin_elementwise_fma(x2, (f32x2){ring[7].z, ring[7].w}, xx[11]); ring[7] = *(const LAS f32x4*)(mb + 2816); __builtin_amdgcn_sched_barrier(0);
                xx[12] = __builtin_elementwise_fma(x2, (f32x2){ring[8].x, ring[8].y}, xx[12]); xx[13] = __builtin_elementwise_fma(x2, (f32x2){ring[8].z, ring[8].w}, xx[13]); ring[8] = *(const LAS f32x4*)(mb + 2832); __builtin_amdgcn_sched_barrier(0);
                xx[14] = __builtin_elementwise_fma(x2, (f32x2){ring[9].x, ring[9].y}, xx[14]); xx[15] = __builtin_elementwise_fma(x2, (f32x2){ring[9].z, ring[9].w}, xx[15]); ring[9] = *(const LAS f32x4*)(mb + 2848); __builtin_amdgcn_sched_barrier(0);
                x2 = (f32x2){xx[8][0], xx[8][0]}; xx[8] = __builtin_elementwise_fma(x2, (f32x2){ring[10].x, ring[10].y}, xx[8]); xx[9] = __builtin_elementwise_fma(x2, (f32x2){ring[10].z, ring[10].w}, xx[9]); ring[10] = *(const LAS f32x4*)(mb + 2960); __builtin_amdgcn_sched_barrier(0);
                xx[10] = __builtin_elementwise_fma(x2, (f32x2){ring[11].x, ring[11].y}, xx[10]); xx[11] = __builtin_elementwise_fma(x2, (f32x2){ring[11].z, ring[11].w}, xx[11]); ring[11] = *(const LAS f32x4*)(mb + 2976); __builtin_amdgcn_sched_barrier(0);
                xx[12] = __builtin_elementwise_fma(x2, (f32x2){ring[12].x, ring[12].y}, xx[12]); xx[13] = __builtin_elementwise_fma(x2, (f32x2){ring[12].z, ring[12].w}, xx[13]); ring[12] = *(const LAS f32x4*)(mb + 2992); __builtin_amdgcn_sched_barrier(0);
                xx[14] = __builtin_elementwise_fma(x2, (f32x2){ring[13].x, ring[13].y}, xx[14]); xx[15] = __builtin_elementwise_fma(x2, (f32x2){ring[13].z, ring[13].w}, xx[15]); ring[13] = *(const LAS f32x4*)(mb + 3104); __builtin_amdgcn_sched_barrier(0);
                x2 = (f32x2){xx[8][1], xx[8][1]}; xx[8] = __builtin_elementwise_fma(x2, (f32x2){ring[14].x, ring[14].y}, xx[8]); xx[9] = __builtin_elementwise_fma(x2, (f32x2){ring[14].z, ring[14].w}, xx[9]); ring[14] = *(const LAS f32x4*)(mb + 3120); __builtin_amdgcn_sched_barrier(0);
                xx[10] = __builtin_elementwise_fma(x2, (f32x2){ring[0].x, ring[0].y}, xx[10]); xx[11] = __builtin_elementwise_fma(x2, (f32x2){ring[0].z, ring[0].w}, xx[11]); ring[0] = *(const LAS f32x4*)(mb + 3136); __builtin_amdgcn_sched_barrier(0);
                xx[12] = __builtin_elementwise_fma(x2, (f32x2){ring[1].x, ring[1].y}, xx[12]); xx[13] = __builtin_elementwise_fma(x2, (f32x2){ring[1].z, ring[1].w}, xx[13]); ring[1] = *(const LAS f32x4*)(mb + 3248); __builtin_amdgcn_sched_barrier(0);
                xx[14] = __builtin_elementwise_fma(x2, (f32x2){ring[2].x, ring[2].y}, xx[14]); xx[15] = __builtin_elementwise_fma(x2, (f32x2){ring[2].z, ring[2].w}, xx[15]); ring[2] = *(const LAS f32x4*)(mb + 3264); __builtin_amdgcn_sched_barrier(0);
                x2 = (f32x2){xx[9][0], xx[9][0]}; xx[8] = __builtin_elementwise_fma(x2, (f32x2){ring[3].x, ring[3].y}, xx[8]); xx[9] = __builtin_elementwise_fma(x2, (f32x2){ring[3].z, ring[3].w}, xx[9]); ring[3] = *(const LAS f32x4*)(mb + 3280); __builtin_amdgcn_sched_barrier(0);
                xx[10] = __builtin_elementwise_fma(x2, (f32x2){ring[4].x, ring[4].y}, xx[10]); xx[11] = __builtin_elementwise_fma(x2, (f32x2){ring[4].z, ring[4].w}, xx[11]); ring[4] = *(const LAS f32x4*)(mb + 3408); __builtin_amdgcn_sched_barrier(0);
                xx[12] = __builtin_elementwise_fma(x2, (f32x2){ring[5].x, ring[5].y}, xx[12]); xx[13] = __builtin_elementwise_fma(x2, (f32x2){ring[5].z, ring[5].w}, xx[13]); ring[5] = *(const LAS f32x4*)(mb + 3424); __builtin_amdgcn_sched_barrier(0);
                xx[14] = __builtin_elementwise_fma(x2, (f32x2){ring[6].x, ring[6].y}, xx[14]); xx[15] = __builtin_elementwise_fma(x2, (f32x2){ring[6].z, ring[6].w}, xx[15]); ring[6] = *(const LAS f32x4*)(mb + 3552); __builtin_amdgcn_sched_barrier(0);
                x2 = (f32x2){xx[9][1], xx[9][1]}; xx[10] = __builtin_elementwise_fma(x2, (f32x2){ring[7].x, ring[7].y}, xx[10]); xx[11] = __builtin_elementwise_fma(x2, (f32x2){ring[7].z, ring[7].w}, xx[11]); ring[7] = *(const LAS f32x4*)(mb + 3568); __builtin_amdgcn_sched_barrier(0);
                xx[12] = __builtin_elementwise_fma(x2, (f32x2){ring[8].x, ring[8].y}, xx[12]); xx[13] = __builtin_elementwise_fma(x2, (f32x2){ring[8].z, ring[8].w}, xx[13]); ring[8] = *(const LAS f32x4*)(mb + 3696); __builtin_amdgcn_sched_barrier(0);
                xx[14] = __builtin_elementwise_fma(x2, (f32x2){ring[9].x, ring[9].y}, xx[14]); xx[15] = __builtin_elementwise_fma(x2, (f32x2){ring[9].z, ring[9].w}, xx[15]); ring[9] = *(const LAS f32x4*)(mb + 3712); __builtin_amdgcn_sched_barrier(0);
                x2 = (f32x2){xx[10][0], xx[10][0]}; xx[10] = __builtin_elementwise_fma(x2, (f32x2){ring[10].x, ring[10].y}, xx[10]); xx[11] = __builtin_elementwise_fma(x2, (f32x2){ring[10].z, ring[10].w}, xx[11]); ring[10] = *(const LAS f32x4*)(mb + 3840); __builtin_amdgcn_sched_barrier(0);
                xx[12] = __builtin_elementwise_fma(x2, (f32x2){ring[11].x, ring[11].y}, xx[12]); xx[13] = __builtin_elementwise_fma(x2, (f32x2){ring[11].z, ring[11].w}, xx[13]); ring[11] = *(const LAS f32x4*)(mb + 3856); __builtin_amdgcn_sched_barrier(0);
                xx[14] = __builtin_elementwise_fma(x2, (f32x2){ring[12].x, ring[12].y}, xx[14]); xx[15] = __builtin_elementwise_fma(x2, (f32x2){ring[12].z, ring[12].w}, xx[15]); ring[12] = *(const LAS f32x4*)(mb + 4000); __builtin_amdgcn_sched_barrier(0);
                x2 = (f32x2){xx[10][1], xx[10][1]}; xx[10] = __builtin_elementwise_fma(x2, (f32x2){ring[13].x, ring[13].y}, xx[10]); xx[11] = __builtin_elementwise_fma(x2, (f32x2){ring[13].z, ring[13].w}, xx[11]); ring[13] = *(const LAS f32x4*)(mb + 4144); __builtin_amdgcn_sched_barrier(0);
                xx[12] = __builtin_elementwise_fma(x2, (f32x2){ring[14].x, ring[14].y}, xx[12]); xx[13] = __builtin_elementwise_fma(x2, (f32x2){ring[14].z, ring[14].w}, xx[13]); ring[14] = *(const LAS f32x4*)(mb + 4288); __builtin_amdgcn_sched_barrier(0);
                xx[14] = __builtin_elementwise_fma(x2, (f32x2){ring[0].x, ring[0].y}, xx[14]); xx[15] = __builtin_elementwise_fma(x2, (f32x2){ring[0].z, ring[0].w}, xx[15]); ring[0] = *(const LAS f32x4*)(mb + 4432); __builtin_amdgcn_sched_barrier(0);
                x2 = (f32x2){xx[11][0], xx[11][0]}; xx[10] = __builtin_elementwise_fma(x2, (f32x2){ring[1].x, ring[1].y}, xx[10]); xx[11] = __builtin_elementwise_fma(x2, (f32x2){ring[1].z, ring[1].w}, xx[11]); __builtin_amdgcn_sched_barrier(0);
                xx[12] = __builtin_elementwise_fma(x2, (f32x2){ring[2].x, ring[2].y}, xx[12]); xx[13] = __builtin_elementwise_fma(x2, (f32x2){ring[2].z, ring[2].w}, xx[13]); __builtin_amdgcn_sched_barrier(0);
                xx[14] = __builtin_elementwise_fma(x2, (f32x2){ring[3].x, ring[3].y}, xx[14]); xx[15] = __builtin_elementwise_fma(x2, (f32x2){ring[3].z, ring[3].w}, xx[15]); __builtin_amdgcn_sched_barrier(0);
                x2 = (f32x2){xx[11][1], xx[11][1]}; xx[12] = __builtin_elementwise_fma(x2, (f32x2){ring[4].x, ring[4].y}, xx[12]); xx[13] = __builtin_elementwise_fma(x2, (f32x2){ring[4].z, ring[4].w}, xx[13]); __builtin_amdgcn_sched_barrier(0);
                xx[14] = __builtin_elementwise_fma(x2, (f32x2){ring[5].x, ring[5].y}, xx[14]); xx[15] = __builtin_elementwise_fma(x2, (f32x2){ring[5].z, ring[5].w}, xx[15]); __builtin_amdgcn_sched_barrier(0);
                x2 = (f32x2){xx[12][0], xx[12][0]}; xx[12] = __builtin_elementwise_fma(x2, (f32x2){ring[6].x, ring[6].y}, xx[12]); xx[13] = __builtin_elementwise_fma(x2, (f32x2){ring[6].z, ring[6].w}, xx[13]); __builtin_amdgcn_sched_barrier(0);
                xx[14] = __builtin_elementwise_fma(x2, (f32x2){ring[7].x, ring[7].y}, xx[14]); xx[15] = __builtin_elementwise_fma(x2, (f32x2){ring[7].z, ring[7].w}, xx[15]); __builtin_amdgcn_sched_barrier(0);
                x2 = (f32x2){xx[12][1], xx[12][1]}; xx[12] = __builtin_elementwise_fma(x2, (f32x2){ring[8].x, ring[8].y}, xx[12]); xx[13] = __builtin_elementwise_fma(x2, (f32x2){ring[8].z, ring[8].w}, xx[13]); __builtin_amdgcn_sched_barrier(0);
                xx[14] = __builtin_elementwise_fma(x2, (f32x2){ring[9].x, ring[9].y}, xx[14]); xx[15] = __builtin_elementwise_fma(x2, (f32x2){ring[9].z, ring[9].w}, xx[15]); __builtin_amdgcn_sched_barrier(0);
                x2 = (f32x2){xx[13][0], xx[13][0]}; xx[12] = __builtin_elementwise_fma(x2, (f32x2){ring[10].x, ring[10].y}, xx[12]); xx[13] = __builtin_elementwise_fma(x2, (f32x2){ring[10].z, ring[10].w}, xx[13]); __builtin_amdgcn_sched_barrier(0);
                xx[14] = __builtin_elementwise_fma(x2, (f32x2){ring[11].x, ring[11].y}, xx[14]); xx[15] = __builtin_elementwise_fma(x2, (f32x2){ring[11].z, ring[11].w}, xx[15]); __builtin_amdgcn_sched_barrier(0);
                x2 = (f32x2){xx[13][1], xx[13][1]}; xx[14] = __builtin_elementwise_fma(x2, (f32x2){ring[12].x, ring[12].y}, xx[14]); xx[15] = __builtin_elementwise_fma(x2, (f32x2){ring[12].z, ring[12].w}, xx[15]); __builtin_amdgcn_sched_barrier(0);
                x2 = (f32x2){xx[14][0], xx[14][0]}; xx[14] = __builtin_elementwise_fma(x2, (f32x2){ring[13].x, ring[13].y}, xx[14]); xx[15] = __builtin_elementwise_fma(x2, (f32x2){ring[13].z, ring[13].w}, xx[15]); __builtin_amdgcn_sched_barrier(0);
                x2 = (f32x2){xx[14][1], xx[14][1]}; xx[14] = __builtin_elementwise_fma(x2, (f32x2){ring[14].x, ring[14].y}, xx[14]); xx[15] = __builtin_elementwise_fma(x2, (f32x2){ring[14].z, ring[14].w}, xx[15]); __builtin_amdgcn_sched_barrier(0);
                x2 = (f32x2){xx[15][0], xx[15][0]}; xx[14] = __builtin_elementwise_fma(x2, (f32x2){ring[0].x, ring[0].y}, xx[14]); xx[15] = __builtin_elementwise_fma(x2, (f32x2){ring[0].z, ring[0].w}, xx[15]); __builtin_amdgcn_sched_barrier(0);
#pragma unroll
                for (int g = 0; g < 4; ++g) { v4u o; o.x = pg8::cvt_pk_bf16(xx[4 * g][0], xx[4 * g][1]); o.y = pg8::cvt_pk_bf16(xx[4 * g + 1][0], xx[4 * g + 1][1]);
                    o.z = pg8::cvt_pk_bf16(xx[4 * g + 2][0], xx[4 * g + 2][1]); o.w = pg8::cvt_pk_bf16(xx[4 * g + 3][0], xx[4 * g + 3][1]); *(LAS v4u*)(L + CK_U + lane * 80 + 16 * g) = o; }
            }
            CK_BAR();
            if (w >= 2) {
#pragma unroll
                for (int ks = 0; ks < 2; ++ks) { CK_MFMA(acc, CK_FRAG(MM + CK_MBR, 80, 0, ks), CK_FRAG(CK_U, 80, 32 * ih, ks)); CK_MFMA(acc, CK_FRAG(MM + CK_MKR, 80, 0, ks), CK_FRAGT(TR + CK_VT, 32 * ih, ks)); }
#pragma unroll
                for (int q = 0; q < 16; ++q) *(LAS float*)(L + CK_YB + (((q & 3) + 8 * (q >> 2) + 4 * hh) * 64 + 32 * ih + r32) * 4) = acc[q];
            }
            {
#pragma unroll
                for (int ks = 0; ks < 2; ++ks) { CK_MFMA(Sacc, CK_FRAGT(TR + CK_BTT, 32 * kh, ks), CK_FRAG(CK_U, 80, 32 * ih, ks)); CK_MFMA(Sacc, CK_FRAGT(TR + CK_KTT, 32 * kh, ks), CK_FRAGT(TR + CK_VT, 32 * ih, ks)); }
#pragma unroll
                for (int g = 0; g < 4; ++g) { const f32x4 pl = *(const LAS f32x4*)(L + CK_EXPL + (ch & 1) * 256 + (32 * kh + 8 * g + 4 * hh) * 4);
                    Sacc[4 * g] *= pl.x; Sacc[4 * g + 1] *= pl.y; Sacc[4 * g + 2] *= pl.z; Sacc[4 * g + 3] *= pl.w;
                    *(LAS unsigned long long*)(L + CK_SB + (32 * ih + r32) * 144 + (32 * kh + 8 * g + 4 * hh) * 2) = pack4bf(Sacc[4 * g], Sacc[4 * g + 1], Sacc[4 * g + 2], Sacc[4 * g + 3]); }
            }
            CK_BAR();
        }
        {
            const int lane = F.lane, r32 = lane & 31, hh = lane >> 5;
            float* so = F.out + (smp ? O_WKVS : O_WKVP) + (((size_t)(l * 8 + b) * 16 + h) * 64 + 32 * ih + r32) * 64 + 32 * kh + 4 * hh;
#pragma unroll
            for (int g = 0; g < 4; ++g) *(f32x4*)(so + 8 * g) = (f32x4){Sacc[4 * g], Sacc[4 * g + 1], Sacc[4 * g + 2], Sacc[4 * g + 3]};
        }
    } else {
        const bf16* URW = (const bf16*)(F.ws + B_URW);
        bf16* ORW = (bf16*)(F.ws + B_ORW);
        float mu_r[4], mu_k[4], mu_v[4], k_k[4], k_a[4], r_k[4], ln_w[4], ln_b[4];
        {
            const int c = h * 64 + 4 * (F.tid & 15); const float* mu = GIN(A, 12) + (size_t)l * P_RW;
#pragma unroll
            for (int j = 0; j < 4; ++j) { mu_r[j] = mu[c + j]; mu_k[j] = mu[1024 + c + j]; mu_v[j] = mu[2048 + c + j]; k_k[j] = GIN(A, 18)[l * 1024 + c + j]; k_a[j] = GIN(A, 19)[l * 1024 + c + j]; r_k[j] = GIN(A, 20)[l * 1024 + c + j];
                ln_w[j] = GIN(A, 21)[l * 1024 + c + j]; ln_b[j] = GIN(A, 22)[l * 1024 + c + j]; }
        }
        unsigned long long raw[2][9];
#define CK_RAWLOAD(ch) do { _Pragma("unroll") for (int rep_ = 0; rep_ < 2; ++rep_) { const int tt_ = (pt >> 4) + 16 * rep_; const int tseq = (ch) * CK_L + tt_; const size_t ru_ = (size_t)(row0 + (ch) * CK_L); \
            const int vo_ = tt_ * P_RW + c, vp_ = (tseq > 0) ? vo_ - P_RW : vo_; \
            const bf16* u_ = URW + ru_ * P_RW;     \
            raw[rep_][0] = *(const unsigned long long*)(u_ + vo_); raw[rep_][1] = *(const unsigned long long*)(u_ + vo_ + 1024); raw[rep_][2] = *(const unsigned long long*)(u_ + vo_ + 2048); \
            raw[rep_][5] = *(const unsigned long long*)(u_ + vp_); raw[rep_][6] = *(const unsigned long long*)(u_ + vp_ + 1024); raw[rep_][7] = *(const unsigned long long*)(u_ + vp_ + 2048); } } while (0)
        float r[2][4], kk[2][4], km[2][4], bb[2][4], ld[2][4], vr[2][4], cp[2][4];
        unsigned long long bv1[2], bv2[2], bv3[2], g1[2], g2[2], g3[2];
#pragma unroll
        for (int rep = 0; rep < 2; ++rep) { bv1[rep] = bv2[rep] = bv3[rep] = 0ull; g1[rep] = g2[rep] = g3[rep] = 0ull; }
        auto post = [&](const int ch, const int pt, const int gen) __attribute__((always_inline)) {
            const int cq = pt & 15, c = h * 64 + 4 * cq;
#pragma unroll
            for (int rep = 0; rep < 2; ++rep) {
                const int tt = (pt >> 4) + 16 * rep; const size_t r_ = (size_t)(row0 + ch * CK_L + tt);
                const f32x4 y4 = *(const LAS f32x4*)(L + CK_YB + (tt * 64 + 4 * cq) * 4);
                float gg[4], vv[4]; unpack4(gen == 1 ? g1[rep] : gen == 2 ? g2[rep] : g3[rep], gg); unpack4(gen == 1 ? bv1[rep] : gen == 2 ? bv2[rep] : bv3[rep], vv);
                const float mean = reduce16((y4.x + y4.y) + (y4.z + y4.w)) * (1.f / 64.f);
                const float d0 = y4.x - mean, d1 = y4.y - mean, d2 = y4.z - mean, d3 = y4.w - mean;
                const float var = reduce16((d0 * d0 + d1 * d1) + (d2 * d2 + d3 * d3)) * (1.f / 64.f);
                const float rs = __builtin_amdgcn_rsqf(var + GN_EPS);
                const float o0 = (d0 * rs * ln_w[0] + ln_b[0] + vv[0]) * gg[0], o1 = (d1 * rs * ln_w[1] + ln_b[1] + vv[1]) * gg[1];
                const float o2 = (d2 * rs * ln_w[2] + ln_b[2] + vv[2]) * gg[2], o3 = (d3 * rs * ln_w[3] + ln_b[3] + vv[3]) * gg[3];
                *(unsigned long long*)(ORW + r_ * 1024 + c) = pack4bf(o0, o1, o2, o3);
            }
        };
        auto prep1 = [&](const int chp, const int pt, const int lane) __attribute__((always_inline)) {
            const int cq = pt & 15, c = h * 64 + 4 * cq;
            float ur[2][4], uk[2][4], uv[2][4], pr[2][4], pk[2][4], pv[2][4], la[2][4]; unsigned long long gcur[2];
#pragma unroll
            for (int rep = 0; rep < 2; ++rep) { unpack4(raw[rep][0], ur[rep]); unpack4(raw[rep][1], uk[rep]); unpack4(raw[rep][2], uv[rep]);
                unpack4(raw[rep][5], pr[rep]); unpack4(raw[rep][6], pk[rep]); unpack4(raw[rep][7], pv[rep]);
                const int lo_ = (((pt >> 4) + 16 * rep) * 64 + 4 * cq) * 2;
                unpack4(*(const LAS unsigned long long*)(L + CK_LOR + lo_), ld[rep]); unpack4(*(const LAS unsigned long long*)(L + CK_LOR + 4096 + lo_), la[rep]); gcur[rep] = *(const LAS unsigned long long*)(L + CK_LOR + 8192 + lo_); }
            __builtin_amdgcn_sched_barrier(0);
            { const int chn = (chp + 1 < nch) ? chp + 1 : nch - 1; CK_RAWLOAD(chn); }
            __builtin_amdgcn_sched_barrier(0);
#pragma unroll
            for (int rep = 0; rep < 2; ++rep) {
                const int tt = (pt >> 4) + 16 * rep, tseq = chp * CK_L + tt;
                if (tseq == 0) {
                    const f32x4 a0 = *(const LAS f32x4*)(L + CK_SH + 16 * cq), a1 = *(const LAS f32x4*)(L + CK_SH + 256 + 16 * cq), a2 = *(const LAS f32x4*)(L + CK_SH + 512 + 16 * cq);
#pragma unroll
                    for (int j = 0; j < 4; ++j) { pr[rep][j] = a0[j]; pk[rep][j] = a1[j]; pv[rep][j] = a2[j]; }
                }
                float ssq = 0.f, bon = 0.f, kr[4];
#pragma unroll
                for (int j = 0; j < 4; ++j) {
                    r[rep][j] = ur[rep][j] + (pr[rep][j] - ur[rep][j]) * mu_r[j]; kr[j] = uk[rep][j] + (pk[rep][j] - uk[rep][j]) * mu_k[j]; vr[rep][j] = uv[rep][j] + (pv[rep][j] - uv[rep][j]) * mu_v[j];
                    kk[rep][j] = kr[j] * k_k[j]; ssq += kk[rep][j] * kk[rep][j]; km[rep][j] = kr[j] * (1.f + (la[rep][j] - 1.f) * k_a[j]); bon += r[rep][j] * km[rep][j] * r_k[j]; }
                ssq = reduce16(ssq); bon = reduce16(bon);
                const float inv = __builtin_amdgcn_rsqf(fmaxf(ssq, 1e-24f));
#pragma unroll
                for (int j = 0; j < 4; ++j) { kk[rep][j] *= inv; bb[rep][j] = kk[rep][j] * la[rep][j]; }
#pragma unroll
                for (int j = 0; j < 4; ++j) { float x = ld[rep][j]; const float u1 = __shfl_up(x, 16); x += (lane >= 16) ? u1 : 0.f; const float u2 = __shfl_up(x, 32); x += (lane >= 32) ? u2 : 0.f; cp[rep][j] = x; }
                if (lane >= 48) *(LAS f32x4*)(L + CK_LDF + ((tt >> 2) * 64 + 4 * cq) * 4) = (f32x4){cp[rep][0], cp[rep][1], cp[rep][2], cp[rep][3]};
                bv3[rep] = bv2[rep]; g3[rep] = g2[rep]; bv2[rep] = bv1[rep]; g2[rep] = g1[rep]; bv1[rep] = pack4bf(bon * vr[rep][0], bon * vr[rep][1], bon * vr[rep][2], bon * vr[rep][3]); g1[rep] = gcur[rep];
            }
        };
        auto prep3 = [&](const int chp, const int pt) __attribute__((always_inline)) {
            const int cq = pt & 15; const int TR = CK_TR + (chp & 1) * CK_TR_SZ;
#pragma unroll
            for (int rep = 0; rep < 2; ++rep) {
                const int tt = (pt >> 4) + 16 * rep, grp = tt >> 2;
                f32x4 cum = (f32x4){cp[rep][0], cp[rep][1], cp[rep][2], cp[rep][3]}, cumL = (f32x4){0.f, 0.f, 0.f, 0.f};
#pragma unroll
                for (int g2_ = 0; g2_ < 8; ++g2_) { const f32x4 t4 = *(const LAS f32x4*)(L + CK_LDF + (g2_ * 64 + 4 * cq) * 4); cumL += t4; if (g2_ < grp) cum += t4; }
                float at[4], bt[4], kt[4], rt[4];
#pragma unroll
                for (int j = 0; j < 4; ++j) {
                    const float e1 = __builtin_amdgcn_exp2f(1.4426950408889634f * cum[j]), e2 = __builtin_amdgcn_exp2f(-1.4426950408889634f * cum[j]), ep = __builtin_amdgcn_exp2f(1.4426950408889634f * (cum[j] - ld[rep][j]));
                    at[j] = -kk[rep][j] * ep; bt[j] = bb[rep][j] * e2; kt[j] = km[rep][j] * e2; rt[j] = r[rep][j] * e1; }
                const unsigned long long pa = pack4bf(at[0], at[1], at[2], at[3]), pb = pack4bf(bt[0], bt[1], bt[2], bt[3]), pkk = pack4bf(kt[0], kt[1], kt[2], kt[3]), prr = pack4bf(rt[0], rt[1], rt[2], rt[3]),
                                         pvv = pack4bf(vr[rep][0], vr[rep][1], vr[rep][2], vr[rep][3]);
                *(LAS unsigned long long*)(L + CK_AT + tt * 144 + 8 * cq) = pa; *(LAS unsigned long long*)(L + CK_BT + tt * 144 + 8 * cq) = pb;
                *(LAS unsigned long long*)(L + CK_KT + tt * 144 + 8 * cq) = pkk; *(LAS unsigned long long*)(L + CK_RT + tt * 144 + 8 * cq) = prr;
#pragma unroll
                for (int j = 0; j < 4; ++j) {
                    const int to = (4 * cq + j) * 80 + (((tt >> 3) ^ ((cq >> 1) & 3)) * 16) + (tt & 7) * 2;
                    *(LAS unsigned short*)(L + TR + CK_BTT + to) = (unsigned short)(pb >> (16 * j));
                    *(LAS unsigned short*)(L + TR + CK_KTT + to) = (unsigned short)(pkk >> (16 * j));
                    *(LAS unsigned short*)(L + TR + CK_VT + to) = (unsigned short)(pvv >> (16 * j)); }
                if (tt == 0) *(LAS f32x4*)(L + CK_EXPL + (chp & 1) * 256 + 16 * cq) = (f32x4){__builtin_amdgcn_exp2f(1.4426950408889634f * cumL[0]), __builtin_amdgcn_exp2f(1.4426950408889634f * cumL[1]),
                                                                                          __builtin_amdgcn_exp2f(1.4426950408889634f * cumL[2]), __builtin_amdgcn_exp2f(1.4426950408889634f * cumL[3])};
            }
        };
        auto prep4 = [&](const int chp, const int lane) __attribute__((always_inline)) {
            const int r32 = lane & 31, hh = lane >> 5, wt = w - 4; const int MM = CK_MM + (chp & 1) * CK_MM_SZ;
            f32x16s acc;
#pragma unroll
            for (int q = 0; q < 16; ++q) acc[q] = 0.f;
            const int abase = (wt & 1) ? CK_KT : CK_BT, bbase = (wt & 2) ? CK_RT : CK_AT;
#pragma unroll
            for (int ks = 0; ks < 4; ++ks) CK_MFMA(acc, CK_FRAG(abase, 144, 0, ks), CK_FRAG(bbase, 144, 0, ks));
#pragma unroll
            for (int q = 0; q < 16; ++q) { const int s = (q & 3) + 8 * (q >> 2) + 4 * hh; const bool keep = (wt & 2) ? (s <= r32) : (s < r32); acc[q] = keep ? acc[q] : 0.f; }
            if (wt == 0) {
#pragma unroll
                for (int q = 0; q < 16; ++q) *(LAS float*)(L + MM + CK_MBA + ((q & 3) + 8 * (q >> 2) + 4 * hh) * 144 + r32 * 4) = acc[q];
            } else {
                const int obase = MM + ((wt == 1) ? CK_MKA : (wt == 2) ? CK_MBR : CK_MKR);
#pragma unroll
                for (int g = 0; g < 4; ++g) *(LAS unsigned long long*)(L + obase + r32 * 80 + (8 * g + 4 * hh) * 2) = pack4bf(acc[4 * g], acc[4 * g + 1], acc[4 * g + 2], acc[4 * g + 3]);
            }
        };
        { const int pt = F.tid - 256, c = h * 64 + 4 * (pt & 15); CK_RAWLOAD(0); }
        __syncthreads();
        { int tv = threadIdx.x; asm volatile("" : "+v"(tv)); prep1(0, tv - 256, tv & 63); }
        CK_BAR();
        { int tv = threadIdx.x; asm volatile("" : "+v"(tv)); prep3(0, tv - 256); }
        CK_BAR();
        { int tv = threadIdx.x; asm volatile("" : "+v"(tv)); prep4(0, tv & 63); }
        CK_BAR();
        for (int ch = 0; ch < nch; ++ch) {
            int tv = threadIdx.x; asm volatile("" : "+v"(tv));
            const int pt = tv - 256, lane = tv & 63; const bool more = ch + 1 < nch;
            if (more) prep1(ch + 1, pt, lane);
            CK_BAR();
            if (ch > 0) { if (more) post(ch - 1, pt, 3); else post(ch - 1, pt, 2); }
            CK_BAR();
            if (more) prep3(ch + 1, pt);
            CK_BAR();
            if (more) prep4(ch + 1, lane);
            CK_BAR();
        }
        { int tv = threadIdx.x; asm volatile("" : "+v"(tv)); post(nch - 1, tv - 256, 1); }
#undef CK_RAWLOAD
    }
    __syncthreads();
}
__device__ __forceinline__ void ph_scan(Frame& F, CArgsP A, int l, const int s0, const int ns) {
    for (int it = s0; it < 256; it += ns) scan_chunked(F, A, l, it, (const bf16*)(F.ws + WS_W + W_LORA), (const bf16*)(F.ws + B_LIN));
}

__device__ __forceinline__ void ph_final(Frame& F, CArgsP A) {
    const int gw = F.vcu * NWAVES + F.wave, NGW = F.G * NWAVES;
    float* X = F.out + O_YP; const float* SS = (const float*)(F.ctl + CW_SS) + 4 * MT; const float* g = GIN(A, 30);
    const GAS f32x4* gr = (const GAS f32x4*)g + F.lane;
    f32x4 gg[4];
#pragma unroll
    for (int j = 0; j < 4; ++j) gg[j] = gr[64 * j];
    for (int m0 = gw; m0 < MT; m0 += 3 * NGW) {
        f32x4 v[3][4]; float r[3];
#pragma unroll
        for (int q = 0; q < 3; ++q) { const int m = m0 + q * NGW, mm = (m < MT) ? m : 0; r[q] = SS[mm];
            const GAS f32x4* xr = (const GAS f32x4*)(X + (size_t)mm * 1024) + F.lane;
#pragma unroll
            for (int j = 0; j < 4; ++j) v[q][j] = xr[64 * j]; }
#pragma unroll
        for (int q = 0; q < 3; ++q) { const int m = m0 + q * NGW;
            if (m < MT) { const float rs = 1.0f / sqrtf(r[q] * (1.0f / 1024.f) + EPS);
                GAS f32x4* xo = (GAS f32x4*)(X + (size_t)m * 1024) + F.lane;
#pragma unroll
                for (int j = 0; j < 4; ++j) xo[64 * j] = v[q][j] * rs * gg[j]; } }
    }
}

typedef float f32x16g __attribute__((ext_vector_type(16)));
template <int NB, class EPI> __device__ __forceinline__ void mini_gemm(Frame& F, const bf16* A, const bf16* Bt, const int K, const int nblk_n, EPI epi) {
    LAS float* red = (LAS float*)(F.lds + RING_OFF);
    const int KW = K / NWAVES, i = F.lane & 31, h = F.lane >> 5;
    for (int bi = F.vcu; bi < 8 * nblk_n; bi += F.G) {
        const int rb = bi & 7, cb = bi >> 3;
        const bf16* ap = A + (size_t)(rb * 32 + i) * K + F.wave * KW + 8 * h;
        const bf16* bp = Bt + (size_t)(cb * 32 + i) * K + F.wave * KW + 8 * h;
        f32x16g acc;
#pragma unroll
        for (int r = 0; r < 16; ++r) acc[r] = 0.f;
        for (int k0 = 0; k0 < KW; k0 += 16 * NB) {
            bf16x8 a[NB], b[NB];
#pragma unroll
            for (int j = 0; j < NB; ++j) { a[j] = *(const bf16x8*)(ap + k0 + 16 * j); b[j] = *(const bf16x8*)(bp + k0 + 16 * j); }
#pragma unroll
            for (int j = 0; j < NB; ++j) acc = __builtin_amdgcn_mfma_f32_32x32x16_bf16(a[j], b[j], acc, 0, 0, 0);
        }
        __syncthreads();
#pragma unroll
        for (int r = 0; r < 16; ++r) red[(F.wave * 16 + r) * 64 + F.lane] = acc[r];
        __syncthreads();
        const int q = F.wave;
        float s0 = 0.f, s1 = 0.f;
#pragma unroll
        for (int w = 0; w < NWAVES; ++w) { s0 += red[(w * 16 + 2 * q) * 64 + F.lane]; s1 += red[(w * 16 + 2 * q + 1) * 64 + F.lane]; }
        epi(rb * 32 + 2 * (q & 1) + 8 * (q >> 1) + 4 * h, cb * 32 + i, s0, s1);
    }
}
__device__ __forceinline__ void mini_gated(Frame& F, const bf16* A, const bf16* Bt, const bf16* G, const int goff, const bf16* S, bf16* O) {
    mini_gemm<8>(F, A + (size_t)MP * 1024, Bt, 1024, 32, [=](int row, int col, float v0, float v1) {
        const size_t r0 = (size_t)(MP + row);
        v0 *= bf2f(G[r0 * 2048 + goff + col]); v1 *= bf2f(G[(r0 + 1) * 2048 + goff + col]);
        if (S) { v0 += bf2f(S[r0 * 1024 + col]); v1 += bf2f(S[(r0 + 1) * 1024 + col]); }
        O[r0 * 1024 + col] = (bf16)f2bf(v0); O[(r0 + 1) * 1024 + col] = (bf16)f2bf(v1);
    });
}
template <int NB> __device__ __forceinline__ void mini_res(Frame& F, const bf16* A, const bf16* Bt, const int K, const float* Xr, float* X, bf16* XB, float* SS) {
    mini_gemm<NB>(F, A + (size_t)MP * K, Bt, K, 32, [=](int row, int col, float v0, float v1) {
        const size_t r0 = (size_t)(MP + row);
        v0 += Xr[(size_t)row * 1024 + col]; v1 += Xr[(size_t)(row + 1) * 1024 + col];
        X[r0 * 1024 + col] = v0; X[(r0 + 1) * 1024 + col] = v1;
        XB[r0 * 1024 + col] = (bf16)f2bf(v0); XB[(r0 + 1) * 1024 + col] = (bf16)f2bf(v1);
        float q0 = reduce16(v0 * v0), q1 = reduce16(v1 * v1);
        q0 += __shfl_xor(q0, 16); q1 += __shfl_xor(q1, 16);
        if ((col & 31) == 0) { atomicAdd(SS + r0, q0); atomicAdd(SS + r0 + 1, q1); }
    });
}
__device__ __forceinline__ void mini_gate(Frame& F, const bf16* A, const bf16* Bt, const float* ss, bf16* GATE) {
    mini_gemm<8>(F, A + (size_t)MP * 1024, Bt, 1024, 64, [=](int row, int col, float v0, float v1) {
        const size_t r0 = (size_t)(MP + row);
        const float rs0 = 1.0f / sqrtf(ss[r0] * (1.0f / 1024.f) + 1e-6f), rs1 = 1.0f / sqrtf(ss[r0 + 1] * (1.0f / 1024.f) + 1e-6f);
        GATE[r0 * 2048 + col] = (bf16)f2bf(pg8::fast_sigmoid(v0 * rs0)); GATE[(r0 + 1) * 2048 + col] = (bf16)f2bf(pg8::fast_sigmoid(v1 * rs1));
    });
}

__device__ __forceinline__ int edge_row(int idx) { const int j = idx & 31, q = j >> 1, e = j & 1; const int base = (q < 8) ? q * SEQ : MP + (q - 8) * DEC_SEQ, len = (q < 8) ? SEQ : DEC_SEQ; return base + ((idx >= 32) ? len - 2 + e : e); }
__device__ __forceinline__ void up_edge_rows(Frame& F, CArgsP A, int l, const bf16* XB, const bf16* Bt, const float* ss, bf16* GT, float* cv_p, float* cv_s) {
    LAS float* red = (LAS float*)(F.lds + RING_OFF);
    const int KW = 1024 / NWAVES, i = F.lane & 31, h = F.lane >> 5;
    const float* cw = GIN(A, 27) + (size_t)l * 3 * UPW; const float* cb = GIN(A, 28) + (size_t)l * UPW;
    for (int bi = F.vcu; bi < 2 * (D_FF / 32); bi += F.G) {
        const int rb = bi & 1, cq = bi >> 1, nbA = (cq >> 2) * 256 + (cq & 3) * 32;
        const bf16* ap = XB + (size_t)edge_row(rb * 32 + i) * 1024 + F.wave * KW + 8 * h;
        const bf16* bp = Bt + (size_t)(nbA + i) * 1024 + F.wave * KW + 8 * h;
        f32x16g accA, accG;
#pragma unroll
        for (int r = 0; r < 16; ++r) { accA[r] = 0.f; accG[r] = 0.f; }
        { bf16x8 a[8], b0[8], b1[8];
#pragma unroll
            for (int j = 0; j < 8; ++j) { a[j] = *(const bf16x8*)(ap + 16 * j); b0[j] = *(const bf16x8*)(bp + 16 * j); b1[j] = *(const bf16x8*)(bp + 128 * 1024 + 16 * j); }
#pragma unroll
            for (int j = 0; j < 8; ++j) { accA = __builtin_amdgcn_mfma_f32_32x32x16_bf16(a[j], b0[j], accA, 0, 0, 0); accG = __builtin_amdgcn_mfma_f32_32x32x16_bf16(a[j], b1[j], accG, 0, 0, 0); } }
        __syncthreads();
#pragma unroll
        for (int r = 0; r < 16; ++r) { red[(F.wave * 16 + r) * 64 + F.lane] = accA[r]; red[8192 + (F.wave * 16 + r) * 64 + F.lane] = accG[r]; }
        __syncthreads();
        const int q = F.wave;
        float a0 = 0.f, a1 = 0.f, g0 = 0.f, g1 = 0.f;
#pragma unroll
        for (int w = 0; w < NWAVES; ++w) { a0 += red[(w * 16 + 2 * q) * 64 + F.lane]; a1 += red[(w * 16 + 2 * q + 1) * 64 + F.lane]; g0 += red[8192 + (w * 16 + 2 * q) * 64 + F.lane]; g1 += red[8192 + (w * 16 + 2 * q + 1) * 64 + F.lane]; }
        const int idx = rb * 32 + 2 * (q & 1) + 8 * (q >> 1) + 4 * h;
        const int j = (cq >> 2) * 128 + (cq & 3) * 32 + i, sq = (idx & 31) >> 1;
        const int row = edge_row(idx);
        const float r0 = 1.0f / sqrtf(ss[row] * (1.0f / 1024.f) + EPS), r1 = 1.0f / sqrtf(ss[row + 1] * (1.0f / 1024.f) + EPS);
        a0 *= r0; g0 *= r0; a1 *= r1; g1 *= r1;
        if (rb == 1) { float* o = (sq < 8) ? cv_p + (size_t)sq * 2 * UPW : cv_s + (size_t)(sq - 8) * 2 * UPW; o[j] = a0; o[D_FF + j] = g0; o[UPW + j] = a1; o[UPW + D_FF + j] = g1; }
        else {
            float c0[2], c1[2];
#pragma unroll
            for (int hf = 0; hf < 2; ++hf) { const int col = j + hf * D_FF; const float x0 = hf ? g0 : a0, x1 = hf ? g1 : a1;
                float s2 = 0.f, s1 = 0.f;
                if (sq >= 8) { const float* st = GIN(A, 6) + ((size_t)(l * 8 + sq - 8) * 2) * UPW + col; s2 = st[0]; s1 = st[UPW]; }
                const float w0 = cw[col], w1 = cw[UPW + col], w2 = cw[2 * UPW + col], bs = cb[col];
                c0[hf] = bs + s2 * w0 + s1 * w1 + x0 * w2; c1[hf] = bs + s1 * w0 + x0 * w1 + x1 * w2; }
            GT[(size_t)row * D_FF + j] = (bf16)f2bf(c0[0] * __builtin_amdgcn_rcpf(1.0f + __builtin_amdgcn_exp2f(-1.4426950408889634f * c0[0])) * c0[1]);
            GT[(size_t)(row + 1) * D_FF + j] = (bf16)f2bf(c1[0] * __builtin_amdgcn_rcpf(1.0f + __builtin_amdgcn_exp2f(-1.4426950408889634f * c1[0])) * c1[1]);
        }
    }
}

#define REOPAQUE() do { int tv = threadIdx.x; asm volatile("" : "+v"(tv)); F.tid = tv; F.lane = tv & 63; F.wave = __builtin_amdgcn_readfirstlane(tv >> 6); \
    ap = (CArgsP)__builtin_amdgcn_kernarg_segment_ptr(); asm volatile("" : "+s"(ap)); \
    { GAS unsigned char* w_ = ap->ws; GAS float* o_ = ap->out; asm volatile("" : "+s"(w_), "+s"(o_)); F.ws = (unsigned char*)w_; F.out = (float*)o_; F.ctl = (gu32*)(w_ + WS_CTL); } } while (0)
#ifndef MK_PROBE_MASK
#define MK_PROBE_MASK 0u
#endif
#define MK_PROBE_AMP 4u
#define PH_BEGIN(idx) if (lo <= (idx) && (idx) < hi) { REOPAQUE(); if ((MK_PROBE_MASK >> (idx)) & 1u) { if (F.tid == 0) F.MISC[14] = (unsigned)rt(); }
#define PH_END(idx) if ((idx) + 1 < hi) xcd_barrier(bar); if ((MK_PROBE_MASK >> (idx)) & 1u) { if (threadIdx.x == 0) F.MISC[13] += (unsigned)rt() - F.MISC[14]; } }
#define PH_END_NOBAR(idx) if (MK_PER_PHASE && (idx) + 1 < hi) xcd_barrier(bar); if ((MK_PROBE_MASK >> (idx)) & 1u) { if (threadIdx.x == 0) F.MISC[13] += (unsigned)rt() - F.MISC[14]; } }

#define IDLE_CONVERT(nu, part) do { const int rem_ = (nu) % F.G; __syncthreads(); if (rem_ && (int)blockIdx.x >= rem_) { REOPAQUE(); p0_weights(F, ap, 1, ((int)blockIdx.x - rem_) * NWAVES + F.wave, (F.G - rem_) * NWAVES, part); } \
        else if (!rem_) { REOPAQUE(); p0_weights(F, ap, 1, (int)blockIdx.x * NWAVES + F.wave, F.G * NWAVES, part); } } while (0)

template <int l> __device__ __forceinline__ void layer_phases(Frame& F, CArgsP& ap, const XcdBarrier& bar, const int lo, const int hi) {
    constexpr int P0 = 1 + l * PH_PER_LAYER;
#define WL (F.ws + WS_W)
#define SSP ((float*)(F.ctl + CW_SS))
    PH_BEGIN(P0 + K_G1) {
        int kk_ = 1024; asm volatile("" : "+s"(kk_)); pg8::Gemm g{(const bf16*)(F.ws + WS_XB), (const bf16*)(WL + W_IN), MT, P_DA + P_RW, kk_}; pg8::StaticOrder S; S.init(MT, P_DA + P_RW, F.G, (int)blockIdx.x);
        pg8::EpiIn E{SSP + (size_t)(2 * l) * MT, (const float*)(F.ws + WS_ROPE), (bf16*)(F.ws + B_Q), (bf16*)(F.ws + B_K), (bf16*)(F.ws + B_V), (bf16*)(F.ws + B_URW),
                     F.out + O_KP + (size_t)l * MP * 1024, F.out + O_VP + (size_t)l * MP * 1024, F.out + O_KS + (size_t)l * MS * 1024, F.out + O_VS + (size_t)l * MS * 1024,
                     F.out + O_SHP + (size_t)l * BATCH * P_RW, F.out + O_SHS + (size_t)l * DEC_BATCH * P_RW};
        pg8::gemm_phase<pg8::EpiIn, pg8::StaticOrder, true, true>(F.lds + RING_OFF, g, S, E);
        if constexpr (l == 0) IDLE_CONVERT((MT / 256) * ((P_DA + P_RW) / 256), WP_UP | WP_DN);
    } PH_END(P0 + K_G1)
    PH_BEGIN(P0 + K_LP) { ph_linprep(F, ap, l); } PH_END(P0 + K_LP)
    PH_BEGIN(P0 + K_LR) { } PH_END_NOBAR(P0 + K_LR)
    PH_BEGIN(P0 + K_SC) {
        const int NSC = (F.G >= 256) ? 128 : F.G / 2;
        if (!(F.vcu & 1) && (F.vcu >> 1) < NSC) { ph_scan(F, ap, l, F.vcu >> 1, NSC); REOPAQUE(); }
        ph_attn(F, ap, l);
    } PH_END(P0 + K_SC)
    PH_BEGIN(P0 + K_CB) {
        ph_combine(F, ap, l);
        int kk_ = 1024; asm volatile("" : "+s"(kk_)); pg8::Gemm g{(const bf16*)(F.ws + WS_XB), (const bf16*)(WL + W_IN) + (size_t)(P_DA + P_RW) * 1024, MP, P_GATE, kk_}; pg8::StaticOrder S; S.init(MP, P_GATE, F.G, (int)blockIdx.x);
        pg8::EpiGate E{SSP + (size_t)(2 * l) * MT, (bf16*)(F.ws + B_GATE)};
        pg8::gemm_phase<pg8::EpiGate, pg8::StaticOrder, true, true>(F.lds + RING_OFF, g, S, E);
        REOPAQUE(); mini_gate(F, (const bf16*)(F.ws + WS_XB), (const bf16*)(WL + W_IN) + (size_t)(P_DA + P_RW) * 1024, SSP + (size_t)(2 * l) * MT, (bf16*)(F.ws + B_GATE));
    } PH_END(P0 + K_CB)
    PH_BEGIN(P0 + K_M1) {
        int kk_ = 1024; asm volatile("" : "+s"(kk_)); pg8::Gemm g{(const bf16*)(F.ws + B_OA), (const bf16*)(WL + W_ODA), MP, 1024, kk_}; pg8::StaticOrder S; S.init(MP, 1024, F.G, (int)blockIdx.x);
        pg8::EpiGated E{(const bf16*)(F.ws + B_GATE), 0, nullptr, (bf16*)(F.ws + B_MRG)};
        pg8::gemm_phase<pg8::EpiGated, pg8::StaticOrder, true, true>(F.lds + RING_OFF, g, S, E);
        REOPAQUE(); mini_gated(F, (const bf16*)(F.ws + B_OA), (const bf16*)(WL + W_ODA), (const bf16*)(F.ws + B_GATE), 0, nullptr, (bf16*)(F.ws + B_MRG));
    } PH_END_NOBAR(P0 + K_M1)
    PH_BEGIN(P0 + K_M2) {
        int kk_ = 1024; asm volatile("" : "+s"(kk_)); pg8::Gemm g{(const bf16*)(F.ws + B_ORW), (const bf16*)(WL + W_ORW), MP, 1024, kk_}; pg8::StaticOrder S; S.init(MP, 1024, F.G, (int)blockIdx.x);
        pg8::EpiGated E{(const bf16*)(F.ws + B_GATE), 1024, (const bf16*)(F.ws + B_MRG), (bf16*)(F.ws + B_MRG)};
        pg8::gemm_phase<pg8::EpiGated, pg8::StaticOrder, true, true>(F.lds + RING_OFF, g, S, E);
        REOPAQUE(); mini_gated(F, (const bf16*)(F.ws + B_ORW), (const bf16*)(WL + W_ORW), (const bf16*)(F.ws + B_GATE), 1024, (const bf16*)(F.ws + B_MRG), (bf16*)(F.ws + B_MRG));
    } PH_END(P0 + K_M2)
    PH_BEGIN(P0 + K_WO) {
        int kk_ = 1024; asm volatile("" : "+s"(kk_)); pg8::Gemm g{(const bf16*)(F.ws + B_MRG), (const bf16*)(WL + W_OUT), MP, 1024, kk_}; pg8::StaticOrder S; S.init(MP, 1024, F.G, (int)blockIdx.x);
        pg8::EpiRes E{l == 0 ? GIN(ap, 0) : (const float*)(F.out + O_YP), F.out + O_YP, (bf16*)(F.ws + WS_XB), SSP + (size_t)(2 * l + 1) * MT};
        pg8::gemm_phase<pg8::EpiRes, pg8::StaticOrder, true, true>(F.lds + RING_OFF, g, S, E);
        REOPAQUE(); mini_res<8>(F, (const bf16*)(F.ws + B_MRG), (const bf16*)(WL + W_OUT), 1024, l == 0 ? GIN(ap, 1) : (const float*)(F.out + O_YP + (size_t)MP * 1024), F.out + O_YP, (bf16*)(F.ws + WS_XB), SSP + (size_t)(2 * l + 1) * MT);
    } PH_END(P0 + K_WO)
    PH_BEGIN(P0 + K_UP) {
        int kk_ = 1024; asm volatile("" : "+s"(kk_)); pg8::Gemm g{(const bf16*)(F.ws + WS_XB), (const bf16*)(WL + (l ? W_UP1 : W_UP)), pg8::UC_TILES * 256, UPW, kk_, pg8::UC_ROWS, -2};
        pg8::StaticOrder S; S.init(pg8::UC_TILES * 256, UPW, F.G, (int)blockIdx.x);
        pg8::EpiUpConv E{SSP + (size_t)(2 * l + 1) * MT, (bf16*)(F.ws + B_GT), GIN(ap, 27) + (size_t)l * 3 * UPW, GIN(ap, 28) + (size_t)l * UPW, (LAS float*)(F.lds + UC_HALO_OFF)};
        pg8::gemm_phase<pg8::EpiUpConv, pg8::StaticOrder, true, true>(F.lds + RING_OFF, g, S, E);
        REOPAQUE(); up_edge_rows(F, ap, l, (const bf16*)(F.ws + WS_XB), (const bf16*)(WL + (l ? W_UP1 : W_UP)), SSP + (size_t)(2 * l + 1) * MT, (bf16*)(F.ws + B_GT),
                                 F.out + O_CVP + (size_t)l * BATCH * 2 * UPW, F.out + O_CVS + (size_t)l * DEC_BATCH * 2 * UPW);
        if constexpr (l == 0) IDLE_CONVERT(pg8::UC_TILES * (UPW / 256), WP_IN | WP_SQ | WP_LORA);
    } PH_END(P0 + K_UP)
    PH_BEGIN(P0 + K_CV) { } PH_END_NOBAR(P0 + K_CV)
    PH_BEGIN(P0 + K_DN) {
        int kk_ = D_FF; asm volatile("" : "+s"(kk_)); pg8::Gemm g{(const bf16*)(F.ws + B_GT), (const bf16*)(l ? F.ws + WS_DN1 : WL + W_DN), MP, 1024, kk_}; pg8::StaticOrder S; S.init(MP, 1024, F.G, (int)blockIdx.x);
        pg8::EpiRes E{F.out + O_YP, F.out + O_YP, (bf16*)(F.ws + WS_XB), SSP + (size_t)(2 * l + 2) * MT};
        pg8::gemm_phase<pg8::EpiRes, pg8::StaticOrder, true, true>(F.lds + RING_OFF, g, S, E);
        REOPAQUE(); mini_res<11>(F, (const bf16*)(F.ws + B_GT), (const bf16*)(l ? F.ws + WS_DN1 : WL + W_DN), D_FF, F.out + O_YP + (size_t)MP * 1024, F.out + O_YP, (bf16*)(F.ws + WS_XB), SSP + (size_t)(2 * l + 2) * MT);
    } PH_END(P0 + K_DN)
#undef WL
#undef SSP
}

__global__ void __launch_bounds__(NWAVES * 64, 2) mk_fwd(Args args) {
    extern __shared__ __attribute__((aligned(16))) unsigned char lds[];
    Frame F;
    F.lds = (LAS unsigned char*)lds;
    F.MISC = (volatile LAS unsigned*)(F.lds + MISC_OFF);
    F.tid = threadIdx.x; F.lane = F.tid & 63; F.wave = __builtin_amdgcn_readfirstlane(F.tid >> 6);
    F.G = gridDim.x; { const int bx = blockIdx.x; F.vcu = (F.G % 8 == 0) ? (bx % 8) * (F.G / 8) + bx / 8 : bx; }
    F.out = (float*)args.out; F.ws = (unsigned char*)args.ws;
    F.ctl = (gu32*)(args.ws + WS_CTL);
    for (int u = F.tid; u < (LDS_BYTES - LDSCTL_OFF) / 4; u += NWAVES * 64) ((LAS unsigned*)(F.lds + LDSCTL_OFF))[u] = 0u;
    __syncthreads();
    XcdBarrier bar; bar.bar = (unsigned*)(F.ctl + CW_BAR); bar.x = 0; bar.st = nullptr;
    if (!MK_PER_PHASE) bar = xcd_barrier_post((unsigned*)(F.ctl + CW_BAR), F.MISC + 8);
    const int lo = args.ph_lo, hi = args.ph_hi;
    CArgsP ap;
    PH_BEGIN(0) { p0_prologue(F, ap); } PH_END(0)
    layer_phases<0>(F, ap, bar, lo, hi);
    layer_phases<1>(F, ap, bar, lo, hi);
    PH_BEGIN(NPHASE - 1) { ph_final(F, ap); } PH_END(NPHASE - 1)
    if (MK_PROBE_MASK) { __syncthreads(); if (threadIdx.x == 0) { const unsigned t0 = (unsigned)rt(), dt = F.MISC[13] * MK_PROBE_AMP; while ((unsigned)rt() - t0 < dt) __builtin_amdgcn_s_sleep(8); } __syncthreads(); }
}

extern "C" void kernel_launch(void* const* d_in, const int* in_sizes, int n_in, void* d_out, int out_size, void* d_ws, size_t ws_size, hipStream_t stream) {
    (void)in_sizes;
    static int grid = 0;
    if (grid == 0) {
        if (n_in != 31 || out_size != (int)O_END || ws_size < B_END2) { fprintf(stderr, "kernel_launch: unexpected shapes (n_in %d out %d ws %zu)\n", n_in, out_size, ws_size); grid = -1; return; }
        int dev = 0, cus = 0;
        if (hipGetDevice(&dev) != hipSuccess || hipDeviceGetAttribute(&cus, hipDeviceAttributeMultiprocessorCount, dev) != hipSuccess) { grid = -1; return; }
        if (hipFuncSetAttribute((const void*)mk_fwd, hipFuncAttributeMaxDynamicSharedMemorySize, LDS_BYTES) != hipSuccess) { fprintf(stderr, "kernel_launch: hipFuncSetAttribute failed\n"); grid = -1; return; }
        (void)hipGetLastError();
        grid = cus;
    }
    if (grid < 0) return;
    if (hipMemsetAsync((char*)d_ws + WS_CTL, 0, CTL_ZERO_BYTES, stream) != hipSuccess) { fprintf(stderr, "kernel_launch: memset failed\n"); return; }
    Args a{};
    for (int i = 0; i < 31; ++i) a.in[i] = (const GAS float*)d_in[i];
    a.out = (GAS float*)d_out; a.ws = (GAS unsigned char*)d_ws;
    for (int i = 0; i < 8; ++i) a.rinv[i] = (float)pow(500000.0, -(double)i / 8.0);
#if MK_PER_PHASE
    for (int p = 0; p < NPHASE; ++p) { a.ph_lo = p; a.ph_hi = p + 1; hipLaunchKernelGGL(mk_fwd, dim3(grid), dim3(NWAVES * 64), LDS_BYTES, stream, a); }
#else
    a.ph_lo = 0; a.ph_hi = NPHASE;
    hipLaunchKernelGGL(mk_fwd, dim3(grid), dim3(NWAVES * 64), LDS_BYTES, stream, a);
#endif
    const hipError_t le = hipPeekAtLastError();
    if (le != hipSuccess) fprintf(stderr, "kernel_launch: launch failed: %s\n", hipGetErrorName(le));
}
```
